# Optimizing an MI355X kernel written in HIP

```python
import math
import jax
import jax.numpy as jnp
from jax import lax
import numpy as np

D_MODEL = 1024
BATCH = 8
SEQ = 2048
DEPTH = 2

D_MIX = D_MODEL
HEAD_DIM = 64
RWKV_WIDTH = D_MIX // 2
RWKV_HEADS = RWKV_WIDTH // HEAD_DIM
MOBA_WIDTH = D_MIX - RWKV_WIDTH
MOBA_HEADS = MOBA_WIDTH // HEAD_DIM
DECAY_LORA = 64
ICLR_LORA = 64
GATE_LORA = 128
RWKV_PROJ = 3 * RWKV_WIDTH + DECAY_LORA + ICLR_LORA + GATE_LORA
MOBA_PROJ = 3 * MOBA_WIDTH
D_PROJ = RWKV_PROJ + MOBA_PROJ
LNX_EPS = 64e-5
MOBA_BLOCK = 256
MOBA_TOPK = 3
MOBA_Q_CHUNK = 16
REL_BUCKETS = 32
REL_MAX_DISTANCE = 1024
MEM_LEN = 256
XATTN_HEADS = 4
XATTN_HEAD_DIM = D_MODEL // XATTN_HEADS
D_FF = ((8 * D_MODEL // 3 + 127) // 128) * 128
FFN_RES_WEIGHT = 0.5
NORM_EPS = 1e-6

kernel_name = "hybrid_rwkv7_moba_macaron"


def rms_norm(x, g):
    xf = x.astype(jnp.float32)
    y = xf * lax.rsqrt(jnp.mean(xf * xf, axis=-1, keepdims=True) + NORM_EPS)
    return (y * g.astype(jnp.float32)).astype(x.dtype)


def swiglu_ffn(h, w_in, w_out):
    gate, up = jnp.split(h @ w_in, 2, axis=-1)
    return (jax.nn.silu(gate) * up) @ w_out


def token_shift(z):
    return jnp.pad(z, ((0, 0), (1, 0), (0, 0)))[:, :-1]


def rel_bucket(dist):
    n = jnp.maximum(dist, 0)
    max_exact = REL_BUCKETS // 2
    nf = jnp.maximum(n, 1).astype(jnp.float32)
    large = max_exact + (jnp.log(nf / max_exact) / math.log(REL_MAX_DISTANCE / max_exact)
                         * (REL_BUCKETS - max_exact)).astype(jnp.int32)
    large = jnp.minimum(large, REL_BUCKETS - 1)
    return jnp.where(n < max_exact, n, large)


def rwkv7_time_mix(p, mu, w0, w_up, a0, a_up, g_up, k_k, k_a, r_k, ln_g, ln_b):
    B, S, _ = p.shape
    H, Dh, W = RWKV_HEADS, HEAD_DIM, RWKV_WIDTH
    dt = p.dtype
    f32 = jnp.float32
    p = p + (token_shift(p) - p) * mu
    r, k, v, w_lo, a_lo, g_lo = jnp.split(
        p, [W, 2 * W, 3 * W, 3 * W + DECAY_LORA, 3 * W + DECAY_LORA + ICLR_LORA], axis=-1)
    w_log = -jax.nn.softplus(-(w0 + jnp.tanh(w_lo) @ w_up).astype(f32)) - 0.5
    decay = jnp.exp(-jnp.exp(w_log))
    a = jax.nn.sigmoid(a0 + a_lo @ a_up)
    g = jax.nn.sigmoid(g_lo) @ g_up
    kk = k * k_k
    k = k * (1 + (a - 1) * k_a)
    heads = lambda z: z.reshape(B, S, H, Dh).astype(f32)
    r, k, v, a, decay, kk = (heads(z) for z in (r, k, v, a, decay, kk))
    kk = kk / jnp.maximum(jnp.sqrt(jnp.sum(kk * kk, axis=-1, keepdims=True)), 1e-12)
    b = kk * a

    def step(state, inp):
        r_t, w_t, k_t, v_t, kk_t, b_t = inp
        sa = jnp.einsum('bhij,bhj->bhi', state, -kk_t)
        state = (state * w_t[:, :, None, :] + sa[..., None] * b_t[:, :, None, :]
                 + v_t[..., None] * k_t[:, :, None, :])
        return state, jnp.einsum('bhij,bhj->bhi', state, r_t)

    tm = lambda z: jnp.swapaxes(z, 0, 1)
    state0 = jnp.zeros((B, H, Dh, Dh), f32)
    _, y = lax.scan(step, state0, tuple(tm(z) for z in (r, decay, k, v, kk, b)))
    y = tm(y)
    mean = jnp.mean(y, axis=-1, keepdims=True)
    var = jnp.mean(jnp.square(y - mean), axis=-1, keepdims=True)
    y = ((y - mean) * lax.rsqrt(var + LNX_EPS)).reshape(B, S, W) * ln_g + ln_b
    bonus = jnp.sum(r * k * r_k, axis=-1, keepdims=True) * v
    y = y + bonus.reshape(B, S, W)
    return (y * g).astype(dt)


def moba_attention(q, k, v, rel_bias):
    B, S, _ = q.shape
    H, Dh, BLK, QC = MOBA_HEADS, HEAD_DIM, MOBA_BLOCK, MOBA_Q_CHUNK
    f32 = jnp.float32
    nb = -(-S // BLK)
    pad = nb * BLK - S
    to_heads = lambda z: z.reshape(B, S, H, Dh).transpose(0, 2, 1, 3)
    q = to_heads(q) * (Dh ** -0.5)
    k = jnp.pad(to_heads(k), ((0, 0), (0, 0), (0, pad), (0, 0)))
    v = jnp.pad(to_heads(v), ((0, 0), (0, 0), (0, pad), (0, 0)))
    kb = k.reshape(B, H, nb, BLK, Dh)
    vb = v.reshape(B, H, nb, BLK, Dh)
    k_mean = jnp.mean(kb.astype(f32), axis=3).astype(q.dtype)
    topk = min(MOBA_TOPK, nb)
    n_chunks = S // QC
    qc = q.reshape(B, H, n_chunks, QC, Dh).transpose(2, 0, 1, 3, 4)
    b_ix = jnp.arange(B)[:, None, None, None]
    h_ix = jnp.arange(H)[None, :, None, None]
    blk_ar = jnp.arange(BLK)

    def chunk_fn(args):
        q_c, c = args
        q_start = c * QC
        q_pos = q_start + jnp.arange(QC)
        q_blk = q_start // BLK
        gate = jnp.einsum('bhqd,bhnd->bhqn', q_c, k_mean)
        gate = jnp.where(jnp.arange(nb) < q_blk, gate, -jnp.inf)
        _, idx = lax.top_k(gate, topk)
        valid = idx < q_blk
        k_sel = kb[b_ix, h_ix, idx]
        v_sel = vb[b_ix, h_ix, idx]
        k_pos_sel = idx[..., None] * BLK + blk_ar
        bias_sel = rel_bias[h_ix[..., None], rel_bucket(q_pos[None, None, :, None, None] - k_pos_sel)]
        s_sel = jnp.einsum('bhqd,bhqtkd->bhqtk', q_c, k_sel).astype(f32) + bias_sel.astype(f32)
        s_sel = jnp.where(valid[..., None], s_sel, -jnp.inf)
        k_own = lax.dynamic_index_in_dim(kb, q_blk, axis=2, keepdims=False)
        v_own = lax.dynamic_index_in_dim(vb, q_blk, axis=2, keepdims=False)
        own_pos = q_blk * BLK + blk_ar
        bias_own = rel_bias[:, rel_bucket(q_pos[:, None] - own_pos[None, :])]
        s_own = jnp.einsum('bhqd,bhkd->bhqk', q_c, k_own).astype(f32) + bias_own.astype(f32)[None]
        s_own = jnp.where(own_pos[None, :] <= q_pos[:, None], s_own, -jnp.inf)
        logits = jnp.concatenate([s_sel.reshape(B, H, QC, topk * BLK), s_own], axis=-1)
        probs = jax.nn.softmax(logits, axis=-1).astype(v.dtype)
        p_sel = probs[..., :topk * BLK].reshape(B, H, QC, topk, BLK)
        p_own = probs[..., topk * BLK:]
        return (jnp.einsum('bhqtk,bhqtkd->bhqd', p_sel, v_sel)
                + jnp.einsum('bhqk,bhkd->bhqd', p_own, v_own))

    out = lax.map(chunk_fn, (qc, jnp.arange(n_chunks)))
    return out.transpose(1, 0, 3, 2, 4).reshape(B, S, H * Dh)


def memory_cross_attention(h, mem_n, w_q, w_kv, w_o):
    B, S, D = h.shape
    M = mem_n.shape[1]
    q = (h @ w_q).reshape(B, S, XATTN_HEADS, XATTN_HEAD_DIM)
    k, v = jnp.split(mem_n @ w_kv, 2, axis=-1)
    k = k.reshape(B, M, XATTN_HEADS, XATTN_HEAD_DIM)
    v = v.reshape(B, M, XATTN_HEADS, XATTN_HEAD_DIM)
    logits = jnp.einsum('bshd,bmhd->bhsm', q, k).astype(jnp.float32) * (XATTN_HEAD_DIM ** -0.5)
    probs = jax.nn.softmax(logits, axis=-1).astype(v.dtype)
    o = jnp.einsum('bhsm,bmhd->bshd', probs, v).reshape(B, S, D)
    return o @ w_o


def setup_inputs(seed: int = 0) -> dict:
    key = jax.random.key(seed)
    ks = iter(jax.random.split(key, 40))
    f32 = jnp.float32

    def nrm(shape, scale):
        return scale * jax.random.normal(next(ks), shape, f32)

    def dense(fan_in, fan_out):
        return nrm((DEPTH, fan_in, fan_out), fan_in ** -0.5)

    def gain(n):
        return 1.0 + nrm((DEPTH, n), 0.02)

    W = RWKV_WIDTH
    return {
        "x": nrm((BATCH, SEQ, D_MODEL), 1.0),
        "mem": nrm((BATCH, MEM_LEN, D_MODEL), 1.0),
        "rel_bias": nrm((MOBA_HEADS, REL_BUCKETS), 0.5),
        "final_norm_g": 1.0 + nrm((D_MODEL,), 0.02),
        "ffn1_norm_g": gain(D_MODEL),
        "ffn1_w_in": dense(D_MODEL, 2 * D_FF),
        "ffn1_w_out": dense(D_FF, D_MODEL),
        "mix_norm_g": gain(D_MODEL),
        "w_mix_in": dense(D_MODEL, D_PROJ),
        "w_mix_out": dense(D_MIX, D_MODEL),
        "rwkv_mu": jax.random.uniform(next(ks), (DEPTH, RWKV_PROJ), f32),
        "rwkv_w0": jnp.linspace(-6.0, -1.0, W, dtype=f32)[None, :] + nrm((DEPTH, W), 0.1),
        "rwkv_w_up": nrm((DEPTH, DECAY_LORA, W), 0.5 * DECAY_LORA ** -0.5),
        "rwkv_a0": nrm((DEPTH, W), 0.1),
        "rwkv_a_up": dense(ICLR_LORA, W),
        "rwkv_g_up": dense(GATE_LORA, W),
        "rwkv_k_k": 0.85 + nrm((DEPTH, W), 0.02),
        "rwkv_k_a": 1.0 + nrm((DEPTH, W), 0.02),
        "rwkv_r_k": nrm((DEPTH, RWKV_HEADS, HEAD_DIM), 0.1),
        "rwkv_ln_g": gain(W),
        "rwkv_ln_b": nrm((DEPTH, W), 0.02),
        "xattn_norm_g": gain(D_MODEL),
        "mem_norm_g": gain(D_MODEL),
        "xattn_w_q": dense(D_MODEL, D_MODEL),
        "xattn_w_kv": dense(D_MODEL, 2 * D_MODEL),
        "xattn_w_o": dense(D_MODEL, D_MODEL),
        "ffn2_norm_g": gain(D_MODEL),
        "ffn2_w_in": dense(D_MODEL, 2 * D_FF),
        "ffn2_w_out": dense(D_FF, D_MODEL),
    }


def reference(x, mem, rel_bias, final_norm_g, ffn1_norm_g, ffn1_w_in, ffn1_w_out, mix_norm_g,
              w_mix_in, w_mix_out, rwkv_mu, rwkv_w0, rwkv_w_up, rwkv_a0, rwkv_a_up, rwkv_g_up,
              rwkv_k_k, rwkv_k_a, rwkv_r_k, rwkv_ln_g, rwkv_ln_b, xattn_norm_g, mem_norm_g,
              xattn_w_q, xattn_w_kv, xattn_w_o, ffn2_norm_g, ffn2_w_in, ffn2_w_out):
    for l in range(DEPTH):
        x = x + FFN_RES_WEIGHT * swiglu_ffn(rms_norm(x, ffn1_norm_g[l]), ffn1_w_in[l], ffn1_w_out[l])
        proj = rms_norm(x, mix_norm_g[l]) @ w_mix_in[l]
        p_rwkv = proj[..., :RWKV_PROJ]
        q_m, k_m, v_m = jnp.split(proj[..., RWKV_PROJ:], 3, axis=-1)
        y_rwkv = rwkv7_time_mix(p_rwkv, rwkv_mu[l], rwkv_w0[l], rwkv_w_up[l], rwkv_a0[l],
                                rwkv_a_up[l], rwkv_g_up[l], rwkv_k_k[l], rwkv_k_a[l], rwkv_r_k[l],
                                rwkv_ln_g[l], rwkv_ln_b[l])
        y_moba = moba_attention(q_m, k_m, v_m, rel_bias)
        x = x + jnp.concatenate([y_rwkv, y_moba], axis=-1) @ w_mix_out[l]
        x = x + memory_cross_attention(rms_norm(x, xattn_norm_g[l]), rms_norm(mem, mem_norm_g[l]),
                                       xattn_w_q[l], xattn_w_kv[l], xattn_w_o[l])
        x = x + FFN_RES_WEIGHT * swiglu_ffn(rms_norm(x, ffn2_norm_g[l]), ffn2_w_in[l], ffn2_w_out[l])
    return rms_norm(x, final_norm_g)
```

```cpp
#include <hip/hip_runtime.h>
#include <hip/hip_cooperative_groups.h>
#include <cstdio>
#include <cstdint>

constexpr int BATCH = 8, SEQ = 2048, DM = 1024, DEPTH = 2, M = BATCH * SEQ;
constexpr int RW = 512, NH = 8, HD = 64;
constexpr int RPROJ = 1792, DPROJ = 3328;
constexpr int DFF = 2816;
constexpr int MEMLEN = 256, XH = 4, XHD = 256, MM = BATCH * MEMLEN;
constexpr int MBLK = 256, NBLK = SEQ / MBLK;
constexpr float NORM_EPS = 1e-6f, LNX_EPS = 64e-5f;
constexpr float LOG2E = 1.4426950408889634f;
constexpr float MOBA_QSCALE = 0.125f * LOG2E;
constexpr float XATT_QSCALE = 0.0625f * LOG2E;

enum { I_X = 0, I_MEM, I_RELB, I_FING, I_F1G, I_F1IN, I_F1OUT, I_MIXG, I_MIXIN, I_MIXOUT, I_MU, I_W0, I_WUP, I_A0, I_AUP, I_GUP, I_KK, I_KA, I_RK, I_LNG, I_LNB,
       I_XG, I_MEMG, I_WQ, I_WKV, I_WO, I_F2G, I_F2IN, I_F2OUT, N_IN };

constexpr size_t MiB = 1u << 20;
constexpr size_t WS_CTL = 0, CTL_ZERO_BYTES = 1 * MiB;
constexpr size_t WS_BIAS = 1 * MiB;
constexpr size_t WS_MEMRS = WS_BIAS + 64 * 1024;
constexpr size_t WS_BONUS = WS_MEMRS + 64 * 1024;
constexpr size_t WS_SSQ = 2 * MiB;
constexpr size_t WS_MEMB = 3 * MiB;
constexpr size_t WS_XK = 7 * MiB, WS_XVT = 11 * MiB;
constexpr size_t WS_W = 15 * MiB;
constexpr size_t W_F1IN = 0, W_F1OUT = W_F1IN + (size_t)2 * DFF * DM * 2, W_F2IN = W_F1OUT + (size_t)DM * DFF * 2, W_F2OUT = W_F2IN + (size_t)2 * DFF * DM * 2,
                 W_MIXIN = W_F2OUT + (size_t)DM * DFF * 2, W_MIXOUT = W_MIXIN + (size_t)DPROJ * DM * 2, W_WQ = W_MIXOUT + (size_t)DM * DM * 2, W_WKV = W_WQ + (size_t)DM * DM * 2,
                 W_WO = W_WKV + (size_t)2 * DM * DM * 2, W_END = W_WO + (size_t)DM * DM * 2;
static_assert(W_END <= 50 * MiB, "weights fit");
constexpr size_t WS_XB = 65 * MiB;
constexpr size_t WS_AR = 97 * MiB;
constexpr size_t AR_H = WS_AR;
constexpr size_t AR_PR = WS_AR, AR_MQ = WS_AR + 56 * MiB, AR_MK = WS_AR + 72 * MiB, AR_MVT = WS_AR + 88 * MiB;
constexpr size_t AR_SCANIN = WS_AR + 56 * MiB;
constexpr size_t AR_YLOC = WS_AR, AR_Z = WS_AR + 32 * MiB;
constexpr size_t AR_STATE = WS_AR + 152 * MiB;
constexpr size_t AR_XB2 = WS_AR, AR_XQ = WS_AR + 32 * MiB, AR_XO = WS_AR + 64 * MiB;
constexpr size_t WS_END = WS_AR + 168 * MiB;

#define GAS __attribute__((address_space(1)))
#define LAS __attribute__((address_space(3)))

namespace pg8 {
#define PG8_LAS __attribute__((address_space(3)))
typedef unsigned short bf16_t;
typedef short bf16x8 __attribute__((ext_vector_type(8)));
typedef float f32x4 __attribute__((ext_vector_type(4)));
typedef unsigned u32x4 __attribute__((ext_vector_type(4)));
constexpr int BM = 256, BK = 64, HALF = 128, HTB = HALF * BK * 2  , STAGE_BYTES = 8 * HTB, NXCD = 8, WGM = 8;

__host__ __device__ __forceinline__ int lds_byte(int r, int c) { const int st = (r >> 4) * 2 + (c >> 5), rr = r & 15, cc = c & 31, ob = rr * 64 + cc * 2; return st * 1024 + (ob ^ (((ob >> 9) & 1) << 5)); }
__host__ __device__ __forceinline__ void stage_rc(int b, int& R, int& C) { const int st = b / 1024, sb = b % 1024, swz = sb ^ (((sb >> 9) & 1) << 5); R = (st >> 1) * 16 + swz / 64; C = (st & 1) * 32 + (swz % 64) / 2; }
__host__ __device__ __forceinline__ int perm32(int rho) { const int n = rho >> 4, i = rho & 15; return 8 * (i >> 2) + 4 * n + (i & 3); }

struct Unit { int pm, pn; };
struct Gemm { const bf16_t* A; const bf16_t* Bt; int M, N, K; };

struct StaticOrder {
    int nM, nN, nwg, G, c;
    __host__ __device__ void init(int M, int N, int G_, int c_) { nM = M / BM; nN = N / BM; nwg = nM * nN; G = G_; c = c_; }
    __host__ __device__ bool next(int i, Unit& u) const {
        const long L = (long)i * G + c; if (L >= nwg) return false;
        int wgid = (int)L; { const int q = nwg / NXCD, r = nwg % NXCD, xcd = wgid % NXCD, off = wgid / NXCD; wgid = (xcd < r ? xcd * (q + 1) : r * (q + 1) + (xcd - r) * q) + off; }
        const int nig = WGM * nN, gid = wgid / nig, fm = gid * WGM, gsz = (nM - fm) < WGM ? (nM - fm) : WGM;
        u.pm = fm + ((wgid % nig) % gsz); u.pn = (wgid % nig) / gsz; return true;
    }
    __device__ __forceinline__ void a_ready(const Unit&) const {}
    __device__ __forceinline__ void done(const Unit&) const {}
};

__device__ __forceinline__ unsigned cvt_pk_bf16(float lo, float hi) { unsigned r; asm volatile("v_cvt_pk_bf16_f32 %0, %1, %2" : "=v"(r) : "v"(lo), "v"(hi)); return r; }
typedef float f32x2 __attribute__((ext_vector_type(2)));
__device__ __forceinline__ float row_rstd16(const float* ssq, int r) {
    const f32x4* p = (const f32x4*)(ssq + (size_t)r * 16);
    const f32x4 a = p[0], b = p[1], c = p[2], d = p[3];
    const float s = ((a[0] + a[1]) + (a[2] + a[3])) + ((b[0] + b[1]) + (b[2] + b[3])) + ((c[0] + c[1]) + (c[2] + c[3])) + ((d[0] + d[1]) + (d[2] + d[3]));
    return __builtin_amdgcn_rsqf(s * (1.0f / 1024.0f) + 1e-6f);
}
__device__ __forceinline__ float silu_mul(float g, float u) { return g * __builtin_amdgcn_rcpf(1.0f + __expf(-g)) * u; }
__device__ __forceinline__ u32x4 pack8(const f32x4 v0, const f32x4 v1) { u32x4 w; w.x = cvt_pk_bf16(v0[0], v0[1]); w.y = cvt_pk_bf16(v0[2], v0[3]); w.z = cvt_pk_bf16(v1[0], v1[1]); w.w = cvt_pk_bf16(v1[2], v1[3]); return w; }
__device__ __forceinline__ int pos16(int k) { return 8 * ((k >> 2) & 1) + (k & 3) + 4 * (k >> 3); }

struct EpiSwiGLU {
    static constexpr bool PERM = true, AFTER_DRAIN = false;
    unsigned char* ws;
    __device__ __forceinline__ void operator()(const f32x4 (&acc)[2][2][4][2], const Unit& u, int wr, int wc, int fr, int fq) const {
        const int row0 = u.pm * BM + wr * 64 + fr, hcol = u.pn * 128 + wc * 32 + 8 * fq; bf16_t* H = (bf16_t*)(ws + AR_H); const float* ssq = (const float*)(ws + WS_SSQ);
#pragma unroll
        for (int ai = 0; ai < 2; ++ai)
#pragma unroll
            for (int m = 0; m < 4; ++m) { const int r = row0 + ai * HALF + m * 16; const float rs = row_rstd16(ssq, r);
                f32x4 h0, h1;
#pragma unroll
                for (int i = 0; i < 4; ++i) { h0[i] = silu_mul(acc[ai][0][m][0][i] * rs, acc[ai][1][m][0][i] * rs); h1[i] = silu_mul(acc[ai][0][m][1][i] * rs, acc[ai][1][m][1][i] * rs); }
                *(u32x4*)(H + (size_t)r * 2816 + hcol) = pack8(h0, h1); }
    }
};
struct EpiResid {
    static constexpr bool PERM = true, AFTER_DRAIN = false;
    const float* base; float* out; unsigned char* ws; size_t xb_off; float alpha;
    __device__ __forceinline__ void operator()(const f32x4 (&acc)[2][2][4][2], const Unit& u, int wr, int wc, int fr, int fq) const {
        const int row0 = u.pm * BM + wr * 64 + fr, col0 = u.pn * BM + wc * 32 + 8 * fq; bf16_t* xb = (bf16_t*)(ws + xb_off); float* ssq = (float*)(ws + WS_SSQ);
#pragma unroll
        for (int ai = 0; ai < 2; ++ai)
#pragma unroll
            for (int m = 0; m < 4; ++m) { const int r = row0 + ai * HALF + m * 16; float s = 0.f;
#pragma unroll
                for (int bj = 0; bj < 2; ++bj) { const size_t off = (size_t)r * 1024 + col0 + bj * HALF;
                    const f32x4 b0 = *(const f32x4*)(base + off), b1 = *(const f32x4*)(base + off + 4);
                    const f32x4 v0 = b0 + acc[ai][bj][m][0] * alpha, v1 = b1 + acc[ai][bj][m][1] * alpha;
                    *(f32x4*)(out + off) = v0; *(f32x4*)(out + off + 4) = v1; *(u32x4*)(xb + off) = pack8(v0, v1);
                    s += (v0[0] * v0[0] + v0[1] * v0[1]) + (v0[2] * v0[2] + v0[3] * v0[3]) + (v1[0] * v1[0] + v1[1] * v1[1]) + (v1[2] * v1[2] + v1[3] * v1[3]); }
                s += __shfl_xor(s, 16); s += __shfl_xor(s, 32);
                if (fq == 0) ssq[(size_t)r * 16 + u.pn * 4 + wc] = s; }
    }
};
struct EpiMixIn {
    static constexpr bool PERM = true, AFTER_DRAIN = false;
    unsigned char* ws;
    __device__ __forceinline__ void operator()(const f32x4 (&acc)[2][2][4][2], const Unit& u, int wr, int wc, int fr, int fq) const {
        const int row0 = u.pm * BM + wr * 64 + fr, cw = wc * 32 + 8 * fq; const float* ssq = (const float*)(ws + WS_SSQ);
        bf16_t* PR = (bf16_t*)(ws + AR_PR); bf16_t* MQ = (bf16_t*)(ws + AR_MQ); bf16_t* MK = (bf16_t*)(ws + AR_MK); bf16_t* MVT = (bf16_t*)(ws + AR_MVT);
#pragma unroll
        for (int ai = 0; ai < 2; ++ai)
#pragma unroll
            for (int m = 0; m < 4; ++m) { const int r = row0 + ai * HALF + m * 16; const float rs = row_rstd16(ssq, r);
#pragma unroll
                for (int bj = 0; bj < 2; ++bj) { const int c = cw + bj * HALF;
                    f32x4 v0 = acc[ai][bj][m][0] * rs, v1 = acc[ai][bj][m][1] * rs;
                    if (u.pn < 7) *(u32x4*)(PR + (size_t)r * 1792 + u.pn * 256 + c) = pack8(v0, v1);
                    else if (u.pn < 9) { v0 = v0 * MOBA_QSCALE; v1 = v1 * MOBA_QSCALE; *(u32x4*)(MQ + (size_t)r * 512 + (u.pn - 7) * 256 + c) = pack8(v0, v1); }
                    else if (u.pn < 11) *(u32x4*)(MK + (size_t)r * 512 + (u.pn - 9) * 256 + c) = pack8(v0, v1);
                    else { const int cc = (u.pn - 11) * 256 + c, hh = cc >> 6, d = cc & 63, b = r >> 11, t = r & 2047;
                        bf16_t* p = MVT + ((size_t)(b * 8 + hh) * 64 + d) * 2048 + (t & ~15) + pos16(t & 15);
                        const u32x4 w = pack8(v0, v1);
                        p[0] = (bf16_t)(w.x & 0xffffu); p[2048] = (bf16_t)(w.x >> 16); p[2 * 2048] = (bf16_t)(w.y & 0xffffu); p[3 * 2048] = (bf16_t)(w.y >> 16);
                        p[4 * 2048] = (bf16_t)(w.z & 0xffffu); p[5 * 2048] = (bf16_t)(w.z >> 16); p[6 * 2048] = (bf16_t)(w.w & 0xffffu); p[7 * 2048] = (bf16_t)(w.w >> 16); }
                } }
    }
};
struct EpiXQ {
    static constexpr bool PERM = true, AFTER_DRAIN = false;
    unsigned char* ws;
    __device__ __forceinline__ void operator()(const f32x4 (&acc)[2][2][4][2], const Unit& u, int wr, int wc, int fr, int fq) const {
        const int row0 = u.pm * BM + wr * 64 + fr, col0 = u.pn * BM + wc * 32 + 8 * fq; bf16_t* Q = (bf16_t*)(ws + AR_XQ); const float* ssq = (const float*)(ws + WS_SSQ);
#pragma unroll
        for (int ai = 0; ai < 2; ++ai)
#pragma unroll
            for (int m = 0; m < 4; ++m) { const int r = row0 + ai * HALF + m * 16; const float rs = row_rstd16(ssq, r) * XATT_QSCALE;
#pragma unroll
                for (int bj = 0; bj < 2; ++bj) *(u32x4*)(Q + (size_t)r * 1024 + col0 + bj * HALF) = pack8(acc[ai][bj][m][0] * rs, acc[ai][bj][m][1] * rs); }
    }
};
struct EpiKV {
    static constexpr bool PERM = true, AFTER_DRAIN = false;
    unsigned char* ws;
    __device__ __forceinline__ void operator()(const f32x4 (&acc)[2][2][4][2], const Unit& u, int wr, int wc, int fr, int fq) const {
        const int row0 = u.pm * BM + wr * 64 + fr, cw = wc * 32 + 8 * fq; bf16_t* XK = (bf16_t*)(ws + WS_XK); bf16_t* XVT = (bf16_t*)(ws + WS_XVT); const float* memrs = (const float*)(ws + WS_MEMRS);
#pragma unroll
        for (int ai = 0; ai < 2; ++ai)
#pragma unroll
            for (int m = 0; m < 4; ++m) { const int r = row0 + ai * HALF + m * 16; const float rs = memrs[r];
#pragma unroll
                for (int bj = 0; bj < 2; ++bj) { const int c = cw + bj * HALF;
                    const f32x4 v0 = acc[ai][bj][m][0] * rs, v1 = acc[ai][bj][m][1] * rs;
                    if (u.pn < 4) *(u32x4*)(XK + (size_t)r * 1024 + u.pn * 256 + c) = pack8(v0, v1);
                    else { const int hx = u.pn - 4, b = r >> 8, key = r & 255;
                        bf16_t* p = XVT + ((size_t)(b * 4 + hx) * 256 + c) * 256 + (key & ~15) + pos16(key & 15);
                        const u32x4 w = pack8(v0, v1);
                        p[0] = (bf16_t)(w.x & 0xffffu); p[256] = (bf16_t)(w.x >> 16); p[2 * 256] = (bf16_t)(w.y & 0xffffu); p[3 * 256] = (bf16_t)(w.y >> 16);
                        p[4 * 256] = (bf16_t)(w.z & 0xffffu); p[5 * 256] = (bf16_t)(w.z >> 16); p[6 * 256] = (bf16_t)(w.w & 0xffffu); p[7 * 256] = (bf16_t)(w.w >> 16); }
                } }
    }
};

template <class Epi, class Sched, bool ALIGN_EPI = false, bool SP2 = false>
__device__ __forceinline__ void gemm_phase(PG8_LAS unsigned char* lds, const Gemm g, const Sched& S, const Epi& E) {
    int tid_ = threadIdx.x; asm volatile("" : "+v"(tid_));
    const int tid = tid_, wid = __builtin_amdgcn_readfirstlane(tid >> 6), lane = tid & 63, wr = wid >> 2, wc = wid & 3, fr = lane & 15, fq = lane >> 4;
    const int K = g.K, nt = K / BK;
    unsigned voffA[2], voffB[2];
#pragma unroll
    for (int i = 0; i < 2; ++i) { int R, C; stage_rc(tid * 16 + i * 8192, R, C); const int Rb = Epi::PERM ? ((R & ~31) + perm32(R & 31)) : R;
        voffA[i] = (unsigned)(R * K + C) * 2u; voffB[i] = (unsigned)(Rb * K + C) * 2u; }
    const size_t kstep = (size_t)(BK * 2);
    const size_t hstep = (size_t)HALF * K * 2;
    const size_t tstep = 2 * hstep;
    const unsigned ldsw = (unsigned)wid * 1024u;
    const int aoff = lds_byte(wr * 64 + fr, fq * 8), boff = lds_byte(wc * 32 + fr, fq * 8);
#define PG8_SA(b, h) (((b) * 2 + (h)) * HTB)
#define PG8_SB(b, h) ((4 + (b) * 2 + (h)) * HTB)
#define PG8_STAGE(bufoff, gbase, voff) do { _Pragma("unroll") for (int _i = 0; _i < 2; ++_i) \
        __builtin_amdgcn_global_load_lds((const unsigned*)((const char*)(gbase) + (voff)[_i]), (PG8_LAS unsigned*)(lds + (bufoff) + ldsw + _i * 8192), 16, 0, 0); } while (0)
#define PG8_LDA(dst, b, h) do { _Pragma("unroll") for (int m = 0; m < 4; ++m) _Pragma("unroll") for (int k = 0; k < 2; ++k) dst[m][k] = *(const PG8_LAS bf16x8*)(lds + PG8_SA(b, h) + aoff + m * 2048 + k * 1024); } while (0)
#define PG8_LDB(dst, b, h) do { _Pragma("unroll") for (int n = 0; n < 2; ++n) _Pragma("unroll") for (int k = 0; k < 2; ++k) dst[n][k] = *(const PG8_LAS bf16x8*)(lds + PG8_SB(b, h) + boff + n * 2048 + k * 1024); } while (0)
#define PG8_MMA(ai, bj, At, Bt) do { __builtin_amdgcn_s_setprio(1); _Pragma("unroll") for (int m = 0; m < 4; ++m) _Pragma("unroll") for (int n = 0; n < 2; ++n) _Pragma("unroll") for (int k = 0; k < 2; ++k) \
        acc[ai][bj][m][n] = __builtin_amdgcn_mfma_f32_16x16x32_bf16(Bt[n][k], At[m][k], acc[ai][bj][m][n], 0, 0, 0); __builtin_amdgcn_s_setprio(0); } while (0)
#define PG8_WAIT_V(n) asm volatile("s_waitcnt vmcnt(" #n ")" ::: "memory")
#define PG8_WAIT_L(n) asm volatile("s_waitcnt lgkmcnt(" #n ")" ::: "memory")
#define PG8_BAR __builtin_amdgcn_s_barrier()
#define PG8_SCHED __builtin_amdgcn_sched_barrier(0)
    Unit cur, nxt; int ui = 0;
    if (!S.next(0, cur)) return;
    f32x4 acc[2][2][4][2];
#pragma unroll
    for (int a = 0; a < 2; ++a)
#pragma unroll
        for (int b = 0; b < 2; ++b)
#pragma unroll
            for (int m = 0; m < 4; ++m)
#pragma unroll
                for (int n = 0; n < 2; ++n) acc[a][b][m][n] = (f32x4){0.f, 0.f, 0.f, 0.f};
    bf16x8 At[4][2], B0[2][2], B1[2][2];
    const char* cA = (const char*)g.A + (size_t)cur.pm * tstep; const char* cB = (const char*)g.Bt + (size_t)cur.pn * tstep;
    S.a_ready(cur);
    if constexpr (SP2) {
        PG8_STAGE(PG8_SB(0, 0), cB, voffB); PG8_STAGE(PG8_SB(0, 1), cB + hstep, voffB); PG8_STAGE(PG8_SA(0, 0), cA, voffA); PG8_STAGE(PG8_SA(0, 1), cA + hstep, voffA);
        if (wr == 1) PG8_BAR;
        PG8_WAIT_V(2); PG8_BAR;
        PG8_STAGE(PG8_SB(1, 0), cB + kstep, voffB); PG8_STAGE(PG8_SA(1, 0), cA + kstep, voffA); PG8_STAGE(PG8_SB(1, 1), cB + hstep + kstep, voffB);
        PG8_WAIT_V(6); PG8_BAR;
    } else {
        PG8_STAGE(PG8_SB(0, 0), cB, voffB); PG8_STAGE(PG8_SA(0, 0), cA, voffA); PG8_STAGE(PG8_SB(0, 1), cB + hstep, voffB); PG8_STAGE(PG8_SA(0, 1), cA + hstep, voffA);
        if (wr == 1) PG8_BAR;
        PG8_WAIT_V(4); PG8_BAR;
        PG8_STAGE(PG8_SB(1, 0), cB + kstep, voffB); PG8_STAGE(PG8_SA(1, 0), cA + kstep, voffA); PG8_STAGE(PG8_SB(1, 1), cB + hstep + kstep, voffB);
        PG8_WAIT_V(6); PG8_BAR;
    }
    for (;;) {
        const bool has_next = S.next(ui + 1, nxt);
        const char* nA = has_next ? (const char*)g.A + (size_t)nxt.pm * tstep : cA; const char* nB = has_next ? (const char*)g.Bt + (size_t)nxt.pn * tstep : cB;
        for (int t = 0; t < nt; t += 2) {
            const bool last = (t == nt - 2);
            const char* a1 = cA + (size_t)(t + 1) * kstep;
            const char* a2 = last ? nA : cA + (size_t)(t + 2) * kstep; const char* b2 = last ? nB : cB + (size_t)(t + 2) * kstep;
            const char* a3 = a2 + kstep; const char* b3 = b2 + kstep;
            if (last && has_next) S.a_ready(nxt);
            if constexpr (SP2) {
            PG8_LDB(B0, 0, 0); PG8_LDB(B1, 0, 1); PG8_SCHED; PG8_LDA(At, 0, 0); PG8_STAGE(PG8_SA(1, 1), a1 + hstep, voffA);
            PG8_WAIT_V(8); PG8_WAIT_L(0); PG8_BAR; PG8_MMA(0, 0, At, B0); PG8_MMA(0, 1, At, B1); PG8_BAR; PG8_SCHED;
            PG8_LDA(At, 0, 1); PG8_STAGE(PG8_SB(0, 0), b2, voffB); PG8_STAGE(PG8_SB(0, 1), b2 + hstep, voffB); PG8_STAGE(PG8_SA(0, 0), a2, voffA);
            PG8_WAIT_V(8); PG8_WAIT_L(0); PG8_BAR; PG8_MMA(1, 0, At, B0); PG8_MMA(1, 1, At, B1); PG8_BAR; PG8_SCHED;
            PG8_LDB(B0, 1, 0); PG8_LDB(B1, 1, 1); PG8_SCHED; PG8_LDA(At, 1, 0); PG8_STAGE(PG8_SA(0, 1), a2 + hstep, voffA);
            PG8_WAIT_V(8); PG8_WAIT_L(0); PG8_BAR; PG8_MMA(0, 0, At, B0); PG8_MMA(0, 1, At, B1); PG8_BAR; PG8_SCHED;
            PG8_LDA(At, 1, 1); PG8_STAGE(PG8_SB(1, 0), b3, voffB); PG8_STAGE(PG8_SB(1, 1), b3 + hstep, voffB); PG8_STAGE(PG8_SA(1, 0), a3, voffA);
            PG8_WAIT_V(8); PG8_WAIT_L(0); PG8_BAR; PG8_MMA(1, 0, At, B0); PG8_MMA(1, 1, At, B1); PG8_BAR; PG8_SCHED;
            } else {
            PG8_LDB(B0, 0, 0); PG8_SCHED; PG8_LDA(At, 0, 0); PG8_STAGE(PG8_SA(1, 1), a1 + hstep, voffA);
            PG8_WAIT_L(8); PG8_BAR; PG8_WAIT_L(0); PG8_MMA(0, 0, At, B0); PG8_BAR; PG8_SCHED;
            PG8_LDB(B1, 0, 1); PG8_STAGE(PG8_SB(0, 0), b2, voffB);
            PG8_BAR; PG8_WAIT_L(0); PG8_MMA(0, 1, At, B1); PG8_BAR;
            PG8_LDA(At, 0, 1); PG8_STAGE(PG8_SA(0, 0), a2, voffA);
            PG8_BAR; PG8_WAIT_L(0); PG8_MMA(1, 0, At, B0); PG8_BAR; PG8_SCHED;
            PG8_STAGE(PG8_SB(0, 1), b2 + hstep, voffB);
            PG8_WAIT_V(6); PG8_BAR; PG8_MMA(1, 1, At, B1); PG8_BAR;
            PG8_LDB(B0, 1, 0); PG8_SCHED; PG8_LDA(At, 1, 0); PG8_STAGE(PG8_SA(0, 1), a2 + hstep, voffA);
            PG8_WAIT_L(8); PG8_BAR; PG8_WAIT_L(0); PG8_MMA(0, 0, At, B0); PG8_BAR; PG8_SCHED;
            PG8_LDB(B1, 1, 1); PG8_STAGE(PG8_SB(1, 0), b3, voffB);
            PG8_BAR; PG8_WAIT_L(0); PG8_MMA(0, 1, At, B1); PG8_BAR;
            PG8_LDA(At, 1, 1); PG8_STAGE(PG8_SA(1, 0), a3, voffA);
            PG8_BAR; PG8_WAIT_L(0); PG8_MMA(1, 0, At, B0); PG8_BAR; PG8_SCHED;
            PG8_STAGE(PG8_SB(1, 1), b3 + hstep, voffB);
            PG8_WAIT_V(6); PG8_BAR; PG8_MMA(1, 1, At, B1); PG8_BAR;
            }
        }
        if constexpr (ALIGN_EPI) { if (wr == 0) PG8_BAR; }
        if constexpr (!Epi::AFTER_DRAIN) { E(acc, cur, wr, wc, fr, fq); S.done(cur); }
        if (!has_next) break;
#pragma unroll
        for (int a = 0; a < 2; ++a)
#pragma unroll
            for (int b = 0; b < 2; ++b)
#pragma unroll
                for (int m = 0; m < 4; ++m)
#pragma unroll
                    for (int n = 0; n < 2; ++n) acc[a][b][m][n] = (f32x4){0.f, 0.f, 0.f, 0.f};
        cur = nxt; cA = nA; cB = nB; ++ui;
        if constexpr (ALIGN_EPI) { if (wr == 1) PG8_BAR; }
    }
    PG8_WAIT_V(0);
    if constexpr (!ALIGN_EPI) { if (wr == 0) PG8_BAR; }
    PG8_BAR;
    if constexpr (Epi::AFTER_DRAIN) { E.fused(acc, cur, wr, wc, fr, fq, lds, wid, lane); S.done(cur); }
#undef PG8_SA
#undef PG8_SB
#undef PG8_STAGE
#undef PG8_LDA
#undef PG8_LDB
#undef PG8_MMA
#undef PG8_WAIT_V
#undef PG8_WAIT_L
#undef PG8_BAR
#undef PG8_SCHED
}
}

constexpr int NWAVES = 8;
constexpr int RING_BYTES = 131072, LDSCTL_OFF = RING_BYTES, MISC_OFF = LDSCTL_OFF + 320, LDS_BYTES = 147456;
constexpr int SCAN_R = 1, SCAN_NCH = 1;

typedef unsigned short bf16;
typedef unsigned u32x4 __attribute__((ext_vector_type(4)));
typedef unsigned u32x2 __attribute__((ext_vector_type(2)));
typedef float f32x4 __attribute__((ext_vector_type(4)));
typedef float f32x16 __attribute__((ext_vector_type(16)));
typedef short bf16x8 __attribute__((ext_vector_type(8)));
typedef GAS unsigned gu32;
#define RLX_AGENT __ATOMIC_RELAXED, __HIP_MEMORY_SCOPE_AGENT
#define LDS_WAIT() asm volatile("s_waitcnt lgkmcnt(0)" ::: "memory")
#define VM_WAIT() asm volatile("s_waitcnt vmcnt(0)" ::: "memory")
__device__ __forceinline__ float bf2f(unsigned b) { return __uint_as_float(b << 16); }
__device__ __forceinline__ unsigned f2bf(float f) { unsigned u = __builtin_bit_cast(unsigned, f); return (u + 0x7fffu + ((u >> 16) & 1u)) >> 16; }
__device__ __forceinline__ unsigned pk2(float lo, float hi) { return pg8::cvt_pk_bf16(lo, hi); }
__device__ __forceinline__ float wave_sum(float v) {
#pragma unroll
    for (int o = 1; o < 64; o <<= 1) v += __shfl_xor(v, o);
    return v;
}
__device__ __forceinline__ float quad_sum(float x) {
    x += __builtin_bit_cast(float, __builtin_amdgcn_update_dpp(0, __builtin_bit_cast(int, x), 0xB1, 0xF, 0xF, true));
    x += __builtin_bit_cast(float, __builtin_amdgcn_update_dpp(0, __builtin_bit_cast(int, x), 0x4E, 0xF, 0xF, true));
    return x;
}
__device__ __forceinline__ float sigmoidf_(float x) { return __builtin_amdgcn_rcpf(1.0f + __expf(-x)); }
__device__ __forceinline__ int crow(int r, int hi) { return (r & 3) + 8 * (r >> 2) + 4 * hi; }
__device__ __forceinline__ bf16x8 pack_bf16x8(float a0, float a1, float a2, float a3, float a4, float a5, float a6, float a7) {
    u32x4 w; w.x = pk2(a0, a1); w.y = pk2(a2, a3); w.z = pk2(a4, a5); w.w = pk2(a6, a7); return __builtin_bit_cast(bf16x8, w);
}

#define XB_TMO      128
#define XB_XCNT(j)  (256  + 64 * (j))
#define XB_XSUB(j)  (1280 + 64 * (j))
#define XB_XGEN(j)  (2304 + 64 * (j))
#define XB_TOP      3328
#define XB_TOPGEN   3392
#define XCD_BAR_WORDS 3456
#define XB_SPIN_CAP (1u << 18)

__device__ __forceinline__ unsigned xb_ld(unsigned* p)              { return __hip_atomic_load(p, __ATOMIC_RELAXED, __HIP_MEMORY_SCOPE_AGENT); }
__device__ __forceinline__ unsigned xb_add(unsigned* p, unsigned v) { return __hip_atomic_fetch_add(p, v, __ATOMIC_RELAXED, __HIP_MEMORY_SCOPE_AGENT); }
__device__ __forceinline__ unsigned xb_xcc_id() { return (unsigned)__builtin_amdgcn_s_getreg((3 << 11) | 20) & 0xFu; }
#define XB_SPIN(cond, bar) do { unsigned _sp = 0; while (cond) { __builtin_amdgcn_s_sleep(1); \
    if ((++_sp & 255u) == 0u) { if (xb_ld(&(bar)[XB_TMO])) break; if (_sp > XB_SPIN_CAP) { atomicAdd(&(bar)[XB_TMO], 1u); break; } } } } while (0)

struct XcdBarrier {
    unsigned* bar; unsigned x;
    volatile LAS unsigned* st;
};

__device__ __forceinline__ XcdBarrier xcd_barrier_post(unsigned* bar, volatile LAS unsigned* st) {
    XcdBarrier b; b.bar = bar; b.x = xb_xcc_id(); b.st = st;
    if (threadIdx.x == 0) (void)xb_add(&bar[XB_XCNT(b.x)], 1u);
    return b;
}
__device__ __forceinline__ void xcd_barrier_complete(unsigned* bar, unsigned x, unsigned& nloc, unsigned& nx) {
    const unsigned G = gridDim.x * gridDim.y * gridDim.z;
    unsigned sum, cnt, mine, sp = 0u;
    for (;;) {
        sum = 0u; cnt = 0u; mine = 0u;
#pragma unroll
        for (unsigned j = 0; j < 16; ++j) { const unsigned c = xb_ld(&bar[XB_XCNT(j)]); sum += c; cnt += (c > 0u) ? 1u : 0u; mine = (j == x) ? c : mine; }
        if (sum == G) break;
        __builtin_amdgcn_s_sleep(1);
        if ((++sp & 255u) == 0u) { if (xb_ld(&bar[XB_TMO])) break; if (sp > XB_SPIN_CAP) { atomicAdd(&bar[XB_TMO], 1u); break; } }
    }
    nloc = mine > 0u ? mine : 1u; nx = cnt > 0u ? cnt : 1u;
}

__device__ __forceinline__ void xcd_barrier(const XcdBarrier& b) {
    asm volatile("s_waitcnt vmcnt(0)" ::: "memory");
    __syncthreads();
    if (threadIdx.x == 0) {
        unsigned* bar = b.bar;
        __builtin_amdgcn_s_waitcnt(0);
        unsigned nloc = b.st[0], nx = b.st[1];
        if (nloc == 0u) { xcd_barrier_complete(bar, b.x, nloc, nx); b.st[0] = nloc; b.st[1] = nx; }
        const unsigned old = xb_add(&bar[XB_XSUB(b.x)], 1u);
        const unsigned gen = old / nloc;
        if (old + 1u == (gen + 1u) * nloc) {
            __builtin_amdgcn_fence(__ATOMIC_RELEASE, "agent");
            asm volatile("s_waitcnt vmcnt(0)" ::: "memory");
            const unsigned og = xb_add(&bar[XB_TOP], 1u);
            const unsigned tg = og / nx;
            if (og + 1u == (tg + 1u) * nx) xb_add(&bar[XB_TOPGEN], 1u);
            else XB_SPIN(xb_ld(&bar[XB_TOPGEN]) == tg, bar);
            __builtin_amdgcn_fence(__ATOMIC_ACQUIRE, "agent");
            xb_add(&bar[XB_XGEN(b.x)], 1u);
            asm volatile("s_waitcnt vmcnt(0)" ::: "memory");
        } else {
            XB_SPIN(xb_ld(&bar[XB_XGEN(b.x)]) == gen, bar);
            __builtin_amdgcn_fence(__ATOMIC_ACQUIRE, "agent");
            asm volatile("s_waitcnt vmcnt(0)" ::: "memory");
        }
    }
    __syncthreads();
}


struct Args { const float* in[N_IN]; float* out; unsigned char* ws; int ph_lo, ph_hi; };
static_assert(sizeof(Args) == N_IN * 8 + 24, "Args has no padding");
struct Frame {
    LAS unsigned char* lds; volatile LAS unsigned* MISC; gu32* ctl;
    int tid, lane, wave, vcu, G;
    const __attribute__((address_space(4))) struct Args* ka; float* out; unsigned char* ws;
};
#define FIN(i) (F.ka->in[i])
#define WSP(T, off) ((T*)(F.ws + (off)))

__device__ __forceinline__ void ph_init(Frame& F) {
    const int gw = F.vcu * NWAVES + F.wave, NGW = F.G * NWAVES;
    float* bias = WSP(float, WS_BIAS); const float* relb = FIN(I_RELB);
    for (int i = blockIdx.x * 512 + F.tid; i < NH * 2048; i += F.G * 512) { const int h = i >> 11, n = i & 2047; int bkt;
        if (n < 16) bkt = n; else { const float nf = (float)n; const int lg = 16 + (int)(logf(nf / 16.0f) / 4.1588830833596715f * 16.0f); bkt = lg < 31 ? lg : 31; }
        bias[i] = relb[h * 32 + bkt] * LOG2E; }
    const float* mem = FIN(I_MEM); bf16* memb = WSP(bf16, WS_MEMB); float* memrs = WSP(float, WS_MEMRS);
    for (int r = gw; r < MM; r += NGW) { const f32x4* xr = (const f32x4*)(mem + (size_t)r * DM) + F.lane; f32x4 v[4]; float s = 0.f;
#pragma unroll
        for (int j = 0; j < 4; ++j) { v[j] = xr[64 * j]; s += (v[j].x * v[j].x + v[j].y * v[j].y) + (v[j].z * v[j].z + v[j].w * v[j].w); }
        s = wave_sum(s); u32x2* o = (u32x2*)(memb + (size_t)r * DM) + F.lane;
#pragma unroll
        for (int j = 0; j < 4; ++j) { u32x2 w; w.x = pk2(v[j].x, v[j].y); w.y = pk2(v[j].z, v[j].w); o[64 * j] = w; }
        if (F.lane == 0) memrs[r] = __builtin_amdgcn_rsqf(s * (1.0f / DM) + NORM_EPS); }
    const float* x = FIN(I_X); bf16* xb = WSP(bf16, WS_XB); float* ssq = WSP(float, WS_SSQ);
    for (int r = gw; r < M; r += NGW) { const f32x4* xr = (const f32x4*)(x + (size_t)r * DM) + F.lane; f32x4 v[4]; float s = 0.f;
#pragma unroll
        for (int j = 0; j < 4; ++j) { v[j] = xr[64 * j]; s += (v[j].x * v[j].x + v[j].y * v[j].y) + (v[j].z * v[j].z + v[j].w * v[j].w); }
        s = wave_sum(s); u32x2* o = (u32x2*)(xb + (size_t)r * DM) + F.lane;
#pragma unroll
        for (int j = 0; j < 4; ++j) { u32x2 w; w.x = pk2(v[j].x, v[j].y); w.y = pk2(v[j].z, v[j].w); o[64 * j] = w; }
        if (F.lane < 16) ssq[(size_t)r * 16 + F.lane] = F.lane == 0 ? s : 0.f; }
}

__device__ __forceinline__ void conv_item(const float* W, int K, int N, const float* gk, bf16* WT, int item, bool ffn_in, LAS float* scr, int lane) {
    const int nblk = N / 32, kb = item / nblk, nb = item % nblk, k0 = 64 * kb, n0 = 32 * nb;
#pragma unroll 8
    for (int i = 0; i < 32; ++i) { const int kk = 2 * i + (lane >> 5); float w = W[(size_t)(k0 + kk) * N + n0 + (lane & 31)]; if (gk) w *= gk[k0 + kk]; scr[kk * 33 + (lane & 31)] = w; }
    LDS_WAIT(); asm volatile("" ::: "memory");
    int drow0 = n0; if (ffn_in) drow0 = n0 < DFF ? 256 * (n0 / 128) + (n0 % 128) : 256 * ((n0 - DFF) / 128) + 128 + ((n0 - DFF) % 128);
    const int c = lane & 7;
#pragma unroll
    for (int j = 0; j < 4; ++j) { const int n = (lane >> 3) + 8 * j; const LAS float* s = scr + (8 * c) * 33 + n;
        u32x4 o; o.x = pk2(s[0 * 33], s[1 * 33]); o.y = pk2(s[2 * 33], s[3 * 33]); o.z = pk2(s[4 * 33], s[5 * 33]); o.w = pk2(s[6 * 33], s[7 * 33]);
        *(u32x4*)(WT + (size_t)(drow0 + n) * K + k0 + 8 * c) = o; }
    LDS_WAIT(); asm volatile("" ::: "memory");
}
__device__ __forceinline__ void ph_conv(Frame& F, int l) {
    LAS float* scr = (LAS float*)(F.lds + F.wave * 16384);
    const int gw = F.vcu * NWAVES + F.wave, NGW = F.G * NWAVES;
    constexpr int I_FIN = (DM / 64) * (2 * DFF / 32), I_FOUT = (DFF / 64) * (DM / 32), I_MI = (DM / 64) * (DPROJ / 32), I_SQ = (DM / 64) * (DM / 32), I_KV = (DM / 64) * (2 * DM / 32);
    constexpr int NITEMS = 2 * I_FIN + 2 * I_FOUT + I_MI + 3 * I_SQ + I_KV;
    unsigned char* wb = F.ws + WS_W;
    for (int it = gw; it < NITEMS; it += NGW) { int r = it;
        if (r < I_FIN) { conv_item(FIN(I_F1IN) + (size_t)l * DM * 2 * DFF, DM, 2 * DFF, FIN(I_F1G) + l * DM, (bf16*)(wb + W_F1IN), r, true, scr, F.lane); continue; } r -= I_FIN;
        if (r < I_FIN) { conv_item(FIN(I_F2IN) + (size_t)l * DM * 2 * DFF, DM, 2 * DFF, FIN(I_F2G) + l * DM, (bf16*)(wb + W_F2IN), r, true, scr, F.lane); continue; } r -= I_FIN;
        if (r < I_FOUT) { conv_item(FIN(I_F1OUT) + (size_t)l * DFF * DM, DFF, DM, nullptr, (bf16*)(wb + W_F1OUT), r, false, scr, F.lane); continue; } r -= I_FOUT;
        if (r < I_FOUT) { conv_item(FIN(I_F2OUT) + (size_t)l * DFF * DM, DFF, DM, nullptr, (bf16*)(wb + W_F2OUT), r, false, scr, F.lane); continue; } r -= I_FOUT;
        if (r < I_MI) { conv_item(FIN(I_MIXIN) + (size_t)l * DM * DPROJ, DM, DPROJ, FIN(I_MIXG) + l * DM, (bf16*)(wb + W_MIXIN), r, false, scr, F.lane); continue; } r -= I_MI;
        if (r < I_SQ) { conv_item(FIN(I_MIXOUT) + (size_t)l * DM * DM, DM, DM, nullptr, (bf16*)(wb + W_MIXOUT), r, false, scr, F.lane); continue; } r -= I_SQ;
        if (r < I_SQ) { conv_item(FIN(I_WQ) + (size_t)l * DM * DM, DM, DM, FIN(I_XG) + l * DM, (bf16*)(wb + W_WQ), r, false, scr, F.lane); continue; } r -= I_SQ;
        if (r < I_SQ) { conv_item(FIN(I_WO) + (size_t)l * DM * DM, DM, DM, nullptr, (bf16*)(wb + W_WO), r, false, scr, F.lane); continue; } r -= I_SQ;
        conv_item(FIN(I_WKV) + (size_t)l * DM * 2 * DM, DM, 2 * DM, FIN(I_MEMG) + l * DM, (bf16*)(wb + W_WKV), r, false, scr, F.lane);
    }
}

__device__ __forceinline__ void ph_moba(Frame& F) {
    LAS float* kmean = (LAS float*)F.lds;
    LAS float* btab = (LAS float*)(F.lds + 2048);
    const bf16* MQ = WSP(bf16, AR_MQ); const bf16* MK = WSP(bf16, AR_MK); const bf16* MVT = WSP(bf16, AR_MVT); bf16* XB = WSP(bf16, WS_XB); const float* bias = WSP(float, WS_BIAS);
    const int lane = F.lane, r32 = lane & 31, hi = lane >> 5, wave = F.wave;
    for (int u = blockIdx.x; u < 512; u += F.G) {
        const int rnd = u >> 8, iu = u & 255, qsel = iu >> 6, bh = iu & 63, qb = rnd == 0 ? 7 - qsel : qsel, b = bh >> 3, hh = bh & 7;
        __syncthreads();
        { const int n = F.tid >> 6, d = F.tid & 63;
          if (n < qb) { const bf16* kp = MK + (size_t)(b * 2048 + n * 256) * 512 + hh * 64 + d; float s = 0.f;
#pragma unroll 8
              for (int k = 0; k < 256; ++k) s += bf2f(kp[(size_t)k * 512]);
              kmean[n * 64 + d] = s * (1.0f / 256.0f); }
          for (int i2 = F.tid; i2 < 2048; i2 += 512) btab[i2] = bias[hh * 2048 + i2]; }
        __syncthreads();
        const int q0 = qb * 256 + wave * 32; const size_t tok = (size_t)b * 2048 + q0 + r32;
        bf16x8 qf[4];
#pragma unroll
        for (int s = 0; s < 4; ++s) qf[s] = *(const bf16x8*)(MQ + tok * 512 + hh * 64 + 16 * s + 8 * hi);
        float g[7]; unsigned selmask = 0u;
#pragma unroll
        for (int n = 0; n < 7; ++n) { g[n] = -INFINITY;
            if (n < qb) { float p = 0.f;
#pragma unroll
                for (int s = 0; s < 4; ++s) { const f32x4 k0v = *(const LAS f32x4*)(kmean + n * 64 + 16 * s + 8 * hi), k1v = *(const LAS f32x4*)(kmean + n * 64 + 16 * s + 8 * hi + 4);
                    p += bf2f((unsigned short)qf[s][0]) * k0v[0] + bf2f((unsigned short)qf[s][1]) * k0v[1] + bf2f((unsigned short)qf[s][2]) * k0v[2] + bf2f((unsigned short)qf[s][3]) * k0v[3]
                       + bf2f((unsigned short)qf[s][4]) * k1v[0] + bf2f((unsigned short)qf[s][5]) * k1v[1] + bf2f((unsigned short)qf[s][6]) * k1v[2] + bf2f((unsigned short)qf[s][7]) * k1v[3]; }
                p += __shfl_xor(p, 32); g[n] = p; } }
        if (qb <= 3) selmask = (1u << qb) - 1u;
        else {
#pragma unroll
            for (int n = 0; n < 7; ++n) if (n < qb) { int cnt = 0;
#pragma unroll
                for (int n2 = 0; n2 < 7; ++n2) if (n2 != n && n2 < qb) cnt += (g[n2] > g[n] || (g[n2] == g[n] && n2 < n)) ? 1 : 0;
                if (cnt < 3) selmask |= 1u << n; } }
        float mrun = -INFINITY, lrun = 0.f; f32x16 o0, o1;
#pragma unroll
        for (int i = 0; i < 16; ++i) { o0[i] = 0.f; o1[i] = 0.f; }
        const int qpos = q0 + r32;
        const bf16* Kb = MK + (size_t)b * 2048 * 512 + hh * 64 + 8 * hi;
        const bf16* Vb = MVT + ((size_t)(b * 8 + hh) * 64 + r32) * 2048 + 8 * hi;
        for (int blk = 0; blk <= qb; ++blk) {
            const bool own = blk == qb; const bool selme = own || ((selmask >> blk) & 1u);
            if (!own && __ballot(selme) == 0ull) continue;
            const int nt = own ? wave + 1 : 8;
            for (int kt = 0; kt < nt; ++kt) { const int k0 = blk * 256 + kt * 32;
                bf16x8 kf[4], vf[2][2];
#pragma unroll
                for (int s = 0; s < 4; ++s) kf[s] = *(const bf16x8*)(Kb + (size_t)(k0 + r32) * 512 + 16 * s);
#pragma unroll
                for (int dt = 0; dt < 2; ++dt)
#pragma unroll
                    for (int sp = 0; sp < 2; ++sp) vf[dt][sp] = *(const bf16x8*)(Vb + (size_t)dt * 32 * 2048 + k0 + 16 * sp);
                f32x16 sc;
#pragma unroll
                for (int i = 0; i < 16; ++i) sc[i] = 0.f;
#pragma unroll
                for (int s = 0; s < 4; ++s) sc = __builtin_amdgcn_mfma_f32_32x32x16_bf16(kf[s], qf[s], sc, 0, 0, 0);
                float mx = -INFINITY;
#pragma unroll
                for (int r = 0; r < 16; ++r) { const int dist = qpos - (k0 + crow(r, hi)); const bool valid = selme && (!own || dist >= 0);
                    const float v = valid ? sc[r] + btab[dist < 0 ? 0 : dist] : -INFINITY; sc[r] = v; mx = fmaxf(mx, v); }
                mx = fmaxf(mx, __shfl_xor(mx, 32));
                const float mnew = fmaxf(mrun, mx), muse = (mnew == -INFINITY) ? 0.f : mnew;
                const float alpha = __builtin_amdgcn_exp2f(mrun - muse);
                float ps = 0.f;
#pragma unroll
                for (int r = 0; r < 16; ++r) { const float p = __builtin_amdgcn_exp2f(sc[r] - muse); sc[r] = p; ps += p; }
                lrun = lrun * alpha + ps; mrun = mnew;
#pragma unroll
                for (int i = 0; i < 16; ++i) { o0[i] *= alpha; o1[i] *= alpha; }
                const bf16x8 pf0 = pack_bf16x8(sc[0], sc[1], sc[2], sc[3], sc[4], sc[5], sc[6], sc[7]), pf1 = pack_bf16x8(sc[8], sc[9], sc[10], sc[11], sc[12], sc[13], sc[14], sc[15]);
                o0 = __builtin_amdgcn_mfma_f32_32x32x16_bf16(vf[0][0], pf0, o0, 0, 0, 0); o0 = __builtin_amdgcn_mfma_f32_32x32x16_bf16(vf[0][1], pf1, o0, 0, 0, 0);
                o1 = __builtin_amdgcn_mfma_f32_32x32x16_bf16(vf[1][0], pf0, o1, 0, 0, 0); o1 = __builtin_amdgcn_mfma_f32_32x32x16_bf16(vf[1][1], pf1, o1, 0, 0, 0);
            }
        }
        lrun += __shfl_xor(lrun, 32); const float inv = 1.0f / lrun;
        bf16* op = XB + tok * 1024 + 512 + hh * 64 + 4 * hi;
#pragma unroll
        for (int g4 = 0; g4 < 4; ++g4) { u32x2 w0, w1; w0.x = pk2(o0[4 * g4] * inv, o0[4 * g4 + 1] * inv); w0.y = pk2(o0[4 * g4 + 2] * inv, o0[4 * g4 + 3] * inv);
            w1.x = pk2(o1[4 * g4] * inv, o1[4 * g4 + 1] * inv); w1.y = pk2(o1[4 * g4 + 2] * inv, o1[4 * g4 + 3] * inv);
            *(u32x2*)(op + 8 * g4) = w0; *(u32x2*)(op + 32 + 8 * g4) = w1; }
    }
}

__device__ __forceinline__ void ph_xatt(Frame& F) {
    const bf16* XQ = WSP(bf16, AR_XQ); const bf16* XK = WSP(bf16, WS_XK); const bf16* XVT = WSP(bf16, WS_XVT); bf16* XO = WSP(bf16, AR_XO);
    const int lane = F.lane, r32 = lane & 31, hi = lane >> 5, wave = F.wave;
    for (int u = blockIdx.x; u < 256; u += F.G) {
        const int b = u >> 5, hx = (u >> 3) & 3, qt = u & 7;
        const size_t tok = (size_t)b * 2048 + qt * 256 + wave * 32 + r32;
        const bf16* Qp = XQ + tok * 1024 + hx * 256 + 8 * hi;
        const bf16* Kb = XK + (size_t)(b * 256 + r32) * 1024 + hx * 256 + 8 * hi;
        const bf16* Vb = XVT + ((size_t)(b * 4 + hx) * 256 + r32) * 256 + 8 * hi;
        float mrun = -INFINITY, lrun = 0.f; f32x16 o[8];
#pragma unroll
        for (int dt = 0; dt < 8; ++dt)
#pragma unroll
            for (int i = 0; i < 16; ++i) o[dt][i] = 0.f;
        for (int kt = 0; kt < 8; ++kt) { const int k0 = kt * 32;
            f32x16 sc;
#pragma unroll
            for (int i = 0; i < 16; ++i) sc[i] = 0.f;
#pragma unroll
            for (int s = 0; s < 16; ++s) { const bf16x8 kf = *(const bf16x8*)(Kb + (size_t)k0 * 1024 + 16 * s), qf = *(const bf16x8*)(Qp + 16 * s);
                sc = __builtin_amdgcn_mfma_f32_32x32x16_bf16(kf, qf, sc, 0, 0, 0); }
            float mx = sc[0];
#pragma unroll
            for (int r = 1; r < 16; ++r) mx = fmaxf(mx, sc[r]);
            mx = fmaxf(mx, __shfl_xor(mx, 32));
            const float mnew = fmaxf(mrun, mx), alpha = __builtin_amdgcn_exp2f(mrun - mnew);
            float ps = 0.f;
#pragma unroll
            for (int r = 0; r < 16; ++r) { const float p = __builtin_amdgcn_exp2f(sc[r] - mnew); sc[r] = p; ps += p; }
            lrun = lrun * alpha + ps; mrun = mnew;
            const bf16x8 pf0 = pack_bf16x8(sc[0], sc[1], sc[2], sc[3], sc[4], sc[5], sc[6], sc[7]), pf1 = pack_bf16x8(sc[8], sc[9], sc[10], sc[11], sc[12], sc[13], sc[14], sc[15]);
#pragma unroll
            for (int dt = 0; dt < 8; ++dt) {
#pragma unroll
                for (int i = 0; i < 16; ++i) o[dt][i] *= alpha;
                const bf16x8 v0 = *(const bf16x8*)(Vb + (size_t)dt * 32 * 256 + k0), v1 = *(const bf16x8*)(Vb + (size_t)dt * 32 * 256 + k0 + 16);
                o[dt] = __builtin_amdgcn_mfma_f32_32x32x16_bf16(v0, pf0, o[dt], 0, 0, 0); o[dt] = __builtin_amdgcn_mfma_f32_32x32x16_bf16(v1, pf1, o[dt], 0, 0, 0); }
        }
        lrun += __shfl_xor(lrun, 32); const float inv = 1.0f / lrun;
        bf16* op = XO + tok * 1024 + hx * 256 + 4 * hi;
#pragma unroll
        for (int dt = 0; dt < 8; ++dt)
#pragma unroll
            for (int g4 = 0; g4 < 4; ++g4) { u32x2 w; w.x = pk2(o[dt][4 * g4] * inv, o[dt][4 * g4 + 1] * inv); w.y = pk2(o[dt][4 * g4 + 2] * inv, o[dt][4 * g4 + 3] * inv);
                *(u32x2*)(op + 32 * dt + 8 * g4) = w; }
    }
}

__device__ __forceinline__ void ph_prep(Frame& F, int l) {
    LAS float* lat = (LAS float*)F.lds;
    const bf16* PR = WSP(bf16, AR_PR); bf16* SCANIN = WSP(bf16, AR_SCANIN); bf16* XB = WSP(bf16, WS_XB); float* BONUS = WSP(float, WS_BONUS);
    const int c = F.tid, h = F.wave, j = F.lane;
    const float* mu = FIN(I_MU) + l * RPROJ; const float* wup = FIN(I_WUP) + (size_t)l * 64 * RW; const float* aup = FIN(I_AUP) + (size_t)l * 64 * RW; const float* gup = FIN(I_GUP) + (size_t)l * 128 * RW;
    const float mu_r = mu[c], mu_k = mu[512 + c], mu_v = mu[1024 + c], w0c = FIN(I_W0)[l * RW + c], a0c = FIN(I_A0)[l * RW + c], kkc = FIN(I_KK)[l * RW + c], kac = FIN(I_KA)[l * RW + c], rkc = FIN(I_RK)[l * RW + c];
    for (int tile = blockIdx.x; tile < M / 16; tile += F.G) { const int t0 = tile * 16;
        __syncthreads();
        { const int tt = F.tid >> 5, l8 = (F.tid & 31) * 8, t = t0 + tt;
          const u32x4 cur = *(const u32x4*)(PR + (size_t)t * RPROJ + 1536 + l8); u32x4 prv = {0u, 0u, 0u, 0u}; if (t & 2047) prv = *(const u32x4*)(PR + (size_t)(t - 1) * RPROJ + 1536 + l8);
          const f32x4 m0 = *(const f32x4*)(mu + 1536 + l8), m1 = *(const f32x4*)(mu + 1536 + l8 + 4);
          float xv[8];
#pragma unroll
          for (int i = 0; i < 4; ++i) { const unsigned cw = cur[i], pw = prv[i]; const float p0 = bf2f(cw & 0xffffu), p1 = bf2f(cw >> 16), q0 = bf2f(pw & 0xffffu), q1 = bf2f(pw >> 16);
              const float ma = i < 2 ? m0[2 * i] : m1[2 * i - 4], mb = i < 2 ? m0[2 * i + 1] : m1[2 * i - 3];
              xv[2 * i] = p0 + (q0 - p0) * ma; xv[2 * i + 1] = p1 + (q1 - p1) * mb; }
#pragma unroll
          for (int i = 0; i < 8; ++i) { if (l8 < 64) xv[i] = tanhf(xv[i]); else if (l8 >= 128) xv[i] = sigmoidf_(xv[i]); }
          *(LAS f32x4*)(lat + tt * 256 + l8) = (f32x4){xv[0], xv[1], xv[2], xv[3]}; *(LAS f32x4*)(lat + tt * 256 + l8 + 4) = (f32x4){xv[4], xv[5], xv[6], xv[7]}; }
        __syncthreads();
        float aw[16], aa[16], ag[16];
#pragma unroll
        for (int tt = 0; tt < 16; ++tt) { aw[tt] = 0.f; aa[tt] = 0.f; ag[tt] = 0.f; }
        for (int i4 = 0; i4 < 16; ++i4) { float wu[4], au[4];
#pragma unroll
            for (int q = 0; q < 4; ++q) { wu[q] = wup[(size_t)(4 * i4 + q) * RW + c]; au[q] = aup[(size_t)(4 * i4 + q) * RW + c]; }
#pragma unroll
            for (int tt = 0; tt < 16; ++tt) { const f32x4 lw = *(const LAS f32x4*)(lat + tt * 256 + 4 * i4), la = *(const LAS f32x4*)(lat + tt * 256 + 64 + 4 * i4);
                aw[tt] += lw[0] * wu[0] + lw[1] * wu[1] + lw[2] * wu[2] + lw[3] * wu[3]; aa[tt] += la[0] * au[0] + la[1] * au[1] + la[2] * au[2] + la[3] * au[3]; } }
        for (int i4 = 0; i4 < 32; ++i4) { float gu[4];
#pragma unroll
            for (int q = 0; q < 4; ++q) gu[q] = gup[(size_t)(4 * i4 + q) * RW + c];
#pragma unroll
            for (int tt = 0; tt < 16; ++tt) { const f32x4 lg = *(const LAS f32x4*)(lat + tt * 256 + 128 + 4 * i4); ag[tt] += lg[0] * gu[0] + lg[1] * gu[1] + lg[2] * gu[2] + lg[3] * gu[3]; } }
#pragma unroll
        for (int tt = 0; tt < 16; ++tt) { const int t = t0 + tt, bb = t >> 11, tp = t & 2047; const bf16* pc = PR + (size_t)t * RPROJ;
            float r = bf2f(pc[c]), k = bf2f(pc[512 + c]), v = bf2f(pc[1024 + c]), rp = 0.f, kp = 0.f, vp = 0.f;
            if (tp != 0) { rp = bf2f(pc[c - RPROJ]); kp = bf2f(pc[512 + c - RPROJ]); vp = bf2f(pc[1024 + c - RPROJ]); }
            r += (rp - r) * mu_r; k += (kp - k) * mu_k; v += (vp - v) * mu_v;
            const float wv = w0c + aw[tt], xs = -wv, sp = xs > 20.f ? xs : log1pf(__expf(xs)), wlog = -sp - 0.5f, ld = -__expf(wlog);
            const float a = sigmoidf_(a0c + aa[tt]);
            const float kk = k * kkc, kt = k * (1.0f + (a - 1.0f) * kac);
            const float n2 = wave_sum(kk * kk), kkn = kk / fmaxf(sqrtf(n2), 1e-12f);
            const float bon = wave_sum(r * kt * rkc); if (j == 0) BONUS[(size_t)t * 8 + h] = bon;
            bf16* so = SCANIN + ((size_t)(bb * 8 + h) * 2048 + tp) * 384 + j;
            so[0] = (bf16)f2bf(-kkn); so[64] = (bf16)f2bf(ld); so[128] = (bf16)f2bf(kkn * a); so[192] = (bf16)f2bf(kt); so[256] = (bf16)f2bf(r); so[320] = (bf16)f2bf(v);
            XB[(size_t)t * 1024 + c] = (bf16)f2bf(ag[tt]); }
    }
}

template <int R, int NCH, bool KINDP>
__device__ __forceinline__ void scan_stream(Frame& F, LAS float* ring, int bh, int ch, int rg, int lis) {
    constexpr int CLEN = SEQ / NCH, NHALF = CLEN / 8;
    const int lane = F.lane, js = lane & 3, q = lane >> 2, row0 = rg * 16 * R + q * R, tbase = ch * CLEN;
    const bf16* src = WSP(bf16, AR_SCANIN) + ((size_t)bh * 2048 + tbase) * 384;
    float* YL = WSP(float, AR_YLOC) + ((size_t)bh * 2048 + tbase) * 64; bf16* ZZ = WSP(bf16, AR_Z) + ((size_t)bh * 2048 + tbase) * 64;
    float S[R][16];
#pragma unroll
    for (int rr = 0; rr < R; ++rr)
#pragma unroll
        for (int jj = 0; jj < 16; ++jj) S[rr][jj] = (KINDP && (row0 + rr) == 16 * js + jj) ? 1.f : 0.f;
    u32x4 pre[2];
#pragma unroll
    for (int k = 0; k < 2; ++k) { const int ci = lis + k * 256; if (ci < 384) pre[k] = *(const u32x4*)(src + (size_t)ci * 8); }
#pragma unroll
    for (int k = 0; k < 2; ++k) { const int ci = lis + k * 256; if (ci < 384) { const bool isld = ((ci % 48) >> 3) == 1; float f[8];
#pragma unroll
            for (int i = 0; i < 4; ++i) { f[2 * i] = bf2f(pre[k][i] & 0xffffu); f[2 * i + 1] = bf2f(pre[k][i] >> 16); }
            if (isld) {
#pragma unroll
                for (int i = 0; i < 8; ++i) f[i] = __expf(f[i]); }
            *(LAS f32x4*)(ring + ci * 8) = (f32x4){f[0], f[1], f[2], f[3]}; *(LAS f32x4*)(ring + ci * 8 + 4) = (f32x4){f[4], f[5], f[6], f[7]}; } }
    __syncthreads();
    for (int hf = 0; hf < NHALF; ++hf) {
        const bool more = hf + 1 < NHALF;
        if (more) {
#pragma unroll
            for (int k = 0; k < 2; ++k) { const int ci = lis + k * 256; if (ci < 384) pre[k] = *(const u32x4*)(src + (size_t)(hf + 1) * 3072 + (size_t)ci * 8); } }
        for (int st = 0; st < 8; ++st) {
            const LAS float* sp = ring + ((hf & 1) * 8 + st) * 384 + 16 * js;
            float sa[R];
            { f32x4 n[4];
#pragma unroll
              for (int i = 0; i < 4; ++i) n[i] = *(const LAS f32x4*)(sp + 4 * i);
#pragma unroll
              for (int rr = 0; rr < R; ++rr) { float a = 0.f;
#pragma unroll
                  for (int jj = 0; jj < 16; ++jj) a += S[rr][jj] * n[jj >> 2][jj & 3];
                  sa[rr] = quad_sum(a); } }
            f32x4 w[4], bv[4], kv[4], rv[4];
#pragma unroll
            for (int i = 0; i < 4; ++i) { w[i] = *(const LAS f32x4*)(sp + 64 + 4 * i); bv[i] = *(const LAS f32x4*)(sp + 128 + 4 * i); rv[i] = *(const LAS f32x4*)(sp + 256 + 4 * i);
                if (!KINDP) kv[i] = *(const LAS f32x4*)(sp + 192 + 4 * i); }
            float y[R];
#pragma unroll
            for (int rr = 0; rr < R; ++rr) { float vv = 0.f; if (!KINDP) vv = ring[((hf & 1) * 8 + st) * 384 + 320 + row0 + rr]; float a = 0.f;
#pragma unroll
                for (int jj = 0; jj < 16; ++jj) { float s = S[rr][jj] * w[jj >> 2][jj & 3] + sa[rr] * bv[jj >> 2][jj & 3]; if (!KINDP) s += vv * kv[jj >> 2][jj & 3]; S[rr][jj] = s; a += s * rv[jj >> 2][jj & 3]; }
                y[rr] = quad_sum(a); }
            if (js == 0) { const int t = hf * 8 + st;
#pragma unroll
                for (int rr = 0; rr < R; ++rr) { if (KINDP) ZZ[(size_t)t * 64 + row0 + rr] = (bf16)f2bf(y[rr]); else YL[(size_t)t * 64 + row0 + rr] = y[rr]; } }
        }
        if (more) {
#pragma unroll
            for (int k = 0; k < 2; ++k) { const int ci = lis + k * 256; if (ci < 384) { const bool isld = ((ci % 48) >> 3) == 1; float f[8];
#pragma unroll
                    for (int i = 0; i < 4; ++i) { f[2 * i] = bf2f(pre[k][i] & 0xffffu); f[2 * i + 1] = bf2f(pre[k][i] >> 16); }
                    if (isld) {
#pragma unroll
                        for (int i = 0; i < 8; ++i) f[i] = __expf(f[i]); }
                    LAS float* dst = ring + (((hf + 1) & 1) * 8) * 384 + ci * 8;
                    *(LAS f32x4*)(dst) = (f32x4){f[0], f[1], f[2], f[3]}; *(LAS f32x4*)(dst + 4) = (f32x4){f[4], f[5], f[6], f[7]}; } } }
        __syncthreads();
    }
    if (NCH > 1) {
        float* st = WSP(float, AR_STATE) + ((size_t)(bh * NCH + ch) * 2 + (KINDP ? 0 : 1)) * 4096;
#pragma unroll
        for (int rr = 0; rr < R; ++rr)
#pragma unroll
            for (int i = 0; i < 4; ++i) *(f32x4*)(st + (size_t)(row0 + rr) * 64 + 16 * js + 4 * i) = (f32x4){S[rr][4 * i], S[rr][4 * i + 1], S[rr][4 * i + 2], S[rr][4 * i + 3]};
    }
}
template <int R, int NCH>
__device__ __forceinline__ void ph_scan(Frame& F) {
    constexpr int KINDS = NCH > 1 ? 2 : 1, RG = 4 / R, WPS = KINDS * RG, SPW = NWAVES / WPS, NSTREAM = BATCH * NH * NCH;
    static_assert(WPS == 4, "staging assumes 4 waves per stream");
    const int sl = F.wave / WPS, role = F.wave % WPS, kind = role / RG, rg = role % RG, lis = role * 64 + F.lane;
    LAS float* ring = (LAS float*)F.lds + sl * (16 * 384);
    for (int it = blockIdx.x; it * SPW < NSTREAM; it += F.G) {
        const int sid = it * SPW + sl, bh = sid / NCH, ch = sid % NCH;
        __syncthreads();
        if (kind == 0) scan_stream<R, NCH, false>(F, ring, bh, ch, rg, lis); else scan_stream<R, NCH, true>(F, ring, bh, ch, rg, lis);
    }
}

template <int NCH>
__device__ __forceinline__ void ph_post(Frame& F, int l) {
    const float* YL = WSP(float, AR_YLOC); const bf16* SCANIN = WSP(bf16, AR_SCANIN); bf16* XB = WSP(bf16, WS_XB); const float* BONUS = WSP(float, WS_BONUS);
    const int c = F.tid, h = F.wave, j = F.lane; const float lng = FIN(I_LNG)[l * RW + c], lnb = FIN(I_LNB)[l * RW + c];
    for (int tile = blockIdx.x; tile < M / 16; tile += F.G) {
#pragma unroll 4
        for (int tt = 0; tt < 16; ++tt) { const int t = tile * 16 + tt, bb = t >> 11, tp = t & 2047, bh = bb * 8 + h;
            const float y = YL[((size_t)bh * 2048 + tp) * 64 + j];
            const float mean = wave_sum(y) * (1.0f / 64.0f), d = y - mean, var = wave_sum(d * d) * (1.0f / 64.0f);
            const float yn = d * __builtin_amdgcn_rsqf(var + LNX_EPS) * lng + lnb;
            const float v = bf2f(SCANIN[((size_t)bh * 2048 + tp) * 384 + 320 + j]), bon = BONUS[(size_t)t * 8 + h], g = bf2f(XB[(size_t)t * 1024 + c]);
            XB[(size_t)t * 1024 + c] = (bf16)f2bf((yn + bon * v) * g); }
    }
}

__device__ __forceinline__ void ph_final(Frame& F) {
    const int gw = F.vcu * NWAVES + F.wave, NGW = F.G * NWAVES; const float* ssq = WSP(float, WS_SSQ); const float* g = FIN(I_FING);
    f32x4 gv[4];
#pragma unroll
    for (int j = 0; j < 4; ++j) gv[j] = ((const f32x4*)g)[F.lane + 64 * j];
    for (int r = gw; r < M; r += NGW) { const float rs = pg8::row_rstd16(ssq, r); f32x4* xr = (f32x4*)(F.out + (size_t)r * DM) + F.lane;
#pragma unroll
        for (int j = 0; j < 4; ++j) { const f32x4 v = xr[64 * j]; xr[64 * j] = v * rs * gv[j]; } }
}

constexpr int PH_INIT = 0, PH_PER_LAYER = 16, PH_FINAL = 1 + DEPTH * PH_PER_LAYER, N_PHASES = PH_FINAL + 1;
enum { K_CONV = 0, K_KV, K_F1UP, K_F1DN, K_MIXIN, K_MOBA, K_PREP, K_SCAN, K_FIX, K_POST, K_MIXOUT, K_XQ, K_XATT, K_XO, K_F2UP, K_F2DN };

__global__ void __launch_bounds__(NWAVES * 64, 2) fwd(Args args) {
    extern __shared__ __attribute__((aligned(16))) unsigned char lds[];
    Frame F;
    F.lds = (LAS unsigned char*)lds; F.MISC = (volatile LAS unsigned*)(F.lds + MISC_OFF);
    F.tid = threadIdx.x; F.lane = F.tid & 63; F.wave = __builtin_amdgcn_readfirstlane(F.tid >> 6);
    F.G = gridDim.x; { const int bx = blockIdx.x; F.vcu = (F.G % 8 == 0) ? (bx % 8) * (F.G / 8) + bx / 8 : bx; }
    F.out = args.out; F.ws = args.ws; F.ctl = (gu32*)(args.ws + WS_CTL);
    F.ka = (const __attribute__((address_space(4))) Args*)(uintptr_t)__builtin_amdgcn_kernarg_segment_ptr();
    for (int u = F.tid; u < (LDS_BYTES - LDSCTL_OFF) / 4; u += NWAVES * 64) ((LAS unsigned*)(F.lds + LDSCTL_OFF))[u] = 0u;
    __syncthreads();
    const bool multi = args.ph_hi - args.ph_lo > 1;
    XcdBarrier bar; bar.bar = (unsigned*)(F.ctl + 4096); bar.x = 0; bar.st = nullptr;
    if (multi) bar = xcd_barrier_post((unsigned*)(F.ctl + 4096), F.MISC + 8);
    for (int ph = args.ph_lo; ph < args.ph_hi; ++ph) {
        { uintptr_t kp = (uintptr_t)__builtin_amdgcn_kernarg_segment_ptr(); asm volatile("" : "+s"(kp)); F.ka = (const __attribute__((address_space(4))) Args*)kp; }
        { int t_ = threadIdx.x; asm volatile("" : "+v"(t_)); F.tid = t_; F.lane = t_ & 63; F.wave = __builtin_amdgcn_readfirstlane(t_ >> 6); }
        unsigned char* wb = F.ws + WS_W;
        if (ph == PH_INIT) ph_init(F);
        else if (ph == PH_FINAL) ph_final(F);
        else { const int l = (ph - 1) / PH_PER_LAYER, k = (ph - 1) % PH_PER_LAYER;
            const float* xin = (l == 0) ? FIN(I_X) : (const float*)F.out;
            switch (k) {
            case K_CONV: ph_conv(F, l); break;
            case K_KV: { pg8::Gemm g{WSP(bf16, WS_MEMB), (const bf16*)(wb + W_WKV), MM, 2 * DM, DM}; pg8::StaticOrder S; S.init(MM, 2 * DM, F.G, (int)blockIdx.x);
                pg8::EpiKV E{F.ws}; pg8::gemm_phase<pg8::EpiKV, pg8::StaticOrder, true, true>(F.lds, g, S, E); } break;
            case K_F1UP: case K_F2UP: { pg8::Gemm g{WSP(bf16, WS_XB), (const bf16*)(wb + (k == K_F1UP ? W_F1IN : W_F2IN)), M, 2 * DFF, DM}; pg8::StaticOrder S; S.init(M, 2 * DFF, F.G, (int)blockIdx.x);
                pg8::EpiSwiGLU E{F.ws}; pg8::gemm_phase<pg8::EpiSwiGLU, pg8::StaticOrder, true, true>(F.lds, g, S, E); } break;
            case K_F1DN: case K_F2DN: { pg8::Gemm g{WSP(bf16, AR_H), (const bf16*)(wb + (k == K_F1DN ? W_F1OUT : W_F2OUT)), M, DM, DFF}; pg8::StaticOrder S; S.init(M, DM, F.G, (int)blockIdx.x);
                pg8::EpiResid E{k == K_F1DN ? xin : (const float*)F.out, F.out, F.ws, WS_XB, 0.5f}; pg8::gemm_phase<pg8::EpiResid, pg8::StaticOrder, true, true>(F.lds, g, S, E); } break;
            case K_MIXIN: { pg8::Gemm g{WSP(bf16, WS_XB), (const bf16*)(wb + W_MIXIN), M, DPROJ, DM}; pg8::StaticOrder S; S.init(M, DPROJ, F.G, (int)blockIdx.x);
                pg8::EpiMixIn E{F.ws}; pg8::gemm_phase<pg8::EpiMixIn, pg8::StaticOrder, true, true>(F.lds, g, S, E); } break;
            case K_MOBA: ph_moba(F); break;
            case K_PREP: ph_prep(F, l); break;
            case K_SCAN: ph_scan<SCAN_R, SCAN_NCH>(F); break;
            case K_FIX: break;
            case K_POST: ph_post<SCAN_NCH>(F, l); break;
            case K_MIXOUT: { pg8::Gemm g{WSP(bf16, WS_XB), (const bf16*)(wb + W_MIXOUT), M, DM, DM}; pg8::StaticOrder S; S.init(M, DM, F.G, (int)blockIdx.x);
                pg8::EpiResid E{F.out, F.out, F.ws, AR_XB2, 1.0f}; pg8::gemm_phase<pg8::EpiResid, pg8::StaticOrder, true, true>(F.lds, g, S, E); } break;
            case K_XQ: { pg8::Gemm g{WSP(bf16, AR_XB2), (const bf16*)(wb + W_WQ), M, DM, DM}; pg8::StaticOrder S; S.init(M, DM, F.G, (int)blockIdx.x);
                pg8::EpiXQ E{F.ws}; pg8::gemm_phase<pg8::EpiXQ, pg8::StaticOrder, true, true>(F.lds, g, S, E); } break;
            case K_XATT: ph_xatt(F); break;
            case K_XO: { pg8::Gemm g{WSP(bf16, AR_XO), (const bf16*)(wb + W_WO), M, DM, DM}; pg8::StaticOrder S; S.init(M, DM, F.G, (int)blockIdx.x);
                pg8::EpiResid E{F.out, F.out, F.ws, WS_XB, 1.0f}; pg8::gemm_phase<pg8::EpiResid, pg8::StaticOrder, true, true>(F.lds, g, S, E); } break;
            default: break;
            }
        }
        if (ph + 1 < args.ph_hi) {
            const bool noop = (ph != PH_INIT && ph != PH_FINAL && ((ph - 1) % PH_PER_LAYER) == K_FIX && SCAN_NCH == 1);
            if (!noop) { if (ph == PH_INIT) cooperative_groups::this_grid().sync(); else xcd_barrier(bar); }
        }
    }
}

extern "C" void kernel_launch(void* const* d_in, const int* in_sizes, int n_in, void* d_out, int out_size, void* d_ws, size_t ws_size, hipStream_t stream) {
    static int grid = 0;
    if (grid == 0) {
        if (n_in != N_IN || in_sizes[0] != M * DM || out_size != M * DM || ws_size < WS_END) { fprintf(stderr, "kernel_launch: unexpected problem (n_in %d, in0 %d, out %d, ws %zu < %zu); nothing launched\n", n_in, n_in > 0 ? in_sizes[0] : -1, out_size, ws_size, (size_t)WS_END); grid = -1; return; }
        int dev = 0, cus = 0;
        if (hipGetDevice(&dev) != hipSuccess || hipDeviceGetAttribute(&cus, hipDeviceAttributeMultiprocessorCount, dev) != hipSuccess) { grid = -1; return; }
        if (hipFuncSetAttribute((const void*)fwd, hipFuncAttributeMaxDynamicSharedMemorySize, LDS_BYTES) != hipSuccess) { fprintf(stderr, "kernel_launch: hipFuncSetAttribute failed\n"); grid = -1; return; }
        int per_cu = 0;
        if (hipOccupancyMaxActiveBlocksPerMultiprocessor(&per_cu, (const void*)fwd, NWAVES * 64, LDS_BYTES) != hipSuccess || per_cu < 1) { fprintf(stderr, "kernel_launch: occupancy query reports %d workgroups per CU; nothing launched\n", per_cu); grid = -1; return; }
        grid = cus;
    }
    if (grid < 0) return;
    (void)hipMemsetAsync((char*)d_ws + WS_CTL, 0, CTL_ZERO_BYTES, stream);
    Args a{};
    for (int i = 0; i < N_IN; ++i) a.in[i] = (const float*)d_in[i];
    a.out = (float*)d_out; a.ws = (unsigned char*)d_ws;
    a.ph_lo = 0; a.ph_hi = N_PHASES;
    void* kargs[] = {&a};
    const hipError_t e = hipLaunchCooperativeKernel((const void*)fwd, dim3(grid), dim3(NWAVES * 64), kargs, LDS_BYTES, stream);
    if (e != hipSuccess) fprintf(stderr, "kernel_launch: cooperative launch failed: %s (grid %d)\n", hipGetErrorString(e), grid);
}
```

```cpp
#include <hip/hip_runtime.h>
#include <hip/hip_cooperative_groups.h>
#include <cstdio>
#include <cstdint>

constexpr int BATCH = 8, SEQ = 2048, DM = 1024, DEPTH = 2, M = BATCH * SEQ;
constexpr int RW = 512, NH = 8, HD = 64;
constexpr int RPROJ = 1792, DPROJ = 3328;
constexpr int DFF = 2816;
constexpr int MEMLEN = 256, XH = 4, XHD = 256, MM = BATCH * MEMLEN;
constexpr int MBLK = 256, NBLK = SEQ / MBLK;
constexpr float NORM_EPS = 1e-6f, LNX_EPS = 64e-5f;
constexpr float LOG2E = 1.4426950408889634f;
constexpr float MOBA_QSCALE = 0.125f * LOG2E;
constexpr float XATT_QSCALE = 0.0625f * LOG2E;

enum { I_X = 0, I_MEM, I_RELB, I_FING, I_F1G, I_F1IN, I_F1OUT, I_MIXG, I_MIXIN, I_MIXOUT, I_MU, I_W0, I_WUP, I_A0, I_AUP, I_GUP, I_KK, I_KA, I_RK, I_LNG, I_LNB,
       I_XG, I_MEMG, I_WQ, I_WKV, I_WO, I_F2G, I_F2IN, I_F2OUT, N_IN };

constexpr size_t MiB = 1u << 20;
constexpr size_t WS_CTL = 0, CTL_ZERO_BYTES = 1 * MiB;
constexpr size_t WS_BIAS = 1 * MiB;
constexpr size_t WS_MEMRS = WS_BIAS + 64 * 1024;
constexpr size_t WS_BONUS = WS_MEMRS + 64 * 1024;
constexpr size_t WS_SSQ = 2 * MiB;
constexpr size_t WS_MEMB = 3 * MiB;
constexpr size_t WS_XK = 7 * MiB, WS_XVT = 11 * MiB;
constexpr size_t WS_W = 15 * MiB;
constexpr size_t W_F1IN = 0, W_F1OUT = W_F1IN + (size_t)2 * DFF * DM * 2, W_F2IN = W_F1OUT + (size_t)DM * DFF * 2, W_F2OUT = W_F2IN + (size_t)2 * DFF * DM * 2,
                 W_MIXIN = W_F2OUT + (size_t)DM * DFF * 2, W_MIXOUT = W_MIXIN + (size_t)DPROJ * DM * 2, W_WQ = W_MIXOUT + (size_t)DM * DM * 2, W_WKV = W_WQ + (size_t)DM * DM * 2,
                 W_WO = W_WKV + (size_t)2 * DM * DM * 2, W_END = W_WO + (size_t)DM * DM * 2;
static_assert(W_END <= 50 * MiB, "weights fit");
constexpr size_t WS_XB = 65 * MiB;
constexpr size_t WS_AR = 97 * MiB;
constexpr size_t AR_H = WS_AR;
constexpr size_t AR_PR = WS_AR, AR_MQ = WS_AR + 56 * MiB, AR_MK = WS_AR + 72 * MiB, AR_MVT = WS_AR + 88 * MiB;
constexpr size_t AR_SCANIN = WS_AR + 56 * MiB;
constexpr size_t AR_YLOC = WS_AR, AR_Z = WS_AR + 32 * MiB;
constexpr size_t AR_STATE = WS_AR + 152 * MiB;
constexpr size_t AR_XB2 = WS_AR, AR_XQ = WS_AR + 32 * MiB, AR_XO = WS_AR + 64 * MiB;
constexpr size_t WS_END = WS_AR + 168 * MiB;

#define GAS __attribute__((address_space(1)))
#define LAS __attribute__((address_space(3)))

namespace pg8 {
#define PG8_LAS __attribute__((address_space(3)))
typedef unsigned short bf16_t;
typedef short bf16x8 __attribute__((ext_vector_type(8)));
typedef float f32x4 __attribute__((ext_vector_type(4)));
typedef unsigned u32x4 __attribute__((ext_vector_type(4)));
constexpr int BM = 256, BK = 64, HALF = 128, HTB = HALF * BK * 2  , STAGE_BYTES = 8 * HTB, NXCD = 8, WGM = 8;

__host__ __device__ __forceinline__ int lds_byte(int r, int c) { const int st = (r >> 4) * 2 + (c >> 5), rr = r & 15, cc = c & 31, ob = rr * 64 + cc * 2; return st * 1024 + (ob ^ (((ob >> 9) & 1) << 5)); }
__host__ __device__ __forceinline__ void stage_rc(int b, int& R, int& C) { const int st = b / 1024, sb = b % 1024, swz = sb ^ (((sb >> 9) & 1) << 5); R = (st >> 1) * 16 + swz / 64; C = (st & 1) * 32 + (swz % 64) / 2; }
__host__ __device__ __forceinline__ int perm32(int rho) { const int n = rho >> 4, i = rho & 15; return 8 * (i >> 2) + 4 * n + (i & 3); }

struct Unit { int pm, pn; };
struct Gemm { const bf16_t* A; const bf16_t* Bt; int M, N, K; };

struct StaticOrder {
    int nM, nN, nwg, G, c;
    __host__ __device__ void init(int M, int N, int G_, int c_) { nM = M / BM; nN = N / BM; nwg = nM * nN; G = G_; c = c_; }
    __host__ __device__ bool next(int i, Unit& u) const {
        const long L = (long)i * G + c; if (L >= nwg) return false;
        int wgid = (int)L; { const int q = nwg / NXCD, r = nwg % NXCD, xcd = wgid % NXCD, off = wgid / NXCD; wgid = (xcd < r ? xcd * (q + 1) : r * (q + 1) + (xcd - r) * q) + off; }
        const int nig = WGM * nN, gid = wgid / nig, fm = gid * WGM, gsz = (nM - fm) < WGM ? (nM - fm) : WGM;
        u.pm = fm + ((wgid % nig) % gsz); u.pn = (wgid % nig) / gsz; return true;
    }
    __device__ __forceinline__ void a_ready(const Unit&) const {}
    __device__ __forceinline__ void done(const Unit&) const {}
};

__device__ __forceinline__ unsigned cvt_pk_bf16(float lo, float hi) { unsigned r; asm volatile("v_cvt_pk_bf16_f32 %0, %1, %2" : "=v"(r) : "v"(lo), "v"(hi)); return r; }
typedef float f32x2 __attribute__((ext_vector_type(2)));
__device__ __forceinline__ float row_rstd16(const float* ssq, int r) {
    const f32x4* p = (const f32x4*)(ssq + (size_t)r * 16);
    const f32x4 a = p[0], b = p[1], c = p[2], d = p[3];
    const float s = ((a[0] + a[1]) + (a[2] + a[3])) + ((b[0] + b[1]) + (b[2] + b[3])) + ((c[0] + c[1]) + (c[2] + c[3])) + ((d[0] + d[1]) + (d[2] + d[3]));
    return __builtin_amdgcn_rsqf(s * (1.0f / 1024.0f) + 1e-6f);
}
__device__ __forceinline__ float silu_mul(float g, float u) { return g * __builtin_amdgcn_rcpf(1.0f + __expf(-g)) * u; }
__device__ __forceinline__ u32x4 pack8(const f32x4 v0, const f32x4 v1) { u32x4 w; w.x = cvt_pk_bf16(v0[0], v0[1]); w.y = cvt_pk_bf16(v0[2], v0[3]); w.z = cvt_pk_bf16(v1[0], v1[1]); w.w = cvt_pk_bf16(v1[2], v1[3]); return w; }
__device__ __forceinline__ int pos16(int k) { return 8 * ((k >> 2) & 1) + (k & 3) + 4 * (k >> 3); }

struct EpiSwiGLU {
    static constexpr bool PERM = true, AFTER_DRAIN = false;
    unsigned char* ws;
    __device__ __forceinline__ void operator()(const f32x4 (&acc)[2][2][4][2], const Unit& u, int wr, int wc, int fr, int fq) const {
        const int row0 = u.pm * BM + wr * 64 + fr, hcol = u.pn * 128 + wc * 32 + 8 * fq; bf16_t* H = (bf16_t*)(ws + AR_H); const float* ssq = (const float*)(ws + WS_SSQ);
#pragma unroll
        for (int ai = 0; ai < 2; ++ai)
#pragma unroll
            for (int m = 0; m < 4; ++m) { const int r = row0 + ai * HALF + m * 16; const float rs = row_rstd16(ssq, r);
                f32x4 h0, h1;
#pragma unroll
                for (int i = 0; i < 4; ++i) { h0[i] = silu_mul(acc[ai][0][m][0][i] * rs, acc[ai][1][m][0][i] * rs); h1[i] = silu_mul(acc[ai][0][m][1][i] * rs, acc[ai][1][m][1][i] * rs); }
                *(u32x4*)(H + (size_t)r * 2816 + hcol) = pack8(h0, h1); }
    }
};
struct EpiResid {
    static constexpr bool PERM = true, AFTER_DRAIN = false;
    const float* base; float* out; unsigned char* ws; size_t xb_off; float alpha;
    __device__ __forceinline__ void operator()(const f32x4 (&acc)[2][2][4][2], const Unit& u, int wr, int wc, int fr, int fq) const {
        const int row0 = u.pm * BM + wr * 64 + fr, col0 = u.pn * BM + wc * 32 + 8 * fq; bf16_t* xb = (bf16_t*)(ws + xb_off); float* ssq = (float*)(ws + WS_SSQ);
#pragma unroll
        for (int ai = 0; ai < 2; ++ai)
#pragma unroll
            for (int m = 0; m < 4; ++m) { const int r = row0 + ai * HALF + m * 16; float s = 0.f;
#pragma unroll
                for (int bj = 0; bj < 2; ++bj) { const size_t off = (size_t)r * 1024 + col0 + bj * HALF;
                    const f32x4 b0 = *(const f32x4*)(base + off), b1 = *(const f32x4*)(base + off + 4);
                    const f32x4 v0 = b0 + acc[ai][bj][m][0] * alpha, v1 = b1 + acc[ai][bj][m][1] * alpha;
                    *(f32x4*)(out + off) = v0; *(f32x4*)(out + off + 4) = v1; *(u32x4*)(xb + off) = pack8(v0, v1);
                    s += (v0[0] * v0[0] + v0[1] * v0[1]) + (v0[2] * v0[2] + v0[3] * v0[3]) + (v1[0] * v1[0] + v1[1] * v1[1]) + (v1[2] * v1[2] + v1[3] * v1[3]); }
                s += __shfl_xor(s, 16); s += __shfl_xor(s, 32);
                if (fq == 0) ssq[(size_t)r * 16 + u.pn * 4 + wc] = s; }
    }
};
struct EpiMixIn {
    static constexpr bool PERM = true, AFTER_DRAIN = false;
    unsigned char* ws;
    __device__ __forceinline__ void operator()(const f32x4 (&acc)[2][2][4][2], const Unit& u, int wr, int wc, int fr, int fq) const {
        const int row0 = u.pm * BM + wr * 64 + fr, cw = wc * 32 + 8 * fq; const float* ssq = (const float*)(ws + WS_SSQ);
        bf16_t* PR = (bf16_t*)(ws + AR_PR); bf16_t* MQ = (bf16_t*)(ws + AR_MQ); bf16_t* MK = (bf16_t*)(ws + AR_MK); bf16_t* MVT = (bf16_t*)(ws + AR_MVT);
#pragma unroll
        for (int ai = 0; ai < 2; ++ai)
#pragma unroll
            for (int m = 0; m < 4; ++m) { const int r = row0 + ai * HALF + m * 16; const float rs = row_rstd16(ssq, r);
#pragma unroll
                for (int bj = 0; bj < 2; ++bj) { const int c = cw + bj * HALF;
                    f32x4 v0 = acc[ai][bj][m][0] * rs, v1 = acc[ai][bj][m][1] * rs;
                    if (u.pn < 7) *(u32x4*)(PR + (size_t)r * 1792 + u.pn * 256 + c) = pack8(v0, v1);
                    else if (u.pn < 9) { v0 = v0 * MOBA_QSCALE; v1 = v1 * MOBA_QSCALE; *(u32x4*)(MQ + (size_t)r * 512 + (u.pn - 7) * 256 + c) = pack8(v0, v1); }
                    else if (u.pn < 11) *(u32x4*)(MK + (size_t)r * 512 + (u.pn - 9) * 256 + c) = pack8(v0, v1);
                    else { const int cc = (u.pn - 11) * 256 + c, hh = cc >> 6, d = cc & 63, b = r >> 11, t = r & 2047;
                        bf16_t* p = MVT + ((size_t)(b * 8 + hh) * 64 + d) * 2048 + (t & ~15) + pos16(t & 15);
                        const u32x4 w = pack8(v0, v1);
                        p[0] = (bf16_t)(w.x & 0xffffu); p[2048] = (bf16_t)(w.x >> 16); p[2 * 2048] = (bf16_t)(w.y & 0xffffu); p[3 * 2048] = (bf16_t)(w.y >> 16);
                        p[4 * 2048] = (bf16_t)(w.z & 0xffffu); p[5 * 2048] = (bf16_t)(w.z >> 16); p[6 * 2048] = (bf16_t)(w.w & 0xffffu); p[7 * 2048] = (bf16_t)(w.w >> 16); }
                } }
    }
};
struct EpiXQ {
    static constexpr bool PERM = true, AFTER_DRAIN = false;
    unsigned char* ws;
    __device__ __forceinline__ void operator()(const f32x4 (&acc)[2][2][4][2], const Unit& u, int wr, int wc, int fr, int fq) const {
        const int row0 = u.pm * BM + wr * 64 + fr, col0 = u.pn * BM + wc * 32 + 8 * fq; bf16_t* Q = (bf16_t*)(ws + AR_XQ); const float* ssq = (const float*)(ws + WS_SSQ);
#pragma unroll
        for (int ai = 0; ai < 2; ++ai)
#pragma unroll
            for (int m = 0; m < 4; ++m) { const int r = row0 + ai * HALF + m * 16; const float rs = row_rstd16(ssq, r) * XATT_QSCALE;
#pragma unroll
                for (int bj = 0; bj < 2; ++bj) *(u32x4*)(Q + (size_t)r * 1024 + col0 + bj * HALF) = pack8(acc[ai][bj][m][0] * rs, acc[ai][bj][m][1] * rs); }
    }
};
struct EpiKV {
    static constexpr bool PERM = true, AFTER_DRAIN = false;
    unsigned char* ws;
    __device__ __forceinline__ void operator()(const f32x4 (&acc)[2][2][4][2], const Unit& u, int wr, int wc, int fr, int fq) const {
        const int row0 = u.pm * BM + wr * 64 + fr, cw = wc * 32 + 8 * fq; bf16_t* XK = (bf16_t*)(ws + WS_XK); bf16_t* XVT = (bf16_t*)(ws + WS_XVT); const float* memrs = (const float*)(ws + WS_MEMRS);
#pragma unroll
        for (int ai = 0; ai < 2; ++ai)
#pragma unroll
            for (int m = 0; m < 4; ++m) { const int r = row0 + ai * HALF + m * 16; const float rs = memrs[r];
#pragma unroll
                for (int bj = 0; bj < 2; ++bj) { const int c = cw + bj * HALF;
                    const f32x4 v0 = acc[ai][bj][m][0] * rs, v1 = acc[ai][bj][m][1] * rs;
                    if (u.pn < 4) *(u32x4*)(XK + (size_t)r * 1024 + u.pn * 256 + c) = pack8(v0, v1);
                    else { const int hx = u.pn - 4, b = r >> 8, key = r & 255;
                        bf16_t* p = XVT + ((size_t)(b * 4 + hx) * 256 + c) * 256 + (key & ~15) + pos16(key & 15);
                        const u32x4 w = pack8(v0, v1);
                        p[0] = (bf16_t)(w.x & 0xffffu); p[256] = (bf16_t)(w.x >> 16); p[2 * 256] = (bf16_t)(w.y & 0xffffu); p[3 * 256] = (bf16_t)(w.y >> 16);
                        p[4 * 256] = (bf16_t)(w.z & 0xffffu); p[5 * 256] = (bf16_t)(w.z >> 16); p[6 * 256] = (bf16_t)(w.w & 0xffffu); p[7 * 256] = (bf16_t)(w.w >> 16); }
                } }
    }
};

template <class Epi, class Sched, bool ALIGN_EPI = false, bool SP2 = false>
__device__ __forceinline__ void gemm_phase(PG8_LAS unsigned char* lds, const Gemm g, const Sched& S, const Epi& E) {
    int tid_ = threadIdx.x; asm volatile("" : "+v"(tid_));
    const int tid = tid_, wid = __builtin_amdgcn_readfirstlane(tid >> 6), lane = tid & 63, wr = wid >> 2, wc = wid & 3, fr = lane & 15, fq = lane >> 4;
    const int K = g.K, nt = K / BK;
    unsigned voffA[2], voffB[2];
#pragma unroll
    for (int i = 0; i < 2; ++i) { int R, C; stage_rc(tid * 16 + i * 8192, R, C); const int Rb = Epi::PERM ? ((R & ~31) + perm32(R & 31)) : R;
        voffA[i] = (unsigned)(R * K + C) * 2u; voffB[i] = (unsigned)(Rb * K + C) * 2u; }
    const size_t kstep = (size_t)(BK * 2);
    const size_t hstep = (size_t)HALF * K * 2;
    const size_t tstep = 2 * hstep;
    const unsigned ldsw = (unsigned)wid * 1024u;
    const int aoff = lds_byte(wr * 64 + fr, fq * 8), boff = lds_byte(wc * 32 + fr, fq * 8);
#define PG8_SA(b, h) (((b) * 2 + (h)) * HTB)
#define PG8_SB(b, h) ((4 + (b) * 2 + (h)) * HTB)
#define PG8_STAGE(bufoff, gbase, voff) do { _Pragma("unroll") for (int _i = 0; _i < 2; ++_i) \
        __builtin_amdgcn_global_load_lds((const unsigned*)((const char*)(gbase) + (voff)[_i]), (PG8_LAS unsigned*)(lds + (bufoff) + ldsw + _i * 8192), 16, 0, 0); } while (0)
#define PG8_LDA(dst, b, h) do { _Pragma("unroll") for (int m = 0; m < 4; ++m) _Pragma("unroll") for (int k = 0; k < 2; ++k) dst[m][k] = *(const PG8_LAS bf16x8*)(lds + PG8_SA(b, h) + aoff + m * 2048 + k * 1024); } while (0)
#define PG8_LDB(dst, b, h) do { _Pragma("unroll") for (int n = 0; n < 2; ++n) _Pragma("unroll") for (int k = 0; k < 2; ++k) dst[n][k] = *(const PG8_LAS bf16x8*)(lds + PG8_SB(b, h) + boff + n * 2048 + k * 1024); } while (0)
#define PG8_MMA(ai, bj, At, Bt) do { __builtin_amdgcn_s_setprio(1); _Pragma("unroll") for (int m = 0; m < 4; ++m) _Pragma("unroll") for (int n = 0; n < 2; ++n) _Pragma("unroll") for (int k = 0; k < 2; ++k) \
        acc[ai][bj][m][n] = __builtin_amdgcn_mfma_f32_16x16x32_bf16(Bt[n][k], At[m][k], acc[ai][bj][m][n], 0, 0, 0); __builtin_amdgcn_s_setprio(0); } while (0)
#define PG8_WAIT_V(n) asm volatile("s_waitcnt vmcnt(" #n ")" ::: "memory")
#define PG8_WAIT_L(n) asm volatile("s_waitcnt lgkmcnt(" #n ")" ::: "memory")
#define PG8_BAR __builtin_amdgcn_s_barrier()
#define PG8_SCHED __builtin_amdgcn_sched_barrier(0)
    Unit cur, nxt; int ui = 0;
    if (!S.next(0, cur)) return;
    f32x4 acc[2][2][4][2];
#pragma unroll
    for (int a = 0; a < 2; ++a)
#pragma unroll
        for (int b = 0; b < 2; ++b)
#pragma unroll
            for (int m = 0; m < 4; ++m)
#pragma unroll
                for (int n = 0; n < 2; ++n) acc[a][b][m][n] = (f32x4){0.f, 0.f, 0.f, 0.f};
    bf16x8 At[4][2], B0[2][2], B1[2][2];
    const char* cA = (const char*)g.A + (size_t)cur.pm * tstep; const char* cB = (const char*)g.Bt + (size_t)cur.pn * tstep;
    S.a_ready(cur);
    if constexpr (SP2) {
        PG8_STAGE(PG8_SB(0, 0), cB, voffB); PG8_STAGE(PG8_SB(0, 1), cB + hstep, voffB); PG8_STAGE(PG8_SA(0, 0), cA, voffA); PG8_STAGE(PG8_SA(0, 1), cA + hstep, voffA);
        if (wr == 1) PG8_BAR;
        PG8_WAIT_V(2); PG8_BAR;
        PG8_STAGE(PG8_SB(1, 0), cB + kstep, voffB); PG8_STAGE(PG8_SA(1, 0), cA + kstep, voffA); PG8_STAGE(PG8_SB(1, 1), cB + hstep + kstep, voffB);
        PG8_WAIT_V(6); PG8_BAR;
    } else {
        PG8_STAGE(PG8_SB(0, 0), cB, voffB); PG8_STAGE(PG8_SA(0, 0), cA, voffA); PG8_STAGE(PG8_SB(0, 1), cB + hstep, voffB); PG8_STAGE(PG8_SA(0, 1), cA + hstep, voffA);
        if (wr == 1) PG8_BAR;
        PG8_WAIT_V(4); PG8_BAR;
        PG8_STAGE(PG8_SB(1, 0), cB + kstep, voffB); PG8_STAGE(PG8_SA(1, 0), cA + kstep, voffA); PG8_STAGE(PG8_SB(1, 1), cB + hstep + kstep, voffB);
        PG8_WAIT_V(6); PG8_BAR;
    }
    for (;;) {
        const bool has_next = S.next(ui + 1, nxt);
        const char* nA = has_next ? (const char*)g.A + (size_t)nxt.pm * tstep : cA; const char* nB = has_next ? (const char*)g.Bt + (size_t)nxt.pn * tstep : cB;
        for (int t = 0; t < nt; t += 2) {
            const bool last = (t == nt - 2);
            const char* a1 = cA + (size_t)(t + 1) * kstep;
            const char* a2 = last ? nA : cA + (size_t)(t + 2) * kstep; const char* b2 = last ? nB : cB + (size_t)(t + 2) * kstep;
            const char* a3 = a2 + kstep; const char* b3 = b2 + kstep;
            if (last && has_next) S.a_ready(nxt);
            if constexpr (SP2) {
            PG8_LDB(B0, 0, 0); PG8_LDB(B1, 0, 1); PG8_SCHED; PG8_LDA(At, 0, 0); PG8_STAGE(PG8_SA(1, 1), a1 + hstep, voffA);
            PG8_WAIT_V(8); PG8_WAIT_L(0); PG8_BAR; PG8_MMA(0, 0, At, B0); PG8_MMA(0, 1, At, B1); PG8_BAR; PG8_SCHED;
            PG8_LDA(At, 0, 1); PG8_STAGE(PG8_SB(0, 0), b2, voffB); PG8_STAGE(PG8_SB(0, 1), b2 + hstep, voffB); PG8_STAGE(PG8_SA(0, 0), a2, voffA);
            PG8_WAIT_V(8); PG8_WAIT_L(0); PG8_BAR; PG8_MMA(1, 0, At, B0); PG8_MMA(1, 1, At, B1); PG8_BAR; PG8_SCHED;
            PG8_LDB(B0, 1, 0); PG8_LDB(B1, 1, 1); PG8_SCHED; PG8_LDA(At, 1, 0); PG8_STAGE(PG8_SA(0, 1), a2 + hstep, voffA);
            PG8_WAIT_V(8); PG8_WAIT_L(0); PG8_BAR; PG8_MMA(0, 0, At, B0); PG8_MMA(0, 1, At, B1); PG8_BAR; PG8_SCHED;
            PG8_LDA(At, 1, 1); PG8_STAGE(PG8_SB(1, 0), b3, voffB); PG8_STAGE(PG8_SB(1, 1), b3 + hstep, voffB); PG8_STAGE(PG8_SA(1, 0), a3, voffA);
            PG8_WAIT_V(8); PG8_WAIT_L(0); PG8_BAR; PG8_MMA(1, 0, At, B0); PG8_MMA(1, 1, At, B1); PG8_BAR; PG8_SCHED;
            } else {
            PG8_LDB(B0, 0, 0); PG8_SCHED; PG8_LDA(At, 0, 0); PG8_STAGE(PG8_SA(1, 1), a1 + hstep, voffA);
            PG8_WAIT_L(8); PG8_BAR; PG8_WAIT_L(0); PG8_MMA(0, 0, At, B0); PG8_BAR; PG8_SCHED;
            PG8_LDB(B1, 0, 1); PG8_STAGE(PG8_SB(0, 0), b2, voffB);
            PG8_BAR; PG8_WAIT_L(0); PG8_MMA(0, 1, At, B1); PG8_BAR;
            PG8_LDA(At, 0, 1); PG8_STAGE(PG8_SA(0, 0), a2, voffA);
            PG8_BAR; PG8_WAIT_L(0); PG8_MMA(1, 0, At, B0); PG8_BAR; PG8_SCHED;
            PG8_STAGE(PG8_SB(0, 1), b2 + hstep, voffB);
            PG8_WAIT_V(6); PG8_BAR; PG8_MMA(1, 1, At, B1); PG8_BAR;
            PG8_LDB(B0, 1, 0); PG8_SCHED; PG8_LDA(At, 1, 0); PG8_STAGE(PG8_SA(0, 1), a2 + hstep, voffA);
            PG8_WAIT_L(8); PG8_BAR; PG8_WAIT_L(0); PG8_MMA(0, 0, At, B0); PG8_BAR; PG8_SCHED;
            PG8_LDB(B1, 1, 1); PG8_STAGE(PG8_SB(1, 0), b3, voffB);
            PG8_BAR; PG8_WAIT_L(0); PG8_MMA(0, 1, At, B1); PG8_BAR;
            PG8_LDA(At, 1, 1); PG8_STAGE(PG8_SA(1, 0), a3, voffA);
            PG8_BAR; PG8_WAIT_L(0); PG8_MMA(1, 0, At, B0); PG8_BAR; PG8_SCHED;
            PG8_STAGE(PG8_SB(1, 1), b3 + hstep, voffB);
            PG8_WAIT_V(6); PG8_BAR; PG8_MMA(1, 1, At, B1); PG8_BAR;
            }
        }
        if constexpr (ALIGN_EPI) { if (wr == 0) PG8_BAR; }
        if constexpr (!Epi::AFTER_DRAIN) { E(acc, cur, wr, wc, fr, fq); S.done(cur); }
        if (!has_next) break;
#pragma unroll
        for (int a = 0; a < 2; ++a)
#pragma unroll
            for (int b = 0; b < 2; ++b)
#pragma unroll
                for (int m = 0; m < 4; ++m)
#pragma unroll
                    for (int n = 0; n < 2; ++n) acc[a][b][m][n] = (f32x4){0.f, 0.f, 0.f, 0.f};
        cur = nxt; cA = nA; cB = nB; ++ui;
        if constexpr (ALIGN_EPI) { if (wr == 1) PG8_BAR; }
    }
    PG8_WAIT_V(0);
    if constexpr (!ALIGN_EPI) { if (wr == 0) PG8_BAR; }
    PG8_BAR;
    if constexpr (Epi::AFTER_DRAIN) { E.fused(acc, cur, wr, wc, fr, fq, lds, wid, lane); S.done(cur); }
#undef PG8_SA
#undef PG8_SB
#undef PG8_STAGE
#undef PG8_LDA
#undef PG8_LDB
#undef PG8_MMA
#undef PG8_WAIT_V
#undef PG8_WAIT_L
#undef PG8_BAR
#undef PG8_SCHED
}
}

constexpr int NWAVES = 8;
constexpr int RING_BYTES = 131072, LDSCTL_OFF = RING_BYTES, MISC_OFF = LDSCTL_OFF + 320, LDS_BYTES = 147456;
constexpr int SCAN_R = 2, SCAN_NCH = 8;

typedef unsigned short bf16;
typedef unsigned u32x4 __attribute__((ext_vector_type(4)));
typedef unsigned u32x2 __attribute__((ext_vector_type(2)));
typedef float f32x4 __attribute__((ext_vector_type(4)));
typedef float f32x16 __attribute__((ext_vector_type(16)));
typedef short bf16x8 __attribute__((ext_vector_type(8)));
typedef GAS unsigned gu32;
#define RLX_AGENT __ATOMIC_RELAXED, __HIP_MEMORY_SCOPE_AGENT
#define LDS_WAIT() asm volatile("s_waitcnt lgkmcnt(0)" ::: "memory")
#define VM_WAIT() asm volatile("s_waitcnt vmcnt(0)" ::: "memory")
__device__ __forceinline__ float bf2f(unsigned b) { return __uint_as_float(b << 16); }
__device__ __forceinline__ unsigned f2bf(float f) { unsigned u = __builtin_bit_cast(unsigned, f); return (u + 0x7fffu + ((u >> 16) & 1u)) >> 16; }
__device__ __forceinline__ unsigned pk2(float lo, float hi) { return pg8::cvt_pk_bf16(lo, hi); }
__device__ __forceinline__ float wave_sum(float v) {
#pragma unroll
    for (int o = 1; o < 64; o <<= 1) v += __shfl_xor(v, o);
    return v;
}
__device__ __forceinline__ float quad_sum(float x) {
    x += __builtin_bit_cast(float, __builtin_amdgcn_update_dpp(0, __builtin_bit_cast(int, x), 0xB1, 0xF, 0xF, true));
    x += __builtin_bit_cast(float, __builtin_amdgcn_update_dpp(0, __builtin_bit_cast(int, x), 0x4E, 0xF, 0xF, true));
    return x;
}
__device__ __forceinline__ float sigmoidf_(float x) { return __builtin_amdgcn_rcpf(1.0f + __expf(-x)); }
__device__ __forceinline__ int crow(int r, int hi) { return (r & 3) + 8 * (r >> 2) + 4 * hi; }
__device__ __forceinline__ bf16x8 pack_bf16x8(float a0, float a1, float a2, float a3, float a4, float a5, float a6, float a7) {
    u32x4 w; w.x = pk2(a0, a1); w.y = pk2(a2, a3); w.z = pk2(a4, a5); w.w = pk2(a6, a7); return __builtin_bit_cast(bf16x8, w);
}

#define XB_TMO      128
#define XB_XCNT(j)  (256  + 64 * (j))
#define XB_XSUB(j)  (1280 + 64 * (j))
#define XB_XGEN(j)  (2304 + 64 * (j))
#define XB_TOP      3328
#define XB_TOPGEN   3392
#define XCD_BAR_WORDS 3456
#define XB_SPIN_CAP (1u << 18)

__device__ __forceinline__ unsigned xb_ld(unsigned* p)              { return __hip_atomic_load(p, __ATOMIC_RELAXED, __HIP_MEMORY_SCOPE_AGENT); }
__device__ __forceinline__ unsigned xb_add(unsigned* p, unsigned v) { return __hip_atomic_fetch_add(p, v, __ATOMIC_RELAXED, __HIP_MEMORY_SCOPE_AGENT); }
__device__ __forceinline__ unsigned xb_xcc_id() { return (unsigned)__builtin_amdgcn_s_getreg((3 << 11) | 20) & 0xFu; }
#define XB_SPIN(cond, bar) do { unsigned _sp = 0; while (cond) { __builtin_amdgcn_s_sleep(1); \
    if ((++_sp & 255u) == 0u) { if (xb_ld(&(bar)[XB_TMO])) break; if (_sp > XB_SPIN_CAP) { atomicAdd(&(bar)[XB_TMO], 1u); break; } } } } while (0)

struct XcdBarrier {
    unsigned* bar; unsigned x;
    volatile LAS unsigned* st;
};

__device__ __forceinline__ XcdBarrier xcd_barrier_post(unsigned* bar, volatile LAS unsigned* st) {
    XcdBarrier b; b.bar = bar; b.x = xb_xcc_id(); b.st = st;
    if (threadIdx.x == 0) (void)xb_add(&bar[XB_XCNT(b.x)], 1u);
    return b;
}
__device__ __forceinline__ void xcd_barrier_complete(unsigned* bar, unsigned x, unsigned& nloc, unsigned& nx) {
    const unsigned G = gridDim.x * gridDim.y * gridDim.z;
    unsigned sum, cnt, mine, sp = 0u;
    for (;;) {
        sum = 0u; cnt = 0u; mine = 0u;
#pragma unroll
        for (unsigned j = 0; j < 16; ++j) { const unsigned c = xb_ld(&bar[XB_XCNT(j)]); sum += c; cnt += (c > 0u) ? 1u : 0u; mine = (j == x) ? c : mine; }
        if (sum == G) break;
        __builtin_amdgcn_s_sleep(1);
        if ((++sp & 255u) == 0u) { if (xb_ld(&bar[XB_TMO])) break; if (sp > XB_SPIN_CAP) { atomicAdd(&bar[XB_TMO], 1u); break; } }
    }
    nloc = mine > 0u ? mine : 1u; nx = cnt > 0u ? cnt : 1u;
}

__device__ __forceinline__ void xcd_barrier(const XcdBarrier& b) {
    asm volatile("s_waitcnt vmcnt(0)" ::: "memory");
    __syncthreads();
    if (threadIdx.x == 0) {
        unsigned* bar = b.bar;
        __builtin_amdgcn_s_waitcnt(0);
        unsigned nloc = b.st[0], nx = b.st[1];
        if (nloc == 0u) { xcd_barrier_complete(bar, b.x, nloc, nx); b.st[0] = nloc; b.st[1] = nx; }
        const unsigned old = xb_add(&bar[XB_XSUB(b.x)], 1u);
        const unsigned gen = old / nloc;
        if (old + 1u == (gen + 1u) * nloc) {
            __builtin_amdgcn_fence(__ATOMIC_RELEASE, "agent");
            asm volatile("s_waitcnt vmcnt(0)" ::: "memory");
            const unsigned og = xb_add(&bar[XB_TOP], 1u);
            const unsigned tg = og / nx;
            if (og + 1u == (tg + 1u) * nx) xb_add(&bar[XB_TOPGEN], 1u);
            else XB_SPIN(xb_ld(&bar[XB_TOPGEN]) == tg, bar);
            __builtin_amdgcn_fence(__ATOMIC_ACQUIRE, "agent");
            xb_add(&bar[XB_XGEN(b.x)], 1u);
            asm volatile("s_waitcnt vmcnt(0)" ::: "memory");
        } else {
            XB_SPIN(xb_ld(&bar[XB_XGEN(b.x)]) == gen, bar);
            __builtin_amdgcn_fence(__ATOMIC_ACQUIRE, "agent");
            asm volatile("s_waitcnt vmcnt(0)" ::: "memory");
        }
    }
    __syncthreads();
}


struct Args { const float* in[N_IN]; float* out; unsigned char* ws; int ph_lo, ph_hi; };
static_assert(sizeof(Args) == N_IN * 8 + 24, "Args has no padding");
struct Frame {
    LAS unsigned char* lds; volatile LAS unsigned* MISC; gu32* ctl;
    int tid, lane, wave, vcu, G;
    const __attribute__((address_space(4))) struct Args* ka; float* out; unsigned char* ws;
};
#define FIN(i) (F.ka->in[i])
#define WSP(T, off) ((T*)(F.ws + (off)))

__device__ __forceinline__ void ph_init(Frame& F) {
    const int gw = F.vcu * NWAVES + F.wave, NGW = F.G * NWAVES;
    float* bias = WSP(float, WS_BIAS); const float* relb = FIN(I_RELB);
    for (int i = blockIdx.x * 512 + F.tid; i < NH * 2048; i += F.G * 512) { const int h = i >> 11, n = i & 2047; int bkt;
        if (n < 16) bkt = n; else { const float nf = (float)n; const int lg = 16 + (int)(logf(nf / 16.0f) / 4.1588830833596715f * 16.0f); bkt = lg < 31 ? lg : 31; }
        bias[i] = relb[h * 32 + bkt] * LOG2E; }
    const float* mem = FIN(I_MEM); bf16* memb = WSP(bf16, WS_MEMB); float* memrs = WSP(float, WS_MEMRS);
    for (int r = gw; r < MM; r += NGW) { const f32x4* xr = (const f32x4*)(mem + (size_t)r * DM) + F.lane; f32x4 v[4]; float s = 0.f;
#pragma unroll
        for (int j = 0; j < 4; ++j) { v[j] = xr[64 * j]; s += (v[j].x * v[j].x + v[j].y * v[j].y) + (v[j].z * v[j].z + v[j].w * v[j].w); }
        s = wave_sum(s); u32x2* o = (u32x2*)(memb + (size_t)r * DM) + F.lane;
#pragma unroll
        for (int j = 0; j < 4; ++j) { u32x2 w; w.x = pk2(v[j].x, v[j].y); w.y = pk2(v[j].z, v[j].w); o[64 * j] = w; }
        if (F.lane == 0) memrs[r] = __builtin_amdgcn_rsqf(s * (1.0f / DM) + NORM_EPS); }
    const float* x = FIN(I_X); bf16* xb = WSP(bf16, WS_XB); float* ssq = WSP(float, WS_SSQ);
    for (int r = gw; r < M; r += NGW) { const f32x4* xr = (const f32x4*)(x + (size_t)r * DM) + F.lane; f32x4 v[4]; float s = 0.f;
#pragma unroll
        for (int j = 0; j < 4; ++j) { v[j] = xr[64 * j]; s += (v[j].x * v[j].x + v[j].y * v[j].y) + (v[j].z * v[j].z + v[j].w * v[j].w); }
        s = wave_sum(s); u32x2* o = (u32x2*)(xb + (size_t)r * DM) + F.lane;
#pragma unroll
        for (int j = 0; j < 4; ++j) { u32x2 w; w.x = pk2(v[j].x, v[j].y); w.y = pk2(v[j].z, v[j].w); o[64 * j] = w; }
        if (F.lane < 16) ssq[(size_t)r * 16 + F.lane] = F.lane == 0 ? s : 0.f; }
}

__device__ __forceinline__ void conv_item(const float* W, int K, int N, const float* gk, bf16* WT, int item, bool ffn_in, LAS float* scr, int lane) {
    const int nblk = N / 32, kb = item / nblk, nb = item % nblk, k0 = 64 * kb, n0 = 32 * nb;
#pragma unroll 8
    for (int i = 0; i < 32; ++i) { const int kk = 2 * i + (lane >> 5); float w = W[(size_t)(k0 + kk) * N + n0 + (lane & 31)]; if (gk) w *= gk[k0 + kk]; scr[kk * 33 + (lane & 31)] = w; }
    LDS_WAIT(); asm volatile("" ::: "memory");
    int drow0 = n0; if (ffn_in) drow0 = n0 < DFF ? 256 * (n0 / 128) + (n0 % 128) : 256 * ((n0 - DFF) / 128) + 128 + ((n0 - DFF) % 128);
    const int c = lane & 7;
#pragma unroll
    for (int j = 0; j < 4; ++j) { const int n = (lane >> 3) + 8 * j; const LAS float* s = scr + (8 * c) * 33 + n;
        u32x4 o; o.x = pk2(s[0 * 33], s[1 * 33]); o.y = pk2(s[2 * 33], s[3 * 33]); o.z = pk2(s[4 * 33], s[5 * 33]); o.w = pk2(s[6 * 33], s[7 * 33]);
        *(u32x4*)(WT + (size_t)(drow0 + n) * K + k0 + 8 * c) = o; }
    LDS_WAIT(); asm volatile("" ::: "memory");
}
__device__ __forceinline__ void ph_conv(Frame& F, int l) {
    LAS float* scr = (LAS float*)(F.lds + F.wave * 16384);
    const int gw = F.vcu * NWAVES + F.wave, NGW = F.G * NWAVES;
    constexpr int I_FIN = (DM / 64) * (2 * DFF / 32), I_FOUT = (DFF / 64) * (DM / 32), I_MI = (DM / 64) * (DPROJ / 32), I_SQ = (DM / 64) * (DM / 32), I_KV = (DM / 64) * (2 * DM / 32);
    constexpr int NITEMS = 2 * I_FIN + 2 * I_FOUT + I_MI + 3 * I_SQ + I_KV;
    unsigned char* wb = F.ws + WS_W;
    for (int it = gw; it < NITEMS; it += NGW) { int r = it;
        if (r < I_FIN) { conv_item(FIN(I_F1IN) + (size_t)l * DM * 2 * DFF, DM, 2 * DFF, FIN(I_F1G) + l * DM, (bf16*)(wb + W_F1IN), r, true, scr, F.lane); continue; } r -= I_FIN;
        if (r < I_FIN) { conv_item(FIN(I_F2IN) + (size_t)l * DM * 2 * DFF, DM, 2 * DFF, FIN(I_F2G) + l * DM, (bf16*)(wb + W_F2IN), r, true, scr, F.lane); continue; } r -= I_FIN;
        if (r < I_FOUT) { conv_item(FIN(I_F1OUT) + (size_t)l * DFF * DM, DFF, DM, nullptr, (bf16*)(wb + W_F1OUT), r, false, scr, F.lane); continue; } r -= I_FOUT;
        if (r < I_FOUT) { conv_item(FIN(I_F2OUT) + (size_t)l * DFF * DM, DFF, DM, nullptr, (bf16*)(wb + W_F2OUT), r, false, scr, F.lane); continue; } r -= I_FOUT;
        if (r < I_MI) { conv_item(FIN(I_MIXIN) + (size_t)l * DM * DPROJ, DM, DPROJ, FIN(I_MIXG) + l * DM, (bf16*)(wb + W_MIXIN), r, false, scr, F.lane); continue; } r -= I_MI;
        if (r < I_SQ) { conv_item(FIN(I_MIXOUT) + (size_t)l * DM * DM, DM, DM, nullptr, (bf16*)(wb + W_MIXOUT), r, false, scr, F.lane); continue; } r -= I_SQ;
        if (r < I_SQ) { conv_item(FIN(I_WQ) + (size_t)l * DM * DM, DM, DM, FIN(I_XG) + l * DM, (bf16*)(wb + W_WQ), r, false, scr, F.lane); continue; } r -= I_SQ;
        if (r < I_SQ) { conv_item(FIN(I_WO) + (size_t)l * DM * DM, DM, DM, nullptr, (bf16*)(wb + W_WO), r, false, scr, F.lane); continue; } r -= I_SQ;
        conv_item(FIN(I_WKV) + (size_t)l * DM * 2 * DM, DM, 2 * DM, FIN(I_MEMG) + l * DM, (bf16*)(wb + W_WKV), r, false, scr, F.lane);
    }
}

__device__ __forceinline__ void ph_moba(Frame& F) {
    LAS float* kmean = (LAS float*)F.lds;
    LAS float* btab = (LAS float*)(F.lds + 2048);
    const bf16* MQ = WSP(bf16, AR_MQ); const bf16* MK = WSP(bf16, AR_MK); const bf16* MVT = WSP(bf16, AR_MVT); bf16* XB = WSP(bf16, WS_XB); const float* bias = WSP(float, WS_BIAS);
    const int lane = F.lane, r32 = lane & 31, hi = lane >> 5, wave = F.wave;
    for (int u = blockIdx.x; u < 512; u += F.G) {
        const int rnd = u >> 8, iu = u & 255, qsel = iu >> 6, bh = iu & 63, qb = rnd == 0 ? 7 - qsel : qsel, b = bh >> 3, hh = bh & 7;
        __syncthreads();
        { const int n = F.tid >> 6, d = F.tid & 63;
          if (n < qb) { const bf16* kp = MK + (size_t)(b * 2048 + n * 256) * 512 + hh * 64 + d; float s = 0.f;
#pragma unroll 8
              for (int k = 0; k < 256; ++k) s += bf2f(kp[(size_t)k * 512]);
              kmean[n * 64 + d] = s * (1.0f / 256.0f); }
          for (int i2 = F.tid; i2 < 2048; i2 += 512) btab[i2] = bias[hh * 2048 + i2]; }
        __syncthreads();
        const int q0 = qb * 256 + wave * 32; const size_t tok = (size_t)b * 2048 + q0 + r32;
        bf16x8 qf[4];
#pragma unroll
        for (int s = 0; s < 4; ++s) qf[s] = *(const bf16x8*)(MQ + tok * 512 + hh * 64 + 16 * s + 8 * hi);
        float g[7]; unsigned selmask = 0u;
#pragma unroll
        for (int n = 0; n < 7; ++n) { g[n] = -INFINITY;
            if (n < qb) { float p = 0.f;
#pragma unroll
                for (int s = 0; s < 4; ++s) { const f32x4 k0v = *(const LAS f32x4*)(kmean + n * 64 + 16 * s + 8 * hi), k1v = *(const LAS f32x4*)(kmean + n * 64 + 16 * s + 8 * hi + 4);
                    p += bf2f((unsigned short)qf[s][0]) * k0v[0] + bf2f((unsigned short)qf[s][1]) * k0v[1] + bf2f((unsigned short)qf[s][2]) * k0v[2] + bf2f((unsigned short)qf[s][3]) * k0v[3]
                       + bf2f((unsigned short)qf[s][4]) * k1v[0] + bf2f((unsigned short)qf[s][5]) * k1v[1] + bf2f((unsigned short)qf[s][6]) * k1v[2] + bf2f((unsigned short)qf[s][7]) * k1v[3]; }
                p += __shfl_xor(p, 32); g[n] = p; } }
        if (qb <= 3) selmask = (1u << qb) - 1u;
        else {
#pragma unroll
            for (int n = 0; n < 7; ++n) if (n < qb) { int cnt = 0;
#pragma unroll
                for (int n2 = 0; n2 < 7; ++n2) if (n2 != n && n2 < qb) cnt += (g[n2] > g[n] || (g[n2] == g[n] && n2 < n)) ? 1 : 0;
                if (cnt < 3) selmask |= 1u << n; } }
        float mrun = -INFINITY, lrun = 0.f; f32x16 o0, o1;
#pragma unroll
        for (int i = 0; i < 16; ++i) { o0[i] = 0.f; o1[i] = 0.f; }
        const int qpos = q0 + r32;
        const bf16* Kb = MK + (size_t)b * 2048 * 512 + hh * 64 + 8 * hi;
        const bf16* Vb = MVT + ((size_t)(b * 8 + hh) * 64 + r32) * 2048 + 8 * hi;
        for (int blk = 0; blk <= qb; ++blk) {
            const bool own = blk == qb; const bool selme = own || ((selmask >> blk) & 1u);
            if (!own && __ballot(selme) == 0ull) continue;
            const int nt = own ? wave + 1 : 8;
            for (int kt = 0; kt < nt; ++kt) { const int k0 = blk * 256 + kt * 32;
                bf16x8 kf[4], vf[2][2];
#pragma unroll
                for (int s = 0; s < 4; ++s) kf[s] = *(const bf16x8*)(Kb + (size_t)(k0 + r32) * 512 + 16 * s);
#pragma unroll
                for (int dt = 0; dt < 2; ++dt)
#pragma unroll
                    for (int sp = 0; sp < 2; ++sp) vf[dt][sp] = *(const bf16x8*)(Vb + (size_t)dt * 32 * 2048 + k0 + 16 * sp);
                f32x16 sc;
#pragma unroll
                for (int i = 0; i < 16; ++i) sc[i] = 0.f;
#pragma unroll
                for (int s = 0; s < 4; ++s) sc = __builtin_amdgcn_mfma_f32_32x32x16_bf16(kf[s], qf[s], sc, 0, 0, 0);
                float mx = -INFINITY;
#pragma unroll
                for (int r = 0; r < 16; ++r) { const int dist = qpos - (k0 + crow(r, hi)); const bool valid = selme && (!own || dist >= 0);
                    const float v = valid ? sc[r] + btab[dist < 0 ? 0 : dist] : -INFINITY; sc[r] = v; mx = fmaxf(mx, v); }
                mx = fmaxf(mx, __shfl_xor(mx, 32));
                const float mnew = fmaxf(mrun, mx), muse = (mnew == -INFINITY) ? 0.f : mnew;
                const float alpha = __builtin_amdgcn_exp2f(mrun - muse);
                float ps = 0.f;
#pragma unroll
                for (int r = 0; r < 16; ++r) { const float p = __builtin_amdgcn_exp2f(sc[r] - muse); sc[r] = p; ps += p; }
                lrun = lrun * alpha + ps; mrun = mnew;
#pragma unroll
                for (int i = 0; i < 16; ++i) { o0[i] *= alpha; o1[i] *= alpha; }
                const bf16x8 pf0 = pack_bf16x8(sc[0], sc[1], sc[2], sc[3], sc[4], sc[5], sc[6], sc[7]), pf1 = pack_bf16x8(sc[8], sc[9], sc[10], sc[11], sc[12], sc[13], sc[14], sc[15]);
                o0 = __builtin_amdgcn_mfma_f32_32x32x16_bf16(vf[0][0], pf0, o0, 0, 0, 0); o0 = __builtin_amdgcn_mfma_f32_32x32x16_bf16(vf[0][1], pf1, o0, 0, 0, 0);
                o1 = __builtin_amdgcn_mfma_f32_32x32x16_bf16(vf[1][0], pf0, o1, 0, 0, 0); o1 = __builtin_amdgcn_mfma_f32_32x32x16_bf16(vf[1][1], pf1, o1, 0, 0, 0);
            }
        }
        lrun += __shfl_xor(lrun, 32); const float inv = 1.0f / lrun;
        bf16* op = XB + tok * 1024 + 512 + hh * 64 + 4 * hi;
#pragma unroll
        for (int g4 = 0; g4 < 4; ++g4) { u32x2 w0, w1; w0.x = pk2(o0[4 * g4] * inv, o0[4 * g4 + 1] * inv); w0.y = pk2(o0[4 * g4 + 2] * inv, o0[4 * g4 + 3] * inv);
            w1.x = pk2(o1[4 * g4] * inv, o1[4 * g4 + 1] * inv); w1.y = pk2(o1[4 * g4 + 2] * inv, o1[4 * g4 + 3] * inv);
            *(u32x2*)(op + 8 * g4) = w0; *(u32x2*)(op + 32 + 8 * g4) = w1; }
    }
}

__device__ __forceinline__ void ph_xatt(Frame& F) {
    const bf16* XQ = WSP(bf16, AR_XQ); const bf16* XK = WSP(bf16, WS_XK); const bf16* XVT = WSP(bf16, WS_XVT); bf16* XO = WSP(bf16, AR_XO);
    const int lane = F.lane, r32 = lane & 31, hi = lane >> 5, wave = F.wave;
    for (int u = blockIdx.x; u < 256; u += F.G) {
        const int b = u >> 5, hx = (u >> 3) & 3, qt = u & 7;
        const size_t tok = (size_t)b * 2048 + qt * 256 + wave * 32 + r32;
        const bf16* Qp = XQ + tok * 1024 + hx * 256 + 8 * hi;
        const bf16* Kb = XK + (size_t)(b * 256 + r32) * 1024 + hx * 256 + 8 * hi;
        const bf16* Vb = XVT + ((size_t)(b * 4 + hx) * 256 + r32) * 256 + 8 * hi;
        float mrun = -INFINITY, lrun = 0.f; f32x16 o[8];
#pragma unroll
        for (int dt = 0; dt < 8; ++dt)
#pragma unroll
            for (int i = 0; i < 16; ++i) o[dt][i] = 0.f;
        for (int kt = 0; kt < 8; ++kt) { const int k0 = kt * 32;
            f32x16 sc;
#pragma unroll
            for (int i = 0; i < 16; ++i) sc[i] = 0.f;
#pragma unroll
            for (int s = 0; s < 16; ++s) { const bf16x8 kf = *(const bf16x8*)(Kb + (size_t)k0 * 1024 + 16 * s), qf = *(const bf16x8*)(Qp + 16 * s);
                sc = __builtin_amdgcn_mfma_f32_32x32x16_bf16(kf, qf, sc, 0, 0, 0); }
            float mx = sc[0];
#pragma unroll
            for (int r = 1; r < 16; ++r) mx = fmaxf(mx, sc[r]);
            mx = fmaxf(mx, __shfl_xor(mx, 32));
            const float mnew = fmaxf(mrun, mx), alpha = __builtin_amdgcn_exp2f(mrun - mnew);
            float ps = 0.f;
#pragma unroll
            for (int r = 0; r < 16; ++r) { const float p = __builtin_amdgcn_exp2f(sc[r] - mnew); sc[r] = p; ps += p; }
            lrun = lrun * alpha + ps; mrun = mnew;
            const bf16x8 pf0 = pack_bf16x8(sc[0], sc[1], sc[2], sc[3], sc[4], sc[5], sc[6], sc[7]), pf1 = pack_bf16x8(sc[8], sc[9], sc[10], sc[11], sc[12], sc[13], sc[14], sc[15]);
#pragma unroll
            for (int dt = 0; dt < 8; ++dt) {
#pragma unroll
                for (int i = 0; i < 16; ++i) o[dt][i] *= alpha;
                const bf16x8 v0 = *(const bf16x8*)(Vb + (size_t)dt * 32 * 256 + k0), v1 = *(const bf16x8*)(Vb + (size_t)dt * 32 * 256 + k0 + 16);
                o[dt] = __builtin_amdgcn_mfma_f32_32x32x16_bf16(v0, pf0, o[dt], 0, 0, 0); o[dt] = __builtin_amdgcn_mfma_f32_32x32x16_bf16(v1, pf1, o[dt], 0, 0, 0); }
        }
        lrun += __shfl_xor(lrun, 32); const float inv = 1.0f / lrun;
        bf16* op = XO + tok * 1024 + hx * 256 + 4 * hi;
#pragma unroll
        for (int dt = 0; dt < 8; ++dt)
#pragma unroll
            for (int g4 = 0; g4 < 4; ++g4) { u32x2 w; w.x = pk2(o[dt][4 * g4] * inv, o[dt][4 * g4 + 1] * inv); w.y = pk2(o[dt][4 * g4 + 2] * inv, o[dt][4 * g4 + 3] * inv);
                *(u32x2*)(op + 32 * dt + 8 * g4) = w; }
    }
}

__device__ __forceinline__ void ph_prep(Frame& F, int l) {
    LAS float* lat = (LAS float*)F.lds;
    const bf16* PR = WSP(bf16, AR_PR); bf16* SCANIN = WSP(bf16, AR_SCANIN); bf16* XB = WSP(bf16, WS_XB); float* BONUS = WSP(float, WS_BONUS);
    const int c = F.tid, h = F.wave, j = F.lane;
    const float* mu = FIN(I_MU) + l * RPROJ; const float* wup = FIN(I_WUP) + (size_t)l * 64 * RW; const float* aup = FIN(I_AUP) + (size_t)l * 64 * RW; const float* gup = FIN(I_GUP) + (size_t)l * 128 * RW;
    const float mu_r = mu[c], mu_k = mu[512 + c], mu_v = mu[1024 + c], w0c = FIN(I_W0)[l * RW + c], a0c = FIN(I_A0)[l * RW + c], kkc = FIN(I_KK)[l * RW + c], kac = FIN(I_KA)[l * RW + c], rkc = FIN(I_RK)[l * RW + c];
    for (int tile = blockIdx.x; tile < M / 16; tile += F.G) { const int t0 = tile * 16;
        __syncthreads();
        { const int tt = F.tid >> 5, l8 = (F.tid & 31) * 8, t = t0 + tt;
          const u32x4 cur = *(const u32x4*)(PR + (size_t)t * RPROJ + 1536 + l8); u32x4 prv = {0u, 0u, 0u, 0u}; if (t & 2047) prv = *(const u32x4*)(PR + (size_t)(t - 1) * RPROJ + 1536 + l8);
          const f32x4 m0 = *(const f32x4*)(mu + 1536 + l8), m1 = *(const f32x4*)(mu + 1536 + l8 + 4);
          float xv[8];
#pragma unroll
          for (int i = 0; i < 4; ++i) { const unsigned cw = cur[i], pw = prv[i]; const float p0 = bf2f(cw & 0xffffu), p1 = bf2f(cw >> 16), q0 = bf2f(pw & 0xffffu), q1 = bf2f(pw >> 16);
              const float ma = i < 2 ? m0[2 * i] : m1[2 * i - 4], mb = i < 2 ? m0[2 * i + 1] : m1[2 * i - 3];
              xv[2 * i] = p0 + (q0 - p0) * ma; xv[2 * i + 1] = p1 + (q1 - p1) * mb; }
#pragma unroll
          for (int i = 0; i < 8; ++i) { if (l8 < 64) xv[i] = tanhf(xv[i]); else if (l8 >= 128) xv[i] = sigmoidf_(xv[i]); }
          *(LAS f32x4*)(lat + tt * 256 + l8) = (f32x4){xv[0], xv[1], xv[2], xv[3]}; *(LAS f32x4*)(lat + tt * 256 + l8 + 4) = (f32x4){xv[4], xv[5], xv[6], xv[7]}; }
        __syncthreads();
        float aw[16], aa[16], ag[16];
#pragma unroll
        for (int tt = 0; tt < 16; ++tt) { aw[tt] = 0.f; aa[tt] = 0.f; ag[tt] = 0.f; }
        for (int i4 = 0; i4 < 16; ++i4) { float wu[4], au[4];
#pragma unroll
            for (int q = 0; q < 4; ++q) { wu[q] = wup[(size_t)(4 * i4 + q) * RW + c]; au[q] = aup[(size_t)(4 * i4 + q) * RW + c]; }
#pragma unroll
            for (int tt = 0; tt < 16; ++tt) { const f32x4 lw = *(const LAS f32x4*)(lat + tt * 256 + 4 * i4), la = *(const LAS f32x4*)(lat + tt * 256 + 64 + 4 * i4);
                aw[tt] += lw[0] * wu[0] + lw[1] * wu[1] + lw[2] * wu[2] + lw[3] * wu[3]; aa[tt] += la[0] * au[0] + la[1] * au[1] + la[2] * au[2] + la[3] * au[3]; } }
        for (int i4 = 0; i4 < 32; ++i4) { float gu[4];
#pragma unroll
            for (int q = 0; q < 4; ++q) gu[q] = gup[(size_t)(4 * i4 + q) * RW + c];
#pragma unroll
            for (int tt = 0; tt < 16; ++tt) { const f32x4 lg = *(const LAS f32x4*)(lat + tt * 256 + 128 + 4 * i4); ag[tt] += lg[0] * gu[0] + lg[1] * gu[1] + lg[2] * gu[2] + lg[3] * gu[3]; } }
#pragma unroll
        for (int tt = 0; tt < 16; ++tt) { const int t = t0 + tt, bb = t >> 11, tp = t & 2047; const bf16* pc = PR + (size_t)t * RPROJ;
            float r = bf2f(pc[c]), k = bf2f(pc[512 + c]), v = bf2f(pc[1024 + c]), rp = 0.f, kp = 0.f, vp = 0.f;
            if (tp != 0) { rp = bf2f(pc[c - RPROJ]); kp = bf2f(pc[512 + c - RPROJ]); vp = bf2f(pc[1024 + c - RPROJ]); }
            r += (rp - r) * mu_r; k += (kp - k) * mu_k; v += (vp - v) * mu_v;
            const float wv = w0c + aw[tt], xs = -wv, sp = xs > 20.f ? xs : log1pf(__expf(xs)), wlog = -sp - 0.5f, ld = -__expf(wlog);
            const float a = sigmoidf_(a0c + aa[tt]);
            const float kk = k * kkc, kt = k * (1.0f + (a - 1.0f) * kac);
            const float n2 = wave_sum(kk * kk), kkn = kk / fmaxf(sqrtf(n2), 1e-12f);
            const float bon = wave_sum(r * kt * rkc); if (j == 0) BONUS[(size_t)t * 8 + h] = bon;
            bf16* so = SCANIN + ((size_t)(bb * 8 + h) * 2048 + tp) * 384 + j;
            so[0] = (bf16)f2bf(-kkn); so[64] = (bf16)f2bf(ld); so[128] = (bf16)f2bf(kkn * a); so[192] = (bf16)f2bf(kt); so[256] = (bf16)f2bf(r); so[320] = (bf16)f2bf(v);
            XB[(size_t)t * 1024 + c] = (bf16)f2bf(ag[tt]); }
    }
}

template <int R, int NCH, bool KINDP>
__device__ __forceinline__ void scan_stream(Frame& F, LAS float* ring, int bh, int ch, int rg, int lis) {
    constexpr int CLEN = SEQ / NCH, NHALF = CLEN / 8;
    const int lane = F.lane, js = lane & 3, q = lane >> 2, row0 = rg * 16 * R + q * R, tbase = ch * CLEN;
    const bf16* src = WSP(bf16, AR_SCANIN) + ((size_t)bh * 2048 + tbase) * 384;
    float* YL = WSP(float, AR_YLOC) + ((size_t)bh * 2048 + tbase) * 64; bf16* ZZ = WSP(bf16, AR_Z) + ((size_t)bh * 2048 + tbase) * 64;
    float S[R][16];
#pragma unroll
    for (int rr = 0; rr < R; ++rr)
#pragma unroll
        for (int jj = 0; jj < 16; ++jj) S[rr][jj] = (KINDP && (row0 + rr) == 16 * js + jj) ? 1.f : 0.f;
    u32x4 pre[2];
#pragma unroll
    for (int k = 0; k < 2; ++k) { const int ci = lis + k * 256; if (ci < 384) pre[k] = *(const u32x4*)(src + (size_t)ci * 8); }
#pragma unroll
    for (int k = 0; k < 2; ++k) { const int ci = lis + k * 256; if (ci < 384) { const bool isld = ((ci % 48) >> 3) == 1; float f[8];
#pragma unroll
            for (int i = 0; i < 4; ++i) { f[2 * i] = bf2f(pre[k][i] & 0xffffu); f[2 * i + 1] = bf2f(pre[k][i] >> 16); }
            if (isld) {
#pragma unroll
                for (int i = 0; i < 8; ++i) f[i] = __expf(f[i]); }
            *(LAS f32x4*)(ring + ci * 8) = (f32x4){f[0], f[1], f[2], f[3]}; *(LAS f32x4*)(ring + ci * 8 + 4) = (f32x4){f[4], f[5], f[6], f[7]}; } }
    __syncthreads();
    for (int hf = 0; hf < NHALF; ++hf) {
        const bool more = hf + 1 < NHALF;
        if (more) {
#pragma unroll
            for (int k = 0; k < 2; ++k) { const int ci = lis + k * 256; if (ci < 384) pre[k] = *(const u32x4*)(src + (size_t)(hf + 1) * 3072 + (size_t)ci * 8); } }
        for (int st = 0; st < 8; ++st) {
            const LAS float* sp = ring + ((hf & 1) * 8 + st) * 384 + 16 * js;
            float sa[R];
            { f32x4 n[4];
#pragma unroll
              for (int i = 0; i < 4; ++i) n[i] = *(const LAS f32x4*)(sp + 4 * i);
#pragma unroll
              for (int rr = 0; rr < R; ++rr) { float p[4];
#pragma unroll
                  for (int g = 0; g < 4; ++g) { p[g] = S[rr][4 * g] * n[g][0];
#pragma unroll
                      for (int e = 1; e < 4; ++e) p[g] += S[rr][4 * g + e] * n[g][e]; }
                  sa[rr] = quad_sum((p[0] + p[1]) + (p[2] + p[3])); } }
            f32x4 w[4], bv[4], kv[4], rv[4];
#pragma unroll
            for (int i = 0; i < 4; ++i) { w[i] = *(const LAS f32x4*)(sp + 64 + 4 * i); bv[i] = *(const LAS f32x4*)(sp + 128 + 4 * i); rv[i] = *(const LAS f32x4*)(sp + 256 + 4 * i);
                if (!KINDP) kv[i] = *(const LAS f32x4*)(sp + 192 + 4 * i); }
            float y[R];
#pragma unroll
            for (int rr = 0; rr < R; ++rr) { float vv = 0.f; if (!KINDP) vv = ring[((hf & 1) * 8 + st) * 384 + 320 + row0 + rr]; float p[4];
#pragma unroll
                for (int g = 0; g < 4; ++g) { p[g] = 0.f;
#pragma unroll
                    for (int e = 0; e < 4; ++e) { const int jj = 4 * g + e; float s = S[rr][jj] * w[g][e] + sa[rr] * bv[g][e]; if (!KINDP) s += vv * kv[g][e]; S[rr][jj] = s; p[g] += s * rv[g][e]; } }
                y[rr] = quad_sum((p[0] + p[1]) + (p[2] + p[3])); }
            if (js == 0) { const int t = hf * 8 + st;
#pragma unroll
                for (int rr = 0; rr < R; ++rr) { if (KINDP) ZZ[(size_t)t * 64 + row0 + rr] = (bf16)f2bf(y[rr]); else YL[(size_t)t * 64 + row0 + rr] = y[rr]; } }
        }
        if (more) {
#pragma unroll
            for (int k = 0; k < 2; ++k) { const int ci = lis + k * 256; if (ci < 384) { const bool isld = ((ci % 48) >> 3) == 1; float f[8];
#pragma unroll
                    for (int i = 0; i < 4; ++i) { f[2 * i] = bf2f(pre[k][i] & 0xffffu); f[2 * i + 1] = bf2f(pre[k][i] >> 16); }
                    if (isld) {
#pragma unroll
                        for (int i = 0; i < 8; ++i) f[i] = __expf(f[i]); }
                    LAS float* dst = ring + (((hf + 1) & 1) * 8) * 384 + ci * 8;
                    *(LAS f32x4*)(dst) = (f32x4){f[0], f[1], f[2], f[3]}; *(LAS f32x4*)(dst + 4) = (f32x4){f[4], f[5], f[6], f[7]}; } } }
        __syncthreads();
    }
    if (NCH > 1) {
        float* st = WSP(float, AR_STATE) + ((size_t)(bh * NCH + ch) * 2 + (KINDP ? 0 : 1)) * 4096;
#pragma unroll
        for (int rr = 0; rr < R; ++rr)
#pragma unroll
            for (int i = 0; i < 4; ++i) *(f32x4*)(st + (size_t)(row0 + rr) * 64 + 16 * js + 4 * i) = (f32x4){S[rr][4 * i], S[rr][4 * i + 1], S[rr][4 * i + 2], S[rr][4 * i + 3]};
    }
}
template <int R, int NCH>
__device__ __forceinline__ void ph_scan(Frame& F) {
    constexpr int KINDS = NCH > 1 ? 2 : 1, RG = 4 / R, WPS = KINDS * RG, SPW = NWAVES / WPS, NSTREAM = BATCH * NH * NCH;
    static_assert(WPS == 4, "staging assumes 4 waves per stream");
    const int sl = F.wave / WPS, role = F.wave % WPS, kind = role / RG, rg = role % RG, lis = role * 64 + F.lane;
    LAS float* ring = (LAS float*)F.lds + sl * (16 * 384);
    for (int it = blockIdx.x; it * SPW < NSTREAM; it += F.G) {
        const int sid = it * SPW + sl, bh = sid / NCH, ch = sid % NCH;
        __syncthreads();
        if (kind == 0) scan_stream<R, NCH, false>(F, ring, bh, ch, rg, lis); else scan_stream<R, NCH, true>(F, ring, bh, ch, rg, lis);
    }
}

template <int NCH>
__device__ __forceinline__ void ph_fix(Frame& F) {
    typedef float f32x2 __attribute__((ext_vector_type(2)));
    LAS float* cur = (LAS float*)F.lds;
    for (int u = blockIdx.x; u < 256; u += F.G) { const int bh = u >> 2, rgx = u & 3, i = F.tid >> 5, j2 = (F.tid & 31) * 2, row = rgx * 16 + i;
        float* base = WSP(float, AR_STATE) + (size_t)bh * NCH * 2 * 4096;
        __syncthreads();
        { const f32x2 v = *(const f32x2*)(base + 4096 + row * 64 + j2); cur[i * 64 + j2] = v.x; cur[i * 64 + j2 + 1] = v.y; }
        __syncthreads();
        for (int c = 1; c < NCH - 1; ++c) { const float* P = base + (size_t)(c * 2) * 4096; float* SL = base + (size_t)(c * 2 + 1) * 4096;
            f32x2 acc = *(const f32x2*)(SL + row * 64 + j2);
#pragma unroll 8
            for (int ii = 0; ii < 64; ++ii) { const float sv = cur[i * 64 + ii]; const f32x2 p = *(const f32x2*)(P + ii * 64 + j2); acc.x += sv * p.x; acc.y += sv * p.y; }
            __syncthreads();
            cur[i * 64 + j2] = acc.x; cur[i * 64 + j2 + 1] = acc.y; *(f32x2*)(SL + row * 64 + j2) = acc;
            __syncthreads(); }
    }
}

template <int NCH>
__device__ __forceinline__ void ph_post(Frame& F, int l) {
    constexpr int CLEN = SEQ / NCH;
    const float* YL = WSP(float, AR_YLOC); const bf16* SCANIN = WSP(bf16, AR_SCANIN); bf16* XB = WSP(bf16, WS_XB); const float* BONUS = WSP(float, WS_BONUS); const bf16* ZZ = WSP(bf16, AR_Z);
    LAS float* zt = (LAS float*)F.lds;
    const int c = F.tid, h = F.wave, j = F.lane; const float lng = FIN(I_LNG)[l * RW + c], lnb = FIN(I_LNB)[l * RW + c];
    for (int grp = blockIdx.x; grp < M / 64; grp += F.G) { const int t0g = grp * 64, bb = t0g >> 11, ch = (t0g & 2047) / CLEN, bh = bb * 8 + h; const bool corr = NCH > 1 && ch > 0;
        float st[64];
        if (corr) { const float* sp = WSP(float, AR_STATE) + ((size_t)(bh * NCH + ch - 1) * 2 + 1) * 4096 + j * 64;
#pragma unroll
            for (int i4 = 0; i4 < 16; ++i4) { const f32x4 v = *(const f32x4*)(sp + 4 * i4); st[4 * i4] = v[0]; st[4 * i4 + 1] = v[1]; st[4 * i4 + 2] = v[2]; st[4 * i4 + 3] = v[3]; } }
        for (int ti = 0; ti < 4; ++ti) { const int t0 = t0g + 16 * ti;
            if (corr) { __syncthreads();
#pragma unroll 4
                for (int tt = 0; tt < 16; ++tt) zt[tt * 512 + c] = bf2f(ZZ[((size_t)bh * 2048 + ((t0 + tt) & 2047)) * 64 + j]);
                __syncthreads(); }
#pragma unroll 2
            for (int tt = 0; tt < 16; ++tt) { const int t = t0 + tt, tp = t & 2047;
                float y = YL[((size_t)bh * 2048 + tp) * 64 + j];
                if (corr) { const LAS float* zp = zt + tt * 512 + h * 64; float p0 = 0.f, p1 = 0.f, p2 = 0.f, p3 = 0.f;
#pragma unroll
                    for (int j4 = 0; j4 < 16; ++j4) { const f32x4 zz = *(const LAS f32x4*)(zp + 4 * j4); p0 += st[4 * j4] * zz[0]; p1 += st[4 * j4 + 1] * zz[1]; p2 += st[4 * j4 + 2] * zz[2]; p3 += st[4 * j4 + 3] * zz[3]; }
                    y += (p0 + p1) + (p2 + p3); }
                const float mean = wave_sum(y) * (1.0f / 64.0f), d = y - mean, var = wave_sum(d * d) * (1.0f / 64.0f);
                const float yn = d * __builtin_amdgcn_rsqf(var + LNX_EPS) * lng + lnb;
                const float v = bf2f(SCANIN[((size_t)bh * 2048 + tp) * 384 + 320 + j]), bon = BONUS[(size_t)t * 8 + h], g = bf2f(XB[(size_t)t * 1024 + c]);
                XB[(size_t)t * 1024 + c] = (bf16)f2bf((yn + bon * v) * g); }
        }
    }
}

__device__ __forceinline__ void ph_final(Frame& F) {
    const int gw = F.vcu * NWAVES + F.wave, NGW = F.G * NWAVES; const float* ssq = WSP(float, WS_SSQ); const float* g = FIN(I_FING);
    f32x4 gv[4];
#pragma unroll
    for (int j = 0; j < 4; ++j) gv[j] = ((const f32x4*)g)[F.lane + 64 * j];
    for (int r = gw; r < M; r += NGW) { const float rs = pg8::row_rstd16(ssq, r); f32x4* xr = (f32x4*)(F.out + (size_t)r * DM) + F.lane;
#pragma unroll
        for (int j = 0; j < 4; ++j) { const f32x4 v = xr[64 * j]; xr[64 * j] = v * rs * gv[j]; } }
}

constexpr int PH_INIT = 0, PH_PER_LAYER = 16, PH_FINAL = 1 + DEPTH * PH_PER_LAYER, N_PHASES = PH_FINAL + 1;
enum { K_CONV = 0, K_KV, K_F1UP, K_F1DN, K_MIXIN, K_MOBA, K_PREP, K_SCAN, K_FIX, K_POST, K_MIXOUT, K_XQ, K_XATT, K_XO, K_F2UP, K_F2DN };

__global__ void __launch_bounds__(NWAVES * 64, 2) fwd(Args args) {
    extern __shared__ __attribute__((aligned(16))) unsigned char lds[];
    Frame F;
    F.lds = (LAS unsigned char*)lds; F.MISC = (volatile LAS unsigned*)(F.lds + MISC_OFF);
    F.tid = threadIdx.x; F.lane = F.tid & 63; F.wave = __builtin_amdgcn_readfirstlane(F.tid >> 6);
    F.G = gridDim.x; { const int bx = blockIdx.x; F.vcu = (F.G % 8 == 0) ? (bx % 8) * (F.G / 8) + bx / 8 : bx; }
    F.out = args.out; F.ws = args.ws; F.ctl = (gu32*)(args.ws + WS_CTL);
    F.ka = (const __attribute__((address_space(4))) Args*)(uintptr_t)__builtin_amdgcn_kernarg_segment_ptr();
    for (int u = F.tid; u < (LDS_BYTES - LDSCTL_OFF) / 4; u += NWAVES * 64) ((LAS unsigned*)(F.lds + LDSCTL_OFF))[u] = 0u;
    __syncthreads();
    const bool multi = args.ph_hi - args.ph_lo > 1;
    XcdBarrier bar; bar.bar = (unsigned*)(F.ctl + 4096); bar.x = 0; bar.st = nullptr;
    if (multi) bar = xcd_barrier_post((unsigned*)(F.ctl + 4096), F.MISC + 8);
#ifndef REP_AT
#define REP_AT 1000
#endif
    for (int pi = args.ph_lo; pi < args.ph_hi + (REP_AT < 1000 ? 1 : 0); ++pi) { const int ph = pi - (pi > REP_AT ? 1 : 0);
        { uintptr_t kp = (uintptr_t)__builtin_amdgcn_kernarg_segment_ptr(); asm volatile("" : "+s"(kp)); F.ka = (const __attribute__((address_space(4))) Args*)kp; }
        { int t_ = threadIdx.x; asm volatile("" : "+v"(t_)); F.tid = t_; F.lane = t_ & 63; F.wave = __builtin_amdgcn_readfirstlane(t_ >> 6); }
        unsigned char* wb = F.ws + WS_W;
        if (ph == PH_INIT) ph_init(F);
        else if (ph == PH_FINAL) ph_final(F);
        else { const int l = (ph - 1) / PH_PER_LAYER, k = (ph - 1) % PH_PER_LAYER;
            const float* xin = (l == 0) ? FIN(I_X) : (const float*)F.out;
            switch (k) {
            case K_CONV: ph_conv(F, l); break;
            case K_KV: { pg8::Gemm g{WSP(bf16, WS_MEMB), (const bf16*)(wb + W_WKV), MM, 2 * DM, DM}; pg8::StaticOrder S; S.init(MM, 2 * DM, F.G, (int)blockIdx.x);
                pg8::EpiKV E{F.ws}; pg8::gemm_phase<pg8::EpiKV, pg8::StaticOrder, true, true>(F.lds, g, S, E); } break;
            case K_F1UP: case K_F2UP: { pg8::Gemm g{WSP(bf16, WS_XB), (const bf16*)(wb + (k == K_F1UP ? W_F1IN : W_F2IN)), M, 2 * DFF, DM}; pg8::StaticOrder S; S.init(M, 2 * DFF, F.G, (int)blockIdx.x);
                pg8::EpiSwiGLU E{F.ws}; pg8::gemm_phase<pg8::EpiSwiGLU, pg8::StaticOrder, true, true>(F.lds, g, S, E); } break;
            case K_F1DN: case K_F2DN: { pg8::Gemm g{WSP(bf16, AR_H), (const bf16*)(wb + (k == K_F1DN ? W_F1OUT : W_F2OUT)), M, DM, DFF}; pg8::StaticOrder S; S.init(M, DM, F.G, (int)blockIdx.x);
                pg8::EpiResid E{k == K_F1DN ? xin : (const float*)F.out, F.out, F.ws, WS_XB, 0.5f}; pg8::gemm_phase<pg8::EpiResid, pg8::StaticOrder, true, true>(F.lds, g, S, E); } break;
            case K_MIXIN: { pg8::Gemm g{WSP(bf16, WS_XB), (const bf16*)(wb + W_MIXIN), M, DPROJ, DM}; pg8::StaticOrder S; S.init(M, DPROJ, F.G, (int)blockIdx.x);
                pg8::EpiMixIn E{F.ws}; pg8::gemm_phase<pg8::EpiMixIn, pg8::StaticOrder, true, true>(F.lds, g, S, E); } break;
            case K_MOBA: ph_moba(F); break;
            case K_PREP: ph_prep(F, l); break;
            case K_SCAN: ph_scan<SCAN_R, SCAN_NCH>(F); break;
            case K_FIX: if (SCAN_NCH > 1) ph_fix<SCAN_NCH>(F); break;
            case K_POST: ph_post<SCAN_NCH>(F, l); break;
            case K_MIXOUT: { pg8::Gemm g{WSP(bf16, WS_XB), (const bf16*)(wb + W_MIXOUT), M, DM, DM}; pg8::StaticOrder S; S.init(M, DM, F.G, (int)blockIdx.x);
                pg8::EpiResid E{F.out, F.out, F.ws, AR_XB2, 1.0f}; pg8::gemm_phase<pg8::EpiResid, pg8::StaticOrder, true, true>(F.lds, g, S, E); } break;
            case K_XQ: { pg8::Gemm g{WSP(bf16, AR_XB2), (const bf16*)(wb + W_WQ), M, DM, DM}; pg8::StaticOrder S; S.init(M, DM, F.G, (int)blockIdx.x);
                pg8::EpiXQ E{F.ws}; pg8::gemm_phase<pg8::EpiXQ, pg8::StaticOrder, true, true>(F.lds, g, S, E); } break;
            case K_XATT: ph_xatt(F); break;
            case K_XO: { pg8::Gemm g{WSP(bf16, AR_XO), (const bf16*)(wb + W_WO), M, DM, DM}; pg8::StaticOrder S; S.init(M, DM, F.G, (int)blockIdx.x);
                pg8::EpiResid E{F.out, F.out, F.ws, WS_XB, 1.0f}; pg8::gemm_phase<pg8::EpiResid, pg8::StaticOrder, true, true>(F.lds, g, S, E); } break;
            default: break;
            }
        }
        if (pi + 1 < args.ph_hi + (REP_AT < 1000 ? 1 : 0)) {
            const bool noop = (ph != PH_INIT && ph != PH_FINAL && ((ph - 1) % PH_PER_LAYER) == K_FIX && SCAN_NCH == 1);
            if (!noop) { if (ph == PH_INIT) cooperative_groups::this_grid().sync(); else xcd_barrier(bar); }
        }
    }
}

extern "C" void kernel_launch(void* const* d_in, const int* in_sizes, int n_in, void* d_out, int out_size, void* d_ws, size_t ws_size, hipStream_t stream) {
    static int grid = 0;
    if (grid == 0) {
        if (n_in != N_IN || in_sizes[0] != M * DM || out_size != M * DM || ws_size < WS_END) { fprintf(stderr, "kernel_launch: unexpected problem (n_in %d, in0 %d, out %d, ws %zu < %zu); nothing launched\n", n_in, n_in > 0 ? in_sizes[0] : -1, out_size, ws_size, (size_t)WS_END); grid = -1; return; }
        int dev = 0, cus = 0;
        if (hipGetDevice(&dev) != hipSuccess || hipDeviceGetAttribute(&cus, hipDeviceAttributeMultiprocessorCount, dev) != hipSuccess) { grid = -1; return; }
        if (hipFuncSetAttribute((const void*)fwd, hipFuncAttributeMaxDynamicSharedMemorySize, LDS_BYTES) != hipSuccess) { fprintf(stderr, "kernel_launch: hipFuncSetAttribute failed\n"); grid = -1; return; }
        int per_cu = 0;
        if (hipOccupancyMaxActiveBlocksPerMultiprocessor(&per_cu, (const void*)fwd, NWAVES * 64, LDS_BYTES) != hipSuccess || per_cu < 1) { fprintf(stderr, "kernel_launch: occupancy query reports %d workgroups per CU; nothing launched\n", per_cu); grid = -1; return; }
        grid = cus;
    }
    if (grid < 0) return;
    (void)hipMemsetAsync((char*)d_ws + WS_CTL, 0, CTL_ZERO_BYTES, stream);
    Args a{};
    for (int i = 0; i < N_IN; ++i) a.in[i] = (const float*)d_in[i];
    a.out = (float*)d_out; a.ws = (unsigned char*)d_ws;
    a.ph_lo = 0; a.ph_hi = N_PHASES;
    void* kargs[] = {&a};
    const hipError_t e = hipLaunchCooperativeKernel((const void*)fwd, dim3(grid), dim3(NWAVES * 64), kargs, LDS_BYTES, stream);
    if (e != hipSuccess) fprintf(stderr, "kernel_launch: cooperative launch failed: %s (grid %d)\n", hipGetErrorString(e), grid);
}
```

```cpp
#include <hip/hip_runtime.h>
#include <hip/hip_cooperative_groups.h>
#include <cstdio>
#include <cstdint>

constexpr int BATCH = 8, SEQ = 2048, DM = 1024, DEPTH = 2, M = BATCH * SEQ;
constexpr int RW = 512, NH = 8, HD = 64;
constexpr int RPROJ = 1792, DPROJ = 3328;
constexpr int DFF = 2816;
constexpr int MEMLEN = 256, XH = 4, XHD = 256, MM = BATCH * MEMLEN;
constexpr int MBLK = 256, NBLK = SEQ / MBLK;
constexpr float NORM_EPS = 1e-6f, LNX_EPS = 64e-5f;
constexpr float LOG2E = 1.4426950408889634f;
constexpr float MOBA_QSCALE = 0.125f * LOG2E;
constexpr float XATT_QSCALE = 0.0625f * LOG2E;

enum { I_X = 0, I_MEM, I_RELB, I_FING, I_F1G, I_F1IN, I_F1OUT, I_MIXG, I_MIXIN, I_MIXOUT, I_MU, I_W0, I_WUP, I_A0, I_AUP, I_GUP, I_KK, I_KA, I_RK, I_LNG, I_LNB,
       I_XG, I_MEMG, I_WQ, I_WKV, I_WO, I_F2G, I_F2IN, I_F2OUT, N_IN };

constexpr size_t MiB = 1u << 20;
constexpr size_t WS_CTL = 0, CTL_ZERO_BYTES = 1 * MiB;
constexpr size_t WS_BIAS = 1 * MiB;
constexpr size_t WS_MEMRS = WS_BIAS + 64 * 1024;
constexpr size_t WS_BONUS = WS_MEMRS + 64 * 1024;
constexpr size_t WS_SSQ = 2 * MiB;
constexpr size_t WS_MEMB = 3 * MiB;
constexpr size_t WS_XK = 7 * MiB, WS_XVT = 11 * MiB;
constexpr size_t WS_W = 15 * MiB;
constexpr size_t W_F1IN = 0, W_F1OUT = W_F1IN + (size_t)2 * DFF * DM * 2, W_F2IN = W_F1OUT + (size_t)DM * DFF * 2, W_F2OUT = W_F2IN + (size_t)2 * DFF * DM * 2,
                 W_MIXIN = W_F2OUT + (size_t)DM * DFF * 2, W_MIXOUT = W_MIXIN + (size_t)DPROJ * DM * 2, W_WQ = W_MIXOUT + (size_t)DM * DM * 2, W_WKV = W_WQ + (size_t)DM * DM * 2,
                 W_WO = W_WKV + (size_t)2 * DM * DM * 2, W_END = W_WO + (size_t)DM * DM * 2;
static_assert(W_END <= 50 * MiB, "weights fit");
constexpr size_t WS_XB = 65 * MiB;
constexpr size_t WS_AR = 97 * MiB;
constexpr size_t AR_H = WS_AR;
constexpr size_t AR_PR = WS_AR, AR_MQ = WS_AR + 56 * MiB, AR_MK = WS_AR + 72 * MiB, AR_MVT = WS_AR + 88 * MiB;
constexpr size_t AR_SCANIN = WS_AR + 56 * MiB;
constexpr size_t AR_YLOC = WS_AR, AR_Z = WS_AR + 32 * MiB;
constexpr size_t AR_STATE = WS_AR + 152 * MiB;
constexpr size_t AR_XB2 = WS_AR, AR_XQ = WS_AR + 32 * MiB, AR_XO = WS_AR + 64 * MiB;
constexpr size_t WS_END = WS_AR + 168 * MiB;

#define GAS __attribute__((address_space(1)))
#define LAS __attribute__((address_space(3)))

namespace pg8 {
#define PG8_LAS __attribute__((address_space(3)))
typedef unsigned short bf16_t;
typedef short bf16x8 __attribute__((ext_vector_type(8)));
typedef float f32x4 __attribute__((ext_vector_type(4)));
typedef unsigned u32x4 __attribute__((ext_vector_type(4)));
constexpr int BM = 256, BK = 64, HALF = 128, HTB = HALF * BK * 2  , STAGE_BYTES = 8 * HTB, NXCD = 8, WGM = 8;

__host__ __device__ __forceinline__ int lds_byte(int r, int c) { const int st = (r >> 4) * 2 + (c >> 5), rr = r & 15, cc = c & 31, ob = rr * 64 + cc * 2; return st * 1024 + (ob ^ (((ob >> 9) & 1) << 5)); }
__host__ __device__ __forceinline__ void stage_rc(int b, int& R, int& C) { const int st = b / 1024, sb = b % 1024, swz = sb ^ (((sb >> 9) & 1) << 5); R = (st >> 1) * 16 + swz / 64; C = (st & 1) * 32 + (swz % 64) / 2; }
__host__ __device__ __forceinline__ int perm32(int rho) { const int n = rho >> 4, i = rho & 15; return 8 * (i >> 2) + 4 * n + (i & 3); }

struct Unit { int pm, pn; };
struct Gemm { const bf16_t* A; const bf16_t* Bt; int M, N, K; };

struct StaticOrder {
    int nM, nN, nwg, G, c;
    __host__ __device__ void init(int M, int N, int G_, int c_) { nM = M / BM; nN = N / BM; nwg = nM * nN; G = G_; c = c_; }
    __host__ __device__ bool next(int i, Unit& u) const {
        const long L = (long)i * G + c; if (L >= nwg) return false;
        int wgid = (int)L; { const int q = nwg / NXCD, r = nwg % NXCD, xcd = wgid % NXCD, off = wgid / NXCD; wgid = (xcd < r ? xcd * (q + 1) : r * (q + 1) + (xcd - r) * q) + off; }
        const int nig = WGM * nN, gid = wgid / nig, fm = gid * WGM, gsz = (nM - fm) < WGM ? (nM - fm) : WGM;
        u.pm = fm + ((wgid % nig) % gsz); u.pn = (wgid % nig) / gsz; return true;
    }
    __device__ __forceinline__ void a_ready(const Unit&) const {}
    __device__ __forceinline__ void done(const Unit&) const {}
};

__device__ __forceinline__ unsigned cvt_pk_bf16(float lo, float hi) { unsigned r; asm volatile("v_cvt_pk_bf16_f32 %0, %1, %2" : "=v"(r) : "v"(lo), "v"(hi)); return r; }
typedef float f32x2 __attribute__((ext_vector_type(2)));
__device__ __forceinline__ float row_rstd16(const float* ssq, int r) {
    const f32x4* p = (const f32x4*)(ssq + (size_t)r * 16);
    const f32x4 a = p[0], b = p[1], c = p[2], d = p[3];
    const float s = ((a[0] + a[1]) + (a[2] + a[3])) + ((b[0] + b[1]) + (b[2] + b[3])) + ((c[0] + c[1]) + (c[2] + c[3])) + ((d[0] + d[1]) + (d[2] + d[3]));
    return __builtin_amdgcn_rsqf(s * (1.0f / 1024.0f) + 1e-6f);
}
__device__ __forceinline__ float silu_mul(float g, float u) { return g * __builtin_amdgcn_rcpf(1.0f + __expf(-g)) * u; }
__device__ __forceinline__ u32x4 pack8(const f32x4 v0, const f32x4 v1) { u32x4 w; w.x = cvt_pk_bf16(v0[0], v0[1]); w.y = cvt_pk_bf16(v0[2], v0[3]); w.z = cvt_pk_bf16(v1[0], v1[1]); w.w = cvt_pk_bf16(v1[2], v1[3]); return w; }
__device__ __forceinline__ int pos16(int k) { return 8 * ((k >> 2) & 1) + (k & 3) + 4 * (k >> 3); }

struct EpiSwiGLU {
    static constexpr bool PERM = true, AFTER_DRAIN = false;
    unsigned char* ws;
    __device__ __forceinline__ void operator()(const f32x4 (&acc)[2][2][4][2], const Unit& u, int wr, int wc, int fr, int fq) const {
        const int row0 = u.pm * BM + wr * 64 + fr, hcol = u.pn * 128 + wc * 32 + 8 * fq; bf16_t* H = (bf16_t*)(ws + AR_H); const float* ssq = (const float*)(ws + WS_SSQ);
#pragma unroll
        for (int ai = 0; ai < 2; ++ai)
#pragma unroll
            for (int m = 0; m < 4; ++m) { const int r = row0 + ai * HALF + m * 16; const float rs = row_rstd16(ssq, r);
                f32x4 h0, h1;
#pragma unroll
                for (int i = 0; i < 4; ++i) { h0[i] = silu_mul(acc[ai][0][m][0][i] * rs, acc[ai][1][m][0][i] * rs); h1[i] = silu_mul(acc[ai][0][m][1][i] * rs, acc[ai][1][m][1][i] * rs); }
                *(u32x4*)(H + (size_t)r * 2816 + hcol) = pack8(h0, h1); }
    }
};
struct EpiResid {
    static constexpr bool PERM = true, AFTER_DRAIN = false;
    const float* base; float* out; unsigned char* ws; size_t xb_off; float alpha;
    __device__ __forceinline__ void operator()(const f32x4 (&acc)[2][2][4][2], const Unit& u, int wr, int wc, int fr, int fq) const {
        const int row0 = u.pm * BM + wr * 64 + fr, col0 = u.pn * BM + wc * 32 + 8 * fq; bf16_t* xb = (bf16_t*)(ws + xb_off); float* ssq = (float*)(ws + WS_SSQ);
#pragma unroll
        for (int ai = 0; ai < 2; ++ai)
#pragma unroll
            for (int m = 0; m < 4; ++m) { const int r = row0 + ai * HALF + m * 16; float s = 0.f;
#pragma unroll
                for (int bj = 0; bj < 2; ++bj) { const size_t off = (size_t)r * 1024 + col0 + bj * HALF;
                    const f32x4 b0 = *(const f32x4*)(base + off), b1 = *(const f32x4*)(base + off + 4);
                    const f32x4 v0 = b0 + acc[ai][bj][m][0] * alpha, v1 = b1 + acc[ai][bj][m][1] * alpha;
                    *(f32x4*)(out + off) = v0; *(f32x4*)(out + off + 4) = v1; *(u32x4*)(xb + off) = pack8(v0, v1);
                    s += (v0[0] * v0[0] + v0[1] * v0[1]) + (v0[2] * v0[2] + v0[3] * v0[3]) + (v1[0] * v1[0] + v1[1] * v1[1]) + (v1[2] * v1[2] + v1[3] * v1[3]); }
                s += __shfl_xor(s, 16); s += __shfl_xor(s, 32);
                if (fq == 0) ssq[(size_t)r * 16 + u.pn * 4 + wc] = s; }
    }
};
struct EpiMixIn {
    static constexpr bool PERM = true, AFTER_DRAIN = false;
    unsigned char* ws;
    __device__ __forceinline__ void operator()(const f32x4 (&acc)[2][2][4][2], const Unit& u, int wr, int wc, int fr, int fq) const {
        const int row0 = u.pm * BM + wr * 64 + fr, cw = wc * 32 + 8 * fq; const float* ssq = (const float*)(ws + WS_SSQ);
        bf16_t* PR = (bf16_t*)(ws + AR_PR); bf16_t* MQ = (bf16_t*)(ws + AR_MQ); bf16_t* MK = (bf16_t*)(ws + AR_MK); bf16_t* MVT = (bf16_t*)(ws + AR_MVT);
#pragma unroll
        for (int ai = 0; ai < 2; ++ai)
#pragma unroll
            for (int m = 0; m < 4; ++m) { const int r = row0 + ai * HALF + m * 16; const float rs = row_rstd16(ssq, r);
#pragma unroll
                for (int bj = 0; bj < 2; ++bj) { const int c = cw + bj * HALF;
                    f32x4 v0 = acc[ai][bj][m][0] * rs, v1 = acc[ai][bj][m][1] * rs;
                    if (u.pn < 7) *(u32x4*)(PR + (size_t)r * 1792 + u.pn * 256 + c) = pack8(v0, v1);
                    else if (u.pn < 9) { v0 = v0 * MOBA_QSCALE; v1 = v1 * MOBA_QSCALE; *(u32x4*)(MQ + (size_t)r * 512 + (u.pn - 7) * 256 + c) = pack8(v0, v1); }
                    else if (u.pn < 11) *(u32x4*)(MK + (size_t)r * 512 + (u.pn - 9) * 256 + c) = pack8(v0, v1);
                    else { const int cc = (u.pn - 11) * 256 + c, hh = cc >> 6, d = cc & 63, b = r >> 11, t = r & 2047;
                        bf16_t* p = MVT + ((size_t)(b * 8 + hh) * 64 + d) * 2048 + (t & ~15) + pos16(t & 15);
                        const u32x4 w = pack8(v0, v1);
                        p[0] = (bf16_t)(w.x & 0xffffu); p[2048] = (bf16_t)(w.x >> 16); p[2 * 2048] = (bf16_t)(w.y & 0xffffu); p[3 * 2048] = (bf16_t)(w.y >> 16);
                        p[4 * 2048] = (bf16_t)(w.z & 0xffffu); p[5 * 2048] = (bf16_t)(w.z >> 16); p[6 * 2048] = (bf16_t)(w.w & 0xffffu); p[7 * 2048] = (bf16_t)(w.w >> 16); }
                } }
    }
};
struct EpiXQ {
    static constexpr bool PERM = true, AFTER_DRAIN = false;
    unsigned char* ws;
    __device__ __forceinline__ void operator()(const f32x4 (&acc)[2][2][4][2], const Unit& u, int wr, int wc, int fr, int fq) const {
        const int row0 = u.pm * BM + wr * 64 + fr, col0 = u.pn * BM + wc * 32 + 8 * fq; bf16_t* Q = (bf16_t*)(ws + AR_XQ); const float* ssq = (const float*)(ws + WS_SSQ);
#pragma unroll
        for (int ai = 0; ai < 2; ++ai)
#pragma unroll
            for (int m = 0; m < 4; ++m) { const int r = row0 + ai * HALF + m * 16; const float rs = row_rstd16(ssq, r) * XATT_QSCALE;
#pragma unroll
                for (int bj = 0; bj < 2; ++bj) *(u32x4*)(Q + (size_t)r * 1024 + col0 + bj * HALF) = pack8(acc[ai][bj][m][0] * rs, acc[ai][bj][m][1] * rs); }
    }
};
struct EpiKV {
    static constexpr bool PERM = true, AFTER_DRAIN = false;
    unsigned char* ws;
    __device__ __forceinline__ void operator()(const f32x4 (&acc)[2][2][4][2], const Unit& u, int wr, int wc, int fr, int fq) const {
        const int row0 = u.pm * BM + wr * 64 + fr, cw = wc * 32 + 8 * fq; bf16_t* XK = (bf16_t*)(ws + WS_XK); bf16_t* XVT = (bf16_t*)(ws + WS_XVT); const float* memrs = (const float*)(ws + WS_MEMRS);
#pragma unroll
        for (int ai = 0; ai < 2; ++ai)
#pragma unroll
            for (int m = 0; m < 4; ++m) { const int r = row0 + ai * HALF + m * 16; const float rs = memrs[r];
#pragma unroll
                for (int bj = 0; bj < 2; ++bj) { const int c = cw + bj * HALF;
                    const f32x4 v0 = acc[ai][bj][m][0] * rs, v1 = acc[ai][bj][m][1] * rs;
                    if (u.pn < 4) *(u32x4*)(XK + (size_t)r * 1024 + u.pn * 256 + c) = pack8(v0, v1);
                    else { const int hx = u.pn - 4, b = r >> 8, key = r & 255;
                        bf16_t* p = XVT + ((size_t)(b * 4 + hx) * 256 + c) * 256 + (key & ~15) + pos16(key & 15);
                        const u32x4 w = pack8(v0, v1);
                        p[0] = (bf16_t)(w.x & 0xffffu); p[256] = (bf16_t)(w.x >> 16); p[2 * 256] = (bf16_t)(w.y & 0xffffu); p[3 * 256] = (bf16_t)(w.y >> 16);
                        p[4 * 256] = (bf16_t)(w.z & 0xffffu); p[5 * 256] = (bf16_t)(w.z >> 16); p[6 * 256] = (bf16_t)(w.w & 0xffffu); p[7 * 256] = (bf16_t)(w.w >> 16); }
                } }
    }
};

template <class Epi, class Sched, bool ALIGN_EPI = false, bool SP2 = false>
__device__ __forceinline__ void gemm_phase(PG8_LAS unsigned char* lds, const Gemm g, const Sched& S, const Epi& E) {
    int tid_ = threadIdx.x; asm volatile("" : "+v"(tid_));
    const int tid = tid_, wid = __builtin_amdgcn_readfirstlane(tid >> 6), lane = tid & 63, wr = wid >> 2, wc = wid & 3, fr = lane & 15, fq = lane >> 4;
    const int K = g.K, nt = K / BK;
    unsigned voffA[2], voffB[2];
#pragma unroll
    for (int i = 0; i < 2; ++i) { int R, C; stage_rc(tid * 16 + i * 8192, R, C); const int Rb = Epi::PERM ? ((R & ~31) + perm32(R & 31)) : R;
        voffA[i] = (unsigned)(R * K + C) * 2u; voffB[i] = (unsigned)(Rb * K + C) * 2u; }
    const size_t kstep = (size_t)(BK * 2);
    const size_t hstep = (size_t)HALF * K * 2;
    const size_t tstep = 2 * hstep;
    const unsigned ldsw = (unsigned)wid * 1024u;
    const int aoff = lds_byte(wr * 64 + fr, fq * 8), boff = lds_byte(wc * 32 + fr, fq * 8);
#define PG8_SA(b, h) (((b) * 2 + (h)) * HTB)
#define PG8_SB(b, h) ((4 + (b) * 2 + (h)) * HTB)
#define PG8_STAGE(bufoff, gbase, voff) do { _Pragma("unroll") for (int _i = 0; _i < 2; ++_i) \
        __builtin_amdgcn_global_load_lds((const unsigned*)((const char*)(gbase) + (voff)[_i]), (PG8_LAS unsigned*)(lds + (bufoff) + ldsw + _i * 8192), 16, 0, 0); } while (0)
#define PG8_LDA(dst, b, h) do { _Pragma("unroll") for (int m = 0; m < 4; ++m) _Pragma("unroll") for (int k = 0; k < 2; ++k) dst[m][k] = *(const PG8_LAS bf16x8*)(lds + PG8_SA(b, h) + aoff + m * 2048 + k * 1024); } while (0)
#define PG8_LDB(dst, b, h) do { _Pragma("unroll") for (int n = 0; n < 2; ++n) _Pragma("unroll") for (int k = 0; k < 2; ++k) dst[n][k] = *(const PG8_LAS bf16x8*)(lds + PG8_SB(b, h) + boff + n * 2048 + k * 1024); } while (0)
#define PG8_MMA(ai, bj, At, Bt) do { __builtin_amdgcn_s_setprio(1); _Pragma("unroll") for (int m = 0; m < 4; ++m) _Pragma("unroll") for (int n = 0; n < 2; ++n) _Pragma("unroll") for (int k = 0; k < 2; ++k) \
        acc[ai][bj][m][n] = __builtin_amdgcn_mfma_f32_16x16x32_bf16(Bt[n][k], At[m][k], acc[ai][bj][m][n], 0, 0, 0); __builtin_amdgcn_s_setprio(0); } while (0)
#define PG8_WAIT_V(n) asm volatile("s_waitcnt vmcnt(" #n ")" ::: "memory")
#define PG8_WAIT_L(n) asm volatile("s_waitcnt lgkmcnt(" #n ")" ::: "memory")
#define PG8_BAR __builtin_amdgcn_s_barrier()
#define PG8_SCHED __builtin_amdgcn_sched_barrier(0)
    Unit cur, nxt; int ui = 0;
    if (!S.next(0, cur)) return;
    f32x4 acc[2][2][4][2];
#pragma unroll
    for (int a = 0; a < 2; ++a)
#pragma unroll
        for (int b = 0; b < 2; ++b)
#pragma unroll
            for (int m = 0; m < 4; ++m)
#pragma unroll
                for (int n = 0; n < 2; ++n) acc[a][b][m][n] = (f32x4){0.f, 0.f, 0.f, 0.f};
    bf16x8 At[4][2], B0[2][2], B1[2][2];
    const char* cA = (const char*)g.A + (size_t)cur.pm * tstep; const char* cB = (const char*)g.Bt + (size_t)cur.pn * tstep;
    S.a_ready(cur);
    if constexpr (SP2) {
        PG8_STAGE(PG8_SB(0, 0), cB, voffB); PG8_STAGE(PG8_SB(0, 1), cB + hstep, voffB); PG8_STAGE(PG8_SA(0, 0), cA, voffA); PG8_STAGE(PG8_SA(0, 1), cA + hstep, voffA);
        if (wr == 1) PG8_BAR;
        PG8_WAIT_V(2); PG8_BAR;
        PG8_STAGE(PG8_SB(1, 0), cB + kstep, voffB); PG8_STAGE(PG8_SA(1, 0), cA + kstep, voffA); PG8_STAGE(PG8_SB(1, 1), cB + hstep + kstep, voffB);
        PG8_WAIT_V(6); PG8_BAR;
    } else {
        PG8_STAGE(PG8_SB(0, 0), cB, voffB); PG8_STAGE(PG8_SA(0, 0), cA, voffA); PG8_STAGE(PG8_SB(0, 1), cB + hstep, voffB); PG8_STAGE(PG8_SA(0, 1), cA + hstep, voffA);
        if (wr == 1) PG8_BAR;
        PG8_WAIT_V(4); PG8_BAR;
        PG8_STAGE(PG8_SB(1, 0), cB + kstep, voffB); PG8_STAGE(PG8_SA(1, 0), cA + kstep, voffA); PG8_STAGE(PG8_SB(1, 1), cB + hstep + kstep, voffB);
        PG8_WAIT_V(6); PG8_BAR;
    }
    for (;;) {
        const bool has_next = S.next(ui + 1, nxt);
        const char* nA = has_next ? (const char*)g.A + (size_t)nxt.pm * tstep : cA; const char* nB = has_next ? (const char*)g.Bt + (size_t)nxt.pn * tstep : cB;
        for (int t = 0; t < nt; t += 2) {
            const bool last = (t == nt - 2);
            const char* a1 = cA + (size_t)(t + 1) * kstep;
            const char* a2 = last ? nA : cA + (size_t)(t + 2) * kstep; const char* b2 = last ? nB : cB + (size_t)(t + 2) * kstep;
            const char* a3 = a2 + kstep; const char* b3 = b2 + kstep;
            if (last && has_next) S.a_ready(nxt);
            if constexpr (SP2) {
            PG8_LDB(B0, 0, 0); PG8_LDB(B1, 0, 1); PG8_SCHED; PG8_LDA(At, 0, 0); PG8_STAGE(PG8_SA(1, 1), a1 + hstep, voffA);
            PG8_WAIT_V(8); PG8_WAIT_L(0); PG8_BAR; PG8_MMA(0, 0, At, B0); PG8_MMA(0, 1, At, B1); PG8_BAR; PG8_SCHED;
            PG8_LDA(At, 0, 1); PG8_STAGE(PG8_SB(0, 0), b2, voffB); PG8_STAGE(PG8_SB(0, 1), b2 + hstep, voffB); PG8_STAGE(PG8_SA(0, 0), a2, voffA);
            PG8_WAIT_V(8); PG8_WAIT_L(0); PG8_BAR; PG8_MMA(1, 0, At, B0); PG8_MMA(1, 1, At, B1); PG8_BAR; PG8_SCHED;
            PG8_LDB(B0, 1, 0); PG8_LDB(B1, 1, 1); PG8_SCHED; PG8_LDA(At, 1, 0); PG8_STAGE(PG8_SA(0, 1), a2 + hstep, voffA);
            PG8_WAIT_V(8); PG8_WAIT_L(0); PG8_BAR; PG8_MMA(0, 0, At, B0); PG8_MMA(0, 1, At, B1); PG8_BAR; PG8_SCHED;
            PG8_LDA(At, 1, 1); PG8_STAGE(PG8_SB(1, 0), b3, voffB); PG8_STAGE(PG8_SB(1, 1), b3 + hstep, voffB); PG8_STAGE(PG8_SA(1, 0), a3, voffA);
            PG8_WAIT_V(8); PG8_WAIT_L(0); PG8_BAR; PG8_MMA(1, 0, At, B0); PG8_MMA(1, 1, At, B1); PG8_BAR; PG8_SCHED;
            } else {
            PG8_LDB(B0, 0, 0); PG8_SCHED; PG8_LDA(At, 0, 0); PG8_STAGE(PG8_SA(1, 1), a1 + hstep, voffA);
            PG8_WAIT_L(8); PG8_BAR; PG8_WAIT_L(0); PG8_MMA(0, 0, At, B0); PG8_BAR; PG8_SCHED;
            PG8_LDB(B1, 0, 1); PG8_STAGE(PG8_SB(0, 0), b2, voffB);
            PG8_BAR; PG8_WAIT_L(0); PG8_MMA(0, 1, At, B1); PG8_BAR;
            PG8_LDA(At, 0, 1); PG8_STAGE(PG8_SA(0, 0), a2, voffA);
            PG8_BAR; PG8_WAIT_L(0); PG8_MMA(1, 0, At, B0); PG8_BAR; PG8_SCHED;
            PG8_STAGE(PG8_SB(0, 1), b2 + hstep, voffB);
            PG8_WAIT_V(6); PG8_BAR; PG8_MMA(1, 1, At, B1); PG8_BAR;
            PG8_LDB(B0, 1, 0); PG8_SCHED; PG8_LDA(At, 1, 0); PG8_STAGE(PG8_SA(0, 1), a2 + hstep, voffA);
            PG8_WAIT_L(8); PG8_BAR; PG8_WAIT_L(0); PG8_MMA(0, 0, At, B0); PG8_BAR; PG8_SCHED;
            PG8_LDB(B1, 1, 1); PG8_STAGE(PG8_SB(1, 0), b3, voffB);
            PG8_BAR; PG8_WAIT_L(0); PG8_MMA(0, 1, At, B1); PG8_BAR;
            PG8_LDA(At, 1, 1); PG8_STAGE(PG8_SA(1, 0), a3, voffA);
            PG8_BAR; PG8_WAIT_L(0); PG8_MMA(1, 0, At, B0); PG8_BAR; PG8_SCHED;
            PG8_STAGE(PG8_SB(1, 1), b3 + hstep, voffB);
            PG8_WAIT_V(6); PG8_BAR; PG8_MMA(1, 1, At, B1); PG8_BAR;
            }
        }
        if constexpr (ALIGN_EPI) { if (wr == 0) PG8_BAR; }
        if constexpr (!Epi::AFTER_DRAIN) { E(acc, cur, wr, wc, fr, fq); S.done(cur); }
        if (!has_next) break;
#pragma unroll
        for (int a = 0; a < 2; ++a)
#pragma unroll
            for (int b = 0; b < 2; ++b)
#pragma unroll
                for (int m = 0; m < 4; ++m)
#pragma unroll
                    for (int n = 0; n < 2; ++n) acc[a][b][m][n] = (f32x4){0.f, 0.f, 0.f, 0.f};
        cur = nxt; cA = nA; cB = nB; ++ui;
        if constexpr (ALIGN_EPI) { if (wr == 1) PG8_BAR; }
    }
    PG8_WAIT_V(0);
    if constexpr (!ALIGN_EPI) { if (wr == 0) PG8_BAR; }
    PG8_BAR;
    if constexpr (Epi::AFTER_DRAIN) { E.fused(acc, cur, wr, wc, fr, fq, lds, wid, lane); S.done(cur); }
#undef PG8_SA
#undef PG8_SB
#undef PG8_STAGE
#undef PG8_LDA
#undef PG8_LDB
#undef PG8_MMA
#undef PG8_WAIT_V
#undef PG8_WAIT_L
#undef PG8_BAR
#undef PG8_SCHED
}
}

constexpr int NWAVES = 8;
constexpr int RING_BYTES = 131072, LDSCTL_OFF = RING_BYTES, MISC_OFF = LDSCTL_OFF + 320, LDS_BYTES = 147456;
constexpr int SCAN_R = 2, SCAN_NCH = 8;

typedef unsigned short bf16;
typedef unsigned u32x4 __attribute__((ext_vector_type(4)));
typedef unsigned u32x2 __attribute__((ext_vector_type(2)));
typedef float f32x4 __attribute__((ext_vector_type(4)));
typedef float f32x16 __attribute__((ext_vector_type(16)));
typedef short bf16x8 __attribute__((ext_vector_type(8)));
typedef GAS unsigned gu32;
#define RLX_AGENT __ATOMIC_RELAXED, __HIP_MEMORY_SCOPE_AGENT
#define LDS_WAIT() asm volatile("s_waitcnt lgkmcnt(0)" ::: "memory")
#define VM_WAIT() asm volatile("s_waitcnt vmcnt(0)" ::: "memory")
__device__ __forceinline__ float bf2f(unsigned b) { return __uint_as_float(b << 16); }
__device__ __forceinline__ unsigned f2bf(float f) { unsigned u = __builtin_bit_cast(unsigned, f); return (u + 0x7fffu + ((u >> 16) & 1u)) >> 16; }
__device__ __forceinline__ unsigned pk2(float lo, float hi) { return pg8::cvt_pk_bf16(lo, hi); }
__device__ __forceinline__ float wave_sum(float v) {
#pragma unroll
    for (int o = 1; o < 64; o <<= 1) v += __shfl_xor(v, o);
    return v;
}
__device__ __forceinline__ float quad_sum(float x) {
    x += __builtin_bit_cast(float, __builtin_amdgcn_update_dpp(0, __builtin_bit_cast(int, x), 0xB1, 0xF, 0xF, true));
    x += __builtin_bit_cast(float, __builtin_amdgcn_update_dpp(0, __builtin_bit_cast(int, x), 0x4E, 0xF, 0xF, true));
    return x;
}
__device__ __forceinline__ float sigmoidf_(float x) { return __builtin_amdgcn_rcpf(1.0f + __expf(-x)); }
__device__ __forceinline__ int crow(int r, int hi) { return (r & 3) + 8 * (r >> 2) + 4 * hi; }
__device__ __forceinline__ bf16x8 pack_bf16x8(float a0, float a1, float a2, float a3, float a4, float a5, float a6, float a7) {
    u32x4 w; w.x = pk2(a0, a1); w.y = pk2(a2, a3); w.z = pk2(a4, a5); w.w = pk2(a6, a7); return __builtin_bit_cast(bf16x8, w);
}

#define XB_TMO      128
#define XB_XCNT(j)  (256  + 64 * (j))
#define XB_XSUB(j)  (1280 + 64 * (j))
#define XB_XGEN(j)  (2304 + 64 * (j))
#define XB_TOP      3328
#define XB_TOPGEN   3392
#define XCD_BAR_WORDS 3456
#define XB_SPIN_CAP (1u << 18)

__device__ __forceinline__ unsigned xb_ld(unsigned* p)              { return __hip_atomic_load(p, __ATOMIC_RELAXED, __HIP_MEMORY_SCOPE_AGENT); }
__device__ __forceinline__ unsigned xb_add(unsigned* p, unsigned v) { return __hip_atomic_fetch_add(p, v, __ATOMIC_RELAXED, __HIP_MEMORY_SCOPE_AGENT); }
__device__ __forceinline__ unsigned xb_xcc_id() { return (unsigned)__builtin_amdgcn_s_getreg((3 << 11) | 20) & 0xFu; }
#define XB_SPIN(cond, bar) do { unsigned _sp = 0; while (cond) { __builtin_amdgcn_s_sleep(1); \
    if ((++_sp & 255u) == 0u) { if (xb_ld(&(bar)[XB_TMO])) break; if (_sp > XB_SPIN_CAP) { atomicAdd(&(bar)[XB_TMO], 1u); break; } } } } while (0)

struct XcdBarrier {
    unsigned* bar; unsigned x;
    volatile LAS unsigned* st;
};

__device__ __forceinline__ XcdBarrier xcd_barrier_post(unsigned* bar, volatile LAS unsigned* st) {
    XcdBarrier b; b.bar = bar; b.x = xb_xcc_id(); b.st = st;
    if (threadIdx.x == 0) (void)xb_add(&bar[XB_XCNT(b.x)], 1u);
    return b;
}
__device__ __forceinline__ void xcd_barrier_complete(unsigned* bar, unsigned x, unsigned& nloc, unsigned& nx) {
    const unsigned G = gridDim.x * gridDim.y * gridDim.z;
    unsigned sum, cnt, mine, sp = 0u;
    for (;;) {
        sum = 0u; cnt = 0u; mine = 0u;
#pragma unroll
        for (unsigned j = 0; j < 16; ++j) { const unsigned c = xb_ld(&bar[XB_XCNT(j)]); sum += c; cnt += (c > 0u) ? 1u : 0u; mine = (j == x) ? c : mine; }
        if (sum == G) break;
        __builtin_amdgcn_s_sleep(1);
        if ((++sp & 255u) == 0u) { if (xb_ld(&bar[XB_TMO])) break; if (sp > XB_SPIN_CAP) { atomicAdd(&bar[XB_TMO], 1u); break; } }
    }
    nloc = mine > 0u ? mine : 1u; nx = cnt > 0u ? cnt : 1u;
}

__device__ __forceinline__ void xcd_barrier(const XcdBarrier& b) {
    asm volatile("s_waitcnt vmcnt(0)" ::: "memory");
    __syncthreads();
    if (threadIdx.x == 0) {
        unsigned* bar = b.bar;
        __builtin_amdgcn_s_waitcnt(0);
        unsigned nloc = b.st[0], nx = b.st[1];
        if (nloc == 0u) { xcd_barrier_complete(bar, b.x, nloc, nx); b.st[0] = nloc; b.st[1] = nx; }
        const unsigned old = xb_add(&bar[XB_XSUB(b.x)], 1u);
        const unsigned gen = old / nloc;
        if (old + 1u == (gen + 1u) * nloc) {
            __builtin_amdgcn_fence(__ATOMIC_RELEASE, "agent");
            asm volatile("s_waitcnt vmcnt(0)" ::: "memory");
            const unsigned og = xb_add(&bar[XB_TOP], 1u);
            const unsigned tg = og / nx;
            if (og + 1u == (tg + 1u) * nx) xb_add(&bar[XB_TOPGEN], 1u);
            else XB_SPIN(xb_ld(&bar[XB_TOPGEN]) == tg, bar);
            __builtin_amdgcn_fence(__ATOMIC_ACQUIRE, "agent");
            xb_add(&bar[XB_XGEN(b.x)], 1u);
            asm volatile("s_waitcnt vmcnt(0)" ::: "memory");
        } else {
            XB_SPIN(xb_ld(&bar[XB_XGEN(b.x)]) == gen, bar);
            __builtin_amdgcn_fence(__ATOMIC_ACQUIRE, "agent");
            asm volatile("s_waitcnt vmcnt(0)" ::: "memory");
        }
    }
    __syncthreads();
}


struct Args { const float* in[N_IN]; float* out; unsigned char* ws; int ph_lo, ph_hi; };
static_assert(sizeof(Args) == N_IN * 8 + 24, "Args has no padding");
struct Frame {
    LAS unsigned char* lds; volatile LAS unsigned* MISC; gu32* ctl;
    int tid, lane, wave, vcu, G;
    const __attribute__((address_space(4))) struct Args* ka; float* out; unsigned char* ws;
};
#define FIN(i) (F.ka->in[i])
#define WSP(T, off) ((T*)(F.ws + (off)))

__device__ __forceinline__ void ph_init(Frame& F) {
    const int gw = F.vcu * NWAVES + F.wave, NGW = F.G * NWAVES;
    float* bias = WSP(float, WS_BIAS); const float* relb = FIN(I_RELB);
    for (int i = blockIdx.x * 512 + F.tid; i < NH * 2048; i += F.G * 512) { const int h = i >> 11, n = i & 2047; int bkt;
        if (n < 16) bkt = n; else { const float nf = (float)n; const int lg = 16 + (int)(logf(nf / 16.0f) / 4.1588830833596715f * 16.0f); bkt = lg < 31 ? lg : 31; }
        bias[i] = relb[h * 32 + bkt] * LOG2E; }
    const float* mem = FIN(I_MEM); bf16* memb = WSP(bf16, WS_MEMB); float* memrs = WSP(float, WS_MEMRS);
    for (int r = gw; r < MM; r += NGW) { const f32x4* xr = (const f32x4*)(mem + (size_t)r * DM) + F.lane; f32x4 v[4]; float s = 0.f;
#pragma unroll
        for (int j = 0; j < 4; ++j) { v[j] = xr[64 * j]; s += (v[j].x * v[j].x + v[j].y * v[j].y) + (v[j].z * v[j].z + v[j].w * v[j].w); }
        s = wave_sum(s); u32x2* o = (u32x2*)(memb + (size_t)r * DM) + F.lane;
#pragma unroll
        for (int j = 0; j < 4; ++j) { u32x2 w; w.x = pk2(v[j].x, v[j].y); w.y = pk2(v[j].z, v[j].w); o[64 * j] = w; }
        if (F.lane == 0) memrs[r] = __builtin_amdgcn_rsqf(s * (1.0f / DM) + NORM_EPS); }
    const float* x = FIN(I_X); bf16* xb = WSP(bf16, WS_XB); float* ssq = WSP(float, WS_SSQ);
    for (int r = gw; r < M; r += NGW) { const f32x4* xr = (const f32x4*)(x + (size_t)r * DM) + F.lane; f32x4 v[4]; float s = 0.f;
#pragma unroll
        for (int j = 0; j < 4; ++j) { v[j] = xr[64 * j]; s += (v[j].x * v[j].x + v[j].y * v[j].y) + (v[j].z * v[j].z + v[j].w * v[j].w); }
        s = wave_sum(s); u32x2* o = (u32x2*)(xb + (size_t)r * DM) + F.lane;
#pragma unroll
        for (int j = 0; j < 4; ++j) { u32x2 w; w.x = pk2(v[j].x, v[j].y); w.y = pk2(v[j].z, v[j].w); o[64 * j] = w; }
        if (F.lane < 16) ssq[(size_t)r * 16 + F.lane] = F.lane == 0 ? s : 0.f; }
}

__device__ __forceinline__ void conv_item(const float* W, int K, int N, const float* gk, bf16* WT, int item, bool ffn_in, LAS float* scr, int lane) {
    const int nblk = N / 32, kb = item / nblk, nb = item % nblk, k0 = 64 * kb, n0 = 32 * nb;
#pragma unroll 8
    for (int i = 0; i < 32; ++i) { const int kk = 2 * i + (lane >> 5); float w = W[(size_t)(k0 + kk) * N + n0 + (lane & 31)]; if (gk) w *= gk[k0 + kk]; scr[kk * 33 + (lane & 31)] = w; }
    LDS_WAIT(); asm volatile("" ::: "memory");
    int drow0 = n0; if (ffn_in) drow0 = n0 < DFF ? 256 * (n0 / 128) + (n0 % 128) : 256 * ((n0 - DFF) / 128) + 128 + ((n0 - DFF) % 128);
    const int c = lane & 7;
#pragma unroll
    for (int j = 0; j < 4; ++j) { const int n = (lane >> 3) + 8 * j; const LAS float* s = scr + (8 * c) * 33 + n;
        u32x4 o; o.x = pk2(s[0 * 33], s[1 * 33]); o.y = pk2(s[2 * 33], s[3 * 33]); o.z = pk2(s[4 * 33], s[5 * 33]); o.w = pk2(s[6 * 33], s[7 * 33]);
        *(u32x4*)(WT + (size_t)(drow0 + n) * K + k0 + 8 * c) = o; }
    LDS_WAIT(); asm volatile("" ::: "memory");
}
__device__ __forceinline__ void ph_conv(Frame& F, int l) {
    LAS float* scr = (LAS float*)(F.lds + F.wave * 16384);
    const int gw = F.vcu * NWAVES + F.wave, NGW = F.G * NWAVES;
    constexpr int I_FIN = (DM / 64) * (2 * DFF / 32), I_FOUT = (DFF / 64) * (DM / 32), I_MI = (DM / 64) * (DPROJ / 32), I_SQ = (DM / 64) * (DM / 32), I_KV = (DM / 64) * (2 * DM / 32);
    constexpr int NITEMS = 2 * I_FIN + 2 * I_FOUT + I_MI + 3 * I_SQ + I_KV;
    unsigned char* wb = F.ws + WS_W;
    for (int it = gw; it < NITEMS; it += NGW) { int r = it;
        if (r < I_FIN) { conv_item(FIN(I_F1IN) + (size_t)l * DM * 2 * DFF, DM, 2 * DFF, FIN(I_F1G) + l * DM, (bf16*)(wb + W_F1IN), r, true, scr, F.lane); continue; } r -= I_FIN;
        if (r < I_FIN) { conv_item(FIN(I_F2IN) + (size_t)l * DM * 2 * DFF, DM, 2 * DFF, FIN(I_F2G) + l * DM, (bf16*)(wb + W_F2IN), r, true, scr, F.lane); continue; } r -= I_FIN;
        if (r < I_FOUT) { conv_item(FIN(I_F1OUT) + (size_t)l * DFF * DM, DFF, DM, nullptr, (bf16*)(wb + W_F1OUT), r, false, scr, F.lane); continue; } r -= I_FOUT;
        if (r < I_FOUT) { conv_item(FIN(I_F2OUT) + (size_t)l * DFF * DM, DFF, DM, nullptr, (bf16*)(wb + W_F2OUT), r, false, scr, F.lane); continue; } r -= I_FOUT;
        if (r < I_MI) { conv_item(FIN(I_MIXIN) + (size_t)l * DM * DPROJ, DM, DPROJ, FIN(I_MIXG) + l * DM, (bf16*)(wb + W_MIXIN), r, false, scr, F.lane); continue; } r -= I_MI;
        if (r < I_SQ) { conv_item(FIN(I_MIXOUT) + (size_t)l * DM * DM, DM, DM, nullptr, (bf16*)(wb + W_MIXOUT), r, false, scr, F.lane); continue; } r -= I_SQ;
        if (r < I_SQ) { conv_item(FIN(I_WQ) + (size_t)l * DM * DM, DM, DM, FIN(I_XG) + l * DM, (bf16*)(wb + W_WQ), r, false, scr, F.lane); continue; } r -= I_SQ;
        if (r < I_SQ) { conv_item(FIN(I_WO) + (size_t)l * DM * DM, DM, DM, nullptr, (bf16*)(wb + W_WO), r, false, scr, F.lane); continue; } r -= I_SQ;
        conv_item(FIN(I_WKV) + (size_t)l * DM * 2 * DM, DM, 2 * DM, FIN(I_MEMG) + l * DM, (bf16*)(wb + W_WKV), r, false, scr, F.lane);
    }
}

__device__ __forceinline__ void ph_moba(Frame& F) {
    LAS float* kmean = (LAS float*)F.lds;
    LAS float* btab = (LAS float*)(F.lds + 2048);
    const bf16* MQ = WSP(bf16, AR_MQ); const bf16* MK = WSP(bf16, AR_MK); const bf16* MVT = WSP(bf16, AR_MVT); bf16* XB = WSP(bf16, WS_XB); const float* bias = WSP(float, WS_BIAS);
    const int lane = F.lane, r32 = lane & 31, hi = lane >> 5, wave = F.wave;
    for (int u = blockIdx.x; u < 512; u += F.G) {
        const int rnd = u >> 8, iu = u & 255, qsel = iu >> 6, bh = iu & 63, qb = rnd == 0 ? 7 - qsel : qsel, b = bh >> 3, hh = bh & 7;
        __syncthreads();
        { const int n = F.tid >> 6, d = F.tid & 63;
          if (n < qb) { const bf16* kp = MK + (size_t)(b * 2048 + n * 256) * 512 + hh * 64 + d; float s = 0.f;
#pragma unroll 8
              for (int k = 0; k < 256; ++k) s += bf2f(kp[(size_t)k * 512]);
              kmean[n * 64 + d] = s * (1.0f / 256.0f); }
          for (int i2 = F.tid; i2 < 2048; i2 += 512) btab[i2] = bias[hh * 2048 + i2]; }
        __syncthreads();
        const int q0 = qb * 256 + wave * 32; const size_t tok = (size_t)b * 2048 + q0 + r32;
        bf16x8 qf[4];
#pragma unroll
        for (int s = 0; s < 4; ++s) qf[s] = *(const bf16x8*)(MQ + tok * 512 + hh * 64 + 16 * s + 8 * hi);
        float g[7]; unsigned selmask = 0u;
#pragma unroll
        for (int n = 0; n < 7; ++n) { g[n] = -INFINITY;
            if (n < qb) { float p = 0.f;
#pragma unroll
                for (int s = 0; s < 4; ++s) { const f32x4 k0v = *(const LAS f32x4*)(kmean + n * 64 + 16 * s + 8 * hi), k1v = *(const LAS f32x4*)(kmean + n * 64 + 16 * s + 8 * hi + 4);
                    p += bf2f((unsigned short)qf[s][0]) * k0v[0] + bf2f((unsigned short)qf[s][1]) * k0v[1] + bf2f((unsigned short)qf[s][2]) * k0v[2] + bf2f((unsigned short)qf[s][3]) * k0v[3]
                       + bf2f((unsigned short)qf[s][4]) * k1v[0] + bf2f((unsigned short)qf[s][5]) * k1v[1] + bf2f((unsigned short)qf[s][6]) * k1v[2] + bf2f((unsigned short)qf[s][7]) * k1v[3]; }
                p += __shfl_xor(p, 32); g[n] = p; } }
        if (qb <= 3) selmask = (1u << qb) - 1u;
        else {
#pragma unroll
            for (int n = 0; n < 7; ++n) if (n < qb) { int cnt = 0;
#pragma unroll
                for (int n2 = 0; n2 < 7; ++n2) if (n2 != n && n2 < qb) cnt += (g[n2] > g[n] || (g[n2] == g[n] && n2 < n)) ? 1 : 0;
                if (cnt < 3) selmask |= 1u << n; } }
        float mrun = -INFINITY, lrun = 0.f; f32x16 o0, o1;
#pragma unroll
        for (int i = 0; i < 16; ++i) { o0[i] = 0.f; o1[i] = 0.f; }
        const int qpos = q0 + r32;
        const bf16* Kb = MK + (size_t)b * 2048 * 512 + hh * 64 + 8 * hi;
        const bf16* Vb = MVT + ((size_t)(b * 8 + hh) * 64 + r32) * 2048 + 8 * hi;
        for (int blk = 0; blk <= qb; ++blk) {
            const bool own = blk == qb; const bool selme = own || ((selmask >> blk) & 1u);
            if (!own && __ballot(selme) == 0ull) continue;
            const int nt = own ? wave + 1 : 8;
            for (int kt = 0; kt < nt; ++kt) { const int k0 = blk * 256 + kt * 32;
                bf16x8 kf[4], vf[2][2];
#pragma unroll
                for (int s = 0; s < 4; ++s) kf[s] = *(const bf16x8*)(Kb + (size_t)(k0 + r32) * 512 + 16 * s);
#pragma unroll
                for (int dt = 0; dt < 2; ++dt)
#pragma unroll
                    for (int sp = 0; sp < 2; ++sp) vf[dt][sp] = *(const bf16x8*)(Vb + (size_t)dt * 32 * 2048 + k0 + 16 * sp);
                f32x16 sc;
#pragma unroll
                for (int i = 0; i < 16; ++i) sc[i] = 0.f;
#pragma unroll
                for (int s = 0; s < 4; ++s) sc = __builtin_amdgcn_mfma_f32_32x32x16_bf16(kf[s], qf[s], sc, 0, 0, 0);
                float mx = -INFINITY;
#pragma unroll
                for (int r = 0; r < 16; ++r) { const int dist = qpos - (k0 + crow(r, hi)); const bool valid = selme && (!own || dist >= 0);
                    const float v = valid ? sc[r] + btab[dist < 0 ? 0 : dist] : -INFINITY; sc[r] = v; mx = fmaxf(mx, v); }
                mx = fmaxf(mx, __shfl_xor(mx, 32));
                const float mnew = fmaxf(mrun, mx), muse = (mnew == -INFINITY) ? 0.f : mnew;
                const float alpha = __builtin_amdgcn_exp2f(mrun - muse);
                float ps = 0.f;
#pragma unroll
                for (int r = 0; r < 16; ++r) { const float p = __builtin_amdgcn_exp2f(sc[r] - muse); sc[r] = p; ps += p; }
                lrun = lrun * alpha + ps; mrun = mnew;
#pragma unroll
                for (int i = 0; i < 16; ++i) { o0[i] *= alpha; o1[i] *= alpha; }
                const bf16x8 pf0 = pack_bf16x8(sc[0], sc[1], sc[2], sc[3], sc[4], sc[5], sc[6], sc[7]), pf1 = pack_bf16x8(sc[8], sc[9], sc[10], sc[11], sc[12], sc[13], sc[14], sc[15]);
                o0 = __builtin_amdgcn_mfma_f32_32x32x16_bf16(vf[0][0], pf0, o0, 0, 0, 0); o0 = __builtin_amdgcn_mfma_f32_32x32x16_bf16(vf[0][1], pf1, o0, 0, 0, 0);
                o1 = __builtin_amdgcn_mfma_f32_32x32x16_bf16(vf[1][0], pf0, o1, 0, 0, 0); o1 = __builtin_amdgcn_mfma_f32_32x32x16_bf16(vf[1][1], pf1, o1, 0, 0, 0);
            }
        }
        lrun += __shfl_xor(lrun, 32); const float inv = 1.0f / lrun;
        bf16* op = XB + tok * 1024 + 512 + hh * 64 + 4 * hi;
#pragma unroll
        for (int g4 = 0; g4 < 4; ++g4) { u32x2 w0, w1; w0.x = pk2(o0[4 * g4] * inv, o0[4 * g4 + 1] * inv); w0.y = pk2(o0[4 * g4 + 2] * inv, o0[4 * g4 + 3] * inv);
            w1.x = pk2(o1[4 * g4] * inv, o1[4 * g4 + 1] * inv); w1.y = pk2(o1[4 * g4 + 2] * inv, o1[4 * g4 + 3] * inv);
            *(u32x2*)(op + 8 * g4) = w0; *(u32x2*)(op + 32 + 8 * g4) = w1; }
    }
}

__device__ __forceinline__ void ph_xatt(Frame& F) {
    const bf16* XQ = WSP(bf16, AR_XQ); const bf16* XK = WSP(bf16, WS_XK); const bf16* XVT = WSP(bf16, WS_XVT); bf16* XO = WSP(bf16, AR_XO);
    const int lane = F.lane, r32 = lane & 31, hi = lane >> 5, wave = F.wave;
    for (int u = blockIdx.x; u < 256; u += F.G) {
        const int b = u >> 5, hx = (u >> 3) & 3, qt = u & 7;
        const size_t tok = (size_t)b * 2048 + qt * 256 + wave * 32 + r32;
        const bf16* Qp = XQ + tok * 1024 + hx * 256 + 8 * hi;
        const bf16* Kb = XK + (size_t)(b * 256 + r32) * 1024 + hx * 256 + 8 * hi;
        const bf16* Vb = XVT + ((size_t)(b * 4 + hx) * 256 + r32) * 256 + 8 * hi;
        float mrun = -INFINITY, lrun = 0.f; f32x16 o[8];
#pragma unroll
        for (int dt = 0; dt < 8; ++dt)
#pragma unroll
            for (int i = 0; i < 16; ++i) o[dt][i] = 0.f;
        for (int kt = 0; kt < 8; ++kt) { const int k0 = kt * 32;
            f32x16 sc;
#pragma unroll
            for (int i = 0; i < 16; ++i) sc[i] = 0.f;
#pragma unroll
            for (int s = 0; s < 16; ++s) { const bf16x8 kf = *(const bf16x8*)(Kb + (size_t)k0 * 1024 + 16 * s), qf = *(const bf16x8*)(Qp + 16 * s);
                sc = __builtin_amdgcn_mfma_f32_32x32x16_bf16(kf, qf, sc, 0, 0, 0); }
            float mx = sc[0];
#pragma unroll
            for (int r = 1; r < 16; ++r) mx = fmaxf(mx, sc[r]);
            mx = fmaxf(mx, __shfl_xor(mx, 32));
            const float mnew = fmaxf(mrun, mx), alpha = __builtin_amdgcn_exp2f(mrun - mnew);
            float ps = 0.f;
#pragma unroll
            for (int r = 0; r < 16; ++r) { const float p = __builtin_amdgcn_exp2f(sc[r] - mnew); sc[r] = p; ps += p; }
            lrun = lrun * alpha + ps; mrun = mnew;
            const bf16x8 pf0 = pack_bf16x8(sc[0], sc[1], sc[2], sc[3], sc[4], sc[5], sc[6], sc[7]), pf1 = pack_bf16x8(sc[8], sc[9], sc[10], sc[11], sc[12], sc[13], sc[14], sc[15]);
#pragma unroll
            for (int dt = 0; dt < 8; ++dt) {
#pragma unroll
                for (int i = 0; i < 16; ++i) o[dt][i] *= alpha;
                const bf16x8 v0 = *(const bf16x8*)(Vb + (size_t)dt * 32 * 256 + k0), v1 = *(const bf16x8*)(Vb + (size_t)dt * 32 * 256 + k0 + 16);
                o[dt] = __builtin_amdgcn_mfma_f32_32x32x16_bf16(v0, pf0, o[dt], 0, 0, 0); o[dt] = __builtin_amdgcn_mfma_f32_32x32x16_bf16(v1, pf1, o[dt], 0, 0, 0); }
        }
        lrun += __shfl_xor(lrun, 32); const float inv = 1.0f / lrun;
        bf16* op = XO + tok * 1024 + hx * 256 + 4 * hi;
#pragma unroll
        for (int dt = 0; dt < 8; ++dt)
#pragma unroll
            for (int g4 = 0; g4 < 4; ++g4) { u32x2 w; w.x = pk2(o[dt][4 * g4] * inv, o[dt][4 * g4 + 1] * inv); w.y = pk2(o[dt][4 * g4 + 2] * inv, o[dt][4 * g4 + 3] * inv);
                *(u32x2*)(op + 32 * dt + 8 * g4) = w; }
    }
}

__device__ __forceinline__ void ph_prep(Frame& F, int l) {
    LAS float* lat = (LAS float*)F.lds;
    const bf16* PR = WSP(bf16, AR_PR); bf16* SCANIN = WSP(bf16, AR_SCANIN); bf16* XB = WSP(bf16, WS_XB); float* BONUS = WSP(float, WS_BONUS);
    const int c = F.tid, h = F.wave, j = F.lane;
    const float* mu = FIN(I_MU) + l * RPROJ; const float* wup = FIN(I_WUP) + (size_t)l * 64 * RW; const float* aup = FIN(I_AUP) + (size_t)l * 64 * RW; const float* gup = FIN(I_GUP) + (size_t)l * 128 * RW;
    const float mu_r = mu[c], mu_k = mu[512 + c], mu_v = mu[1024 + c], w0c = FIN(I_W0)[l * RW + c], a0c = FIN(I_A0)[l * RW + c], kkc = FIN(I_KK)[l * RW + c], kac = FIN(I_KA)[l * RW + c], rkc = FIN(I_RK)[l * RW + c];
    for (int tile = blockIdx.x; tile < M / 16; tile += F.G) { const int t0 = tile * 16;
        __syncthreads();
        { const int tt = F.tid >> 5, l8 = (F.tid & 31) * 8, t = t0 + tt;
          const u32x4 cur = *(const u32x4*)(PR + (size_t)t * RPROJ + 1536 + l8); u32x4 prv = {0u, 0u, 0u, 0u}; if (t & 2047) prv = *(const u32x4*)(PR + (size_t)(t - 1) * RPROJ + 1536 + l8);
          const f32x4 m0 = *(const f32x4*)(mu + 1536 + l8), m1 = *(const f32x4*)(mu + 1536 + l8 + 4);
          float xv[8];
#pragma unroll
          for (int i = 0; i < 4; ++i) { const unsigned cw = cur[i], pw = prv[i]; const float p0 = bf2f(cw & 0xffffu), p1 = bf2f(cw >> 16), q0 = bf2f(pw & 0xffffu), q1 = bf2f(pw >> 16);
              const float ma = i < 2 ? m0[2 * i] : m1[2 * i - 4], mb = i < 2 ? m0[2 * i + 1] : m1[2 * i - 3];
              xv[2 * i] = p0 + (q0 - p0) * ma; xv[2 * i + 1] = p1 + (q1 - p1) * mb; }
#pragma unroll
          for (int i = 0; i < 8; ++i) { if (l8 < 64) xv[i] = tanhf(xv[i]); else if (l8 >= 128) xv[i] = sigmoidf_(xv[i]); }
          *(LAS f32x4*)(lat + tt * 256 + l8) = (f32x4){xv[0], xv[1], xv[2], xv[3]}; *(LAS f32x4*)(lat + tt * 256 + l8 + 4) = (f32x4){xv[4], xv[5], xv[6], xv[7]}; }
        __syncthreads();
        float aw[16], aa[16], ag[16];
#pragma unroll
        for (int tt = 0; tt < 16; ++tt) { aw[tt] = 0.f; aa[tt] = 0.f; ag[tt] = 0.f; }
        for (int i4 = 0; i4 < 16; ++i4) { float wu[4], au[4];
#pragma unroll
            for (int q = 0; q < 4; ++q) { wu[q] = wup[(size_t)(4 * i4 + q) * RW + c]; au[q] = aup[(size_t)(4 * i4 + q) * RW + c]; }
#pragma unroll
            for (int tt = 0; tt < 16; ++tt) { const f32x4 lw = *(const LAS f32x4*)(lat + tt * 256 + 4 * i4), la = *(const LAS f32x4*)(lat + tt * 256 + 64 + 4 * i4);
                aw[tt] += lw[0] * wu[0] + lw[1] * wu[1] + lw[2] * wu[2] + lw[3] * wu[3]; aa[tt] += la[0] * au[0] + la[1] * au[1] + la[2] * au[2] + la[3] * au[3]; } }
        for (int i4 = 0; i4 < 32; ++i4) { float gu[4];
#pragma unroll
            for (int q = 0; q < 4; ++q) gu[q] = gup[(size_t)(4 * i4 + q) * RW + c];
#pragma unroll
            for (int tt = 0; tt < 16; ++tt) { const f32x4 lg = *(const LAS f32x4*)(lat + tt * 256 + 128 + 4 * i4); ag[tt] += lg[0] * gu[0] + lg[1] * gu[1] + lg[2] * gu[2] + lg[3] * gu[3]; } }
#pragma unroll
        for (int tt = 0; tt < 16; ++tt) { const int t = t0 + tt, bb = t >> 11, tp = t & 2047; const bf16* pc = PR + (size_t)t * RPROJ;
            float r = bf2f(pc[c]), k = bf2f(pc[512 + c]), v = bf2f(pc[1024 + c]), rp = 0.f, kp = 0.f, vp = 0.f;
            if (tp != 0) { rp = bf2f(pc[c - RPROJ]); kp = bf2f(pc[512 + c - RPROJ]); vp = bf2f(pc[1024 + c - RPROJ]); }
            r += (rp - r) * mu_r; k += (kp - k) * mu_k; v += (vp - v) * mu_v;
            const float wv = w0c + aw[tt], xs = -wv, sp = xs > 20.f ? xs : log1pf(__expf(xs)), wlog = -sp - 0.5f, ld = -__expf(wlog);
            const float a = sigmoidf_(a0c + aa[tt]);
            const float kk = k * kkc, kt = k * (1.0f + (a - 1.0f) * kac);
            const float n2 = wave_sum(kk * kk), kkn = kk / fmaxf(sqrtf(n2), 1e-12f);
            const float bon = wave_sum(r * kt * rkc); if (j == 0) BONUS[(size_t)t * 8 + h] = bon;
            bf16* so = SCANIN + ((size_t)(bb * 8 + h) * 2048 + tp) * 384 + j;
            so[0] = (bf16)f2bf(-kkn); so[64] = (bf16)f2bf(ld); so[128] = (bf16)f2bf(kkn * a); so[192] = (bf16)f2bf(kt); so[256] = (bf16)f2bf(r); so[320] = (bf16)f2bf(v);
            XB[(size_t)t * 1024 + c] = (bf16)f2bf(ag[tt]); }
    }
}

template <int R, int NCH, bool KINDP>
__device__ __forceinline__ void scan_stream(Frame& F, LAS float* ring, int bh, int ch, int rg, int lis) {
    typedef float f32x2 __attribute__((ext_vector_type(2)));
    constexpr int CLEN = SEQ / NCH, NHALF = CLEN / 8;
    const int lane = F.lane, js = lane & 3, q = lane >> 2, row0 = rg * 16 * R + q * R, tbase = ch * CLEN;
    const bf16* src = WSP(bf16, AR_SCANIN) + ((size_t)bh * 2048 + tbase) * 384;
    float* YL = WSP(float, AR_YLOC) + ((size_t)bh * 2048 + tbase) * 64; bf16* ZZ = WSP(bf16, AR_Z) + ((size_t)bh * 2048 + tbase) * 64;
    f32x2 S[R][8];
#pragma unroll
    for (int rr = 0; rr < R; ++rr)
#pragma unroll
        for (int k = 0; k < 8; ++k) { S[rr][k].x = (KINDP && (row0 + rr) == 16 * js + 2 * k) ? 1.f : 0.f; S[rr][k].y = (KINDP && (row0 + rr) == 16 * js + 2 * k + 1) ? 1.f : 0.f; }
    u32x4 pre[2];
#pragma unroll
    for (int k = 0; k < 2; ++k) { const int ci = lis + k * 256; if (ci < 384) pre[k] = *(const u32x4*)(src + (size_t)ci * 8); }
#pragma unroll
    for (int k = 0; k < 2; ++k) { const int ci = lis + k * 256; if (ci < 384) { const bool isld = ((ci % 48) >> 3) == 1; float f[8];
#pragma unroll
            for (int i = 0; i < 4; ++i) { f[2 * i] = bf2f(pre[k][i] & 0xffffu); f[2 * i + 1] = bf2f(pre[k][i] >> 16); }
            if (isld) {
#pragma unroll
                for (int i = 0; i < 8; ++i) f[i] = __expf(f[i]); }
            *(LAS f32x4*)(ring + ci * 8) = (f32x4){f[0], f[1], f[2], f[3]}; *(LAS f32x4*)(ring + ci * 8 + 4) = (f32x4){f[4], f[5], f[6], f[7]}; } }
    __syncthreads();
    for (int hf = 0; hf < NHALF; ++hf) {
        const bool more = hf + 1 < NHALF;
        if (more) {
#pragma unroll
            for (int k = 0; k < 2; ++k) { const int ci = lis + k * 256; if (ci < 384) pre[k] = *(const u32x4*)(src + (size_t)(hf + 1) * 3072 + (size_t)ci * 8); } }
#pragma unroll 2
        for (int st = 0; st < 8; ++st) {
            const LAS float* sp = ring + ((hf & 1) * 8 + st) * 384 + 16 * js;
            f32x2 nn[8], ww[8], bb[8], kk[8], rr2[8];
#pragma unroll
            for (int i = 0; i < 4; ++i) { const f32x4 a = *(const LAS f32x4*)(sp + 4 * i); nn[2 * i] = (f32x2){a[0], a[1]}; nn[2 * i + 1] = (f32x2){a[2], a[3]}; }
#pragma unroll
            for (int i = 0; i < 4; ++i) { const f32x4 a = *(const LAS f32x4*)(sp + 64 + 4 * i); ww[2 * i] = (f32x2){a[0], a[1]}; ww[2 * i + 1] = (f32x2){a[2], a[3]}; }
#pragma unroll
            for (int i = 0; i < 4; ++i) { const f32x4 a = *(const LAS f32x4*)(sp + 128 + 4 * i); bb[2 * i] = (f32x2){a[0], a[1]}; bb[2 * i + 1] = (f32x2){a[2], a[3]}; }
            if (!KINDP) {
#pragma unroll
                for (int i = 0; i < 4; ++i) { const f32x4 a = *(const LAS f32x4*)(sp + 192 + 4 * i); kk[2 * i] = (f32x2){a[0], a[1]}; kk[2 * i + 1] = (f32x2){a[2], a[3]}; } }
#pragma unroll
            for (int i = 0; i < 4; ++i) { const f32x4 a = *(const LAS f32x4*)(sp + 256 + 4 * i); rr2[2 * i] = (f32x2){a[0], a[1]}; rr2[2 * i + 1] = (f32x2){a[2], a[3]}; }
            float vv[R];
            if (!KINDP) {
#pragma unroll
                for (int rr = 0; rr < R; ++rr) vv[rr] = ring[((hf & 1) * 8 + st) * 384 + 320 + row0 + rr]; }
            float sa[R];
#pragma unroll
            for (int rr = 0; rr < R; ++rr) { f32x2 p0 = S[rr][0] * nn[0], p1 = S[rr][1] * nn[1];
#pragma unroll
                for (int k = 2; k < 8; k += 2) { p0 = S[rr][k] * nn[k] + p0; p1 = S[rr][k + 1] * nn[k + 1] + p1; }
                p0 = p0 + p1; sa[rr] = quad_sum(p0.x + p0.y); }
            float y[R];
#pragma unroll
            for (int rr = 0; rr < R; ++rr) { const f32x2 sa2 = (f32x2){sa[rr], sa[rr]}; f32x2 p0 = (f32x2){0.f, 0.f}, p1 = (f32x2){0.f, 0.f};
#pragma unroll
                for (int k = 0; k < 8; k += 2) {
                    f32x2 t0 = S[rr][k] * ww[k], t1 = S[rr][k + 1] * ww[k + 1];
                    t0 = sa2 * bb[k] + t0; t1 = sa2 * bb[k + 1] + t1;
                    if (!KINDP) { const f32x2 v2 = (f32x2){vv[rr], vv[rr]}; t0 = v2 * kk[k] + t0; t1 = v2 * kk[k + 1] + t1; }
                    S[rr][k] = t0; S[rr][k + 1] = t1; p0 = t0 * rr2[k] + p0; p1 = t1 * rr2[k + 1] + p1; }
                p0 = p0 + p1; y[rr] = quad_sum(p0.x + p0.y); }
            if (js == 0) { const int t = hf * 8 + st;
                if (R == 2) { if (KINDP) *(unsigned*)(ZZ + (size_t)t * 64 + row0) = pk2(y[0], y[R - 1]); else *(f32x2*)(YL + (size_t)t * 64 + row0) = (f32x2){y[0], y[R - 1]}; }
                else {
#pragma unroll
                    for (int rr = 0; rr < R; ++rr) { if (KINDP) ZZ[(size_t)t * 64 + row0 + rr] = (bf16)f2bf(y[rr]); else YL[(size_t)t * 64 + row0 + rr] = y[rr]; } } }
        }
        if (more) {
#pragma unroll
            for (int k = 0; k < 2; ++k) { const int ci = lis + k * 256; if (ci < 384) { const bool isld = ((ci % 48) >> 3) == 1; float f[8];
#pragma unroll
                    for (int i = 0; i < 4; ++i) { f[2 * i] = bf2f(pre[k][i] & 0xffffu); f[2 * i + 1] = bf2f(pre[k][i] >> 16); }
                    if (isld) {
#pragma unroll
                        for (int i = 0; i < 8; ++i) f[i] = __expf(f[i]); }
                    LAS float* dst = ring + (((hf + 1) & 1) * 8) * 384 + ci * 8;
                    *(LAS f32x4*)(dst) = (f32x4){f[0], f[1], f[2], f[3]}; *(LAS f32x4*)(dst + 4) = (f32x4){f[4], f[5], f[6], f[7]}; } } }
        __syncthreads();
    }
    if (NCH > 1) {
        float* st = WSP(float, AR_STATE) + ((size_t)(bh * NCH + ch) * 2 + (KINDP ? 0 : 1)) * 4096;
#pragma unroll
        for (int rr = 0; rr < R; ++rr)
#pragma unroll
            for (int i = 0; i < 4; ++i) *(f32x4*)(st + (size_t)(row0 + rr) * 64 + 16 * js + 4 * i) = (f32x4){S[rr][2 * i].x, S[rr][2 * i].y, S[rr][2 * i + 1].x, S[rr][2 * i + 1].y};
    }
}
template <int R, int NCH>
__device__ __forceinline__ void ph_scan(Frame& F) {
    constexpr int KINDS = NCH > 1 ? 2 : 1, RG = 4 / R, WPS = KINDS * RG, SPW = NWAVES / WPS, NSTREAM = BATCH * NH * NCH;
    static_assert(WPS == 4, "staging assumes 4 waves per stream");
    const int sl = F.wave / WPS, role = F.wave % WPS, kind = role / RG, rg = role % RG, lis = role * 64 + F.lane;
    LAS float* ring = (LAS float*)F.lds + sl * (16 * 384);
    for (int it = blockIdx.x; it * SPW < NSTREAM; it += F.G) {
        const int sid = it * SPW + sl, bh = sid / NCH, ch = sid % NCH;
        __syncthreads();
        if (kind == 0) scan_stream<R, NCH, false>(F, ring, bh, ch, rg, lis); else scan_stream<R, NCH, true>(F, ring, bh, ch, rg, lis);
    }
}

template <int NCH>
__device__ __forceinline__ void ph_fix(Frame& F) {
    typedef float f32x2 __attribute__((ext_vector_type(2)));
    LAS float* cur = (LAS float*)F.lds;
    for (int u = blockIdx.x; u < 256; u += F.G) { const int bh = u >> 2, rgx = u & 3, i = F.tid >> 5, j2 = (F.tid & 31) * 2, row = rgx * 16 + i;
        float* base = WSP(float, AR_STATE) + (size_t)bh * NCH * 2 * 4096;
        __syncthreads();
        { const f32x2 v = *(const f32x2*)(base + 4096 + row * 64 + j2); cur[i * 64 + j2] = v.x; cur[i * 64 + j2 + 1] = v.y; }
        __syncthreads();
        for (int c = 1; c < NCH - 1; ++c) { const float* P = base + (size_t)(c * 2) * 4096; float* SL = base + (size_t)(c * 2 + 1) * 4096;
            f32x2 acc = *(const f32x2*)(SL + row * 64 + j2);
#pragma unroll
            for (int ii = 0; ii < 64; ++ii) { const float sv = cur[i * 64 + ii]; const f32x2 p = *(const f32x2*)(P + ii * 64 + j2); acc.x += sv * p.x; acc.y += sv * p.y; }
            __syncthreads();
            cur[i * 64 + j2] = acc.x; cur[i * 64 + j2 + 1] = acc.y; *(f32x2*)(SL + row * 64 + j2) = acc;
            __syncthreads(); }
    }
}

template <int NCH>
__device__ __forceinline__ void ph_post(Frame& F, int l) {
    constexpr int CLEN = SEQ / NCH;
    const float* YL = WSP(float, AR_YLOC); const bf16* SCANIN = WSP(bf16, AR_SCANIN); bf16* XB = WSP(bf16, WS_XB); const float* BONUS = WSP(float, WS_BONUS); const bf16* ZZ = WSP(bf16, AR_Z);
    LAS float* zt = (LAS float*)F.lds;
    const int c = F.tid, h = F.wave, j = F.lane; const float lng = FIN(I_LNG)[l * RW + c], lnb = FIN(I_LNB)[l * RW + c];
    for (int grp = blockIdx.x; grp < M / 64; grp += F.G) { const int t0g = grp * 64, bb = t0g >> 11, ch = (t0g & 2047) / CLEN, bh = bb * 8 + h; const bool corr = NCH > 1 && ch > 0;
        float st[64];
        if (corr) { const float* sp = WSP(float, AR_STATE) + ((size_t)(bh * NCH + ch - 1) * 2 + 1) * 4096 + j * 64;
#pragma unroll
            for (int i4 = 0; i4 < 16; ++i4) { const f32x4 v = *(const f32x4*)(sp + 4 * i4); st[4 * i4] = v[0]; st[4 * i4 + 1] = v[1]; st[4 * i4 + 2] = v[2]; st[4 * i4 + 3] = v[3]; } }
        for (int ti = 0; ti < 4; ++ti) { const int t0 = t0g + 16 * ti;
            if (corr) { __syncthreads();
#pragma unroll 4
                for (int tt = 0; tt < 16; ++tt) zt[tt * 512 + c] = bf2f(ZZ[((size_t)bh * 2048 + ((t0 + tt) & 2047)) * 64 + j]);
                __syncthreads(); }
#pragma unroll 2
            for (int tt = 0; tt < 16; ++tt) { const int t = t0 + tt, tp = t & 2047;
                float y = YL[((size_t)bh * 2048 + tp) * 64 + j];
                if (corr) { const LAS float* zp = zt + tt * 512 + h * 64; float p0 = 0.f, p1 = 0.f, p2 = 0.f, p3 = 0.f;
#pragma unroll
                    for (int j4 = 0; j4 < 16; ++j4) { const f32x4 zz = *(const LAS f32x4*)(zp + 4 * j4); p0 += st[4 * j4] * zz[0]; p1 += st[4 * j4 + 1] * zz[1]; p2 += st[4 * j4 + 2] * zz[2]; p3 += st[4 * j4 + 3] * zz[3]; }
                    y += (p0 + p1) + (p2 + p3); }
                const float mean = wave_sum(y) * (1.0f / 64.0f), d = y - mean, var = wave_sum(d * d) * (1.0f / 64.0f);
                const float yn = d * __builtin_amdgcn_rsqf(var + LNX_EPS) * lng + lnb;
                const float v = bf2f(SCANIN[((size_t)bh * 2048 + tp) * 384 + 320 + j]), bon = BONUS[(size_t)t * 8 + h], g = bf2f(XB[(size_t)t * 1024 + c]);
                XB[(size_t)t * 1024 + c] = (bf16)f2bf((yn + bon * v) * g); }
        }
    }
}

__device__ __forceinline__ void ph_final(Frame& F) {
    const int gw = F.vcu * NWAVES + F.wave, NGW = F.G * NWAVES; const float* ssq = WSP(float, WS_SSQ); const float* g = FIN(I_FING);
    f32x4 gv[4];
#pragma unroll
    for (int j = 0; j < 4; ++j) gv[j] = ((const f32x4*)g)[F.lane + 64 * j];
    for (int r = gw; r < M; r += NGW) { const float rs = pg8::row_rstd16(ssq, r); f32x4* xr = (f32x4*)(F.out + (size_t)r * DM) + F.lane;
#pragma unroll
        for (int j = 0; j < 4; ++j) { const f32x4 v = xr[64 * j]; xr[64 * j] = v * rs * gv[j]; } }
}

constexpr int PH_INIT = 0, PH_PER_LAYER = 16, PH_FINAL = 1 + DEPTH * PH_PER_LAYER, N_PHASES = PH_FINAL + 1;
enum { K_CONV = 0, K_KV, K_F1UP, K_F1DN, K_MIXIN, K_MOBA, K_PREP, K_SCAN, K_FIX, K_POST, K_MIXOUT, K_XQ, K_XATT, K_XO, K_F2UP, K_F2DN };

__global__ void __launch_bounds__(NWAVES * 64, 2) fwd(Args args) {
    extern __shared__ __attribute__((aligned(16))) unsigned char lds[];
    Frame F;
    F.lds = (LAS unsigned char*)lds; F.MISC = (volatile LAS unsigned*)(F.lds + MISC_OFF);
    F.tid = threadIdx.x; F.lane = F.tid & 63; F.wave = __builtin_amdgcn_readfirstlane(F.tid >> 6);
    F.G = gridDim.x; { const int bx = blockIdx.x; F.vcu = (F.G % 8 == 0) ? (bx % 8) * (F.G / 8) + bx / 8 : bx; }
    F.out = args.out; F.ws = args.ws; F.ctl = (gu32*)(args.ws + WS_CTL);
    F.ka = (const __attribute__((address_space(4))) Args*)(uintptr_t)__builtin_amdgcn_kernarg_segment_ptr();
    for (int u = F.tid; u < (LDS_BYTES - LDSCTL_OFF) / 4; u += NWAVES * 64) ((LAS unsigned*)(F.lds + LDSCTL_OFF))[u] = 0u;
    __syncthreads();
    const bool multi = args.ph_hi - args.ph_lo > 1;
    XcdBarrier bar; bar.bar = (unsigned*)(F.ctl + 4096); bar.x = 0; bar.st = nullptr;
    if (multi) bar = xcd_barrier_post((unsigned*)(F.ctl + 4096), F.MISC + 8);
#ifndef REP_AT
#define REP_AT 1000
#endif
    for (int pi = args.ph_lo; pi < args.ph_hi + (REP_AT < 1000 ? 1 : 0); ++pi) { const int ph = pi - (pi > REP_AT ? 1 : 0);
        { uintptr_t kp = (uintptr_t)__builtin_amdgcn_kernarg_segment_ptr(); asm volatile("" : "+s"(kp)); F.ka = (const __attribute__((address_space(4))) Args*)kp; }
        { int t_ = threadIdx.x; asm volatile("" : "+v"(t_)); F.tid = t_; F.lane = t_ & 63; F.wave = __builtin_amdgcn_readfirstlane(t_ >> 6); }
        unsigned char* wb = F.ws + WS_W;
        if (ph == PH_INIT) ph_init(F);
        else if (ph == PH_FINAL) ph_final(F);
        else { const int l = (ph - 1) / PH_PER_LAYER, k = (ph - 1) % PH_PER_LAYER;
            const float* xin = (l == 0) ? FIN(I_X) : (const float*)F.out;
            switch (k) {
            case K_CONV: ph_conv(F, l); break;
            case K_KV: { pg8::Gemm g{WSP(bf16, WS_MEMB), (const bf16*)(wb + W_WKV), MM, 2 * DM, DM}; pg8::StaticOrder S; S.init(MM, 2 * DM, F.G, (int)blockIdx.x);
                pg8::EpiKV E{F.ws}; pg8::gemm_phase<pg8::EpiKV, pg8::StaticOrder, true, true>(F.lds, g, S, E); } break;
            case K_F1UP: case K_F2UP: { pg8::Gemm g{WSP(bf16, WS_XB), (const bf16*)(wb + (k == K_F1UP ? W_F1IN : W_F2IN)), M, 2 * DFF, DM}; pg8::StaticOrder S; S.init(M, 2 * DFF, F.G, (int)blockIdx.x);
                pg8::EpiSwiGLU E{F.ws}; pg8::gemm_phase<pg8::EpiSwiGLU, pg8::StaticOrder, true, true>(F.lds, g, S, E); } break;
            case K_F1DN: case K_F2DN: { pg8::Gemm g{WSP(bf16, AR_H), (const bf16*)(wb + (k == K_F1DN ? W_F1OUT : W_F2OUT)), M, DM, DFF}; pg8::StaticOrder S; S.init(M, DM, F.G, (int)blockIdx.x);
                pg8::EpiResid E{k == K_F1DN ? xin : (const float*)F.out, F.out, F.ws, WS_XB, 0.5f}; pg8::gemm_phase<pg8::EpiResid, pg8::StaticOrder, true, true>(F.lds, g, S, E); } break;
            case K_MIXIN: { pg8::Gemm g{WSP(bf16, WS_XB), (const bf16*)(wb + W_MIXIN), M, DPROJ, DM}; pg8::StaticOrder S; S.init(M, DPROJ, F.G, (int)blockIdx.x);
                pg8::EpiMixIn E{F.ws}; pg8::gemm_phase<pg8::EpiMixIn, pg8::StaticOrder, true, true>(F.lds, g, S, E); } break;
            case K_MOBA: ph_moba(F); break;
            case K_PREP: ph_prep(F, l); break;
            case K_SCAN: ph_scan<SCAN_R, SCAN_NCH>(F); break;
            case K_FIX: if (SCAN_NCH > 1) ph_fix<SCAN_NCH>(F); break;
            case K_POST: ph_post<SCAN_NCH>(F, l); break;
            case K_MIXOUT: { pg8::Gemm g{WSP(bf16, WS_XB), (const bf16*)(wb + W_MIXOUT), M, DM, DM}; pg8::StaticOrder S; S.init(M, DM, F.G, (int)blockIdx.x);
                pg8::EpiResid E{F.out, F.out, F.ws, AR_XB2, 1.0f}; pg8::gemm_phase<pg8::EpiResid, pg8::StaticOrder, true, true>(F.lds, g, S, E); } break;
            case K_XQ: { pg8::Gemm g{WSP(bf16, AR_XB2), (const bf16*)(wb + W_WQ), M, DM, DM}; pg8::StaticOrder S; S.init(M, DM, F.G, (int)blockIdx.x);
                pg8::EpiXQ E{F.ws}; pg8::gemm_phase<pg8::EpiXQ, pg8::StaticOrder, true, true>(F.lds, g, S, E); } break;
            case K_XATT: ph_xatt(F); break;
            case K_XO: { pg8::Gemm g{WSP(bf16, AR_XO), (const bf16*)(wb + W_WO), M, DM, DM}; pg8::StaticOrder S; S.init(M, DM, F.G, (int)blockIdx.x);
                pg8::EpiResid E{F.out, F.out, F.ws, WS_XB, 1.0f}; pg8::gemm_phase<pg8::EpiResid, pg8::StaticOrder, true, true>(F.lds, g, S, E); } break;
            default: break;
            }
        }
        if (pi + 1 < args.ph_hi + (REP_AT < 1000 ? 1 : 0)) {
            const bool noop = (ph != PH_INIT && ph != PH_FINAL && ((ph - 1) % PH_PER_LAYER) == K_FIX && SCAN_NCH == 1);
            if (!noop) { if (ph == PH_INIT) cooperative_groups::this_grid().sync(); else xcd_barrier(bar); }
        }
    }
}

extern "C" void kernel_launch(void* const* d_in, const int* in_sizes, int n_in, void* d_out, int out_size, void* d_ws, size_t ws_size, hipStream_t stream) {
    static int grid = 0;
    if (grid == 0) {
        if (n_in != N_IN || in_sizes[0] != M * DM || out_size != M * DM || ws_size < WS_END) { fprintf(stderr, "kernel_launch: unexpected problem (n_in %d, in0 %d, out %d, ws %zu < %zu); nothing launched\n", n_in, n_in > 0 ? in_sizes[0] : -1, out_size, ws_size, (size_t)WS_END); grid = -1; return; }
        int dev = 0, cus = 0;
        if (hipGetDevice(&dev) != hipSuccess || hipDeviceGetAttribute(&cus, hipDeviceAttributeMultiprocessorCount, dev) != hipSuccess) { grid = -1; return; }
        if (hipFuncSetAttribute((const void*)fwd, hipFuncAttributeMaxDynamicSharedMemorySize, LDS_BYTES) != hipSuccess) { fprintf(stderr, "kernel_launch: hipFuncSetAttribute failed\n"); grid = -1; return; }
        int per_cu = 0;
        if (hipOccupancyMaxActiveBlocksPerMultiprocessor(&per_cu, (const void*)fwd, NWAVES * 64, LDS_BYTES) != hipSuccess || per_cu < 1) { fprintf(stderr, "kernel_launch: occupancy query reports %d workgroups per CU; nothing launched\n", per_cu); grid = -1; return; }
        grid = cus;
    }
    if (grid < 0) return;
    (void)hipMemsetAsync((char*)d_ws + WS_CTL, 0, CTL_ZERO_BYTES, stream);
    Args a{};
    for (int i = 0; i < N_IN; ++i) a.in[i] = (const float*)d_in[i];
    a.out = (float*)d_out; a.ws = (unsigned char*)d_ws;
    a.ph_lo = 0; a.ph_hi = N_PHASES;
    void* kargs[] = {&a};
    const hipError_t e = hipLaunchCooperativeKernel((const void*)fwd, dim3(grid), dim3(NWAVES * 64), kargs, LDS_BYTES, stream);
    if (e != hipSuccess) fprintf(stderr, "kernel_launch: cooperative launch failed: %s (grid %d)\n", hipGetErrorString(e), grid);
}
```

```cpp
#include <hip/hip_runtime.h>
#include <hip/hip_cooperative_groups.h>
#include <cstdio>
#include <cstdint>

constexpr int BATCH = 8, SEQ = 2048, DM = 1024, DEPTH = 2, M = BATCH * SEQ;
constexpr int RW = 512, NH = 8, HD = 64;
constexpr int RPROJ = 1792, DPROJ = 3328;
constexpr int DFF = 2816;
constexpr int MEMLEN = 256, XH = 4, XHD = 256, MM = BATCH * MEMLEN;
constexpr int MBLK = 256, NBLK = SEQ / MBLK;
constexpr float NORM_EPS = 1e-6f, LNX_EPS = 64e-5f;
constexpr float LOG2E = 1.4426950408889634f;
constexpr float MOBA_QSCALE = 0.125f * LOG2E;
constexpr float XATT_QSCALE = 0.0625f * LOG2E;

enum { I_X = 0, I_MEM, I_RELB, I_FING, I_F1G, I_F1IN, I_F1OUT, I_MIXG, I_MIXIN, I_MIXOUT, I_MU, I_W0, I_WUP, I_A0, I_AUP, I_GUP, I_KK, I_KA, I_RK, I_LNG, I_LNB,
       I_XG, I_MEMG, I_WQ, I_WKV, I_WO, I_F2G, I_F2IN, I_F2OUT, N_IN };

constexpr size_t MiB = 1u << 20;
constexpr size_t WS_CTL = 0, CTL_ZERO_BYTES = 1 * MiB;
constexpr size_t WS_BIAS = 1 * MiB;
constexpr size_t WS_MEMRS = WS_BIAS + 64 * 1024;
constexpr size_t WS_BONUS = WS_MEMRS + 64 * 1024;
constexpr size_t WS_SSQ = 2 * MiB;
constexpr size_t WS_MEMB = 3 * MiB;
constexpr size_t WS_XK = 7 * MiB, WS_XVT = 11 * MiB;
constexpr size_t WS_W = 15 * MiB;
constexpr size_t W_F1IN = 0, W_F1OUT = W_F1IN + (size_t)2 * DFF * DM * 2, W_F2IN = W_F1OUT + (size_t)DM * DFF * 2, W_F2OUT = W_F2IN + (size_t)2 * DFF * DM * 2,
                 W_MIXIN = W_F2OUT + (size_t)DM * DFF * 2, W_MIXOUT = W_MIXIN + (size_t)DPROJ * DM * 2, W_WQ = W_MIXOUT + (size_t)DM * DM * 2, W_WKV = W_WQ + (size_t)DM * DM * 2,
                 W_WO = W_WKV + (size_t)2 * DM * DM * 2, W_WUPT = W_WO + (size_t)DM * DM * 2, W_AUPT = W_WUPT + (size_t)RW * 64 * 2, W_GUPT = W_AUPT + (size_t)RW * 64 * 2, W_END = W_GUPT + (size_t)RW * 128 * 2;
static_assert(W_END <= 50 * MiB, "weights fit");
constexpr size_t WS_XB = 65 * MiB;
constexpr size_t WS_AR = 97 * MiB;
constexpr size_t AR_H = WS_AR;
constexpr size_t AR_PR = WS_AR, AR_MQ = WS_AR + 56 * MiB, AR_MK = WS_AR + 72 * MiB, AR_MVT = WS_AR + 88 * MiB;
constexpr size_t AR_SCANIN = WS_AR + 56 * MiB;
constexpr size_t AR_YLOC = WS_AR, AR_Z = WS_AR + 32 * MiB;
constexpr size_t AR_STATE = WS_AR + 152 * MiB;
constexpr size_t AR_XB2 = WS_AR, AR_XQ = WS_AR + 32 * MiB, AR_XO = WS_AR + 64 * MiB;
constexpr size_t WS_END = WS_AR + 168 * MiB;

#define GAS __attribute__((address_space(1)))
#define LAS __attribute__((address_space(3)))

namespace pg8 {
#define PG8_LAS __attribute__((address_space(3)))
typedef unsigned short bf16_t;
typedef short bf16x8 __attribute__((ext_vector_type(8)));
typedef float f32x4 __attribute__((ext_vector_type(4)));
typedef unsigned u32x4 __attribute__((ext_vector_type(4)));
constexpr int BM = 256, BK = 64, HALF = 128, HTB = HALF * BK * 2  , STAGE_BYTES = 8 * HTB, NXCD = 8, WGM = 8;

__host__ __device__ __forceinline__ int lds_byte(int r, int c) { const int st = (r >> 4) * 2 + (c >> 5), rr = r & 15, cc = c & 31, ob = rr * 64 + cc * 2; return st * 1024 + (ob ^ (((ob >> 9) & 1) << 5)); }
__host__ __device__ __forceinline__ void stage_rc(int b, int& R, int& C) { const int st = b / 1024, sb = b % 1024, swz = sb ^ (((sb >> 9) & 1) << 5); R = (st >> 1) * 16 + swz / 64; C = (st & 1) * 32 + (swz % 64) / 2; }
__host__ __device__ __forceinline__ int perm32(int rho) { const int n = rho >> 4, i = rho & 15; return 8 * (i >> 2) + 4 * n + (i & 3); }

struct Unit { int pm, pn; };
struct Gemm { const bf16_t* A; const bf16_t* Bt; int M, N, K; };

struct StaticOrder {
    int nM, nN, nwg, G, c;
    __host__ __device__ void init(int M, int N, int G_, int c_) { nM = M / BM; nN = N / BM; nwg = nM * nN; G = G_; c = c_; }
    __host__ __device__ bool next(int i, Unit& u) const {
        const long L = (long)i * G + c; if (L >= nwg) return false;
        int wgid = (int)L; { const int q = nwg / NXCD, r = nwg % NXCD, xcd = wgid % NXCD, off = wgid / NXCD; wgid = (xcd < r ? xcd * (q + 1) : r * (q + 1) + (xcd - r) * q) + off; }
        const int nig = WGM * nN, gid = wgid / nig, fm = gid * WGM, gsz = (nM - fm) < WGM ? (nM - fm) : WGM;
        u.pm = fm + ((wgid % nig) % gsz); u.pn = (wgid % nig) / gsz; return true;
    }
    __device__ __forceinline__ void a_ready(const Unit&) const {}
    __device__ __forceinline__ void done(const Unit&) const {}
};

__device__ __forceinline__ unsigned cvt_pk_bf16(float lo, float hi) { unsigned r; asm volatile("v_cvt_pk_bf16_f32 %0, %1, %2" : "=v"(r) : "v"(lo), "v"(hi)); return r; }
typedef float f32x2 __attribute__((ext_vector_type(2)));
__device__ __forceinline__ float row_rstd16(const float* ssq, int r) {
    const f32x4* p = (const f32x4*)(ssq + (size_t)r * 16);
    const f32x4 a = p[0], b = p[1], c = p[2], d = p[3];
    const float s = ((a[0] + a[1]) + (a[2] + a[3])) + ((b[0] + b[1]) + (b[2] + b[3])) + ((c[0] + c[1]) + (c[2] + c[3])) + ((d[0] + d[1]) + (d[2] + d[3]));
    return __builtin_amdgcn_rsqf(s * (1.0f / 1024.0f) + 1e-6f);
}
__device__ __forceinline__ float silu_mul(float g, float u) { return g * __builtin_amdgcn_rcpf(1.0f + __expf(-g)) * u; }
__device__ __forceinline__ u32x4 pack8(const f32x4 v0, const f32x4 v1) { u32x4 w; w.x = cvt_pk_bf16(v0[0], v0[1]); w.y = cvt_pk_bf16(v0[2], v0[3]); w.z = cvt_pk_bf16(v1[0], v1[1]); w.w = cvt_pk_bf16(v1[2], v1[3]); return w; }
__device__ __forceinline__ int pos16(int k) { return 8 * ((k >> 2) & 1) + (k & 3) + 4 * (k >> 3); }

struct EpiSwiGLU {
    static constexpr bool PERM = true, AFTER_DRAIN = false;
    unsigned char* ws;
    __device__ __forceinline__ void operator()(const f32x4 (&acc)[2][2][4][2], const Unit& u, int wr, int wc, int fr, int fq) const {
        const int row0 = u.pm * BM + wr * 64 + fr, hcol = u.pn * 128 + wc * 32 + 8 * fq; bf16_t* H = (bf16_t*)(ws + AR_H); const float* ssq = (const float*)(ws + WS_SSQ);
#pragma unroll
        for (int ai = 0; ai < 2; ++ai)
#pragma unroll
            for (int m = 0; m < 4; ++m) { const int r = row0 + ai * HALF + m * 16; const float rs = row_rstd16(ssq, r);
                f32x4 h0, h1;
#pragma unroll
                for (int i = 0; i < 4; ++i) { h0[i] = silu_mul(acc[ai][0][m][0][i] * rs, acc[ai][1][m][0][i] * rs); h1[i] = silu_mul(acc[ai][0][m][1][i] * rs, acc[ai][1][m][1][i] * rs); }
                *(u32x4*)(H + (size_t)r * 2816 + hcol) = pack8(h0, h1); }
    }
};
struct EpiResid {
    static constexpr bool PERM = true, AFTER_DRAIN = false;
    const float* base; float* out; unsigned char* ws; size_t xb_off; float alpha;
    __device__ __forceinline__ void operator()(const f32x4 (&acc)[2][2][4][2], const Unit& u, int wr, int wc, int fr, int fq) const {
        const int row0 = u.pm * BM + wr * 64 + fr, col0 = u.pn * BM + wc * 32 + 8 * fq; bf16_t* xb = (bf16_t*)(ws + xb_off); float* ssq = (float*)(ws + WS_SSQ);
#pragma unroll
        for (int ai = 0; ai < 2; ++ai)
#pragma unroll
            for (int m = 0; m < 4; ++m) { const int r = row0 + ai * HALF + m * 16; float s = 0.f;
#pragma unroll
                for (int bj = 0; bj < 2; ++bj) { const size_t off = (size_t)r * 1024 + col0 + bj * HALF;
                    const f32x4 b0 = *(const f32x4*)(base + off), b1 = *(const f32x4*)(base + off + 4);
                    const f32x4 v0 = b0 + acc[ai][bj][m][0] * alpha, v1 = b1 + acc[ai][bj][m][1] * alpha;
                    *(f32x4*)(out + off) = v0; *(f32x4*)(out + off + 4) = v1; *(u32x4*)(xb + off) = pack8(v0, v1);
                    s += (v0[0] * v0[0] + v0[1] * v0[1]) + (v0[2] * v0[2] + v0[3] * v0[3]) + (v1[0] * v1[0] + v1[1] * v1[1]) + (v1[2] * v1[2] + v1[3] * v1[3]); }
                s += __shfl_xor(s, 16); s += __shfl_xor(s, 32);
                if (fq == 0) ssq[(size_t)r * 16 + u.pn * 4 + wc] = s; }
    }
};
struct EpiMixIn {
    static constexpr bool PERM = true, AFTER_DRAIN = false;
    unsigned char* ws;
    __device__ __forceinline__ void operator()(const f32x4 (&acc)[2][2][4][2], const Unit& u, int wr, int wc, int fr, int fq) const {
        const int row0 = u.pm * BM + wr * 64 + fr, cw = wc * 32 + 8 * fq; const float* ssq = (const float*)(ws + WS_SSQ);
        bf16_t* PR = (bf16_t*)(ws + AR_PR); bf16_t* MQ = (bf16_t*)(ws + AR_MQ); bf16_t* MK = (bf16_t*)(ws + AR_MK); bf16_t* MVT = (bf16_t*)(ws + AR_MVT);
#pragma unroll
        for (int ai = 0; ai < 2; ++ai)
#pragma unroll
            for (int m = 0; m < 4; ++m) { const int r = row0 + ai * HALF + m * 16; const float rs = row_rstd16(ssq, r);
#pragma unroll
                for (int bj = 0; bj < 2; ++bj) { const int c = cw + bj * HALF;
                    f32x4 v0 = acc[ai][bj][m][0] * rs, v1 = acc[ai][bj][m][1] * rs;
                    if (u.pn < 7) *(u32x4*)(PR + (size_t)r * 1792 + u.pn * 256 + c) = pack8(v0, v1);
                    else if (u.pn < 9) { v0 = v0 * MOBA_QSCALE; v1 = v1 * MOBA_QSCALE; *(u32x4*)(MQ + (size_t)r * 512 + (u.pn - 7) * 256 + c) = pack8(v0, v1); }
                    else if (u.pn < 11) *(u32x4*)(MK + (size_t)r * 512 + (u.pn - 9) * 256 + c) = pack8(v0, v1);
                    else { const int cc = (u.pn - 11) * 256 + c, hh = cc >> 6, d = cc & 63, b = r >> 11, t = r & 2047;
                        bf16_t* p = MVT + ((size_t)(b * 8 + hh) * 64 + d) * 2048 + (t & ~15) + pos16(t & 15);
                        const u32x4 w = pack8(v0, v1);
                        p[0] = (bf16_t)(w.x & 0xffffu); p[2048] = (bf16_t)(w.x >> 16); p[2 * 2048] = (bf16_t)(w.y & 0xffffu); p[3 * 2048] = (bf16_t)(w.y >> 16);
                        p[4 * 2048] = (bf16_t)(w.z & 0xffffu); p[5 * 2048] = (bf16_t)(w.z >> 16); p[6 * 2048] = (bf16_t)(w.w & 0xffffu); p[7 * 2048] = (bf16_t)(w.w >> 16); }
                } }
    }
};
struct EpiXQ {
    static constexpr bool PERM = true, AFTER_DRAIN = false;
    unsigned char* ws;
    __device__ __forceinline__ void operator()(const f32x4 (&acc)[2][2][4][2], const Unit& u, int wr, int wc, int fr, int fq) const {
        const int row0 = u.pm * BM + wr * 64 + fr, col0 = u.pn * BM + wc * 32 + 8 * fq; bf16_t* Q = (bf16_t*)(ws + AR_XQ); const float* ssq = (const float*)(ws + WS_SSQ);
#pragma unroll
        for (int ai = 0; ai < 2; ++ai)
#pragma unroll
            for (int m = 0; m < 4; ++m) { const int r = row0 + ai * HALF + m * 16; const float rs = row_rstd16(ssq, r) * XATT_QSCALE;
#pragma unroll
                for (int bj = 0; bj < 2; ++bj) *(u32x4*)(Q + (size_t)r * 1024 + col0 + bj * HALF) = pack8(acc[ai][bj][m][0] * rs, acc[ai][bj][m][1] * rs); }
    }
};
struct EpiKV {
    static constexpr bool PERM = true, AFTER_DRAIN = false;
    unsigned char* ws;
    __device__ __forceinline__ void operator()(const f32x4 (&acc)[2][2][4][2], const Unit& u, int wr, int wc, int fr, int fq) const {
        const int row0 = u.pm * BM + wr * 64 + fr, cw = wc * 32 + 8 * fq; bf16_t* XK = (bf16_t*)(ws + WS_XK); bf16_t* XVT = (bf16_t*)(ws + WS_XVT); const float* memrs = (const float*)(ws + WS_MEMRS);
#pragma unroll
        for (int ai = 0; ai < 2; ++ai)
#pragma unroll
            for (int m = 0; m < 4; ++m) { const int r = row0 + ai * HALF + m * 16; const float rs = memrs[r];
#pragma unroll
                for (int bj = 0; bj < 2; ++bj) { const int c = cw + bj * HALF;
                    const f32x4 v0 = acc[ai][bj][m][0] * rs, v1 = acc[ai][bj][m][1] * rs;
                    if (u.pn < 4) *(u32x4*)(XK + (size_t)r * 1024 + u.pn * 256 + c) = pack8(v0, v1);
                    else { const int hx = u.pn - 4, b = r >> 8, key = r & 255;
                        bf16_t* p = XVT + ((size_t)(b * 4 + hx) * 256 + c) * 256 + (key & ~15) + pos16(key & 15);
                        const u32x4 w = pack8(v0, v1);
                        p[0] = (bf16_t)(w.x & 0xffffu); p[256] = (bf16_t)(w.x >> 16); p[2 * 256] = (bf16_t)(w.y & 0xffffu); p[3 * 256] = (bf16_t)(w.y >> 16);
                        p[4 * 256] = (bf16_t)(w.z & 0xffffu); p[5 * 256] = (bf16_t)(w.z >> 16); p[6 * 256] = (bf16_t)(w.w & 0xffffu); p[7 * 256] = (bf16_t)(w.w >> 16); }
                } }
    }
};

template <class Epi, class Sched, bool ALIGN_EPI = false, bool SP2 = false>
__device__ __forceinline__ void gemm_phase(PG8_LAS unsigned char* lds, const Gemm g, const Sched& S, const Epi& E) {
    int tid_ = threadIdx.x; asm volatile("" : "+v"(tid_));
    const int tid = tid_, wid = __builtin_amdgcn_readfirstlane(tid >> 6), lane = tid & 63, wr = wid >> 2, wc = wid & 3, fr = lane & 15, fq = lane >> 4;
    const int K = g.K, nt = K / BK;
    unsigned voffA[2], voffB[2];
#pragma unroll
    for (int i = 0; i < 2; ++i) { int R, C; stage_rc(tid * 16 + i * 8192, R, C); const int Rb = Epi::PERM ? ((R & ~31) + perm32(R & 31)) : R;
        voffA[i] = (unsigned)(R * K + C) * 2u; voffB[i] = (unsigned)(Rb * K + C) * 2u; }
    const size_t kstep = (size_t)(BK * 2);
    const size_t hstep = (size_t)HALF * K * 2;
    const size_t tstep = 2 * hstep;
    const unsigned ldsw = (unsigned)wid * 1024u;
    const int aoff = lds_byte(wr * 64 + fr, fq * 8), boff = lds_byte(wc * 32 + fr, fq * 8);
#define PG8_SA(b, h) (((b) * 2 + (h)) * HTB)
#define PG8_SB(b, h) ((4 + (b) * 2 + (h)) * HTB)
#define PG8_STAGE(bufoff, gbase, voff) do { _Pragma("unroll") for (int _i = 0; _i < 2; ++_i) \
        __builtin_amdgcn_global_load_lds((const unsigned*)((const char*)(gbase) + (voff)[_i]), (PG8_LAS unsigned*)(lds + (bufoff) + ldsw + _i * 8192), 16, 0, 0); } while (0)
#define PG8_LDA(dst, b, h) do { _Pragma("unroll") for (int m = 0; m < 4; ++m) _Pragma("unroll") for (int k = 0; k < 2; ++k) dst[m][k] = *(const PG8_LAS bf16x8*)(lds + PG8_SA(b, h) + aoff + m * 2048 + k * 1024); } while (0)
#define PG8_LDB(dst, b, h) do { _Pragma("unroll") for (int n = 0; n < 2; ++n) _Pragma("unroll") for (int k = 0; k < 2; ++k) dst[n][k] = *(const PG8_LAS bf16x8*)(lds + PG8_SB(b, h) + boff + n * 2048 + k * 1024); } while (0)
#define PG8_MMA(ai, bj, At, Bt) do { __builtin_amdgcn_s_setprio(1); _Pragma("unroll") for (int m = 0; m < 4; ++m) _Pragma("unroll") for (int n = 0; n < 2; ++n) _Pragma("unroll") for (int k = 0; k < 2; ++k) \
        acc[ai][bj][m][n] = __builtin_amdgcn_mfma_f32_16x16x32_bf16(Bt[n][k], At[m][k], acc[ai][bj][m][n], 0, 0, 0); __builtin_amdgcn_s_setprio(0); } while (0)
#define PG8_WAIT_V(n) asm volatile("s_waitcnt vmcnt(" #n ")" ::: "memory")
#define PG8_WAIT_L(n) asm volatile("s_waitcnt lgkmcnt(" #n ")" ::: "memory")
#define PG8_BAR __builtin_amdgcn_s_barrier()
#define PG8_SCHED __builtin_amdgcn_sched_barrier(0)
    Unit cur, nxt; int ui = 0;
    if (!S.next(0, cur)) return;
    f32x4 acc[2][2][4][2];
#pragma unroll
    for (int a = 0; a < 2; ++a)
#pragma unroll
        for (int b = 0; b < 2; ++b)
#pragma unroll
            for (int m = 0; m < 4; ++m)
#pragma unroll
                for (int n = 0; n < 2; ++n) acc[a][b][m][n] = (f32x4){0.f, 0.f, 0.f, 0.f};
    bf16x8 At[4][2], B0[2][2], B1[2][2];
    const char* cA = (const char*)g.A + (size_t)cur.pm * tstep; const char* cB = (const char*)g.Bt + (size_t)cur.pn * tstep;
    S.a_ready(cur);
    if constexpr (SP2) {
        PG8_STAGE(PG8_SB(0, 0), cB, voffB); PG8_STAGE(PG8_SB(0, 1), cB + hstep, voffB); PG8_STAGE(PG8_SA(0, 0), cA, voffA); PG8_STAGE(PG8_SA(0, 1), cA + hstep, voffA);
        if (wr == 1) PG8_BAR;
        PG8_WAIT_V(2); PG8_BAR;
        PG8_STAGE(PG8_SB(1, 0), cB + kstep, voffB); PG8_STAGE(PG8_SA(1, 0), cA + kstep, voffA); PG8_STAGE(PG8_SB(1, 1), cB + hstep + kstep, voffB);
        PG8_WAIT_V(6); PG8_BAR;
    } else {
        PG8_STAGE(PG8_SB(0, 0), cB, voffB); PG8_STAGE(PG8_SA(0, 0), cA, voffA); PG8_STAGE(PG8_SB(0, 1), cB + hstep, voffB); PG8_STAGE(PG8_SA(0, 1), cA + hstep, voffA);
        if (wr == 1) PG8_BAR;
        PG8_WAIT_V(4); PG8_BAR;
        PG8_STAGE(PG8_SB(1, 0), cB + kstep, voffB); PG8_STAGE(PG8_SA(1, 0), cA + kstep, voffA); PG8_STAGE(PG8_SB(1, 1), cB + hstep + kstep, voffB);
        PG8_WAIT_V(6); PG8_BAR;
    }
    for (;;) {
        const bool has_next = S.next(ui + 1, nxt);
        const char* nA = has_next ? (const char*)g.A + (size_t)nxt.pm * tstep : cA; const char* nB = has_next ? (const char*)g.Bt + (size_t)nxt.pn * tstep : cB;
        for (int t = 0; t < nt; t += 2) {
            const bool last = (t == nt - 2);
            const char* a1 = cA + (size_t)(t + 1) * kstep;
            const char* a2 = last ? nA : cA + (size_t)(t + 2) * kstep; const char* b2 = last ? nB : cB + (size_t)(t + 2) * kstep;
            const char* a3 = a2 + kstep; const char* b3 = b2 + kstep;
            if (last && has_next) S.a_ready(nxt);
            if constexpr (SP2) {
            PG8_LDB(B0, 0, 0); PG8_LDB(B1, 0, 1); PG8_SCHED; PG8_LDA(At, 0, 0); PG8_STAGE(PG8_SA(1, 1), a1 + hstep, voffA);
            PG8_WAIT_V(8); PG8_WAIT_L(0); PG8_BAR; PG8_MMA(0, 0, At, B0); PG8_MMA(0, 1, At, B1); PG8_BAR; PG8_SCHED;
            PG8_LDA(At, 0, 1); PG8_STAGE(PG8_SB(0, 0), b2, voffB); PG8_STAGE(PG8_SB(0, 1), b2 + hstep, voffB); PG8_STAGE(PG8_SA(0, 0), a2, voffA);
            PG8_WAIT_V(8); PG8_WAIT_L(0); PG8_BAR; PG8_MMA(1, 0, At, B0); PG8_MMA(1, 1, At, B1); PG8_BAR; PG8_SCHED;
            PG8_LDB(B0, 1, 0); PG8_LDB(B1, 1, 1); PG8_SCHED; PG8_LDA(At, 1, 0); PG8_STAGE(PG8_SA(0, 1), a2 + hstep, voffA);
            PG8_WAIT_V(8); PG8_WAIT_L(0); PG8_BAR; PG8_MMA(0, 0, At, B0); PG8_MMA(0, 1, At, B1); PG8_BAR; PG8_SCHED;
            PG8_LDA(At, 1, 1); PG8_STAGE(PG8_SB(1, 0), b3, voffB); PG8_STAGE(PG8_SB(1, 1), b3 + hstep, voffB); PG8_STAGE(PG8_SA(1, 0), a3, voffA);
            PG8_WAIT_V(8); PG8_WAIT_L(0); PG8_BAR; PG8_MMA(1, 0, At, B0); PG8_MMA(1, 1, At, B1); PG8_BAR; PG8_SCHED;
            } else {
            PG8_LDB(B0, 0, 0); PG8_SCHED; PG8_LDA(At, 0, 0); PG8_STAGE(PG8_SA(1, 1), a1 + hstep, voffA);
            PG8_WAIT_L(8); PG8_BAR; PG8_WAIT_L(0); PG8_MMA(0, 0, At, B0); PG8_BAR; PG8_SCHED;
            PG8_LDB(B1, 0, 1); PG8_STAGE(PG8_SB(0, 0), b2, voffB);
            PG8_BAR; PG8_WAIT_L(0); PG8_MMA(0, 1, At, B1); PG8_BAR;
            PG8_LDA(At, 0, 1); PG8_STAGE(PG8_SA(0, 0), a2, voffA);
            PG8_BAR; PG8_WAIT_L(0); PG8_MMA(1, 0, At, B0); PG8_BAR; PG8_SCHED;
            PG8_STAGE(PG8_SB(0, 1), b2 + hstep, voffB);
            PG8_WAIT_V(6); PG8_BAR; PG8_MMA(1, 1, At, B1); PG8_BAR;
            PG8_LDB(B0, 1, 0); PG8_SCHED; PG8_LDA(At, 1, 0); PG8_STAGE(PG8_SA(0, 1), a2 + hstep, voffA);
            PG8_WAIT_L(8); PG8_BAR; PG8_WAIT_L(0); PG8_MMA(0, 0, At, B0); PG8_BAR; PG8_SCHED;
            PG8_LDB(B1, 1, 1); PG8_STAGE(PG8_SB(1, 0), b3, voffB);
            PG8_BAR; PG8_WAIT_L(0); PG8_MMA(0, 1, At, B1); PG8_BAR;
            PG8_LDA(At, 1, 1); PG8_STAGE(PG8_SA(1, 0), a3, voffA);
            PG8_BAR; PG8_WAIT_L(0); PG8_MMA(1, 0, At, B0); PG8_BAR; PG8_SCHED;
            PG8_STAGE(PG8_SB(1, 1), b3 + hstep, voffB);
            PG8_WAIT_V(6); PG8_BAR; PG8_MMA(1, 1, At, B1); PG8_BAR;
            }
        }
        if constexpr (ALIGN_EPI) { if (wr == 0) PG8_BAR; }
        if constexpr (!Epi::AFTER_DRAIN) { E(acc, cur, wr, wc, fr, fq); S.done(cur); }
        if (!has_next) break;
#pragma unroll
        for (int a = 0; a < 2; ++a)
#pragma unroll
            for (int b = 0; b < 2; ++b)
#pragma unroll
                for (int m = 0; m < 4; ++m)
#pragma unroll
                    for (int n = 0; n < 2; ++n) acc[a][b][m][n] = (f32x4){0.f, 0.f, 0.f, 0.f};
        cur = nxt; cA = nA; cB = nB; ++ui;
        if constexpr (ALIGN_EPI) { if (wr == 1) PG8_BAR; }
    }
    PG8_WAIT_V(0);
    if constexpr (!ALIGN_EPI) { if (wr == 0) PG8_BAR; }
    PG8_BAR;
    if constexpr (Epi::AFTER_DRAIN) { E.fused(acc, cur, wr, wc, fr, fq, lds, wid, lane); S.done(cur); }
#undef PG8_SA
#undef PG8_SB
#undef PG8_STAGE
#undef PG8_LDA
#undef PG8_LDB
#undef PG8_MMA
#undef PG8_WAIT_V
#undef PG8_WAIT_L
#undef PG8_BAR
#undef PG8_SCHED
}
}

constexpr int NWAVES = 8;
constexpr int RING_BYTES = 131072, LDSCTL_OFF = RING_BYTES, MISC_OFF = LDSCTL_OFF + 320, LDS_BYTES = 147456;
constexpr int SCAN_R = 2, SCAN_NCH = 8;

typedef unsigned short bf16;
typedef unsigned u32x4 __attribute__((ext_vector_type(4)));
typedef unsigned u32x2 __attribute__((ext_vector_type(2)));
typedef float f32x4 __attribute__((ext_vector_type(4)));
typedef float f32x16 __attribute__((ext_vector_type(16)));
typedef short bf16x8 __attribute__((ext_vector_type(8)));
typedef GAS unsigned gu32;
#define RLX_AGENT __ATOMIC_RELAXED, __HIP_MEMORY_SCOPE_AGENT
#define LDS_WAIT() asm volatile("s_waitcnt lgkmcnt(0)" ::: "memory")
#define VM_WAIT() asm volatile("s_waitcnt vmcnt(0)" ::: "memory")
__device__ __forceinline__ float bf2f(unsigned b) { return __uint_as_float(b << 16); }
__device__ __forceinline__ unsigned f2bf(float f) { unsigned u = __builtin_bit_cast(unsigned, f); return (u + 0x7fffu + ((u >> 16) & 1u)) >> 16; }
__device__ __forceinline__ unsigned pk2(float lo, float hi) { return pg8::cvt_pk_bf16(lo, hi); }
__device__ __forceinline__ float wave_sum(float v) {
#pragma unroll
    for (int o = 1; o < 64; o <<= 1) v += __shfl_xor(v, o);
    return v;
}
__device__ __forceinline__ float quad_sum(float x) {
    x += __builtin_bit_cast(float, __builtin_amdgcn_update_dpp(0, __builtin_bit_cast(int, x), 0xB1, 0xF, 0xF, true));
    x += __builtin_bit_cast(float, __builtin_amdgcn_update_dpp(0, __builtin_bit_cast(int, x), 0x4E, 0xF, 0xF, true));
    return x;
}
__device__ __forceinline__ float sigmoidf_(float x) { return __builtin_amdgcn_rcpf(1.0f + __expf(-x)); }
__device__ __forceinline__ int crow(int r, int hi) { return (r & 3) + 8 * (r >> 2) + 4 * hi; }
__device__ __forceinline__ bf16x8 pack_bf16x8(float a0, float a1, float a2, float a3, float a4, float a5, float a6, float a7) {
    u32x4 w; w.x = pk2(a0, a1); w.y = pk2(a2, a3); w.z = pk2(a4, a5); w.w = pk2(a6, a7); return __builtin_bit_cast(bf16x8, w);
}

#define XB_TMO      128
#define XB_XCNT(j)  (256  + 64 * (j))
#define XB_XSUB(j)  (1280 + 64 * (j))
#define XB_XGEN(j)  (2304 + 64 * (j))
#define XB_TOP      3328
#define XB_TOPGEN   3392
#define XCD_BAR_WORDS 3456
#define XB_SPIN_CAP (1u << 18)

__device__ __forceinline__ unsigned xb_ld(unsigned* p)              { return __hip_atomic_load(p, __ATOMIC_RELAXED, __HIP_MEMORY_SCOPE_AGENT); }
__device__ __forceinline__ unsigned xb_add(unsigned* p, unsigned v) { return __hip_atomic_fetch_add(p, v, __ATOMIC_RELAXED, __HIP_MEMORY_SCOPE_AGENT); }
__device__ __forceinline__ unsigned xb_xcc_id() { return (unsigned)__builtin_amdgcn_s_getreg((3 << 11) | 20) & 0xFu; }
#define XB_SPIN(cond, bar) do { unsigned _sp = 0; while (cond) { __builtin_amdgcn_s_sleep(1); \
    if ((++_sp & 255u) == 0u) { if (xb_ld(&(bar)[XB_TMO])) break; if (_sp > XB_SPIN_CAP) { atomicAdd(&(bar)[XB_TMO], 1u); break; } } } } while (0)

struct XcdBarrier {
    unsigned* bar; unsigned x;
    volatile LAS unsigned* st;
};

__device__ __forceinline__ XcdBarrier xcd_barrier_post(unsigned* bar, volatile LAS unsigned* st) {
    XcdBarrier b; b.bar = bar; b.x = xb_xcc_id(); b.st = st;
    if (threadIdx.x == 0) (void)xb_add(&bar[XB_XCNT(b.x)], 1u);
    return b;
}
__device__ __forceinline__ void xcd_barrier_complete(unsigned* bar, unsigned x, unsigned& nloc, unsigned& nx) {
    const unsigned G = gridDim.x * gridDim.y * gridDim.z;
    unsigned sum, cnt, mine, sp = 0u;
    for (;;) {
        sum = 0u; cnt = 0u; mine = 0u;
#pragma unroll
        for (unsigned j = 0; j < 16; ++j) { const unsigned c = xb_ld(&bar[XB_XCNT(j)]); sum += c; cnt += (c > 0u) ? 1u : 0u; mine = (j == x) ? c : mine; }
        if (sum == G) break;
        __builtin_amdgcn_s_sleep(1);
        if ((++sp & 255u) == 0u) { if (xb_ld(&bar[XB_TMO])) break; if (sp > XB_SPIN_CAP) { atomicAdd(&bar[XB_TMO], 1u); break; } }
    }
    nloc = mine > 0u ? mine : 1u; nx = cnt > 0u ? cnt : 1u;
}

__device__ __forceinline__ void xcd_barrier(const XcdBarrier& b) {
    asm volatile("s_waitcnt vmcnt(0)" ::: "memory");
    __syncthreads();
    if (threadIdx.x == 0) {
        unsigned* bar = b.bar;
        __builtin_amdgcn_s_waitcnt(0);
        unsigned nloc = b.st[0], nx = b.st[1];
        if (nloc == 0u) { xcd_barrier_complete(bar, b.x, nloc, nx); b.st[0] = nloc; b.st[1] = nx; }
        const unsigned old = xb_add(&bar[XB_XSUB(b.x)], 1u);
        const unsigned gen = old / nloc;
        if (old + 1u == (gen + 1u) * nloc) {
            __builtin_amdgcn_fence(__ATOMIC_RELEASE, "agent");
            asm volatile("s_waitcnt vmcnt(0)" ::: "memory");
            const unsigned og = xb_add(&bar[XB_TOP], 1u);
            const unsigned tg = og / nx;
            if (og + 1u == (tg + 1u) * nx) xb_add(&bar[XB_TOPGEN], 1u);
            else XB_SPIN(xb_ld(&bar[XB_TOPGEN]) == tg, bar);
            __builtin_amdgcn_fence(__ATOMIC_ACQUIRE, "agent");
            xb_add(&bar[XB_XGEN(b.x)], 1u);
            asm volatile("s_waitcnt vmcnt(0)" ::: "memory");
        } else {
            XB_SPIN(xb_ld(&bar[XB_XGEN(b.x)]) == gen, bar);
            __builtin_amdgcn_fence(__ATOMIC_ACQUIRE, "agent");
            asm volatile("s_waitcnt vmcnt(0)" ::: "memory");
        }
    }
    __syncthreads();
}


struct Args { const float* in[N_IN]; float* out; unsigned char* ws; int ph_lo, ph_hi; };
static_assert(sizeof(Args) == N_IN * 8 + 24, "Args has no padding");
struct Frame {
    LAS unsigned char* lds; volatile LAS unsigned* MISC; gu32* ctl;
    int tid, lane, wave, vcu, G;
    const __attribute__((address_space(4))) struct Args* ka; float* out; unsigned char* ws;
};
#define FIN(i) (F.ka->in[i])
#define WSP(T, off) ((T*)(F.ws + (off)))

__device__ __forceinline__ void ph_init(Frame& F) {
    const int gw = F.vcu * NWAVES + F.wave, NGW = F.G * NWAVES;
    float* bias = WSP(float, WS_BIAS); const float* relb = FIN(I_RELB);
    for (int i = blockIdx.x * 512 + F.tid; i < NH * 2048; i += F.G * 512) { const int h = i >> 11, n = i & 2047; int bkt;
        if (n < 16) bkt = n; else { const float nf = (float)n; const int lg = 16 + (int)(logf(nf / 16.0f) / 4.1588830833596715f * 16.0f); bkt = lg < 31 ? lg : 31; }
        bias[i] = relb[h * 32 + bkt] * LOG2E; }
    const float* mem = FIN(I_MEM); bf16* memb = WSP(bf16, WS_MEMB); float* memrs = WSP(float, WS_MEMRS);
    for (int r = gw; r < MM; r += NGW) { const f32x4* xr = (const f32x4*)(mem + (size_t)r * DM) + F.lane; f32x4 v[4]; float s = 0.f;
#pragma unroll
        for (int j = 0; j < 4; ++j) { v[j] = xr[64 * j]; s += (v[j].x * v[j].x + v[j].y * v[j].y) + (v[j].z * v[j].z + v[j].w * v[j].w); }
        s = wave_sum(s); u32x2* o = (u32x2*)(memb + (size_t)r * DM) + F.lane;
#pragma unroll
        for (int j = 0; j < 4; ++j) { u32x2 w; w.x = pk2(v[j].x, v[j].y); w.y = pk2(v[j].z, v[j].w); o[64 * j] = w; }
        if (F.lane == 0) memrs[r] = __builtin_amdgcn_rsqf(s * (1.0f / DM) + NORM_EPS); }
    const float* x = FIN(I_X); bf16* xb = WSP(bf16, WS_XB); float* ssq = WSP(float, WS_SSQ);
    for (int r = gw; r < M; r += NGW) { const f32x4* xr = (const f32x4*)(x + (size_t)r * DM) + F.lane; f32x4 v[4]; float s = 0.f;
#pragma unroll
        for (int j = 0; j < 4; ++j) { v[j] = xr[64 * j]; s += (v[j].x * v[j].x + v[j].y * v[j].y) + (v[j].z * v[j].z + v[j].w * v[j].w); }
        s = wave_sum(s); u32x2* o = (u32x2*)(xb + (size_t)r * DM) + F.lane;
#pragma unroll
        for (int j = 0; j < 4; ++j) { u32x2 w; w.x = pk2(v[j].x, v[j].y); w.y = pk2(v[j].z, v[j].w); o[64 * j] = w; }
        if (F.lane < 16) ssq[(size_t)r * 16 + F.lane] = F.lane == 0 ? s : 0.f; }
}

__device__ __forceinline__ void conv_item(const float* W, int K, int N, const float* gk, bf16* WT, int item, bool ffn_in, LAS float* scr, int lane) {
    const int nblk = N / 32, kb = item / nblk, nb = item % nblk, k0 = 64 * kb, n0 = 32 * nb;
#pragma unroll 8
    for (int i = 0; i < 32; ++i) { const int kk = 2 * i + (lane >> 5); float w = W[(size_t)(k0 + kk) * N + n0 + (lane & 31)]; if (gk) w *= gk[k0 + kk]; scr[kk * 33 + (lane & 31)] = w; }
    LDS_WAIT(); asm volatile("" ::: "memory");
    int drow0 = n0; if (ffn_in) drow0 = n0 < DFF ? 256 * (n0 / 128) + (n0 % 128) : 256 * ((n0 - DFF) / 128) + 128 + ((n0 - DFF) % 128);
    const int c = lane & 7;
#pragma unroll
    for (int j = 0; j < 4; ++j) { const int n = (lane >> 3) + 8 * j; const LAS float* s = scr + (8 * c) * 33 + n;
        u32x4 o; o.x = pk2(s[0 * 33], s[1 * 33]); o.y = pk2(s[2 * 33], s[3 * 33]); o.z = pk2(s[4 * 33], s[5 * 33]); o.w = pk2(s[6 * 33], s[7 * 33]);
        *(u32x4*)(WT + (size_t)(drow0 + n) * K + k0 + 8 * c) = o; }
    LDS_WAIT(); asm volatile("" ::: "memory");
}
__device__ __forceinline__ void ph_conv(Frame& F, int l) {
    LAS float* scr = (LAS float*)(F.lds + F.wave * 16384);
    const int gw = F.vcu * NWAVES + F.wave, NGW = F.G * NWAVES;
    constexpr int I_FIN = (DM / 64) * (2 * DFF / 32), I_FOUT = (DFF / 64) * (DM / 32), I_MI = (DM / 64) * (DPROJ / 32), I_SQ = (DM / 64) * (DM / 32), I_KV = (DM / 64) * (2 * DM / 32);
    constexpr int I_L64 = (64 / 64) * (RW / 32), I_L128 = (128 / 64) * (RW / 32);
    constexpr int NITEMS = 2 * I_FIN + 2 * I_FOUT + I_MI + 3 * I_SQ + I_KV + 2 * I_L64 + I_L128;
    unsigned char* wb = F.ws + WS_W;
    for (int it = gw; it < NITEMS; it += NGW) { int r = it;
        if (r < I_FIN) { conv_item(FIN(I_F1IN) + (size_t)l * DM * 2 * DFF, DM, 2 * DFF, FIN(I_F1G) + l * DM, (bf16*)(wb + W_F1IN), r, true, scr, F.lane); continue; } r -= I_FIN;
        if (r < I_FIN) { conv_item(FIN(I_F2IN) + (size_t)l * DM * 2 * DFF, DM, 2 * DFF, FIN(I_F2G) + l * DM, (bf16*)(wb + W_F2IN), r, true, scr, F.lane); continue; } r -= I_FIN;
        if (r < I_FOUT) { conv_item(FIN(I_F1OUT) + (size_t)l * DFF * DM, DFF, DM, nullptr, (bf16*)(wb + W_F1OUT), r, false, scr, F.lane); continue; } r -= I_FOUT;
        if (r < I_FOUT) { conv_item(FIN(I_F2OUT) + (size_t)l * DFF * DM, DFF, DM, nullptr, (bf16*)(wb + W_F2OUT), r, false, scr, F.lane); continue; } r -= I_FOUT;
        if (r < I_MI) { conv_item(FIN(I_MIXIN) + (size_t)l * DM * DPROJ, DM, DPROJ, FIN(I_MIXG) + l * DM, (bf16*)(wb + W_MIXIN), r, false, scr, F.lane); continue; } r -= I_MI;
        if (r < I_SQ) { conv_item(FIN(I_MIXOUT) + (size_t)l * DM * DM, DM, DM, nullptr, (bf16*)(wb + W_MIXOUT), r, false, scr, F.lane); continue; } r -= I_SQ;
        if (r < I_SQ) { conv_item(FIN(I_WQ) + (size_t)l * DM * DM, DM, DM, FIN(I_XG) + l * DM, (bf16*)(wb + W_WQ), r, false, scr, F.lane); continue; } r -= I_SQ;
        if (r < I_SQ) { conv_item(FIN(I_WO) + (size_t)l * DM * DM, DM, DM, nullptr, (bf16*)(wb + W_WO), r, false, scr, F.lane); continue; } r -= I_SQ;
        if (r < I_KV) { conv_item(FIN(I_WKV) + (size_t)l * DM * 2 * DM, DM, 2 * DM, FIN(I_MEMG) + l * DM, (bf16*)(wb + W_WKV), r, false, scr, F.lane); continue; } r -= I_KV;
        if (r < I_L64) { conv_item(FIN(I_WUP) + (size_t)l * 64 * RW, 64, RW, nullptr, (bf16*)(wb + W_WUPT), r, false, scr, F.lane); continue; } r -= I_L64;
        if (r < I_L64) { conv_item(FIN(I_AUP) + (size_t)l * 64 * RW, 64, RW, nullptr, (bf16*)(wb + W_AUPT), r, false, scr, F.lane); continue; } r -= I_L64;
        conv_item(FIN(I_GUP) + (size_t)l * 128 * RW, 128, RW, nullptr, (bf16*)(wb + W_GUPT), r, false, scr, F.lane);
    }
}

__device__ __forceinline__ void ph_moba(Frame& F) {
    LAS float* kmean = (LAS float*)F.lds;
    LAS float* btab = (LAS float*)(F.lds + 2048);
    const bf16* MQ = WSP(bf16, AR_MQ); const bf16* MK = WSP(bf16, AR_MK); const bf16* MVT = WSP(bf16, AR_MVT); bf16* XB = WSP(bf16, WS_XB); const float* bias = WSP(float, WS_BIAS);
    const int lane = F.lane, r32 = lane & 31, hi = lane >> 5, wave = F.wave;
    for (int u = blockIdx.x; u < 512; u += F.G) {
        const int rnd = u >> 8, iu = u & 255, qsel = iu >> 6, bh = iu & 63, qb = rnd == 0 ? 7 - qsel : qsel, b = bh >> 3, hh = bh & 7;
        __syncthreads();
        { const int n = F.tid >> 6, d = F.tid & 63;
          if (n < qb) { const bf16* kp = MK + (size_t)(b * 2048 + n * 256) * 512 + hh * 64 + d; float s = 0.f;
#pragma unroll 8
              for (int k = 0; k < 256; ++k) s += bf2f(kp[(size_t)k * 512]);
              kmean[n * 64 + d] = s * (1.0f / 256.0f); }
          for (int i2 = F.tid; i2 < 2048; i2 += 512) btab[i2] = bias[hh * 2048 + i2]; }
        __syncthreads();
        const int q0 = qb * 256 + wave * 32; const size_t tok = (size_t)b * 2048 + q0 + r32;
        bf16x8 qf[4];
#pragma unroll
        for (int s = 0; s < 4; ++s) qf[s] = *(const bf16x8*)(MQ + tok * 512 + hh * 64 + 16 * s + 8 * hi);
        float g[7]; unsigned selmask = 0u;
#pragma unroll
        for (int n = 0; n < 7; ++n) { g[n] = -INFINITY;
            if (n < qb) { float p = 0.f;
#pragma unroll
                for (int s = 0; s < 4; ++s) { const f32x4 k0v = *(const LAS f32x4*)(kmean + n * 64 + 16 * s + 8 * hi), k1v = *(const LAS f32x4*)(kmean + n * 64 + 16 * s + 8 * hi + 4);
                    p += bf2f((unsigned short)qf[s][0]) * k0v[0] + bf2f((unsigned short)qf[s][1]) * k0v[1] + bf2f((unsigned short)qf[s][2]) * k0v[2] + bf2f((unsigned short)qf[s][3]) * k0v[3]
                       + bf2f((unsigned short)qf[s][4]) * k1v[0] + bf2f((unsigned short)qf[s][5]) * k1v[1] + bf2f((unsigned short)qf[s][6]) * k1v[2] + bf2f((unsigned short)qf[s][7]) * k1v[3]; }
                p += __shfl_xor(p, 32); g[n] = p; } }
        if (qb <= 3) selmask = (1u << qb) - 1u;
        else {
#pragma unroll
            for (int n = 0; n < 7; ++n) if (n < qb) { int cnt = 0;
#pragma unroll
                for (int n2 = 0; n2 < 7; ++n2) if (n2 != n && n2 < qb) cnt += (g[n2] > g[n] || (g[n2] == g[n] && n2 < n)) ? 1 : 0;
                if (cnt < 3) selmask |= 1u << n; } }
        float mrun = -INFINITY, lrun = 0.f; f32x16 o0, o1;
#pragma unroll
        for (int i = 0; i < 16; ++i) { o0[i] = 0.f; o1[i] = 0.f; }
        const int qpos = q0 + r32;
        const bf16* Kb = MK + (size_t)b * 2048 * 512 + hh * 64 + 8 * hi;
        const bf16* Vb = MVT + ((size_t)(b * 8 + hh) * 64 + r32) * 2048 + 8 * hi;
        for (int blk = 0; blk <= qb; ++blk) {
            const bool own = blk == qb; const bool selme = own || ((selmask >> blk) & 1u);
            if (!own && __ballot(selme) == 0ull) continue;
            const int nt = own ? wave + 1 : 8;
            for (int kt = 0; kt < nt; ++kt) { const int k0 = blk * 256 + kt * 32;
                bf16x8 kf[4], vf[2][2];
#pragma unroll
                for (int s = 0; s < 4; ++s) kf[s] = *(const bf16x8*)(Kb + (size_t)(k0 + r32) * 512 + 16 * s);
#pragma unroll
                for (int dt = 0; dt < 2; ++dt)
#pragma unroll
                    for (int sp = 0; sp < 2; ++sp) vf[dt][sp] = *(const bf16x8*)(Vb + (size_t)dt * 32 * 2048 + k0 + 16 * sp);
                f32x16 sc;
#pragma unroll
                for (int i = 0; i < 16; ++i) sc[i] = 0.f;
#pragma unroll
                for (int s = 0; s < 4; ++s) sc = __builtin_amdgcn_mfma_f32_32x32x16_bf16(kf[s], qf[s], sc, 0, 0, 0);
                float mx = -INFINITY;
#pragma unroll
                for (int r = 0; r < 16; ++r) { const int dist = qpos - (k0 + crow(r, hi)); const bool valid = selme && (!own || dist >= 0);
                    const float v = valid ? sc[r] + btab[dist < 0 ? 0 : dist] : -INFINITY; sc[r] = v; mx = fmaxf(mx, v); }
                mx = fmaxf(mx, __shfl_xor(mx, 32));
                const float mnew = fmaxf(mrun, mx), muse = (mnew == -INFINITY) ? 0.f : mnew;
                const float alpha = __builtin_amdgcn_exp2f(mrun - muse);
                float ps = 0.f;
#pragma unroll
                for (int r = 0; r < 16; ++r) { const float p = __builtin_amdgcn_exp2f(sc[r] - muse); sc[r] = p; ps += p; }
                lrun = lrun * alpha + ps; mrun = mnew;
#pragma unroll
                for (int i = 0; i < 16; ++i) { o0[i] *= alpha; o1[i] *= alpha; }
                const bf16x8 pf0 = pack_bf16x8(sc[0], sc[1], sc[2], sc[3], sc[4], sc[5], sc[6], sc[7]), pf1 = pack_bf16x8(sc[8], sc[9], sc[10], sc[11], sc[12], sc[13], sc[14], sc[15]);
                o0 = __builtin_amdgcn_mfma_f32_32x32x16_bf16(vf[0][0], pf0, o0, 0, 0, 0); o0 = __builtin_amdgcn_mfma_f32_32x32x16_bf16(vf[0][1], pf1, o0, 0, 0, 0);
                o1 = __builtin_amdgcn_mfma_f32_32x32x16_bf16(vf[1][0], pf0, o1, 0, 0, 0); o1 = __builtin_amdgcn_mfma_f32_32x32x16_bf16(vf[1][1], pf1, o1, 0, 0, 0);
            }
        }
        lrun += __shfl_xor(lrun, 32); const float inv = 1.0f / lrun;
        bf16* op = XB + tok * 1024 + 512 + hh * 64 + 4 * hi;
#pragma unroll
        for (int g4 = 0; g4 < 4; ++g4) { u32x2 w0, w1; w0.x = pk2(o0[4 * g4] * inv, o0[4 * g4 + 1] * inv); w0.y = pk2(o0[4 * g4 + 2] * inv, o0[4 * g4 + 3] * inv);
            w1.x = pk2(o1[4 * g4] * inv, o1[4 * g4 + 1] * inv); w1.y = pk2(o1[4 * g4 + 2] * inv, o1[4 * g4 + 3] * inv);
            *(u32x2*)(op + 8 * g4) = w0; *(u32x2*)(op + 32 + 8 * g4) = w1; }
    }
}

__device__ __forceinline__ void ph_xatt(Frame& F) {
    const bf16* XQ = WSP(bf16, AR_XQ); const bf16* XK = WSP(bf16, WS_XK); const bf16* XVT = WSP(bf16, WS_XVT); bf16* XO = WSP(bf16, AR_XO);
    const int lane = F.lane, r32 = lane & 31, hi = lane >> 5, wave = F.wave;
    for (int u = blockIdx.x; u < 256; u += F.G) {
        const int b = u >> 5, hx = (u >> 3) & 3, qt = u & 7;
        const size_t tok = (size_t)b * 2048 + qt * 256 + wave * 32 + r32;
        const bf16* Qp = XQ + tok * 1024 + hx * 256 + 8 * hi;
        const bf16* Kb = XK + (size_t)(b * 256 + r32) * 1024 + hx * 256 + 8 * hi;
        const bf16* Vb = XVT + ((size_t)(b * 4 + hx) * 256 + r32) * 256 + 8 * hi;
        float mrun = -INFINITY, lrun = 0.f; f32x16 o[8];
#pragma unroll
        for (int dt = 0; dt < 8; ++dt)
#pragma unroll
            for (int i = 0; i < 16; ++i) o[dt][i] = 0.f;
        for (int kt = 0; kt < 8; ++kt) { const int k0 = kt * 32;
            f32x16 sc;
#pragma unroll
            for (int i = 0; i < 16; ++i) sc[i] = 0.f;
#pragma unroll
            for (int s = 0; s < 16; ++s) { const bf16x8 kf = *(const bf16x8*)(Kb + (size_t)k0 * 1024 + 16 * s), qf = *(const bf16x8*)(Qp + 16 * s);
                sc = __builtin_amdgcn_mfma_f32_32x32x16_bf16(kf, qf, sc, 0, 0, 0); }
            float mx = sc[0];
#pragma unroll
            for (int r = 1; r < 16; ++r) mx = fmaxf(mx, sc[r]);
            mx = fmaxf(mx, __shfl_xor(mx, 32));
            const float mnew = fmaxf(mrun, mx), alpha = __builtin_amdgcn_exp2f(mrun - mnew);
            float ps = 0.f;
#pragma unroll
            for (int r = 0; r < 16; ++r) { const float p = __builtin_amdgcn_exp2f(sc[r] - mnew); sc[r] = p; ps += p; }
            lrun = lrun * alpha + ps; mrun = mnew;
            const bf16x8 pf0 = pack_bf16x8(sc[0], sc[1], sc[2], sc[3], sc[4], sc[5], sc[6], sc[7]), pf1 = pack_bf16x8(sc[8], sc[9], sc[10], sc[11], sc[12], sc[13], sc[14], sc[15]);
#pragma unroll
            for (int dt = 0; dt < 8; ++dt) {
#pragma unroll
                for (int i = 0; i < 16; ++i) o[dt][i] *= alpha;
                const bf16x8 v0 = *(const bf16x8*)(Vb + (size_t)dt * 32 * 256 + k0), v1 = *(const bf16x8*)(Vb + (size_t)dt * 32 * 256 + k0 + 16);
                o[dt] = __builtin_amdgcn_mfma_f32_32x32x16_bf16(v0, pf0, o[dt], 0, 0, 0); o[dt] = __builtin_amdgcn_mfma_f32_32x32x16_bf16(v1, pf1, o[dt], 0, 0, 0); }
        }
        lrun += __shfl_xor(lrun, 32); const float inv = 1.0f / lrun;
        bf16* op = XO + tok * 1024 + hx * 256 + 4 * hi;
#pragma unroll
        for (int dt = 0; dt < 8; ++dt)
#pragma unroll
            for (int g4 = 0; g4 < 4; ++g4) { u32x2 w; w.x = pk2(o[dt][4 * g4] * inv, o[dt][4 * g4 + 1] * inv); w.y = pk2(o[dt][4 * g4 + 2] * inv, o[dt][4 * g4 + 3] * inv);
                *(u32x2*)(op + 32 * dt + 8 * g4) = w; }
    }
}

__device__ __forceinline__ void ph_prep(Frame& F, int l) {
    constexpr int LROW = 528;
    LAS unsigned char* lat = F.lds;
    const bf16* PR = WSP(bf16, AR_PR); bf16* SCANIN = WSP(bf16, AR_SCANIN); bf16* XB = WSP(bf16, WS_XB); float* BONUS = WSP(float, WS_BONUS);
    const bf16* WUPT = (const bf16*)(F.ws + WS_W + W_WUPT); const bf16* AUPT = (const bf16*)(F.ws + WS_W + W_AUPT); const bf16* GUPT = (const bf16*)(F.ws + WS_W + W_GUPT);
    const int h = F.wave, lane = F.lane, r32 = lane & 31, hi = lane >> 5;
    const float* mu = FIN(I_MU) + l * RPROJ; const float* w0p = FIN(I_W0) + l * RW; const float* a0p = FIN(I_A0) + l * RW; const float* kkp = FIN(I_KK) + l * RW; const float* kap = FIN(I_KA) + l * RW; const float* rkp = FIN(I_RK) + l * RW;
    for (int task = blockIdx.x; task < M / 32; task += F.G) { const int t0 = task * 32;
        __syncthreads();
        { const int tt = F.tid >> 4, l16 = (F.tid & 15) * 16, t = t0 + tt; const bf16* pc = PR + (size_t)t * RPROJ + 1536 + l16;
          u32x4 cur[2], prv[2]; cur[0] = *(const u32x4*)pc; cur[1] = *(const u32x4*)(pc + 8); prv[0] = (u32x4){0u, 0u, 0u, 0u}; prv[1] = prv[0];
          if (t & 2047) { prv[0] = *(const u32x4*)(pc - RPROJ); prv[1] = *(const u32x4*)(pc - RPROJ + 8); }
          u32x4 ow[2];
#pragma unroll
          for (int hh = 0; hh < 2; ++hh) { const f32x4 m0 = *(const f32x4*)(mu + 1536 + l16 + 8 * hh), m1 = *(const f32x4*)(mu + 1536 + l16 + 8 * hh + 4); float xv[8];
#pragma unroll
              for (int i = 0; i < 4; ++i) { const unsigned cw = cur[hh][i], pw = prv[hh][i]; const float p0 = bf2f(cw & 0xffffu), p1 = bf2f(cw >> 16), q0 = bf2f(pw & 0xffffu), q1 = bf2f(pw >> 16);
                  const float ma = i < 2 ? m0[2 * i] : m1[2 * i - 4], mb = i < 2 ? m0[2 * i + 1] : m1[2 * i - 3];
                  xv[2 * i] = p0 + (q0 - p0) * ma; xv[2 * i + 1] = p1 + (q1 - p1) * mb; }
#pragma unroll
              for (int i = 0; i < 8; ++i) { if (l16 < 64) xv[i] = 1.0f - 2.0f * __builtin_amdgcn_rcpf(1.0f + __expf(2.0f * xv[i])); else if (l16 >= 128) xv[i] = sigmoidf_(xv[i]); }
              ow[hh] = (u32x4){pk2(xv[0], xv[1]), pk2(xv[2], xv[3]), pk2(xv[4], xv[5]), pk2(xv[6], xv[7])}; }
          *(LAS u32x4*)(lat + tt * LROW + l16 * 2) = ow[0]; *(LAS u32x4*)(lat + tt * LROW + l16 * 2 + 16) = ow[1]; }
        __syncthreads();
        const int t = t0 + r32, bb = t >> 11, tp = t & 2047; const bool hasprev = tp != 0;
        const bf16* prow = PR + (size_t)t * RPROJ; bf16* so = SCANIN + ((size_t)(bb * 8 + h) * 2048 + tp) * 384;
        float n2 = 0.f, bon = 0.f;
#pragma unroll
        for (int q = 0; q < 8; ++q) { const int c4 = h * 64 + 8 * q + 4 * hi;
            const u32x2 kc = *(const u32x2*)(prow + 512 + c4); u32x2 kp = {0u, 0u}; if (hasprev) kp = *(const u32x2*)(prow + 512 + c4 - RPROJ);
            const f32x4 mk = *(const f32x4*)(mu + 512 + c4), kkc = *(const f32x4*)(kkp + c4);
#pragma unroll
            for (int i = 0; i < 4; ++i) { const unsigned sh = (i & 1) * 16; float k = bf2f((kc[i >> 1] >> sh) & 0xffffu); const float kq = bf2f((kp[i >> 1] >> sh) & 0xffffu);
                k += (kq - k) * mk[i]; const float kk = k * kkc[i]; n2 += kk * kk; } }
        n2 += __shfl_xor(n2, 32);
        const float inv = 1.0f / fmaxf(sqrtf(n2), 1e-12f);
        asm volatile("" ::: "memory");
#pragma unroll 1
        for (int ct = 0; ct < 2; ++ct) { const int cb = h * 64 + 32 * ct;
            f32x16 aw, aa, ag;
#pragma unroll
            for (int i = 0; i < 16; ++i) { aw[i] = 0.f; aa[i] = 0.f; ag[i] = 0.f; }
            const LAS unsigned char* lb = lat + r32 * LROW + 16 * hi;
#pragma unroll
            for (int s = 0; s < 4; ++s) { const bf16x8 wf = *(const bf16x8*)(WUPT + (size_t)(cb + r32) * 64 + 16 * s + 8 * hi), af = *(const bf16x8*)(AUPT + (size_t)(cb + r32) * 64 + 16 * s + 8 * hi);
                const bf16x8 lw = *(const LAS bf16x8*)(lb + 32 * s), la = *(const LAS bf16x8*)(lb + 128 + 32 * s);
                aw = __builtin_amdgcn_mfma_f32_32x32x16_bf16(wf, lw, aw, 0, 0, 0); aa = __builtin_amdgcn_mfma_f32_32x32x16_bf16(af, la, aa, 0, 0, 0); }
#pragma unroll
            for (int s = 0; s < 8; ++s) { const bf16x8 gf = *(const bf16x8*)(GUPT + (size_t)(cb + r32) * 128 + 16 * s + 8 * hi); const bf16x8 lg = *(const LAS bf16x8*)(lb + 256 + 32 * s);
                ag = __builtin_amdgcn_mfma_f32_32x32x16_bf16(gf, lg, ag, 0, 0, 0); }
#pragma unroll
            for (int g = 0; g < 4; ++g) { const int c4 = cb + 8 * g + 4 * hi;
                asm volatile("" ::: "memory");
                const u32x2 rc = *(const u32x2*)(prow + c4), kc = *(const u32x2*)(prow + 512 + c4), vc = *(const u32x2*)(prow + 1024 + c4);
                u32x2 rp = {0u, 0u}, kp = {0u, 0u}, vp = {0u, 0u};
                if (hasprev) { rp = *(const u32x2*)(prow + c4 - RPROJ); kp = *(const u32x2*)(prow + 512 + c4 - RPROJ); vp = *(const u32x2*)(prow + 1024 + c4 - RPROJ); }
                const f32x4 mr = *(const f32x4*)(mu + c4), mk = *(const f32x4*)(mu + 512 + c4), mv = *(const f32x4*)(mu + 1024 + c4);
                const f32x4 w0v = *(const f32x4*)(w0p + c4), a0v = *(const f32x4*)(a0p + c4), kkc = *(const f32x4*)(kkp + c4), kac = *(const f32x4*)(kap + c4), rkc = *(const f32x4*)(rkp + c4);
                float ro[4], ko[4], vo[4], ldo[4], go[4], nk[4], bo[4];
#pragma unroll
                for (int i = 0; i < 4; ++i) { const unsigned sh = (i & 1) * 16;
                    float r = bf2f((rc[i >> 1] >> sh) & 0xffffu), k = bf2f((kc[i >> 1] >> sh) & 0xffffu), v = bf2f((vc[i >> 1] >> sh) & 0xffffu);
                    const float rq = bf2f((rp[i >> 1] >> sh) & 0xffffu), kq = bf2f((kp[i >> 1] >> sh) & 0xffffu), vq = bf2f((vp[i >> 1] >> sh) & 0xffffu);
                    r += (rq - r) * mr[i]; k += (kq - k) * mk[i]; v += (vq - v) * mv[i];
                    const float wv = w0v[i] + aw[4 * g + i], xs = -wv, sp = xs > 20.f ? xs : __logf(1.0f + __expf(xs)), ld = -__expf(-sp - 0.5f);
                    const float a = sigmoidf_(a0v[i] + aa[4 * g + i]);
                    const float kn = k * kkc[i] * inv, kt = k * (1.0f + (a - 1.0f) * kac[i]);
                    bon += r * kt * rkc[i];
                    ro[i] = r; ko[i] = kt; vo[i] = v; ldo[i] = ld; go[i] = ag[4 * g + i]; nk[i] = -kn; bo[i] = kn * a; }
                const int co = 32 * ct + 8 * g + 4 * hi;
                *(u32x2*)(so + co) = (u32x2){pk2(nk[0], nk[1]), pk2(nk[2], nk[3])}; *(u32x2*)(so + 64 + co) = (u32x2){pk2(ldo[0], ldo[1]), pk2(ldo[2], ldo[3])};
                *(u32x2*)(so + 128 + co) = (u32x2){pk2(bo[0], bo[1]), pk2(bo[2], bo[3])}; *(u32x2*)(so + 192 + co) = (u32x2){pk2(ko[0], ko[1]), pk2(ko[2], ko[3])};
                *(u32x2*)(so + 256 + co) = (u32x2){pk2(ro[0], ro[1]), pk2(ro[2], ro[3])}; *(u32x2*)(so + 320 + co) = (u32x2){pk2(vo[0], vo[1]), pk2(vo[2], vo[3])};
                *(u32x2*)(XB + (size_t)t * 1024 + c4) = (u32x2){pk2(go[0], go[1]), pk2(go[2], go[3])}; }
        }
        bon += __shfl_xor(bon, 32);
        if (hi == 0) BONUS[(size_t)t * 8 + h] = bon;
    }
}

template <int R, int NCH, bool KINDP>
__device__ __forceinline__ void scan_stream(Frame& F, LAS float* ring, int bh, int ch, int rg, int lis) {
    typedef float f32x2 __attribute__((ext_vector_type(2)));
    constexpr int CLEN = SEQ / NCH, NHALF = CLEN / 8;
    const int lane = F.lane, js = lane & 3, q = lane >> 2, row0 = rg * 16 * R + q * R, tbase = ch * CLEN;
    const bf16* src = WSP(bf16, AR_SCANIN) + ((size_t)bh * 2048 + tbase) * 384;
    float* YL = WSP(float, AR_YLOC) + ((size_t)bh * 2048 + tbase) * 64; bf16* ZZ = WSP(bf16, AR_Z) + ((size_t)bh * 2048 + tbase) * 64;
    f32x2 S[R][8];
#pragma unroll
    for (int rr = 0; rr < R; ++rr)
#pragma unroll
        for (int k = 0; k < 8; ++k) { S[rr][k].x = (KINDP && (row0 + rr) == 16 * js + 2 * k) ? 1.f : 0.f; S[rr][k].y = (KINDP && (row0 + rr) == 16 * js + 2 * k + 1) ? 1.f : 0.f; }
    u32x4 pre[2];
#pragma unroll
    for (int k = 0; k < 2; ++k) { const int ci = lis + k * 256; if (ci < 384) pre[k] = *(const u32x4*)(src + (size_t)ci * 8); }
#pragma unroll
    for (int k = 0; k < 2; ++k) { const int ci = lis + k * 256; if (ci < 384) { const bool isld = ((ci % 48) >> 3) == 1; float f[8];
#pragma unroll
            for (int i = 0; i < 4; ++i) { f[2 * i] = bf2f(pre[k][i] & 0xffffu); f[2 * i + 1] = bf2f(pre[k][i] >> 16); }
            if (isld) {
#pragma unroll
                for (int i = 0; i < 8; ++i) f[i] = __expf(f[i]); }
            *(LAS f32x4*)(ring + ci * 8) = (f32x4){f[0], f[1], f[2], f[3]}; *(LAS f32x4*)(ring + ci * 8 + 4) = (f32x4){f[4], f[5], f[6], f[7]}; } }
    __syncthreads();
    for (int hf = 0; hf < NHALF; ++hf) {
        const bool more = hf + 1 < NHALF;
        if (more) {
#pragma unroll
            for (int k = 0; k < 2; ++k) { const int ci = lis + k * 256; if (ci < 384) pre[k] = *(const u32x4*)(src + (size_t)(hf + 1) * 3072 + (size_t)ci * 8); } }
#pragma unroll 2
        for (int st = 0; st < 8; ++st) {
            const LAS float* sp = ring + ((hf & 1) * 8 + st) * 384 + 16 * js;
            f32x2 nn[8], ww[8], bb[8], kk[8], rr2[8];
#pragma unroll
            for (int i = 0; i < 4; ++i) { const f32x4 a = *(const LAS f32x4*)(sp + 4 * i); nn[2 * i] = (f32x2){a[0], a[1]}; nn[2 * i + 1] = (f32x2){a[2], a[3]}; }
#pragma unroll
            for (int i = 0; i < 4; ++i) { const f32x4 a = *(const LAS f32x4*)(sp + 64 + 4 * i); ww[2 * i] = (f32x2){a[0], a[1]}; ww[2 * i + 1] = (f32x2){a[2], a[3]}; }
#pragma unroll
            for (int i = 0; i < 4; ++i) { const f32x4 a = *(const LAS f32x4*)(sp + 128 + 4 * i); bb[2 * i] = (f32x2){a[0], a[1]}; bb[2 * i + 1] = (f32x2){a[2], a[3]}; }
            if (!KINDP) {
#pragma unroll
                for (int i = 0; i < 4; ++i) { const f32x4 a = *(const LAS f32x4*)(sp + 192 + 4 * i); kk[2 * i] = (f32x2){a[0], a[1]}; kk[2 * i + 1] = (f32x2){a[2], a[3]}; } }
#pragma unroll
            for (int i = 0; i < 4; ++i) { const f32x4 a = *(const LAS f32x4*)(sp + 256 + 4 * i); rr2[2 * i] = (f32x2){a[0], a[1]}; rr2[2 * i + 1] = (f32x2){a[2], a[3]}; }
            float vv[R];
            if (!KINDP) {
#pragma unroll
                for (int rr = 0; rr < R; ++rr) vv[rr] = ring[((hf & 1) * 8 + st) * 384 + 320 + row0 + rr]; }
            float sa[R];
#pragma unroll
            for (int rr = 0; rr < R; ++rr) { f32x2 p0 = S[rr][0] * nn[0], p1 = S[rr][1] * nn[1];
#pragma unroll
                for (int k = 2; k < 8; k += 2) { p0 = S[rr][k] * nn[k] + p0; p1 = S[rr][k + 1] * nn[k + 1] + p1; }
                p0 = p0 + p1; sa[rr] = quad_sum(p0.x + p0.y); }
            float y[R];
#pragma unroll
            for (int rr = 0; rr < R; ++rr) { const f32x2 sa2 = (f32x2){sa[rr], sa[rr]}; f32x2 p0 = (f32x2){0.f, 0.f}, p1 = (f32x2){0.f, 0.f};
#pragma unroll
                for (int k = 0; k < 8; k += 2) {
                    f32x2 t0 = S[rr][k] * ww[k], t1 = S[rr][k + 1] * ww[k + 1];
                    t0 = sa2 * bb[k] + t0; t1 = sa2 * bb[k + 1] + t1;
                    if (!KINDP) { const f32x2 v2 = (f32x2){vv[rr], vv[rr]}; t0 = v2 * kk[k] + t0; t1 = v2 * kk[k + 1] + t1; }
                    S[rr][k] = t0; S[rr][k + 1] = t1; p0 = t0 * rr2[k] + p0; p1 = t1 * rr2[k + 1] + p1; }
                p0 = p0 + p1; y[rr] = quad_sum(p0.x + p0.y); }
            if (js == 0) { const int t = hf * 8 + st;
                if (R == 2) { if (KINDP) *(unsigned*)(ZZ + (size_t)t * 64 + row0) = pk2(y[0], y[R - 1]); else *(f32x2*)(YL + (size_t)t * 64 + row0) = (f32x2){y[0], y[R - 1]}; }
                else {
#pragma unroll
                    for (int rr = 0; rr < R; ++rr) { if (KINDP) ZZ[(size_t)t * 64 + row0 + rr] = (bf16)f2bf(y[rr]); else YL[(size_t)t * 64 + row0 + rr] = y[rr]; } } }
        }
        if (more) {
#pragma unroll
            for (int k = 0; k < 2; ++k) { const int ci = lis + k * 256; if (ci < 384) { const bool isld = ((ci % 48) >> 3) == 1; float f[8];
#pragma unroll
                    for (int i = 0; i < 4; ++i) { f[2 * i] = bf2f(pre[k][i] & 0xffffu); f[2 * i + 1] = bf2f(pre[k][i] >> 16); }
                    if (isld) {
#pragma unroll
                        for (int i = 0; i < 8; ++i) f[i] = __expf(f[i]); }
                    LAS float* dst = ring + (((hf + 1) & 1) * 8) * 384 + ci * 8;
                    *(LAS f32x4*)(dst) = (f32x4){f[0], f[1], f[2], f[3]}; *(LAS f32x4*)(dst + 4) = (f32x4){f[4], f[5], f[6], f[7]}; } } }
        __syncthreads();
    }
    if (NCH > 1) {
        float* st = WSP(float, AR_STATE) + ((size_t)(bh * NCH + ch) * 2 + (KINDP ? 0 : 1)) * 4096;
#pragma unroll
        for (int rr = 0; rr < R; ++rr)
#pragma unroll
            for (int i = 0; i < 4; ++i) *(f32x4*)(st + (size_t)(row0 + rr) * 64 + 16 * js + 4 * i) = (f32x4){S[rr][2 * i].x, S[rr][2 * i].y, S[rr][2 * i + 1].x, S[rr][2 * i + 1].y};
    }
}
template <int R, int NCH>
__device__ __forceinline__ void ph_scan(Frame& F) {
    constexpr int KINDS = NCH > 1 ? 2 : 1, RG = 4 / R, WPS = KINDS * RG, SPW = NWAVES / WPS, NSTREAM = BATCH * NH * NCH;
    static_assert(WPS == 4, "staging assumes 4 waves per stream");
    const int sl = F.wave / WPS, role = F.wave % WPS, kind = role / RG, rg = role % RG, lis = role * 64 + F.lane;
    LAS float* ring = (LAS float*)F.lds + sl * (16 * 384);
    for (int it = blockIdx.x; it * SPW < NSTREAM; it += F.G) {
        const int sid = it * SPW + sl, bh = sid / NCH, ch = sid % NCH;
        __syncthreads();
        if (kind == 0) scan_stream<R, NCH, false>(F, ring, bh, ch, rg, lis); else scan_stream<R, NCH, true>(F, ring, bh, ch, rg, lis);
    }
}

template <int NCH>
__device__ __forceinline__ void ph_fix(Frame& F) {
    typedef float f32x2 __attribute__((ext_vector_type(2)));
    LAS float* cur = (LAS float*)F.lds;
    for (int u = blockIdx.x; u < 256; u += F.G) { const int bh = u >> 2, rgx = u & 3, i = F.tid >> 5, j2 = (F.tid & 31) * 2, row = rgx * 16 + i;
        float* base = WSP(float, AR_STATE) + (size_t)bh * NCH * 2 * 4096;
        __syncthreads();
        { const f32x2 v = *(const f32x2*)(base + 4096 + row * 64 + j2); cur[i * 64 + j2] = v.x; cur[i * 64 + j2 + 1] = v.y; }
        __syncthreads();
        for (int c = 1; c < NCH - 1; ++c) { const float* P = base + (size_t)(c * 2) * 4096; float* SL = base + (size_t)(c * 2 + 1) * 4096;
            f32x2 acc = *(const f32x2*)(SL + row * 64 + j2);
#pragma unroll
            for (int ii = 0; ii < 64; ++ii) { const float sv = cur[i * 64 + ii]; const f32x2 p = *(const f32x2*)(P + ii * 64 + j2); acc.x += sv * p.x; acc.y += sv * p.y; }
            __syncthreads();
            cur[i * 64 + j2] = acc.x; cur[i * 64 + j2 + 1] = acc.y; *(f32x2*)(SL + row * 64 + j2) = acc;
            __syncthreads(); }
    }
}

template <int NCH>
__device__ __forceinline__ void ph_post(Frame& F, int l) {
    constexpr int CLEN = SEQ / NCH;
    const float* YL = WSP(float, AR_YLOC); const bf16* SCANIN = WSP(bf16, AR_SCANIN); bf16* XB = WSP(bf16, WS_XB); const float* BONUS = WSP(float, WS_BONUS); const bf16* ZZ = WSP(bf16, AR_Z);
    LAS float* zt = (LAS float*)F.lds;
    const int c = F.tid, h = F.wave, j = F.lane; const float lng = FIN(I_LNG)[l * RW + c], lnb = FIN(I_LNB)[l * RW + c];
    for (int grp = blockIdx.x; grp < M / 64; grp += F.G) { const int t0g = grp * 64, bb = t0g >> 11, ch = (t0g & 2047) / CLEN, bh = bb * 8 + h; const bool corr = NCH > 1 && ch > 0;
        float st[64];
        if (corr) { const float* sp = WSP(float, AR_STATE) + ((size_t)(bh * NCH + ch - 1) * 2 + 1) * 4096 + j * 64;
#pragma unroll
            for (int i4 = 0; i4 < 16; ++i4) { const f32x4 v = *(const f32x4*)(sp + 4 * i4); st[4 * i4] = v[0]; st[4 * i4 + 1] = v[1]; st[4 * i4 + 2] = v[2]; st[4 * i4 + 3] = v[3]; } }
        for (int ti = 0; ti < 4; ++ti) { const int t0 = t0g + 16 * ti;
            if (corr) { __syncthreads();
#pragma unroll 4
                for (int tt = 0; tt < 16; ++tt) zt[tt * 512 + c] = bf2f(ZZ[((size_t)bh * 2048 + ((t0 + tt) & 2047)) * 64 + j]);
                __syncthreads(); }
#pragma unroll 2
            for (int tt = 0; tt < 16; ++tt) { const int t = t0 + tt, tp = t & 2047;
                float y = YL[((size_t)bh * 2048 + tp) * 64 + j];
                if (corr) { const LAS float* zp = zt + tt * 512 + h * 64; float p0 = 0.f, p1 = 0.f, p2 = 0.f, p3 = 0.f;
#pragma unroll
                    for (int j4 = 0; j4 < 16; ++j4) { const f32x4 zz = *(const LAS f32x4*)(zp + 4 * j4); p0 += st[4 * j4] * zz[0]; p1 += st[4 * j4 + 1] * zz[1]; p2 += st[4 * j4 + 2] * zz[2]; p3 += st[4 * j4 + 3] * zz[3]; }
                    y += (p0 + p1) + (p2 + p3); }
                const float mean = wave_sum(y) * (1.0f / 64.0f), d = y - mean, var = wave_sum(d * d) * (1.0f / 64.0f);
                const float yn = d * __builtin_amdgcn_rsqf(var + LNX_EPS) * lng + lnb;
                const float v = bf2f(SCANIN[((size_t)bh * 2048 + tp) * 384 + 320 + j]), bon = BONUS[(size_t)t * 8 + h], g = bf2f(XB[(size_t)t * 1024 + c]);
                XB[(size_t)t * 1024 + c] = (bf16)f2bf((yn + bon * v) * g); }
        }
    }
}

__device__ __forceinline__ void ph_final(Frame& F) {
    const int gw = F.vcu * NWAVES + F.wave, NGW = F.G * NWAVES; const float* ssq = WSP(float, WS_SSQ); const float* g = FIN(I_FING);
    f32x4 gv[4];
#pragma unroll
    for (int j = 0; j < 4; ++j) gv[j] = ((const f32x4*)g)[F.lane + 64 * j];
    for (int r = gw; r < M; r += NGW) { const float rs = pg8::row_rstd16(ssq, r); f32x4* xr = (f32x4*)(F.out + (size_t)r * DM) + F.lane;
#pragma unroll
        for (int j = 0; j < 4; ++j) { const f32x4 v = xr[64 * j]; xr[64 * j] = v * rs * gv[j]; } }
}

constexpr int PH_INIT = 0, PH_PER_LAYER = 16, PH_FINAL = 1 + DEPTH * PH_PER_LAYER, N_PHASES = PH_FINAL + 1;
enum { K_CONV = 0, K_KV, K_F1UP, K_F1DN, K_MIXIN, K_MOBA, K_PREP, K_SCAN, K_FIX, K_POST, K_MIXOUT, K_XQ, K_XATT, K_XO, K_F2UP, K_F2DN };

#ifdef ONLY
#define PH_ON(k) ((k) == (ONLY))
#else
#define PH_ON(k) true
#endif
__global__ void __launch_bounds__(NWAVES * 64, 2) fwd(Args args) {
    extern __shared__ __attribute__((aligned(16))) unsigned char lds[];
    Frame F;
    F.lds = (LAS unsigned char*)lds; F.MISC = (volatile LAS unsigned*)(F.lds + MISC_OFF);
    F.tid = threadIdx.x; F.lane = F.tid & 63; F.wave = __builtin_amdgcn_readfirstlane(F.tid >> 6);
    F.G = gridDim.x; { const int bx = blockIdx.x; F.vcu = (F.G % 8 == 0) ? (bx % 8) * (F.G / 8) + bx / 8 : bx; }
    F.out = args.out; F.ws = args.ws; F.ctl = (gu32*)(args.ws + WS_CTL);
    F.ka = (const __attribute__((address_space(4))) Args*)(uintptr_t)__builtin_amdgcn_kernarg_segment_ptr();
    for (int u = F.tid; u < (LDS_BYTES - LDSCTL_OFF) / 4; u += NWAVES * 64) ((LAS unsigned*)(F.lds + LDSCTL_OFF))[u] = 0u;
    __syncthreads();
    const bool multi = args.ph_hi - args.ph_lo > 1;
    XcdBarrier bar; bar.bar = (unsigned*)(F.ctl + 4096); bar.x = 0; bar.st = nullptr;
    if (multi) bar = xcd_barrier_post((unsigned*)(F.ctl + 4096), F.MISC + 8);
#ifndef REP_AT
#define REP_AT 1000
#endif
    for (int pi = args.ph_lo; pi < args.ph_hi + (REP_AT < 1000 ? 1 : 0); ++pi) { const int ph = pi - (pi > REP_AT ? 1 : 0);
        { uintptr_t kp = (uintptr_t)__builtin_amdgcn_kernarg_segment_ptr(); asm volatile("" : "+s"(kp)); F.ka = (const __attribute__((address_space(4))) Args*)kp; }
        { int t_ = threadIdx.x; asm volatile("" : "+v"(t_)); F.tid = t_; F.lane = t_ & 63; F.wave = __builtin_amdgcn_readfirstlane(t_ >> 6); }
        unsigned char* wb = F.ws + WS_W;
        if (ph == PH_INIT) { if (PH_ON(100)) ph_init(F); }
        else if (ph == PH_FINAL) { if (PH_ON(101)) ph_final(F); }
        else { const int l = (ph - 1) / PH_PER_LAYER, k = (ph - 1) % PH_PER_LAYER;
            const float* xin = (l == 0) ? FIN(I_X) : (const float*)F.out;
            switch (k) {
            case K_CONV: if (!PH_ON(K_CONV)) break; ph_conv(F, l); break;
            case K_KV: if (!PH_ON(K_KV)) break; { pg8::Gemm g{WSP(bf16, WS_MEMB), (const bf16*)(wb + W_WKV), MM, 2 * DM, DM}; pg8::StaticOrder S; S.init(MM, 2 * DM, F.G, (int)blockIdx.x);
                pg8::EpiKV E{F.ws}; pg8::gemm_phase<pg8::EpiKV, pg8::StaticOrder, true, true>(F.lds, g, S, E); } break;
            case K_F1UP: case K_F2UP: if (!PH_ON(K_F1UP)) break; { pg8::Gemm g{WSP(bf16, WS_XB), (const bf16*)(wb + (k == K_F1UP ? W_F1IN : W_F2IN)), M, 2 * DFF, DM}; pg8::StaticOrder S; S.init(M, 2 * DFF, F.G, (int)blockIdx.x);
                pg8::EpiSwiGLU E{F.ws}; pg8::gemm_phase<pg8::EpiSwiGLU, pg8::StaticOrder, true, true>(F.lds, g, S, E); } break;
            case K_F1DN: case K_F2DN: if (!PH_ON(K_F1DN)) break; { pg8::Gemm g{WSP(bf16, AR_H), (const bf16*)(wb + (k == K_F1DN ? W_F1OUT : W_F2OUT)), M, DM, DFF}; pg8::StaticOrder S; S.init(M, DM, F.G, (int)blockIdx.x);
                pg8::EpiResid E{k == K_F1DN ? xin : (const float*)F.out, F.out, F.ws, WS_XB, 0.5f}; pg8::gemm_phase<pg8::EpiResid, pg8::StaticOrder, true, true>(F.lds, g, S, E); } break;
            case K_MIXIN: if (!PH_ON(K_MIXIN)) break; { pg8::Gemm g{WSP(bf16, WS_XB), (const bf16*)(wb + W_MIXIN), M, DPROJ, DM}; pg8::StaticOrder S; S.init(M, DPROJ, F.G, (int)blockIdx.x);
                pg8::EpiMixIn E{F.ws}; pg8::gemm_phase<pg8::EpiMixIn, pg8::StaticOrder, true, true>(F.lds, g, S, E); } break;
            case K_MOBA: if (!PH_ON(K_MOBA)) break; ph_moba(F); break;
            case K_PREP: if (!PH_ON(K_PREP)) break; ph_prep(F, l); break;
            case K_SCAN: if (!PH_ON(K_SCAN)) break; ph_scan<SCAN_R, SCAN_NCH>(F); break;
            case K_FIX: if (!PH_ON(K_FIX)) break; if (SCAN_NCH > 1) ph_fix<SCAN_NCH>(F); break;
            case K_POST: if (!PH_ON(K_POST)) break; ph_post<SCAN_NCH>(F, l); break;
            case K_MIXOUT: if (!PH_ON(K_MIXOUT)) break; { pg8::Gemm g{WSP(bf16, WS_XB), (const bf16*)(wb + W_MIXOUT), M, DM, DM}; pg8::StaticOrder S; S.init(M, DM, F.G, (int)blockIdx.x);
                pg8::EpiResid E{F.out, F.out, F.ws, AR_XB2, 1.0f}; pg8::gemm_phase<pg8::EpiResid, pg8::StaticOrder, true, true>(F.lds, g, S, E); } break;
            case K_XQ: if (!PH_ON(K_XQ)) break; { pg8::Gemm g{WSP(bf16, AR_XB2), (const bf16*)(wb + W_WQ), M, DM, DM}; pg8::StaticOrder S; S.init(M, DM, F.G, (int)blockIdx.x);
                pg8::EpiXQ E{F.ws}; pg8::gemm_phase<pg8::EpiXQ, pg8::StaticOrder, true, true>(F.lds, g, S, E); } break;
            case K_XATT: if (!PH_ON(K_XATT)) break; ph_xatt(F); break;
            case K_XO: if (!PH_ON(K_XO)) break; { pg8::Gemm g{WSP(bf16, AR_XO), (const bf16*)(wb + W_WO), M, DM, DM}; pg8::StaticOrder S; S.init(M, DM, F.G, (int)blockIdx.x);
                pg8::EpiResid E{F.out, F.out, F.ws, WS_XB, 1.0f}; pg8::gemm_phase<pg8::EpiResid, pg8::StaticOrder, true, true>(F.lds, g, S, E); } break;
            default: break;
            }
        }
        if (pi + 1 < args.ph_hi + (REP_AT < 1000 ? 1 : 0)) {
            const bool noop = (ph != PH_INIT && ph != PH_FINAL && ((ph - 1) % PH_PER_LAYER) == K_FIX && SCAN_NCH == 1);
            if (!noop) { if (ph == PH_INIT) cooperative_groups::this_grid().sync(); else xcd_barrier(bar); }
        }
    }
}

extern "C" void kernel_launch(void* const* d_in, const int* in_sizes, int n_in, void* d_out, int out_size, void* d_ws, size_t ws_size, hipStream_t stream) {
    static int grid = 0;
    if (grid == 0) {
        if (n_in != N_IN || in_sizes[0] != M * DM || out_size != M * DM || ws_size < WS_END) { fprintf(stderr, "kernel_launch: unexpected problem (n_in %d, in0 %d, out %d, ws %zu < %zu); nothing launched\n", n_in, n_in > 0 ? in_sizes[0] : -1, out_size, ws_size, (size_t)WS_END); grid = -1; return; }
        int dev = 0, cus = 0;
        if (hipGetDevice(&dev) != hipSuccess || hipDeviceGetAttribute(&cus, hipDeviceAttributeMultiprocessorCount, dev) != hipSuccess) { grid = -1; return; }
        if (hipFuncSetAttribute((const void*)fwd, hipFuncAttributeMaxDynamicSharedMemorySize, LDS_BYTES) != hipSuccess) { fprintf(stderr, "kernel_launch: hipFuncSetAttribute failed\n"); grid = -1; return; }
        int per_cu = 0;
        if (hipOccupancyMaxActiveBlocksPerMultiprocessor(&per_cu, (const void*)fwd, NWAVES * 64, LDS_BYTES) != hipSuccess || per_cu < 1) { fprintf(stderr, "kernel_launch: occupancy query reports %d workgroups per CU; nothing launched\n", per_cu); grid = -1; return; }
        grid = cus;
    }
    if (grid < 0) return;
    (void)hipMemsetAsync((char*)d_ws + WS_CTL, 0, CTL_ZERO_BYTES, stream);
    Args a{};
    for (int i = 0; i < N_IN; ++i) a.in[i] = (const float*)d_in[i];
    a.out = (float*)d_out; a.ws = (unsigned char*)d_ws;
    a.ph_lo = 0; a.ph_hi = N_PHASES;
    void* kargs[] = {&a};
    const hipError_t e = hipLaunchCooperativeKernel((const void*)fwd, dim3(grid), dim3(NWAVES * 64), kargs, LDS_BYTES, stream);
    if (e != hipSuccess) fprintf(stderr, "kernel_launch: cooperative launch failed: %s (grid %d)\n", hipGetErrorString(e), grid);
}
```

```cpp
#include <hip/hip_runtime.h>
#include <hip/hip_cooperative_groups.h>
#include <cstdio>
#include <cstdint>

constexpr int BATCH = 8, SEQ = 2048, DM = 1024, DEPTH = 2, M = BATCH * SEQ;
constexpr int RW = 512, NH = 8, HD = 64;
constexpr int RPROJ = 1792, DPROJ = 3328;
constexpr int DFF = 2816;
constexpr int MEMLEN = 256, XH = 4, XHD = 256, MM = BATCH * MEMLEN;
constexpr int MBLK = 256, NBLK = SEQ / MBLK;
constexpr float NORM_EPS = 1e-6f, LNX_EPS = 64e-5f;
constexpr float LOG2E = 1.4426950408889634f;
constexpr float MOBA_QSCALE = 0.125f * LOG2E;
constexpr float XATT_QSCALE = 0.0625f * LOG2E;

enum { I_X = 0, I_MEM, I_RELB, I_FING, I_F1G, I_F1IN, I_F1OUT, I_MIXG, I_MIXIN, I_MIXOUT, I_MU, I_W0, I_WUP, I_A0, I_AUP, I_GUP, I_KK, I_KA, I_RK, I_LNG, I_LNB,
       I_XG, I_MEMG, I_WQ, I_WKV, I_WO, I_F2G, I_F2IN, I_F2OUT, N_IN };

constexpr size_t MiB = 1u << 20;
constexpr size_t WS_CTL = 0, CTL_ZERO_BYTES = 1 * MiB;
constexpr size_t WS_BIAS = 1 * MiB;
constexpr size_t WS_MEMRS = WS_BIAS + 64 * 1024;
constexpr size_t WS_BONUS = WS_MEMRS + 64 * 1024;
constexpr size_t WS_SSQ = 2 * MiB;
constexpr size_t WS_MEMB = 3 * MiB;
constexpr size_t WS_XK = 7 * MiB, WS_XVT = 11 * MiB;
constexpr size_t WS_W = 15 * MiB;
constexpr size_t W_F1IN = 0, W_F1OUT = W_F1IN + (size_t)2 * DFF * DM * 2, W_F2IN = W_F1OUT + (size_t)DM * DFF * 2, W_F2OUT = W_F2IN + (size_t)2 * DFF * DM * 2,
                 W_MIXIN = W_F2OUT + (size_t)DM * DFF * 2, W_MIXOUT = W_MIXIN + (size_t)DPROJ * DM * 2, W_WQ = W_MIXOUT + (size_t)DM * DM * 2, W_WKV = W_WQ + (size_t)DM * DM * 2,
                 W_WO = W_WKV + (size_t)2 * DM * DM * 2, W_WUPT = W_WO + (size_t)DM * DM * 2, W_AUPT = W_WUPT + (size_t)RW * 64 * 2, W_GUPT = W_AUPT + (size_t)RW * 64 * 2, W_END = W_GUPT + (size_t)RW * 128 * 2;
static_assert(W_END <= 50 * MiB, "weights fit");
constexpr size_t WS_XB = 65 * MiB;
constexpr size_t WS_AR = 97 * MiB;
constexpr size_t AR_H = WS_AR;
constexpr size_t AR_PR = WS_AR, AR_MQ = WS_AR + 56 * MiB, AR_MK = WS_AR + 72 * MiB, AR_MVT = WS_AR + 88 * MiB;
constexpr size_t AR_SCANIN = WS_AR + 56 * MiB;
constexpr size_t AR_YLOC = WS_AR, AR_Z = WS_AR + 32 * MiB;
constexpr size_t AR_STATE = WS_AR + 152 * MiB;
constexpr size_t AR_XB2 = WS_AR, AR_XQ = WS_AR + 32 * MiB, AR_XO = WS_AR + 64 * MiB;
constexpr size_t WS_END = WS_AR + 168 * MiB;

#define GAS __attribute__((address_space(1)))
#define LAS __attribute__((address_space(3)))

namespace pg8 {
#define PG8_LAS __attribute__((address_space(3)))
typedef unsigned short bf16_t;
typedef short bf16x8 __attribute__((ext_vector_type(8)));
typedef float f32x4 __attribute__((ext_vector_type(4)));
typedef unsigned u32x4 __attribute__((ext_vector_type(4)));
constexpr int BM = 256, BK = 64, HALF = 128, HTB = HALF * BK * 2  , STAGE_BYTES = 8 * HTB, NXCD = 8, WGM = 8;

__host__ __device__ __forceinline__ int lds_byte(int r, int c) { const int st = (r >> 4) * 2 + (c >> 5), rr = r & 15, cc = c & 31, ob = rr * 64 + cc * 2; return st * 1024 + (ob ^ (((ob >> 9) & 1) << 5)); }
__host__ __device__ __forceinline__ void stage_rc(int b, int& R, int& C) { const int st = b / 1024, sb = b % 1024, swz = sb ^ (((sb >> 9) & 1) << 5); R = (st >> 1) * 16 + swz / 64; C = (st & 1) * 32 + (swz % 64) / 2; }
__host__ __device__ __forceinline__ int perm32(int rho) { const int n = rho >> 4, i = rho & 15; return 8 * (i >> 2) + 4 * n + (i & 3); }

struct Unit { int pm, pn; };
struct Gemm { const bf16_t* A; const bf16_t* Bt; int M, N, K; };

struct StaticOrder {
    int nM, nN, nwg, G, c;
    __host__ __device__ void init(int M, int N, int G_, int c_) { nM = M / BM; nN = N / BM; nwg = nM * nN; G = G_; c = c_; }
    __host__ __device__ bool next(int i, Unit& u) const {
        const long L = (long)i * G + c; if (L >= nwg) return false;
        int wgid = (int)L; { const int q = nwg / NXCD, r = nwg % NXCD, xcd = wgid % NXCD, off = wgid / NXCD; wgid = (xcd < r ? xcd * (q + 1) : r * (q + 1) + (xcd - r) * q) + off; }
        const int nig = WGM * nN, gid = wgid / nig, fm = gid * WGM, gsz = (nM - fm) < WGM ? (nM - fm) : WGM;
        u.pm = fm + ((wgid % nig) % gsz); u.pn = (wgid % nig) / gsz; return true;
    }
    __device__ __forceinline__ void a_ready(const Unit&) const {}
    __device__ __forceinline__ void done(const Unit&) const {}
};

__device__ __forceinline__ unsigned cvt_pk_bf16(float lo, float hi) { unsigned r; asm volatile("v_cvt_pk_bf16_f32 %0, %1, %2" : "=v"(r) : "v"(lo), "v"(hi)); return r; }
typedef float f32x2 __attribute__((ext_vector_type(2)));
__device__ __forceinline__ float row_rstd16(const float* ssq, int r) {
    const f32x4* p = (const f32x4*)(ssq + (size_t)r * 16);
    const f32x4 a = p[0], b = p[1], c = p[2], d = p[3];
    const float s = ((a[0] + a[1]) + (a[2] + a[3])) + ((b[0] + b[1]) + (b[2] + b[3])) + ((c[0] + c[1]) + (c[2] + c[3])) + ((d[0] + d[1]) + (d[2] + d[3]));
    return __builtin_amdgcn_rsqf(s * (1.0f / 1024.0f) + 1e-6f);
}
__device__ __forceinline__ float silu_mul(float g, float u) { return g * __builtin_amdgcn_rcpf(1.0f + __expf(-g)) * u; }
__device__ __forceinline__ u32x4 pack8(const f32x4 v0, const f32x4 v1) { u32x4 w; w.x = cvt_pk_bf16(v0[0], v0[1]); w.y = cvt_pk_bf16(v0[2], v0[3]); w.z = cvt_pk_bf16(v1[0], v1[1]); w.w = cvt_pk_bf16(v1[2], v1[3]); return w; }
__device__ __forceinline__ int pos16(int k) { return 8 * ((k >> 2) & 1) + (k & 3) + 4 * (k >> 3); }

struct EpiSwiGLU {
    static constexpr bool PERM = true, AFTER_DRAIN = false;
    unsigned char* ws;
    __device__ __forceinline__ void operator()(const f32x4 (&acc)[2][2][4][2], const Unit& u, int wr, int wc, int fr, int fq) const {
        const int row0 = u.pm * BM + wr * 64 + fr, hcol = u.pn * 128 + wc * 32 + 8 * fq; bf16_t* H = (bf16_t*)(ws + AR_H); const float* ssq = (const float*)(ws + WS_SSQ);
#pragma unroll
        for (int ai = 0; ai < 2; ++ai)
#pragma unroll
            for (int m = 0; m < 4; ++m) { const int r = row0 + ai * HALF + m * 16; const float rs = row_rstd16(ssq, r);
                f32x4 h0, h1;
#pragma unroll
                for (int i = 0; i < 4; ++i) { h0[i] = silu_mul(acc[ai][0][m][0][i] * rs, acc[ai][1][m][0][i] * rs); h1[i] = silu_mul(acc[ai][0][m][1][i] * rs, acc[ai][1][m][1][i] * rs); }
                *(u32x4*)(H + (size_t)r * 2816 + hcol) = pack8(h0, h1); }
    }
};
struct EpiResid {
    static constexpr bool PERM = true, AFTER_DRAIN = false;
    const float* base; float* out; unsigned char* ws; size_t xb_off; float alpha;
    __device__ __forceinline__ void operator()(const f32x4 (&acc)[2][2][4][2], const Unit& u, int wr, int wc, int fr, int fq) const {
        const int row0 = u.pm * BM + wr * 64 + fr, col0 = u.pn * BM + wc * 32 + 8 * fq; bf16_t* xb = (bf16_t*)(ws + xb_off); float* ssq = (float*)(ws + WS_SSQ);
#pragma unroll
        for (int ai = 0; ai < 2; ++ai)
#pragma unroll
            for (int m = 0; m < 4; ++m) { const int r = row0 + ai * HALF + m * 16; float s = 0.f;
#pragma unroll
                for (int bj = 0; bj < 2; ++bj) { const size_t off = (size_t)r * 1024 + col0 + bj * HALF;
                    const f32x4 b0 = *(const f32x4*)(base + off), b1 = *(const f32x4*)(base + off + 4);
                    const f32x4 v0 = b0 + acc[ai][bj][m][0] * alpha, v1 = b1 + acc[ai][bj][m][1] * alpha;
                    *(f32x4*)(out + off) = v0; *(f32x4*)(out + off + 4) = v1; *(u32x4*)(xb + off) = pack8(v0, v1);
                    s += (v0[0] * v0[0] + v0[1] * v0[1]) + (v0[2] * v0[2] + v0[3] * v0[3]) + (v1[0] * v1[0] + v1[1] * v1[1]) + (v1[2] * v1[2] + v1[3] * v1[3]); }
                s += __shfl_xor(s, 16); s += __shfl_xor(s, 32);
                if (fq == 0) ssq[(size_t)r * 16 + u.pn * 4 + wc] = s; }
    }
};
struct EpiMixIn {
    static constexpr bool PERM = true, AFTER_DRAIN = false;
    unsigned char* ws;
    __device__ __forceinline__ void operator()(const f32x4 (&acc)[2][2][4][2], const Unit& u, int wr, int wc, int fr, int fq) const {
        const int row0 = u.pm * BM + wr * 64 + fr, cw = wc * 32 + 8 * fq; const float* ssq = (const float*)(ws + WS_SSQ);
        bf16_t* PR = (bf16_t*)(ws + AR_PR); bf16_t* MQ = (bf16_t*)(ws + AR_MQ); bf16_t* MK = (bf16_t*)(ws + AR_MK); bf16_t* MVT = (bf16_t*)(ws + AR_MVT);
#pragma unroll
        for (int ai = 0; ai < 2; ++ai)
#pragma unroll
            for (int m = 0; m < 4; ++m) { const int r = row0 + ai * HALF + m * 16; const float rs = row_rstd16(ssq, r);
#pragma unroll
                for (int bj = 0; bj < 2; ++bj) { const int c = cw + bj * HALF;
                    f32x4 v0 = acc[ai][bj][m][0] * rs, v1 = acc[ai][bj][m][1] * rs;
                    if (u.pn < 7) *(u32x4*)(PR + (size_t)r * 1792 + u.pn * 256 + c) = pack8(v0, v1);
                    else if (u.pn < 9) { v0 = v0 * MOBA_QSCALE; v1 = v1 * MOBA_QSCALE; *(u32x4*)(MQ + (size_t)r * 512 + (u.pn - 7) * 256 + c) = pack8(v0, v1); }
                    else if (u.pn < 11) *(u32x4*)(MK + (size_t)r * 512 + (u.pn - 9) * 256 + c) = pack8(v0, v1);
                    else { const int cc = (u.pn - 11) * 256 + c, hh = cc >> 6, d = cc & 63, b = r >> 11, t = r & 2047;
                        bf16_t* p = MVT + ((size_t)(b * 8 + hh) * 64 + d) * 2048 + (t & ~15) + pos16(t & 15);
                        const u32x4 w = pack8(v0, v1);
                        p[0] = (bf16_t)(w.x & 0xffffu); p[2048] = (bf16_t)(w.x >> 16); p[2 * 2048] = (bf16_t)(w.y & 0xffffu); p[3 * 2048] = (bf16_t)(w.y >> 16);
                        p[4 * 2048] = (bf16_t)(w.z & 0xffffu); p[5 * 2048] = (bf16_t)(w.z >> 16); p[6 * 2048] = (bf16_t)(w.w & 0xffffu); p[7 * 2048] = (bf16_t)(w.w >> 16); }
                } }
    }
};
struct EpiXQ {
    static constexpr bool PERM = true, AFTER_DRAIN = false;
    unsigned char* ws;
    __device__ __forceinline__ void operator()(const f32x4 (&acc)[2][2][4][2], const Unit& u, int wr, int wc, int fr, int fq) const {
        const int row0 = u.pm * BM + wr * 64 + fr, col0 = u.pn * BM + wc * 32 + 8 * fq; bf16_t* Q = (bf16_t*)(ws + AR_XQ); const float* ssq = (const float*)(ws + WS_SSQ);
#pragma unroll
        for (int ai = 0; ai < 2; ++ai)
#pragma unroll
            for (int m = 0; m < 4; ++m) { const int r = row0 + ai * HALF + m * 16; const float rs = row_rstd16(ssq, r) * XATT_QSCALE;
#pragma unroll
                for (int bj = 0; bj < 2; ++bj) *(u32x4*)(Q + (size_t)r * 1024 + col0 + bj * HALF) = pack8(acc[ai][bj][m][0] * rs, acc[ai][bj][m][1] * rs); }
    }
};
struct EpiKV {
    static constexpr bool PERM = true, AFTER_DRAIN = false;
    unsigned char* ws;
    __device__ __forceinline__ void operator()(const f32x4 (&acc)[2][2][4][2], const Unit& u, int wr, int wc, int fr, int fq) const {
        const int row0 = u.pm * BM + wr * 64 + fr, cw = wc * 32 + 8 * fq; bf16_t* XK = (bf16_t*)(ws + WS_XK); bf16_t* XVT = (bf16_t*)(ws + WS_XVT); const float* memrs = (const float*)(ws + WS_MEMRS);
#pragma unroll
        for (int ai = 0; ai < 2; ++ai)
#pragma unroll
            for (int m = 0; m < 4; ++m) { const int r = row0 + ai * HALF + m * 16; const float rs = memrs[r];
#pragma unroll
                for (int bj = 0; bj < 2; ++bj) { const int c = cw + bj * HALF;
                    const f32x4 v0 = acc[ai][bj][m][0] * rs, v1 = acc[ai][bj][m][1] * rs;
                    if (u.pn < 4) *(u32x4*)(XK + (size_t)r * 1024 + u.pn * 256 + c) = pack8(v0, v1);
                    else { const int hx = u.pn - 4, b = r >> 8, key = r & 255;
                        bf16_t* p = XVT + ((size_t)(b * 4 + hx) * 256 + c) * 256 + (key & ~15) + pos16(key & 15);
                        const u32x4 w = pack8(v0, v1);
                        p[0] = (bf16_t)(w.x & 0xffffu); p[256] = (bf16_t)(w.x >> 16); p[2 * 256] = (bf16_t)(w.y & 0xffffu); p[3 * 256] = (bf16_t)(w.y >> 16);
                        p[4 * 256] = (bf16_t)(w.z & 0xffffu); p[5 * 256] = (bf16_t)(w.z >> 16); p[6 * 256] = (bf16_t)(w.w & 0xffffu); p[7 * 256] = (bf16_t)(w.w >> 16); }
                } }
    }
};

template <class Epi, class Sched, bool ALIGN_EPI = false, bool SP2 = false>
__device__ __forceinline__ void gemm_phase(PG8_LAS unsigned char* lds, const Gemm g, const Sched& S, const Epi& E) {
    int tid_ = threadIdx.x; asm volatile("" : "+v"(tid_));
    const int tid = tid_, wid = __builtin_amdgcn_readfirstlane(tid >> 6), lane = tid & 63, wr = wid >> 2, wc = wid & 3, fr = lane & 15, fq = lane >> 4;
    const int K = g.K, nt = K / BK;
    unsigned voffA[2], voffB[2];
#pragma unroll
    for (int i = 0; i < 2; ++i) { int R, C; stage_rc(tid * 16 + i * 8192, R, C); const int Rb = Epi::PERM ? ((R & ~31) + perm32(R & 31)) : R;
        voffA[i] = (unsigned)(R * K + C) * 2u; voffB[i] = (unsigned)(Rb * K + C) * 2u; }
    const size_t kstep = (size_t)(BK * 2);
    const size_t hstep = (size_t)HALF * K * 2;
    const size_t tstep = 2 * hstep;
    const unsigned ldsw = (unsigned)wid * 1024u;
    const int aoff = lds_byte(wr * 64 + fr, fq * 8), boff = lds_byte(wc * 32 + fr, fq * 8);
#define PG8_SA(b, h) (((b) * 2 + (h)) * HTB)
#define PG8_SB(b, h) ((4 + (b) * 2 + (h)) * HTB)
#define PG8_STAGE(bufoff, gbase, voff) do { _Pragma("unroll") for (int _i = 0; _i < 2; ++_i) \
        __builtin_amdgcn_global_load_lds((const unsigned*)((const char*)(gbase) + (voff)[_i]), (PG8_LAS unsigned*)(lds + (bufoff) + ldsw + _i * 8192), 16, 0, 0); } while (0)
#define PG8_LDA(dst, b, h) do { _Pragma("unroll") for (int m = 0; m < 4; ++m) _Pragma("unroll") for (int k = 0; k < 2; ++k) dst[m][k] = *(const PG8_LAS bf16x8*)(lds + PG8_SA(b, h) + aoff + m * 2048 + k * 1024); } while (0)
#define PG8_LDB(dst, b, h) do { _Pragma("unroll") for (int n = 0; n < 2; ++n) _Pragma("unroll") for (int k = 0; k < 2; ++k) dst[n][k] = *(const PG8_LAS bf16x8*)(lds + PG8_SB(b, h) + boff + n * 2048 + k * 1024); } while (0)
#define PG8_MMA(ai, bj, At, Bt) do { __builtin_amdgcn_s_setprio(1); _Pragma("unroll") for (int m = 0; m < 4; ++m) _Pragma("unroll") for (int n = 0; n < 2; ++n) _Pragma("unroll") for (int k = 0; k < 2; ++k) \
        acc[ai][bj][m][n] = __builtin_amdgcn_mfma_f32_16x16x32_bf16(Bt[n][k], At[m][k], acc[ai][bj][m][n], 0, 0, 0); __builtin_amdgcn_s_setprio(0); } while (0)
#define PG8_WAIT_V(n) asm volatile("s_waitcnt vmcnt(" #n ")" ::: "memory")
#define PG8_WAIT_L(n) asm volatile("s_waitcnt lgkmcnt(" #n ")" ::: "memory")
#define PG8_BAR __builtin_amdgcn_s_barrier()
#define PG8_SCHED __builtin_amdgcn_sched_barrier(0)
    Unit cur, nxt; int ui = 0;
    if (!S.next(0, cur)) return;
    f32x4 acc[2][2][4][2];
#pragma unroll
    for (int a = 0; a < 2; ++a)
#pragma unroll
        for (int b = 0; b < 2; ++b)
#pragma unroll
            for (int m = 0; m < 4; ++m)
#pragma unroll
                for (int n = 0; n < 2; ++n) acc[a][b][m][n] = (f32x4){0.f, 0.f, 0.f, 0.f};
    bf16x8 At[4][2], B0[2][2], B1[2][2];
    const char* cA = (const char*)g.A + (size_t)cur.pm * tstep; const char* cB = (const char*)g.Bt + (size_t)cur.pn * tstep;
    S.a_ready(cur);
    if constexpr (SP2) {
        PG8_STAGE(PG8_SB(0, 0), cB, voffB); PG8_STAGE(PG8_SB(0, 1), cB + hstep, voffB); PG8_STAGE(PG8_SA(0, 0), cA, voffA); PG8_STAGE(PG8_SA(0, 1), cA + hstep, voffA);
        if (wr == 1) PG8_BAR;
        PG8_WAIT_V(2); PG8_BAR;
        PG8_STAGE(PG8_SB(1, 0), cB + kstep, voffB); PG8_STAGE(PG8_SA(1, 0), cA + kstep, voffA); PG8_STAGE(PG8_SB(1, 1), cB + hstep + kstep, voffB);
        PG8_WAIT_V(6); PG8_BAR;
    } else {
        PG8_STAGE(PG8_SB(0, 0), cB, voffB); PG8_STAGE(PG8_SA(0, 0), cA, voffA); PG8_STAGE(PG8_SB(0, 1), cB + hstep, voffB); PG8_STAGE(PG8_SA(0, 1), cA + hstep, voffA);
        if (wr == 1) PG8_BAR;
        PG8_WAIT_V(4); PG8_BAR;
        PG8_STAGE(PG8_SB(1, 0), cB + kstep, voffB); PG8_STAGE(PG8_SA(1, 0), cA + kstep, voffA); PG8_STAGE(PG8_SB(1, 1), cB + hstep + kstep, voffB);
        PG8_WAIT_V(6); PG8_BAR;
    }
    for (;;) {
        const bool has_next = S.next(ui + 1, nxt);
        const char* nA = has_next ? (const char*)g.A + (size_t)nxt.pm * tstep : cA; const char* nB = has_next ? (const char*)g.Bt + (size_t)nxt.pn * tstep : cB;
        for (int t = 0; t < nt; t += 2) {
            const bool last = (t == nt - 2);
            const char* a1 = cA + (size_t)(t + 1) * kstep;
            const char* a2 = last ? nA : cA + (size_t)(t + 2) * kstep; const char* b2 = last ? nB : cB + (size_t)(t + 2) * kstep;
            const char* a3 = a2 + kstep; const char* b3 = b2 + kstep;
            if (last && has_next) S.a_ready(nxt);
            if constexpr (SP2) {
            PG8_LDB(B0, 0, 0); PG8_LDB(B1, 0, 1); PG8_SCHED; PG8_LDA(At, 0, 0); PG8_STAGE(PG8_SA(1, 1), a1 + hstep, voffA);
            PG8_WAIT_V(8); PG8_WAIT_L(0); PG8_BAR; PG8_MMA(0, 0, At, B0); PG8_MMA(0, 1, At, B1); PG8_BAR; PG8_SCHED;
            PG8_LDA(At, 0, 1); PG8_STAGE(PG8_SB(0, 0), b2, voffB); PG8_STAGE(PG8_SB(0, 1), b2 + hstep, voffB); PG8_STAGE(PG8_SA(0, 0), a2, voffA);
            PG8_WAIT_V(8); PG8_WAIT_L(0); PG8_BAR; PG8_MMA(1, 0, At, B0); PG8_MMA(1, 1, At, B1); PG8_BAR; PG8_SCHED;
            PG8_LDB(B0, 1, 0); PG8_LDB(B1, 1, 1); PG8_SCHED; PG8_LDA(At, 1, 0); PG8_STAGE(PG8_SA(0, 1), a2 + hstep, voffA);
            PG8_WAIT_V(8); PG8_WAIT_L(0); PG8_BAR; PG8_MMA(0, 0, At, B0); PG8_MMA(0, 1, At, B1); PG8_BAR; PG8_SCHED;
            PG8_LDA(At, 1, 1); PG8_STAGE(PG8_SB(1, 0), b3, voffB); PG8_STAGE(PG8_SB(1, 1), b3 + hstep, voffB); PG8_STAGE(PG8_SA(1, 0), a3, voffA);
            PG8_WAIT_V(8); PG8_WAIT_L(0); PG8_BAR; PG8_MMA(1, 0, At, B0); PG8_MMA(1, 1, At, B1); PG8_BAR; PG8_SCHED;
            } else {
            PG8_LDB(B0, 0, 0); PG8_SCHED; PG8_LDA(At, 0, 0); PG8_STAGE(PG8_SA(1, 1), a1 + hstep, voffA);
            PG8_WAIT_L(8); PG8_BAR; PG8_WAIT_L(0); PG8_MMA(0, 0, At, B0); PG8_BAR; PG8_SCHED;
            PG8_LDB(B1, 0, 1); PG8_STAGE(PG8_SB(0, 0), b2, voffB);
            PG8_BAR; PG8_WAIT_L(0); PG8_MMA(0, 1, At, B1); PG8_BAR;
            PG8_LDA(At, 0, 1); PG8_STAGE(PG8_SA(0, 0), a2, voffA);
            PG8_BAR; PG8_WAIT_L(0); PG8_MMA(1, 0, At, B0); PG8_BAR; PG8_SCHED;
            PG8_STAGE(PG8_SB(0, 1), b2 + hstep, voffB);
            PG8_WAIT_V(6); PG8_BAR; PG8_MMA(1, 1, At, B1); PG8_BAR;
            PG8_LDB(B0, 1, 0); PG8_SCHED; PG8_LDA(At, 1, 0); PG8_STAGE(PG8_SA(0, 1), a2 + hstep, voffA);
            PG8_WAIT_L(8); PG8_BAR; PG8_WAIT_L(0); PG8_MMA(0, 0, At, B0); PG8_BAR; PG8_SCHED;
            PG8_LDB(B1, 1, 1); PG8_STAGE(PG8_SB(1, 0), b3, voffB);
            PG8_BAR; PG8_WAIT_L(0); PG8_MMA(0, 1, At, B1); PG8_BAR;
            PG8_LDA(At, 1, 1); PG8_STAGE(PG8_SA(1, 0), a3, voffA);
            PG8_BAR; PG8_WAIT_L(0); PG8_MMA(1, 0, At, B0); PG8_BAR; PG8_SCHED;
            PG8_STAGE(PG8_SB(1, 1), b3 + hstep, voffB);
            PG8_WAIT_V(6); PG8_BAR; PG8_MMA(1, 1, At, B1); PG8_BAR;
            }
        }
        if constexpr (ALIGN_EPI) { if (wr == 0) PG8_BAR; }
        if constexpr (!Epi::AFTER_DRAIN) { E(acc, cur, wr, wc, fr, fq); S.done(cur); }
        if (!has_next) break;
#pragma unroll
        for (int a = 0; a < 2; ++a)
#pragma unroll
            for (int b = 0; b < 2; ++b)
#pragma unroll
                for (int m = 0; m < 4; ++m)
#pragma unroll
                    for (int n = 0; n < 2; ++n) acc[a][b][m][n] = (f32x4){0.f, 0.f, 0.f, 0.f};
        cur = nxt; cA = nA; cB = nB; ++ui;
        if constexpr (ALIGN_EPI) { if (wr == 1) PG8_BAR; }
    }
    PG8_WAIT_V(0);
    if constexpr (!ALIGN_EPI) { if (wr == 0) PG8_BAR; }
    PG8_BAR;
    if constexpr (Epi::AFTER_DRAIN) { E.fused(acc, cur, wr, wc, fr, fq, lds, wid, lane); S.done(cur); }
#undef PG8_SA
#undef PG8_SB
#undef PG8_STAGE
#undef PG8_LDA
#undef PG8_LDB
#undef PG8_MMA
#undef PG8_WAIT_V
#undef PG8_WAIT_L
#undef PG8_BAR
#undef PG8_SCHED
}
}

constexpr int NWAVES = 8;
constexpr int RING_BYTES = 131072, LDSCTL_OFF = RING_BYTES, MISC_OFF = LDSCTL_OFF + 320, LDS_BYTES = 147456;
constexpr int SCAN_R = 2, SCAN_NCH = 8;

typedef unsigned short bf16;
typedef unsigned u32x4 __attribute__((ext_vector_type(4)));
typedef unsigned u32x2 __attribute__((ext_vector_type(2)));
typedef float f32x4 __attribute__((ext_vector_type(4)));
typedef float f32x16 __attribute__((ext_vector_type(16)));
typedef short bf16x8 __attribute__((ext_vector_type(8)));
typedef GAS unsigned gu32;
#define RLX_AGENT __ATOMIC_RELAXED, __HIP_MEMORY_SCOPE_AGENT
#define LDS_WAIT() asm volatile("s_waitcnt lgkmcnt(0)" ::: "memory")
#define VM_WAIT() asm volatile("s_waitcnt vmcnt(0)" ::: "memory")
__device__ __forceinline__ float bf2f(unsigned b) { return __uint_as_float(b << 16); }
__device__ __forceinline__ unsigned f2bf(float f) { unsigned u = __builtin_bit_cast(unsigned, f); return (u + 0x7fffu + ((u >> 16) & 1u)) >> 16; }
__device__ __forceinline__ unsigned pk2(float lo, float hi) { return pg8::cvt_pk_bf16(lo, hi); }
__device__ __forceinline__ float wave_sum(float v) {
#pragma unroll
    for (int o = 1; o < 64; o <<= 1) v += __shfl_xor(v, o);
    return v;
}
__device__ __forceinline__ float quad_sum(float x) {
    x += __builtin_bit_cast(float, __builtin_amdgcn_update_dpp(0, __builtin_bit_cast(int, x), 0xB1, 0xF, 0xF, true));
    x += __builtin_bit_cast(float, __builtin_amdgcn_update_dpp(0, __builtin_bit_cast(int, x), 0x4E, 0xF, 0xF, true));
    return x;
}
__device__ __forceinline__ float sigmoidf_(float x) { return __builtin_amdgcn_rcpf(1.0f + __expf(-x)); }
__device__ __forceinline__ int crow(int r, int hi) { return (r & 3) + 8 * (r >> 2) + 4 * hi; }
__device__ __forceinline__ bf16x8 pack_bf16x8(float a0, float a1, float a2, float a3, float a4, float a5, float a6, float a7) {
    u32x4 w; w.x = pk2(a0, a1); w.y = pk2(a2, a3); w.z = pk2(a4, a5); w.w = pk2(a6, a7); return __builtin_bit_cast(bf16x8, w);
}

#define XB_TMO      128
#define XB_XCNT(j)  (256  + 64 * (j))
#define XB_XSUB(j)  (1280 + 64 * (j))
#define XB_XGEN(j)  (2304 + 64 * (j))
#define XB_TOP      3328
#define XB_TOPGEN   3392
#define XCD_BAR_WORDS 3456
#define XB_SPIN_CAP (1u << 18)

__device__ __forceinline__ unsigned xb_ld(unsigned* p)              { return __hip_atomic_load(p, __ATOMIC_RELAXED, __HIP_MEMORY_SCOPE_AGENT); }
__device__ __forceinline__ unsigned xb_add(unsigned* p, unsigned v) { return __hip_atomic_fetch_add(p, v, __ATOMIC_RELAXED, __HIP_MEMORY_SCOPE_AGENT); }
__device__ __forceinline__ unsigned xb_xcc_id() { return (unsigned)__builtin_amdgcn_s_getreg((3 << 11) | 20) & 0xFu; }
#define XB_SPIN(cond, bar) do { unsigned _sp = 0; while (cond) { __builtin_amdgcn_s_sleep(1); \
    if ((++_sp & 255u) == 0u) { if (xb_ld(&(bar)[XB_TMO])) break; if (_sp > XB_SPIN_CAP) { atomicAdd(&(bar)[XB_TMO], 1u); break; } } } } while (0)

struct XcdBarrier {
    unsigned* bar; unsigned x;
    volatile LAS unsigned* st;
};

__device__ __forceinline__ XcdBarrier xcd_barrier_post(unsigned* bar, volatile LAS unsigned* st) {
    XcdBarrier b; b.bar = bar; b.x = xb_xcc_id(); b.st = st;
    if (threadIdx.x == 0) (void)xb_add(&bar[XB_XCNT(b.x)], 1u);
    return b;
}
__device__ __forceinline__ void xcd_barrier_complete(unsigned* bar, unsigned x, unsigned& nloc, unsigned& nx) {
    const unsigned G = gridDim.x * gridDim.y * gridDim.z;
    unsigned sum, cnt, mine, sp = 0u;
    for (;;) {
        sum = 0u; cnt = 0u; mine = 0u;
#pragma unroll
        for (unsigned j = 0; j < 16; ++j) { const unsigned c = xb_ld(&bar[XB_XCNT(j)]); sum += c; cnt += (c > 0u) ? 1u : 0u; mine = (j == x) ? c : mine; }
        if (sum == G) break;
        __builtin_amdgcn_s_sleep(1);
        if ((++sp & 255u) == 0u) { if (xb_ld(&bar[XB_TMO])) break; if (sp > XB_SPIN_CAP) { atomicAdd(&bar[XB_TMO], 1u); break; } }
    }
    nloc = mine > 0u ? mine : 1u; nx = cnt > 0u ? cnt : 1u;
}

__device__ __forceinline__ void xcd_barrier(const XcdBarrier& b) {
    asm volatile("s_waitcnt vmcnt(0)" ::: "memory");
    __syncthreads();
    if (threadIdx.x == 0) {
        unsigned* bar = b.bar;
        __builtin_amdgcn_s_waitcnt(0);
        unsigned nloc = b.st[0], nx = b.st[1];
        if (nloc == 0u) { xcd_barrier_complete(bar, b.x, nloc, nx); b.st[0] = nloc; b.st[1] = nx; }
        const unsigned old = xb_add(&bar[XB_XSUB(b.x)], 1u);
        const unsigned gen = old / nloc;
        if (old + 1u == (gen + 1u) * nloc) {
            __builtin_amdgcn_fence(__ATOMIC_RELEASE, "agent");
            asm volatile("s_waitcnt vmcnt(0)" ::: "memory");
            const unsigned og = xb_add(&bar[XB_TOP], 1u);
            const unsigned tg = og / nx;
            if (og + 1u == (tg + 1u) * nx) xb_add(&bar[XB_TOPGEN], 1u);
            else XB_SPIN(xb_ld(&bar[XB_TOPGEN]) == tg, bar);
            __builtin_amdgcn_fence(__ATOMIC_ACQUIRE, "agent");
            xb_add(&bar[XB_XGEN(b.x)], 1u);
            asm volatile("s_waitcnt vmcnt(0)" ::: "memory");
        } else {
            XB_SPIN(xb_ld(&bar[XB_XGEN(b.x)]) == gen, bar);
            __builtin_amdgcn_fence(__ATOMIC_ACQUIRE, "agent");
            asm volatile("s_waitcnt vmcnt(0)" ::: "memory");
        }
    }
    __syncthreads();
}


struct Args { const float* in[N_IN]; float* out; unsigned char* ws; int ph_lo, ph_hi; };
static_assert(sizeof(Args) == N_IN * 8 + 24, "Args has no padding");
struct Frame {
    LAS unsigned char* lds; volatile LAS unsigned* MISC; gu32* ctl;
    int tid, lane, wave, vcu, G;
    const __attribute__((address_space(4))) struct Args* ka; float* out; unsigned char* ws;
};
#define FIN(i) (F.ka->in[i])
#define WSP(T, off) ((T*)(F.ws + (off)))

__device__ __forceinline__ void ph_init(Frame& F) {
    const int gw = F.vcu * NWAVES + F.wave, NGW = F.G * NWAVES;
    float* bias = WSP(float, WS_BIAS); const float* relb = FIN(I_RELB);
    for (int i = blockIdx.x * 512 + F.tid; i < NH * 2048; i += F.G * 512) { const int h = i >> 11, n = i & 2047; int bkt;
        if (n < 16) bkt = n; else { const float nf = (float)n; const int lg = 16 + (int)(logf(nf / 16.0f) / 4.1588830833596715f * 16.0f); bkt = lg < 31 ? lg : 31; }
        bias[i] = relb[h * 32 + bkt] * LOG2E; }
    const float* mem = FIN(I_MEM); bf16* memb = WSP(bf16, WS_MEMB); float* memrs = WSP(float, WS_MEMRS);
    for (int r = gw; r < MM; r += NGW) { const f32x4* xr = (const f32x4*)(mem + (size_t)r * DM) + F.lane; f32x4 v[4]; float s = 0.f;
#pragma unroll
        for (int j = 0; j < 4; ++j) { v[j] = xr[64 * j]; s += (v[j].x * v[j].x + v[j].y * v[j].y) + (v[j].z * v[j].z + v[j].w * v[j].w); }
        s = wave_sum(s); u32x2* o = (u32x2*)(memb + (size_t)r * DM) + F.lane;
#pragma unroll
        for (int j = 0; j < 4; ++j) { u32x2 w; w.x = pk2(v[j].x, v[j].y); w.y = pk2(v[j].z, v[j].w); o[64 * j] = w; }
        if (F.lane == 0) memrs[r] = __builtin_amdgcn_rsqf(s * (1.0f / DM) + NORM_EPS); }
    const float* x = FIN(I_X); bf16* xb = WSP(bf16, WS_XB); float* ssq = WSP(float, WS_SSQ);
    for (int r = gw; r < M; r += NGW) { const f32x4* xr = (const f32x4*)(x + (size_t)r * DM) + F.lane; f32x4 v[4]; float s = 0.f;
#pragma unroll
        for (int j = 0; j < 4; ++j) { v[j] = xr[64 * j]; s += (v[j].x * v[j].x + v[j].y * v[j].y) + (v[j].z * v[j].z + v[j].w * v[j].w); }
        s = wave_sum(s); u32x2* o = (u32x2*)(xb + (size_t)r * DM) + F.lane;
#pragma unroll
        for (int j = 0; j < 4; ++j) { u32x2 w; w.x = pk2(v[j].x, v[j].y); w.y = pk2(v[j].z, v[j].w); o[64 * j] = w; }
        if (F.lane < 16) ssq[(size_t)r * 16 + F.lane] = F.lane == 0 ? s : 0.f; }
}

__device__ __forceinline__ void conv_item(const float* W, int K, int N, const float* gk, bf16* WT, int item, bool ffn_in, LAS float* scr, int lane) {
    const int nblk = N / 32, kb = item / nblk, nb = item % nblk, k0 = 64 * kb, n0 = 32 * nb;
#pragma unroll 8
    for (int i = 0; i < 32; ++i) { const int kk = 2 * i + (lane >> 5); float w = W[(size_t)(k0 + kk) * N + n0 + (lane & 31)]; if (gk) w *= gk[k0 + kk]; scr[kk * 33 + (lane & 31)] = w; }
    LDS_WAIT(); asm volatile("" ::: "memory");
    int drow0 = n0; if (ffn_in) drow0 = n0 < DFF ? 256 * (n0 / 128) + (n0 % 128) : 256 * ((n0 - DFF) / 128) + 128 + ((n0 - DFF) % 128);
    const int c = lane & 7;
#pragma unroll
    for (int j = 0; j < 4; ++j) { const int n = (lane >> 3) + 8 * j; const LAS float* s = scr + (8 * c) * 33 + n;
        u32x4 o; o.x = pk2(s[0 * 33], s[1 * 33]); o.y = pk2(s[2 * 33], s[3 * 33]); o.z = pk2(s[4 * 33], s[5 * 33]); o.w = pk2(s[6 * 33], s[7 * 33]);
        *(u32x4*)(WT + (size_t)(drow0 + n) * K + k0 + 8 * c) = o; }
    LDS_WAIT(); asm volatile("" ::: "memory");
}
__device__ __forceinline__ void ph_conv(Frame& F, int l) {
    LAS float* scr = (LAS float*)(F.lds + F.wave * 16384);
    const int gw = F.vcu * NWAVES + F.wave, NGW = F.G * NWAVES;
    constexpr int I_FIN = (DM / 64) * (2 * DFF / 32), I_FOUT = (DFF / 64) * (DM / 32), I_MI = (DM / 64) * (DPROJ / 32), I_SQ = (DM / 64) * (DM / 32), I_KV = (DM / 64) * (2 * DM / 32);
    constexpr int I_L64 = (64 / 64) * (RW / 32), I_L128 = (128 / 64) * (RW / 32);
    constexpr int NITEMS = 2 * I_FIN + 2 * I_FOUT + I_MI + 3 * I_SQ + I_KV + 2 * I_L64 + I_L128;
    unsigned char* wb = F.ws + WS_W;
    for (int it = gw; it < NITEMS; it += NGW) { int r = it;
        if (r < I_FIN) { conv_item(FIN(I_F1IN) + (size_t)l * DM * 2 * DFF, DM, 2 * DFF, FIN(I_F1G) + l * DM, (bf16*)(wb + W_F1IN), r, true, scr, F.lane); continue; } r -= I_FIN;
        if (r < I_FIN) { conv_item(FIN(I_F2IN) + (size_t)l * DM * 2 * DFF, DM, 2 * DFF, FIN(I_F2G) + l * DM, (bf16*)(wb + W_F2IN), r, true, scr, F.lane); continue; } r -= I_FIN;
        if (r < I_FOUT) { conv_item(FIN(I_F1OUT) + (size_t)l * DFF * DM, DFF, DM, nullptr, (bf16*)(wb + W_F1OUT), r, false, scr, F.lane); continue; } r -= I_FOUT;
        if (r < I_FOUT) { conv_item(FIN(I_F2OUT) + (size_t)l * DFF * DM, DFF, DM, nullptr, (bf16*)(wb + W_F2OUT), r, false, scr, F.lane); continue; } r -= I_FOUT;
        if (r < I_MI) { conv_item(FIN(I_MIXIN) + (size_t)l * DM * DPROJ, DM, DPROJ, FIN(I_MIXG) + l * DM, (bf16*)(wb + W_MIXIN), r, false, scr, F.lane); continue; } r -= I_MI;
        if (r < I_SQ) { conv_item(FIN(I_MIXOUT) + (size_t)l * DM * DM, DM, DM, nullptr, (bf16*)(wb + W_MIXOUT), r, false, scr, F.lane); continue; } r -= I_SQ;
        if (r < I_SQ) { conv_item(FIN(I_WQ) + (size_t)l * DM * DM, DM, DM, FIN(I_XG) + l * DM, (bf16*)(wb + W_WQ), r, false, scr, F.lane); continue; } r -= I_SQ;
        if (r < I_SQ) { conv_item(FIN(I_WO) + (size_t)l * DM * DM, DM, DM, nullptr, (bf16*)(wb + W_WO), r, false, scr, F.lane); continue; } r -= I_SQ;
        if (r < I_KV) { conv_item(FIN(I_WKV) + (size_t)l * DM * 2 * DM, DM, 2 * DM, FIN(I_MEMG) + l * DM, (bf16*)(wb + W_WKV), r, false, scr, F.lane); continue; } r -= I_KV;
        if (r < I_L64) { conv_item(FIN(I_WUP) + (size_t)l * 64 * RW, 64, RW, nullptr, (bf16*)(wb + W_WUPT), r, false, scr, F.lane); continue; } r -= I_L64;
        if (r < I_L64) { conv_item(FIN(I_AUP) + (size_t)l * 64 * RW, 64, RW, nullptr, (bf16*)(wb + W_AUPT), r, false, scr, F.lane); continue; } r -= I_L64;
        conv_item(FIN(I_GUP) + (size_t)l * 128 * RW, 128, RW, nullptr, (bf16*)(wb + W_GUPT), r, false, scr, F.lane);
    }
}

__device__ __forceinline__ void ph_moba(Frame& F) {
    constexpr int KROW = 144, KBUF = 64 * KROW, OFF_K = 12288, OFF_V = OFF_K + 2 * KBUF;
    LAS float* kmean = (LAS float*)F.lds;
    LAS float* btab = (LAS float*)(F.lds + 2048);
    volatile LAS unsigned* needw = (volatile LAS unsigned*)(F.lds + 10240);
    const bf16* MQ = WSP(bf16, AR_MQ); const bf16* MK = WSP(bf16, AR_MK); const bf16* MVT = WSP(bf16, AR_MVT); bf16* XB = WSP(bf16, WS_XB); const float* bias = WSP(float, WS_BIAS);
    const int lane = F.lane, r32 = lane & 31, hi = lane >> 5, wave = F.wave, tid = F.tid;
    for (int u = blockIdx.x; u < 512; u += F.G) {
        const int rnd = u >> 8, iu = u & 255, qsel = iu >> 6, bh = iu & 63, qb = rnd == 0 ? 7 - qsel : qsel, b = bh >> 3, hh = bh & 7;
        __syncthreads();
        { const int n = tid >> 6, d = tid & 63;
          if (n < qb) { const bf16* kp = MK + (size_t)(b * 2048 + n * 256) * 512 + hh * 64 + d; float s0 = 0.f, s1 = 0.f, s2 = 0.f, s3 = 0.f;
#pragma unroll 4
              for (int k = 0; k < 256; k += 4) { s0 += bf2f(kp[(size_t)k * 512]); s1 += bf2f(kp[(size_t)(k + 1) * 512]); s2 += bf2f(kp[(size_t)(k + 2) * 512]); s3 += bf2f(kp[(size_t)(k + 3) * 512]); }
              kmean[n * 64 + d] = ((s0 + s1) + (s2 + s3)) * (1.0f / 256.0f); }
          for (int i2 = tid; i2 < 2048; i2 += 512) btab[i2] = bias[hh * 2048 + i2];
          if (tid == 0) needw[0] = 0u; }
        __syncthreads();
        const int q0 = qb * 256 + wave * 32; const size_t tok = (size_t)b * 2048 + q0 + r32;
        bf16x8 qf[4];
#pragma unroll
        for (int s = 0; s < 4; ++s) qf[s] = *(const bf16x8*)(MQ + tok * 512 + hh * 64 + 16 * s + 8 * hi);
        float g[7]; unsigned selmask = 0u;
#pragma unroll
        for (int n = 0; n < 7; ++n) { g[n] = -INFINITY;
            if (n < qb) { float p = 0.f;
#pragma unroll
                for (int s = 0; s < 4; ++s) { const f32x4 k0v = *(const LAS f32x4*)(kmean + n * 64 + 16 * s + 8 * hi), k1v = *(const LAS f32x4*)(kmean + n * 64 + 16 * s + 8 * hi + 4);
                    p += bf2f((unsigned short)qf[s][0]) * k0v[0] + bf2f((unsigned short)qf[s][1]) * k0v[1] + bf2f((unsigned short)qf[s][2]) * k0v[2] + bf2f((unsigned short)qf[s][3]) * k0v[3]
                       + bf2f((unsigned short)qf[s][4]) * k1v[0] + bf2f((unsigned short)qf[s][5]) * k1v[1] + bf2f((unsigned short)qf[s][6]) * k1v[2] + bf2f((unsigned short)qf[s][7]) * k1v[3]; }
                p += __shfl_xor(p, 32); g[n] = p; } }
        if (qb <= 3) selmask = (1u << qb) - 1u;
        else {
#pragma unroll
            for (int n = 0; n < 7; ++n) if (n < qb) { int cnt = 0;
#pragma unroll
                for (int n2 = 0; n2 < 7; ++n2) if (n2 != n && n2 < qb) cnt += (g[n2] > g[n] || (g[n2] == g[n] && n2 < n)) ? 1 : 0;
                if (cnt < 3) selmask |= 1u << n; } }
        unsigned wmask = 0u;
#pragma unroll
        for (int n = 0; n < 7; ++n) if (__ballot((selmask >> n) & 1u) != 0ull) wmask |= 1u << n;
        if (lane == 0 && wmask) __hip_atomic_fetch_or((LAS unsigned*)needw, wmask, __ATOMIC_RELAXED, __HIP_MEMORY_SCOPE_WORKGROUP);
        __syncthreads();
        const unsigned need = needw[0] | (1u << qb);
        float mrun = -INFINITY, lrun = 0.f; f32x16 o0, o1;
#pragma unroll
        for (int i = 0; i < 16; ++i) { o0[i] = 0.f; o1[i] = 0.f; }
        const int qpos = q0 + r32;
        const bf16* Kg = MK + ((size_t)b * 2048 + (tid >> 3)) * 512 + hh * 64 + (tid & 7) * 8;
        const bf16* Vg = MVT + ((size_t)(b * 8 + hh) * 64 + (tid >> 3)) * 2048 + (tid & 7) * 8;
        const int sto = (tid >> 3) * KROW + (tid & 7) * 16;
        int blk = 0; while (!((need >> blk) & 1u)) ++blk;
        int kt = 0, it = 0;
        { const int k0 = blk * 256; const u32x4 kr = *(const u32x4*)(Kg + (size_t)k0 * 512), vr = *(const u32x4*)(Vg + k0);
          *(LAS u32x4*)(F.lds + OFF_K + sto) = kr; *(LAS u32x4*)(F.lds + OFF_V + sto) = vr; }
        __syncthreads();
        while (blk <= qb) {
            int nblk = blk, nkt = kt + 1; if (nkt == 4) { nkt = 0; ++nblk; while (nblk <= qb && !((need >> nblk) & 1u)) ++nblk; }
            const bool more = nblk <= qb; u32x4 kr, vr;
            if (more) { const int k0n = nblk * 256 + nkt * 64; kr = *(const u32x4*)(Kg + (size_t)k0n * 512); vr = *(const u32x4*)(Vg + k0n); }
            const int k0 = blk * 256 + kt * 64; const bool own = blk == qb; const bool selme = own || ((selmask >> blk) & 1u);
            const bool active = own ? (k0 <= q0 + 31) : (__ballot(selme) != 0ull);
            if (active) {
                const LAS unsigned char* kb = F.lds + OFF_K + (it & 1) * KBUF + r32 * KROW + 16 * hi;
                const LAS unsigned char* vb = F.lds + OFF_V + (it & 1) * KBUF + r32 * KROW + 16 * hi;
                const bool h1 = !own || (k0 + 32 <= q0 + 31);
                f32x16 s0, s1;
#pragma unroll
                for (int i = 0; i < 16; ++i) { s0[i] = 0.f; s1[i] = 0.f; }
#pragma unroll
                for (int s = 0; s < 4; ++s) s0 = __builtin_amdgcn_mfma_f32_32x32x16_bf16(*(const LAS bf16x8*)(kb + 32 * s), qf[s], s0, 0, 0, 0);
                if (h1) {
#pragma unroll
                    for (int s = 0; s < 4; ++s) s1 = __builtin_amdgcn_mfma_f32_32x32x16_bf16(*(const LAS bf16x8*)(kb + 32 * KROW + 32 * s), qf[s], s1, 0, 0, 0); }
                float mx = -INFINITY;
#pragma unroll
                for (int r = 0; r < 16; ++r) { const int d0 = qpos - (k0 + crow(r, hi)), d1 = d0 - 32;
                    const bool v0 = selme && (!own || d0 >= 0), v1 = h1 && selme && (!own || d1 >= 0);
                    const float a0 = v0 ? s0[r] + btab[d0 < 0 ? 0 : d0] : -INFINITY, a1 = v1 ? s1[r] + btab[d1 < 0 ? 0 : d1] : -INFINITY;
                    s0[r] = a0; s1[r] = a1; mx = fmaxf(mx, fmaxf(a0, a1)); }
                mx = fmaxf(mx, __shfl_xor(mx, 32));
                const float mnew = fmaxf(mrun, mx), muse = (mnew == -INFINITY) ? 0.f : mnew;
                const float alpha = __builtin_amdgcn_exp2f(mrun - muse);
                float ps = 0.f;
#pragma unroll
                for (int r = 0; r < 16; ++r) { const float p0 = __builtin_amdgcn_exp2f(s0[r] - muse), p1 = __builtin_amdgcn_exp2f(s1[r] - muse); s0[r] = p0; s1[r] = p1; ps += p0 + p1; }
                lrun = lrun * alpha + ps; mrun = mnew;
#pragma unroll
                for (int i = 0; i < 16; ++i) { o0[i] *= alpha; o1[i] *= alpha; }
                const bf16x8 pa0 = pack_bf16x8(s0[0], s0[1], s0[2], s0[3], s0[4], s0[5], s0[6], s0[7]), pa1 = pack_bf16x8(s0[8], s0[9], s0[10], s0[11], s0[12], s0[13], s0[14], s0[15]);
                o0 = __builtin_amdgcn_mfma_f32_32x32x16_bf16(*(const LAS bf16x8*)(vb), pa0, o0, 0, 0, 0); o0 = __builtin_amdgcn_mfma_f32_32x32x16_bf16(*(const LAS bf16x8*)(vb + 32), pa1, o0, 0, 0, 0);
                o1 = __builtin_amdgcn_mfma_f32_32x32x16_bf16(*(const LAS bf16x8*)(vb + 32 * KROW), pa0, o1, 0, 0, 0); o1 = __builtin_amdgcn_mfma_f32_32x32x16_bf16(*(const LAS bf16x8*)(vb + 32 * KROW + 32), pa1, o1, 0, 0, 0);
                if (h1) {
                    const bf16x8 pb0 = pack_bf16x8(s1[0], s1[1], s1[2], s1[3], s1[4], s1[5], s1[6], s1[7]), pb1 = pack_bf16x8(s1[8], s1[9], s1[10], s1[11], s1[12], s1[13], s1[14], s1[15]);
                    o0 = __builtin_amdgcn_mfma_f32_32x32x16_bf16(*(const LAS bf16x8*)(vb + 64), pb0, o0, 0, 0, 0); o0 = __builtin_amdgcn_mfma_f32_32x32x16_bf16(*(const LAS bf16x8*)(vb + 96), pb1, o0, 0, 0, 0);
                    o1 = __builtin_amdgcn_mfma_f32_32x32x16_bf16(*(const LAS bf16x8*)(vb + 32 * KROW + 64), pb0, o1, 0, 0, 0); o1 = __builtin_amdgcn_mfma_f32_32x32x16_bf16(*(const LAS bf16x8*)(vb + 32 * KROW + 96), pb1, o1, 0, 0, 0); }
            }
            if (more) { *(LAS u32x4*)(F.lds + OFF_K + ((it + 1) & 1) * KBUF + sto) = kr; *(LAS u32x4*)(F.lds + OFF_V + ((it + 1) & 1) * KBUF + sto) = vr; }
            __syncthreads();
            blk = nblk; kt = nkt; ++it;
        }
        lrun += __shfl_xor(lrun, 32); const float inv = 1.0f / lrun;
        bf16* op = XB + tok * 1024 + 512 + hh * 64 + 4 * hi;
#pragma unroll
        for (int g4 = 0; g4 < 4; ++g4) { u32x2 w0, w1; w0.x = pk2(o0[4 * g4] * inv, o0[4 * g4 + 1] * inv); w0.y = pk2(o0[4 * g4 + 2] * inv, o0[4 * g4 + 3] * inv);
            w1.x = pk2(o1[4 * g4] * inv, o1[4 * g4 + 1] * inv); w1.y = pk2(o1[4 * g4 + 2] * inv, o1[4 * g4 + 3] * inv);
            *(u32x2*)(op + 8 * g4) = w0; *(u32x2*)(op + 32 + 8 * g4) = w1; }
    }
}

__device__ __forceinline__ void ph_xatt(Frame& F) {
    constexpr int KROW = 528, KBUF = 32 * KROW, VROW = 80, VBUF = 256 * VROW, OFF_K = 0, OFF_V = 2 * KBUF;
    const bf16* XQ = WSP(bf16, AR_XQ); const bf16* XK = WSP(bf16, WS_XK); const bf16* XVT = WSP(bf16, WS_XVT); bf16* XO = WSP(bf16, AR_XO);
    const int lane = F.lane, r32 = lane & 31, hi = lane >> 5, wave = F.wave, tid = F.tid;
    for (int u = blockIdx.x; u < 256; u += F.G) {
        const int b = u >> 5, hx = (u >> 3) & 3, qt = u & 7;
        const size_t tok = (size_t)b * 2048 + qt * 256 + wave * 32 + r32;
        const bf16* Qg = XQ + tok * 1024 + hx * 256 + 8 * hi;
        bf16x8 qf[4];
#pragma unroll
        for (int s = 0; s < 4; ++s) qf[s] = *(const bf16x8*)(Qg + 16 * s);
        const bf16* Kg = XK + (size_t)(b * 256 + (tid >> 5)) * 1024 + hx * 256 + (tid & 31) * 8;
        const bf16* Vg = XVT + ((size_t)(b * 4 + hx) * 256 + (tid >> 2)) * 256 + (tid & 3) * 8;
        const int ksto = (tid >> 5) * KROW + (tid & 31) * 16, vsto = (tid >> 2) * VROW + (tid & 3) * 16;
        float mrun = -INFINITY, lrun = 0.f; f32x16 o[8];
#pragma unroll
        for (int dt = 0; dt < 8; ++dt)
#pragma unroll
            for (int i = 0; i < 16; ++i) o[dt][i] = 0.f;
        __syncthreads();
        { const u32x4 k0r = *(const u32x4*)(Kg), k1r = *(const u32x4*)(Kg + (size_t)16 * 1024), v0r = *(const u32x4*)(Vg), v1r = *(const u32x4*)(Vg + (size_t)128 * 256);
          *(LAS u32x4*)(F.lds + OFF_K + ksto) = k0r; *(LAS u32x4*)(F.lds + OFF_K + ksto + 16 * KROW) = k1r; *(LAS u32x4*)(F.lds + OFF_V + vsto) = v0r; *(LAS u32x4*)(F.lds + OFF_V + vsto + 128 * VROW) = v1r; }
        __syncthreads();
        for (int kt = 0; kt < 8; ++kt) {
            const bool more = kt + 1 < 8; const int k0n = (kt + 1) * 32; u32x4 s0r, s1r;
            if (more) { s0r = *(const u32x4*)(Kg + (size_t)k0n * 1024); s1r = *(const u32x4*)(Kg + (size_t)(k0n + 16) * 1024); }
            const LAS unsigned char* kb = F.lds + OFF_K + (kt & 1) * KBUF + r32 * KROW + 16 * hi;
            const LAS unsigned char* vb = F.lds + OFF_V + (kt & 1) * VBUF + r32 * VROW + 16 * hi;
            f32x16 sc;
#pragma unroll
            for (int i = 0; i < 16; ++i) sc[i] = 0.f;
            bf16x8 qa[4], qb[4];
#pragma unroll
            for (int s = 0; s < 4; ++s) qa[s] = *(const bf16x8*)(Qg + 64 + 16 * s);
#pragma unroll
            for (int s = 0; s < 4; ++s) sc = __builtin_amdgcn_mfma_f32_32x32x16_bf16(*(const LAS bf16x8*)(kb + 32 * s), qf[s], sc, 0, 0, 0);
            asm volatile("" ::: "memory");
#pragma unroll
            for (int s = 0; s < 4; ++s) qb[s] = *(const bf16x8*)(Qg + 128 + 16 * s);
#pragma unroll
            for (int s = 0; s < 4; ++s) sc = __builtin_amdgcn_mfma_f32_32x32x16_bf16(*(const LAS bf16x8*)(kb + 128 + 32 * s), qa[s], sc, 0, 0, 0);
            asm volatile("" ::: "memory");
#pragma unroll
            for (int s = 0; s < 4; ++s) qa[s] = *(const bf16x8*)(Qg + 192 + 16 * s);
#pragma unroll
            for (int s = 0; s < 4; ++s) sc = __builtin_amdgcn_mfma_f32_32x32x16_bf16(*(const LAS bf16x8*)(kb + 256 + 32 * s), qb[s], sc, 0, 0, 0);
            asm volatile("" ::: "memory");
#pragma unroll
            for (int s = 0; s < 4; ++s) sc = __builtin_amdgcn_mfma_f32_32x32x16_bf16(*(const LAS bf16x8*)(kb + 384 + 32 * s), qa[s], sc, 0, 0, 0);
            if (more) { LAS unsigned char* kd = F.lds + OFF_K + ((kt + 1) & 1) * KBUF + ksto; *(LAS u32x4*)(kd) = s0r; *(LAS u32x4*)(kd + 16 * KROW) = s1r;
                s0r = *(const u32x4*)(Vg + k0n); s1r = *(const u32x4*)(Vg + (size_t)128 * 256 + k0n); }
            float mx = sc[0];
#pragma unroll
            for (int r = 1; r < 16; ++r) mx = fmaxf(mx, sc[r]);
            mx = fmaxf(mx, __shfl_xor(mx, 32));
            const float mnew = fmaxf(mrun, mx), alpha = __builtin_amdgcn_exp2f(mrun - mnew);
            float ps = 0.f;
#pragma unroll
            for (int r = 0; r < 16; ++r) { const float p = __builtin_amdgcn_exp2f(sc[r] - mnew); sc[r] = p; ps += p; }
            lrun = lrun * alpha + ps; mrun = mnew;
            const bf16x8 pf0 = pack_bf16x8(sc[0], sc[1], sc[2], sc[3], sc[4], sc[5], sc[6], sc[7]), pf1 = pack_bf16x8(sc[8], sc[9], sc[10], sc[11], sc[12], sc[13], sc[14], sc[15]);
#pragma unroll
            for (int dt = 0; dt < 8; ++dt) {
#pragma unroll
                for (int i = 0; i < 16; ++i) o[dt][i] *= alpha;
                o[dt] = __builtin_amdgcn_mfma_f32_32x32x16_bf16(*(const LAS bf16x8*)(vb + dt * 32 * VROW), pf0, o[dt], 0, 0, 0);
                o[dt] = __builtin_amdgcn_mfma_f32_32x32x16_bf16(*(const LAS bf16x8*)(vb + dt * 32 * VROW + 32), pf1, o[dt], 0, 0, 0); }
            if (more) { LAS unsigned char* vd = F.lds + OFF_V + ((kt + 1) & 1) * VBUF + vsto; *(LAS u32x4*)(vd) = s0r; *(LAS u32x4*)(vd + 128 * VROW) = s1r; }
            __syncthreads();
        }
        lrun += __shfl_xor(lrun, 32); const float inv = 1.0f / lrun;
        bf16* op = XO + tok * 1024 + hx * 256 + 4 * hi;
#pragma unroll
        for (int dt = 0; dt < 8; ++dt)
#pragma unroll
            for (int g4 = 0; g4 < 4; ++g4) { u32x2 w; w.x = pk2(o[dt][4 * g4] * inv, o[dt][4 * g4 + 1] * inv); w.y = pk2(o[dt][4 * g4 + 2] * inv, o[dt][4 * g4 + 3] * inv);
                *(u32x2*)(op + 32 * dt + 8 * g4) = w; }
    }
}

__device__ __forceinline__ void ph_prep(Frame& F, int l) {
    constexpr int LROW = 528;
    LAS unsigned char* lat = F.lds;
    const bf16* PR = WSP(bf16, AR_PR); bf16* SCANIN = WSP(bf16, AR_SCANIN); bf16* XB = WSP(bf16, WS_XB); float* BONUS = WSP(float, WS_BONUS);
    const bf16* WUPT = (const bf16*)(F.ws + WS_W + W_WUPT); const bf16* AUPT = (const bf16*)(F.ws + WS_W + W_AUPT); const bf16* GUPT = (const bf16*)(F.ws + WS_W + W_GUPT);
    const int h = F.wave, lane = F.lane, r32 = lane & 31, hi = lane >> 5;
    const float* mu = FIN(I_MU) + l * RPROJ; const float* w0p = FIN(I_W0) + l * RW; const float* a0p = FIN(I_A0) + l * RW; const float* kkp = FIN(I_KK) + l * RW; const float* kap = FIN(I_KA) + l * RW; const float* rkp = FIN(I_RK) + l * RW;
    for (int task = blockIdx.x; task < M / 32; task += F.G) { const int t0 = task * 32;
        __syncthreads();
        { const int tt = F.tid >> 4, l16 = (F.tid & 15) * 16, t = t0 + tt; const bf16* pc = PR + (size_t)t * RPROJ + 1536 + l16;
          u32x4 cur[2], prv[2]; cur[0] = *(const u32x4*)pc; cur[1] = *(const u32x4*)(pc + 8); prv[0] = (u32x4){0u, 0u, 0u, 0u}; prv[1] = prv[0];
          if (t & 2047) { prv[0] = *(const u32x4*)(pc - RPROJ); prv[1] = *(const u32x4*)(pc - RPROJ + 8); }
          u32x4 ow[2];
#pragma unroll
          for (int hh = 0; hh < 2; ++hh) { const f32x4 m0 = *(const f32x4*)(mu + 1536 + l16 + 8 * hh), m1 = *(const f32x4*)(mu + 1536 + l16 + 8 * hh + 4); float xv[8];
#pragma unroll
              for (int i = 0; i < 4; ++i) { const unsigned cw = cur[hh][i], pw = prv[hh][i]; const float p0 = bf2f(cw & 0xffffu), p1 = bf2f(cw >> 16), q0 = bf2f(pw & 0xffffu), q1 = bf2f(pw >> 16);
                  const float ma = i < 2 ? m0[2 * i] : m1[2 * i - 4], mb = i < 2 ? m0[2 * i + 1] : m1[2 * i - 3];
                  xv[2 * i] = p0 + (q0 - p0) * ma; xv[2 * i + 1] = p1 + (q1 - p1) * mb; }
#pragma unroll
              for (int i = 0; i < 8; ++i) { if (l16 < 64) xv[i] = 1.0f - 2.0f * __builtin_amdgcn_rcpf(1.0f + __expf(2.0f * xv[i])); else if (l16 >= 128) xv[i] = sigmoidf_(xv[i]); }
              ow[hh] = (u32x4){pk2(xv[0], xv[1]), pk2(xv[2], xv[3]), pk2(xv[4], xv[5]), pk2(xv[6], xv[7])}; }
          *(LAS u32x4*)(lat + tt * LROW + l16 * 2) = ow[0]; *(LAS u32x4*)(lat + tt * LROW + l16 * 2 + 16) = ow[1]; }
        __syncthreads();
        const int t = t0 + r32, bb = t >> 11, tp = t & 2047; const bool hasprev = tp != 0;
        const bf16* prow = PR + (size_t)t * RPROJ; bf16* so = SCANIN + ((size_t)(bb * 8 + h) * 2048 + tp) * 384;
        float n2 = 0.f, bon = 0.f;
#pragma unroll
        for (int q = 0; q < 8; ++q) { const int c4 = h * 64 + 8 * q + 4 * hi;
            const u32x2 kc = *(const u32x2*)(prow + 512 + c4); u32x2 kp = {0u, 0u}; if (hasprev) kp = *(const u32x2*)(prow + 512 + c4 - RPROJ);
            const f32x4 mk = *(const f32x4*)(mu + 512 + c4), kkc = *(const f32x4*)(kkp + c4);
#pragma unroll
            for (int i = 0; i < 4; ++i) { const unsigned sh = (i & 1) * 16; float k = bf2f((kc[i >> 1] >> sh) & 0xffffu); const float kq = bf2f((kp[i >> 1] >> sh) & 0xffffu);
                k += (kq - k) * mk[i]; const float kk = k * kkc[i]; n2 += kk * kk; } }
        n2 += __shfl_xor(n2, 32);
        const float inv = 1.0f / fmaxf(sqrtf(n2), 1e-12f);
        asm volatile("" ::: "memory");
#pragma unroll 1
        for (int ct = 0; ct < 2; ++ct) { const int cb = h * 64 + 32 * ct;
            f32x16 aw, aa, ag;
#pragma unroll
            for (int i = 0; i < 16; ++i) { aw[i] = 0.f; aa[i] = 0.f; ag[i] = 0.f; }
            const LAS unsigned char* lb = lat + r32 * LROW + 16 * hi;
#pragma unroll
            for (int s = 0; s < 4; ++s) { const bf16x8 wf = *(const bf16x8*)(WUPT + (size_t)(cb + r32) * 64 + 16 * s + 8 * hi), af = *(const bf16x8*)(AUPT + (size_t)(cb + r32) * 64 + 16 * s + 8 * hi);
                const bf16x8 lw = *(const LAS bf16x8*)(lb + 32 * s), la = *(const LAS bf16x8*)(lb + 128 + 32 * s);
                aw = __builtin_amdgcn_mfma_f32_32x32x16_bf16(wf, lw, aw, 0, 0, 0); aa = __builtin_amdgcn_mfma_f32_32x32x16_bf16(af, la, aa, 0, 0, 0); }
#pragma unroll
            for (int s = 0; s < 8; ++s) { const bf16x8 gf = *(const bf16x8*)(GUPT + (size_t)(cb + r32) * 128 + 16 * s + 8 * hi); const bf16x8 lg = *(const LAS bf16x8*)(lb + 256 + 32 * s);
                ag = __builtin_amdgcn_mfma_f32_32x32x16_bf16(gf, lg, ag, 0, 0, 0); }
#pragma unroll
            for (int g = 0; g < 4; ++g) { const int c4 = cb + 8 * g + 4 * hi;
                asm volatile("" ::: "memory");
                const u32x2 rc = *(const u32x2*)(prow + c4), kc = *(const u32x2*)(prow + 512 + c4), vc = *(const u32x2*)(prow + 1024 + c4);
                u32x2 rp = {0u, 0u}, kp = {0u, 0u}, vp = {0u, 0u};
                if (hasprev) { rp = *(const u32x2*)(prow + c4 - RPROJ); kp = *(const u32x2*)(prow + 512 + c4 - RPROJ); vp = *(const u32x2*)(prow + 1024 + c4 - RPROJ); }
                const f32x4 mr = *(const f32x4*)(mu + c4), mk = *(const f32x4*)(mu + 512 + c4), mv = *(const f32x4*)(mu + 1024 + c4);
                const f32x4 w0v = *(const f32x4*)(w0p + c4), a0v = *(const f32x4*)(a0p + c4), kkc = *(const f32x4*)(kkp + c4), kac = *(const f32x4*)(kap + c4), rkc = *(const f32x4*)(rkp + c4);
                float ro[4], ko[4], vo[4], ldo[4], go[4], nk[4], bo[4];
#pragma unroll
                for (int i = 0; i < 4; ++i) { const unsigned sh = (i & 1) * 16;
                    float r = bf2f((rc[i >> 1] >> sh) & 0xffffu), k = bf2f((kc[i >> 1] >> sh) & 0xffffu), v = bf2f((vc[i >> 1] >> sh) & 0xffffu);
                    const float rq = bf2f((rp[i >> 1] >> sh) & 0xffffu), kq = bf2f((kp[i >> 1] >> sh) & 0xffffu), vq = bf2f((vp[i >> 1] >> sh) & 0xffffu);
                    r += (rq - r) * mr[i]; k += (kq - k) * mk[i]; v += (vq - v) * mv[i];
                    const float wv = w0v[i] + aw[4 * g + i], xs = -wv, sp = xs > 20.f ? xs : __logf(1.0f + __expf(xs)), ld = -__expf(-sp - 0.5f);
                    const float a = sigmoidf_(a0v[i] + aa[4 * g + i]);
                    const float kn = k * kkc[i] * inv, kt = k * (1.0f + (a - 1.0f) * kac[i]);
                    bon += r * kt * rkc[i];
                    ro[i] = r; ko[i] = kt; vo[i] = v; ldo[i] = ld; go[i] = ag[4 * g + i]; nk[i] = -kn; bo[i] = kn * a; }
                const int co = 32 * ct + 8 * g + 4 * hi;
                *(u32x2*)(so + co) = (u32x2){pk2(nk[0], nk[1]), pk2(nk[2], nk[3])}; *(u32x2*)(so + 64 + co) = (u32x2){pk2(ldo[0], ldo[1]), pk2(ldo[2], ldo[3])};
                *(u32x2*)(so + 128 + co) = (u32x2){pk2(bo[0], bo[1]), pk2(bo[2], bo[3])}; *(u32x2*)(so + 192 + co) = (u32x2){pk2(ko[0], ko[1]), pk2(ko[2], ko[3])};
                *(u32x2*)(so + 256 + co) = (u32x2){pk2(ro[0], ro[1]), pk2(ro[2], ro[3])}; *(u32x2*)(so + 320 + co) = (u32x2){pk2(vo[0], vo[1]), pk2(vo[2], vo[3])};
                *(u32x2*)(XB + (size_t)t * 1024 + c4) = (u32x2){pk2(go[0], go[1]), pk2(go[2], go[3])}; }
        }
        bon += __shfl_xor(bon, 32);
        if (hi == 0) BONUS[(size_t)t * 8 + h] = bon;
    }
}

template <int R, int NCH, bool KINDP>
__device__ __forceinline__ void scan_stream(Frame& F, LAS float* ring, int bh, int ch, int rg, int lis) {
    typedef float f32x2 __attribute__((ext_vector_type(2)));
    constexpr int CLEN = SEQ / NCH, NHALF = CLEN / 8;
    const int lane = F.lane, js = lane & 3, q = lane >> 2, row0 = rg * 16 * R + q * R, tbase = ch * CLEN;
    const bf16* src = WSP(bf16, AR_SCANIN) + ((size_t)bh * 2048 + tbase) * 384;
    float* YL = WSP(float, AR_YLOC) + ((size_t)bh * 2048 + tbase) * 64; bf16* ZZ = WSP(bf16, AR_Z) + ((size_t)bh * 2048 + tbase) * 64;
    f32x2 S[R][8];
#pragma unroll
    for (int rr = 0; rr < R; ++rr)
#pragma unroll
        for (int k = 0; k < 8; ++k) { S[rr][k].x = (KINDP && (row0 + rr) == 16 * js + 2 * k) ? 1.f : 0.f; S[rr][k].y = (KINDP && (row0 + rr) == 16 * js + 2 * k + 1) ? 1.f : 0.f; }
    u32x4 pre[2];
#pragma unroll
    for (int k = 0; k < 2; ++k) { const int ci = lis + k * 256; if (ci < 384) pre[k] = *(const u32x4*)(src + (size_t)ci * 8); }
#pragma unroll
    for (int k = 0; k < 2; ++k) { const int ci = lis + k * 256; if (ci < 384) { const bool isld = ((ci % 48) >> 3) == 1; float f[8];
#pragma unroll
            for (int i = 0; i < 4; ++i) { f[2 * i] = bf2f(pre[k][i] & 0xffffu); f[2 * i + 1] = bf2f(pre[k][i] >> 16); }
            if (isld) {
#pragma unroll
                for (int i = 0; i < 8; ++i) f[i] = __expf(f[i]); }
            *(LAS f32x4*)(ring + ci * 8) = (f32x4){f[0], f[1], f[2], f[3]}; *(LAS f32x4*)(ring + ci * 8 + 4) = (f32x4){f[4], f[5], f[6], f[7]}; } }
    __syncthreads();
    for (int hf = 0; hf < NHALF; ++hf) {
        const bool more = hf + 1 < NHALF;
        if (more) {
#pragma unroll
            for (int k = 0; k < 2; ++k) { const int ci = lis + k * 256; if (ci < 384) pre[k] = *(const u32x4*)(src + (size_t)(hf + 1) * 3072 + (size_t)ci * 8); } }
#pragma unroll 2
        for (int st = 0; st < 8; ++st) {
            const LAS float* sp = ring + ((hf & 1) * 8 + st) * 384 + 16 * js;
            f32x2 nn[8], ww[8], bb[8], kk[8], rr2[8];
#pragma unroll
            for (int i = 0; i < 4; ++i) { const f32x4 a = *(const LAS f32x4*)(sp + 4 * i); nn[2 * i] = (f32x2){a[0], a[1]}; nn[2 * i + 1] = (f32x2){a[2], a[3]}; }
#pragma unroll
            for (int i = 0; i < 4; ++i) { const f32x4 a = *(const LAS f32x4*)(sp + 64 + 4 * i); ww[2 * i] = (f32x2){a[0], a[1]}; ww[2 * i + 1] = (f32x2){a[2], a[3]}; }
#pragma unroll
            for (int i = 0; i < 4; ++i) { const f32x4 a = *(const LAS f32x4*)(sp + 128 + 4 * i); bb[2 * i] = (f32x2){a[0], a[1]}; bb[2 * i + 1] = (f32x2){a[2], a[3]}; }
            if (!KINDP) {
#pragma unroll
                for (int i = 0; i < 4; ++i) { const f32x4 a = *(const LAS f32x4*)(sp + 192 + 4 * i); kk[2 * i] = (f32x2){a[0], a[1]}; kk[2 * i + 1] = (f32x2){a[2], a[3]}; } }
#pragma unroll
            for (int i = 0; i < 4; ++i) { const f32x4 a = *(const LAS f32x4*)(sp + 256 + 4 * i); rr2[2 * i] = (f32x2){a[0], a[1]}; rr2[2 * i + 1] = (f32x2){a[2], a[3]}; }
            float vv[R];
            if (!KINDP) {
#pragma unroll
                for (int rr = 0; rr < R; ++rr) vv[rr] = ring[((hf & 1) * 8 + st) * 384 + 320 + row0 + rr]; }
            float sa[R];
#pragma unroll
            for (int rr = 0; rr < R; ++rr) { f32x2 p0 = S[rr][0] * nn[0], p1 = S[rr][1] * nn[1];
#pragma unroll
                for (int k = 2; k < 8; k += 2) { p0 = S[rr][k] * nn[k] + p0; p1 = S[rr][k + 1] * nn[k + 1] + p1; }
                p0 = p0 + p1; sa[rr] = quad_sum(p0.x + p0.y); }
            float y[R];
#pragma unroll
            for (int rr = 0; rr < R; ++rr) { const f32x2 sa2 = (f32x2){sa[rr], sa[rr]}; f32x2 p0 = (f32x2){0.f, 0.f}, p1 = (f32x2){0.f, 0.f};
#pragma unroll
                for (int k = 0; k < 8; k += 2) {
                    f32x2 t0 = S[rr][k] * ww[k], t1 = S[rr][k + 1] * ww[k + 1];
                    t0 = sa2 * bb[k] + t0; t1 = sa2 * bb[k + 1] + t1;
                    if (!KINDP) { const f32x2 v2 = (f32x2){vv[rr], vv[rr]}; t0 = v2 * kk[k] + t0; t1 = v2 * kk[k + 1] + t1; }
                    S[rr][k] = t0; S[rr][k + 1] = t1; p0 = t0 * rr2[k] + p0; p1 = t1 * rr2[k + 1] + p1; }
                p0 = p0 + p1; y[rr] = quad_sum(p0.x + p0.y); }
            if (js == 0) { const int t = hf * 8 + st;
                if (R == 2) { if (KINDP) *(unsigned*)(ZZ + (size_t)t * 64 + row0) = pk2(y[0], y[R - 1]); else *(f32x2*)(YL + (size_t)t * 64 + row0) = (f32x2){y[0], y[R - 1]}; }
                else {
#pragma unroll
                    for (int rr = 0; rr < R; ++rr) { if (KINDP) ZZ[(size_t)t * 64 + row0 + rr] = (bf16)f2bf(y[rr]); else YL[(size_t)t * 64 + row0 + rr] = y[rr]; } } }
        }
        if (more) {
#pragma unroll
            for (int k = 0; k < 2; ++k) { const int ci = lis + k * 256; if (ci < 384) { const bool isld = ((ci % 48) >> 3) == 1; float f[8];
#pragma unroll
                    for (int i = 0; i < 4; ++i) { f[2 * i] = bf2f(pre[k][i] & 0xffffu); f[2 * i + 1] = bf2f(pre[k][i] >> 16); }
                    if (isld) {
#pragma unroll
                        for (int i = 0; i < 8; ++i) f[i] = __expf(f[i]); }
                    LAS float* dst = ring + (((hf + 1) & 1) * 8) * 384 + ci * 8;
                    *(LAS f32x4*)(dst) = (f32x4){f[0], f[1], f[2], f[3]}; *(LAS f32x4*)(dst + 4) = (f32x4){f[4], f[5], f[6], f[7]}; } } }
        __syncthreads();
    }
    if (NCH > 1) {
        float* st = WSP(float, AR_STATE) + ((size_t)(bh * NCH + ch) * 2 + (KINDP ? 0 : 1)) * 4096;
#pragma unroll
        for (int rr = 0; rr < R; ++rr)
#pragma unroll
            for (int i = 0; i < 4; ++i) *(f32x4*)(st + (size_t)(row0 + rr) * 64 + 16 * js + 4 * i) = (f32x4){S[rr][2 * i].x, S[rr][2 * i].y, S[rr][2 * i + 1].x, S[rr][2 * i + 1].y};
    }
}
template <int R, int NCH>
__device__ __forceinline__ void ph_scan(Frame& F) {
    constexpr int KINDS = NCH > 1 ? 2 : 1, RG = 4 / R, WPS = KINDS * RG, SPW = NWAVES / WPS, NSTREAM = BATCH * NH * NCH;
    static_assert(WPS == 4, "staging assumes 4 waves per stream");
    const int sl = F.wave / WPS, role = F.wave % WPS, kind = role / RG, rg = role % RG, lis = role * 64 + F.lane;
    LAS float* ring = (LAS float*)F.lds + sl * (16 * 384);
    for (int it = blockIdx.x; it * SPW < NSTREAM; it += F.G) {
        const int sid = it * SPW + sl, bh = sid / NCH, ch = sid % NCH;
        __syncthreads();
        if (kind == 0) scan_stream<R, NCH, false>(F, ring, bh, ch, rg, lis); else scan_stream<R, NCH, true>(F, ring, bh, ch, rg, lis);
    }
}

template <int NCH>
__device__ __forceinline__ void ph_fix(Frame& F) {
    typedef float f32x2 __attribute__((ext_vector_type(2)));
    LAS float* cur = (LAS float*)F.lds;
    for (int u = blockIdx.x; u < 256; u += F.G) { const int bh = u >> 2, rgx = u & 3, i = F.tid >> 5, j2 = (F.tid & 31) * 2, row = rgx * 16 + i;
        float* base = WSP(float, AR_STATE) + (size_t)bh * NCH * 2 * 4096;
        __syncthreads();
        { const f32x2 v = *(const f32x2*)(base + 4096 + row * 64 + j2); cur[i * 64 + j2] = v.x; cur[i * 64 + j2 + 1] = v.y; }
        __syncthreads();
        for (int c = 1; c < NCH - 1; ++c) { const float* P = base + (size_t)(c * 2) * 4096; float* SL = base + (size_t)(c * 2 + 1) * 4096;
            f32x2 acc = *(const f32x2*)(SL + row * 64 + j2);
#pragma unroll
            for (int ii = 0; ii < 64; ++ii) { const float sv = cur[i * 64 + ii]; const f32x2 p = *(const f32x2*)(P + ii * 64 + j2); acc.x += sv * p.x; acc.y += sv * p.y; }
            __syncthreads();
            cur[i * 64 + j2] = acc.x; cur[i * 64 + j2 + 1] = acc.y; *(f32x2*)(SL + row * 64 + j2) = acc;
            __syncthreads(); }
    }
}

template <int NCH>
__device__ __forceinline__ void ph_post(Frame& F, int l) {
    constexpr int CLEN = SEQ / NCH;
    const float* YL = WSP(float, AR_YLOC); const bf16* SCANIN = WSP(bf16, AR_SCANIN); bf16* XB = WSP(bf16, WS_XB); const float* BONUS = WSP(float, WS_BONUS); const bf16* ZZ = WSP(bf16, AR_Z);
    LAS float* zt = (LAS float*)F.lds;
    const int c = F.tid, h = F.wave, j = F.lane; const float lng = FIN(I_LNG)[l * RW + c], lnb = FIN(I_LNB)[l * RW + c];
    for (int grp = blockIdx.x; grp < M / 64; grp += F.G) { const int t0g = grp * 64, bb = t0g >> 11, ch = (t0g & 2047) / CLEN, bh = bb * 8 + h; const bool corr = NCH > 1 && ch > 0;
        float st[64];
        if (corr) { const float* sp = WSP(float, AR_STATE) + ((size_t)(bh * NCH + ch - 1) * 2 + 1) * 4096 + j * 64;
#pragma unroll
            for (int i4 = 0; i4 < 16; ++i4) { const f32x4 v = *(const f32x4*)(sp + 4 * i4); st[4 * i4] = v[0]; st[4 * i4 + 1] = v[1]; st[4 * i4 + 2] = v[2]; st[4 * i4 + 3] = v[3]; } }
        for (int ti = 0; ti < 4; ++ti) { const int t0 = t0g + 16 * ti;
            if (corr) { __syncthreads();
#pragma unroll 4
                for (int tt = 0; tt < 16; ++tt) zt[tt * 512 + c] = bf2f(ZZ[((size_t)bh * 2048 + ((t0 + tt) & 2047)) * 64 + j]);
                __syncthreads(); }
#pragma unroll 2
            for (int tt = 0; tt < 16; ++tt) { const int t = t0 + tt, tp = t & 2047;
                float y = YL[((size_t)bh * 2048 + tp) * 64 + j];
                if (corr) { const LAS float* zp = zt + tt * 512 + h * 64; float p0 = 0.f, p1 = 0.f, p2 = 0.f, p3 = 0.f;
#pragma unroll
                    for (int j4 = 0; j4 < 16; ++j4) { const f32x4 zz = *(const LAS f32x4*)(zp + 4 * j4); p0 += st[4 * j4] * zz[0]; p1 += st[4 * j4 + 1] * zz[1]; p2 += st[4 * j4 + 2] * zz[2]; p3 += st[4 * j4 + 3] * zz[3]; }
                    y += (p0 + p1) + (p2 + p3); }
                const float mean = wave_sum(y) * (1.0f / 64.0f), d = y - mean, var = wave_sum(d * d) * (1.0f / 64.0f);
                const float yn = d * __builtin_amdgcn_rsqf(var + LNX_EPS) * lng + lnb;
                const float v = bf2f(SCANIN[((size_t)bh * 2048 + tp) * 384 + 320 + j]), bon = BONUS[(size_t)t * 8 + h], g = bf2f(XB[(size_t)t * 1024 + c]);
                XB[(size_t)t * 1024 + c] = (bf16)f2bf((yn + bon * v) * g); }
        }
    }
}

__device__ __forceinline__ void ph_final(Frame& F) {
    const int gw = F.vcu * NWAVES + F.wave, NGW = F.G * NWAVES; const float* ssq = WSP(float, WS_SSQ); const float* g = FIN(I_FING);
    f32x4 gv[4];
#pragma unroll
    for (int j = 0; j < 4; ++j) gv[j] = ((const f32x4*)g)[F.lane + 64 * j];
    for (int r = gw; r < M; r += NGW) { const float rs = pg8::row_rstd16(ssq, r); f32x4* xr = (f32x4*)(F.out + (size_t)r * DM) + F.lane;
#pragma unroll
        for (int j = 0; j < 4; ++j) { const f32x4 v = xr[64 * j]; xr[64 * j] = v * rs * gv[j]; } }
}

constexpr int PH_INIT = 0, PH_PER_LAYER = 16, PH_FINAL = 1 + DEPTH * PH_PER_LAYER, N_PHASES = PH_FINAL + 1;
enum { K_CONV = 0, K_KV, K_F1UP, K_F1DN, K_MIXIN, K_MOBA, K_PREP, K_SCAN, K_FIX, K_POST, K_MIXOUT, K_XQ, K_XATT, K_XO, K_F2UP, K_F2DN };

#ifdef ONLY
#define PH_ON(k) ((k) == (ONLY))
#else
#define PH_ON(k) true
#endif
__global__ void __launch_bounds__(NWAVES * 64, 2) fwd(Args args) {
    extern __shared__ __attribute__((aligned(16))) unsigned char lds[];
    Frame F;
    F.lds = (LAS unsigned char*)lds; F.MISC = (volatile LAS unsigned*)(F.lds + MISC_OFF);
    F.tid = threadIdx.x; F.lane = F.tid & 63; F.wave = __builtin_amdgcn_readfirstlane(F.tid >> 6);
    F.G = gridDim.x; { const int bx = blockIdx.x; F.vcu = (F.G % 8 == 0) ? (bx % 8) * (F.G / 8) + bx / 8 : bx; }
    F.out = args.out; F.ws = args.ws; F.ctl = (gu32*)(args.ws + WS_CTL);
    F.ka = (const __attribute__((address_space(4))) Args*)(uintptr_t)__builtin_amdgcn_kernarg_segment_ptr();
    for (int u = F.tid; u < (LDS_BYTES - LDSCTL_OFF) / 4; u += NWAVES * 64) ((LAS unsigned*)(F.lds + LDSCTL_OFF))[u] = 0u;
    __syncthreads();
    const bool multi = args.ph_hi - args.ph_lo > 1;
    XcdBarrier bar; bar.bar = (unsigned*)(F.ctl + 4096); bar.x = 0; bar.st = nullptr;
    if (multi) bar = xcd_barrier_post((unsigned*)(F.ctl + 4096), F.MISC + 8);
#ifndef REP_AT
#define REP_AT 1000
#endif
    for (int pi = args.ph_lo; pi < args.ph_hi + (REP_AT < 1000 ? 1 : 0); ++pi) { const int ph = pi - (pi > REP_AT ? 1 : 0);
        { uintptr_t kp = (uintptr_t)__builtin_amdgcn_kernarg_segment_ptr(); asm volatile("" : "+s"(kp)); F.ka = (const __attribute__((address_space(4))) Args*)kp; }
        { int t_ = threadIdx.x; asm volatile("" : "+v"(t_)); F.tid = t_; F.lane = t_ & 63; F.wave = __builtin_amdgcn_readfirstlane(t_ >> 6); }
        unsigned char* wb = F.ws + WS_W;
        if (ph == PH_INIT) { if (PH_ON(100)) ph_init(F); }
        else if (ph == PH_FINAL) { if (PH_ON(101)) ph_final(F); }
        else { const int l = (ph - 1) / PH_PER_LAYER, k = (ph - 1) % PH_PER_LAYER;
            const float* xin = (l == 0) ? FIN(I_X) : (const float*)F.out;
            switch (k) {
            case K_CONV: if (!PH_ON(K_CONV)) break; ph_conv(F, l); break;
            case K_KV: if (!PH_ON(K_KV)) break; { pg8::Gemm g{WSP(bf16, WS_MEMB), (const bf16*)(wb + W_WKV), MM, 2 * DM, DM}; pg8::StaticOrder S; S.init(MM, 2 * DM, F.G, (int)blockIdx.x);
                pg8::EpiKV E{F.ws}; pg8::gemm_phase<pg8::EpiKV, pg8::StaticOrder, true, true>(F.lds, g, S, E); } break;
            case K_F1UP: case K_F2UP: if (!PH_ON(K_F1UP)) break; { pg8::Gemm g{WSP(bf16, WS_XB), (const bf16*)(wb + (k == K_F1UP ? W_F1IN : W_F2IN)), M, 2 * DFF, DM}; pg8::StaticOrder S; S.init(M, 2 * DFF, F.G, (int)blockIdx.x);
                pg8::EpiSwiGLU E{F.ws}; pg8::gemm_phase<pg8::EpiSwiGLU, pg8::StaticOrder, true, true>(F.lds, g, S, E); } break;
            case K_F1DN: case K_F2DN: if (!PH_ON(K_F1DN)) break; { pg8::Gemm g{WSP(bf16, AR_H), (const bf16*)(wb + (k == K_F1DN ? W_F1OUT : W_F2OUT)), M, DM, DFF}; pg8::StaticOrder S; S.init(M, DM, F.G, (int)blockIdx.x);
                pg8::EpiResid E{k == K_F1DN ? xin : (const float*)F.out, F.out, F.ws, WS_XB, 0.5f}; pg8::gemm_phase<pg8::EpiResid, pg8::StaticOrder, true, true>(F.lds, g, S, E); } break;
            case K_MIXIN: if (!PH_ON(K_MIXIN)) break; { pg8::Gemm g{WSP(bf16, WS_XB), (const bf16*)(wb + W_MIXIN), M, DPROJ, DM}; pg8::StaticOrder S; S.init(M, DPROJ, F.G, (int)blockIdx.x);
                pg8::EpiMixIn E{F.ws}; pg8::gemm_phase<pg8::EpiMixIn, pg8::StaticOrder, true, true>(F.lds, g, S, E); } break;
            case K_MOBA: if (!PH_ON(K_MOBA)) break; ph_moba(F); break;
            case K_PREP: if (!PH_ON(K_PREP)) break; ph_prep(F, l); break;
            case K_SCAN: if (!PH_ON(K_SCAN)) break; ph_scan<SCAN_R, SCAN_NCH>(F); break;
            case K_FIX: if (!PH_ON(K_FIX)) break; if (SCAN_NCH > 1) ph_fix<SCAN_NCH>(F); break;
            case K_POST: if (!PH_ON(K_POST)) break; ph_post<SCAN_NCH>(F, l); break;
            case K_MIXOUT: if (!PH_ON(K_MIXOUT)) break; { pg8::Gemm g{WSP(bf16, WS_XB), (const bf16*)(wb + W_MIXOUT), M, DM, DM}; pg8::StaticOrder S; S.init(M, DM, F.G, (int)blockIdx.x);
                pg8::EpiResid E{F.out, F.out, F.ws, AR_XB2, 1.0f}; pg8::gemm_phase<pg8::EpiResid, pg8::StaticOrder, true, true>(F.lds, g, S, E); } break;
            case K_XQ: if (!PH_ON(K_XQ)) break; { pg8::Gemm g{WSP(bf16, AR_XB2), (const bf16*)(wb + W_WQ), M, DM, DM}; pg8::StaticOrder S; S.init(M, DM, F.G, (int)blockIdx.x);
                pg8::EpiXQ E{F.ws}; pg8::gemm_phase<pg8::EpiXQ, pg8::StaticOrder, true, true>(F.lds, g, S, E); } break;
            case K_XATT: if (!PH_ON(K_XATT)) break; ph_xatt(F); break;
            case K_XO: if (!PH_ON(K_XO)) break; { pg8::Gemm g{WSP(bf16, AR_XO), (const bf16*)(wb + W_WO), M, DM, DM}; pg8::StaticOrder S; S.init(M, DM, F.G, (int)blockIdx.x);
                pg8::EpiResid E{F.out, F.out, F.ws, WS_XB, 1.0f}; pg8::gemm_phase<pg8::EpiResid, pg8::StaticOrder, true, true>(F.lds, g, S, E); } break;
            default: break;
            }
        }
        if (pi + 1 < args.ph_hi + (REP_AT < 1000 ? 1 : 0)) {
            const bool noop = (ph != PH_INIT && ph != PH_FINAL && ((ph - 1) % PH_PER_LAYER) == K_FIX && SCAN_NCH == 1);
            if (!noop) { if (ph == PH_INIT) cooperative_groups::this_grid().sync(); else xcd_barrier(bar); }
        }
    }
}

extern "C" void kernel_launch(void* const* d_in, const int* in_sizes, int n_in, void* d_out, int out_size, void* d_ws, size_t ws_size, hipStream_t stream) {
    static int grid = 0;
    if (grid == 0) {
        if (n_in != N_IN || in_sizes[0] != M * DM || out_size != M * DM || ws_size < WS_END) { fprintf(stderr, "kernel_launch: unexpected problem (n_in %d, in0 %d, out %d, ws %zu < %zu); nothing launched\n", n_in, n_in > 0 ? in_sizes[0] : -1, out_size, ws_size, (size_t)WS_END); grid = -1; return; }
        int dev = 0, cus = 0;
        if (hipGetDevice(&dev) != hipSuccess || hipDeviceGetAttribute(&cus, hipDeviceAttributeMultiprocessorCount, dev) != hipSuccess) { grid = -1; return; }
        if (hipFuncSetAttribute((const void*)fwd, hipFuncAttributeMaxDynamicSharedMemorySize, LDS_BYTES) != hipSuccess) { fprintf(stderr, "kernel_launch: hipFuncSetAttribute failed\n"); grid = -1; return; }
        int per_cu = 0;
        if (hipOccupancyMaxActiveBlocksPerMultiprocessor(&per_cu, (const void*)fwd, NWAVES * 64, LDS_BYTES) != hipSuccess || per_cu < 1) { fprintf(stderr, "kernel_launch: occupancy query reports %d workgroups per CU; nothing launched\n", per_cu); grid = -1; return; }
        grid = cus;
    }
    if (grid < 0) return;
    (void)hipMemsetAsync((char*)d_ws + WS_CTL, 0, CTL_ZERO_BYTES, stream);
    Args a{};
    for (int i = 0; i < N_IN; ++i) a.in[i] = (const float*)d_in[i];
    a.out = (float*)d_out; a.ws = (unsigned char*)d_ws;
    a.ph_lo = 0; a.ph_hi = N_PHASES;
    void* kargs[] = {&a};
    const hipError_t e = hipLaunchCooperativeKernel((const void*)fwd, dim3(grid), dim3(NWAVES * 64), kargs, LDS_BYTES, stream);
    if (e != hipSuccess) fprintf(stderr, "kernel_launch: cooperative launch failed: %s (grid %d)\n", hipGetErrorString(e), grid);
}
```

```cpp
#include <hip/hip_runtime.h>
#include <hip/hip_cooperative_groups.h>
#include <cstdio>
#include <cstdint>

constexpr int BATCH = 8, SEQ = 2048, DM = 1024, DEPTH = 2, M = BATCH * SEQ;
constexpr int RW = 512, NH = 8, HD = 64;
constexpr int RPROJ = 1792, DPROJ = 3328;
constexpr int DFF = 2816;
constexpr int MEMLEN = 256, XH = 4, XHD = 256, MM = BATCH * MEMLEN;
constexpr int MBLK = 256, NBLK = SEQ / MBLK;
constexpr float NORM_EPS = 1e-6f, LNX_EPS = 64e-5f;
constexpr float LOG2E = 1.4426950408889634f;
constexpr float MOBA_QSCALE = 0.125f * LOG2E;
constexpr float XATT_QSCALE = 0.0625f * LOG2E;

enum { I_X = 0, I_MEM, I_RELB, I_FING, I_F1G, I_F1IN, I_F1OUT, I_MIXG, I_MIXIN, I_MIXOUT, I_MU, I_W0, I_WUP, I_A0, I_AUP, I_GUP, I_KK, I_KA, I_RK, I_LNG, I_LNB,
       I_XG, I_MEMG, I_WQ, I_WKV, I_WO, I_F2G, I_F2IN, I_F2OUT, N_IN };

constexpr size_t MiB = 1u << 20;
constexpr size_t WS_CTL = 0, CTL_ZERO_BYTES = 1 * MiB;
constexpr size_t WS_BIAS = 1 * MiB;
constexpr size_t WS_MEMRS = WS_BIAS + 64 * 1024;
constexpr size_t WS_BONUS = WS_MEMRS + 64 * 1024;
constexpr size_t WS_KMS = WS_BONUS + 512 * 1024;
constexpr size_t WS_SSQ = 2 * MiB;
constexpr size_t WS_MEMB = 3 * MiB;
constexpr size_t WS_XK = 7 * MiB, WS_XVT = 11 * MiB;
constexpr size_t WS_W = 15 * MiB;
constexpr size_t W_F1IN = 0, W_F1OUT = W_F1IN + (size_t)2 * DFF * DM * 2, W_F2IN = W_F1OUT + (size_t)DM * DFF * 2, W_F2OUT = W_F2IN + (size_t)2 * DFF * DM * 2,
                 W_MIXIN = W_F2OUT + (size_t)DM * DFF * 2, W_MIXOUT = W_MIXIN + (size_t)DPROJ * DM * 2, W_WQ = W_MIXOUT + (size_t)DM * DM * 2, W_WKV = W_WQ + (size_t)DM * DM * 2,
                 W_WO = W_WKV + (size_t)2 * DM * DM * 2, W_WUPT = W_WO + (size_t)DM * DM * 2, W_AUPT = W_WUPT + (size_t)RW * 64 * 2, W_GUPT = W_AUPT + (size_t)RW * 64 * 2, W_END = W_GUPT + (size_t)RW * 128 * 2;
static_assert(W_END <= 50 * MiB, "weights fit");
constexpr size_t WS_XB = 65 * MiB;
constexpr size_t WS_AR = 97 * MiB;
constexpr size_t AR_H = WS_AR;
constexpr size_t AR_PR = WS_AR, AR_MQ = WS_AR + 56 * MiB, AR_MK = WS_AR + 72 * MiB, AR_MVT = WS_AR + 88 * MiB;
constexpr size_t AR_SCANIN = WS_AR + 56 * MiB;
constexpr size_t AR_YLOC = WS_AR, AR_Z = WS_AR + 32 * MiB;
constexpr size_t AR_STATE = WS_AR + 152 * MiB;
constexpr size_t AR_XB2 = WS_AR, AR_XQ = WS_AR + 32 * MiB, AR_XO = WS_AR + 64 * MiB;
constexpr size_t WS_END = WS_AR + 168 * MiB;

#define GAS __attribute__((address_space(1)))
#define LAS __attribute__((address_space(3)))

namespace pg8 {
#define PG8_LAS __attribute__((address_space(3)))
typedef unsigned short bf16_t;
typedef short bf16x8 __attribute__((ext_vector_type(8)));
typedef float f32x4 __attribute__((ext_vector_type(4)));
typedef unsigned u32x4 __attribute__((ext_vector_type(4)));
constexpr int BM = 256, BK = 64, HALF = 128, HTB = HALF * BK * 2  , STAGE_BYTES = 8 * HTB, NXCD = 8, WGM = 8;

__host__ __device__ __forceinline__ int lds_byte(int r, int c) { const int st = (r >> 4) * 2 + (c >> 5), rr = r & 15, cc = c & 31, ob = rr * 64 + cc * 2; return st * 1024 + (ob ^ (((ob >> 9) & 1) << 5)); }
__host__ __device__ __forceinline__ void stage_rc(int b, int& R, int& C) { const int st = b / 1024, sb = b % 1024, swz = sb ^ (((sb >> 9) & 1) << 5); R = (st >> 1) * 16 + swz / 64; C = (st & 1) * 32 + (swz % 64) / 2; }
__host__ __device__ __forceinline__ int perm32(int rho) { const int n = rho >> 4, i = rho & 15; return 8 * (i >> 2) + 4 * n + (i & 3); }

struct Unit { int pm, pn; };
struct Gemm { const bf16_t* A; const bf16_t* Bt; int M, N, K; };

struct StaticOrder {
    int nM, nN, nwg, G, c;
    __host__ __device__ void init(int M, int N, int G_, int c_) { nM = M / BM; nN = N / BM; nwg = nM * nN; G = G_; c = c_; }
    __host__ __device__ bool next(int i, Unit& u) const {
        const long L = (long)i * G + c; if (L >= nwg) return false;
        int wgid = (int)L; { const int q = nwg / NXCD, r = nwg % NXCD, xcd = wgid % NXCD, off = wgid / NXCD; wgid = (xcd < r ? xcd * (q + 1) : r * (q + 1) + (xcd - r) * q) + off; }
        const int nig = WGM * nN, gid = wgid / nig, fm = gid * WGM, gsz = (nM - fm) < WGM ? (nM - fm) : WGM;
        u.pm = fm + ((wgid % nig) % gsz); u.pn = (wgid % nig) / gsz; return true;
    }
    __device__ __forceinline__ void a_ready(const Unit&) const {}
    __device__ __forceinline__ void done(const Unit&) const {}
};

__device__ __forceinline__ unsigned cvt_pk_bf16(float lo, float hi) { unsigned r; asm volatile("v_cvt_pk_bf16_f32 %0, %1, %2" : "=v"(r) : "v"(lo), "v"(hi)); return r; }
typedef float f32x2 __attribute__((ext_vector_type(2)));
__device__ __forceinline__ float row_rstd16(const float* ssq, int r) {
    const f32x4* p = (const f32x4*)(ssq + (size_t)r * 16);
    const f32x4 a = p[0], b = p[1], c = p[2], d = p[3];
    const float s = ((a[0] + a[1]) + (a[2] + a[3])) + ((b[0] + b[1]) + (b[2] + b[3])) + ((c[0] + c[1]) + (c[2] + c[3])) + ((d[0] + d[1]) + (d[2] + d[3]));
    return __builtin_amdgcn_rsqf(s * (1.0f / 1024.0f) + 1e-6f);
}
__device__ __forceinline__ float silu_mul(float g, float u) { return g * __builtin_amdgcn_rcpf(1.0f + __expf(-g)) * u; }
__device__ __forceinline__ u32x4 pack8(const f32x4 v0, const f32x4 v1) { u32x4 w; w.x = cvt_pk_bf16(v0[0], v0[1]); w.y = cvt_pk_bf16(v0[2], v0[3]); w.z = cvt_pk_bf16(v1[0], v1[1]); w.w = cvt_pk_bf16(v1[2], v1[3]); return w; }
__device__ __forceinline__ int pos16(int k) { return 8 * ((k >> 2) & 1) + (k & 3) + 4 * (k >> 3); }

struct EpiSwiGLU {
    static constexpr bool PERM = true, AFTER_DRAIN = false;
    unsigned char* ws;
    __device__ __forceinline__ void operator()(const f32x4 (&acc)[2][2][4][2], const Unit& u, int wr, int wc, int fr, int fq) const {
        const int row0 = u.pm * BM + wr * 64 + fr, hcol = u.pn * 128 + wc * 32 + 8 * fq; bf16_t* H = (bf16_t*)(ws + AR_H); const float* ssq = (const float*)(ws + WS_SSQ);
#pragma unroll
        for (int ai = 0; ai < 2; ++ai)
#pragma unroll
            for (int m = 0; m < 4; ++m) { const int r = row0 + ai * HALF + m * 16; const float rs = row_rstd16(ssq, r);
                f32x4 h0, h1;
#pragma unroll
                for (int i = 0; i < 4; ++i) { h0[i] = silu_mul(acc[ai][0][m][0][i] * rs, acc[ai][1][m][0][i] * rs); h1[i] = silu_mul(acc[ai][0][m][1][i] * rs, acc[ai][1][m][1][i] * rs); }
                *(u32x4*)(H + (size_t)r * 2816 + hcol) = pack8(h0, h1); }
    }
};
struct EpiResid {
    static constexpr bool PERM = true, AFTER_DRAIN = false;
    const float* base; float* out; unsigned char* ws; size_t xb_off; float alpha;
    __device__ __forceinline__ void operator()(const f32x4 (&acc)[2][2][4][2], const Unit& u, int wr, int wc, int fr, int fq) const {
        const int row0 = u.pm * BM + wr * 64 + fr, col0 = u.pn * BM + wc * 32 + 8 * fq; bf16_t* xb = (bf16_t*)(ws + xb_off); float* ssq = (float*)(ws + WS_SSQ);
#pragma unroll
        for (int ai = 0; ai < 2; ++ai)
#pragma unroll
            for (int m = 0; m < 4; ++m) { const int r = row0 + ai * HALF + m * 16; float s = 0.f;
#pragma unroll
                for (int bj = 0; bj < 2; ++bj) { const size_t off = (size_t)r * 1024 + col0 + bj * HALF;
                    const f32x4 b0 = *(const f32x4*)(base + off), b1 = *(const f32x4*)(base + off + 4);
                    const f32x4 v0 = b0 + acc[ai][bj][m][0] * alpha, v1 = b1 + acc[ai][bj][m][1] * alpha;
                    *(f32x4*)(out + off) = v0; *(f32x4*)(out + off + 4) = v1; *(u32x4*)(xb + off) = pack8(v0, v1);
                    s += (v0[0] * v0[0] + v0[1] * v0[1]) + (v0[2] * v0[2] + v0[3] * v0[3]) + (v1[0] * v1[0] + v1[1] * v1[1]) + (v1[2] * v1[2] + v1[3] * v1[3]); }
                s += __shfl_xor(s, 16); s += __shfl_xor(s, 32);
                if (fq == 0) ssq[(size_t)r * 16 + u.pn * 4 + wc] = s; }
    }
};
struct EpiMixIn {
    static constexpr bool PERM = true, AFTER_DRAIN = false;
    unsigned char* ws;
    __device__ __forceinline__ void operator()(const f32x4 (&acc)[2][2][4][2], const Unit& u, int wr, int wc, int fr, int fq) const {
        const int row0 = u.pm * BM + wr * 64 + fr, cw = wc * 32 + 8 * fq; const float* ssq = (const float*)(ws + WS_SSQ);
        bf16_t* PR = (bf16_t*)(ws + AR_PR); bf16_t* MQ = (bf16_t*)(ws + AR_MQ); bf16_t* MK = (bf16_t*)(ws + AR_MK); bf16_t* MVT = (bf16_t*)(ws + AR_MVT);
        f32x4 ks[2][2]; ks[0][0] = (f32x4){0.f, 0.f, 0.f, 0.f}; ks[0][1] = ks[0][0]; ks[1][0] = ks[0][0]; ks[1][1] = ks[0][0];
#pragma unroll
        for (int ai = 0; ai < 2; ++ai)
#pragma unroll
            for (int m = 0; m < 4; ++m) { const int r = row0 + ai * HALF + m * 16; const float rs = row_rstd16(ssq, r);
#pragma unroll
                for (int bj = 0; bj < 2; ++bj) { const int c = cw + bj * HALF;
                    f32x4 v0 = acc[ai][bj][m][0] * rs, v1 = acc[ai][bj][m][1] * rs;
                    if (u.pn < 7) *(u32x4*)(PR + (size_t)r * 1792 + u.pn * 256 + c) = pack8(v0, v1);
                    else if (u.pn < 9) { v0 = v0 * MOBA_QSCALE; v1 = v1 * MOBA_QSCALE; *(u32x4*)(MQ + (size_t)r * 512 + (u.pn - 7) * 256 + c) = pack8(v0, v1); }
                    else if (u.pn < 11) { *(u32x4*)(MK + (size_t)r * 512 + (u.pn - 9) * 256 + c) = pack8(v0, v1); ks[bj][0] += v0; ks[bj][1] += v1; }
                    else { const int cc = (u.pn - 11) * 256 + c, hh = cc >> 6, d = cc & 63, b = r >> 11, t = r & 2047;
                        bf16_t* p = MVT + ((size_t)(b * 8 + hh) * 64 + d) * 2048 + (t & ~15) + pos16(t & 15);
                        const u32x4 w = pack8(v0, v1);
                        p[0] = (bf16_t)(w.x & 0xffffu); p[2048] = (bf16_t)(w.x >> 16); p[2 * 2048] = (bf16_t)(w.y & 0xffffu); p[3 * 2048] = (bf16_t)(w.y >> 16);
                        p[4 * 2048] = (bf16_t)(w.z & 0xffffu); p[5 * 2048] = (bf16_t)(w.z >> 16); p[6 * 2048] = (bf16_t)(w.w & 0xffffu); p[7 * 2048] = (bf16_t)(w.w >> 16); }
                } }
        if (u.pn == 9 || u.pn == 10) {
            float* KMS = (float*)(ws + WS_KMS) + ((size_t)u.pm * 2 + wr) * 512 + (u.pn - 9) * 256 + cw;
#pragma unroll
            for (int bj = 0; bj < 2; ++bj)
#pragma unroll
                for (int n = 0; n < 2; ++n) { f32x4 v = ks[bj][n];
#pragma unroll
                    for (int o = 1; o < 16; o <<= 1) { v[0] += __shfl_xor(v[0], o); v[1] += __shfl_xor(v[1], o); v[2] += __shfl_xor(v[2], o); v[3] += __shfl_xor(v[3], o); }
                    if (fr == 0) *(f32x4*)(KMS + bj * HALF + 4 * n) = v; } }
    }
};
struct EpiXQ {
    static constexpr bool PERM = true, AFTER_DRAIN = false;
    unsigned char* ws;
    __device__ __forceinline__ void operator()(const f32x4 (&acc)[2][2][4][2], const Unit& u, int wr, int wc, int fr, int fq) const {
        const int row0 = u.pm * BM + wr * 64 + fr, col0 = u.pn * BM + wc * 32 + 8 * fq; bf16_t* Q = (bf16_t*)(ws + AR_XQ); const float* ssq = (const float*)(ws + WS_SSQ);
#pragma unroll
        for (int ai = 0; ai < 2; ++ai)
#pragma unroll
            for (int m = 0; m < 4; ++m) { const int r = row0 + ai * HALF + m * 16; const float rs = row_rstd16(ssq, r) * XATT_QSCALE;
#pragma unroll
                for (int bj = 0; bj < 2; ++bj) *(u32x4*)(Q + (size_t)r * 1024 + col0 + bj * HALF) = pack8(acc[ai][bj][m][0] * rs, acc[ai][bj][m][1] * rs); }
    }
};
struct EpiKV {
    static constexpr bool PERM = true, AFTER_DRAIN = false;
    unsigned char* ws;
    __device__ __forceinline__ void operator()(const f32x4 (&acc)[2][2][4][2], const Unit& u, int wr, int wc, int fr, int fq) const {
        const int row0 = u.pm * BM + wr * 64 + fr, cw = wc * 32 + 8 * fq; bf16_t* XK = (bf16_t*)(ws + WS_XK); bf16_t* XVT = (bf16_t*)(ws + WS_XVT); const float* memrs = (const float*)(ws + WS_MEMRS);
#pragma unroll
        for (int ai = 0; ai < 2; ++ai)
#pragma unroll
            for (int m = 0; m < 4; ++m) { const int r = row0 + ai * HALF + m * 16; const float rs = memrs[r];
#pragma unroll
                for (int bj = 0; bj < 2; ++bj) { const int c = cw + bj * HALF;
                    const f32x4 v0 = acc[ai][bj][m][0] * rs, v1 = acc[ai][bj][m][1] * rs;
                    if (u.pn < 4) *(u32x4*)(XK + (size_t)r * 1024 + u.pn * 256 + c) = pack8(v0, v1);
                    else { const int hx = u.pn - 4, b = r >> 8, key = r & 255;
                        bf16_t* p = XVT + ((size_t)(b * 4 + hx) * 256 + c) * 256 + (key & ~15) + pos16(key & 15);
                        const u32x4 w = pack8(v0, v1);
                        p[0] = (bf16_t)(w.x & 0xffffu); p[256] = (bf16_t)(w.x >> 16); p[2 * 256] = (bf16_t)(w.y & 0xffffu); p[3 * 256] = (bf16_t)(w.y >> 16);
                        p[4 * 256] = (bf16_t)(w.z & 0xffffu); p[5 * 256] = (bf16_t)(w.z >> 16); p[6 * 256] = (bf16_t)(w.w & 0xffffu); p[7 * 256] = (bf16_t)(w.w >> 16); }
                } }
    }
};

template <class Epi, class Sched, bool ALIGN_EPI = false, bool SP2 = false>
__device__ __forceinline__ void gemm_phase(PG8_LAS unsigned char* lds, const Gemm g, const Sched& S, const Epi& E) {
    int tid_ = threadIdx.x; asm volatile("" : "+v"(tid_));
    const int tid = tid_, wid = __builtin_amdgcn_readfirstlane(tid >> 6), lane = tid & 63, wr = wid >> 2, wc = wid & 3, fr = lane & 15, fq = lane >> 4;
    const int K = g.K, nt = K / BK;
    unsigned voffA[2], voffB[2];
#pragma unroll
    for (int i = 0; i < 2; ++i) { int R, C; stage_rc(tid * 16 + i * 8192, R, C); const int Rb = Epi::PERM ? ((R & ~31) + perm32(R & 31)) : R;
        voffA[i] = (unsigned)(R * K + C) * 2u; voffB[i] = (unsigned)(Rb * K + C) * 2u; }
    const size_t kstep = (size_t)(BK * 2);
    const size_t hstep = (size_t)HALF * K * 2;
    const size_t tstep = 2 * hstep;
    const unsigned ldsw = (unsigned)wid * 1024u;
    const int aoff = lds_byte(wr * 64 + fr, fq * 8), boff = lds_byte(wc * 32 + fr, fq * 8);
#define PG8_SA(b, h) (((b) * 2 + (h)) * HTB)
#define PG8_SB(b, h) ((4 + (b) * 2 + (h)) * HTB)
#define PG8_STAGE(bufoff, gbase, voff) do { _Pragma("unroll") for (int _i = 0; _i < 2; ++_i) \
        __builtin_amdgcn_global_load_lds((const unsigned*)((const char*)(gbase) + (voff)[_i]), (PG8_LAS unsigned*)(lds + (bufoff) + ldsw + _i * 8192), 16, 0, 0); } while (0)
#define PG8_LDA(dst, b, h) do { _Pragma("unroll") for (int m = 0; m < 4; ++m) _Pragma("unroll") for (int k = 0; k < 2; ++k) dst[m][k] = *(const PG8_LAS bf16x8*)(lds + PG8_SA(b, h) + aoff + m * 2048 + k * 1024); } while (0)
#define PG8_LDB(dst, b, h) do { _Pragma("unroll") for (int n = 0; n < 2; ++n) _Pragma("unroll") for (int k = 0; k < 2; ++k) dst[n][k] = *(const PG8_LAS bf16x8*)(lds + PG8_SB(b, h) + boff + n * 2048 + k * 1024); } while (0)
#define PG8_MMA(ai, bj, At, Bt) do { __builtin_amdgcn_s_setprio(1); _Pragma("unroll") for (int m = 0; m < 4; ++m) _Pragma("unroll") for (int n = 0; n < 2; ++n) _Pragma("unroll") for (int k = 0; k < 2; ++k) \
        acc[ai][bj][m][n] = __builtin_amdgcn_mfma_f32_16x16x32_bf16(Bt[n][k], At[m][k], acc[ai][bj][m][n], 0, 0, 0); __builtin_amdgcn_s_setprio(0); } while (0)
#define PG8_WAIT_V(n) asm volatile("s_waitcnt vmcnt(" #n ")" ::: "memory")
#define PG8_WAIT_L(n) asm volatile("s_waitcnt lgkmcnt(" #n ")" ::: "memory")
#define PG8_BAR __builtin_amdgcn_s_barrier()
#define PG8_SCHED __builtin_amdgcn_sched_barrier(0)
    Unit cur, nxt; int ui = 0;
    if (!S.next(0, cur)) return;
    f32x4 acc[2][2][4][2];
#pragma unroll
    for (int a = 0; a < 2; ++a)
#pragma unroll
        for (int b = 0; b < 2; ++b)
#pragma unroll
            for (int m = 0; m < 4; ++m)
#pragma unroll
                for (int n = 0; n < 2; ++n) acc[a][b][m][n] = (f32x4){0.f, 0.f, 0.f, 0.f};
    bf16x8 At[4][2], B0[2][2], B1[2][2];
    const char* cA = (const char*)g.A + (size_t)cur.pm * tstep; const char* cB = (const char*)g.Bt + (size_t)cur.pn * tstep;
    S.a_ready(cur);
    if constexpr (SP2) {
        PG8_STAGE(PG8_SB(0, 0), cB, voffB); PG8_STAGE(PG8_SB(0, 1), cB + hstep, voffB); PG8_STAGE(PG8_SA(0, 0), cA, voffA); PG8_STAGE(PG8_SA(0, 1), cA + hstep, voffA);
        if (wr == 1) PG8_BAR;
        PG8_WAIT_V(2); PG8_BAR;
        PG8_STAGE(PG8_SB(1, 0), cB + kstep, voffB); PG8_STAGE(PG8_SA(1, 0), cA + kstep, voffA); PG8_STAGE(PG8_SB(1, 1), cB + hstep + kstep, voffB);
        PG8_WAIT_V(6); PG8_BAR;
    } else {
        PG8_STAGE(PG8_SB(0, 0), cB, voffB); PG8_STAGE(PG8_SA(0, 0), cA, voffA); PG8_STAGE(PG8_SB(0, 1), cB + hstep, voffB); PG8_STAGE(PG8_SA(0, 1), cA + hstep, voffA);
        if (wr == 1) PG8_BAR;
        PG8_WAIT_V(4); PG8_BAR;
        PG8_STAGE(PG8_SB(1, 0), cB + kstep, voffB); PG8_STAGE(PG8_SA(1, 0), cA + kstep, voffA); PG8_STAGE(PG8_SB(1, 1), cB + hstep + kstep, voffB);
        PG8_WAIT_V(6); PG8_BAR;
    }
    for (;;) {
        const bool has_next = S.next(ui + 1, nxt);
        const char* nA = has_next ? (const char*)g.A + (size_t)nxt.pm * tstep : cA; const char* nB = has_next ? (const char*)g.Bt + (size_t)nxt.pn * tstep : cB;
        for (int t = 0; t < nt; t += 2) {
            const bool last = (t == nt - 2);
            const char* a1 = cA + (size_t)(t + 1) * kstep;
            const char* a2 = last ? nA : cA + (size_t)(t + 2) * kstep; const char* b2 = last ? nB : cB + (size_t)(t + 2) * kstep;
            const char* a3 = a2 + kstep; const char* b3 = b2 + kstep;
            if (last && has_next) S.a_ready(nxt);
            if constexpr (SP2) {
            PG8_LDB(B0, 0, 0); PG8_LDB(B1, 0, 1); PG8_SCHED; PG8_LDA(At, 0, 0); PG8_STAGE(PG8_SA(1, 1), a1 + hstep, voffA);
            PG8_WAIT_V(8); PG8_WAIT_L(0); PG8_BAR; PG8_MMA(0, 0, At, B0); PG8_MMA(0, 1, At, B1); PG8_BAR; PG8_SCHED;
            PG8_LDA(At, 0, 1); PG8_STAGE(PG8_SB(0, 0), b2, voffB); PG8_STAGE(PG8_SB(0, 1), b2 + hstep, voffB); PG8_STAGE(PG8_SA(0, 0), a2, voffA);
            PG8_WAIT_V(8); PG8_WAIT_L(0); PG8_BAR; PG8_MMA(1, 0, At, B0); PG8_MMA(1, 1, At, B1); PG8_BAR; PG8_SCHED;
            PG8_LDB(B0, 1, 0); PG8_LDB(B1, 1, 1); PG8_SCHED; PG8_LDA(At, 1, 0); PG8_STAGE(PG8_SA(0, 1), a2 + hstep, voffA);
            PG8_WAIT_V(8); PG8_WAIT_L(0); PG8_BAR; PG8_MMA(0, 0, At, B0); PG8_MMA(0, 1, At, B1); PG8_BAR; PG8_SCHED;
            PG8_LDA(At, 1, 1); PG8_STAGE(PG8_SB(1, 0), b3, voffB); PG8_STAGE(PG8_SB(1, 1), b3 + hstep, voffB); PG8_STAGE(PG8_SA(1, 0), a3, voffA);
            PG8_WAIT_V(8); PG8_WAIT_L(0); PG8_BAR; PG8_MMA(1, 0, At, B0); PG8_MMA(1, 1, At, B1); PG8_BAR; PG8_SCHED;
            } else {
            PG8_LDB(B0, 0, 0); PG8_SCHED; PG8_LDA(At, 0, 0); PG8_STAGE(PG8_SA(1, 1), a1 + hstep, voffA);
            PG8_WAIT_L(8); PG8_BAR; PG8_WAIT_L(0); PG8_MMA(0, 0, At, B0); PG8_BAR; PG8_SCHED;
            PG8_LDB(B1, 0, 1); PG8_STAGE(PG8_SB(0, 0), b2, voffB);
            PG8_BAR; PG8_WAIT_L(0); PG8_MMA(0, 1, At, B1); PG8_BAR;
            PG8_LDA(At, 0, 1); PG8_STAGE(PG8_SA(0, 0), a2, voffA);
            PG8_BAR; PG8_WAIT_L(0); PG8_MMA(1, 0, At, B0); PG8_BAR; PG8_SCHED;
            PG8_STAGE(PG8_SB(0, 1), b2 + hstep, voffB);
            PG8_WAIT_V(6); PG8_BAR; PG8_MMA(1, 1, At, B1); PG8_BAR;
            PG8_LDB(B0, 1, 0); PG8_SCHED; PG8_LDA(At, 1, 0); PG8_STAGE(PG8_SA(0, 1), a2 + hstep, voffA);
            PG8_WAIT_L(8); PG8_BAR; PG8_WAIT_L(0); PG8_MMA(0, 0, At, B0); PG8_BAR; PG8_SCHED;
            PG8_LDB(B1, 1, 1); PG8_STAGE(PG8_SB(1, 0), b3, voffB);
            PG8_BAR; PG8_WAIT_L(0); PG8_MMA(0, 1, At, B1); PG8_BAR;
            PG8_LDA(At, 1, 1); PG8_STAGE(PG8_SA(1, 0), a3, voffA);
            PG8_BAR; PG8_WAIT_L(0); PG8_MMA(1, 0, At, B0); PG8_BAR; PG8_SCHED;
            PG8_STAGE(PG8_SB(1, 1), b3 + hstep, voffB);
            PG8_WAIT_V(6); PG8_BAR; PG8_MMA(1, 1, At, B1); PG8_BAR;
            }
        }
        if constexpr (ALIGN_EPI) { if (wr == 0) PG8_BAR; }
        if constexpr (!Epi::AFTER_DRAIN) { E(acc, cur, wr, wc, fr, fq); S.done(cur); }
        if (!has_next) break;
#pragma unroll
        for (int a = 0; a < 2; ++a)
#pragma unroll
            for (int b = 0; b < 2; ++b)
#pragma unroll
                for (int m = 0; m < 4; ++m)
#pragma unroll
                    for (int n = 0; n < 2; ++n) acc[a][b][m][n] = (f32x4){0.f, 0.f, 0.f, 0.f};
        cur = nxt; cA = nA; cB = nB; ++ui;
        if constexpr (ALIGN_EPI) { if (wr == 1) PG8_BAR; }
    }
    PG8_WAIT_V(0);
    if constexpr (!ALIGN_EPI) { if (wr == 0) PG8_BAR; }
    PG8_BAR;
    if constexpr (Epi::AFTER_DRAIN) { E.fused(acc, cur, wr, wc, fr, fq, lds, wid, lane); S.done(cur); }
#undef PG8_SA
#undef PG8_SB
#undef PG8_STAGE
#undef PG8_LDA
#undef PG8_LDB
#undef PG8_MMA
#undef PG8_WAIT_V
#undef PG8_WAIT_L
#undef PG8_BAR
#undef PG8_SCHED
}
}

constexpr int NWAVES = 8;
constexpr int RING_BYTES = 131072, LDSCTL_OFF = RING_BYTES, MISC_OFF = LDSCTL_OFF + 320, LDS_BYTES = 147456;
constexpr int SCAN_R = 2, SCAN_NCH = 8;

typedef unsigned short bf16;
typedef unsigned u32x4 __attribute__((ext_vector_type(4)));
typedef unsigned u32x2 __attribute__((ext_vector_type(2)));
typedef float f32x4 __attribute__((ext_vector_type(4)));
typedef float f32x16 __attribute__((ext_vector_type(16)));
typedef short bf16x8 __attribute__((ext_vector_type(8)));
typedef GAS unsigned gu32;
#define RLX_AGENT __ATOMIC_RELAXED, __HIP_MEMORY_SCOPE_AGENT
#define LDS_WAIT() asm volatile("s_waitcnt lgkmcnt(0)" ::: "memory")
#define VM_WAIT() asm volatile("s_waitcnt vmcnt(0)" ::: "memory")
__device__ __forceinline__ float bf2f(unsigned b) { return __uint_as_float(b << 16); }
__device__ __forceinline__ unsigned f2bf(float f) { unsigned u = __builtin_bit_cast(unsigned, f); return (u + 0x7fffu + ((u >> 16) & 1u)) >> 16; }
__device__ __forceinline__ unsigned pk2(float lo, float hi) { return pg8::cvt_pk_bf16(lo, hi); }
__device__ __forceinline__ float wave_sum(float v) {
#pragma unroll
    for (int o = 1; o < 64; o <<= 1) v += __shfl_xor(v, o);
    return v;
}
__device__ __forceinline__ float quad_sum(float x) {
    x += __builtin_bit_cast(float, __builtin_amdgcn_update_dpp(0, __builtin_bit_cast(int, x), 0xB1, 0xF, 0xF, true));
    x += __builtin_bit_cast(float, __builtin_amdgcn_update_dpp(0, __builtin_bit_cast(int, x), 0x4E, 0xF, 0xF, true));
    return x;
}
__device__ __forceinline__ float sigmoidf_(float x) { return __builtin_amdgcn_rcpf(1.0f + __expf(-x)); }
__device__ __forceinline__ int crow(int r, int hi) { return (r & 3) + 8 * (r >> 2) + 4 * hi; }
__device__ __forceinline__ bf16x8 pack_bf16x8(float a0, float a1, float a2, float a3, float a4, float a5, float a6, float a7) {
    u32x4 w; w.x = pk2(a0, a1); w.y = pk2(a2, a3); w.z = pk2(a4, a5); w.w = pk2(a6, a7); return __builtin_bit_cast(bf16x8, w);
}

#define XB_TMO      128
#define XB_XCNT(j)  (256  + 64 * (j))
#define XB_XSUB(j)  (1280 + 64 * (j))
#define XB_XGEN(j)  (2304 + 64 * (j))
#define XB_TOP      3328
#define XB_TOPGEN   3392
#define XCD_BAR_WORDS 3456
#define XB_SPIN_CAP (1u << 18)

__device__ __forceinline__ unsigned xb_ld(unsigned* p)              { return __hip_atomic_load(p, __ATOMIC_RELAXED, __HIP_MEMORY_SCOPE_AGENT); }
__device__ __forceinline__ unsigned xb_add(unsigned* p, unsigned v) { return __hip_atomic_fetch_add(p, v, __ATOMIC_RELAXED, __HIP_MEMORY_SCOPE_AGENT); }
__device__ __forceinline__ unsigned xb_xcc_id() { return (unsigned)__builtin_amdgcn_s_getreg((3 << 11) | 20) & 0xFu; }
#define XB_SPIN(cond, bar) do { unsigned _sp = 0; while (cond) { __builtin_amdgcn_s_sleep(1); \
    if ((++_sp & 255u) == 0u) { if (xb_ld(&(bar)[XB_TMO])) break; if (_sp > XB_SPIN_CAP) { atomicAdd(&(bar)[XB_TMO], 1u); break; } } } } while (0)

struct XcdBarrier {
    unsigned* bar; unsigned x;
    volatile LAS unsigned* st;
};

__device__ __forceinline__ XcdBarrier xcd_barrier_post(unsigned* bar, volatile LAS unsigned* st) {
    XcdBarrier b; b.bar = bar; b.x = xb_xcc_id(); b.st = st;
    if (threadIdx.x == 0) (void)xb_add(&bar[XB_XCNT(b.x)], 1u);
    return b;
}
__device__ __forceinline__ void xcd_barrier_complete(unsigned* bar, unsigned x, unsigned& nloc, unsigned& nx) {
    const unsigned G = gridDim.x * gridDim.y * gridDim.z;
    unsigned sum, cnt, mine, sp = 0u;
    for (;;) {
        sum = 0u; cnt = 0u; mine = 0u;
#pragma unroll
        for (unsigned j = 0; j < 16; ++j) { const unsigned c = xb_ld(&bar[XB_XCNT(j)]); sum += c; cnt += (c > 0u) ? 1u : 0u; mine = (j == x) ? c : mine; }
        if (sum == G) break;
        __builtin_amdgcn_s_sleep(1);
        if ((++sp & 255u) == 0u) { if (xb_ld(&bar[XB_TMO])) break; if (sp > XB_SPIN_CAP) { atomicAdd(&bar[XB_TMO], 1u); break; } }
    }
    nloc = mine > 0u ? mine : 1u; nx = cnt > 0u ? cnt : 1u;
}

__device__ __forceinline__ void xcd_barrier(const XcdBarrier& b) {
    asm volatile("s_waitcnt vmcnt(0)" ::: "memory");
    __syncthreads();
    if (threadIdx.x == 0) {
        unsigned* bar = b.bar;
        __builtin_amdgcn_s_waitcnt(0);
        unsigned nloc = b.st[0], nx = b.st[1];
        if (nloc == 0u) { xcd_barrier_complete(bar, b.x, nloc, nx); b.st[0] = nloc; b.st[1] = nx; }
        const unsigned old = xb_add(&bar[XB_XSUB(b.x)], 1u);
        const unsigned gen = old / nloc;
        if (old + 1u == (gen + 1u) * nloc) {
            __builtin_amdgcn_fence(__ATOMIC_RELEASE, "agent");
            asm volatile("s_waitcnt vmcnt(0)" ::: "memory");
            const unsigned og = xb_add(&bar[XB_TOP], 1u);
            const unsigned tg = og / nx;
            if (og + 1u == (tg + 1u) * nx) xb_add(&bar[XB_TOPGEN], 1u);
            else XB_SPIN(xb_ld(&bar[XB_TOPGEN]) == tg, bar);
            __builtin_amdgcn_fence(__ATOMIC_ACQUIRE, "agent");
            xb_add(&bar[XB_XGEN(b.x)], 1u);
            asm volatile("s_waitcnt vmcnt(0)" ::: "memory");
        } else {
            XB_SPIN(xb_ld(&bar[XB_XGEN(b.x)]) == gen, bar);
            __builtin_amdgcn_fence(__ATOMIC_ACQUIRE, "agent");
            asm volatile("s_waitcnt vmcnt(0)" ::: "memory");
        }
    }
    __syncthreads();
}


struct Args { const float* in[N_IN]; float* out; unsigned char* ws; int ph_lo, ph_hi; };
static_assert(sizeof(Args) == N_IN * 8 + 24, "Args has no padding");
struct Frame {
    LAS unsigned char* lds; volatile LAS unsigned* MISC; gu32* ctl;
    int tid, lane, wave, vcu, G;
    const __attribute__((address_space(4))) struct Args* ka; float* out; unsigned char* ws;
};
#define FIN(i) (F.ka->in[i])
#define WSP(T, off) ((T*)(F.ws + (off)))

__device__ __forceinline__ void ph_init(Frame& F) {
    const int gw = F.vcu * NWAVES + F.wave, NGW = F.G * NWAVES;
    float* bias = WSP(float, WS_BIAS); const float* relb = FIN(I_RELB);
    for (int i = blockIdx.x * 512 + F.tid; i < NH * 2048; i += F.G * 512) { const int h = i >> 11, n = i & 2047; int bkt;
        if (n < 16) bkt = n; else { const float nf = (float)n; const int lg = 16 + (int)(logf(nf / 16.0f) / 4.1588830833596715f * 16.0f); bkt = lg < 31 ? lg : 31; }
        bias[i] = relb[h * 32 + bkt] * LOG2E; }
    const float* mem = FIN(I_MEM); bf16* memb = WSP(bf16, WS_MEMB); float* memrs = WSP(float, WS_MEMRS);
    for (int r = gw; r < MM; r += NGW) { const f32x4* xr = (const f32x4*)(mem + (size_t)r * DM) + F.lane; f32x4 v[4]; float s = 0.f;
#pragma unroll
        for (int j = 0; j < 4; ++j) { v[j] = xr[64 * j]; s += (v[j].x * v[j].x + v[j].y * v[j].y) + (v[j].z * v[j].z + v[j].w * v[j].w); }
        s = wave_sum(s); u32x2* o = (u32x2*)(memb + (size_t)r * DM) + F.lane;
#pragma unroll
        for (int j = 0; j < 4; ++j) { u32x2 w; w.x = pk2(v[j].x, v[j].y); w.y = pk2(v[j].z, v[j].w); o[64 * j] = w; }
        if (F.lane == 0) memrs[r] = __builtin_amdgcn_rsqf(s * (1.0f / DM) + NORM_EPS); }
    const float* x = FIN(I_X); bf16* xb = WSP(bf16, WS_XB); float* ssq = WSP(float, WS_SSQ);
    for (int r = gw; r < M; r += NGW) { const f32x4* xr = (const f32x4*)(x + (size_t)r * DM) + F.lane; f32x4 v[4]; float s = 0.f;
#pragma unroll
        for (int j = 0; j < 4; ++j) { v[j] = xr[64 * j]; s += (v[j].x * v[j].x + v[j].y * v[j].y) + (v[j].z * v[j].z + v[j].w * v[j].w); }
        s = wave_sum(s); u32x2* o = (u32x2*)(xb + (size_t)r * DM) + F.lane;
#pragma unroll
        for (int j = 0; j < 4; ++j) { u32x2 w; w.x = pk2(v[j].x, v[j].y); w.y = pk2(v[j].z, v[j].w); o[64 * j] = w; }
        if (F.lane < 16) ssq[(size_t)r * 16 + F.lane] = F.lane == 0 ? s : 0.f; }
}

__device__ __forceinline__ void conv_item(const float* W, int K, int N, const float* gk, bf16* WT, int item, bool ffn_in, LAS float* scr, int lane) {
    const int nblk = N / 32, kb = item / nblk, nb = item % nblk, k0 = 64 * kb, n0 = 32 * nb;
#pragma unroll 8
    for (int i = 0; i < 32; ++i) { const int kk = 2 * i + (lane >> 5); float w = W[(size_t)(k0 + kk) * N + n0 + (lane & 31)]; if (gk) w *= gk[k0 + kk]; scr[kk * 33 + (lane & 31)] = w; }
    LDS_WAIT(); asm volatile("" ::: "memory");
    int drow0 = n0; if (ffn_in) drow0 = n0 < DFF ? 256 * (n0 / 128) + (n0 % 128) : 256 * ((n0 - DFF) / 128) + 128 + ((n0 - DFF) % 128);
    const int c = lane & 7;
#pragma unroll
    for (int j = 0; j < 4; ++j) { const int n = (lane >> 3) + 8 * j; const LAS float* s = scr + (8 * c) * 33 + n;
        u32x4 o; o.x = pk2(s[0 * 33], s[1 * 33]); o.y = pk2(s[2 * 33], s[3 * 33]); o.z = pk2(s[4 * 33], s[5 * 33]); o.w = pk2(s[6 * 33], s[7 * 33]);
        *(u32x4*)(WT + (size_t)(drow0 + n) * K + k0 + 8 * c) = o; }
    LDS_WAIT(); asm volatile("" ::: "memory");
}
__device__ __forceinline__ void ph_conv(Frame& F, int l) {
    LAS float* scr = (LAS float*)(F.lds + F.wave * 16384);
    const int gw = F.vcu * NWAVES + F.wave, NGW = F.G * NWAVES;
    constexpr int I_FIN = (DM / 64) * (2 * DFF / 32), I_FOUT = (DFF / 64) * (DM / 32), I_MI = (DM / 64) * (DPROJ / 32), I_SQ = (DM / 64) * (DM / 32), I_KV = (DM / 64) * (2 * DM / 32);
    constexpr int I_L64 = (64 / 64) * (RW / 32), I_L128 = (128 / 64) * (RW / 32);
    constexpr int NITEMS = 2 * I_FIN + 2 * I_FOUT + I_MI + 3 * I_SQ + I_KV + 2 * I_L64 + I_L128;
    unsigned char* wb = F.ws + WS_W;
    for (int it = gw; it < NITEMS; it += NGW) { int r = it;
        if (r < I_FIN) { conv_item(FIN(I_F1IN) + (size_t)l * DM * 2 * DFF, DM, 2 * DFF, FIN(I_F1G) + l * DM, (bf16*)(wb + W_F1IN), r, true, scr, F.lane); continue; } r -= I_FIN;
        if (r < I_FIN) { conv_item(FIN(I_F2IN) + (size_t)l * DM * 2 * DFF, DM, 2 * DFF, FIN(I_F2G) + l * DM, (bf16*)(wb + W_F2IN), r, true, scr, F.lane); continue; } r -= I_FIN;
        if (r < I_FOUT) { conv_item(FIN(I_F1OUT) + (size_t)l * DFF * DM, DFF, DM, nullptr, (bf16*)(wb + W_F1OUT), r, false, scr, F.lane); continue; } r -= I_FOUT;
        if (r < I_FOUT) { conv_item(FIN(I_F2OUT) + (size_t)l * DFF * DM, DFF, DM, nullptr, (bf16*)(wb + W_F2OUT), r, false, scr, F.lane); continue; } r -= I_FOUT;
        if (r < I_MI) { conv_item(FIN(I_MIXIN) + (size_t)l * DM * DPROJ, DM, DPROJ, FIN(I_MIXG) + l * DM, (bf16*)(wb + W_MIXIN), r, false, scr, F.lane); continue; } r -= I_MI;
        if (r < I_SQ) { conv_item(FIN(I_MIXOUT) + (size_t)l * DM * DM, DM, DM, nullptr, (bf16*)(wb + W_MIXOUT), r, false, scr, F.lane); continue; } r -= I_SQ;
        if (r < I_SQ) { conv_item(FIN(I_WQ) + (size_t)l * DM * DM, DM, DM, FIN(I_XG) + l * DM, (bf16*)(wb + W_WQ), r, false, scr, F.lane); continue; } r -= I_SQ;
        if (r < I_SQ) { conv_item(FIN(I_WO) + (size_t)l * DM * DM, DM, DM, nullptr, (bf16*)(wb + W_WO), r, false, scr, F.lane); continue; } r -= I_SQ;
        if (r < I_KV) { conv_item(FIN(I_WKV) + (size_t)l * DM * 2 * DM, DM, 2 * DM, FIN(I_MEMG) + l * DM, (bf16*)(wb + W_WKV), r, false, scr, F.lane); continue; } r -= I_KV;
        if (r < I_L64) { conv_item(FIN(I_WUP) + (size_t)l * 64 * RW, 64, RW, nullptr, (bf16*)(wb + W_WUPT), r, false, scr, F.lane); continue; } r -= I_L64;
        if (r < I_L64) { conv_item(FIN(I_AUP) + (size_t)l * 64 * RW, 64, RW, nullptr, (bf16*)(wb + W_AUPT), r, false, scr, F.lane); continue; } r -= I_L64;
        conv_item(FIN(I_GUP) + (size_t)l * 128 * RW, 128, RW, nullptr, (bf16*)(wb + W_GUPT), r, false, scr, F.lane);
    }
}

__device__ __forceinline__ void ph_moba(Frame& F) {
    constexpr int KROW = 144, KBUF = 64 * KROW, OFF_K = 12288, OFF_V = OFF_K + 2 * KBUF;
    LAS float* kmean = (LAS float*)F.lds;
    LAS float* btab = (LAS float*)(F.lds + 2048);
    volatile LAS unsigned* needw = (volatile LAS unsigned*)(F.lds + 10240);
    const bf16* MQ = WSP(bf16, AR_MQ); const bf16* MK = WSP(bf16, AR_MK); const bf16* MVT = WSP(bf16, AR_MVT); bf16* XB = WSP(bf16, WS_XB); const float* bias = WSP(float, WS_BIAS);
    const int lane = F.lane, r32 = lane & 31, hi = lane >> 5, wave = F.wave, tid = F.tid;
    for (int u = blockIdx.x; u < 512; u += F.G) {
        const int rnd = u >> 8, iu = u & 255, qsel = iu >> 6, bh = iu & 63, qb = rnd == 0 ? 7 - qsel : qsel, b = bh >> 3, hh = bh & 7;
        __syncthreads();
        { const int n = tid >> 6, d = tid & 63;
          if (n < qb) { const float* kp = WSP(float, WS_KMS) + ((size_t)(b * 8 + n) * 2) * 512 + hh * 64 + d; kmean[n * 64 + d] = (kp[0] + kp[512]) * (1.0f / 256.0f); }
          for (int i2 = tid; i2 < 2048; i2 += 512) btab[i2] = bias[hh * 2048 + i2];
          if (tid == 0) needw[0] = 0u; }
        __syncthreads();
        const int q0 = qb * 256 + wave * 32; const size_t tok = (size_t)b * 2048 + q0 + r32;
        bf16x8 qf[4];
#pragma unroll
        for (int s = 0; s < 4; ++s) qf[s] = *(const bf16x8*)(MQ + tok * 512 + hh * 64 + 16 * s + 8 * hi);
        float g[7]; unsigned selmask = 0u;
#pragma unroll
        for (int n = 0; n < 7; ++n) { g[n] = -INFINITY;
            if (n < qb) { float p = 0.f;
#pragma unroll
                for (int s = 0; s < 4; ++s) { const f32x4 k0v = *(const LAS f32x4*)(kmean + n * 64 + 16 * s + 8 * hi), k1v = *(const LAS f32x4*)(kmean + n * 64 + 16 * s + 8 * hi + 4);
                    p += bf2f((unsigned short)qf[s][0]) * k0v[0] + bf2f((unsigned short)qf[s][1]) * k0v[1] + bf2f((unsigned short)qf[s][2]) * k0v[2] + bf2f((unsigned short)qf[s][3]) * k0v[3]
                       + bf2f((unsigned short)qf[s][4]) * k1v[0] + bf2f((unsigned short)qf[s][5]) * k1v[1] + bf2f((unsigned short)qf[s][6]) * k1v[2] + bf2f((unsigned short)qf[s][7]) * k1v[3]; }
                p += __shfl_xor(p, 32); g[n] = p; } }
        if (qb <= 3) selmask = (1u << qb) - 1u;
        else {
#pragma unroll
            for (int n = 0; n < 7; ++n) if (n < qb) { int cnt = 0;
#pragma unroll
                for (int n2 = 0; n2 < 7; ++n2) if (n2 != n && n2 < qb) cnt += (g[n2] > g[n] || (g[n2] == g[n] && n2 < n)) ? 1 : 0;
                if (cnt < 3) selmask |= 1u << n; } }
        unsigned wmask = 0u;
#pragma unroll
        for (int n = 0; n < 7; ++n) if (__ballot((selmask >> n) & 1u) != 0ull) wmask |= 1u << n;
        if (lane == 0 && wmask) __hip_atomic_fetch_or((LAS unsigned*)needw, wmask, __ATOMIC_RELAXED, __HIP_MEMORY_SCOPE_WORKGROUP);
        __syncthreads();
        const unsigned need = needw[0] | (1u << qb);
        float mrun = -INFINITY, lrun = 0.f; f32x16 o0, o1;
#pragma unroll
        for (int i = 0; i < 16; ++i) { o0[i] = 0.f; o1[i] = 0.f; }
        const int qpos = q0 + r32;
        const bf16* Kg = MK + ((size_t)b * 2048 + (tid >> 3)) * 512 + hh * 64 + (tid & 7) * 8;
        const bf16* Vg = MVT + ((size_t)(b * 8 + hh) * 64 + (tid >> 3)) * 2048 + (tid & 7) * 8;
        const int sto = (tid >> 3) * KROW + (tid & 7) * 16;
        int blk = 0; while (!((need >> blk) & 1u)) ++blk;
        int kt = 0, it = 0;
        { const int k0 = blk * 256; const u32x4 kr = *(const u32x4*)(Kg + (size_t)k0 * 512), vr = *(const u32x4*)(Vg + k0);
          *(LAS u32x4*)(F.lds + OFF_K + sto) = kr; *(LAS u32x4*)(F.lds + OFF_V + sto) = vr; }
        __syncthreads();
        while (blk <= qb) {
            int nblk = blk, nkt = kt + 1; if (nkt == 4) { nkt = 0; ++nblk; while (nblk <= qb && !((need >> nblk) & 1u)) ++nblk; }
            const bool more = nblk <= qb; u32x4 kr, vr;
            if (more) { const int k0n = nblk * 256 + nkt * 64; kr = *(const u32x4*)(Kg + (size_t)k0n * 512); vr = *(const u32x4*)(Vg + k0n); }
            const int k0 = blk * 256 + kt * 64; const bool own = blk == qb; const bool selme = own || ((selmask >> blk) & 1u);
            const bool active = own ? (k0 <= q0 + 31) : (__ballot(selme) != 0ull);
            if (active) {
                const LAS unsigned char* kb = F.lds + OFF_K + (it & 1) * KBUF + r32 * KROW + 16 * hi;
                const LAS unsigned char* vb = F.lds + OFF_V + (it & 1) * KBUF + r32 * KROW + 16 * hi;
                const bool h1 = !own || (k0 + 32 <= q0 + 31);
                f32x16 s0, s1;
#pragma unroll
                for (int i = 0; i < 16; ++i) { s0[i] = 0.f; s1[i] = 0.f; }
#pragma unroll
                for (int s = 0; s < 4; ++s) s0 = __builtin_amdgcn_mfma_f32_32x32x16_bf16(*(const LAS bf16x8*)(kb + 32 * s), qf[s], s0, 0, 0, 0);
                if (h1) {
#pragma unroll
                    for (int s = 0; s < 4; ++s) s1 = __builtin_amdgcn_mfma_f32_32x32x16_bf16(*(const LAS bf16x8*)(kb + 32 * KROW + 32 * s), qf[s], s1, 0, 0, 0); }
                float mx = -INFINITY;
                float bv0[16], bv1[16];
#pragma unroll
                for (int r = 0; r < 16; ++r) { const int d0 = qpos - (k0 + crow(r, hi)), d1 = d0 - 32; bv0[r] = btab[d0 < 0 ? 0 : d0]; bv1[r] = btab[d1 < 0 ? 0 : d1]; }
#pragma unroll
                for (int r = 0; r < 16; ++r) asm volatile("" : "+v"(bv0[r]), "+v"(bv1[r]));
#pragma unroll
                for (int r = 0; r < 16; ++r) { const int d0 = qpos - (k0 + crow(r, hi)), d1 = d0 - 32;
                    const bool v0 = selme && (!own || d0 >= 0), v1 = h1 && selme && (!own || d1 >= 0);
                    const float a0 = v0 ? s0[r] + bv0[r] : -INFINITY, a1 = v1 ? s1[r] + bv1[r] : -INFINITY;
                    s0[r] = a0; s1[r] = a1; mx = fmaxf(mx, fmaxf(a0, a1)); }
                mx = fmaxf(mx, __shfl_xor(mx, 32));
                const float mnew = fmaxf(mrun, mx), muse = (mnew == -INFINITY) ? 0.f : mnew;
                const float alpha = __builtin_amdgcn_exp2f(mrun - muse);
                float ps = 0.f;
#pragma unroll
                for (int r = 0; r < 16; ++r) { const float p0 = __builtin_amdgcn_exp2f(s0[r] - muse), p1 = __builtin_amdgcn_exp2f(s1[r] - muse); s0[r] = p0; s1[r] = p1; ps += p0 + p1; }
                lrun = lrun * alpha + ps; mrun = mnew;
#pragma unroll
                for (int i = 0; i < 16; ++i) { o0[i] *= alpha; o1[i] *= alpha; }
                const bf16x8 pa0 = pack_bf16x8(s0[0], s0[1], s0[2], s0[3], s0[4], s0[5], s0[6], s0[7]), pa1 = pack_bf16x8(s0[8], s0[9], s0[10], s0[11], s0[12], s0[13], s0[14], s0[15]);
                o0 = __builtin_amdgcn_mfma_f32_32x32x16_bf16(*(const LAS bf16x8*)(vb), pa0, o0, 0, 0, 0); o0 = __builtin_amdgcn_mfma_f32_32x32x16_bf16(*(const LAS bf16x8*)(vb + 32), pa1, o0, 0, 0, 0);
                o1 = __builtin_amdgcn_mfma_f32_32x32x16_bf16(*(const LAS bf16x8*)(vb + 32 * KROW), pa0, o1, 0, 0, 0); o1 = __builtin_amdgcn_mfma_f32_32x32x16_bf16(*(const LAS bf16x8*)(vb + 32 * KROW + 32), pa1, o1, 0, 0, 0);
                if (h1) {
                    const bf16x8 pb0 = pack_bf16x8(s1[0], s1[1], s1[2], s1[3], s1[4], s1[5], s1[6], s1[7]), pb1 = pack_bf16x8(s1[8], s1[9], s1[10], s1[11], s1[12], s1[13], s1[14], s1[15]);
                    o0 = __builtin_amdgcn_mfma_f32_32x32x16_bf16(*(const LAS bf16x8*)(vb + 64), pb0, o0, 0, 0, 0); o0 = __builtin_amdgcn_mfma_f32_32x32x16_bf16(*(const LAS bf16x8*)(vb + 96), pb1, o0, 0, 0, 0);
                    o1 = __builtin_amdgcn_mfma_f32_32x32x16_bf16(*(const LAS bf16x8*)(vb + 32 * KROW + 64), pb0, o1, 0, 0, 0); o1 = __builtin_amdgcn_mfma_f32_32x32x16_bf16(*(const LAS bf16x8*)(vb + 32 * KROW + 96), pb1, o1, 0, 0, 0); }
            }
            if (more) { *(LAS u32x4*)(F.lds + OFF_K + ((it + 1) & 1) * KBUF + sto) = kr; *(LAS u32x4*)(F.lds + OFF_V + ((it + 1) & 1) * KBUF + sto) = vr; }
            __syncthreads();
            blk = nblk; kt = nkt; ++it;
        }
        lrun += __shfl_xor(lrun, 32); const float inv = 1.0f / lrun;
        bf16* op = XB + tok * 1024 + 512 + hh * 64 + 4 * hi;
#pragma unroll
        for (int g4 = 0; g4 < 4; ++g4) { u32x2 w0, w1; w0.x = pk2(o0[4 * g4] * inv, o0[4 * g4 + 1] * inv); w0.y = pk2(o0[4 * g4 + 2] * inv, o0[4 * g4 + 3] * inv);
            w1.x = pk2(o1[4 * g4] * inv, o1[4 * g4 + 1] * inv); w1.y = pk2(o1[4 * g4 + 2] * inv, o1[4 * g4 + 3] * inv);
            *(u32x2*)(op + 8 * g4) = w0; *(u32x2*)(op + 32 + 8 * g4) = w1; }
    }
}

__device__ __forceinline__ void ph_xatt(Frame& F) {
    constexpr int KROW = 528, KBUF = 32 * KROW, VROW = 80, VBUF = 256 * VROW, OFF_K = 0, OFF_V = 2 * KBUF;
    const bf16* XQ = WSP(bf16, AR_XQ); const bf16* XK = WSP(bf16, WS_XK); const bf16* XVT = WSP(bf16, WS_XVT); bf16* XO = WSP(bf16, AR_XO);
    const int lane = F.lane, r32 = lane & 31, hi = lane >> 5, wave = F.wave, tid = F.tid;
    for (int u = blockIdx.x; u < 256; u += F.G) {
        const int b = u >> 5, hx = (u >> 3) & 3, qt = u & 7;
        const size_t tok = (size_t)b * 2048 + qt * 256 + wave * 32 + r32;
        const bf16* Qg = XQ + tok * 1024 + hx * 256 + 8 * hi;
        const bf16* Kg = XK + (size_t)(b * 256 + (tid >> 5)) * 1024 + hx * 256 + (tid & 31) * 8;
        const bf16* Vg = XVT + ((size_t)(b * 4 + hx) * 256 + (tid >> 2)) * 256 + (tid & 3) * 8;
        const int ksto = (tid >> 5) * KROW + (tid & 31) * 16, vsto = (tid >> 2) * VROW + (tid & 3) * 16;
        float mrun = -INFINITY, lrun = 0.f; f32x16 o[8];
#pragma unroll
        for (int dt = 0; dt < 8; ++dt)
#pragma unroll
            for (int i = 0; i < 16; ++i) o[dt][i] = 0.f;
        __syncthreads();
        { const u32x4 k0r = *(const u32x4*)(Kg), k1r = *(const u32x4*)(Kg + (size_t)16 * 1024), v0r = *(const u32x4*)(Vg), v1r = *(const u32x4*)(Vg + (size_t)128 * 256);
          *(LAS u32x4*)(F.lds + OFF_K + ksto) = k0r; *(LAS u32x4*)(F.lds + OFF_K + ksto + 16 * KROW) = k1r; *(LAS u32x4*)(F.lds + OFF_V + vsto) = v0r; *(LAS u32x4*)(F.lds + OFF_V + vsto + 128 * VROW) = v1r; }
        __syncthreads();
        for (int kt = 0; kt < 8; ++kt) {
            const bool more = kt + 1 < 8; const int k0n = (kt + 1) * 32; u32x4 s0r, s1r;
            if (more) { s0r = *(const u32x4*)(Kg + (size_t)k0n * 1024); s1r = *(const u32x4*)(Kg + (size_t)(k0n + 16) * 1024); }
            const LAS unsigned char* kb = F.lds + OFF_K + (kt & 1) * KBUF + r32 * KROW + 16 * hi;
            const LAS unsigned char* vb = F.lds + OFF_V + (kt & 1) * VBUF + r32 * VROW + 16 * hi;
            f32x16 sc;
#pragma unroll
            for (int i = 0; i < 16; ++i) sc[i] = 0.f;
            bf16x8 qa[4], qb[4];
#pragma unroll
            for (int s = 0; s < 4; ++s) qa[s] = *(const bf16x8*)(Qg + 16 * s);
#pragma unroll
            for (int s = 0; s < 4; ++s) qb[s] = *(const bf16x8*)(Qg + 64 + 16 * s);
#pragma unroll
            for (int s = 0; s < 4; ++s) sc = __builtin_amdgcn_mfma_f32_32x32x16_bf16(*(const LAS bf16x8*)(kb + 32 * s), qa[s], sc, 0, 0, 0);
            asm volatile("" ::: "memory");
#pragma unroll
            for (int s = 0; s < 4; ++s) qa[s] = *(const bf16x8*)(Qg + 128 + 16 * s);
#pragma unroll
            for (int s = 0; s < 4; ++s) sc = __builtin_amdgcn_mfma_f32_32x32x16_bf16(*(const LAS bf16x8*)(kb + 128 + 32 * s), qb[s], sc, 0, 0, 0);
            asm volatile("" ::: "memory");
#pragma unroll
            for (int s = 0; s < 4; ++s) qb[s] = *(const bf16x8*)(Qg + 192 + 16 * s);
#pragma unroll
            for (int s = 0; s < 4; ++s) sc = __builtin_amdgcn_mfma_f32_32x32x16_bf16(*(const LAS bf16x8*)(kb + 256 + 32 * s), qa[s], sc, 0, 0, 0);
            asm volatile("" ::: "memory");
#pragma unroll
            for (int s = 0; s < 4; ++s) sc = __builtin_amdgcn_mfma_f32_32x32x16_bf16(*(const LAS bf16x8*)(kb + 384 + 32 * s), qb[s], sc, 0, 0, 0);
            if (more) { LAS unsigned char* kd = F.lds + OFF_K + ((kt + 1) & 1) * KBUF + ksto; *(LAS u32x4*)(kd) = s0r; *(LAS u32x4*)(kd + 16 * KROW) = s1r;
                s0r = *(const u32x4*)(Vg + k0n); s1r = *(const u32x4*)(Vg + (size_t)128 * 256 + k0n); }
            float mx = sc[0];
#pragma unroll
            for (int r = 1; r < 16; ++r) mx = fmaxf(mx, sc[r]);
            mx = fmaxf(mx, __shfl_xor(mx, 32));
            const float mnew = fmaxf(mrun, mx), alpha = __builtin_amdgcn_exp2f(mrun - mnew);
            float ps = 0.f;
#pragma unroll
            for (int r = 0; r < 16; ++r) { const float p = __builtin_amdgcn_exp2f(sc[r] - mnew); sc[r] = p; ps += p; }
            lrun = lrun * alpha + ps; mrun = mnew;
            const bf16x8 pf0 = pack_bf16x8(sc[0], sc[1], sc[2], sc[3], sc[4], sc[5], sc[6], sc[7]), pf1 = pack_bf16x8(sc[8], sc[9], sc[10], sc[11], sc[12], sc[13], sc[14], sc[15]);
#pragma unroll
            for (int dt = 0; dt < 8; ++dt) {
#pragma unroll
                for (int i = 0; i < 16; ++i) o[dt][i] *= alpha;
                o[dt] = __builtin_amdgcn_mfma_f32_32x32x16_bf16(*(const LAS bf16x8*)(vb + dt * 32 * VROW), pf0, o[dt], 0, 0, 0);
                o[dt] = __builtin_amdgcn_mfma_f32_32x32x16_bf16(*(const LAS bf16x8*)(vb + dt * 32 * VROW + 32), pf1, o[dt], 0, 0, 0); }
            if (more) { LAS unsigned char* vd = F.lds + OFF_V + ((kt + 1) & 1) * VBUF + vsto; *(LAS u32x4*)(vd) = s0r; *(LAS u32x4*)(vd + 128 * VROW) = s1r; }
            __syncthreads();
        }
        lrun += __shfl_xor(lrun, 32); const float inv = 1.0f / lrun;
        bf16* op = XO + tok * 1024 + hx * 256 + 4 * hi;
#pragma unroll
        for (int dt = 0; dt < 8; ++dt)
#pragma unroll
            for (int g4 = 0; g4 < 4; ++g4) { u32x2 w; w.x = pk2(o[dt][4 * g4] * inv, o[dt][4 * g4 + 1] * inv); w.y = pk2(o[dt][4 * g4 + 2] * inv, o[dt][4 * g4 + 3] * inv);
                *(u32x2*)(op + 32 * dt + 8 * g4) = w; }
    }
}

__device__ __forceinline__ void ph_prep(Frame& F, int l) {
    constexpr int LROW = 528;
    LAS unsigned char* lat = F.lds;
    const bf16* PR = WSP(bf16, AR_PR); bf16* SCANIN = WSP(bf16, AR_SCANIN); bf16* XB = WSP(bf16, WS_XB); float* BONUS = WSP(float, WS_BONUS);
    const bf16* WUPT = (const bf16*)(F.ws + WS_W + W_WUPT); const bf16* AUPT = (const bf16*)(F.ws + WS_W + W_AUPT); const bf16* GUPT = (const bf16*)(F.ws + WS_W + W_GUPT);
    const int h = F.wave, lane = F.lane, r32 = lane & 31, hi = lane >> 5;
    const float* mu = FIN(I_MU) + l * RPROJ; const float* w0p = FIN(I_W0) + l * RW; const float* a0p = FIN(I_A0) + l * RW; const float* kkp = FIN(I_KK) + l * RW; const float* kap = FIN(I_KA) + l * RW; const float* rkp = FIN(I_RK) + l * RW;
    for (int task = blockIdx.x; task < M / 32; task += F.G) { const int t0 = task * 32;
        __syncthreads();
        { const int tt = F.tid >> 4, l16 = (F.tid & 15) * 16, t = t0 + tt; const bf16* pc = PR + (size_t)t * RPROJ + 1536 + l16;
          u32x4 cur[2], prv[2]; cur[0] = *(const u32x4*)pc; cur[1] = *(const u32x4*)(pc + 8); prv[0] = (u32x4){0u, 0u, 0u, 0u}; prv[1] = prv[0];
          if (t & 2047) { prv[0] = *(const u32x4*)(pc - RPROJ); prv[1] = *(const u32x4*)(pc - RPROJ + 8); }
          u32x4 ow[2];
#pragma unroll
          for (int hh = 0; hh < 2; ++hh) { const f32x4 m0 = *(const f32x4*)(mu + 1536 + l16 + 8 * hh), m1 = *(const f32x4*)(mu + 1536 + l16 + 8 * hh + 4); float xv[8];
#pragma unroll
              for (int i = 0; i < 4; ++i) { const unsigned cw = cur[hh][i], pw = prv[hh][i]; const float p0 = bf2f(cw & 0xffffu), p1 = bf2f(cw >> 16), q0 = bf2f(pw & 0xffffu), q1 = bf2f(pw >> 16);
                  const float ma = i < 2 ? m0[2 * i] : m1[2 * i - 4], mb = i < 2 ? m0[2 * i + 1] : m1[2 * i - 3];
                  xv[2 * i] = p0 + (q0 - p0) * ma; xv[2 * i + 1] = p1 + (q1 - p1) * mb; }
#pragma unroll
              for (int i = 0; i < 8; ++i) { if (l16 < 64) xv[i] = 1.0f - 2.0f * __builtin_amdgcn_rcpf(1.0f + __expf(2.0f * xv[i])); else if (l16 >= 128) xv[i] = sigmoidf_(xv[i]); }
              ow[hh] = (u32x4){pk2(xv[0], xv[1]), pk2(xv[2], xv[3]), pk2(xv[4], xv[5]), pk2(xv[6], xv[7])}; }
          *(LAS u32x4*)(lat + tt * LROW + l16 * 2) = ow[0]; *(LAS u32x4*)(lat + tt * LROW + l16 * 2 + 16) = ow[1]; }
        __syncthreads();
        const int t = t0 + r32, bb = t >> 11, tp = t & 2047; const bool hasprev = tp != 0;
        const bf16* prow = PR + (size_t)t * RPROJ; bf16* so = SCANIN + ((size_t)(bb * 8 + h) * 2048 + tp) * 384;
        float n2 = 0.f, bon = 0.f;
#pragma unroll
        for (int q = 0; q < 8; ++q) { const int c4 = h * 64 + 8 * q + 4 * hi;
            const u32x2 kc = *(const u32x2*)(prow + 512 + c4); u32x2 kp = {0u, 0u}; if (hasprev) kp = *(const u32x2*)(prow + 512 + c4 - RPROJ);
            const f32x4 mk = *(const f32x4*)(mu + 512 + c4), kkc = *(const f32x4*)(kkp + c4);
#pragma unroll
            for (int i = 0; i < 4; ++i) { const unsigned sh = (i & 1) * 16; float k = bf2f((kc[i >> 1] >> sh) & 0xffffu); const float kq = bf2f((kp[i >> 1] >> sh) & 0xffffu);
                k += (kq - k) * mk[i]; const float kk = k * kkc[i]; n2 += kk * kk; } }
        n2 += __shfl_xor(n2, 32);
        const float inv = 1.0f / fmaxf(sqrtf(n2), 1e-12f);
        asm volatile("" ::: "memory");
#pragma unroll 1
        for (int ct = 0; ct < 2; ++ct) { const int cb = h * 64 + 32 * ct;
            f32x16 aw, aa, ag;
#pragma unroll
            for (int i = 0; i < 16; ++i) { aw[i] = 0.f; aa[i] = 0.f; ag[i] = 0.f; }
            const LAS unsigned char* lb = lat + r32 * LROW + 16 * hi;
#pragma unroll
            for (int s = 0; s < 4; ++s) { const bf16x8 wf = *(const bf16x8*)(WUPT + (size_t)(cb + r32) * 64 + 16 * s + 8 * hi), af = *(const bf16x8*)(AUPT + (size_t)(cb + r32) * 64 + 16 * s + 8 * hi);
                const bf16x8 lw = *(const LAS bf16x8*)(lb + 32 * s), la = *(const LAS bf16x8*)(lb + 128 + 32 * s);
                aw = __builtin_amdgcn_mfma_f32_32x32x16_bf16(wf, lw, aw, 0, 0, 0); aa = __builtin_amdgcn_mfma_f32_32x32x16_bf16(af, la, aa, 0, 0, 0); }
#pragma unroll
            for (int s = 0; s < 8; ++s) { const bf16x8 gf = *(const bf16x8*)(GUPT + (size_t)(cb + r32) * 128 + 16 * s + 8 * hi); const bf16x8 lg = *(const LAS bf16x8*)(lb + 256 + 32 * s);
                ag = __builtin_amdgcn_mfma_f32_32x32x16_bf16(gf, lg, ag, 0, 0, 0); }
#pragma unroll
            for (int g = 0; g < 4; ++g) { const int c4 = cb + 8 * g + 4 * hi;
                asm volatile("" ::: "memory");
                const u32x2 rc = *(const u32x2*)(prow + c4), kc = *(const u32x2*)(prow + 512 + c4), vc = *(const u32x2*)(prow + 1024 + c4);
                u32x2 rp = {0u, 0u}, kp = {0u, 0u}, vp = {0u, 0u};
                if (hasprev) { rp = *(const u32x2*)(prow + c4 - RPROJ); kp = *(const u32x2*)(prow + 512 + c4 - RPROJ); vp = *(const u32x2*)(prow + 1024 + c4 - RPROJ); }
                const f32x4 mr = *(const f32x4*)(mu + c4), mk = *(const f32x4*)(mu + 512 + c4), mv = *(const f32x4*)(mu + 1024 + c4);
                const f32x4 w0v = *(const f32x4*)(w0p + c4), a0v = *(const f32x4*)(a0p + c4), kkc = *(const f32x4*)(kkp + c4), kac = *(const f32x4*)(kap + c4), rkc = *(const f32x4*)(rkp + c4);
                float ro[4], ko[4], vo[4], ldo[4], go[4], nk[4], bo[4];
#pragma unroll
                for (int i = 0; i < 4; ++i) { const unsigned sh = (i & 1) * 16;
                    float r = bf2f((rc[i >> 1] >> sh) & 0xffffu), k = bf2f((kc[i >> 1] >> sh) & 0xffffu), v = bf2f((vc[i >> 1] >> sh) & 0xffffu);
                    const float rq = bf2f((rp[i >> 1] >> sh) & 0xffffu), kq = bf2f((kp[i >> 1] >> sh) & 0xffffu), vq = bf2f((vp[i >> 1] >> sh) & 0xffffu);
                    r += (rq - r) * mr[i]; k += (kq - k) * mk[i]; v += (vq - v) * mv[i];
                    const float wv = w0v[i] + aw[4 * g + i], xs = -wv, sp = xs > 20.f ? xs : __logf(1.0f + __expf(xs)), ld = -__expf(-sp - 0.5f);
                    const float a = sigmoidf_(a0v[i] + aa[4 * g + i]);
                    const float kn = k * kkc[i] * inv, kt = k * (1.0f + (a - 1.0f) * kac[i]);
                    bon += r * kt * rkc[i];
                    ro[i] = r; ko[i] = kt; vo[i] = v; ldo[i] = ld; go[i] = ag[4 * g + i]; nk[i] = -kn; bo[i] = kn * a; }
                const int co = 32 * ct + 8 * g + 4 * hi;
                *(u32x2*)(so + co) = (u32x2){pk2(nk[0], nk[1]), pk2(nk[2], nk[3])}; *(u32x2*)(so + 64 + co) = (u32x2){pk2(ldo[0], ldo[1]), pk2(ldo[2], ldo[3])};
                *(u32x2*)(so + 128 + co) = (u32x2){pk2(bo[0], bo[1]), pk2(bo[2], bo[3])}; *(u32x2*)(so + 192 + co) = (u32x2){pk2(ko[0], ko[1]), pk2(ko[2], ko[3])};
                *(u32x2*)(so + 256 + co) = (u32x2){pk2(ro[0], ro[1]), pk2(ro[2], ro[3])}; *(u32x2*)(so + 320 + co) = (u32x2){pk2(vo[0], vo[1]), pk2(vo[2], vo[3])};
                *(u32x2*)(XB + (size_t)t * 1024 + c4) = (u32x2){pk2(go[0], go[1]), pk2(go[2], go[3])}; }
        }
        bon += __shfl_xor(bon, 32);
        if (hi == 0) BONUS[(size_t)t * 8 + h] = bon;
    }
}

template <int R, int NCH, bool KINDP>
__device__ __forceinline__ void scan_stream(Frame& F, LAS float* ring, int bh, int ch, int rg, int lis) {
    typedef float f32x2 __attribute__((ext_vector_type(2)));
    constexpr int CLEN = SEQ / NCH, NHALF = CLEN / 8;
    const int lane = F.lane, js = lane & 3, q = lane >> 2, row0 = rg * 16 * R + q * R, tbase = ch * CLEN;
    const bf16* src = WSP(bf16, AR_SCANIN) + ((size_t)bh * 2048 + tbase) * 384;
    float* YL = WSP(float, AR_YLOC) + ((size_t)bh * 2048 + tbase) * 64; bf16* ZZ = WSP(bf16, AR_Z) + ((size_t)bh * 2048 + tbase) * 64;
    f32x2 S[R][8];
#pragma unroll
    for (int rr = 0; rr < R; ++rr)
#pragma unroll
        for (int k = 0; k < 8; ++k) { S[rr][k].x = (KINDP && (row0 + rr) == 16 * js + 2 * k) ? 1.f : 0.f; S[rr][k].y = (KINDP && (row0 + rr) == 16 * js + 2 * k + 1) ? 1.f : 0.f; }
    u32x4 pre[2];
#pragma unroll
    for (int k = 0; k < 2; ++k) { const int ci = lis + k * 256; if (ci < 384) pre[k] = *(const u32x4*)(src + (size_t)ci * 8); }
#pragma unroll
    for (int k = 0; k < 2; ++k) { const int ci = lis + k * 256; if (ci < 384) { const bool isld = ((ci % 48) >> 3) == 1; float f[8];
#pragma unroll
            for (int i = 0; i < 4; ++i) { f[2 * i] = bf2f(pre[k][i] & 0xffffu); f[2 * i + 1] = bf2f(pre[k][i] >> 16); }
            if (isld) {
#pragma unroll
                for (int i = 0; i < 8; ++i) f[i] = __expf(f[i]); }
            *(LAS f32x4*)(ring + ci * 8) = (f32x4){f[0], f[1], f[2], f[3]}; *(LAS f32x4*)(ring + ci * 8 + 4) = (f32x4){f[4], f[5], f[6], f[7]}; } }
    __syncthreads();
    for (int hf = 0; hf < NHALF; ++hf) {
        const bool more = hf + 1 < NHALF;
        if (more) {
#pragma unroll
            for (int k = 0; k < 2; ++k) { const int ci = lis + k * 256; if (ci < 384) pre[k] = *(const u32x4*)(src + (size_t)(hf + 1) * 3072 + (size_t)ci * 8); } }
#pragma unroll 2
        for (int st = 0; st < 8; ++st) {
            const LAS float* sp = ring + ((hf & 1) * 8 + st) * 384 + 16 * js;
            f32x2 nn[8], ww[8], bb[8], kk[8], rr2[8];
#pragma unroll
            for (int i = 0; i < 4; ++i) { const f32x4 a = *(const LAS f32x4*)(sp + 4 * i); nn[2 * i] = (f32x2){a[0], a[1]}; nn[2 * i + 1] = (f32x2){a[2], a[3]}; }
#pragma unroll
            for (int i = 0; i < 4; ++i) { const f32x4 a = *(const LAS f32x4*)(sp + 64 + 4 * i); ww[2 * i] = (f32x2){a[0], a[1]}; ww[2 * i + 1] = (f32x2){a[2], a[3]}; }
#pragma unroll
            for (int i = 0; i < 4; ++i) { const f32x4 a = *(const LAS f32x4*)(sp + 128 + 4 * i); bb[2 * i] = (f32x2){a[0], a[1]}; bb[2 * i + 1] = (f32x2){a[2], a[3]}; }
            if (!KINDP) {
#pragma unroll
                for (int i = 0; i < 4; ++i) { const f32x4 a = *(const LAS f32x4*)(sp + 192 + 4 * i); kk[2 * i] = (f32x2){a[0], a[1]}; kk[2 * i + 1] = (f32x2){a[2], a[3]}; } }
#pragma unroll
            for (int i = 0; i < 4; ++i) { const f32x4 a = *(const LAS f32x4*)(sp + 256 + 4 * i); rr2[2 * i] = (f32x2){a[0], a[1]}; rr2[2 * i + 1] = (f32x2){a[2], a[3]}; }
            float vv[R];
            if (!KINDP) {
#pragma unroll
                for (int rr = 0; rr < R; ++rr) vv[rr] = ring[((hf & 1) * 8 + st) * 384 + 320 + row0 + rr]; }
            float sa[R];
#pragma unroll
            for (int rr = 0; rr < R; ++rr) { f32x2 p0 = S[rr][0] * nn[0], p1 = S[rr][1] * nn[1];
#pragma unroll
                for (int k = 2; k < 8; k += 2) { p0 = S[rr][k] * nn[k] + p0; p1 = S[rr][k + 1] * nn[k + 1] + p1; }
                p0 = p0 + p1; sa[rr] = quad_sum(p0.x + p0.y); }
            float y[R];
#pragma unroll
            for (int rr = 0; rr < R; ++rr) { const f32x2 sa2 = (f32x2){sa[rr], sa[rr]}; f32x2 p0 = (f32x2){0.f, 0.f}, p1 = (f32x2){0.f, 0.f};
#pragma unroll
                for (int k = 0; k < 8; k += 2) {
                    f32x2 t0 = S[rr][k] * ww[k], t1 = S[rr][k + 1] * ww[k + 1];
                    t0 = sa2 * bb[k] + t0; t1 = sa2 * bb[k + 1] + t1;
                    if (!KINDP) { const f32x2 v2 = (f32x2){vv[rr], vv[rr]}; t0 = v2 * kk[k] + t0; t1 = v2 * kk[k + 1] + t1; }
                    S[rr][k] = t0; S[rr][k + 1] = t1; p0 = t0 * rr2[k] + p0; p1 = t1 * rr2[k + 1] + p1; }
                p0 = p0 + p1; y[rr] = quad_sum(p0.x + p0.y); }
            if (js == 0) { const int t = hf * 8 + st;
                if (R == 2) { if (KINDP) *(unsigned*)(ZZ + (size_t)t * 64 + row0) = pk2(y[0], y[R - 1]); else *(f32x2*)(YL + (size_t)t * 64 + row0) = (f32x2){y[0], y[R - 1]}; }
                else {
#pragma unroll
                    for (int rr = 0; rr < R; ++rr) { if (KINDP) ZZ[(size_t)t * 64 + row0 + rr] = (bf16)f2bf(y[rr]); else YL[(size_t)t * 64 + row0 + rr] = y[rr]; } } }
        }
        if (more) {
#pragma unroll
            for (int k = 0; k < 2; ++k) { const int ci = lis + k * 256; if (ci < 384) { const bool isld = ((ci % 48) >> 3) == 1; float f[8];
#pragma unroll
                    for (int i = 0; i < 4; ++i) { f[2 * i] = bf2f(pre[k][i] & 0xffffu); f[2 * i + 1] = bf2f(pre[k][i] >> 16); }
                    if (isld) {
#pragma unroll
                        for (int i = 0; i < 8; ++i) f[i] = __expf(f[i]); }
                    LAS float* dst = ring + (((hf + 1) & 1) * 8) * 384 + ci * 8;
                    *(LAS f32x4*)(dst) = (f32x4){f[0], f[1], f[2], f[3]}; *(LAS f32x4*)(dst + 4) = (f32x4){f[4], f[5], f[6], f[7]}; } } }
        __syncthreads();
    }
    if (NCH > 1) {
        float* st = WSP(float, AR_STATE) + ((size_t)(bh * NCH + ch) * 2 + (KINDP ? 0 : 1)) * 4096;
#pragma unroll
        for (int rr = 0; rr < R; ++rr)
#pragma unroll
            for (int i = 0; i < 4; ++i) *(f32x4*)(st + (size_t)(row0 + rr) * 64 + 16 * js + 4 * i) = (f32x4){S[rr][2 * i].x, S[rr][2 * i].y, S[rr][2 * i + 1].x, S[rr][2 * i + 1].y};
    }
}
template <int R, int NCH>
__device__ __forceinline__ void ph_scan(Frame& F) {
    constexpr int KINDS = NCH > 1 ? 2 : 1, RG = 4 / R, WPS = KINDS * RG, SPW = NWAVES / WPS, NSTREAM = BATCH * NH * NCH;
    static_assert(WPS == 4, "staging assumes 4 waves per stream");
    const int sl = F.wave / WPS, role = F.wave % WPS, kind = role / RG, rg = role % RG, lis = role * 64 + F.lane;
    LAS float* ring = (LAS float*)F.lds + sl * (16 * 384);
    for (int it = blockIdx.x; it * SPW < NSTREAM; it += F.G) {
        const int sid = it * SPW + sl, bh = sid / NCH, ch = sid % NCH;
        __syncthreads();
        if (kind == 0) scan_stream<R, NCH, false>(F, ring, bh, ch, rg, lis); else scan_stream<R, NCH, true>(F, ring, bh, ch, rg, lis);
    }
}

template <int NCH>
__device__ __forceinline__ void ph_fix(Frame& F) {
    typedef float f32x2 __attribute__((ext_vector_type(2)));
    LAS float* cur = (LAS float*)F.lds;
    for (int u = blockIdx.x; u < 256; u += F.G) { const int bh = u >> 2, rgx = u & 3, i = F.tid >> 5, j2 = (F.tid & 31) * 2, row = rgx * 16 + i;
        float* base = WSP(float, AR_STATE) + (size_t)bh * NCH * 2 * 4096;
        __syncthreads();
        { const f32x2 v = *(const f32x2*)(base + 4096 + row * 64 + j2); cur[i * 64 + j2] = v.x; cur[i * 64 + j2 + 1] = v.y; }
        __syncthreads();
        for (int c = 1; c < NCH - 1; ++c) { const float* P = base + (size_t)(c * 2) * 4096; float* SL = base + (size_t)(c * 2 + 1) * 4096;
            f32x2 acc = *(const f32x2*)(SL + row * 64 + j2);
#pragma unroll
            for (int ii = 0; ii < 64; ++ii) { const float sv = cur[i * 64 + ii]; const f32x2 p = *(const f32x2*)(P + ii * 64 + j2); acc.x += sv * p.x; acc.y += sv * p.y; }
            __syncthreads();
            cur[i * 64 + j2] = acc.x; cur[i * 64 + j2 + 1] = acc.y; *(f32x2*)(SL + row * 64 + j2) = acc;
            __syncthreads(); }
    }
}

template <int NCH>
__device__ __forceinline__ void ph_post(Frame& F, int l) {
    constexpr int CLEN = SEQ / NCH;
    const float* YL = WSP(float, AR_YLOC); const bf16* SCANIN = WSP(bf16, AR_SCANIN); bf16* XB = WSP(bf16, WS_XB); const float* BONUS = WSP(float, WS_BONUS); const bf16* ZZ = WSP(bf16, AR_Z);
    LAS float* zt = (LAS float*)F.lds;
    const int c = F.tid, h = F.wave, j = F.lane; const float lng = FIN(I_LNG)[l * RW + c], lnb = FIN(I_LNB)[l * RW + c];
    for (int grp = blockIdx.x; grp < M / 64; grp += F.G) { const int t0g = grp * 64, bb = t0g >> 11, ch = (t0g & 2047) / CLEN, bh = bb * 8 + h; const bool corr = NCH > 1 && ch > 0;
        float st[64];
        if (corr) { const float* sp = WSP(float, AR_STATE) + ((size_t)(bh * NCH + ch - 1) * 2 + 1) * 4096 + j * 64;
#pragma unroll
            for (int i4 = 0; i4 < 16; ++i4) { const f32x4 v = *(const f32x4*)(sp + 4 * i4); st[4 * i4] = v[0]; st[4 * i4 + 1] = v[1]; st[4 * i4 + 2] = v[2]; st[4 * i4 + 3] = v[3]; } }
        for (int ti = 0; ti < 4; ++ti) { const int t0 = t0g + 16 * ti;
            if (corr) { __syncthreads();
#pragma unroll 4
                for (int tt = 0; tt < 16; ++tt) zt[tt * 512 + c] = bf2f(ZZ[((size_t)bh * 2048 + ((t0 + tt) & 2047)) * 64 + j]);
                __syncthreads(); }
#pragma unroll 2
            for (int tt = 0; tt < 16; ++tt) { const int t = t0 + tt, tp = t & 2047;
                float y = YL[((size_t)bh * 2048 + tp) * 64 + j];
                if (corr) { const LAS float* zp = zt + tt * 512 + h * 64; float p0 = 0.f, p1 = 0.f, p2 = 0.f, p3 = 0.f;
#pragma unroll
                    for (int j4 = 0; j4 < 16; ++j4) { const f32x4 zz = *(const LAS f32x4*)(zp + 4 * j4); p0 += st[4 * j4] * zz[0]; p1 += st[4 * j4 + 1] * zz[1]; p2 += st[4 * j4 + 2] * zz[2]; p3 += st[4 * j4 + 3] * zz[3]; }
                    y += (p0 + p1) + (p2 + p3); }
                const float mean = wave_sum(y) * (1.0f / 64.0f), d = y - mean, var = wave_sum(d * d) * (1.0f / 64.0f);
                const float yn = d * __builtin_amdgcn_rsqf(var + LNX_EPS) * lng + lnb;
                const float v = bf2f(SCANIN[((size_t)bh * 2048 + tp) * 384 + 320 + j]), bon = BONUS[(size_t)t * 8 + h], g = bf2f(XB[(size_t)t * 1024 + c]);
                XB[(size_t)t * 1024 + c] = (bf16)f2bf((yn + bon * v) * g); }
        }
    }
}

__device__ __forceinline__ void ph_final(Frame& F) {
    const int gw = F.vcu * NWAVES + F.wave, NGW = F.G * NWAVES; const float* ssq = WSP(float, WS_SSQ); const float* g = FIN(I_FING);
    f32x4 gv[4];
#pragma unroll
    for (int j = 0; j < 4; ++j) gv[j] = ((const f32x4*)g)[F.lane + 64 * j];
    for (int r = gw; r < M; r += NGW) { const float rs = pg8::row_rstd16(ssq, r); f32x4* xr = (f32x4*)(F.out + (size_t)r * DM) + F.lane;
#pragma unroll
        for (int j = 0; j < 4; ++j) { const f32x4 v = xr[64 * j]; xr[64 * j] = v * rs * gv[j]; } }
}

constexpr int PH_INIT = 0, PH_PER_LAYER = 16, PH_FINAL = 1 + DEPTH * PH_PER_LAYER, N_PHASES = PH_FINAL + 1;
enum { K_CONV = 0, K_KV, K_F1UP, K_F1DN, K_MIXIN, K_MOBA, K_PREP, K_SCAN, K_FIX, K_POST, K_MIXOUT, K_XQ, K_XATT, K_XO, K_F2UP, K_F2DN };

#ifdef ONLY
#define PH_ON(k) ((k) == (ONLY))
#else
#define PH_ON(k) true
#endif
__global__ void __launch_bounds__(NWAVES * 64, 2) fwd(Args args) {
    extern __shared__ __attribute__((aligned(16))) unsigned char lds[];
    Frame F;
    F.lds = (LAS unsigned char*)lds; F.MISC = (volatile LAS unsigned*)(F.lds + MISC_OFF);
    F.tid = threadIdx.x; F.lane = F.tid & 63; F.wave = __builtin_amdgcn_readfirstlane(F.tid >> 6);
    F.G = gridDim.x; { const int bx = blockIdx.x; F.vcu = (F.G % 8 == 0) ? (bx % 8) * (F.G / 8) + bx / 8 : bx; }
    F.out = args.out; F.ws = args.ws; F.ctl = (gu32*)(args.ws + WS_CTL);
    F.ka = (const __attribute__((address_space(4))) Args*)(uintptr_t)__builtin_amdgcn_kernarg_segment_ptr();
    for (int u = F.tid; u < (LDS_BYTES - LDSCTL_OFF) / 4; u += NWAVES * 64) ((LAS unsigned*)(F.lds + LDSCTL_OFF))[u] = 0u;
    __syncthreads();
    const bool multi = args.ph_hi - args.ph_lo > 1;
    XcdBarrier bar; bar.bar = (unsigned*)(F.ctl + 4096); bar.x = 0; bar.st = nullptr;
    if (multi) bar = xcd_barrier_post((unsigned*)(F.ctl + 4096), F.MISC + 8);
#ifndef REP_AT
#define REP_AT 1000
#endif
    for (int pi = args.ph_lo; pi < args.ph_hi + (REP_AT < 1000 ? 1 : 0); ++pi) { const int ph = pi - (pi > REP_AT ? 1 : 0);
        { uintptr_t kp = (uintptr_t)__builtin_amdgcn_kernarg_segment_ptr(); asm volatile("" : "+s"(kp)); F.ka = (const __attribute__((address_space(4))) Args*)kp; }
        { int t_ = threadIdx.x; asm volatile("" : "+v"(t_)); F.tid = t_; F.lane = t_ & 63; F.wave = __builtin_amdgcn_readfirstlane(t_ >> 6); }
        unsigned char* wb = F.ws + WS_W;
        if (ph == PH_INIT) { if (PH_ON(100)) ph_init(F); }
        else if (ph == PH_FINAL) { if (PH_ON(101)) ph_final(F); }
        else { const int l = (ph - 1) / PH_PER_LAYER, k = (ph - 1) % PH_PER_LAYER;
            const float* xin = (l == 0) ? FIN(I_X) : (const float*)F.out;
            switch (k) {
            case K_CONV: if (!PH_ON(K_CONV)) break; ph_conv(F, l); break;
            case K_KV: if (!PH_ON(K_KV)) break; { pg8::Gemm g{WSP(bf16, WS_MEMB), (const bf16*)(wb + W_WKV), MM, 2 * DM, DM}; pg8::StaticOrder S; S.init(MM, 2 * DM, F.G, (int)blockIdx.x);
                pg8::EpiKV E{F.ws}; pg8::gemm_phase<pg8::EpiKV, pg8::StaticOrder, true, true>(F.lds, g, S, E); } break;
            case K_F1UP: case K_F2UP: if (!PH_ON(K_F1UP)) break; { pg8::Gemm g{WSP(bf16, WS_XB), (const bf16*)(wb + (k == K_F1UP ? W_F1IN : W_F2IN)), M, 2 * DFF, DM}; pg8::StaticOrder S; S.init(M, 2 * DFF, F.G, (int)blockIdx.x);
                pg8::EpiSwiGLU E{F.ws}; pg8::gemm_phase<pg8::EpiSwiGLU, pg8::StaticOrder, true, true>(F.lds, g, S, E); } break;
            case K_F1DN: case K_F2DN: if (!PH_ON(K_F1DN)) break; { pg8::Gemm g{WSP(bf16, AR_H), (const bf16*)(wb + (k == K_F1DN ? W_F1OUT : W_F2OUT)), M, DM, DFF}; pg8::StaticOrder S; S.init(M, DM, F.G, (int)blockIdx.x);
                pg8::EpiResid E{k == K_F1DN ? xin : (const float*)F.out, F.out, F.ws, WS_XB, 0.5f}; pg8::gemm_phase<pg8::EpiResid, pg8::StaticOrder, true, true>(F.lds, g, S, E); } break;
            case K_MIXIN: if (!PH_ON(K_MIXIN)) break; { pg8::Gemm g{WSP(bf16, WS_XB), (const bf16*)(wb + W_MIXIN), M, DPROJ, DM}; pg8::StaticOrder S; S.init(M, DPROJ, F.G, (int)blockIdx.x);
                pg8::EpiMixIn E{F.ws}; pg8::gemm_phase<pg8::EpiMixIn, pg8::StaticOrder, true, true>(F.lds, g, S, E); } break;
            case K_MOBA: if (!PH_ON(K_MOBA)) break; ph_moba(F); break;
            case K_PREP: if (!PH_ON(K_PREP)) break; ph_prep(F, l); break;
            case K_SCAN: if (!PH_ON(K_SCAN)) break; ph_scan<SCAN_R, SCAN_NCH>(F); break;
            case K_FIX: if (!PH_ON(K_FIX)) break; if (SCAN_NCH > 1) ph_fix<SCAN_NCH>(F); break;
            case K_POST: if (!PH_ON(K_POST)) break; ph_post<SCAN_NCH>(F, l); break;
            case K_MIXOUT: if (!PH_ON(K_MIXOUT)) break; { pg8::Gemm g{WSP(bf16, WS_XB), (const bf16*)(wb + W_MIXOUT), M, DM, DM}; pg8::StaticOrder S; S.init(M, DM, F.G, (int)blockIdx.x);
                pg8::EpiResid E{F.out, F.out, F.ws, AR_XB2, 1.0f}; pg8::gemm_phase<pg8::EpiResid, pg8::StaticOrder, true, true>(F.lds, g, S, E); } break;
            case K_XQ: if (!PH_ON(K_XQ)) break; { pg8::Gemm g{WSP(bf16, AR_XB2), (const bf16*)(wb + W_WQ), M, DM, DM}; pg8::StaticOrder S; S.init(M, DM, F.G, (int)blockIdx.x);
                pg8::EpiXQ E{F.ws}; pg8::gemm_phase<pg8::EpiXQ, pg8::StaticOrder, true, true>(F.lds, g, S, E); } break;
            case K_XATT: if (!PH_ON(K_XATT)) break; ph_xatt(F); break;
            case K_XO: if (!PH_ON(K_XO)) break; { pg8::Gemm g{WSP(bf16, AR_XO), (const bf16*)(wb + W_WO), M, DM, DM}; pg8::StaticOrder S; S.init(M, DM, F.G, (int)blockIdx.x);
                pg8::EpiResid E{F.out, F.out, F.ws, WS_XB, 1.0f}; pg8::gemm_phase<pg8::EpiResid, pg8::StaticOrder, true, true>(F.lds, g, S, E); } break;
            default: break;
            }
        }
        if (pi + 1 < args.ph_hi + (REP_AT < 1000 ? 1 : 0)) {
            const bool noop = (ph != PH_INIT && ph != PH_FINAL && ((ph - 1) % PH_PER_LAYER) == K_FIX && SCAN_NCH == 1);
            if (!noop) { if (ph == PH_INIT) cooperative_groups::this_grid().sync(); else xcd_barrier(bar); }
        }
    }
}

extern "C" void kernel_launch(void* const* d_in, const int* in_sizes, int n_in, void* d_out, int out_size, void* d_ws, size_t ws_size, hipStream_t stream) {
    static int grid = 0;
    if (grid == 0) {
        if (n_in != N_IN || in_sizes[0] != M * DM || out_size != M * DM || ws_size < WS_END) { fprintf(stderr, "kernel_launch: unexpected problem (n_in %d, in0 %d, out %d, ws %zu < %zu); nothing launched\n", n_in, n_in > 0 ? in_sizes[0] : -1, out_size, ws_size, (size_t)WS_END); grid = -1; return; }
        int dev = 0, cus = 0;
        if (hipGetDevice(&dev) != hipSuccess || hipDeviceGetAttribute(&cus, hipDeviceAttributeMultiprocessorCount, dev) != hipSuccess) { grid = -1; return; }
        if (hipFuncSetAttribute((const void*)fwd, hipFuncAttributeMaxDynamicSharedMemorySize, LDS_BYTES) != hipSuccess) { fprintf(stderr, "kernel_launch: hipFuncSetAttribute failed\n"); grid = -1; return; }
        int per_cu = 0;
        if (hipOccupancyMaxActiveBlocksPerMultiprocessor(&per_cu, (const void*)fwd, NWAVES * 64, LDS_BYTES) != hipSuccess || per_cu < 1) { fprintf(stderr, "kernel_launch: occupancy query reports %d workgroups per CU; nothing launched\n", per_cu); grid = -1; return; }
        grid = cus;
    }
    if (grid < 0) return;
    (void)hipMemsetAsync((char*)d_ws + WS_CTL, 0, CTL_ZERO_BYTES, stream);
    Args a{};
    for (int i = 0; i < N_IN; ++i) a.in[i] = (const float*)d_in[i];
    a.out = (float*)d_out; a.ws = (unsigned char*)d_ws;
    a.ph_lo = 0; a.ph_hi = N_PHASES;
    void* kargs[] = {&a};
    const hipError_t e = hipLaunchCooperativeKernel((const void*)fwd, dim3(grid), dim3(NWAVES * 64), kargs, LDS_BYTES, stream);
    if (e != hipSuccess) fprintf(stderr, "kernel_launch: cooperative launch failed: %s (grid %d)\n", hipGetErrorString(e), grid);
}
```

```cpp
#include <hip/hip_runtime.h>
#include <hip/hip_cooperative_groups.h>
#include <cstdio>
#include <cstdint>

constexpr int BATCH = 8, SEQ = 2048, DM = 1024, DEPTH = 2, M = BATCH * SEQ;
constexpr int RW = 512, NH = 8, HD = 64;
constexpr int RPROJ = 1792, DPROJ = 3328;
constexpr int DFF = 2816;
constexpr int MEMLEN = 256, XH = 4, XHD = 256, MM = BATCH * MEMLEN;
constexpr int MBLK = 256, NBLK = SEQ / MBLK;
constexpr float NORM_EPS = 1e-6f, LNX_EPS = 64e-5f;
constexpr float LOG2E = 1.4426950408889634f;
constexpr float MOBA_QSCALE = 0.125f * LOG2E;
constexpr float XATT_QSCALE = 0.0625f * LOG2E;

enum { I_X = 0, I_MEM, I_RELB, I_FING, I_F1G, I_F1IN, I_F1OUT, I_MIXG, I_MIXIN, I_MIXOUT, I_MU, I_W0, I_WUP, I_A0, I_AUP, I_GUP, I_KK, I_KA, I_RK, I_LNG, I_LNB,
       I_XG, I_MEMG, I_WQ, I_WKV, I_WO, I_F2G, I_F2IN, I_F2OUT, N_IN };

constexpr size_t MiB = 1u << 20;
constexpr size_t WS_CTL = 0, CTL_ZERO_BYTES = 1 * MiB;
constexpr size_t WS_BIAS = 1 * MiB;
constexpr size_t WS_MEMRS = WS_BIAS + 64 * 1024;
constexpr size_t WS_BONUS = WS_MEMRS + 64 * 1024;
constexpr size_t WS_KMS = WS_BONUS + 512 * 1024;
constexpr size_t WS_SSQ = 2 * MiB;
constexpr size_t WS_MEMB = 3 * MiB;
constexpr size_t WS_XK = 7 * MiB, WS_XVT = 11 * MiB;
constexpr size_t WS_W = 15 * MiB;
constexpr size_t W_F1IN = 0, W_F1OUT = W_F1IN + (size_t)2 * DFF * DM * 2, W_F2IN = W_F1OUT + (size_t)DM * DFF * 2, W_F2OUT = W_F2IN + (size_t)2 * DFF * DM * 2,
                 W_MIXIN = W_F2OUT + (size_t)DM * DFF * 2, W_MIXOUT = W_MIXIN + (size_t)DPROJ * DM * 2, W_WQ = W_MIXOUT + (size_t)DM * DM * 2, W_WKV = W_WQ + (size_t)DM * DM * 2,
                 W_WO = W_WKV + (size_t)2 * DM * DM * 2, W_WUPT = W_WO + (size_t)DM * DM * 2, W_AUPT = W_WUPT + (size_t)RW * 64 * 2, W_GUPT = W_AUPT + (size_t)RW * 64 * 2, W_END = W_GUPT + (size_t)RW * 128 * 2;
static_assert(W_END <= 50 * MiB, "weights fit");
constexpr size_t WS_XB = 65 * MiB;
constexpr size_t WS_AR = 97 * MiB;
constexpr size_t AR_H = WS_AR;
constexpr size_t AR_PR = WS_AR, AR_MQ = WS_AR + 56 * MiB, AR_MK = WS_AR + 72 * MiB, AR_MVT = WS_AR + 88 * MiB;
constexpr size_t AR_SCANIN = WS_AR + 56 * MiB;
constexpr size_t AR_YLOC = WS_AR, AR_Z = WS_AR + 32 * MiB;
constexpr size_t AR_STATE = WS_AR + 152 * MiB;
constexpr size_t AR_XB2 = WS_AR, AR_XQ = WS_AR + 32 * MiB, AR_XO = WS_AR + 64 * MiB;
constexpr size_t WS_END = WS_AR + 168 * MiB;

#define GAS __attribute__((address_space(1)))
#define LAS __attribute__((address_space(3)))

namespace pg8 {
#define PG8_LAS __attribute__((address_space(3)))
typedef unsigned short bf16_t;
typedef short bf16x8 __attribute__((ext_vector_type(8)));
typedef float f32x4 __attribute__((ext_vector_type(4)));
typedef unsigned u32x4 __attribute__((ext_vector_type(4)));
constexpr int BM = 256, BK = 64, HALF = 128, HTB = HALF * BK * 2  , STAGE_BYTES = 8 * HTB, NXCD = 8, WGM = 8;

__host__ __device__ __forceinline__ int lds_byte(int r, int c) { const int st = (r >> 4) * 2 + (c >> 5), rr = r & 15, cc = c & 31, ob = rr * 64 + cc * 2; return st * 1024 + (ob ^ (((ob >> 9) & 1) << 5)); }
__host__ __device__ __forceinline__ void stage_rc(int b, int& R, int& C) { const int st = b / 1024, sb = b % 1024, swz = sb ^ (((sb >> 9) & 1) << 5); R = (st >> 1) * 16 + swz / 64; C = (st & 1) * 32 + (swz % 64) / 2; }
__host__ __device__ __forceinline__ int perm32(int rho) { const int n = rho >> 4, i = rho & 15; return 8 * (i >> 2) + 4 * n + (i & 3); }

struct Unit { int pm, pn; };
struct Gemm { const bf16_t* A; const bf16_t* Bt; int M, N, K; };

struct StaticOrder {
    int nM, nN, nwg, G, c;
    __host__ __device__ void init(int M, int N, int G_, int c_) { nM = M / BM; nN = N / BM; nwg = nM * nN; G = G_; c = c_; }
    __host__ __device__ bool next(int i, Unit& u) const {
        const long L = (long)i * G + c; if (L >= nwg) return false;
        int wgid = (int)L; { const int q = nwg / NXCD, r = nwg % NXCD, xcd = wgid % NXCD, off = wgid / NXCD; wgid = (xcd < r ? xcd * (q + 1) : r * (q + 1) + (xcd - r) * q) + off; }
        const int nig = WGM * nN, gid = wgid / nig, fm = gid * WGM, gsz = (nM - fm) < WGM ? (nM - fm) : WGM;
        u.pm = fm + ((wgid % nig) % gsz); u.pn = (wgid % nig) / gsz; return true;
    }
    __device__ __forceinline__ void a_ready(const Unit&) const {}
    __device__ __forceinline__ void done(const Unit&) const {}
};

__device__ __forceinline__ unsigned cvt_pk_bf16(float lo, float hi) { unsigned r; asm volatile("v_cvt_pk_bf16_f32 %0, %1, %2" : "=v"(r) : "v"(lo), "v"(hi)); return r; }
typedef float f32x2 __attribute__((ext_vector_type(2)));
__device__ __forceinline__ float row_rstd16(const float* ssq, int r) {
    const f32x4* p = (const f32x4*)(ssq + (size_t)r * 16);
    const f32x4 a = p[0], b = p[1], c = p[2], d = p[3];
    const float s = ((a[0] + a[1]) + (a[2] + a[3])) + ((b[0] + b[1]) + (b[2] + b[3])) + ((c[0] + c[1]) + (c[2] + c[3])) + ((d[0] + d[1]) + (d[2] + d[3]));
    return __builtin_amdgcn_rsqf(s * (1.0f / 1024.0f) + 1e-6f);
}
__device__ __forceinline__ float silu_mul(float g, float u) { return g * __builtin_amdgcn_rcpf(1.0f + __expf(-g)) * u; }
__device__ __forceinline__ u32x4 pack8(const f32x4 v0, const f32x4 v1) { u32x4 w; w.x = cvt_pk_bf16(v0[0], v0[1]); w.y = cvt_pk_bf16(v0[2], v0[3]); w.z = cvt_pk_bf16(v1[0], v1[1]); w.w = cvt_pk_bf16(v1[2], v1[3]); return w; }
__device__ __forceinline__ int pos16(int k) { return 8 * ((k >> 2) & 1) + (k & 3) + 4 * (k >> 3); }

struct EpiSwiGLU {
    static constexpr bool PERM = true, AFTER_DRAIN = false;
    unsigned char* ws;
    __device__ __forceinline__ void operator()(const f32x4 (&acc)[2][2][4][2], const Unit& u, int wr, int wc, int fr, int fq) const {
        const int row0 = u.pm * BM + wr * 64 + fr, hcol = u.pn * 128 + wc * 32 + 8 * fq; bf16_t* H = (bf16_t*)(ws + AR_H); const float* ssq = (const float*)(ws + WS_SSQ);
#pragma unroll
        for (int ai = 0; ai < 2; ++ai)
#pragma unroll
            for (int m = 0; m < 4; ++m) { const int r = row0 + ai * HALF + m * 16; const float rs = row_rstd16(ssq, r);
                f32x4 h0, h1;
#pragma unroll
                for (int i = 0; i < 4; ++i) { h0[i] = silu_mul(acc[ai][0][m][0][i] * rs, acc[ai][1][m][0][i] * rs); h1[i] = silu_mul(acc[ai][0][m][1][i] * rs, acc[ai][1][m][1][i] * rs); }
                *(u32x4*)(H + (size_t)r * 2816 + hcol) = pack8(h0, h1); }
    }
};
struct EpiResid {
    static constexpr bool PERM = true, AFTER_DRAIN = false;
    const float* base; float* out; unsigned char* ws; size_t xb_off; float alpha;
    __device__ __forceinline__ void operator()(const f32x4 (&acc)[2][2][4][2], const Unit& u, int wr, int wc, int fr, int fq) const {
        const int row0 = u.pm * BM + wr * 64 + fr, col0 = u.pn * BM + wc * 32 + 8 * fq; bf16_t* xb = (bf16_t*)(ws + xb_off); float* ssq = (float*)(ws + WS_SSQ);
#pragma unroll
        for (int ai = 0; ai < 2; ++ai)
#pragma unroll
            for (int m = 0; m < 4; ++m) { const int r = row0 + ai * HALF + m * 16; float s = 0.f;
#pragma unroll
                for (int bj = 0; bj < 2; ++bj) { const size_t off = (size_t)r * 1024 + col0 + bj * HALF;
                    const f32x4 b0 = *(const f32x4*)(base + off), b1 = *(const f32x4*)(base + off + 4);
                    const f32x4 v0 = b0 + acc[ai][bj][m][0] * alpha, v1 = b1 + acc[ai][bj][m][1] * alpha;
                    *(f32x4*)(out + off) = v0; *(f32x4*)(out + off + 4) = v1; *(u32x4*)(xb + off) = pack8(v0, v1);
                    s += (v0[0] * v0[0] + v0[1] * v0[1]) + (v0[2] * v0[2] + v0[3] * v0[3]) + (v1[0] * v1[0] + v1[1] * v1[1]) + (v1[2] * v1[2] + v1[3] * v1[3]); }
                s += __shfl_xor(s, 16); s += __shfl_xor(s, 32);
                if (fq == 0) ssq[(size_t)r * 16 + u.pn * 4 + wc] = s; }
    }
};
struct EpiMixIn {
    static constexpr bool PERM = true, AFTER_DRAIN = false;
    unsigned char* ws;
    __device__ __forceinline__ void operator()(const f32x4 (&acc)[2][2][4][2], const Unit& u, int wr, int wc, int fr, int fq) const {
        const int row0 = u.pm * BM + wr * 64 + fr, cw = wc * 32 + 8 * fq; const float* ssq = (const float*)(ws + WS_SSQ);
        bf16_t* PR = (bf16_t*)(ws + AR_PR); bf16_t* MQ = (bf16_t*)(ws + AR_MQ); bf16_t* MK = (bf16_t*)(ws + AR_MK); bf16_t* MVT = (bf16_t*)(ws + AR_MVT);
        f32x4 ks[2][2]; ks[0][0] = (f32x4){0.f, 0.f, 0.f, 0.f}; ks[0][1] = ks[0][0]; ks[1][0] = ks[0][0]; ks[1][1] = ks[0][0];
#pragma unroll
        for (int ai = 0; ai < 2; ++ai)
#pragma unroll
            for (int m = 0; m < 4; ++m) { const int r = row0 + ai * HALF + m * 16; const float rs = row_rstd16(ssq, r);
#pragma unroll
                for (int bj = 0; bj < 2; ++bj) { const int c = cw + bj * HALF;
                    f32x4 v0 = acc[ai][bj][m][0] * rs, v1 = acc[ai][bj][m][1] * rs;
                    if (u.pn < 7) *(u32x4*)(PR + (size_t)r * 1792 + u.pn * 256 + c) = pack8(v0, v1);
                    else if (u.pn < 9) { v0 = v0 * MOBA_QSCALE; v1 = v1 * MOBA_QSCALE; *(u32x4*)(MQ + (size_t)r * 512 + (u.pn - 7) * 256 + c) = pack8(v0, v1); }
                    else if (u.pn < 11) { *(u32x4*)(MK + (size_t)r * 512 + (u.pn - 9) * 256 + c) = pack8(v0, v1); ks[bj][0] += v0; ks[bj][1] += v1; }
                    else { const int cc = (u.pn - 11) * 256 + c, hh = cc >> 6, d = cc & 63, b = r >> 11, t = r & 2047;
                        bf16_t* p = MVT + ((size_t)(b * 8 + hh) * 64 + d) * 2048 + (t & ~15) + pos16(t & 15);
                        const u32x4 w = pack8(v0, v1);
                        p[0] = (bf16_t)(w.x & 0xffffu); p[2048] = (bf16_t)(w.x >> 16); p[2 * 2048] = (bf16_t)(w.y & 0xffffu); p[3 * 2048] = (bf16_t)(w.y >> 16);
                        p[4 * 2048] = (bf16_t)(w.z & 0xffffu); p[5 * 2048] = (bf16_t)(w.z >> 16); p[6 * 2048] = (bf16_t)(w.w & 0xffffu); p[7 * 2048] = (bf16_t)(w.w >> 16); }
                } }
        if (u.pn == 9 || u.pn == 10) {
            float* KMS = (float*)(ws + WS_KMS) + ((size_t)u.pm * 2 + wr) * 512 + (u.pn - 9) * 256 + cw;
#pragma unroll
            for (int bj = 0; bj < 2; ++bj)
#pragma unroll
                for (int n = 0; n < 2; ++n) { f32x4 v = ks[bj][n];
#pragma unroll
                    for (int o = 1; o < 16; o <<= 1) { v[0] += __shfl_xor(v[0], o); v[1] += __shfl_xor(v[1], o); v[2] += __shfl_xor(v[2], o); v[3] += __shfl_xor(v[3], o); }
                    if (fr == 0) *(f32x4*)(KMS + bj * HALF + 4 * n) = v; } }
    }
};
struct EpiXQ {
    static constexpr bool PERM = true, AFTER_DRAIN = false;
    unsigned char* ws;
    __device__ __forceinline__ void operator()(const f32x4 (&acc)[2][2][4][2], const Unit& u, int wr, int wc, int fr, int fq) const {
        const int row0 = u.pm * BM + wr * 64 + fr, col0 = u.pn * BM + wc * 32 + 8 * fq; bf16_t* Q = (bf16_t*)(ws + AR_XQ); const float* ssq = (const float*)(ws + WS_SSQ);
#pragma unroll
        for (int ai = 0; ai < 2; ++ai)
#pragma unroll
            for (int m = 0; m < 4; ++m) { const int r = row0 + ai * HALF + m * 16; const float rs = row_rstd16(ssq, r) * XATT_QSCALE;
#pragma unroll
                for (int bj = 0; bj < 2; ++bj) *(u32x4*)(Q + (size_t)r * 1024 + col0 + bj * HALF) = pack8(acc[ai][bj][m][0] * rs, acc[ai][bj][m][1] * rs); }
    }
};
struct EpiKV {
    static constexpr bool PERM = true, AFTER_DRAIN = false;
    unsigned char* ws;
    __device__ __forceinline__ void operator()(const f32x4 (&acc)[2][2][4][2], const Unit& u, int wr, int wc, int fr, int fq) const {
        const int row0 = u.pm * BM + wr * 64 + fr, cw = wc * 32 + 8 * fq; bf16_t* XK = (bf16_t*)(ws + WS_XK); bf16_t* XVT = (bf16_t*)(ws + WS_XVT); const float* memrs = (const float*)(ws + WS_MEMRS);
#pragma unroll
        for (int ai = 0; ai < 2; ++ai)
#pragma unroll
            for (int m = 0; m < 4; ++m) { const int r = row0 + ai * HALF + m * 16; const float rs = memrs[r];
#pragma unroll
                for (int bj = 0; bj < 2; ++bj) { const int c = cw + bj * HALF;
                    const f32x4 v0 = acc[ai][bj][m][0] * rs, v1 = acc[ai][bj][m][1] * rs;
                    if (u.pn < 4) *(u32x4*)(XK + (size_t)r * 1024 + u.pn * 256 + c) = pack8(v0, v1);
                    else { const int hx = u.pn - 4, b = r >> 8, key = r & 255;
                        bf16_t* p = XVT + ((size_t)(b * 4 + hx) * 256 + c) * 256 + (key & ~15) + pos16(key & 15);
                        const u32x4 w = pack8(v0, v1);
                        p[0] = (bf16_t)(w.x & 0xffffu); p[256] = (bf16_t)(w.x >> 16); p[2 * 256] = (bf16_t)(w.y & 0xffffu); p[3 * 256] = (bf16_t)(w.y >> 16);
                        p[4 * 256] = (bf16_t)(w.z & 0xffffu); p[5 * 256] = (bf16_t)(w.z >> 16); p[6 * 256] = (bf16_t)(w.w & 0xffffu); p[7 * 256] = (bf16_t)(w.w >> 16); }
                } }
    }
};

template <class Epi, class Sched, bool ALIGN_EPI = false, bool SP2 = false>
__device__ __forceinline__ void gemm_phase(PG8_LAS unsigned char* lds, const Gemm g, const Sched& S, const Epi& E) {
    int tid_ = threadIdx.x; asm volatile("" : "+v"(tid_));
    const int tid = tid_, wid = __builtin_amdgcn_readfirstlane(tid >> 6), lane = tid & 63, wr = wid >> 2, wc = wid & 3, fr = lane & 15, fq = lane >> 4;
    const int K = g.K, nt = K / BK;
    unsigned voffA[2], voffB[2];
#pragma unroll
    for (int i = 0; i < 2; ++i) { int R, C; stage_rc(tid * 16 + i * 8192, R, C); const int Rb = Epi::PERM ? ((R & ~31) + perm32(R & 31)) : R;
        voffA[i] = (unsigned)(R * K + C) * 2u; voffB[i] = (unsigned)(Rb * K + C) * 2u; }
    const size_t kstep = (size_t)(BK * 2);
    const size_t hstep = (size_t)HALF * K * 2;
    const size_t tstep = 2 * hstep;
    const unsigned ldsw = (unsigned)wid * 1024u;
    const int aoff = lds_byte(wr * 64 + fr, fq * 8), boff = lds_byte(wc * 32 + fr, fq * 8);
#define PG8_SA(b, h) (((b) * 2 + (h)) * HTB)
#define PG8_SB(b, h) ((4 + (b) * 2 + (h)) * HTB)
#define PG8_STAGE(bufoff, gbase, voff) do { _Pragma("unroll") for (int _i = 0; _i < 2; ++_i) \
        __builtin_amdgcn_global_load_lds((const unsigned*)((const char*)(gbase) + (voff)[_i]), (PG8_LAS unsigned*)(lds + (bufoff) + ldsw + _i * 8192), 16, 0, 0); } while (0)
#define PG8_LDA(dst, b, h) do { _Pragma("unroll") for (int m = 0; m < 4; ++m) _Pragma("unroll") for (int k = 0; k < 2; ++k) dst[m][k] = *(const PG8_LAS bf16x8*)(lds + PG8_SA(b, h) + aoff + m * 2048 + k * 1024); } while (0)
#define PG8_LDB(dst, b, h) do { _Pragma("unroll") for (int n = 0; n < 2; ++n) _Pragma("unroll") for (int k = 0; k < 2; ++k) dst[n][k] = *(const PG8_LAS bf16x8*)(lds + PG8_SB(b, h) + boff + n * 2048 + k * 1024); } while (0)
#define PG8_MMA(ai, bj, At, Bt) do { __builtin_amdgcn_s_setprio(1); _Pragma("unroll") for (int m = 0; m < 4; ++m) _Pragma("unroll") for (int n = 0; n < 2; ++n) _Pragma("unroll") for (int k = 0; k < 2; ++k) \
        acc[ai][bj][m][n] = __builtin_amdgcn_mfma_f32_16x16x32_bf16(Bt[n][k], At[m][k], acc[ai][bj][m][n], 0, 0, 0); __builtin_amdgcn_s_setprio(0); } while (0)
#define PG8_WAIT_V(n) asm volatile("s_waitcnt vmcnt(" #n ")" ::: "memory")
#define PG8_WAIT_L(n) asm volatile("s_waitcnt lgkmcnt(" #n ")" ::: "memory")
#define PG8_BAR __builtin_amdgcn_s_barrier()
#define PG8_SCHED __builtin_amdgcn_sched_barrier(0)
    Unit cur, nxt; int ui = 0;
    if (!S.next(0, cur)) return;
    f32x4 acc[2][2][4][2];
#pragma unroll
    for (int a = 0; a < 2; ++a)
#pragma unroll
        for (int b = 0; b < 2; ++b)
#pragma unroll
            for (int m = 0; m < 4; ++m)
#pragma unroll
                for (int n = 0; n < 2; ++n) acc[a][b][m][n] = (f32x4){0.f, 0.f, 0.f, 0.f};
    bf16x8 At[4][2], B0[2][2], B1[2][2];
    const char* cA = (const char*)g.A + (size_t)cur.pm * tstep; const char* cB = (const char*)g.Bt + (size_t)cur.pn * tstep;
    S.a_ready(cur);
    if constexpr (SP2) {
        PG8_STAGE(PG8_SB(0, 0), cB, voffB); PG8_STAGE(PG8_SB(0, 1), cB + hstep, voffB); PG8_STAGE(PG8_SA(0, 0), cA, voffA); PG8_STAGE(PG8_SA(0, 1), cA + hstep, voffA);
        if (wr == 1) PG8_BAR;
        PG8_WAIT_V(2); PG8_BAR;
        PG8_STAGE(PG8_SB(1, 0), cB + kstep, voffB); PG8_STAGE(PG8_SA(1, 0), cA + kstep, voffA); PG8_STAGE(PG8_SB(1, 1), cB + hstep + kstep, voffB);
        PG8_WAIT_V(6); PG8_BAR;
    } else {
        PG8_STAGE(PG8_SB(0, 0), cB, voffB); PG8_STAGE(PG8_SA(0, 0), cA, voffA); PG8_STAGE(PG8_SB(0, 1), cB + hstep, voffB); PG8_STAGE(PG8_SA(0, 1), cA + hstep, voffA);
        if (wr == 1) PG8_BAR;
        PG8_WAIT_V(4); PG8_BAR;
        PG8_STAGE(PG8_SB(1, 0), cB + kstep, voffB); PG8_STAGE(PG8_SA(1, 0), cA + kstep, voffA); PG8_STAGE(PG8_SB(1, 1), cB + hstep + kstep, voffB);
        PG8_WAIT_V(6); PG8_BAR;
    }
    for (;;) {
        const bool has_next = S.next(ui + 1, nxt);
        const char* nA = has_next ? (const char*)g.A + (size_t)nxt.pm * tstep : cA; const char* nB = has_next ? (const char*)g.Bt + (size_t)nxt.pn * tstep : cB;
        for (int t = 0; t < nt; t += 2) {
            const bool last = (t == nt - 2);
            const char* a1 = cA + (size_t)(t + 1) * kstep;
            const char* a2 = last ? nA : cA + (size_t)(t + 2) * kstep; const char* b2 = last ? nB : cB + (size_t)(t + 2) * kstep;
            const char* a3 = a2 + kstep; const char* b3 = b2 + kstep;
            if (last && has_next) S.a_ready(nxt);
            if constexpr (SP2) {
            PG8_LDB(B0, 0, 0); PG8_LDB(B1, 0, 1); PG8_SCHED; PG8_LDA(At, 0, 0); PG8_STAGE(PG8_SA(1, 1), a1 + hstep, voffA);
            PG8_WAIT_V(8); PG8_WAIT_L(0); PG8_BAR; PG8_MMA(0, 0, At, B0); PG8_MMA(0, 1, At, B1); PG8_BAR; PG8_SCHED;
            PG8_LDA(At, 0, 1); PG8_STAGE(PG8_SB(0, 0), b2, voffB); PG8_STAGE(PG8_SB(0, 1), b2 + hstep, voffB); PG8_STAGE(PG8_SA(0, 0), a2, voffA);
            PG8_WAIT_V(8); PG8_WAIT_L(0); PG8_BAR; PG8_MMA(1, 0, At, B0); PG8_MMA(1, 1, At, B1); PG8_BAR; PG8_SCHED;
            PG8_LDB(B0, 1, 0); PG8_LDB(B1, 1, 1); PG8_SCHED; PG8_LDA(At, 1, 0); PG8_STAGE(PG8_SA(0, 1), a2 + hstep, voffA);
            PG8_WAIT_V(8); PG8_WAIT_L(0); PG8_BAR; PG8_MMA(0, 0, At, B0); PG8_MMA(0, 1, At, B1); PG8_BAR; PG8_SCHED;
            PG8_LDA(At, 1, 1); PG8_STAGE(PG8_SB(1, 0), b3, voffB); PG8_STAGE(PG8_SB(1, 1), b3 + hstep, voffB); PG8_STAGE(PG8_SA(1, 0), a3, voffA);
            PG8_WAIT_V(8); PG8_WAIT_L(0); PG8_BAR; PG8_MMA(1, 0, At, B0); PG8_MMA(1, 1, At, B1); PG8_BAR; PG8_SCHED;
            } else {
            PG8_LDB(B0, 0, 0); PG8_SCHED; PG8_LDA(At, 0, 0); PG8_STAGE(PG8_SA(1, 1), a1 + hstep, voffA);
            PG8_WAIT_L(8); PG8_BAR; PG8_WAIT_L(0); PG8_MMA(0, 0, At, B0); PG8_BAR; PG8_SCHED;
            PG8_LDB(B1, 0, 1); PG8_STAGE(PG8_SB(0, 0), b2, voffB);
            PG8_BAR; PG8_WAIT_L(0); PG8_MMA(0, 1, At, B1); PG8_BAR;
            PG8_LDA(At, 0, 1); PG8_STAGE(PG8_SA(0, 0), a2, voffA);
            PG8_BAR; PG8_WAIT_L(0); PG8_MMA(1, 0, At, B0); PG8_BAR; PG8_SCHED;
            PG8_STAGE(PG8_SB(0, 1), b2 + hstep, voffB);
            PG8_WAIT_V(6); PG8_BAR; PG8_MMA(1, 1, At, B1); PG8_BAR;
            PG8_LDB(B0, 1, 0); PG8_SCHED; PG8_LDA(At, 1, 0); PG8_STAGE(PG8_SA(0, 1), a2 + hstep, voffA);
            PG8_WAIT_L(8); PG8_BAR; PG8_WAIT_L(0); PG8_MMA(0, 0, At, B0); PG8_BAR; PG8_SCHED;
            PG8_LDB(B1, 1, 1); PG8_STAGE(PG8_SB(1, 0), b3, voffB);
            PG8_BAR; PG8_WAIT_L(0); PG8_MMA(0, 1, At, B1); PG8_BAR;
            PG8_LDA(At, 1, 1); PG8_STAGE(PG8_SA(1, 0), a3, voffA);
            PG8_BAR; PG8_WAIT_L(0); PG8_MMA(1, 0, At, B0); PG8_BAR; PG8_SCHED;
            PG8_STAGE(PG8_SB(1, 1), b3 + hstep, voffB);
            PG8_WAIT_V(6); PG8_BAR; PG8_MMA(1, 1, At, B1); PG8_BAR;
            }
        }
        if constexpr (ALIGN_EPI) { if (wr == 0) PG8_BAR; }
        if constexpr (!Epi::AFTER_DRAIN) { E(acc, cur, wr, wc, fr, fq); S.done(cur); }
        if (!has_next) break;
#pragma unroll
        for (int a = 0; a < 2; ++a)
#pragma unroll
            for (int b = 0; b < 2; ++b)
#pragma unroll
                for (int m = 0; m < 4; ++m)
#pragma unroll
                    for (int n = 0; n < 2; ++n) acc[a][b][m][n] = (f32x4){0.f, 0.f, 0.f, 0.f};
        cur = nxt; cA = nA; cB = nB; ++ui;
        if constexpr (ALIGN_EPI) { if (wr == 1) PG8_BAR; }
    }
    PG8_WAIT_V(0);
    if constexpr (!ALIGN_EPI) { if (wr == 0) PG8_BAR; }
    PG8_BAR;
    if constexpr (Epi::AFTER_DRAIN) { E.fused(acc, cur, wr, wc, fr, fq, lds, wid, lane); S.done(cur); }
#undef PG8_SA
#undef PG8_SB
#undef PG8_STAGE
#undef PG8_LDA
#undef PG8_LDB
#undef PG8_MMA
#undef PG8_WAIT_V
#undef PG8_WAIT_L
#undef PG8_BAR
#undef PG8_SCHED
}
}

constexpr int NWAVES = 8;
constexpr int RING_BYTES = 131072, LDSCTL_OFF = RING_BYTES, MISC_OFF = LDSCTL_OFF + 320, LDS_BYTES = 147456;
constexpr int SCAN_R = 2, SCAN_NCH = 8;

typedef unsigned short bf16;
typedef unsigned u32x4 __attribute__((ext_vector_type(4)));
typedef unsigned u32x2 __attribute__((ext_vector_type(2)));
typedef float f32x4 __attribute__((ext_vector_type(4)));
typedef float f32x16 __attribute__((ext_vector_type(16)));
typedef short bf16x8 __attribute__((ext_vector_type(8)));
typedef GAS unsigned gu32;
#define RLX_AGENT __ATOMIC_RELAXED, __HIP_MEMORY_SCOPE_AGENT
#define LDS_WAIT() asm volatile("s_waitcnt lgkmcnt(0)" ::: "memory")
#define VM_WAIT() asm volatile("s_waitcnt vmcnt(0)" ::: "memory")
__device__ __forceinline__ float bf2f(unsigned b) { return __uint_as_float(b << 16); }
__device__ __forceinline__ unsigned f2bf(float f) { unsigned u = __builtin_bit_cast(unsigned, f); return (u + 0x7fffu + ((u >> 16) & 1u)) >> 16; }
__device__ __forceinline__ unsigned pk2(float lo, float hi) { return pg8::cvt_pk_bf16(lo, hi); }
__device__ __forceinline__ float wave_sum(float v) {
#pragma unroll
    for (int o = 1; o < 64; o <<= 1) v += __shfl_xor(v, o);
    return v;
}
#define WS8_STEP(o) _Pragma("unroll") for (int q = 0; q < 8; ++q) v[q] += __shfl_xor(v[q], o);
__device__ __forceinline__ void wave_sum8(float (&v)[8]) { WS8_STEP(1) WS8_STEP(2) WS8_STEP(4) WS8_STEP(8) WS8_STEP(16) WS8_STEP(32) }
__device__ __forceinline__ float quad_sum(float x) {
    x += __builtin_bit_cast(float, __builtin_amdgcn_update_dpp(0, __builtin_bit_cast(int, x), 0xB1, 0xF, 0xF, true));
    x += __builtin_bit_cast(float, __builtin_amdgcn_update_dpp(0, __builtin_bit_cast(int, x), 0x4E, 0xF, 0xF, true));
    return x;
}
__device__ __forceinline__ float sigmoidf_(float x) { return __builtin_amdgcn_rcpf(1.0f + __expf(-x)); }
__device__ __forceinline__ int crow(int r, int hi) { return (r & 3) + 8 * (r >> 2) + 4 * hi; }
__device__ __forceinline__ bf16x8 pack_bf16x8(float a0, float a1, float a2, float a3, float a4, float a5, float a6, float a7) {
    u32x4 w; w.x = pk2(a0, a1); w.y = pk2(a2, a3); w.z = pk2(a4, a5); w.w = pk2(a6, a7); return __builtin_bit_cast(bf16x8, w);
}

#define XB_TMO      128
#define XB_XCNT(j)  (256  + 64 * (j))
#define XB_XSUB(j)  (1280 + 64 * (j))
#define XB_XGEN(j)  (2304 + 64 * (j))
#define XB_TOP      3328
#define XB_TOPGEN   3392
#define XCD_BAR_WORDS 3456
#define XB_SPIN_CAP (1u << 18)

__device__ __forceinline__ unsigned xb_ld(unsigned* p)              { return __hip_atomic_load(p, __ATOMIC_RELAXED, __HIP_MEMORY_SCOPE_AGENT); }
__device__ __forceinline__ unsigned xb_add(unsigned* p, unsigned v) { return __hip_atomic_fetch_add(p, v, __ATOMIC_RELAXED, __HIP_MEMORY_SCOPE_AGENT); }
__device__ __forceinline__ unsigned xb_xcc_id() { return (unsigned)__builtin_amdgcn_s_getreg((3 << 11) | 20) & 0xFu; }
#define XB_SPIN(cond, bar) do { unsigned _sp = 0; while (cond) { __builtin_amdgcn_s_sleep(1); \
    if ((++_sp & 255u) == 0u) { if (xb_ld(&(bar)[XB_TMO])) break; if (_sp > XB_SPIN_CAP) { atomicAdd(&(bar)[XB_TMO], 1u); break; } } } } while (0)

struct XcdBarrier {
    unsigned* bar; unsigned x;
    volatile LAS unsigned* st;
};

__device__ __forceinline__ XcdBarrier xcd_barrier_post(unsigned* bar, volatile LAS unsigned* st) {
    XcdBarrier b; b.bar = bar; b.x = xb_xcc_id(); b.st = st;
    if (threadIdx.x == 0) (void)xb_add(&bar[XB_XCNT(b.x)], 1u);
    return b;
}
__device__ __forceinline__ void xcd_barrier_complete(unsigned* bar, unsigned x, unsigned& nloc, unsigned& nx) {
    const unsigned G = gridDim.x * gridDim.y * gridDim.z;
    unsigned sum, cnt, mine, sp = 0u;
    for (;;) {
        sum = 0u; cnt = 0u; mine = 0u;
#pragma unroll
        for (unsigned j = 0; j < 16; ++j) { const unsigned c = xb_ld(&bar[XB_XCNT(j)]); sum += c; cnt += (c > 0u) ? 1u : 0u; mine = (j == x) ? c : mine; }
        if (sum == G) break;
        __builtin_amdgcn_s_sleep(1);
        if ((++sp & 255u) == 0u) { if (xb_ld(&bar[XB_TMO])) break; if (sp > XB_SPIN_CAP) { atomicAdd(&bar[XB_TMO], 1u); break; } }
    }
    nloc = mine > 0u ? mine : 1u; nx = cnt > 0u ? cnt : 1u;
}

__device__ __forceinline__ void xcd_barrier(const XcdBarrier& b) {
    asm volatile("s_waitcnt vmcnt(0)" ::: "memory");
    __syncthreads();
    if (threadIdx.x == 0) {
        unsigned* bar = b.bar;
        __builtin_amdgcn_s_waitcnt(0);
        unsigned nloc = b.st[0], nx = b.st[1];
        if (nloc == 0u) { xcd_barrier_complete(bar, b.x, nloc, nx); b.st[0] = nloc; b.st[1] = nx; }
        const unsigned old = xb_add(&bar[XB_XSUB(b.x)], 1u);
        const unsigned gen = old / nloc;
        if (old + 1u == (gen + 1u) * nloc) {
            __builtin_amdgcn_fence(__ATOMIC_RELEASE, "agent");
            asm volatile("s_waitcnt vmcnt(0)" ::: "memory");
            const unsigned og = xb_add(&bar[XB_TOP], 1u);
            const unsigned tg = og / nx;
            if (og + 1u == (tg + 1u) * nx) xb_add(&bar[XB_TOPGEN], 1u);
            else XB_SPIN(xb_ld(&bar[XB_TOPGEN]) == tg, bar);
            __builtin_amdgcn_fence(__ATOMIC_ACQUIRE, "agent");
            xb_add(&bar[XB_XGEN(b.x)], 1u);
            asm volatile("s_waitcnt vmcnt(0)" ::: "memory");
        } else {
            XB_SPIN(xb_ld(&bar[XB_XGEN(b.x)]) == gen, bar);
            __builtin_amdgcn_fence(__ATOMIC_ACQUIRE, "agent");
            asm volatile("s_waitcnt vmcnt(0)" ::: "memory");
        }
    }
    __syncthreads();
}


struct Args { const float* in[N_IN]; float* out; unsigned char* ws; int ph_lo, ph_hi; };
static_assert(sizeof(Args) == N_IN * 8 + 24, "Args has no padding");
struct Frame {
    LAS unsigned char* lds; volatile LAS unsigned* MISC; gu32* ctl;
    int tid, lane, wave, vcu, G;
    const __attribute__((address_space(4))) struct Args* ka; float* out; unsigned char* ws;
};
#define FIN(i) (F.ka->in[i])
#define WSP(T, off) ((T*)(F.ws + (off)))

__device__ __forceinline__ void ph_init(Frame& F) {
    const int gw = F.vcu * NWAVES + F.wave, NGW = F.G * NWAVES;
    float* bias = WSP(float, WS_BIAS); const float* relb = FIN(I_RELB);
    for (int i = blockIdx.x * 512 + F.tid; i < NH * 2048; i += F.G * 512) { const int h = i >> 11, n = i & 2047; int bkt;
        if (n < 16) bkt = n; else { const float nf = (float)n; const int lg = 16 + (int)(logf(nf / 16.0f) / 4.1588830833596715f * 16.0f); bkt = lg < 31 ? lg : 31; }
        bias[i] = relb[h * 32 + bkt] * LOG2E; }
    const float* mem = FIN(I_MEM); bf16* memb = WSP(bf16, WS_MEMB); float* memrs = WSP(float, WS_MEMRS);
    for (int r = gw; r < MM; r += NGW) { const f32x4* xr = (const f32x4*)(mem + (size_t)r * DM) + F.lane; f32x4 v[4]; float s = 0.f;
#pragma unroll
        for (int j = 0; j < 4; ++j) { v[j] = xr[64 * j]; s += (v[j].x * v[j].x + v[j].y * v[j].y) + (v[j].z * v[j].z + v[j].w * v[j].w); }
        s = wave_sum(s); u32x2* o = (u32x2*)(memb + (size_t)r * DM) + F.lane;
#pragma unroll
        for (int j = 0; j < 4; ++j) { u32x2 w; w.x = pk2(v[j].x, v[j].y); w.y = pk2(v[j].z, v[j].w); o[64 * j] = w; }
        if (F.lane == 0) memrs[r] = __builtin_amdgcn_rsqf(s * (1.0f / DM) + NORM_EPS); }
    const float* x = FIN(I_X); bf16* xb = WSP(bf16, WS_XB); float* ssq = WSP(float, WS_SSQ);
    for (int r = gw; r < M; r += NGW) { const f32x4* xr = (const f32x4*)(x + (size_t)r * DM) + F.lane; f32x4 v[4]; float s = 0.f;
#pragma unroll
        for (int j = 0; j < 4; ++j) { v[j] = xr[64 * j]; s += (v[j].x * v[j].x + v[j].y * v[j].y) + (v[j].z * v[j].z + v[j].w * v[j].w); }
        s = wave_sum(s); u32x2* o = (u32x2*)(xb + (size_t)r * DM) + F.lane;
#pragma unroll
        for (int j = 0; j < 4; ++j) { u32x2 w; w.x = pk2(v[j].x, v[j].y); w.y = pk2(v[j].z, v[j].w); o[64 * j] = w; }
        if (F.lane < 16) ssq[(size_t)r * 16 + F.lane] = F.lane == 0 ? s : 0.f; }
}

__device__ __forceinline__ void conv_item(const float* W, int K, int N, const float* gk, bf16* WT, int item, bool ffn_in, LAS float* scr, int lane) {
    const int nblk = N / 32, kb = item / nblk, nb = item % nblk, k0 = 64 * kb, n0 = 32 * nb;
#pragma unroll 8
    for (int i = 0; i < 32; ++i) { const int kk = 2 * i + (lane >> 5); float w = W[(size_t)(k0 + kk) * N + n0 + (lane & 31)]; if (gk) w *= gk[k0 + kk]; scr[kk * 33 + (lane & 31)] = w; }
    LDS_WAIT(); asm volatile("" ::: "memory");
    int drow0 = n0; if (ffn_in) drow0 = n0 < DFF ? 256 * (n0 / 128) + (n0 % 128) : 256 * ((n0 - DFF) / 128) + 128 + ((n0 - DFF) % 128);
    const int c = lane & 7;
#pragma unroll
    for (int j = 0; j < 4; ++j) { const int n = (lane >> 3) + 8 * j; const LAS float* s = scr + (8 * c) * 33 + n;
        u32x4 o; o.x = pk2(s[0 * 33], s[1 * 33]); o.y = pk2(s[2 * 33], s[3 * 33]); o.z = pk2(s[4 * 33], s[5 * 33]); o.w = pk2(s[6 * 33], s[7 * 33]);
        *(u32x4*)(WT + (size_t)(drow0 + n) * K + k0 + 8 * c) = o; }
    LDS_WAIT(); asm volatile("" ::: "memory");
}
__device__ __forceinline__ void ph_conv(Frame& F, int l) {
    LAS float* scr = (LAS float*)(F.lds + F.wave * 16384);
    const int gw = F.vcu * NWAVES + F.wave, NGW = F.G * NWAVES;
    constexpr int I_FIN = (DM / 64) * (2 * DFF / 32), I_FOUT = (DFF / 64) * (DM / 32), I_MI = (DM / 64) * (DPROJ / 32), I_SQ = (DM / 64) * (DM / 32), I_KV = (DM / 64) * (2 * DM / 32);
    constexpr int I_L64 = (64 / 64) * (RW / 32), I_L128 = (128 / 64) * (RW / 32);
    constexpr int NITEMS = 2 * I_FIN + 2 * I_FOUT + I_MI + 3 * I_SQ + I_KV + 2 * I_L64 + I_L128;
    unsigned char* wb = F.ws + WS_W;
    for (int it = gw; it < NITEMS; it += NGW) { int r = it;
        if (r < I_FIN) { conv_item(FIN(I_F1IN) + (size_t)l * DM * 2 * DFF, DM, 2 * DFF, FIN(I_F1G) + l * DM, (bf16*)(wb + W_F1IN), r, true, scr, F.lane); continue; } r -= I_FIN;
        if (r < I_FIN) { conv_item(FIN(I_F2IN) + (size_t)l * DM * 2 * DFF, DM, 2 * DFF, FIN(I_F2G) + l * DM, (bf16*)(wb + W_F2IN), r, true, scr, F.lane); continue; } r -= I_FIN;
        if (r < I_FOUT) { conv_item(FIN(I_F1OUT) + (size_t)l * DFF * DM, DFF, DM, nullptr, (bf16*)(wb + W_F1OUT), r, false, scr, F.lane); continue; } r -= I_FOUT;
        if (r < I_FOUT) { conv_item(FIN(I_F2OUT) + (size_t)l * DFF * DM, DFF, DM, nullptr, (bf16*)(wb + W_F2OUT), r, false, scr, F.lane); continue; } r -= I_FOUT;
        if (r < I_MI) { conv_item(FIN(I_MIXIN) + (size_t)l * DM * DPROJ, DM, DPROJ, FIN(I_MIXG) + l * DM, (bf16*)(wb + W_MIXIN), r, false, scr, F.lane); continue; } r -= I_MI;
        if (r < I_SQ) { conv_item(FIN(I_MIXOUT) + (size_t)l * DM * DM, DM, DM, nullptr, (bf16*)(wb + W_MIXOUT), r, false, scr, F.lane); continue; } r -= I_SQ;
        if (r < I_SQ) { conv_item(FIN(I_WQ) + (size_t)l * DM * DM, DM, DM, FIN(I_XG) + l * DM, (bf16*)(wb + W_WQ), r, false, scr, F.lane); continue; } r -= I_SQ;
        if (r < I_SQ) { conv_item(FIN(I_WO) + (size_t)l * DM * DM, DM, DM, nullptr, (bf16*)(wb + W_WO), r, false, scr, F.lane); continue; } r -= I_SQ;
        if (r < I_KV) { conv_item(FIN(I_WKV) + (size_t)l * DM * 2 * DM, DM, 2 * DM, FIN(I_MEMG) + l * DM, (bf16*)(wb + W_WKV), r, false, scr, F.lane); continue; } r -= I_KV;
        if (r < I_L64) { conv_item(FIN(I_WUP) + (size_t)l * 64 * RW, 64, RW, nullptr, (bf16*)(wb + W_WUPT), r, false, scr, F.lane); continue; } r -= I_L64;
        if (r < I_L64) { conv_item(FIN(I_AUP) + (size_t)l * 64 * RW, 64, RW, nullptr, (bf16*)(wb + W_AUPT), r, false, scr, F.lane); continue; } r -= I_L64;
        conv_item(FIN(I_GUP) + (size_t)l * 128 * RW, 128, RW, nullptr, (bf16*)(wb + W_GUPT), r, false, scr, F.lane);
    }
}

__device__ __forceinline__ void ph_moba(Frame& F) {
    constexpr int KROW = 144, KBUF = 64 * KROW, OFF_K = 12288, OFF_V = OFF_K + 2 * KBUF;
    LAS float* kmean = (LAS float*)F.lds;
    LAS float* btab = (LAS float*)(F.lds + 2048);
    volatile LAS unsigned* needw = (volatile LAS unsigned*)(F.lds + 10240);
    const bf16* MQ = WSP(bf16, AR_MQ); const bf16* MK = WSP(bf16, AR_MK); const bf16* MVT = WSP(bf16, AR_MVT); bf16* XB = WSP(bf16, WS_XB); const float* bias = WSP(float, WS_BIAS);
    const int lane = F.lane, r32 = lane & 31, hi = lane >> 5, wave = F.wave, tid = F.tid;
    for (int u = blockIdx.x; u < 512; u += F.G) {
        const int rnd = u >> 8, iu = u & 255, qsel = iu >> 6, bh = iu & 63, qb = rnd == 0 ? 7 - qsel : qsel, b = bh >> 3, hh = bh & 7;
        __syncthreads();
        { const int n = tid >> 6, d = tid & 63;
          if (n < qb) { const float* kp = WSP(float, WS_KMS) + ((size_t)(b * 8 + n) * 2) * 512 + hh * 64 + d; kmean[n * 64 + d] = (kp[0] + kp[512]) * (1.0f / 256.0f); }
          for (int i2 = tid; i2 < 2048; i2 += 512) btab[i2] = bias[hh * 2048 + i2];
          if (tid == 0) needw[0] = 0u; }
        __syncthreads();
        const int q0 = qb * 256 + wave * 32; const size_t tok = (size_t)b * 2048 + q0 + r32;
        bf16x8 qf[4];
#pragma unroll
        for (int s = 0; s < 4; ++s) qf[s] = *(const bf16x8*)(MQ + tok * 512 + hh * 64 + 16 * s + 8 * hi);
        float g[7]; unsigned selmask = 0u;
#pragma unroll
        for (int n = 0; n < 7; ++n) { g[n] = -INFINITY;
            if (n < qb) { float p = 0.f;
#pragma unroll
                for (int s = 0; s < 4; ++s) { const f32x4 k0v = *(const LAS f32x4*)(kmean + n * 64 + 16 * s + 8 * hi), k1v = *(const LAS f32x4*)(kmean + n * 64 + 16 * s + 8 * hi + 4);
                    p += bf2f((unsigned short)qf[s][0]) * k0v[0] + bf2f((unsigned short)qf[s][1]) * k0v[1] + bf2f((unsigned short)qf[s][2]) * k0v[2] + bf2f((unsigned short)qf[s][3]) * k0v[3]
                       + bf2f((unsigned short)qf[s][4]) * k1v[0] + bf2f((unsigned short)qf[s][5]) * k1v[1] + bf2f((unsigned short)qf[s][6]) * k1v[2] + bf2f((unsigned short)qf[s][7]) * k1v[3]; }
                p += __shfl_xor(p, 32); g[n] = p; } }
        if (qb <= 3) selmask = (1u << qb) - 1u;
        else {
#pragma unroll
            for (int n = 0; n < 7; ++n) if (n < qb) { int cnt = 0;
#pragma unroll
                for (int n2 = 0; n2 < 7; ++n2) if (n2 != n && n2 < qb) cnt += (g[n2] > g[n] || (g[n2] == g[n] && n2 < n)) ? 1 : 0;
                if (cnt < 3) selmask |= 1u << n; } }
        unsigned wmask = 0u;
#pragma unroll
        for (int n = 0; n < 7; ++n) if (__ballot((selmask >> n) & 1u) != 0ull) wmask |= 1u << n;
        if (lane == 0 && wmask) __hip_atomic_fetch_or((LAS unsigned*)needw, wmask, __ATOMIC_RELAXED, __HIP_MEMORY_SCOPE_WORKGROUP);
        __syncthreads();
        const unsigned need = needw[0] | (1u << qb);
        float mrun = -INFINITY, lrun = 0.f; f32x16 o0, o1;
#pragma unroll
        for (int i = 0; i < 16; ++i) { o0[i] = 0.f; o1[i] = 0.f; }
        const int qpos = q0 + r32;
        const bf16* Kg = MK + ((size_t)b * 2048 + (tid >> 3)) * 512 + hh * 64 + (tid & 7) * 8;
        const bf16* Vg = MVT + ((size_t)(b * 8 + hh) * 64 + (tid >> 3)) * 2048 + (tid & 7) * 8;
        const int sto = (tid >> 3) * KROW + (tid & 7) * 16;
        int blk = 0; while (!((need >> blk) & 1u)) ++blk;
        int kt = 0, it = 0;
        { const int k0 = blk * 256; const u32x4 kr = *(const u32x4*)(Kg + (size_t)k0 * 512), vr = *(const u32x4*)(Vg + k0);
          *(LAS u32x4*)(F.lds + OFF_K + sto) = kr; *(LAS u32x4*)(F.lds + OFF_V + sto) = vr; }
        __syncthreads();
        while (blk <= qb) {
            int nblk = blk, nkt = kt + 1; if (nkt == 4) { nkt = 0; ++nblk; while (nblk <= qb && !((need >> nblk) & 1u)) ++nblk; }
            const bool more = nblk <= qb; u32x4 kr, vr;
            if (more) { const int k0n = nblk * 256 + nkt * 64; kr = *(const u32x4*)(Kg + (size_t)k0n * 512); vr = *(const u32x4*)(Vg + k0n); }
            const int k0 = blk * 256 + kt * 64; const bool own = blk == qb; const bool selme = own || ((selmask >> blk) & 1u);
            const bool active = own ? (k0 <= q0 + 31) : (__ballot(selme) != 0ull);
            if (active) {
                const LAS unsigned char* kb = F.lds + OFF_K + (it & 1) * KBUF + r32 * KROW + 16 * hi;
                const LAS unsigned char* vb = F.lds + OFF_V + (it & 1) * KBUF + r32 * KROW + 16 * hi;
                const bool h1 = !own || (k0 + 32 <= q0 + 31);
                f32x16 s0, s1;
#pragma unroll
                for (int i = 0; i < 16; ++i) { s0[i] = 0.f; s1[i] = 0.f; }
#pragma unroll
                for (int s = 0; s < 4; ++s) s0 = __builtin_amdgcn_mfma_f32_32x32x16_bf16(*(const LAS bf16x8*)(kb + 32 * s), qf[s], s0, 0, 0, 0);
                if (h1) {
#pragma unroll
                    for (int s = 0; s < 4; ++s) s1 = __builtin_amdgcn_mfma_f32_32x32x16_bf16(*(const LAS bf16x8*)(kb + 32 * KROW + 32 * s), qf[s], s1, 0, 0, 0); }
                float mx = -INFINITY;
                float bv0[16], bv1[16];
#pragma unroll
                for (int r = 0; r < 16; ++r) { const int d0 = qpos - (k0 + crow(r, hi)), d1 = d0 - 32; bv0[r] = btab[d0 < 0 ? 0 : d0]; bv1[r] = btab[d1 < 0 ? 0 : d1]; }
#pragma unroll
                for (int r = 0; r < 16; ++r) asm volatile("" : "+v"(bv0[r]), "+v"(bv1[r]));
#pragma unroll
                for (int r = 0; r < 16; ++r) { const int d0 = qpos - (k0 + crow(r, hi)), d1 = d0 - 32;
                    const bool v0 = selme && (!own || d0 >= 0), v1 = h1 && selme && (!own || d1 >= 0);
                    const float a0 = v0 ? s0[r] + bv0[r] : -INFINITY, a1 = v1 ? s1[r] + bv1[r] : -INFINITY;
                    s0[r] = a0; s1[r] = a1; mx = fmaxf(mx, fmaxf(a0, a1)); }
                mx = fmaxf(mx, __shfl_xor(mx, 32));
                const float mnew = fmaxf(mrun, mx), muse = (mnew == -INFINITY) ? 0.f : mnew;
                const float alpha = __builtin_amdgcn_exp2f(mrun - muse);
                float ps = 0.f;
#pragma unroll
                for (int r = 0; r < 16; ++r) { const float p0 = __builtin_amdgcn_exp2f(s0[r] - muse), p1 = __builtin_amdgcn_exp2f(s1[r] - muse); s0[r] = p0; s1[r] = p1; ps += p0 + p1; }
                lrun = lrun * alpha + ps; mrun = mnew;
#pragma unroll
                for (int i = 0; i < 16; ++i) { o0[i] *= alpha; o1[i] *= alpha; }
                const bf16x8 pa0 = pack_bf16x8(s0[0], s0[1], s0[2], s0[3], s0[4], s0[5], s0[6], s0[7]), pa1 = pack_bf16x8(s0[8], s0[9], s0[10], s0[11], s0[12], s0[13], s0[14], s0[15]);
                o0 = __builtin_amdgcn_mfma_f32_32x32x16_bf16(*(const LAS bf16x8*)(vb), pa0, o0, 0, 0, 0); o0 = __builtin_amdgcn_mfma_f32_32x32x16_bf16(*(const LAS bf16x8*)(vb + 32), pa1, o0, 0, 0, 0);
                o1 = __builtin_amdgcn_mfma_f32_32x32x16_bf16(*(const LAS bf16x8*)(vb + 32 * KROW), pa0, o1, 0, 0, 0); o1 = __builtin_amdgcn_mfma_f32_32x32x16_bf16(*(const LAS bf16x8*)(vb + 32 * KROW + 32), pa1, o1, 0, 0, 0);
                if (h1) {
                    const bf16x8 pb0 = pack_bf16x8(s1[0], s1[1], s1[2], s1[3], s1[4], s1[5], s1[6], s1[7]), pb1 = pack_bf16x8(s1[8], s1[9], s1[10], s1[11], s1[12], s1[13], s1[14], s1[15]);
                    o0 = __builtin_amdgcn_mfma_f32_32x32x16_bf16(*(const LAS bf16x8*)(vb + 64), pb0, o0, 0, 0, 0); o0 = __builtin_amdgcn_mfma_f32_32x32x16_bf16(*(const LAS bf16x8*)(vb + 96), pb1, o0, 0, 0, 0);
                    o1 = __builtin_amdgcn_mfma_f32_32x32x16_bf16(*(const LAS bf16x8*)(vb + 32 * KROW + 64), pb0, o1, 0, 0, 0); o1 = __builtin_amdgcn_mfma_f32_32x32x16_bf16(*(const LAS bf16x8*)(vb + 32 * KROW + 96), pb1, o1, 0, 0, 0); }
            }
            if (more) { *(LAS u32x4*)(F.lds + OFF_K + ((it + 1) & 1) * KBUF + sto) = kr; *(LAS u32x4*)(F.lds + OFF_V + ((it + 1) & 1) * KBUF + sto) = vr; }
            __syncthreads();
            blk = nblk; kt = nkt; ++it;
        }
        lrun += __shfl_xor(lrun, 32); const float inv = 1.0f / lrun;
        bf16* op = XB + tok * 1024 + 512 + hh * 64 + 4 * hi;
#pragma unroll
        for (int g4 = 0; g4 < 4; ++g4) { u32x2 w0, w1; w0.x = pk2(o0[4 * g4] * inv, o0[4 * g4 + 1] * inv); w0.y = pk2(o0[4 * g4 + 2] * inv, o0[4 * g4 + 3] * inv);
            w1.x = pk2(o1[4 * g4] * inv, o1[4 * g4 + 1] * inv); w1.y = pk2(o1[4 * g4 + 2] * inv, o1[4 * g4 + 3] * inv);
            *(u32x2*)(op + 8 * g4) = w0; *(u32x2*)(op + 32 + 8 * g4) = w1; }
    }
}

__device__ __forceinline__ void ph_xatt(Frame& F) {
    constexpr int KROW = 528, KBUF = 32 * KROW, VROW = 80, VBUF = 256 * VROW, OFF_K = 0, OFF_V = 2 * KBUF;
    const bf16* XQ = WSP(bf16, AR_XQ); const bf16* XK = WSP(bf16, WS_XK); const bf16* XVT = WSP(bf16, WS_XVT); bf16* XO = WSP(bf16, AR_XO);
    const int lane = F.lane, r32 = lane & 31, hi = lane >> 5, wave = F.wave, tid = F.tid;
    for (int u = blockIdx.x; u < 256; u += F.G) {
        const int b = u >> 5, hx = (u >> 3) & 3, qt = u & 7;
        const size_t tok = (size_t)b * 2048 + qt * 256 + wave * 32 + r32;
        const bf16* Qg = XQ + tok * 1024 + hx * 256 + 8 * hi;
        const bf16* Kg = XK + (size_t)(b * 256 + (tid >> 5)) * 1024 + hx * 256 + (tid & 31) * 8;
        const bf16* Vg = XVT + ((size_t)(b * 4 + hx) * 256 + (tid >> 2)) * 256 + (tid & 3) * 8;
        const int ksto = (tid >> 5) * KROW + (tid & 31) * 16, vsto = (tid >> 2) * VROW + (tid & 3) * 16;
        float mrun = -INFINITY, lrun = 0.f; f32x16 o[8];
#pragma unroll
        for (int dt = 0; dt < 8; ++dt)
#pragma unroll
            for (int i = 0; i < 16; ++i) o[dt][i] = 0.f;
        __syncthreads();
        { const u32x4 k0r = *(const u32x4*)(Kg), k1r = *(const u32x4*)(Kg + (size_t)16 * 1024), v0r = *(const u32x4*)(Vg), v1r = *(const u32x4*)(Vg + (size_t)128 * 256);
          *(LAS u32x4*)(F.lds + OFF_K + ksto) = k0r; *(LAS u32x4*)(F.lds + OFF_K + ksto + 16 * KROW) = k1r; *(LAS u32x4*)(F.lds + OFF_V + vsto) = v0r; *(LAS u32x4*)(F.lds + OFF_V + vsto + 128 * VROW) = v1r; }
        __syncthreads();
        for (int kt = 0; kt < 8; ++kt) {
            const bool more = kt + 1 < 8; const int k0n = (kt + 1) * 32; u32x4 s0r, s1r;
            if (more) { s0r = *(const u32x4*)(Kg + (size_t)k0n * 1024); s1r = *(const u32x4*)(Kg + (size_t)(k0n + 16) * 1024); }
            const LAS unsigned char* kb = F.lds + OFF_K + (kt & 1) * KBUF + r32 * KROW + 16 * hi;
            const LAS unsigned char* vb = F.lds + OFF_V + (kt & 1) * VBUF + r32 * VROW + 16 * hi;
            f32x16 sc;
#pragma unroll
            for (int i = 0; i < 16; ++i) sc[i] = 0.f;
            bf16x8 qa[4], qb[4];
#pragma unroll
            for (int s = 0; s < 4; ++s) qa[s] = *(const bf16x8*)(Qg + 16 * s);
#pragma unroll
            for (int s = 0; s < 4; ++s) qb[s] = *(const bf16x8*)(Qg + 64 + 16 * s);
#pragma unroll
            for (int s = 0; s < 4; ++s) sc = __builtin_amdgcn_mfma_f32_32x32x16_bf16(*(const LAS bf16x8*)(kb + 32 * s), qa[s], sc, 0, 0, 0);
            asm volatile("" ::: "memory");
#pragma unroll
            for (int s = 0; s < 4; ++s) qa[s] = *(const bf16x8*)(Qg + 128 + 16 * s);
#pragma unroll
            for (int s = 0; s < 4; ++s) sc = __builtin_amdgcn_mfma_f32_32x32x16_bf16(*(const LAS bf16x8*)(kb + 128 + 32 * s), qb[s], sc, 0, 0, 0);
            asm volatile("" ::: "memory");
#pragma unroll
            for (int s = 0; s < 4; ++s) qb[s] = *(const bf16x8*)(Qg + 192 + 16 * s);
#pragma unroll
            for (int s = 0; s < 4; ++s) sc = __builtin_amdgcn_mfma_f32_32x32x16_bf16(*(const LAS bf16x8*)(kb + 256 + 32 * s), qa[s], sc, 0, 0, 0);
            asm volatile("" ::: "memory");
#pragma unroll
            for (int s = 0; s < 4; ++s) sc = __builtin_amdgcn_mfma_f32_32x32x16_bf16(*(const LAS bf16x8*)(kb + 384 + 32 * s), qb[s], sc, 0, 0, 0);
            if (more) { LAS unsigned char* kd = F.lds + OFF_K + ((kt + 1) & 1) * KBUF + ksto; *(LAS u32x4*)(kd) = s0r; *(LAS u32x4*)(kd + 16 * KROW) = s1r;
                s0r = *(const u32x4*)(Vg + k0n); s1r = *(const u32x4*)(Vg + (size_t)128 * 256 + k0n); }
            float mx = sc[0];
#pragma unroll
            for (int r = 1; r < 16; ++r) mx = fmaxf(mx, sc[r]);
            mx = fmaxf(mx, __shfl_xor(mx, 32));
            const float mnew = fmaxf(mrun, mx), alpha = __builtin_amdgcn_exp2f(mrun - mnew);
            float ps = 0.f;
#pragma unroll
            for (int r = 0; r < 16; ++r) { const float p = __builtin_amdgcn_exp2f(sc[r] - mnew); sc[r] = p; ps += p; }
            lrun = lrun * alpha + ps; mrun = mnew;
            const bf16x8 pf0 = pack_bf16x8(sc[0], sc[1], sc[2], sc[3], sc[4], sc[5], sc[6], sc[7]), pf1 = pack_bf16x8(sc[8], sc[9], sc[10], sc[11], sc[12], sc[13], sc[14], sc[15]);
#pragma unroll
            for (int dt = 0; dt < 8; ++dt) {
#pragma unroll
                for (int i = 0; i < 16; ++i) o[dt][i] *= alpha;
                o[dt] = __builtin_amdgcn_mfma_f32_32x32x16_bf16(*(const LAS bf16x8*)(vb + dt * 32 * VROW), pf0, o[dt], 0, 0, 0);
                o[dt] = __builtin_amdgcn_mfma_f32_32x32x16_bf16(*(const LAS bf16x8*)(vb + dt * 32 * VROW + 32), pf1, o[dt], 0, 0, 0); }
            if (more) { LAS unsigned char* vd = F.lds + OFF_V + ((kt + 1) & 1) * VBUF + vsto; *(LAS u32x4*)(vd) = s0r; *(LAS u32x4*)(vd + 128 * VROW) = s1r; }
            __syncthreads();
        }
        lrun += __shfl_xor(lrun, 32); const float inv = 1.0f / lrun;
        bf16* op = XO + tok * 1024 + hx * 256 + 4 * hi;
#pragma unroll
        for (int dt = 0; dt < 8; ++dt)
#pragma unroll
            for (int g4 = 0; g4 < 4; ++g4) { u32x2 w; w.x = pk2(o[dt][4 * g4] * inv, o[dt][4 * g4 + 1] * inv); w.y = pk2(o[dt][4 * g4 + 2] * inv, o[dt][4 * g4 + 3] * inv);
                *(u32x2*)(op + 32 * dt + 8 * g4) = w; }
    }
}

__device__ __forceinline__ void ph_prep(Frame& F, int l) {
    constexpr int LROW = 528;
    LAS unsigned char* lat = F.lds;
    const bf16* PR = WSP(bf16, AR_PR); bf16* SCANIN = WSP(bf16, AR_SCANIN); bf16* XB = WSP(bf16, WS_XB); float* BONUS = WSP(float, WS_BONUS);
    const bf16* WUPT = (const bf16*)(F.ws + WS_W + W_WUPT); const bf16* AUPT = (const bf16*)(F.ws + WS_W + W_AUPT); const bf16* GUPT = (const bf16*)(F.ws + WS_W + W_GUPT);
    const int h = F.wave, lane = F.lane, r32 = lane & 31, hi = lane >> 5;
    const float* mu = FIN(I_MU) + l * RPROJ; const float* w0p = FIN(I_W0) + l * RW; const float* a0p = FIN(I_A0) + l * RW; const float* kkp = FIN(I_KK) + l * RW; const float* kap = FIN(I_KA) + l * RW; const float* rkp = FIN(I_RK) + l * RW;
    for (int task = blockIdx.x; task < M / 32; task += F.G) { const int t0 = task * 32;
        __syncthreads();
        { const int tt = F.tid >> 4, l16 = (F.tid & 15) * 16, t = t0 + tt; const bf16* pc = PR + (size_t)t * RPROJ + 1536 + l16;
          u32x4 cur[2], prv[2]; cur[0] = *(const u32x4*)pc; cur[1] = *(const u32x4*)(pc + 8); prv[0] = (u32x4){0u, 0u, 0u, 0u}; prv[1] = prv[0];
          if (t & 2047) { prv[0] = *(const u32x4*)(pc - RPROJ); prv[1] = *(const u32x4*)(pc - RPROJ + 8); }
          u32x4 ow[2];
#pragma unroll
          for (int hh = 0; hh < 2; ++hh) { const f32x4 m0 = *(const f32x4*)(mu + 1536 + l16 + 8 * hh), m1 = *(const f32x4*)(mu + 1536 + l16 + 8 * hh + 4); float xv[8];
#pragma unroll
              for (int i = 0; i < 4; ++i) { const unsigned cw = cur[hh][i], pw = prv[hh][i]; const float p0 = bf2f(cw & 0xffffu), p1 = bf2f(cw >> 16), q0 = bf2f(pw & 0xffffu), q1 = bf2f(pw >> 16);
                  const float ma = i < 2 ? m0[2 * i] : m1[2 * i - 4], mb = i < 2 ? m0[2 * i + 1] : m1[2 * i - 3];
                  xv[2 * i] = p0 + (q0 - p0) * ma; xv[2 * i + 1] = p1 + (q1 - p1) * mb; }
#pragma unroll
              for (int i = 0; i < 8; ++i) { if (l16 < 64) xv[i] = 1.0f - 2.0f * __builtin_amdgcn_rcpf(1.0f + __expf(2.0f * xv[i])); else if (l16 >= 128) xv[i] = sigmoidf_(xv[i]); }
              ow[hh] = (u32x4){pk2(xv[0], xv[1]), pk2(xv[2], xv[3]), pk2(xv[4], xv[5]), pk2(xv[6], xv[7])}; }
          *(LAS u32x4*)(lat + tt * LROW + l16 * 2) = ow[0]; *(LAS u32x4*)(lat + tt * LROW + l16 * 2 + 16) = ow[1]; }
        __syncthreads();
        const int t = t0 + r32, bb = t >> 11, tp = t & 2047; const bool hasprev = tp != 0;
        const bf16* prow = PR + (size_t)t * RPROJ; bf16* so = SCANIN + ((size_t)(bb * 8 + h) * 2048 + tp) * 384;
        float n2 = 0.f, bon = 0.f;
#pragma unroll
        for (int q = 0; q < 8; ++q) { const int c4 = h * 64 + 8 * q + 4 * hi;
            const u32x2 kc = *(const u32x2*)(prow + 512 + c4); u32x2 kp = {0u, 0u}; if (hasprev) kp = *(const u32x2*)(prow + 512 + c4 - RPROJ);
            const f32x4 mk = *(const f32x4*)(mu + 512 + c4), kkc = *(const f32x4*)(kkp + c4);
#pragma unroll
            for (int i = 0; i < 4; ++i) { const unsigned sh = (i & 1) * 16; float k = bf2f((kc[i >> 1] >> sh) & 0xffffu); const float kq = bf2f((kp[i >> 1] >> sh) & 0xffffu);
                k += (kq - k) * mk[i]; const float kk = k * kkc[i]; n2 += kk * kk; } }
        n2 += __shfl_xor(n2, 32);
        const float inv = 1.0f / fmaxf(sqrtf(n2), 1e-12f);
        asm volatile("" ::: "memory");
#pragma unroll 1
        for (int ct = 0; ct < 2; ++ct) { const int cb = h * 64 + 32 * ct;
            f32x16 aw, aa, ag;
#pragma unroll
            for (int i = 0; i < 16; ++i) { aw[i] = 0.f; aa[i] = 0.f; ag[i] = 0.f; }
            const LAS unsigned char* lb = lat + r32 * LROW + 16 * hi;
#pragma unroll
            for (int s = 0; s < 4; ++s) { const bf16x8 wf = *(const bf16x8*)(WUPT + (size_t)(cb + r32) * 64 + 16 * s + 8 * hi), af = *(const bf16x8*)(AUPT + (size_t)(cb + r32) * 64 + 16 * s + 8 * hi);
                const bf16x8 lw = *(const LAS bf16x8*)(lb + 32 * s), la = *(const LAS bf16x8*)(lb + 128 + 32 * s);
                aw = __builtin_amdgcn_mfma_f32_32x32x16_bf16(wf, lw, aw, 0, 0, 0); aa = __builtin_amdgcn_mfma_f32_32x32x16_bf16(af, la, aa, 0, 0, 0); }
#pragma unroll
            for (int s = 0; s < 8; ++s) { const bf16x8 gf = *(const bf16x8*)(GUPT + (size_t)(cb + r32) * 128 + 16 * s + 8 * hi); const bf16x8 lg = *(const LAS bf16x8*)(lb + 256 + 32 * s);
                ag = __builtin_amdgcn_mfma_f32_32x32x16_bf16(gf, lg, ag, 0, 0, 0); }
#pragma unroll
            for (int g = 0; g < 4; ++g) { const int c4 = cb + 8 * g + 4 * hi;
                asm volatile("" ::: "memory");
                const u32x2 rc = *(const u32x2*)(prow + c4), kc = *(const u32x2*)(prow + 512 + c4), vc = *(const u32x2*)(prow + 1024 + c4);
                u32x2 rp = {0u, 0u}, kp = {0u, 0u}, vp = {0u, 0u};
                if (hasprev) { rp = *(const u32x2*)(prow + c4 - RPROJ); kp = *(const u32x2*)(prow + 512 + c4 - RPROJ); vp = *(const u32x2*)(prow + 1024 + c4 - RPROJ); }
                const f32x4 mr = *(const f32x4*)(mu + c4), mk = *(const f32x4*)(mu + 512 + c4), mv = *(const f32x4*)(mu + 1024 + c4);
                const f32x4 w0v = *(const f32x4*)(w0p + c4), a0v = *(const f32x4*)(a0p + c4), kkc = *(const f32x4*)(kkp + c4), kac = *(const f32x4*)(kap + c4), rkc = *(const f32x4*)(rkp + c4);
                float ro[4], ko[4], vo[4], ldo[4], go[4], nk[4], bo[4];
#pragma unroll
                for (int i = 0; i < 4; ++i) { const unsigned sh = (i & 1) * 16;
                    float r = bf2f((rc[i >> 1] >> sh) & 0xffffu), k = bf2f((kc[i >> 1] >> sh) & 0xffffu), v = bf2f((vc[i >> 1] >> sh) & 0xffffu);
                    const float rq = bf2f((rp[i >> 1] >> sh) & 0xffffu), kq = bf2f((kp[i >> 1] >> sh) & 0xffffu), vq = bf2f((vp[i >> 1] >> sh) & 0xffffu);
                    r += (rq - r) * mr[i]; k += (kq - k) * mk[i]; v += (vq - v) * mv[i];
                    const float wv = w0v[i] + aw[4 * g + i], xs = -wv, sp = xs > 20.f ? xs : __logf(1.0f + __expf(xs)), ld = -__expf(-sp - 0.5f);
                    const float a = sigmoidf_(a0v[i] + aa[4 * g + i]);
                    const float kn = k * kkc[i] * inv, kt = k * (1.0f + (a - 1.0f) * kac[i]);
                    bon += r * kt * rkc[i];
                    ro[i] = r; ko[i] = kt; vo[i] = v; ldo[i] = ld; go[i] = ag[4 * g + i]; nk[i] = -kn; bo[i] = kn * a; }
                const int co = 32 * ct + 8 * g + 4 * hi;
                *(u32x2*)(so + co) = (u32x2){pk2(nk[0], nk[1]), pk2(nk[2], nk[3])}; *(u32x2*)(so + 64 + co) = (u32x2){pk2(ldo[0], ldo[1]), pk2(ldo[2], ldo[3])};
                *(u32x2*)(so + 128 + co) = (u32x2){pk2(bo[0], bo[1]), pk2(bo[2], bo[3])}; *(u32x2*)(so + 192 + co) = (u32x2){pk2(ko[0], ko[1]), pk2(ko[2], ko[3])};
                *(u32x2*)(so + 256 + co) = (u32x2){pk2(ro[0], ro[1]), pk2(ro[2], ro[3])}; *(u32x2*)(so + 320 + co) = (u32x2){pk2(vo[0], vo[1]), pk2(vo[2], vo[3])};
                *(u32x2*)(XB + (size_t)t * 1024 + c4) = (u32x2){pk2(go[0], go[1]), pk2(go[2], go[3])}; }
        }
        bon += __shfl_xor(bon, 32);
        if (hi == 0) BONUS[(size_t)t * 8 + h] = bon;
    }
}

template <int R, int NCH, bool KINDP>
__device__ __forceinline__ void scan_stream(Frame& F, LAS float* ring, int bh, int ch, int rg, int lis) {
    typedef float f32x2 __attribute__((ext_vector_type(2)));
    constexpr int CLEN = SEQ / NCH, NHALF = CLEN / 8;
    const int lane = F.lane, js = lane & 3, q = lane >> 2, row0 = rg * 16 * R + q * R, tbase = ch * CLEN;
    const bf16* src = WSP(bf16, AR_SCANIN) + ((size_t)bh * 2048 + tbase) * 384;
    float* YL = WSP(float, AR_YLOC) + ((size_t)bh * 2048 + tbase) * 64; bf16* ZZ = WSP(bf16, AR_Z) + ((size_t)bh * 2048 + tbase) * 64;
    f32x2 S[R][8];
#pragma unroll
    for (int rr = 0; rr < R; ++rr)
#pragma unroll
        for (int k = 0; k < 8; ++k) { S[rr][k].x = (KINDP && (row0 + rr) == 16 * js + 2 * k) ? 1.f : 0.f; S[rr][k].y = (KINDP && (row0 + rr) == 16 * js + 2 * k + 1) ? 1.f : 0.f; }
    u32x4 pre[2];
#pragma unroll
    for (int k = 0; k < 2; ++k) { const int ci = lis + k * 256; if (ci < 384) pre[k] = *(const u32x4*)(src + (size_t)ci * 8); }
#pragma unroll
    for (int k = 0; k < 2; ++k) { const int ci = lis + k * 256; if (ci < 384) { const bool isld = ((ci % 48) >> 3) == 1; float f[8];
#pragma unroll
            for (int i = 0; i < 4; ++i) { f[2 * i] = bf2f(pre[k][i] & 0xffffu); f[2 * i + 1] = bf2f(pre[k][i] >> 16); }
            if (isld) {
#pragma unroll
                for (int i = 0; i < 8; ++i) f[i] = __expf(f[i]); }
            *(LAS f32x4*)(ring + ci * 8) = (f32x4){f[0], f[1], f[2], f[3]}; *(LAS f32x4*)(ring + ci * 8 + 4) = (f32x4){f[4], f[5], f[6], f[7]}; } }
    __syncthreads();
    for (int hf = 0; hf < NHALF; ++hf) {
        const bool more = hf + 1 < NHALF;
        if (more) {
#pragma unroll
            for (int k = 0; k < 2; ++k) { const int ci = lis + k * 256; if (ci < 384) pre[k] = *(const u32x4*)(src + (size_t)(hf + 1) * 3072 + (size_t)ci * 8); } }
#pragma unroll 2
        for (int st = 0; st < 8; ++st) {
            const LAS float* sp = ring + ((hf & 1) * 8 + st) * 384 + 16 * js;
            f32x2 nn[8], ww[8], bb[8], kk[8], rr2[8];
#pragma unroll
            for (int i = 0; i < 4; ++i) { const f32x4 a = *(const LAS f32x4*)(sp + 4 * i); nn[2 * i] = (f32x2){a[0], a[1]}; nn[2 * i + 1] = (f32x2){a[2], a[3]}; }
#pragma unroll
            for (int i = 0; i < 4; ++i) { const f32x4 a = *(const LAS f32x4*)(sp + 64 + 4 * i); ww[2 * i] = (f32x2){a[0], a[1]}; ww[2 * i + 1] = (f32x2){a[2], a[3]}; }
#pragma unroll
            for (int i = 0; i < 4; ++i) { const f32x4 a = *(const LAS f32x4*)(sp + 128 + 4 * i); bb[2 * i] = (f32x2){a[0], a[1]}; bb[2 * i + 1] = (f32x2){a[2], a[3]}; }
            if (!KINDP) {
#pragma unroll
                for (int i = 0; i < 4; ++i) { const f32x4 a = *(const LAS f32x4*)(sp + 192 + 4 * i); kk[2 * i] = (f32x2){a[0], a[1]}; kk[2 * i + 1] = (f32x2){a[2], a[3]}; } }
#pragma unroll
            for (int i = 0; i < 4; ++i) { const f32x4 a = *(const LAS f32x4*)(sp + 256 + 4 * i); rr2[2 * i] = (f32x2){a[0], a[1]}; rr2[2 * i + 1] = (f32x2){a[2], a[3]}; }
            float vv[R];
            if (!KINDP) {
#pragma unroll
                for (int rr = 0; rr < R; ++rr) vv[rr] = ring[((hf & 1) * 8 + st) * 384 + 320 + row0 + rr]; }
            float sa[R];
#pragma unroll
            for (int rr = 0; rr < R; ++rr) { f32x2 p0 = S[rr][0] * nn[0], p1 = S[rr][1] * nn[1];
#pragma unroll
                for (int k = 2; k < 8; k += 2) { p0 = S[rr][k] * nn[k] + p0; p1 = S[rr][k + 1] * nn[k + 1] + p1; }
                p0 = p0 + p1; sa[rr] = quad_sum(p0.x + p0.y); }
            float y[R];
#pragma unroll
            for (int rr = 0; rr < R; ++rr) { const f32x2 sa2 = (f32x2){sa[rr], sa[rr]}; f32x2 p0 = (f32x2){0.f, 0.f}, p1 = (f32x2){0.f, 0.f};
#pragma unroll
                for (int k = 0; k < 8; k += 2) {
                    f32x2 t0 = S[rr][k] * ww[k], t1 = S[rr][k + 1] * ww[k + 1];
                    t0 = sa2 * bb[k] + t0; t1 = sa2 * bb[k + 1] + t1;
                    if (!KINDP) { const f32x2 v2 = (f32x2){vv[rr], vv[rr]}; t0 = v2 * kk[k] + t0; t1 = v2 * kk[k + 1] + t1; }
                    S[rr][k] = t0; S[rr][k + 1] = t1; p0 = t0 * rr2[k] + p0; p1 = t1 * rr2[k + 1] + p1; }
                p0 = p0 + p1; y[rr] = quad_sum(p0.x + p0.y); }
            if (js == 0) { const int t = hf * 8 + st;
                if (R == 2) { if (KINDP) *(unsigned*)(ZZ + (size_t)t * 64 + row0) = pk2(y[0], y[R - 1]); else *(f32x2*)(YL + (size_t)t * 64 + row0) = (f32x2){y[0], y[R - 1]}; }
                else {
#pragma unroll
                    for (int rr = 0; rr < R; ++rr) { if (KINDP) ZZ[(size_t)t * 64 + row0 + rr] = (bf16)f2bf(y[rr]); else YL[(size_t)t * 64 + row0 + rr] = y[rr]; } } }
        }
        if (more) {
#pragma unroll
            for (int k = 0; k < 2; ++k) { const int ci = lis + k * 256; if (ci < 384) { const bool isld = ((ci % 48) >> 3) == 1; float f[8];
#pragma unroll
                    for (int i = 0; i < 4; ++i) { f[2 * i] = bf2f(pre[k][i] & 0xffffu); f[2 * i + 1] = bf2f(pre[k][i] >> 16); }
                    if (isld) {
#pragma unroll
                        for (int i = 0; i < 8; ++i) f[i] = __expf(f[i]); }
                    LAS float* dst = ring + (((hf + 1) & 1) * 8) * 384 + ci * 8;
                    *(LAS f32x4*)(dst) = (f32x4){f[0], f[1], f[2], f[3]}; *(LAS f32x4*)(dst + 4) = (f32x4){f[4], f[5], f[6], f[7]}; } } }
        __syncthreads();
    }
    if (NCH > 1) {
        float* st = WSP(float, AR_STATE) + ((size_t)(bh * NCH + ch) * 2 + (KINDP ? 0 : 1)) * 4096;
#pragma unroll
        for (int rr = 0; rr < R; ++rr)
#pragma unroll
            for (int i = 0; i < 4; ++i) *(f32x4*)(st + (size_t)(row0 + rr) * 64 + 16 * js + 4 * i) = (f32x4){S[rr][2 * i].x, S[rr][2 * i].y, S[rr][2 * i + 1].x, S[rr][2 * i + 1].y};
    }
}
template <int R, int NCH>
__device__ __forceinline__ void ph_scan(Frame& F) {
    constexpr int KINDS = NCH > 1 ? 2 : 1, RG = 4 / R, WPS = KINDS * RG, SPW = NWAVES / WPS, NSTREAM = BATCH * NH * NCH;
    static_assert(WPS == 4, "staging assumes 4 waves per stream");
    const int sl = F.wave / WPS, role = F.wave % WPS, kind = role / RG, rg = role % RG, lis = role * 64 + F.lane;
    LAS float* ring = (LAS float*)F.lds + sl * (16 * 384);
    for (int it = blockIdx.x; it * SPW < NSTREAM; it += F.G) {
        const int sid = it * SPW + sl, bh = sid / NCH, ch = sid % NCH;
        __syncthreads();
        if (kind == 0) scan_stream<R, NCH, false>(F, ring, bh, ch, rg, lis); else scan_stream<R, NCH, true>(F, ring, bh, ch, rg, lis);
    }
}

template <int NCH>
__device__ __forceinline__ void ph_fix(Frame& F) {
    typedef float f32x2 __attribute__((ext_vector_type(2)));
    LAS float* cur = (LAS float*)F.lds;
    for (int u = blockIdx.x; u < 256; u += F.G) { const int bh = u >> 2, rgx = u & 3, i = F.tid >> 5, j2 = (F.tid & 31) * 2, row = rgx * 16 + i;
        float* base = WSP(float, AR_STATE) + (size_t)bh * NCH * 2 * 4096;
        __syncthreads();
        { const f32x2 v = *(const f32x2*)(base + 4096 + row * 64 + j2); cur[i * 64 + j2] = v.x; cur[i * 64 + j2 + 1] = v.y; }
        __syncthreads();
        for (int c = 1; c < NCH - 1; ++c) { const float* P = base + (size_t)(c * 2) * 4096; float* SL = base + (size_t)(c * 2 + 1) * 4096;
            f32x2 acc = *(const f32x2*)(SL + row * 64 + j2);
#pragma unroll
            for (int ii = 0; ii < 64; ++ii) { const float sv = cur[i * 64 + ii]; const f32x2 p = *(const f32x2*)(P + ii * 64 + j2); acc.x += sv * p.x; acc.y += sv * p.y; }
            __syncthreads();
            cur[i * 64 + j2] = acc.x; cur[i * 64 + j2 + 1] = acc.y; *(f32x2*)(SL + row * 64 + j2) = acc;
            __syncthreads(); }
    }
}

template <int NCH>
__device__ __forceinline__ void ph_post(Frame& F, int l) {
    constexpr int CLEN = SEQ / NCH;
    const float* YL = WSP(float, AR_YLOC); const bf16* SCANIN = WSP(bf16, AR_SCANIN); bf16* XB = WSP(bf16, WS_XB); const float* BONUS = WSP(float, WS_BONUS); const bf16* ZZ = WSP(bf16, AR_Z);
    LAS float* zt = (LAS float*)F.lds;
    const int c = F.tid, h = F.wave, j = F.lane; const float lng = FIN(I_LNG)[l * RW + c], lnb = FIN(I_LNB)[l * RW + c];
    for (int grp = blockIdx.x; grp < M / 64; grp += F.G) { const int t0g = grp * 64, bb = t0g >> 11, ch = (t0g & 2047) / CLEN, bh = bb * 8 + h; const bool corr = NCH > 1 && ch > 0;
        float st[64];
        if (corr) { const float* sp = WSP(float, AR_STATE) + ((size_t)(bh * NCH + ch - 1) * 2 + 1) * 4096 + j * 64;
#pragma unroll
            for (int i4 = 0; i4 < 16; ++i4) { const f32x4 v = *(const f32x4*)(sp + 4 * i4); st[4 * i4] = v[0]; st[4 * i4 + 1] = v[1]; st[4 * i4 + 2] = v[2]; st[4 * i4 + 3] = v[3]; } }
        for (int ti = 0; ti < 4; ++ti) { const int t0 = t0g + 16 * ti;
            if (corr) { __syncthreads();
#pragma unroll 4
                for (int tt = 0; tt < 16; ++tt) zt[tt * 512 + c] = bf2f(ZZ[((size_t)bh * 2048 + ((t0 + tt) & 2047)) * 64 + j]);
                __syncthreads(); }
#pragma unroll 1
            for (int tb = 0; tb < 16; tb += 8) {
                float yv[8], vv[8], bv[8], gv[8];
#pragma unroll
                for (int q = 0; q < 8; ++q) { const int t = t0 + tb + q, tp = t & 2047;
                    yv[q] = YL[((size_t)bh * 2048 + tp) * 64 + j]; vv[q] = bf2f(SCANIN[((size_t)bh * 2048 + tp) * 384 + 320 + j]); bv[q] = BONUS[(size_t)t * 8 + h]; gv[q] = bf2f(XB[(size_t)t * 1024 + c]); }
                if (corr) {
#pragma unroll
                    for (int q = 0; q < 8; ++q) { const LAS float* zp = zt + (tb + q) * 512 + h * 64; float p0 = 0.f, p1 = 0.f, p2 = 0.f, p3 = 0.f;
#pragma unroll
                        for (int qq = 0; qq < 4; ++qq) { asm volatile("" ::: "memory");
                            f32x4 zz[4];
#pragma unroll
                            for (int e = 0; e < 4; ++e) zz[e] = *(const LAS f32x4*)(zp + 16 * qq + 4 * e);
#pragma unroll
                            for (int e = 0; e < 4; ++e) { const int j4 = 4 * qq + e; p0 += st[4 * j4] * zz[e][0]; p1 += st[4 * j4 + 1] * zz[e][1]; p2 += st[4 * j4 + 2] * zz[e][2]; p3 += st[4 * j4 + 3] * zz[e][3]; }
                            asm volatile("" : "+v"(p0), "+v"(p1), "+v"(p2), "+v"(p3)); }
                        yv[q] += (p0 + p1) + (p2 + p3); } }
                float mean[8], var[8];
#pragma unroll
                for (int q = 0; q < 8; ++q) mean[q] = yv[q];
                wave_sum8(mean);
#pragma unroll
                for (int q = 0; q < 8; ++q) { mean[q] *= (1.0f / 64.0f); yv[q] -= mean[q]; var[q] = yv[q] * yv[q]; }
                wave_sum8(var);
#pragma unroll
                for (int q = 0; q < 8; ++q) { const int t = t0 + tb + q;
                    const float yn = yv[q] * __builtin_amdgcn_rsqf(var[q] * (1.0f / 64.0f) + LNX_EPS) * lng + lnb;
                    XB[(size_t)t * 1024 + c] = (bf16)f2bf((yn + bv[q] * vv[q]) * gv[q]); }
            }
        }
    }
}

__device__ __forceinline__ void ph_final(Frame& F) {
    const int gw = F.vcu * NWAVES + F.wave, NGW = F.G * NWAVES; const float* ssq = WSP(float, WS_SSQ); const float* g = FIN(I_FING);
    f32x4 gv[4];
#pragma unroll
    for (int j = 0; j < 4; ++j) gv[j] = ((const f32x4*)g)[F.lane + 64 * j];
    for (int r = gw; r < M; r += NGW) { const float rs = pg8::row_rstd16(ssq, r); f32x4* xr = (f32x4*)(F.out + (size_t)r * DM) + F.lane;
#pragma unroll
        for (int j = 0; j < 4; ++j) { const f32x4 v = xr[64 * j]; xr[64 * j] = v * rs * gv[j]; } }
}

constexpr int PH_INIT = 0, PH_PER_LAYER = 16, PH_FINAL = 1 + DEPTH * PH_PER_LAYER, N_PHASES = PH_FINAL + 1;
enum { K_CONV = 0, K_KV, K_F1UP, K_F1DN, K_MIXIN, K_MOBA, K_PREP, K_SCAN, K_FIX, K_POST, K_MIXOUT, K_XQ, K_XATT, K_XO, K_F2UP, K_F2DN };

#ifdef ONLY
#define PH_ON(k) ((k) == (ONLY))
#else
#define PH_ON(k) true
#endif
__global__ void __launch_bounds__(NWAVES * 64, 2) fwd(Args args) {
    extern __shared__ __attribute__((aligned(16))) unsigned char lds[];
    Frame F;
    F.lds = (LAS unsigned char*)lds; F.MISC = (volatile LAS unsigned*)(F.lds + MISC_OFF);
    F.tid = threadIdx.x; F.lane = F.tid & 63; F.wave = __builtin_amdgcn_readfirstlane(F.tid >> 6);
    F.G = gridDim.x; { const int bx = blockIdx.x; F.vcu = (F.G % 8 == 0) ? (bx % 8) * (F.G / 8) + bx / 8 : bx; }
    F.out = args.out; F.ws = args.ws; F.ctl = (gu32*)(args.ws + WS_CTL);
    F.ka = (const __attribute__((address_space(4))) Args*)(uintptr_t)__builtin_amdgcn_kernarg_segment_ptr();
    for (int u = F.tid; u < (LDS_BYTES - LDSCTL_OFF) / 4; u += NWAVES * 64) ((LAS unsigned*)(F.lds + LDSCTL_OFF))[u] = 0u;
    __syncthreads();
    const bool multi = args.ph_hi - args.ph_lo > 1;
    XcdBarrier bar; bar.bar = (unsigned*)(F.ctl + 4096); bar.x = 0; bar.st = nullptr;
    if (multi) bar = xcd_barrier_post((unsigned*)(F.ctl + 4096), F.MISC + 8);
#ifndef REP_AT
#define REP_AT 1000
#endif
    for (int pi = args.ph_lo; pi < args.ph_hi + (REP_AT < 1000 ? 1 : 0); ++pi) { const int ph = pi - (pi > REP_AT ? 1 : 0);
        { uintptr_t kp = (uintptr_t)__builtin_amdgcn_kernarg_segment_ptr(); asm volatile("" : "+s"(kp)); F.ka = (const __attribute__((address_space(4))) Args*)kp; }
        { int t_ = threadIdx.x; asm volatile("" : "+v"(t_)); F.tid = t_; F.lane = t_ & 63; F.wave = __builtin_amdgcn_readfirstlane(t_ >> 6); }
        unsigned char* wb = F.ws + WS_W;
        if (ph == PH_INIT) { if (PH_ON(100)) ph_init(F); }
        else if (ph == PH_FINAL) { if (PH_ON(101)) ph_final(F); }
        else { const int l = (ph - 1) / PH_PER_LAYER, k = (ph - 1) % PH_PER_LAYER;
            const float* xin = (l == 0) ? FIN(I_X) : (const float*)F.out;
            switch (k) {
            case K_CONV: if (!PH_ON(K_CONV)) break; ph_conv(F, l); break;
            case K_KV: if (!PH_ON(K_KV)) break; { pg8::Gemm g{WSP(bf16, WS_MEMB), (const bf16*)(wb + W_WKV), MM, 2 * DM, DM}; pg8::StaticOrder S; S.init(MM, 2 * DM, F.G, (int)blockIdx.x);
                pg8::EpiKV E{F.ws}; pg8::gemm_phase<pg8::EpiKV, pg8::StaticOrder, true, true>(F.lds, g, S, E); } break;
            case K_F1UP: case K_F2UP: if (!PH_ON(K_F1UP)) break; { pg8::Gemm g{WSP(bf16, WS_XB), (const bf16*)(wb + (k == K_F1UP ? W_F1IN : W_F2IN)), M, 2 * DFF, DM}; pg8::StaticOrder S; S.init(M, 2 * DFF, F.G, (int)blockIdx.x);
                pg8::EpiSwiGLU E{F.ws}; pg8::gemm_phase<pg8::EpiSwiGLU, pg8::StaticOrder, true, true>(F.lds, g, S, E); } break;
            case K_F1DN: case K_F2DN: if (!PH_ON(K_F1DN)) break; { pg8::Gemm g{WSP(bf16, AR_H), (const bf16*)(wb + (k == K_F1DN ? W_F1OUT : W_F2OUT)), M, DM, DFF}; pg8::StaticOrder S; S.init(M, DM, F.G, (int)blockIdx.x);
                pg8::EpiResid E{k == K_F1DN ? xin : (const float*)F.out, F.out, F.ws, WS_XB, 0.5f}; pg8::gemm_phase<pg8::EpiResid, pg8::StaticOrder, true, true>(F.lds, g, S, E); } break;
            case K_MIXIN: if (!PH_ON(K_MIXIN)) break; { pg8::Gemm g{WSP(bf16, WS_XB), (const bf16*)(wb + W_MIXIN), M, DPROJ, DM}; pg8::StaticOrder S; S.init(M, DPROJ, F.G, (int)blockIdx.x);
                pg8::EpiMixIn E{F.ws}; pg8::gemm_phase<pg8::EpiMixIn, pg8::StaticOrder, true, true>(F.lds, g, S, E); } break;
            case K_MOBA: if (!PH_ON(K_MOBA)) break; ph_moba(F); break;
            case K_PREP: if (!PH_ON(K_PREP)) break; ph_prep(F, l); break;
            case K_SCAN: if (!PH_ON(K_SCAN)) break; ph_scan<SCAN_R, SCAN_NCH>(F); break;
            case K_FIX: if (!PH_ON(K_FIX)) break; if (SCAN_NCH > 1) ph_fix<SCAN_NCH>(F); break;
            case K_POST: if (!PH_ON(K_POST)) break; ph_post<SCAN_NCH>(F, l); break;
            case K_MIXOUT: if (!PH_ON(K_MIXOUT)) break; { pg8::Gemm g{WSP(bf16, WS_XB), (const bf16*)(wb + W_MIXOUT), M, DM, DM}; pg8::StaticOrder S; S.init(M, DM, F.G, (int)blockIdx.x);
                pg8::EpiResid E{F.out, F.out, F.ws, AR_XB2, 1.0f}; pg8::gemm_phase<pg8::EpiResid, pg8::StaticOrder, true, true>(F.lds, g, S, E); } break;
            case K_XQ: if (!PH_ON(K_XQ)) break; { pg8::Gemm g{WSP(bf16, AR_XB2), (const bf16*)(wb + W_WQ), M, DM, DM}; pg8::StaticOrder S; S.init(M, DM, F.G, (int)blockIdx.x);
                pg8::EpiXQ E{F.ws}; pg8::gemm_phase<pg8::EpiXQ, pg8::StaticOrder, true, true>(F.lds, g, S, E); } break;
            case K_XATT: if (!PH_ON(K_XATT)) break; ph_xatt(F); break;
            case K_XO: if (!PH_ON(K_XO)) break; { pg8::Gemm g{WSP(bf16, AR_XO), (const bf16*)(wb + W_WO), M, DM, DM}; pg8::StaticOrder S; S.init(M, DM, F.G, (int)blockIdx.x);
                pg8::EpiResid E{F.out, F.out, F.ws, WS_XB, 1.0f}; pg8::gemm_phase<pg8::EpiResid, pg8::StaticOrder, true, true>(F.lds, g, S, E); } break;
            default: break;
            }
        }
        if (pi + 1 < args.ph_hi + (REP_AT < 1000 ? 1 : 0)) {
            const bool noop = (ph != PH_INIT && ph != PH_FINAL && ((ph - 1) % PH_PER_LAYER) == K_FIX && SCAN_NCH == 1);
            if (!noop) { if (ph == PH_INIT) cooperative_groups::this_grid().sync(); else xcd_barrier(bar); }
        }
    }
}

extern "C" void kernel_launch(void* const* d_in, const int* in_sizes, int n_in, void* d_out, int out_size, void* d_ws, size_t ws_size, hipStream_t stream) {
    static int grid = 0;
    if (grid == 0) {
        if (n_in != N_IN || in_sizes[0] != M * DM || out_size != M * DM || ws_size < WS_END) { fprintf(stderr, "kernel_launch: unexpected problem (n_in %d, in0 %d, out %d, ws %zu < %zu); nothing launched\n", n_in, n_in > 0 ? in_sizes[0] : -1, out_size, ws_size, (size_t)WS_END); grid = -1; return; }
        int dev = 0, cus = 0;
        if (hipGetDevice(&dev) != hipSuccess || hipDeviceGetAttribute(&cus, hipDeviceAttributeMultiprocessorCount, dev) != hipSuccess) { grid = -1; return; }
        if (hipFuncSetAttribute((const void*)fwd, hipFuncAttributeMaxDynamicSharedMemorySize, LDS_BYTES) != hipSuccess) { fprintf(stderr, "kernel_launch: hipFuncSetAttribute failed\n"); grid = -1; return; }
        int per_cu = 0;
        if (hipOccupancyMaxActiveBlocksPerMultiprocessor(&per_cu, (const void*)fwd, NWAVES * 64, LDS_BYTES) != hipSuccess || per_cu < 1) { fprintf(stderr, "kernel_launch: occupancy query reports %d workgroups per CU; nothing launched\n", per_cu); grid = -1; return; }
        grid = cus;
    }
    if (grid < 0) return;
    (void)hipMemsetAsync((char*)d_ws + WS_CTL, 0, CTL_ZERO_BYTES, stream);
    Args a{};
    for (int i = 0; i < N_IN; ++i) a.in[i] = (const float*)d_in[i];
    a.out = (float*)d_out; a.ws = (unsigned char*)d_ws;
    a.ph_lo = 0; a.ph_hi = N_PHASES;
    void* kargs[] = {&a};
    const hipError_t e = hipLaunchCooperativeKernel((const void*)fwd, dim3(grid), dim3(NWAVES * 64), kargs, LDS_BYTES, stream);
    if (e != hipSuccess) fprintf(stderr, "kernel_launch: cooperative launch failed: %s (grid %d)\n", hipGetErrorString(e), grid);
}
```

```cpp
#include <hip/hip_runtime.h>
#include <hip/hip_cooperative_groups.h>
#include <cstdio>
#include <cstdint>

constexpr int BATCH = 8, SEQ = 2048, DM = 1024, DEPTH = 2, M = BATCH * SEQ;
constexpr int RW = 512, NH = 8, HD = 64;
constexpr int RPROJ = 1792, DPROJ = 3328;
constexpr int DFF = 2816;
constexpr int MEMLEN = 256, XH = 4, XHD = 256, MM = BATCH * MEMLEN;
constexpr int MBLK = 256, NBLK = SEQ / MBLK;
constexpr float NORM_EPS = 1e-6f, LNX_EPS = 64e-5f;
constexpr float LOG2E = 1.4426950408889634f;
constexpr float MOBA_QSCALE = 0.125f * LOG2E;
constexpr float XATT_QSCALE = 0.0625f * LOG2E;

enum { I_X = 0, I_MEM, I_RELB, I_FING, I_F1G, I_F1IN, I_F1OUT, I_MIXG, I_MIXIN, I_MIXOUT, I_MU, I_W0, I_WUP, I_A0, I_AUP, I_GUP, I_KK, I_KA, I_RK, I_LNG, I_LNB,
       I_XG, I_MEMG, I_WQ, I_WKV, I_WO, I_F2G, I_F2IN, I_F2OUT, N_IN };

constexpr size_t MiB = 1u << 20;
constexpr size_t WS_CTL = 0, CTL_ZERO_BYTES = 1 * MiB;
constexpr size_t WS_BIAS = 1 * MiB;
constexpr size_t WS_MEMRS = WS_BIAS + 64 * 1024;
constexpr size_t WS_BONUS = WS_MEMRS + 64 * 1024;
constexpr size_t WS_KMS = WS_BONUS + 512 * 1024;
constexpr size_t WS_SSQ = 2 * MiB;
constexpr size_t WS_MEMB = 3 * MiB;
constexpr size_t WS_XK = 7 * MiB, WS_XVT = 11 * MiB;
constexpr size_t WS_W = 15 * MiB;
constexpr size_t W_F1IN = 0, W_F1OUT = W_F1IN + (size_t)2 * DFF * DM * 2, W_F2IN = W_F1OUT + (size_t)DM * DFF * 2, W_F2OUT = W_F2IN + (size_t)2 * DFF * DM * 2,
                 W_MIXIN = W_F2OUT + (size_t)DM * DFF * 2, W_MIXOUT = W_MIXIN + (size_t)DPROJ * DM * 2, W_WQ = W_MIXOUT + (size_t)DM * DM * 2, W_WKV = W_WQ + (size_t)DM * DM * 2,
                 W_WO = W_WKV + (size_t)2 * DM * DM * 2, W_WUPT = W_WO + (size_t)DM * DM * 2, W_AUPT = W_WUPT + (size_t)RW * 64 * 2, W_GUPT = W_AUPT + (size_t)RW * 64 * 2, W_END = W_GUPT + (size_t)RW * 128 * 2;
static_assert(W_END <= 50 * MiB, "weights fit");
constexpr size_t WS_XB = 65 * MiB;
constexpr size_t WS_AR = 97 * MiB;
constexpr size_t AR_H = WS_AR;
constexpr size_t AR_PR = WS_AR, AR_MQ = WS_AR + 56 * MiB, AR_MK = WS_AR + 72 * MiB, AR_MVT = WS_AR + 88 * MiB;
constexpr size_t AR_SCANIN = WS_AR + 56 * MiB;
constexpr size_t AR_SV = WS_AR + 136 * MiB;
constexpr size_t AR_YLOC = WS_AR, AR_Z = WS_AR + 32 * MiB;
constexpr size_t AR_STATE = WS_AR + 152 * MiB;
constexpr size_t AR_XB2 = WS_AR, AR_XQ = WS_AR + 32 * MiB, AR_XO = WS_AR + 64 * MiB;
constexpr size_t WS_END = WS_AR + 168 * MiB;

#define GAS __attribute__((address_space(1)))
#define LAS __attribute__((address_space(3)))

namespace pg8 {
#define PG8_LAS __attribute__((address_space(3)))
typedef unsigned short bf16_t;
typedef short bf16x8 __attribute__((ext_vector_type(8)));
typedef float f32x4 __attribute__((ext_vector_type(4)));
typedef unsigned u32x4 __attribute__((ext_vector_type(4)));
constexpr int BM = 256, BK = 64, HALF = 128, HTB = HALF * BK * 2  , STAGE_BYTES = 8 * HTB, NXCD = 8, WGM = 8;

__host__ __device__ __forceinline__ int lds_byte(int r, int c) { const int st = (r >> 4) * 2 + (c >> 5), rr = r & 15, cc = c & 31, ob = rr * 64 + cc * 2; return st * 1024 + (ob ^ (((ob >> 9) & 1) << 5)); }
__host__ __device__ __forceinline__ void stage_rc(int b, int& R, int& C) { const int st = b / 1024, sb = b % 1024, swz = sb ^ (((sb >> 9) & 1) << 5); R = (st >> 1) * 16 + swz / 64; C = (st & 1) * 32 + (swz % 64) / 2; }
__host__ __device__ __forceinline__ int perm32(int rho) { const int n = rho >> 4, i = rho & 15; return 8 * (i >> 2) + 4 * n + (i & 3); }

struct Unit { int pm, pn; };
struct Gemm { const bf16_t* A; const bf16_t* Bt; int M, N, K; };

struct StaticOrder {
    int nM, nN, nwg, G, c;
    __host__ __device__ void init(int M, int N, int G_, int c_) { nM = M / BM; nN = N / BM; nwg = nM * nN; G = G_; c = c_; }
    __host__ __device__ bool next(int i, Unit& u) const {
        const long L = (long)i * G + c; if (L >= nwg) return false;
        int wgid = (int)L; { const int q = nwg / NXCD, r = nwg % NXCD, xcd = wgid % NXCD, off = wgid / NXCD; wgid = (xcd < r ? xcd * (q + 1) : r * (q + 1) + (xcd - r) * q) + off; }
        const int nig = WGM * nN, gid = wgid / nig, fm = gid * WGM, gsz = (nM - fm) < WGM ? (nM - fm) : WGM;
        u.pm = fm + ((wgid % nig) % gsz); u.pn = (wgid % nig) / gsz; return true;
    }
    __device__ __forceinline__ void a_ready(const Unit&) const {}
    __device__ __forceinline__ void done(const Unit&) const {}
};

__device__ __forceinline__ unsigned cvt_pk_bf16(float lo, float hi) { unsigned r; asm volatile("v_cvt_pk_bf16_f32 %0, %1, %2" : "=v"(r) : "v"(lo), "v"(hi)); return r; }
typedef float f32x2 __attribute__((ext_vector_type(2)));
__device__ __forceinline__ float row_rstd16(const float* ssq, int r) {
    const f32x4* p = (const f32x4*)(ssq + (size_t)r * 16);
    const f32x4 a = p[0], b = p[1], c = p[2], d = p[3];
    const float s = ((a[0] + a[1]) + (a[2] + a[3])) + ((b[0] + b[1]) + (b[2] + b[3])) + ((c[0] + c[1]) + (c[2] + c[3])) + ((d[0] + d[1]) + (d[2] + d[3]));
    return __builtin_amdgcn_rsqf(s * (1.0f / 1024.0f) + 1e-6f);
}
__device__ __forceinline__ float silu_mul(float g, float u) { return g * __builtin_amdgcn_rcpf(1.0f + __expf(-g)) * u; }
__device__ __forceinline__ u32x4 pack8(const f32x4 v0, const f32x4 v1) { u32x4 w; w.x = cvt_pk_bf16(v0[0], v0[1]); w.y = cvt_pk_bf16(v0[2], v0[3]); w.z = cvt_pk_bf16(v1[0], v1[1]); w.w = cvt_pk_bf16(v1[2], v1[3]); return w; }
__device__ __forceinline__ int pos16(int k) { return 8 * ((k >> 2) & 1) + (k & 3) + 4 * (k >> 3); }

struct EpiSwiGLU {
    static constexpr bool PERM = true, AFTER_DRAIN = false;
    unsigned char* ws;
    __device__ __forceinline__ void operator()(const f32x4 (&acc)[2][2][4][2], const Unit& u, int wr, int wc, int fr, int fq) const {
        const int row0 = u.pm * BM + wr * 64 + fr, hcol = u.pn * 128 + wc * 32 + 8 * fq; bf16_t* H = (bf16_t*)(ws + AR_H); const float* ssq = (const float*)(ws + WS_SSQ);
#pragma unroll
        for (int ai = 0; ai < 2; ++ai)
#pragma unroll
            for (int m = 0; m < 4; ++m) { const int r = row0 + ai * HALF + m * 16; const float rs = row_rstd16(ssq, r);
                f32x4 h0, h1;
#pragma unroll
                for (int i = 0; i < 4; ++i) { h0[i] = silu_mul(acc[ai][0][m][0][i] * rs, acc[ai][1][m][0][i] * rs); h1[i] = silu_mul(acc[ai][0][m][1][i] * rs, acc[ai][1][m][1][i] * rs); }
                *(u32x4*)(H + (size_t)r * 2816 + hcol) = pack8(h0, h1); }
    }
};
struct EpiResid {
    static constexpr bool PERM = true, AFTER_DRAIN = false;
    const float* base; float* out; unsigned char* ws; size_t xb_off; float alpha;
    __device__ __forceinline__ void operator()(const f32x4 (&acc)[2][2][4][2], const Unit& u, int wr, int wc, int fr, int fq) const {
        const int row0 = u.pm * BM + wr * 64 + fr, col0 = u.pn * BM + wc * 32 + 8 * fq; bf16_t* xb = (bf16_t*)(ws + xb_off); float* ssq = (float*)(ws + WS_SSQ);
#pragma unroll
        for (int ai = 0; ai < 2; ++ai)
#pragma unroll
            for (int m = 0; m < 4; ++m) { const int r = row0 + ai * HALF + m * 16; float s = 0.f;
#pragma unroll
                for (int bj = 0; bj < 2; ++bj) { const size_t off = (size_t)r * 1024 + col0 + bj * HALF;
                    const f32x4 b0 = *(const f32x4*)(base + off), b1 = *(const f32x4*)(base + off + 4);
                    const f32x4 v0 = b0 + acc[ai][bj][m][0] * alpha, v1 = b1 + acc[ai][bj][m][1] * alpha;
                    *(f32x4*)(out + off) = v0; *(f32x4*)(out + off + 4) = v1; *(u32x4*)(xb + off) = pack8(v0, v1);
                    s += (v0[0] * v0[0] + v0[1] * v0[1]) + (v0[2] * v0[2] + v0[3] * v0[3]) + (v1[0] * v1[0] + v1[1] * v1[1]) + (v1[2] * v1[2] + v1[3] * v1[3]); }
                s += __shfl_xor(s, 16); s += __shfl_xor(s, 32);
                if (fq == 0) ssq[(size_t)r * 16 + u.pn * 4 + wc] = s; }
    }
};
struct EpiMixIn {
    static constexpr bool PERM = true, AFTER_DRAIN = false;
    unsigned char* ws;
    __device__ __forceinline__ void operator()(const f32x4 (&acc)[2][2][4][2], const Unit& u, int wr, int wc, int fr, int fq) const {
        const int row0 = u.pm * BM + wr * 64 + fr, cw = wc * 32 + 8 * fq; const float* ssq = (const float*)(ws + WS_SSQ);
        bf16_t* PR = (bf16_t*)(ws + AR_PR); bf16_t* MQ = (bf16_t*)(ws + AR_MQ); bf16_t* MK = (bf16_t*)(ws + AR_MK); bf16_t* MVT = (bf16_t*)(ws + AR_MVT);
        f32x4 ks[2][2]; ks[0][0] = (f32x4){0.f, 0.f, 0.f, 0.f}; ks[0][1] = ks[0][0]; ks[1][0] = ks[0][0]; ks[1][1] = ks[0][0];
#pragma unroll
        for (int ai = 0; ai < 2; ++ai)
#pragma unroll
            for (int m = 0; m < 4; ++m) { const int r = row0 + ai * HALF + m * 16; const float rs = row_rstd16(ssq, r);
#pragma unroll
                for (int bj = 0; bj < 2; ++bj) { const int c = cw + bj * HALF;
                    f32x4 v0 = acc[ai][bj][m][0] * rs, v1 = acc[ai][bj][m][1] * rs;
                    if (u.pn < 7) *(u32x4*)(PR + (size_t)r * 1792 + u.pn * 256 + c) = pack8(v0, v1);
                    else if (u.pn < 9) { v0 = v0 * MOBA_QSCALE; v1 = v1 * MOBA_QSCALE; *(u32x4*)(MQ + (size_t)r * 512 + (u.pn - 7) * 256 + c) = pack8(v0, v1); }
                    else if (u.pn < 11) { *(u32x4*)(MK + (size_t)r * 512 + (u.pn - 9) * 256 + c) = pack8(v0, v1); ks[bj][0] += v0; ks[bj][1] += v1; }
                    else { const int cc = (u.pn - 11) * 256 + c, hh = cc >> 6, d = cc & 63, b = r >> 11, t = r & 2047;
                        bf16_t* p = MVT + ((size_t)(b * 8 + hh) * 64 + d) * 2048 + (t & ~15) + pos16(t & 15);
                        const u32x4 w = pack8(v0, v1);
                        p[0] = (bf16_t)(w.x & 0xffffu); p[2048] = (bf16_t)(w.x >> 16); p[2 * 2048] = (bf16_t)(w.y & 0xffffu); p[3 * 2048] = (bf16_t)(w.y >> 16);
                        p[4 * 2048] = (bf16_t)(w.z & 0xffffu); p[5 * 2048] = (bf16_t)(w.z >> 16); p[6 * 2048] = (bf16_t)(w.w & 0xffffu); p[7 * 2048] = (bf16_t)(w.w >> 16); }
                } }
        if (u.pn == 9 || u.pn == 10) {
            float* KMS = (float*)(ws + WS_KMS) + ((size_t)u.pm * 2 + wr) * 512 + (u.pn - 9) * 256 + cw;
#pragma unroll
            for (int bj = 0; bj < 2; ++bj)
#pragma unroll
                for (int n = 0; n < 2; ++n) { f32x4 v = ks[bj][n];
#pragma unroll
                    for (int o = 1; o < 16; o <<= 1) { v[0] += __shfl_xor(v[0], o); v[1] += __shfl_xor(v[1], o); v[2] += __shfl_xor(v[2], o); v[3] += __shfl_xor(v[3], o); }
                    if (fr == 0) *(f32x4*)(KMS + bj * HALF + 4 * n) = v; } }
    }
};
struct EpiXQ {
    static constexpr bool PERM = true, AFTER_DRAIN = false;
    unsigned char* ws;
    __device__ __forceinline__ void operator()(const f32x4 (&acc)[2][2][4][2], const Unit& u, int wr, int wc, int fr, int fq) const {
        const int row0 = u.pm * BM + wr * 64 + fr, col0 = u.pn * BM + wc * 32 + 8 * fq; bf16_t* Q = (bf16_t*)(ws + AR_XQ); const float* ssq = (const float*)(ws + WS_SSQ);
#pragma unroll
        for (int ai = 0; ai < 2; ++ai)
#pragma unroll
            for (int m = 0; m < 4; ++m) { const int r = row0 + ai * HALF + m * 16; const float rs = row_rstd16(ssq, r) * XATT_QSCALE;
#pragma unroll
                for (int bj = 0; bj < 2; ++bj) *(u32x4*)(Q + (size_t)r * 1024 + col0 + bj * HALF) = pack8(acc[ai][bj][m][0] * rs, acc[ai][bj][m][1] * rs); }
    }
};
struct EpiKV {
    static constexpr bool PERM = true, AFTER_DRAIN = false;
    unsigned char* ws;
    __device__ __forceinline__ void operator()(const f32x4 (&acc)[2][2][4][2], const Unit& u, int wr, int wc, int fr, int fq) const {
        const int row0 = u.pm * BM + wr * 64 + fr, cw = wc * 32 + 8 * fq; bf16_t* XK = (bf16_t*)(ws + WS_XK); bf16_t* XVT = (bf16_t*)(ws + WS_XVT); const float* memrs = (const float*)(ws + WS_MEMRS);
#pragma unroll
        for (int ai = 0; ai < 2; ++ai)
#pragma unroll
            for (int m = 0; m < 4; ++m) { const int r = row0 + ai * HALF + m * 16; const float rs = memrs[r];
#pragma unroll
                for (int bj = 0; bj < 2; ++bj) { const int c = cw + bj * HALF;
                    const f32x4 v0 = acc[ai][bj][m][0] * rs, v1 = acc[ai][bj][m][1] * rs;
                    if (u.pn < 4) *(u32x4*)(XK + (size_t)r * 1024 + u.pn * 256 + c) = pack8(v0, v1);
                    else { const int hx = u.pn - 4, b = r >> 8, key = r & 255;
                        bf16_t* p = XVT + ((size_t)(b * 4 + hx) * 256 + c) * 256 + (key & ~15) + pos16(key & 15);
                        const u32x4 w = pack8(v0, v1);
                        p[0] = (bf16_t)(w.x & 0xffffu); p[256] = (bf16_t)(w.x >> 16); p[2 * 256] = (bf16_t)(w.y & 0xffffu); p[3 * 256] = (bf16_t)(w.y >> 16);
                        p[4 * 256] = (bf16_t)(w.z & 0xffffu); p[5 * 256] = (bf16_t)(w.z >> 16); p[6 * 256] = (bf16_t)(w.w & 0xffffu); p[7 * 256] = (bf16_t)(w.w >> 16); }
                } }
    }
};

template <class Epi, class Sched, bool ALIGN_EPI = false, bool SP2 = false>
__device__ __forceinline__ void gemm_phase(PG8_LAS unsigned char* lds, const Gemm g, const Sched& S, const Epi& E) {
    int tid_ = threadIdx.x; asm volatile("" : "+v"(tid_));
    const int tid = tid_, wid = __builtin_amdgcn_readfirstlane(tid >> 6), lane = tid & 63, wr = wid >> 2, wc = wid & 3, fr = lane & 15, fq = lane >> 4;
    const int K = g.K, nt = K / BK;
    unsigned voffA[2], voffB[2];
#pragma unroll
    for (int i = 0; i < 2; ++i) { int R, C; stage_rc(tid * 16 + i * 8192, R, C); const int Rb = Epi::PERM ? ((R & ~31) + perm32(R & 31)) : R;
        voffA[i] = (unsigned)(R * K + C) * 2u; voffB[i] = (unsigned)(Rb * K + C) * 2u; }
    const size_t kstep = (size_t)(BK * 2);
    const size_t hstep = (size_t)HALF * K * 2;
    const size_t tstep = 2 * hstep;
    const unsigned ldsw = (unsigned)wid * 1024u;
    const int aoff = lds_byte(wr * 64 + fr, fq * 8), boff = lds_byte(wc * 32 + fr, fq * 8);
#define PG8_SA(b, h) (((b) * 2 + (h)) * HTB)
#define PG8_SB(b, h) ((4 + (b) * 2 + (h)) * HTB)
#define PG8_STAGE(bufoff, gbase, voff) do { _Pragma("unroll") for (int _i = 0; _i < 2; ++_i) \
        __builtin_amdgcn_global_load_lds((const unsigned*)((const char*)(gbase) + (voff)[_i]), (PG8_LAS unsigned*)(lds + (bufoff) + ldsw + _i * 8192), 16, 0, 0); } while (0)
#define PG8_LDA(dst, b, h) do { _Pragma("unroll") for (int m = 0; m < 4; ++m) _Pragma("unroll") for (int k = 0; k < 2; ++k) dst[m][k] = *(const PG8_LAS bf16x8*)(lds + PG8_SA(b, h) + aoff + m * 2048 + k * 1024); } while (0)
#define PG8_LDB(dst, b, h) do { _Pragma("unroll") for (int n = 0; n < 2; ++n) _Pragma("unroll") for (int k = 0; k < 2; ++k) dst[n][k] = *(const PG8_LAS bf16x8*)(lds + PG8_SB(b, h) + boff + n * 2048 + k * 1024); } while (0)
#define PG8_MMA(ai, bj, At, Bt) do { __builtin_amdgcn_s_setprio(1); _Pragma("unroll") for (int m = 0; m < 4; ++m) _Pragma("unroll") for (int n = 0; n < 2; ++n) _Pragma("unroll") for (int k = 0; k < 2; ++k) \
        acc[ai][bj][m][n] = __builtin_amdgcn_mfma_f32_16x16x32_bf16(Bt[n][k], At[m][k], acc[ai][bj][m][n], 0, 0, 0); __builtin_amdgcn_s_setprio(0); } while (0)
#define PG8_WAIT_V(n) asm volatile("s_waitcnt vmcnt(" #n ")" ::: "memory")
#define PG8_WAIT_L(n) asm volatile("s_waitcnt lgkmcnt(" #n ")" ::: "memory")
#define PG8_BAR __builtin_amdgcn_s_barrier()
#define PG8_SCHED __builtin_amdgcn_sched_barrier(0)
    Unit cur, nxt; int ui = 0;
    if (!S.next(0, cur)) return;
    f32x4 acc[2][2][4][2];
#pragma unroll
    for (int a = 0; a < 2; ++a)
#pragma unroll
        for (int b = 0; b < 2; ++b)
#pragma unroll
            for (int m = 0; m < 4; ++m)
#pragma unroll
                for (int n = 0; n < 2; ++n) acc[a][b][m][n] = (f32x4){0.f, 0.f, 0.f, 0.f};
    bf16x8 At[4][2], B0[2][2], B1[2][2];
    const char* cA = (const char*)g.A + (size_t)cur.pm * tstep; const char* cB = (const char*)g.Bt + (size_t)cur.pn * tstep;
    S.a_ready(cur);
    if constexpr (SP2) {
        PG8_STAGE(PG8_SB(0, 0), cB, voffB); PG8_STAGE(PG8_SB(0, 1), cB + hstep, voffB); PG8_STAGE(PG8_SA(0, 0), cA, voffA); PG8_STAGE(PG8_SA(0, 1), cA + hstep, voffA);
        if (wr == 1) PG8_BAR;
        PG8_WAIT_V(2); PG8_BAR;
        PG8_STAGE(PG8_SB(1, 0), cB + kstep, voffB); PG8_STAGE(PG8_SA(1, 0), cA + kstep, voffA); PG8_STAGE(PG8_SB(1, 1), cB + hstep + kstep, voffB);
        PG8_WAIT_V(6); PG8_BAR;
    } else {
        PG8_STAGE(PG8_SB(0, 0), cB, voffB); PG8_STAGE(PG8_SA(0, 0), cA, voffA); PG8_STAGE(PG8_SB(0, 1), cB + hstep, voffB); PG8_STAGE(PG8_SA(0, 1), cA + hstep, voffA);
        if (wr == 1) PG8_BAR;
        PG8_WAIT_V(4); PG8_BAR;
        PG8_STAGE(PG8_SB(1, 0), cB + kstep, voffB); PG8_STAGE(PG8_SA(1, 0), cA + kstep, voffA); PG8_STAGE(PG8_SB(1, 1), cB + hstep + kstep, voffB);
        PG8_WAIT_V(6); PG8_BAR;
    }
    for (;;) {
        const bool has_next = S.next(ui + 1, nxt);
        const char* nA = has_next ? (const char*)g.A + (size_t)nxt.pm * tstep : cA; const char* nB = has_next ? (const char*)g.Bt + (size_t)nxt.pn * tstep : cB;
        for (int t = 0; t < nt; t += 2) {
            const bool last = (t == nt - 2);
            const char* a1 = cA + (size_t)(t + 1) * kstep;
            const char* a2 = last ? nA : cA + (size_t)(t + 2) * kstep; const char* b2 = last ? nB : cB + (size_t)(t + 2) * kstep;
            const char* a3 = a2 + kstep; const char* b3 = b2 + kstep;
            if (last && has_next) S.a_ready(nxt);
            if constexpr (SP2) {
            PG8_LDB(B0, 0, 0); PG8_LDB(B1, 0, 1); PG8_SCHED; PG8_LDA(At, 0, 0); PG8_STAGE(PG8_SA(1, 1), a1 + hstep, voffA);
            PG8_WAIT_V(8); PG8_WAIT_L(0); PG8_BAR; PG8_MMA(0, 0, At, B0); PG8_MMA(0, 1, At, B1); PG8_BAR; PG8_SCHED;
            PG8_LDA(At, 0, 1); PG8_STAGE(PG8_SB(0, 0), b2, voffB); PG8_STAGE(PG8_SB(0, 1), b2 + hstep, voffB); PG8_STAGE(PG8_SA(0, 0), a2, voffA);
            PG8_WAIT_V(8); PG8_WAIT_L(0); PG8_BAR; PG8_MMA(1, 0, At, B0); PG8_MMA(1, 1, At, B1); PG8_BAR; PG8_SCHED;
            PG8_LDB(B0, 1, 0); PG8_LDB(B1, 1, 1); PG8_SCHED; PG8_LDA(At, 1, 0); PG8_STAGE(PG8_SA(0, 1), a2 + hstep, voffA);
            PG8_WAIT_V(8); PG8_WAIT_L(0); PG8_BAR; PG8_MMA(0, 0, At, B0); PG8_MMA(0, 1, At, B1); PG8_BAR; PG8_SCHED;
            PG8_LDA(At, 1, 1); PG8_STAGE(PG8_SB(1, 0), b3, voffB); PG8_STAGE(PG8_SB(1, 1), b3 + hstep, voffB); PG8_STAGE(PG8_SA(1, 0), a3, voffA);
            PG8_WAIT_V(8); PG8_WAIT_L(0); PG8_BAR; PG8_MMA(1, 0, At, B0); PG8_MMA(1, 1, At, B1); PG8_BAR; PG8_SCHED;
            } else {
            PG8_LDB(B0, 0, 0); PG8_SCHED; PG8_LDA(At, 0, 0); PG8_STAGE(PG8_SA(1, 1), a1 + hstep, voffA);
            PG8_WAIT_L(8); PG8_BAR; PG8_WAIT_L(0); PG8_MMA(0, 0, At, B0); PG8_BAR; PG8_SCHED;
            PG8_LDB(B1, 0, 1); PG8_STAGE(PG8_SB(0, 0), b2, voffB);
            PG8_BAR; PG8_WAIT_L(0); PG8_MMA(0, 1, At, B1); PG8_BAR;
            PG8_LDA(At, 0, 1); PG8_STAGE(PG8_SA(0, 0), a2, voffA);
            PG8_BAR; PG8_WAIT_L(0); PG8_MMA(1, 0, At, B0); PG8_BAR; PG8_SCHED;
            PG8_STAGE(PG8_SB(0, 1), b2 + hstep, voffB);
            PG8_WAIT_V(6); PG8_BAR; PG8_MMA(1, 1, At, B1); PG8_BAR;
            PG8_LDB(B0, 1, 0); PG8_SCHED; PG8_LDA(At, 1, 0); PG8_STAGE(PG8_SA(0, 1), a2 + hstep, voffA);
            PG8_WAIT_L(8); PG8_BAR; PG8_WAIT_L(0); PG8_MMA(0, 0, At, B0); PG8_BAR; PG8_SCHED;
            PG8_LDB(B1, 1, 1); PG8_STAGE(PG8_SB(1, 0), b3, voffB);
            PG8_BAR; PG8_WAIT_L(0); PG8_MMA(0, 1, At, B1); PG8_BAR;
            PG8_LDA(At, 1, 1); PG8_STAGE(PG8_SA(1, 0), a3, voffA);
            PG8_BAR; PG8_WAIT_L(0); PG8_MMA(1, 0, At, B0); PG8_BAR; PG8_SCHED;
            PG8_STAGE(PG8_SB(1, 1), b3 + hstep, voffB);
            PG8_WAIT_V(6); PG8_BAR; PG8_MMA(1, 1, At, B1); PG8_BAR;
            }
        }
        if constexpr (ALIGN_EPI) { if (wr == 0) PG8_BAR; }
        if constexpr (!Epi::AFTER_DRAIN) { E(acc, cur, wr, wc, fr, fq); S.done(cur); }
        if (!has_next) break;
#pragma unroll
        for (int a = 0; a < 2; ++a)
#pragma unroll
            for (int b = 0; b < 2; ++b)
#pragma unroll
                for (int m = 0; m < 4; ++m)
#pragma unroll
                    for (int n = 0; n < 2; ++n) acc[a][b][m][n] = (f32x4){0.f, 0.f, 0.f, 0.f};
        cur = nxt; cA = nA; cB = nB; ++ui;
        if constexpr (ALIGN_EPI) { if (wr == 1) PG8_BAR; }
    }
    PG8_WAIT_V(0);
    if constexpr (!ALIGN_EPI) { if (wr == 0) PG8_BAR; }
    PG8_BAR;
    if constexpr (Epi::AFTER_DRAIN) { E.fused(acc, cur, wr, wc, fr, fq, lds, wid, lane); S.done(cur); }
#undef PG8_SA
#undef PG8_SB
#undef PG8_STAGE
#undef PG8_LDA
#undef PG8_LDB
#undef PG8_MMA
#undef PG8_WAIT_V
#undef PG8_WAIT_L
#undef PG8_BAR
#undef PG8_SCHED
}
}

constexpr int NWAVES = 8;
constexpr int LDS_BYTES = 163840, LDSCTL_OFF = LDS_BYTES - 512, MISC_OFF = LDSCTL_OFF + 320, PHASE_LDS = LDSCTL_OFF;
constexpr int SCAN_R = 2, SCAN_NCH = 8;

typedef unsigned short bf16;
typedef unsigned u32x4 __attribute__((ext_vector_type(4)));
typedef unsigned u32x2 __attribute__((ext_vector_type(2)));
typedef float f32x4 __attribute__((ext_vector_type(4)));
typedef float f32x16 __attribute__((ext_vector_type(16)));
typedef short bf16x8 __attribute__((ext_vector_type(8)));
typedef GAS unsigned gu32;
#define RLX_AGENT __ATOMIC_RELAXED, __HIP_MEMORY_SCOPE_AGENT
#define LDS_WAIT() asm volatile("s_waitcnt lgkmcnt(0)" ::: "memory")
#define VM_WAIT() asm volatile("s_waitcnt vmcnt(0)" ::: "memory")
__device__ __forceinline__ float bf2f(unsigned b) { return __uint_as_float(b << 16); }
__device__ __forceinline__ unsigned f2bf(float f) { unsigned u = __builtin_bit_cast(unsigned, f); return (u + 0x7fffu + ((u >> 16) & 1u)) >> 16; }
__device__ __forceinline__ unsigned pk2(float lo, float hi) { return pg8::cvt_pk_bf16(lo, hi); }
__device__ __forceinline__ float wave_sum(float v) {
#pragma unroll
    for (int o = 1; o < 64; o <<= 1) v += __shfl_xor(v, o);
    return v;
}
#define WS8_STEP(o) _Pragma("unroll") for (int q = 0; q < 8; ++q) v[q] += __shfl_xor(v[q], o);
__device__ __forceinline__ void wave_sum8(float (&v)[8]) { WS8_STEP(1) WS8_STEP(2) WS8_STEP(4) WS8_STEP(8) WS8_STEP(16) WS8_STEP(32) }
__device__ __forceinline__ float quad_sum(float x) {
    x += __builtin_bit_cast(float, __builtin_amdgcn_update_dpp(0, __builtin_bit_cast(int, x), 0xB1, 0xF, 0xF, true));
    x += __builtin_bit_cast(float, __builtin_amdgcn_update_dpp(0, __builtin_bit_cast(int, x), 0x4E, 0xF, 0xF, true));
    return x;
}
__device__ __forceinline__ float sigmoidf_(float x) { return __builtin_amdgcn_rcpf(1.0f + __expf(-x)); }
__device__ __forceinline__ int crow(int r, int hi) { return (r & 3) + 8 * (r >> 2) + 4 * hi; }
__device__ __forceinline__ bf16x8 pack_bf16x8(float a0, float a1, float a2, float a3, float a4, float a5, float a6, float a7) {
    u32x4 w; w.x = pk2(a0, a1); w.y = pk2(a2, a3); w.z = pk2(a4, a5); w.w = pk2(a6, a7); return __builtin_bit_cast(bf16x8, w);
}

#define XB_TMO      128
#define XB_XCNT(j)  (256  + 64 * (j))
#define XB_XSUB(j)  (1280 + 64 * (j))
#define XB_XGEN(j)  (2304 + 64 * (j))
#define XB_TOP      3328
#define XB_TOPGEN   3392
#define XCD_BAR_WORDS 3456
#define XB_SPIN_CAP (1u << 18)

__device__ __forceinline__ unsigned xb_ld(unsigned* p)              { return __hip_atomic_load(p, __ATOMIC_RELAXED, __HIP_MEMORY_SCOPE_AGENT); }
__device__ __forceinline__ unsigned xb_add(unsigned* p, unsigned v) { return __hip_atomic_fetch_add(p, v, __ATOMIC_RELAXED, __HIP_MEMORY_SCOPE_AGENT); }
__device__ __forceinline__ unsigned xb_xcc_id() { return (unsigned)__builtin_amdgcn_s_getreg((3 << 11) | 20) & 0xFu; }
#define XB_SPIN(cond, bar) do { unsigned _sp = 0; while (cond) { __builtin_amdgcn_s_sleep(1); \
    if ((++_sp & 255u) == 0u) { if (xb_ld(&(bar)[XB_TMO])) break; if (_sp > XB_SPIN_CAP) { atomicAdd(&(bar)[XB_TMO], 1u); break; } } } } while (0)

struct XcdBarrier {
    unsigned* bar; unsigned x;
    volatile LAS unsigned* st;
};

__device__ __forceinline__ XcdBarrier xcd_barrier_post(unsigned* bar, volatile LAS unsigned* st) {
    XcdBarrier b; b.bar = bar; b.x = xb_xcc_id(); b.st = st;
    if (threadIdx.x == 0) (void)xb_add(&bar[XB_XCNT(b.x)], 1u);
    return b;
}
__device__ __forceinline__ void xcd_barrier_complete(unsigned* bar, unsigned x, unsigned& nloc, unsigned& nx) {
    const unsigned G = gridDim.x * gridDim.y * gridDim.z;
    unsigned sum, cnt, mine, sp = 0u;
    for (;;) {
        sum = 0u; cnt = 0u; mine = 0u;
#pragma unroll
        for (unsigned j = 0; j < 16; ++j) { const unsigned c = xb_ld(&bar[XB_XCNT(j)]); sum += c; cnt += (c > 0u) ? 1u : 0u; mine = (j == x) ? c : mine; }
        if (sum == G) break;
        __builtin_amdgcn_s_sleep(1);
        if ((++sp & 255u) == 0u) { if (xb_ld(&bar[XB_TMO])) break; if (sp > XB_SPIN_CAP) { atomicAdd(&bar[XB_TMO], 1u); break; } }
    }
    nloc = mine > 0u ? mine : 1u; nx = cnt > 0u ? cnt : 1u;
}

__device__ __forceinline__ void xcd_barrier(const XcdBarrier& b) {
    asm volatile("s_waitcnt vmcnt(0)" ::: "memory");
    __syncthreads();
    if (threadIdx.x == 0) {
        unsigned* bar = b.bar;
        __builtin_amdgcn_s_waitcnt(0);
        unsigned nloc = b.st[0], nx = b.st[1];
        if (nloc == 0u) { xcd_barrier_complete(bar, b.x, nloc, nx); b.st[0] = nloc; b.st[1] = nx; }
        const unsigned old = xb_add(&bar[XB_XSUB(b.x)], 1u);
        const unsigned gen = old / nloc;
        if (old + 1u == (gen + 1u) * nloc) {
            __builtin_amdgcn_fence(__ATOMIC_RELEASE, "agent");
            asm volatile("s_waitcnt vmcnt(0)" ::: "memory");
            const unsigned og = xb_add(&bar[XB_TOP], 1u);
            const unsigned tg = og / nx;
            if (og + 1u == (tg + 1u) * nx) xb_add(&bar[XB_TOPGEN], 1u);
            else XB_SPIN(xb_ld(&bar[XB_TOPGEN]) == tg, bar);
            __builtin_amdgcn_fence(__ATOMIC_ACQUIRE, "agent");
            xb_add(&bar[XB_XGEN(b.x)], 1u);
            asm volatile("s_waitcnt vmcnt(0)" ::: "memory");
        } else {
            XB_SPIN(xb_ld(&bar[XB_XGEN(b.x)]) == gen, bar);
            __builtin_amdgcn_fence(__ATOMIC_ACQUIRE, "agent");
            asm volatile("s_waitcnt vmcnt(0)" ::: "memory");
        }
    }
    __syncthreads();
}


struct Args { const float* in[N_IN]; float* out; unsigned char* ws; int ph_lo, ph_hi; };
static_assert(sizeof(Args) == N_IN * 8 + 24, "Args has no padding");
struct Frame {
    LAS unsigned char* lds; volatile LAS unsigned* MISC; gu32* ctl;
    int tid, lane, wave, vcu, G;
    const __attribute__((address_space(4))) struct Args* ka; float* out; unsigned char* ws;
};
#define FIN(i) (F.ka->in[i])
#define PHASE_IDS() do { int t_ = threadIdx.x; asm volatile("" : "+v"(t_)); F.tid = t_; F.lane = t_ & 63; F.wave = __builtin_amdgcn_readfirstlane(t_ >> 6); } while (0)
#define WSP(T, off) ((T*)(F.ws + (off)))

__device__ __forceinline__ void ph_init(Frame& F) {
    PHASE_IDS();
    const int gw = F.vcu * NWAVES + F.wave, NGW = F.G * NWAVES;
    float* bias = WSP(float, WS_BIAS); const float* relb = FIN(I_RELB);
    for (int i = blockIdx.x * 512 + F.tid; i < NH * 2048; i += F.G * 512) { const int h = i >> 11, n = i & 2047; int bkt;
        if (n < 16) bkt = n; else { const float nf = (float)n; const int lg = 16 + (int)(logf(nf / 16.0f) / 4.1588830833596715f * 16.0f); bkt = lg < 31 ? lg : 31; }
        bias[i] = relb[h * 32 + bkt] * LOG2E; }
    const float* mem = FIN(I_MEM); bf16* memb = WSP(bf16, WS_MEMB); float* memrs = WSP(float, WS_MEMRS);
    for (int r = gw; r < MM; r += NGW) { const f32x4* xr = (const f32x4*)(mem + (size_t)r * DM) + F.lane; f32x4 v[4]; float s = 0.f;
#pragma unroll
        for (int j = 0; j < 4; ++j) { v[j] = xr[64 * j]; s += (v[j].x * v[j].x + v[j].y * v[j].y) + (v[j].z * v[j].z + v[j].w * v[j].w); }
        s = wave_sum(s); u32x2* o = (u32x2*)(memb + (size_t)r * DM) + F.lane;
#pragma unroll
        for (int j = 0; j < 4; ++j) { u32x2 w; w.x = pk2(v[j].x, v[j].y); w.y = pk2(v[j].z, v[j].w); o[64 * j] = w; }
        if (F.lane == 0) memrs[r] = __builtin_amdgcn_rsqf(s * (1.0f / DM) + NORM_EPS); }
    const float* x = FIN(I_X); bf16* xb = WSP(bf16, WS_XB); float* ssq = WSP(float, WS_SSQ);
    for (int r = gw; r < M; r += NGW) { const f32x4* xr = (const f32x4*)(x + (size_t)r * DM) + F.lane; f32x4 v[4]; float s = 0.f;
#pragma unroll
        for (int j = 0; j < 4; ++j) { v[j] = xr[64 * j]; s += (v[j].x * v[j].x + v[j].y * v[j].y) + (v[j].z * v[j].z + v[j].w * v[j].w); }
        s = wave_sum(s); u32x2* o = (u32x2*)(xb + (size_t)r * DM) + F.lane;
#pragma unroll
        for (int j = 0; j < 4; ++j) { u32x2 w; w.x = pk2(v[j].x, v[j].y); w.y = pk2(v[j].z, v[j].w); o[64 * j] = w; }
        if (F.lane < 16) ssq[(size_t)r * 16 + F.lane] = F.lane == 0 ? s : 0.f; }
}

__device__ __forceinline__ void conv_item(const float* W, int K, int N, const float* gk, bf16* WT, int item, bool ffn_in, LAS float* scr, int lane) {
    const int nblk = N / 32, kb = item / nblk, nb = item % nblk, k0 = 64 * kb, n0 = 32 * nb;
#pragma unroll 8
    for (int i = 0; i < 32; ++i) { const int kk = 2 * i + (lane >> 5); float w = W[(size_t)(k0 + kk) * N + n0 + (lane & 31)]; if (gk) w *= gk[k0 + kk]; scr[kk * 33 + (lane & 31)] = w; }
    LDS_WAIT(); asm volatile("" ::: "memory");
    int drow0 = n0; if (ffn_in) drow0 = n0 < DFF ? 256 * (n0 / 128) + (n0 % 128) : 256 * ((n0 - DFF) / 128) + 128 + ((n0 - DFF) % 128);
    const int c = lane & 7;
#pragma unroll
    for (int j = 0; j < 4; ++j) { const int n = (lane >> 3) + 8 * j; const LAS float* s = scr + (8 * c) * 33 + n;
        u32x4 o; o.x = pk2(s[0 * 33], s[1 * 33]); o.y = pk2(s[2 * 33], s[3 * 33]); o.z = pk2(s[4 * 33], s[5 * 33]); o.w = pk2(s[6 * 33], s[7 * 33]);
        *(u32x4*)(WT + (size_t)(drow0 + n) * K + k0 + 8 * c) = o; }
    LDS_WAIT(); asm volatile("" ::: "memory");
}
__device__ __forceinline__ void ph_conv(Frame& F, int l) {
    PHASE_IDS();
    LAS float* scr = (LAS float*)(F.lds + F.wave * 16384);
    const int gw = F.vcu * NWAVES + F.wave, NGW = F.G * NWAVES;
    constexpr int I_FIN = (DM / 64) * (2 * DFF / 32), I_FOUT = (DFF / 64) * (DM / 32), I_MI = (DM / 64) * (DPROJ / 32), I_SQ = (DM / 64) * (DM / 32), I_KV = (DM / 64) * (2 * DM / 32);
    constexpr int I_L64 = (64 / 64) * (RW / 32), I_L128 = (128 / 64) * (RW / 32);
    constexpr int NITEMS = 2 * I_FIN + 2 * I_FOUT + I_MI + 3 * I_SQ + I_KV + 2 * I_L64 + I_L128;
    unsigned char* wb = F.ws + WS_W;
    for (int it = gw; it < NITEMS; it += NGW) { int r = it;
        if (r < I_FIN) { conv_item(FIN(I_F1IN) + (size_t)l * DM * 2 * DFF, DM, 2 * DFF, FIN(I_F1G) + l * DM, (bf16*)(wb + W_F1IN), r, true, scr, F.lane); continue; } r -= I_FIN;
        if (r < I_FIN) { conv_item(FIN(I_F2IN) + (size_t)l * DM * 2 * DFF, DM, 2 * DFF, FIN(I_F2G) + l * DM, (bf16*)(wb + W_F2IN), r, true, scr, F.lane); continue; } r -= I_FIN;
        if (r < I_FOUT) { conv_item(FIN(I_F1OUT) + (size_t)l * DFF * DM, DFF, DM, nullptr, (bf16*)(wb + W_F1OUT), r, false, scr, F.lane); continue; } r -= I_FOUT;
        if (r < I_FOUT) { conv_item(FIN(I_F2OUT) + (size_t)l * DFF * DM, DFF, DM, nullptr, (bf16*)(wb + W_F2OUT), r, false, scr, F.lane); continue; } r -= I_FOUT;
        if (r < I_MI) { conv_item(FIN(I_MIXIN) + (size_t)l * DM * DPROJ, DM, DPROJ, FIN(I_MIXG) + l * DM, (bf16*)(wb + W_MIXIN), r, false, scr, F.lane); continue; } r -= I_MI;
        if (r < I_SQ) { conv_item(FIN(I_MIXOUT) + (size_t)l * DM * DM, DM, DM, nullptr, (bf16*)(wb + W_MIXOUT), r, false, scr, F.lane); continue; } r -= I_SQ;
        if (r < I_SQ) { conv_item(FIN(I_WQ) + (size_t)l * DM * DM, DM, DM, FIN(I_XG) + l * DM, (bf16*)(wb + W_WQ), r, false, scr, F.lane); continue; } r -= I_SQ;
        if (r < I_SQ) { conv_item(FIN(I_WO) + (size_t)l * DM * DM, DM, DM, nullptr, (bf16*)(wb + W_WO), r, false, scr, F.lane); continue; } r -= I_SQ;
        if (r < I_KV) { conv_item(FIN(I_WKV) + (size_t)l * DM * 2 * DM, DM, 2 * DM, FIN(I_MEMG) + l * DM, (bf16*)(wb + W_WKV), r, false, scr, F.lane); continue; } r -= I_KV;
        if (r < I_L64) { conv_item(FIN(I_WUP) + (size_t)l * 64 * RW, 64, RW, nullptr, (bf16*)(wb + W_WUPT), r, false, scr, F.lane); continue; } r -= I_L64;
        if (r < I_L64) { conv_item(FIN(I_AUP) + (size_t)l * 64 * RW, 64, RW, nullptr, (bf16*)(wb + W_AUPT), r, false, scr, F.lane); continue; } r -= I_L64;
        conv_item(FIN(I_GUP) + (size_t)l * 128 * RW, 128, RW, nullptr, (bf16*)(wb + W_GUPT), r, false, scr, F.lane);
    }
}

__device__ __forceinline__ void ph_moba(Frame& F) {
    PHASE_IDS();
    constexpr int KROW = 144, KBUF = 64 * KROW, OFF_K = 12288, OFF_V = OFF_K + 2 * KBUF;
    LAS float* kmean = (LAS float*)F.lds;
    LAS float* btab = (LAS float*)(F.lds + 2048);
    volatile LAS unsigned* needw = (volatile LAS unsigned*)(F.lds + 10240);
    const bf16* MQ = WSP(bf16, AR_MQ); const bf16* MK = WSP(bf16, AR_MK); const bf16* MVT = WSP(bf16, AR_MVT); bf16* XB = WSP(bf16, WS_XB); const float* bias = WSP(float, WS_BIAS);
    const int lane = F.lane, r32 = lane & 31, hi = lane >> 5, wave = F.wave, tid = F.tid;
    for (int u = blockIdx.x; u < 512; u += F.G) {
        const int rnd = u >> 8, iu = u & 255, qsel = iu >> 6, bh = iu & 63, qb = rnd == 0 ? 7 - qsel : qsel, b = bh >> 3, hh = bh & 7;
        __syncthreads();
        { const int n = tid >> 6, d = tid & 63;
          if (n < qb) { const float* kp = WSP(float, WS_KMS) + ((size_t)(b * 8 + n) * 2) * 512 + hh * 64 + d; kmean[n * 64 + d] = (kp[0] + kp[512]) * (1.0f / 256.0f); }
          for (int i2 = tid; i2 < 2048; i2 += 512) btab[i2] = bias[hh * 2048 + i2];
          if (tid == 0) needw[0] = 0u; }
        __syncthreads();
        const int q0 = qb * 256 + wave * 32; const size_t tok = (size_t)b * 2048 + q0 + r32;
        bf16x8 qf[4];
#pragma unroll
        for (int s = 0; s < 4; ++s) qf[s] = *(const bf16x8*)(MQ + tok * 512 + hh * 64 + 16 * s + 8 * hi);
        float g[7]; unsigned selmask = 0u;
#pragma unroll
        for (int n = 0; n < 7; ++n) { g[n] = -INFINITY;
            if (n < qb) { float p = 0.f;
#pragma unroll
                for (int s = 0; s < 4; ++s) { const f32x4 k0v = *(const LAS f32x4*)(kmean + n * 64 + 16 * s + 8 * hi), k1v = *(const LAS f32x4*)(kmean + n * 64 + 16 * s + 8 * hi + 4);
                    p += bf2f((unsigned short)qf[s][0]) * k0v[0] + bf2f((unsigned short)qf[s][1]) * k0v[1] + bf2f((unsigned short)qf[s][2]) * k0v[2] + bf2f((unsigned short)qf[s][3]) * k0v[3]
                       + bf2f((unsigned short)qf[s][4]) * k1v[0] + bf2f((unsigned short)qf[s][5]) * k1v[1] + bf2f((unsigned short)qf[s][6]) * k1v[2] + bf2f((unsigned short)qf[s][7]) * k1v[3]; }
                p += __shfl_xor(p, 32); g[n] = p; } }
        if (qb <= 3) selmask = (1u << qb) - 1u;
        else {
#pragma unroll
            for (int n = 0; n < 7; ++n) if (n < qb) { int cnt = 0;
#pragma unroll
                for (int n2 = 0; n2 < 7; ++n2) if (n2 != n && n2 < qb) cnt += (g[n2] > g[n] || (g[n2] == g[n] && n2 < n)) ? 1 : 0;
                if (cnt < 3) selmask |= 1u << n; } }
        unsigned wmask = 0u;
#pragma unroll
        for (int n = 0; n < 7; ++n) if (__ballot((selmask >> n) & 1u) != 0ull) wmask |= 1u << n;
        if (lane == 0 && wmask) __hip_atomic_fetch_or((LAS unsigned*)needw, wmask, __ATOMIC_RELAXED, __HIP_MEMORY_SCOPE_WORKGROUP);
        __syncthreads();
        const unsigned need = needw[0] | (1u << qb);
        float mrun = -INFINITY, lrun = 0.f; f32x16 o0, o1;
#pragma unroll
        for (int i = 0; i < 16; ++i) { o0[i] = 0.f; o1[i] = 0.f; }
        const int qpos = q0 + r32;
        const bf16* Kg = MK + ((size_t)b * 2048 + (tid >> 3)) * 512 + hh * 64 + (tid & 7) * 8;
        const bf16* Vg = MVT + ((size_t)(b * 8 + hh) * 64 + (tid >> 3)) * 2048 + (tid & 7) * 8;
        const int sto = (tid >> 3) * KROW + (tid & 7) * 16;
        int blk = 0; while (!((need >> blk) & 1u)) ++blk;
        int kt = 0, it = 0;
        { const int k0 = blk * 256; const u32x4 kr = *(const u32x4*)(Kg + (size_t)k0 * 512), vr = *(const u32x4*)(Vg + k0);
          *(LAS u32x4*)(F.lds + OFF_K + sto) = kr; *(LAS u32x4*)(F.lds + OFF_V + sto) = vr; }
        __syncthreads();
        while (blk <= qb) {
            int nblk = blk, nkt = kt + 1; if (nkt == 4) { nkt = 0; ++nblk; while (nblk <= qb && !((need >> nblk) & 1u)) ++nblk; }
            const bool more = nblk <= qb; u32x4 kr, vr;
            if (more) { const int k0n = nblk * 256 + nkt * 64; kr = *(const u32x4*)(Kg + (size_t)k0n * 512); vr = *(const u32x4*)(Vg + k0n); }
            const int k0 = blk * 256 + kt * 64; const bool own = blk == qb; const bool selme = own || ((selmask >> blk) & 1u);
            const bool active = own ? (k0 <= q0 + 31) : (__ballot(selme) != 0ull);
            if (active) {
                const LAS unsigned char* kb = F.lds + OFF_K + (it & 1) * KBUF + r32 * KROW + 16 * hi;
                const LAS unsigned char* vb = F.lds + OFF_V + (it & 1) * KBUF + r32 * KROW + 16 * hi;
                const bool h1 = !own || (k0 + 32 <= q0 + 31);
                f32x16 s0, s1;
#pragma unroll
                for (int i = 0; i < 16; ++i) { s0[i] = 0.f; s1[i] = 0.f; }
#pragma unroll
                for (int s = 0; s < 4; ++s) s0 = __builtin_amdgcn_mfma_f32_32x32x16_bf16(*(const LAS bf16x8*)(kb + 32 * s), qf[s], s0, 0, 0, 0);
                if (h1) {
#pragma unroll
                    for (int s = 0; s < 4; ++s) s1 = __builtin_amdgcn_mfma_f32_32x32x16_bf16(*(const LAS bf16x8*)(kb + 32 * KROW + 32 * s), qf[s], s1, 0, 0, 0); }
                float mx = -INFINITY;
                float bv0[16], bv1[16];
#pragma unroll
                for (int r = 0; r < 16; ++r) { const int d0 = qpos - (k0 + crow(r, hi)), d1 = d0 - 32; bv0[r] = btab[d0 < 0 ? 0 : d0]; bv1[r] = btab[d1 < 0 ? 0 : d1]; }
#pragma unroll
                for (int r = 0; r < 16; ++r) asm volatile("" : "+v"(bv0[r]), "+v"(bv1[r]));
#pragma unroll
                for (int r = 0; r < 16; ++r) { const int d0 = qpos - (k0 + crow(r, hi)), d1 = d0 - 32;
                    const bool v0 = selme && (!own || d0 >= 0), v1 = h1 && selme && (!own || d1 >= 0);
                    const float a0 = v0 ? s0[r] + bv0[r] : -INFINITY, a1 = v1 ? s1[r] + bv1[r] : -INFINITY;
                    s0[r] = a0; s1[r] = a1; mx = fmaxf(mx, fmaxf(a0, a1)); }
                mx = fmaxf(mx, __shfl_xor(mx, 32));
                const float mnew = fmaxf(mrun, mx), muse = (mnew == -INFINITY) ? 0.f : mnew;
                const float alpha = __builtin_amdgcn_exp2f(mrun - muse);
                float ps = 0.f;
#pragma unroll
                for (int r = 0; r < 16; ++r) { const float p0 = __builtin_amdgcn_exp2f(s0[r] - muse), p1 = __builtin_amdgcn_exp2f(s1[r] - muse); s0[r] = p0; s1[r] = p1; ps += p0 + p1; }
                lrun = lrun * alpha + ps; mrun = mnew;
#pragma unroll
                for (int i = 0; i < 16; ++i) { o0[i] *= alpha; o1[i] *= alpha; }
                const bf16x8 pa0 = pack_bf16x8(s0[0], s0[1], s0[2], s0[3], s0[4], s0[5], s0[6], s0[7]), pa1 = pack_bf16x8(s0[8], s0[9], s0[10], s0[11], s0[12], s0[13], s0[14], s0[15]);
                o0 = __builtin_amdgcn_mfma_f32_32x32x16_bf16(*(const LAS bf16x8*)(vb), pa0, o0, 0, 0, 0); o0 = __builtin_amdgcn_mfma_f32_32x32x16_bf16(*(const LAS bf16x8*)(vb + 32), pa1, o0, 0, 0, 0);
                o1 = __builtin_amdgcn_mfma_f32_32x32x16_bf16(*(const LAS bf16x8*)(vb + 32 * KROW), pa0, o1, 0, 0, 0); o1 = __builtin_amdgcn_mfma_f32_32x32x16_bf16(*(const LAS bf16x8*)(vb + 32 * KROW + 32), pa1, o1, 0, 0, 0);
                if (h1) {
                    const bf16x8 pb0 = pack_bf16x8(s1[0], s1[1], s1[2], s1[3], s1[4], s1[5], s1[6], s1[7]), pb1 = pack_bf16x8(s1[8], s1[9], s1[10], s1[11], s1[12], s1[13], s1[14], s1[15]);
                    o0 = __builtin_amdgcn_mfma_f32_32x32x16_bf16(*(const LAS bf16x8*)(vb + 64), pb0, o0, 0, 0, 0); o0 = __builtin_amdgcn_mfma_f32_32x32x16_bf16(*(const LAS bf16x8*)(vb + 96), pb1, o0, 0, 0, 0);
                    o1 = __builtin_amdgcn_mfma_f32_32x32x16_bf16(*(const LAS bf16x8*)(vb + 32 * KROW + 64), pb0, o1, 0, 0, 0); o1 = __builtin_amdgcn_mfma_f32_32x32x16_bf16(*(const LAS bf16x8*)(vb + 32 * KROW + 96), pb1, o1, 0, 0, 0); }
            }
            if (more) { *(LAS u32x4*)(F.lds + OFF_K + ((it + 1) & 1) * KBUF + sto) = kr; *(LAS u32x4*)(F.lds + OFF_V + ((it + 1) & 1) * KBUF + sto) = vr; }
            __syncthreads();
            blk = nblk; kt = nkt; ++it;
        }
        lrun += __shfl_xor(lrun, 32); const float inv = 1.0f / lrun;
        bf16* op = XB + tok * 1024 + 512 + hh * 64 + 4 * hi;
#pragma unroll
        for (int g4 = 0; g4 < 4; ++g4) { u32x2 w0, w1; w0.x = pk2(o0[4 * g4] * inv, o0[4 * g4 + 1] * inv); w0.y = pk2(o0[4 * g4 + 2] * inv, o0[4 * g4 + 3] * inv);
            w1.x = pk2(o1[4 * g4] * inv, o1[4 * g4 + 1] * inv); w1.y = pk2(o1[4 * g4 + 2] * inv, o1[4 * g4 + 3] * inv);
            *(u32x2*)(op + 8 * g4) = w0; *(u32x2*)(op + 32 + 8 * g4) = w1; }
    }
}

__device__ __forceinline__ void ph_xatt(Frame& F) {
    PHASE_IDS();
    constexpr int KROW = 528, KBUF = 32 * KROW, VROW = 80, VBUF = 256 * VROW, OFF_K = 0, OFF_V = 2 * KBUF;
    const bf16* XQ = WSP(bf16, AR_XQ); const bf16* XK = WSP(bf16, WS_XK); const bf16* XVT = WSP(bf16, WS_XVT); bf16* XO = WSP(bf16, AR_XO);
    const int lane = F.lane, r32 = lane & 31, hi = lane >> 5, wave = F.wave, tid = F.tid;
    for (int u = blockIdx.x; u < 256; u += F.G) {
        const int b = u >> 5, hx = (u >> 3) & 3, qt = u & 7;
        const size_t tok = (size_t)b * 2048 + qt * 256 + wave * 32 + r32;
        const bf16* Qg = XQ + tok * 1024 + hx * 256 + 8 * hi;
        const bf16* Kg = XK + (size_t)(b * 256 + (tid >> 5)) * 1024 + hx * 256 + (tid & 31) * 8;
        const bf16* Vg = XVT + ((size_t)(b * 4 + hx) * 256 + (tid >> 2)) * 256 + (tid & 3) * 8;
        const int ksto = (tid >> 5) * KROW + (tid & 31) * 16, vsto = (tid >> 2) * VROW + (tid & 3) * 16;
        float mrun = -INFINITY, lrun = 0.f; f32x16 o[8];
#pragma unroll
        for (int dt = 0; dt < 8; ++dt)
#pragma unroll
            for (int i = 0; i < 16; ++i) o[dt][i] = 0.f;
        __syncthreads();
        { const u32x4 k0r = *(const u32x4*)(Kg), k1r = *(const u32x4*)(Kg + (size_t)16 * 1024), v0r = *(const u32x4*)(Vg), v1r = *(const u32x4*)(Vg + (size_t)128 * 256);
          *(LAS u32x4*)(F.lds + OFF_K + ksto) = k0r; *(LAS u32x4*)(F.lds + OFF_K + ksto + 16 * KROW) = k1r; *(LAS u32x4*)(F.lds + OFF_V + vsto) = v0r; *(LAS u32x4*)(F.lds + OFF_V + vsto + 128 * VROW) = v1r; }
        __syncthreads();
        for (int kt = 0; kt < 8; ++kt) {
            const bool more = kt + 1 < 8; const int k0n = (kt + 1) * 32; u32x4 s0r, s1r;
            if (more) { s0r = *(const u32x4*)(Kg + (size_t)k0n * 1024); s1r = *(const u32x4*)(Kg + (size_t)(k0n + 16) * 1024); }
            const LAS unsigned char* kb = F.lds + OFF_K + (kt & 1) * KBUF + r32 * KROW + 16 * hi;
            const LAS unsigned char* vb = F.lds + OFF_V + (kt & 1) * VBUF + r32 * VROW + 16 * hi;
            f32x16 sc;
#pragma unroll
            for (int i = 0; i < 16; ++i) sc[i] = 0.f;
            bf16x8 qa[4], qb[4];
#pragma unroll
            for (int s = 0; s < 4; ++s) qa[s] = *(const bf16x8*)(Qg + 16 * s);
#pragma unroll
            for (int s = 0; s < 4; ++s) qb[s] = *(const bf16x8*)(Qg + 64 + 16 * s);
#pragma unroll
            for (int s = 0; s < 4; ++s) sc = __builtin_amdgcn_mfma_f32_32x32x16_bf16(*(const LAS bf16x8*)(kb + 32 * s), qa[s], sc, 0, 0, 0);
            asm volatile("" ::: "memory");
#pragma unroll
            for (int s = 0; s < 4; ++s) qa[s] = *(const bf16x8*)(Qg + 128 + 16 * s);
#pragma unroll
            for (int s = 0; s < 4; ++s) sc = __builtin_amdgcn_mfma_f32_32x32x16_bf16(*(const LAS bf16x8*)(kb + 128 + 32 * s), qb[s], sc, 0, 0, 0);
            asm volatile("" ::: "memory");
#pragma unroll
            for (int s = 0; s < 4; ++s) qb[s] = *(const bf16x8*)(Qg + 192 + 16 * s);
#pragma unroll
            for (int s = 0; s < 4; ++s) sc = __builtin_amdgcn_mfma_f32_32x32x16_bf16(*(const LAS bf16x8*)(kb + 256 + 32 * s), qa[s], sc, 0, 0, 0);
            asm volatile("" ::: "memory");
#pragma unroll
            for (int s = 0; s < 4; ++s) sc = __builtin_amdgcn_mfma_f32_32x32x16_bf16(*(const LAS bf16x8*)(kb + 384 + 32 * s), qb[s], sc, 0, 0, 0);
            if (more) { LAS unsigned char* kd = F.lds + OFF_K + ((kt + 1) & 1) * KBUF + ksto; *(LAS u32x4*)(kd) = s0r; *(LAS u32x4*)(kd + 16 * KROW) = s1r;
                s0r = *(const u32x4*)(Vg + k0n); s1r = *(const u32x4*)(Vg + (size_t)128 * 256 + k0n); }
            float mx = sc[0];
#pragma unroll
            for (int r = 1; r < 16; ++r) mx = fmaxf(mx, sc[r]);
            mx = fmaxf(mx, __shfl_xor(mx, 32));
            const float mnew = fmaxf(mrun, mx), alpha = __builtin_amdgcn_exp2f(mrun - mnew);
            float ps = 0.f;
#pragma unroll
            for (int r = 0; r < 16; ++r) { const float p = __builtin_amdgcn_exp2f(sc[r] - mnew); sc[r] = p; ps += p; }
            lrun = lrun * alpha + ps; mrun = mnew;
            const bf16x8 pf0 = pack_bf16x8(sc[0], sc[1], sc[2], sc[3], sc[4], sc[5], sc[6], sc[7]), pf1 = pack_bf16x8(sc[8], sc[9], sc[10], sc[11], sc[12], sc[13], sc[14], sc[15]);
#pragma unroll
            for (int dt = 0; dt < 8; ++dt) {
#pragma unroll
                for (int i = 0; i < 16; ++i) o[dt][i] *= alpha;
                o[dt] = __builtin_amdgcn_mfma_f32_32x32x16_bf16(*(const LAS bf16x8*)(vb + dt * 32 * VROW), pf0, o[dt], 0, 0, 0);
                o[dt] = __builtin_amdgcn_mfma_f32_32x32x16_bf16(*(const LAS bf16x8*)(vb + dt * 32 * VROW + 32), pf1, o[dt], 0, 0, 0); }
            if (more) { LAS unsigned char* vd = F.lds + OFF_V + ((kt + 1) & 1) * VBUF + vsto; *(LAS u32x4*)(vd) = s0r; *(LAS u32x4*)(vd + 128 * VROW) = s1r; }
            __syncthreads();
        }
        lrun += __shfl_xor(lrun, 32); const float inv = 1.0f / lrun;
        bf16* op = XO + tok * 1024 + hx * 256 + 4 * hi;
#pragma unroll
        for (int dt = 0; dt < 8; ++dt)
#pragma unroll
            for (int g4 = 0; g4 < 4; ++g4) { u32x2 w; w.x = pk2(o[dt][4 * g4] * inv, o[dt][4 * g4 + 1] * inv); w.y = pk2(o[dt][4 * g4 + 2] * inv, o[dt][4 * g4 + 3] * inv);
                *(u32x2*)(op + 32 * dt + 8 * g4) = w; }
    }
}

__device__ __forceinline__ void ph_prep(Frame& F, int l) {
    PHASE_IDS();
    constexpr int SROW = 3080, OFF_LAT = 33 * SROW + 8, LROW = 528, OFF_PAR = OFF_LAT + 32 * LROW;
    static_assert(OFF_LAT % 16 == 0 && OFF_PAR % 16 == 0 && OFF_PAR + 8 * 512 * 4 <= PHASE_LDS, "prep LDS map");
    LAS unsigned char* rows = F.lds; LAS unsigned char* lat = F.lds + OFF_LAT; LAS float* par = (LAS float*)(F.lds + OFF_PAR);
    const bf16* PR = WSP(bf16, AR_PR); bf16* SCANIN = WSP(bf16, AR_SCANIN); bf16* SV = WSP(bf16, AR_SV); bf16* XB = WSP(bf16, WS_XB); float* BONUS = WSP(float, WS_BONUS);
    const bf16* WUPT = (const bf16*)(F.ws + WS_W + W_WUPT); const bf16* AUPT = (const bf16*)(F.ws + WS_W + W_AUPT); const bf16* GUPT = (const bf16*)(F.ws + WS_W + W_GUPT);
    const int h = F.wave, lane = F.lane, r32 = lane & 31, hi = lane >> 5, tid = F.tid;
    const float* mu = FIN(I_MU) + l * RPROJ;
    __syncthreads();
    { const int c = tid;
      par[c] = mu[c]; par[512 + c] = mu[512 + c]; par[1024 + c] = mu[1024 + c]; par[1536 + c] = FIN(I_W0)[l * RW + c]; par[2048 + c] = FIN(I_A0)[l * RW + c];
      par[2560 + c] = FIN(I_KK)[l * RW + c]; par[3072 + c] = FIN(I_KA)[l * RW + c]; par[3584 + c] = FIN(I_RK)[l * RW + c]; }
    for (int task = blockIdx.x; task < M / 32; task += F.G) { const int t0 = task * 32;
        __syncthreads();
        {
          u32x4 st[13];
#pragma unroll
          for (int i = 0; i < 13; ++i) { const int q = tid + 512 * i; st[i] = (u32x4){0u, 0u, 0u, 0u};
              if (q < 33 * 192) { const int row = q / 192, c16 = q - row * 192; if (row > 0 || (t0 & 2047) != 0) st[i] = *(const u32x4*)(PR + (size_t)(t0 - 1 + row) * RPROJ + c16 * 8); } }
#pragma unroll
          for (int i = 0; i < 13; ++i) { const int q = tid + 512 * i;
              if (q < 33 * 192) { const int row = q / 192, c16 = q - row * 192; LAS unsigned char* d = rows + row * SROW + c16 * 16; *(LAS u32x2*)d = (u32x2){st[i].x, st[i].y}; *(LAS u32x2*)(d + 8) = (u32x2){st[i].z, st[i].w}; } } }
        {
          const int tt = tid >> 4, l16 = (tid & 15) * 16, t = t0 + tt; const bf16* pc = PR + (size_t)t * RPROJ + 1536 + l16;
          u32x4 cur[2], prv[2]; cur[0] = *(const u32x4*)pc; cur[1] = *(const u32x4*)(pc + 8); prv[0] = (u32x4){0u, 0u, 0u, 0u}; prv[1] = prv[0];
          if (t & 2047) { prv[0] = *(const u32x4*)(pc - RPROJ); prv[1] = *(const u32x4*)(pc - RPROJ + 8); }
          u32x4 ow[2];
#pragma unroll
          for (int hh = 0; hh < 2; ++hh) { const f32x4 m0 = *(const f32x4*)(mu + 1536 + l16 + 8 * hh), m1 = *(const f32x4*)(mu + 1536 + l16 + 8 * hh + 4); float xv[8];
#pragma unroll
              for (int i = 0; i < 4; ++i) { const unsigned cw = cur[hh][i], pw = prv[hh][i]; const float p0 = bf2f(cw & 0xffffu), p1 = bf2f(cw >> 16), q0 = bf2f(pw & 0xffffu), q1 = bf2f(pw >> 16);
                  const float ma = i < 2 ? m0[2 * i] : m1[2 * i - 4], mb = i < 2 ? m0[2 * i + 1] : m1[2 * i - 3];
                  xv[2 * i] = p0 + (q0 - p0) * ma; xv[2 * i + 1] = p1 + (q1 - p1) * mb; }
#pragma unroll
              for (int i = 0; i < 8; ++i) { if (l16 < 64) xv[i] = 1.0f - 2.0f * __builtin_amdgcn_rcpf(1.0f + __expf(2.0f * xv[i])); else if (l16 >= 128) xv[i] = sigmoidf_(xv[i]); }
              ow[hh] = (u32x4){pk2(xv[0], xv[1]), pk2(xv[2], xv[3]), pk2(xv[4], xv[5]), pk2(xv[6], xv[7])}; }
          *(LAS u32x4*)(lat + tt * LROW + l16 * 2) = ow[0]; *(LAS u32x4*)(lat + tt * LROW + l16 * 2 + 16) = ow[1]; }
        __syncthreads();
        const int t = t0 + r32, bb = t >> 11, tp = t & 2047, bh = bb * 8 + h;
        const LAS unsigned char* rc = rows + (r32 + 1) * SROW; const LAS unsigned char* rp = rows + r32 * SROW;
        float n2 = 0.f, bon = 0.f;
#pragma unroll
        for (int q = 0; q < 8; ++q) { const int c4 = h * 64 + 8 * q + 4 * hi;
            const u32x2 kc = *(const LAS u32x2*)(rc + (512 + c4) * 2), kp = *(const LAS u32x2*)(rp + (512 + c4) * 2);
            const f32x4 mk = *(const LAS f32x4*)(par + 512 + c4), kkc = *(const LAS f32x4*)(par + 2560 + c4);
#pragma unroll
            for (int i = 0; i < 4; ++i) { const unsigned sh = (i & 1) * 16; float k = bf2f((kc[i >> 1] >> sh) & 0xffffu); const float kq = bf2f((kp[i >> 1] >> sh) & 0xffffu);
                k += (kq - k) * mk[i]; const float kk = k * kkc[i]; n2 += kk * kk; } }
        n2 += __shfl_xor(n2, 32);
        const float inv = 1.0f / fmaxf(sqrtf(n2), 1e-12f);
        bf16* so = SCANIN + ((size_t)(bh * 64 + (tp >> 5)) * 10) * 1024 + lane * 16;
#pragma unroll 1
        for (int ct = 0; ct < 2; ++ct) { const int cb = h * 64 + 32 * ct;
            f32x16 aw, aa, ag;
#pragma unroll
            for (int i = 0; i < 16; ++i) { aw[i] = 0.f; aa[i] = 0.f; ag[i] = 0.f; }
            const LAS unsigned char* lb = lat + r32 * LROW + 16 * hi;
#pragma unroll
            for (int s = 0; s < 4; ++s) { const bf16x8 wf = *(const bf16x8*)(WUPT + (size_t)(cb + r32) * 64 + 16 * s + 8 * hi), af = *(const bf16x8*)(AUPT + (size_t)(cb + r32) * 64 + 16 * s + 8 * hi);
                const bf16x8 lw = *(const LAS bf16x8*)(lb + 32 * s), la = *(const LAS bf16x8*)(lb + 128 + 32 * s);
                aw = __builtin_amdgcn_mfma_f32_32x32x16_bf16(wf, lw, aw, 0, 0, 0); aa = __builtin_amdgcn_mfma_f32_32x32x16_bf16(af, la, aa, 0, 0, 0); }
#pragma unroll
            for (int s = 0; s < 8; ++s) { const bf16x8 gf = *(const bf16x8*)(GUPT + (size_t)(cb + r32) * 128 + 16 * s + 8 * hi); const bf16x8 lg = *(const LAS bf16x8*)(lb + 256 + 32 * s);
                ag = __builtin_amdgcn_mfma_f32_32x32x16_bf16(gf, lg, ag, 0, 0, 0); }
            unsigned onk[8], old_[8], obv[8], okt[8], orr[8];
#pragma unroll
            for (int g = 0; g < 4; ++g) { const int c4 = cb + 8 * g + 4 * hi;
                const u32x2 rcv = *(const LAS u32x2*)(rc + c4 * 2), kcv = *(const LAS u32x2*)(rc + (512 + c4) * 2), vcv = *(const LAS u32x2*)(rc + (1024 + c4) * 2);
                const u32x2 rpv = *(const LAS u32x2*)(rp + c4 * 2), kpv = *(const LAS u32x2*)(rp + (512 + c4) * 2), vpv = *(const LAS u32x2*)(rp + (1024 + c4) * 2);
                const f32x4 mr = *(const LAS f32x4*)(par + c4), mk = *(const LAS f32x4*)(par + 512 + c4), mv = *(const LAS f32x4*)(par + 1024 + c4);
                const f32x4 w0v = *(const LAS f32x4*)(par + 1536 + c4), a0v = *(const LAS f32x4*)(par + 2048 + c4), kkc = *(const LAS f32x4*)(par + 2560 + c4), kac = *(const LAS f32x4*)(par + 3072 + c4), rkc = *(const LAS f32x4*)(par + 3584 + c4);
                float ro[4], ko[4], vo[4], ldo[4], go[4], nk[4], bo[4];
#pragma unroll
                for (int i = 0; i < 4; ++i) { const unsigned sh = (i & 1) * 16;
                    float r = bf2f((rcv[i >> 1] >> sh) & 0xffffu), k = bf2f((kcv[i >> 1] >> sh) & 0xffffu), v = bf2f((vcv[i >> 1] >> sh) & 0xffffu);
                    const float rq = bf2f((rpv[i >> 1] >> sh) & 0xffffu), kq = bf2f((kpv[i >> 1] >> sh) & 0xffffu), vq = bf2f((vpv[i >> 1] >> sh) & 0xffffu);
                    r += (rq - r) * mr[i]; k += (kq - k) * mk[i]; v += (vq - v) * mv[i];
                    const float wv = w0v[i] + aw[4 * g + i], xs = -wv, sp = xs > 20.f ? xs : __logf(1.0f + __expf(xs)), ld = -__expf(-sp - 0.5f);
                    const float a = sigmoidf_(a0v[i] + aa[4 * g + i]);
                    const float kn = k * kkc[i] * inv, kt = k * (1.0f + (a - 1.0f) * kac[i]);
                    bon += r * kt * rkc[i];
                    ro[i] = r; ko[i] = kt; vo[i] = v; ldo[i] = ld; go[i] = ag[4 * g + i]; nk[i] = -kn; bo[i] = kn * a; }
                onk[2 * g] = pk2(nk[0], nk[1]); onk[2 * g + 1] = pk2(nk[2], nk[3]); old_[2 * g] = pk2(ldo[0], ldo[1]); old_[2 * g + 1] = pk2(ldo[2], ldo[3]);
                obv[2 * g] = pk2(bo[0], bo[1]); obv[2 * g + 1] = pk2(bo[2], bo[3]); okt[2 * g] = pk2(ko[0], ko[1]); okt[2 * g + 1] = pk2(ko[2], ko[3]);
                orr[2 * g] = pk2(ro[0], ro[1]); orr[2 * g + 1] = pk2(ro[2], ro[3]);
                *(u32x2*)(SV + ((size_t)bh * 2048 + tp) * 64 + 32 * ct + 8 * g + 4 * hi) = (u32x2){pk2(vo[0], vo[1]), pk2(vo[2], vo[3])};
                *(u32x2*)(XB + (size_t)t * 1024 + c4) = (u32x2){pk2(go[0], go[1]), pk2(go[2], go[3])}; }
            bf16* sq = so + ct * 1024;
            *(u32x4*)(sq) = (u32x4){onk[0], onk[1], onk[2], onk[3]}; *(u32x4*)(sq + 8) = (u32x4){onk[4], onk[5], onk[6], onk[7]};
            *(u32x4*)(sq + 2048) = (u32x4){old_[0], old_[1], old_[2], old_[3]}; *(u32x4*)(sq + 2048 + 8) = (u32x4){old_[4], old_[5], old_[6], old_[7]};
            *(u32x4*)(sq + 4096) = (u32x4){obv[0], obv[1], obv[2], obv[3]}; *(u32x4*)(sq + 4096 + 8) = (u32x4){obv[4], obv[5], obv[6], obv[7]};
            *(u32x4*)(sq + 6144) = (u32x4){okt[0], okt[1], okt[2], okt[3]}; *(u32x4*)(sq + 6144 + 8) = (u32x4){okt[4], okt[5], okt[6], okt[7]};
            *(u32x4*)(sq + 8192) = (u32x4){orr[0], orr[1], orr[2], orr[3]}; *(u32x4*)(sq + 8192 + 8) = (u32x4){orr[4], orr[5], orr[6], orr[7]};
        }
        bon += __shfl_xor(bon, 32);
        if (hi == 0) BONUS[(size_t)t * 8 + h] = bon;
    }
}

template <int R, int NCH, bool KINDP>
__device__ __forceinline__ void scan_stream(Frame& F, LAS float* ring, int bh, int ch, int rg, int lis) {
    typedef float f32x2 __attribute__((ext_vector_type(2)));
    constexpr int CLEN = SEQ / NCH, NHALF = CLEN / 8;
    const int lane = F.lane, js = lane & 3, q = lane >> 2, row0 = rg * 16 * R + q * R, tbase = ch * CLEN;
    const bf16* src5 = WSP(bf16, AR_SCANIN) + (size_t)bh * 64 * 10 * 1024; const bf16* srcv = WSP(bf16, AR_SV) + (size_t)bh * 2048 * 64;
    float* YL = WSP(float, AR_YLOC) + ((size_t)bh * 2048 + tbase) * 64; bf16* ZZ = WSP(bf16, AR_Z) + ((size_t)bh * 2048 + tbase) * 64;
    int soff[2], doff[2]; bool isv[2], isld[2], cval[2];
#pragma unroll
    for (int k = 0; k < 2; ++k) { const int ci = lis + k * 256; cval[k] = ci < 384; isv[k] = ci >= 320;
        const int run = ci >> 4, vec = run >> 2, ct = (run >> 1) & 1, hi2 = run & 1, tok = (ci & 15) >> 1, hf16 = ci & 1, cv = ci - 320;
        isld[k] = !isv[k] && vec == 1;
        soff[k] = isv[k] ? (cv >> 3) * 64 + (cv & 7) * 8 : ((vec * 2 + ct) * 64 + hi2 * 32 + tok) * 16 + 8 * hf16;
        doff[k] = isv[k] ? (cv >> 3) * 384 + 320 + (cv & 7) * 8 : tok * 384 + vec * 64 + 32 * ct + 16 * hf16 + 4 * hi2; }
#define SCAN_LOAD(hfx) do { const int tg_ = tbase + (hfx) * 8; _Pragma("unroll") for (int k = 0; k < 2; ++k) if (cval[k]) \
        pre[k] = isv[k] ? *(const u32x4*)(srcv + (size_t)tg_ * 64 + soff[k]) : *(const u32x4*)(src5 + (size_t)(tg_ >> 5) * 10240 + (tg_ & 31) * 16 + soff[k]); } while (0)
#define SCAN_WRITE(hfx) do { _Pragma("unroll") for (int k = 0; k < 2; ++k) if (cval[k]) { float f[8]; \
        _Pragma("unroll") for (int i = 0; i < 4; ++i) { f[2 * i] = bf2f(pre[k][i] & 0xffffu); f[2 * i + 1] = bf2f(pre[k][i] >> 16); } \
        if (isld[k]) { _Pragma("unroll") for (int i = 0; i < 8; ++i) f[i] = __expf(f[i]); } \
        LAS float* d_ = ring + (((hfx) & 1) * 8) * 384 + doff[k]; \
        *(LAS f32x4*)(d_) = (f32x4){f[0], f[1], f[2], f[3]}; *(LAS f32x4*)(d_ + (isv[k] ? 4 : 8)) = (f32x4){f[4], f[5], f[6], f[7]}; } } while (0)
    f32x2 S[R][8];
#pragma unroll
    for (int rr = 0; rr < R; ++rr)
#pragma unroll
        for (int k = 0; k < 8; ++k) { S[rr][k].x = (KINDP && (row0 + rr) == 16 * js + 2 * k) ? 1.f : 0.f; S[rr][k].y = (KINDP && (row0 + rr) == 16 * js + 2 * k + 1) ? 1.f : 0.f; }
    u32x4 pre[2];
    SCAN_LOAD(0); SCAN_WRITE(0);
    __syncthreads();
    for (int hf = 0; hf < NHALF; ++hf) {
        const bool more = hf + 1 < NHALF;
        if (more) SCAN_LOAD(hf + 1);
#pragma unroll 2
        for (int st = 0; st < 8; ++st) {
            const LAS float* sp = ring + ((hf & 1) * 8 + st) * 384 + 16 * js;
            f32x2 nn[8], ww[8], bb[8], kk[8], rr2[8];
#pragma unroll
            for (int i = 0; i < 4; ++i) { const f32x4 a = *(const LAS f32x4*)(sp + 4 * i); nn[2 * i] = (f32x2){a[0], a[1]}; nn[2 * i + 1] = (f32x2){a[2], a[3]}; }
#pragma unroll
            for (int i = 0; i < 4; ++i) { const f32x4 a = *(const LAS f32x4*)(sp + 64 + 4 * i); ww[2 * i] = (f32x2){a[0], a[1]}; ww[2 * i + 1] = (f32x2){a[2], a[3]}; }
#pragma unroll
            for (int i = 0; i < 4; ++i) { const f32x4 a = *(const LAS f32x4*)(sp + 128 + 4 * i); bb[2 * i] = (f32x2){a[0], a[1]}; bb[2 * i + 1] = (f32x2){a[2], a[3]}; }
            if (!KINDP) {
#pragma unroll
                for (int i = 0; i < 4; ++i) { const f32x4 a = *(const LAS f32x4*)(sp + 192 + 4 * i); kk[2 * i] = (f32x2){a[0], a[1]}; kk[2 * i + 1] = (f32x2){a[2], a[3]}; } }
#pragma unroll
            for (int i = 0; i < 4; ++i) { const f32x4 a = *(const LAS f32x4*)(sp + 256 + 4 * i); rr2[2 * i] = (f32x2){a[0], a[1]}; rr2[2 * i + 1] = (f32x2){a[2], a[3]}; }
            float vv[R];
            if (!KINDP) {
#pragma unroll
                for (int rr = 0; rr < R; ++rr) vv[rr] = ring[((hf & 1) * 8 + st) * 384 + 320 + row0 + rr]; }
            float sa[R];
#pragma unroll
            for (int rr = 0; rr < R; ++rr) { f32x2 p0 = S[rr][0] * nn[0], p1 = S[rr][1] * nn[1];
#pragma unroll
                for (int k = 2; k < 8; k += 2) { p0 = S[rr][k] * nn[k] + p0; p1 = S[rr][k + 1] * nn[k + 1] + p1; }
                p0 = p0 + p1; sa[rr] = quad_sum(p0.x + p0.y); }
            float y[R];
#pragma unroll
            for (int rr = 0; rr < R; ++rr) { const f32x2 sa2 = (f32x2){sa[rr], sa[rr]}; f32x2 p0 = (f32x2){0.f, 0.f}, p1 = (f32x2){0.f, 0.f};
#pragma unroll
                for (int k = 0; k < 8; k += 2) {
                    f32x2 t0 = S[rr][k] * ww[k], t1 = S[rr][k + 1] * ww[k + 1];
                    t0 = sa2 * bb[k] + t0; t1 = sa2 * bb[k + 1] + t1;
                    if (!KINDP) { const f32x2 v2 = (f32x2){vv[rr], vv[rr]}; t0 = v2 * kk[k] + t0; t1 = v2 * kk[k + 1] + t1; }
                    S[rr][k] = t0; S[rr][k + 1] = t1; p0 = t0 * rr2[k] + p0; p1 = t1 * rr2[k + 1] + p1; }
                p0 = p0 + p1; y[rr] = quad_sum(p0.x + p0.y); }
            if (js == 0) { const int t = hf * 8 + st;
                if (R == 2) { if (KINDP) *(unsigned*)(ZZ + (size_t)t * 64 + row0) = pk2(y[0], y[R - 1]); else *(f32x2*)(YL + (size_t)t * 64 + row0) = (f32x2){y[0], y[R - 1]}; }
                else {
#pragma unroll
                    for (int rr = 0; rr < R; ++rr) { if (KINDP) ZZ[(size_t)t * 64 + row0 + rr] = (bf16)f2bf(y[rr]); else YL[(size_t)t * 64 + row0 + rr] = y[rr]; } } }
        }
        if (more) SCAN_WRITE(hf + 1);
        __syncthreads();
    }
#undef SCAN_LOAD
#undef SCAN_WRITE
    if (NCH > 1) {
        float* st = WSP(float, AR_STATE) + ((size_t)(bh * NCH + ch) * 2 + (KINDP ? 0 : 1)) * 4096;
#pragma unroll
        for (int rr = 0; rr < R; ++rr)
#pragma unroll
            for (int i = 0; i < 4; ++i) *(f32x4*)(st + (size_t)(row0 + rr) * 64 + 16 * js + 4 * i) = (f32x4){S[rr][2 * i].x, S[rr][2 * i].y, S[rr][2 * i + 1].x, S[rr][2 * i + 1].y};
    }
}
template <int R, int NCH>
__device__ __forceinline__ void ph_scan(Frame& F) {
    PHASE_IDS();
    constexpr int KINDS = NCH > 1 ? 2 : 1, RG = 4 / R, WPS = KINDS * RG, SPW = NWAVES / WPS, NSTREAM = BATCH * NH * NCH;
    static_assert(WPS == 4, "staging assumes 4 waves per stream");
    const int sl = F.wave / WPS, role = F.wave % WPS, kind = role / RG, rg = role % RG, lis = role * 64 + F.lane;
    LAS float* ring = (LAS float*)F.lds + sl * (16 * 384);
    for (int it = blockIdx.x; it * SPW < NSTREAM; it += F.G) {
        const int sid = it * SPW + sl, bh = sid / NCH, ch = sid % NCH;
        __syncthreads();
        if (kind == 0) scan_stream<R, NCH, false>(F, ring, bh, ch, rg, lis); else scan_stream<R, NCH, true>(F, ring, bh, ch, rg, lis);
    }
}

template <int NCH>
__device__ __forceinline__ void ph_fix(Frame& F) {
    PHASE_IDS();
    typedef float f32x2 __attribute__((ext_vector_type(2)));
    LAS float* cur = (LAS float*)F.lds;
    for (int u = blockIdx.x; u < 256; u += F.G) { const int bh = u >> 2, rgx = u & 3, i = F.tid >> 5, j2 = (F.tid & 31) * 2, row = rgx * 16 + i;
        float* base = WSP(float, AR_STATE) + (size_t)bh * NCH * 2 * 4096;
        __syncthreads();
        { const f32x2 v = *(const f32x2*)(base + 4096 + row * 64 + j2); cur[i * 64 + j2] = v.x; cur[i * 64 + j2 + 1] = v.y; }
        __syncthreads();
        for (int c = 1; c < NCH - 1; ++c) { const float* P = base + (size_t)(c * 2) * 4096; float* SL = base + (size_t)(c * 2 + 1) * 4096;
            f32x2 acc = *(const f32x2*)(SL + row * 64 + j2);
#pragma unroll
            for (int ii = 0; ii < 64; ++ii) { const float sv = cur[i * 64 + ii]; const f32x2 p = *(const f32x2*)(P + ii * 64 + j2); acc.x += sv * p.x; acc.y += sv * p.y; }
            __syncthreads();
            cur[i * 64 + j2] = acc.x; cur[i * 64 + j2 + 1] = acc.y; *(f32x2*)(SL + row * 64 + j2) = acc;
            __syncthreads(); }
    }
}

template <int NCH>
__device__ __forceinline__ void ph_post(Frame& F, int l) {
    PHASE_IDS();
    constexpr int CLEN = SEQ / NCH;
    const float* YL = WSP(float, AR_YLOC); const bf16* SV = WSP(bf16, AR_SV); bf16* XB = WSP(bf16, WS_XB); const float* BONUS = WSP(float, WS_BONUS); const bf16* ZZ = WSP(bf16, AR_Z);
    LAS float* zt = (LAS float*)F.lds;
    const int c = F.tid, h = F.wave, j = F.lane; const float lng = FIN(I_LNG)[l * RW + c], lnb = FIN(I_LNB)[l * RW + c];
    for (int grp = blockIdx.x; grp < M / 64; grp += F.G) { const int t0g = grp * 64, bb = t0g >> 11, ch = (t0g & 2047) / CLEN, bh = bb * 8 + h; const bool corr = NCH > 1 && ch > 0;
        float st[64];
        if (corr) { const float* sp = WSP(float, AR_STATE) + ((size_t)(bh * NCH + ch - 1) * 2 + 1) * 4096 + j * 64;
#pragma unroll
            for (int i4 = 0; i4 < 16; ++i4) { const f32x4 v = *(const f32x4*)(sp + 4 * i4); st[4 * i4] = v[0]; st[4 * i4 + 1] = v[1]; st[4 * i4 + 2] = v[2]; st[4 * i4 + 3] = v[3]; } }
        for (int ti = 0; ti < 4; ++ti) { const int t0 = t0g + 16 * ti;
            if (corr) { __syncthreads();
#pragma unroll 4
                for (int tt = 0; tt < 16; ++tt) zt[tt * 512 + c] = bf2f(ZZ[((size_t)bh * 2048 + ((t0 + tt) & 2047)) * 64 + j]);
                __syncthreads(); }
#pragma unroll 1
            for (int tb = 0; tb < 16; tb += 8) {
                float yv[8], vv[8], bv[8], gv[8];
#pragma unroll
                for (int q = 0; q < 8; ++q) { const int t = t0 + tb + q, tp = t & 2047;
                    yv[q] = YL[((size_t)bh * 2048 + tp) * 64 + j]; vv[q] = bf2f(SV[((size_t)bh * 2048 + tp) * 64 + j]); bv[q] = BONUS[(size_t)t * 8 + h]; gv[q] = bf2f(XB[(size_t)t * 1024 + c]); }
                if (corr) {
#pragma unroll
                    for (int q = 0; q < 8; ++q) { const LAS float* zp = zt + (tb + q) * 512 + h * 64; float p0 = 0.f, p1 = 0.f, p2 = 0.f, p3 = 0.f;
#pragma unroll
                        for (int qq = 0; qq < 4; ++qq) { asm volatile("" ::: "memory");
                            f32x4 zz[4];
#pragma unroll
                            for (int e = 0; e < 4; ++e) zz[e] = *(const LAS f32x4*)(zp + 16 * qq + 4 * e);
#pragma unroll
                            for (int e = 0; e < 4; ++e) { const int j4 = 4 * qq + e; p0 += st[4 * j4] * zz[e][0]; p1 += st[4 * j4 + 1] * zz[e][1]; p2 += st[4 * j4 + 2] * zz[e][2]; p3 += st[4 * j4 + 3] * zz[e][3]; }
                            asm volatile("" : "+v"(p0), "+v"(p1), "+v"(p2), "+v"(p3)); }
                        yv[q] += (p0 + p1) + (p2 + p3); } }
                float mean[8], var[8];
#pragma unroll
                for (int q = 0; q < 8; ++q) mean[q] = yv[q];
                wave_sum8(mean);
#pragma unroll
                for (int q = 0; q < 8; ++q) { mean[q] *= (1.0f / 64.0f); yv[q] -= mean[q]; var[q] = yv[q] * yv[q]; }
                wave_sum8(var);
#pragma unroll
                for (int q = 0; q < 8; ++q) { const int t = t0 + tb + q;
                    const float yn = yv[q] * __builtin_amdgcn_rsqf(var[q] * (1.0f / 64.0f) + LNX_EPS) * lng + lnb;
                    XB[(size_t)t * 1024 + c] = (bf16)f2bf((yn + bv[q] * vv[q]) * gv[q]); }
            }
        }
    }
}

__device__ __forceinline__ void ph_final(Frame& F) {
    PHASE_IDS();
    const int gw = F.vcu * NWAVES + F.wave, NGW = F.G * NWAVES; const float* ssq = WSP(float, WS_SSQ); const float* g = FIN(I_FING);
    f32x4 gv[4];
#pragma unroll
    for (int j = 0; j < 4; ++j) gv[j] = ((const f32x4*)g)[F.lane + 64 * j];
    for (int r = gw; r < M; r += NGW) { const float rs = pg8::row_rstd16(ssq, r); f32x4* xr = (f32x4*)(F.out + (size_t)r * DM) + F.lane;
#pragma unroll
        for (int j = 0; j < 4; ++j) { const f32x4 v = xr[64 * j]; xr[64 * j] = v * rs * gv[j]; } }
}

constexpr int PH_INIT = 0, PH_PER_LAYER = 16, PH_FINAL = 1 + DEPTH * PH_PER_LAYER, N_PHASES = PH_FINAL + 1;
enum { K_CONV = 0, K_KV, K_F1UP, K_F1DN, K_MIXIN, K_MOBA, K_PREP, K_SCAN, K_FIX, K_POST, K_MIXOUT, K_XQ, K_XATT, K_XO, K_F2UP, K_F2DN };

#ifdef ONLY
#define PH_ON(k) ((k) == (ONLY))
#else
#define PH_ON(k) true
#endif
__global__ void __launch_bounds__(NWAVES * 64, 2) fwd(Args args) {
    extern __shared__ __attribute__((aligned(16))) unsigned char lds[];
    Frame F;
    F.lds = (LAS unsigned char*)lds; F.MISC = (volatile LAS unsigned*)(F.lds + MISC_OFF);
    F.tid = threadIdx.x; F.lane = F.tid & 63; F.wave = __builtin_amdgcn_readfirstlane(F.tid >> 6);
    F.G = gridDim.x; { const int bx = blockIdx.x; F.vcu = (F.G % 8 == 0) ? (bx % 8) * (F.G / 8) + bx / 8 : bx; }
    F.out = args.out; F.ws = args.ws; F.ctl = (gu32*)(args.ws + WS_CTL);
    F.ka = (const __attribute__((address_space(4))) Args*)(uintptr_t)__builtin_amdgcn_kernarg_segment_ptr();
    for (int u = F.tid; u < (LDS_BYTES - LDSCTL_OFF) / 4; u += NWAVES * 64) ((LAS unsigned*)(F.lds + LDSCTL_OFF))[u] = 0u;
    __syncthreads();
    const bool multi = args.ph_hi - args.ph_lo > 1;
    XcdBarrier bar; bar.bar = (unsigned*)(F.ctl + 4096); bar.x = 0; bar.st = nullptr;
    if (multi) bar = xcd_barrier_post((unsigned*)(F.ctl + 4096), F.MISC + 8);
#ifndef REP_AT
#define REP_AT 1000
#endif
    for (int pi = args.ph_lo; pi < args.ph_hi + (REP_AT < 1000 ? 1 : 0); ++pi) { const int ph = pi - (pi > REP_AT ? 1 : 0);
        { uintptr_t kp = (uintptr_t)__builtin_amdgcn_kernarg_segment_ptr(); asm volatile("" : "+s"(kp)); F.ka = (const __attribute__((address_space(4))) Args*)kp; }
        unsigned char* wb = F.ws + WS_W;
        if (ph == PH_INIT) { if (PH_ON(100)) ph_init(F); }
        else if (ph == PH_FINAL) { if (PH_ON(101)) ph_final(F); }
        else { const int l = (ph - 1) / PH_PER_LAYER, k = (ph - 1) % PH_PER_LAYER;
            const float* xin = (l == 0) ? FIN(I_X) : (const float*)F.out;
            switch (k) {
            case K_CONV: if (!PH_ON(K_CONV)) break; ph_conv(F, l); break;
            case K_KV: if (!PH_ON(K_KV)) break; { pg8::Gemm g{WSP(bf16, WS_MEMB), (const bf16*)(wb + W_WKV), MM, 2 * DM, DM}; pg8::StaticOrder S; S.init(MM, 2 * DM, F.G, (int)blockIdx.x);
                pg8::EpiKV E{F.ws}; pg8::gemm_phase<pg8::EpiKV, pg8::StaticOrder, true, true>(F.lds, g, S, E); } break;
            case K_F1UP: case K_F2UP: if (!PH_ON(K_F1UP)) break; { pg8::Gemm g{WSP(bf16, WS_XB), (const bf16*)(wb + (k == K_F1UP ? W_F1IN : W_F2IN)), M, 2 * DFF, DM}; pg8::StaticOrder S; S.init(M, 2 * DFF, F.G, (int)blockIdx.x);
                pg8::EpiSwiGLU E{F.ws}; pg8::gemm_phase<pg8::EpiSwiGLU, pg8::StaticOrder, true, true>(F.lds, g, S, E); } break;
            case K_F1DN: case K_F2DN: if (!PH_ON(K_F1DN)) break; { pg8::Gemm g{WSP(bf16, AR_H), (const bf16*)(wb + (k == K_F1DN ? W_F1OUT : W_F2OUT)), M, DM, DFF}; pg8::StaticOrder S; S.init(M, DM, F.G, (int)blockIdx.x);
                pg8::EpiResid E{k == K_F1DN ? xin : (const float*)F.out, F.out, F.ws, WS_XB, 0.5f}; pg8::gemm_phase<pg8::EpiResid, pg8::StaticOrder, true, true>(F.lds, g, S, E); } break;
            case K_MIXIN: if (!PH_ON(K_MIXIN)) break; { pg8::Gemm g{WSP(bf16, WS_XB), (const bf16*)(wb + W_MIXIN), M, DPROJ, DM}; pg8::StaticOrder S; S.init(M, DPROJ, F.G, (int)blockIdx.x);
                pg8::EpiMixIn E{F.ws}; pg8::gemm_phase<pg8::EpiMixIn, pg8::StaticOrder, true, true>(F.lds, g, S, E); } break;
            case K_MOBA: if (!PH_ON(K_MOBA)) break; ph_moba(F); break;
            case K_PREP: if (!PH_ON(K_PREP)) break; ph_prep(F, l); break;
            case K_SCAN: if (!PH_ON(K_SCAN)) break; ph_scan<SCAN_R, SCAN_NCH>(F); break;
            case K_FIX: if (!PH_ON(K_FIX)) break; if (SCAN_NCH > 1) ph_fix<SCAN_NCH>(F); break;
            case K_POST: if (!PH_ON(K_POST)) break; ph_post<SCAN_NCH>(F, l); break;
            case K_MIXOUT: if (!PH_ON(K_MIXOUT)) break; { pg8::Gemm g{WSP(bf16, WS_XB), (const bf16*)(wb + W_MIXOUT), M, DM, DM}; pg8::StaticOrder S; S.init(M, DM, F.G, (int)blockIdx.x);
                pg8::EpiResid E{F.out, F.out, F.ws, AR_XB2, 1.0f}; pg8::gemm_phase<pg8::EpiResid, pg8::StaticOrder, true, true>(F.lds, g, S, E); } break;
            case K_XQ: if (!PH_ON(K_XQ)) break; { pg8::Gemm g{WSP(bf16, AR_XB2), (const bf16*)(wb + W_WQ), M, DM, DM}; pg8::StaticOrder S; S.init(M, DM, F.G, (int)blockIdx.x);
                pg8::EpiXQ E{F.ws}; pg8::gemm_phase<pg8::EpiXQ, pg8::StaticOrder, true, true>(F.lds, g, S, E); } break;
            case K_XATT: if (!PH_ON(K_XATT)) break; ph_xatt(F); break;
            case K_XO: if (!PH_ON(K_XO)) break; { pg8::Gemm g{WSP(bf16, AR_XO), (const bf16*)(wb + W_WO), M, DM, DM}; pg8::StaticOrder S; S.init(M, DM, F.G, (int)blockIdx.x);
                pg8::EpiResid E{F.out, F.out, F.ws, WS_XB, 1.0f}; pg8::gemm_phase<pg8::EpiResid, pg8::StaticOrder, true, true>(F.lds, g, S, E); } break;
            default: break;
            }
        }
        if (pi + 1 < args.ph_hi + (REP_AT < 1000 ? 1 : 0)) {
            const bool noop = (ph != PH_INIT && ph != PH_FINAL && ((ph - 1) % PH_PER_LAYER) == K_FIX && SCAN_NCH == 1);
            if (!noop) { if (ph == PH_INIT) cooperative_groups::this_grid().sync(); else xcd_barrier(bar); }
        }
    }
}

extern "C" void kernel_launch(void* const* d_in, const int* in_sizes, int n_in, void* d_out, int out_size, void* d_ws, size_t ws_size, hipStream_t stream) {
    static int grid = 0;
    if (grid == 0) {
        if (n_in != N_IN || in_sizes[0] != M * DM || out_size != M * DM || ws_size < WS_END) { fprintf(stderr, "kernel_launch: unexpected problem (n_in %d, in0 %d, out %d, ws %zu < %zu); nothing launched\n", n_in, n_in > 0 ? in_sizes[0] : -1, out_size, ws_size, (size_t)WS_END); grid = -1; return; }
        int dev = 0, cus = 0;
        if (hipGetDevice(&dev) != hipSuccess || hipDeviceGetAttribute(&cus, hipDeviceAttributeMultiprocessorCount, dev) != hipSuccess) { grid = -1; return; }
        if (hipFuncSetAttribute((const void*)fwd, hipFuncAttributeMaxDynamicSharedMemorySize, LDS_BYTES) != hipSuccess) { fprintf(stderr, "kernel_launch: hipFuncSetAttribute failed\n"); grid = -1; return; }
        int per_cu = 0;
        if (hipOccupancyMaxActiveBlocksPerMultiprocessor(&per_cu, (const void*)fwd, NWAVES * 64, LDS_BYTES) != hipSuccess || per_cu < 1) { fprintf(stderr, "kernel_launch: occupancy query reports %d workgroups per CU; nothing launched\n", per_cu); grid = -1; return; }
        grid = cus;
    }
    if (grid < 0) return;
    (void)hipMemsetAsync((char*)d_ws + WS_CTL, 0, CTL_ZERO_BYTES, stream);
    Args a{};
    for (int i = 0; i < N_IN; ++i) a.in[i] = (const float*)d_in[i];
    a.out = (float*)d_out; a.ws = (unsigned char*)d_ws;
    a.ph_lo = 0; a.ph_hi = N_PHASES;
    void* kargs[] = {&a};
    const hipError_t e = hipLaunchCooperativeKernel((const void*)fwd, dim3(grid), dim3(NWAVES * 64), kargs, LDS_BYTES, stream);
    if (e != hipSuccess) fprintf(stderr, "kernel_launch: cooperative launch failed: %s (grid %d)\n", hipGetErrorString(e), grid);
}
```

```cpp
#include <hip/hip_runtime.h>
#include <hip/hip_cooperative_groups.h>
#include <cstdio>
#include <cstdint>

constexpr int BATCH = 8, SEQ = 2048, DM = 1024, DEPTH = 2, M = BATCH * SEQ;
constexpr int RW = 512, NH = 8, HD = 64;
constexpr int RPROJ = 1792, DPROJ = 3328;
constexpr int DFF = 2816;
constexpr int MEMLEN = 256, XH = 4, XHD = 256, MM = BATCH * MEMLEN;
constexpr int MBLK = 256, NBLK = SEQ / MBLK;
constexpr float NORM_EPS = 1e-6f, LNX_EPS = 64e-5f;
constexpr float LOG2E = 1.4426950408889634f;
constexpr float MOBA_QSCALE = 0.125f * LOG2E;
constexpr float XATT_QSCALE = 0.0625f * LOG2E;

enum { I_X = 0, I_MEM, I_RELB, I_FING, I_F1G, I_F1IN, I_F1OUT, I_MIXG, I_MIXIN, I_MIXOUT, I_MU, I_W0, I_WUP, I_A0, I_AUP, I_GUP, I_KK, I_KA, I_RK, I_LNG, I_LNB,
       I_XG, I_MEMG, I_WQ, I_WKV, I_WO, I_F2G, I_F2IN, I_F2OUT, N_IN };

constexpr size_t MiB = 1u << 20;
constexpr size_t WS_CTL = 0, CTL_ZERO_BYTES = 1 * MiB;
constexpr size_t WS_BIAS = 1 * MiB;
constexpr size_t WS_MEMRS = WS_BIAS + 64 * 1024;
constexpr size_t WS_BONUS = WS_MEMRS + 64 * 1024;
constexpr size_t WS_KMS = WS_BONUS + 512 * 1024;
constexpr size_t WS_SSQ = 2 * MiB;
constexpr size_t WS_MEMB = 3 * MiB;
constexpr size_t WS_XK = 7 * MiB, WS_XVT = 11 * MiB;
constexpr size_t WS_W = 15 * MiB;
constexpr size_t W_F1IN = 0, W_F1OUT = W_F1IN + (size_t)2 * DFF * DM * 2, W_F2IN = W_F1OUT + (size_t)DM * DFF * 2, W_F2OUT = W_F2IN + (size_t)2 * DFF * DM * 2,
                 W_MIXIN = W_F2OUT + (size_t)DM * DFF * 2, W_MIXOUT = W_MIXIN + (size_t)DPROJ * DM * 2, W_WQ = W_MIXOUT + (size_t)DM * DM * 2, W_WKV = W_WQ + (size_t)DM * DM * 2,
                 W_WO = W_WKV + (size_t)2 * DM * DM * 2, W_WUPT = W_WO + (size_t)DM * DM * 2, W_AUPT = W_WUPT + (size_t)RW * 64 * 2, W_GUPT = W_AUPT + (size_t)RW * 64 * 2, W_END = W_GUPT + (size_t)RW * 128 * 2;
static_assert(W_END <= 50 * MiB, "weights fit");
constexpr size_t WS_XB = 65 * MiB;
constexpr size_t WS_AR = 97 * MiB;
constexpr size_t AR_H = WS_AR;
constexpr size_t AR_PR = WS_AR, AR_MQ = WS_AR + 56 * MiB, AR_MK = WS_AR + 72 * MiB, AR_MVT = WS_AR + 88 * MiB;
constexpr size_t AR_SCANIN = WS_AR + 56 * MiB;
constexpr size_t AR_SV = WS_AR + 136 * MiB;
constexpr size_t AR_YLOC = WS_AR, AR_Z = WS_AR + 32 * MiB;
constexpr size_t AR_STATE = WS_AR + 152 * MiB;
constexpr size_t AR_XB2 = WS_AR, AR_XQ = WS_AR + 32 * MiB, AR_XO = WS_AR + 64 * MiB;
constexpr size_t WS_END = WS_AR + 168 * MiB;

#define GAS __attribute__((address_space(1)))
#define LAS __attribute__((address_space(3)))

namespace pg8 {
#define PG8_LAS __attribute__((address_space(3)))
typedef unsigned short bf16_t;
typedef short bf16x8 __attribute__((ext_vector_type(8)));
typedef float f32x4 __attribute__((ext_vector_type(4)));
typedef unsigned u32x4 __attribute__((ext_vector_type(4)));
constexpr int BM = 256, BK = 64, HALF = 128, HTB = HALF * BK * 2  , STAGE_BYTES = 8 * HTB, NXCD = 8, WGM = 8;

__host__ __device__ __forceinline__ int lds_byte(int r, int c) { const int st = (r >> 4) * 2 + (c >> 5), rr = r & 15, cc = c & 31, ob = rr * 64 + cc * 2; return st * 1024 + (ob ^ (((ob >> 9) & 1) << 5)); }
__host__ __device__ __forceinline__ void stage_rc(int b, int& R, int& C) { const int st = b / 1024, sb = b % 1024, swz = sb ^ (((sb >> 9) & 1) << 5); R = (st >> 1) * 16 + swz / 64; C = (st & 1) * 32 + (swz % 64) / 2; }
__host__ __device__ __forceinline__ int perm32(int rho) { const int n = rho >> 4, i = rho & 15; return 8 * (i >> 2) + 4 * n + (i & 3); }

struct Unit { int pm, pn; };
struct Gemm { const bf16_t* A; const bf16_t* Bt; int M, N, K; };

struct StaticOrder {
    int nM, nN, nwg, G, c;
    __host__ __device__ void init(int M, int N, int G_, int c_) { nM = M / BM; nN = N / BM; nwg = nM * nN; G = G_; c = c_; }
    __host__ __device__ bool next(int i, Unit& u) const {
        const long L = (long)i * G + c; if (L >= nwg) return false;
        int wgid = (int)L; { const int q = nwg / NXCD, r = nwg % NXCD, xcd = wgid % NXCD, off = wgid / NXCD; wgid = (xcd < r ? xcd * (q + 1) : r * (q + 1) + (xcd - r) * q) + off; }
        const int nig = WGM * nN, gid = wgid / nig, fm = gid * WGM, gsz = (nM - fm) < WGM ? (nM - fm) : WGM;
        u.pm = fm + ((wgid % nig) % gsz); u.pn = (wgid % nig) / gsz; return true;
    }
    __device__ __forceinline__ void a_ready(const Unit&) const {}
    __device__ __forceinline__ void done(const Unit&) const {}
};

__device__ __forceinline__ unsigned cvt_pk_bf16(float lo, float hi) { unsigned r; asm volatile("v_cvt_pk_bf16_f32 %0, %1, %2" : "=v"(r) : "v"(lo), "v"(hi)); return r; }
typedef float f32x2 __attribute__((ext_vector_type(2)));
__device__ __forceinline__ float row_rstd16(const float* ssq, int r) {
    const f32x4* p = (const f32x4*)(ssq + (size_t)r * 16);
    const f32x4 a = p[0], b = p[1], c = p[2], d = p[3];
    const float s = ((a[0] + a[1]) + (a[2] + a[3])) + ((b[0] + b[1]) + (b[2] + b[3])) + ((c[0] + c[1]) + (c[2] + c[3])) + ((d[0] + d[1]) + (d[2] + d[3]));
    return __builtin_amdgcn_rsqf(s * (1.0f / 1024.0f) + 1e-6f);
}
__device__ __forceinline__ float silu_mul(float g, float u) { return g * __builtin_amdgcn_rcpf(1.0f + __expf(-g)) * u; }
__device__ __forceinline__ u32x4 pack8(const f32x4 v0, const f32x4 v1) { u32x4 w; w.x = cvt_pk_bf16(v0[0], v0[1]); w.y = cvt_pk_bf16(v0[2], v0[3]); w.z = cvt_pk_bf16(v1[0], v1[1]); w.w = cvt_pk_bf16(v1[2], v1[3]); return w; }
__device__ __forceinline__ int pos16(int k) { return 8 * ((k >> 2) & 1) + (k & 3) + 4 * (k >> 3); }

struct EpiSwiGLU {
    static constexpr bool PERM = true, AFTER_DRAIN = false;
    unsigned char* ws;
    __device__ __forceinline__ void operator()(const f32x4 (&acc)[2][2][4][2], const Unit& u, int wr, int wc, int fr, int fq) const {
        const int row0 = u.pm * BM + wr * 64 + fr, hcol = u.pn * 128 + wc * 32 + 8 * fq; bf16_t* H = (bf16_t*)(ws + AR_H); const float* ssq = (const float*)(ws + WS_SSQ);
#pragma unroll
        for (int ai = 0; ai < 2; ++ai)
#pragma unroll
            for (int m = 0; m < 4; ++m) { const int r = row0 + ai * HALF + m * 16; const float rs = row_rstd16(ssq, r);
                f32x4 h0, h1;
#pragma unroll
                for (int i = 0; i < 4; ++i) { h0[i] = silu_mul(acc[ai][0][m][0][i] * rs, acc[ai][1][m][0][i] * rs); h1[i] = silu_mul(acc[ai][0][m][1][i] * rs, acc[ai][1][m][1][i] * rs); }
                *(u32x4*)(H + (size_t)r * 2816 + hcol) = pack8(h0, h1); }
    }
};
struct EpiResid {
    static constexpr bool PERM = true, AFTER_DRAIN = false;
    const float* base; float* out; unsigned char* ws; size_t xb_off; float alpha;
    __device__ __forceinline__ void operator()(const f32x4 (&acc)[2][2][4][2], const Unit& u, int wr, int wc, int fr, int fq) const {
        const int row0 = u.pm * BM + wr * 64 + fr, col0 = u.pn * BM + wc * 32 + 8 * fq; bf16_t* xb = (bf16_t*)(ws + xb_off); float* ssq = (float*)(ws + WS_SSQ);
#pragma unroll
        for (int ai = 0; ai < 2; ++ai)
#pragma unroll
            for (int m = 0; m < 4; ++m) { const int r = row0 + ai * HALF + m * 16; float s = 0.f;
#pragma unroll
                for (int bj = 0; bj < 2; ++bj) { const size_t off = (size_t)r * 1024 + col0 + bj * HALF;
                    const f32x4 b0 = *(const f32x4*)(base + off), b1 = *(const f32x4*)(base + off + 4);
                    const f32x4 v0 = b0 + acc[ai][bj][m][0] * alpha, v1 = b1 + acc[ai][bj][m][1] * alpha;
                    *(f32x4*)(out + off) = v0; *(f32x4*)(out + off + 4) = v1; *(u32x4*)(xb + off) = pack8(v0, v1);
                    s += (v0[0] * v0[0] + v0[1] * v0[1]) + (v0[2] * v0[2] + v0[3] * v0[3]) + (v1[0] * v1[0] + v1[1] * v1[1]) + (v1[2] * v1[2] + v1[3] * v1[3]); }
                s += __shfl_xor(s, 16); s += __shfl_xor(s, 32);
                if (fq == 0) ssq[(size_t)r * 16 + u.pn * 4 + wc] = s; }
    }
};
struct EpiMixIn {
    static constexpr bool PERM = true, AFTER_DRAIN = false;
    unsigned char* ws;
    __device__ __forceinline__ void operator()(const f32x4 (&acc)[2][2][4][2], const Unit& u, int wr, int wc, int fr, int fq) const {
        const int row0 = u.pm * BM + wr * 64 + fr, cw = wc * 32 + 8 * fq; const float* ssq = (const float*)(ws + WS_SSQ);
        bf16_t* PR = (bf16_t*)(ws + AR_PR); bf16_t* MQ = (bf16_t*)(ws + AR_MQ); bf16_t* MK = (bf16_t*)(ws + AR_MK); bf16_t* MVT = (bf16_t*)(ws + AR_MVT);
        f32x4 ks[2][2]; ks[0][0] = (f32x4){0.f, 0.f, 0.f, 0.f}; ks[0][1] = ks[0][0]; ks[1][0] = ks[0][0]; ks[1][1] = ks[0][0];
#pragma unroll
        for (int ai = 0; ai < 2; ++ai)
#pragma unroll
            for (int m = 0; m < 4; ++m) { const int r = row0 + ai * HALF + m * 16; const float rs = row_rstd16(ssq, r);
#pragma unroll
                for (int bj = 0; bj < 2; ++bj) { const int c = cw + bj * HALF;
                    f32x4 v0 = acc[ai][bj][m][0] * rs, v1 = acc[ai][bj][m][1] * rs;
                    if (u.pn < 7) *(u32x4*)(PR + (size_t)r * 1792 + u.pn * 256 + c) = pack8(v0, v1);
                    else if (u.pn < 9) { v0 = v0 * MOBA_QSCALE; v1 = v1 * MOBA_QSCALE; *(u32x4*)(MQ + (size_t)r * 512 + (u.pn - 7) * 256 + c) = pack8(v0, v1); }
                    else if (u.pn < 11) { *(u32x4*)(MK + (size_t)r * 512 + (u.pn - 9) * 256 + c) = pack8(v0, v1); ks[bj][0] += v0; ks[bj][1] += v1; }
                    else { const int cc = (u.pn - 11) * 256 + c, hh = cc >> 6, d = cc & 63, b = r >> 11, t = r & 2047;
                        bf16_t* p = MVT + ((size_t)(b * 8 + hh) * 64 + d) * 2048 + (t & ~15) + pos16(t & 15);
                        const u32x4 w = pack8(v0, v1);
                        p[0] = (bf16_t)(w.x & 0xffffu); p[2048] = (bf16_t)(w.x >> 16); p[2 * 2048] = (bf16_t)(w.y & 0xffffu); p[3 * 2048] = (bf16_t)(w.y >> 16);
                        p[4 * 2048] = (bf16_t)(w.z & 0xffffu); p[5 * 2048] = (bf16_t)(w.z >> 16); p[6 * 2048] = (bf16_t)(w.w & 0xffffu); p[7 * 2048] = (bf16_t)(w.w >> 16); }
                } }
        if (u.pn == 9 || u.pn == 10) {
            float* KMS = (float*)(ws + WS_KMS) + ((size_t)u.pm * 2 + wr) * 512 + (u.pn - 9) * 256 + cw;
#pragma unroll
            for (int bj = 0; bj < 2; ++bj)
#pragma unroll
                for (int n = 0; n < 2; ++n) { f32x4 v = ks[bj][n];
#pragma unroll
                    for (int o = 1; o < 16; o <<= 1) { v[0] += __shfl_xor(v[0], o); v[1] += __shfl_xor(v[1], o); v[2] += __shfl_xor(v[2], o); v[3] += __shfl_xor(v[3], o); }
                    if (fr == 0) *(f32x4*)(KMS + bj * HALF + 4 * n) = v; } }
    }
};
struct EpiXQ {
    static constexpr bool PERM = true, AFTER_DRAIN = false;
    unsigned char* ws;
    __device__ __forceinline__ void operator()(const f32x4 (&acc)[2][2][4][2], const Unit& u, int wr, int wc, int fr, int fq) const {
        const int row0 = u.pm * BM + wr * 64 + fr, col0 = u.pn * BM + wc * 32 + 8 * fq; bf16_t* Q = (bf16_t*)(ws + AR_XQ); const float* ssq = (const float*)(ws + WS_SSQ);
#pragma unroll
        for (int ai = 0; ai < 2; ++ai)
#pragma unroll
            for (int m = 0; m < 4; ++m) { const int r = row0 + ai * HALF + m * 16; const float rs = row_rstd16(ssq, r) * XATT_QSCALE;
#pragma unroll
                for (int bj = 0; bj < 2; ++bj) *(u32x4*)(Q + (size_t)r * 1024 + col0 + bj * HALF) = pack8(acc[ai][bj][m][0] * rs, acc[ai][bj][m][1] * rs); }
    }
};
struct EpiKV {
    static constexpr bool PERM = true, AFTER_DRAIN = false;
    unsigned char* ws;
    __device__ __forceinline__ void operator()(const f32x4 (&acc)[2][2][4][2], const Unit& u, int wr, int wc, int fr, int fq) const {
        const int row0 = u.pm * BM + wr * 64 + fr, cw = wc * 32 + 8 * fq; bf16_t* XK = (bf16_t*)(ws + WS_XK); bf16_t* XVT = (bf16_t*)(ws + WS_XVT); const float* memrs = (const float*)(ws + WS_MEMRS);
#pragma unroll
        for (int ai = 0; ai < 2; ++ai)
#pragma unroll
            for (int m = 0; m < 4; ++m) { const int r = row0 + ai * HALF + m * 16; const float rs = memrs[r];
#pragma unroll
                for (int bj = 0; bj < 2; ++bj) { const int c = cw + bj * HALF;
                    const f32x4 v0 = acc[ai][bj][m][0] * rs, v1 = acc[ai][bj][m][1] * rs;
                    if (u.pn < 4) *(u32x4*)(XK + (size_t)r * 1024 + u.pn * 256 + c) = pack8(v0, v1);
                    else { const int hx = u.pn - 4, b = r >> 8, key = r & 255;
                        bf16_t* p = XVT + ((size_t)(b * 4 + hx) * 256 + c) * 256 + (key & ~15) + pos16(key & 15);
                        const u32x4 w = pack8(v0, v1);
                        p[0] = (bf16_t)(w.x & 0xffffu); p[256] = (bf16_t)(w.x >> 16); p[2 * 256] = (bf16_t)(w.y & 0xffffu); p[3 * 256] = (bf16_t)(w.y >> 16);
                        p[4 * 256] = (bf16_t)(w.z & 0xffffu); p[5 * 256] = (bf16_t)(w.z >> 16); p[6 * 256] = (bf16_t)(w.w & 0xffffu); p[7 * 256] = (bf16_t)(w.w >> 16); }
                } }
    }
};

template <class Epi, class Sched, bool ALIGN_EPI = false, bool SP2 = false>
__device__ __forceinline__ void gemm_phase(PG8_LAS unsigned char* lds, const Gemm g, const Sched& S, const Epi& E) {
    int tid_ = threadIdx.x; asm volatile("" : "+v"(tid_));
    const int tid = tid_, wid = __builtin_amdgcn_readfirstlane(tid >> 6), lane = tid & 63, wr = wid >> 2, wc = wid & 3, fr = lane & 15, fq = lane >> 4;
    const int K = g.K, nt = K / BK;
    unsigned voffA[2], voffB[2];
#pragma unroll
    for (int i = 0; i < 2; ++i) { int R, C; stage_rc(tid * 16 + i * 8192, R, C); const int Rb = Epi::PERM ? ((R & ~31) + perm32(R & 31)) : R;
        voffA[i] = (unsigned)(R * K + C) * 2u; voffB[i] = (unsigned)(Rb * K + C) * 2u; }
    const size_t kstep = (size_t)(BK * 2);
    const size_t hstep = (size_t)HALF * K * 2;
    const size_t tstep = 2 * hstep;
    const unsigned ldsw = (unsigned)wid * 1024u;
    const int aoff = lds_byte(wr * 64 + fr, fq * 8), boff = lds_byte(wc * 32 + fr, fq * 8);
#define PG8_SA(b, h) (((b) * 2 + (h)) * HTB)
#define PG8_SB(b, h) ((4 + (b) * 2 + (h)) * HTB)
#define PG8_STAGE(bufoff, gbase, voff) do { _Pragma("unroll") for (int _i = 0; _i < 2; ++_i) \
        __builtin_amdgcn_global_load_lds((const unsigned*)((const char*)(gbase) + (voff)[_i]), (PG8_LAS unsigned*)(lds + (bufoff) + ldsw + _i * 8192), 16, 0, 0); } while (0)
#define PG8_LDA(dst, b, h) do { _Pragma("unroll") for (int m = 0; m < 4; ++m) _Pragma("unroll") for (int k = 0; k < 2; ++k) dst[m][k] = *(const PG8_LAS bf16x8*)(lds + PG8_SA(b, h) + aoff + m * 2048 + k * 1024); } while (0)
#define PG8_LDB(dst, b, h) do { _Pragma("unroll") for (int n = 0; n < 2; ++n) _Pragma("unroll") for (int k = 0; k < 2; ++k) dst[n][k] = *(const PG8_LAS bf16x8*)(lds + PG8_SB(b, h) + boff + n * 2048 + k * 1024); } while (0)
#define PG8_MMA(ai, bj, At, Bt) do { __builtin_amdgcn_s_setprio(1); _Pragma("unroll") for (int m = 0; m < 4; ++m) _Pragma("unroll") for (int n = 0; n < 2; ++n) _Pragma("unroll") for (int k = 0; k < 2; ++k) \
        acc[ai][bj][m][n] = __builtin_amdgcn_mfma_f32_16x16x32_bf16(Bt[n][k], At[m][k], acc[ai][bj][m][n], 0, 0, 0); __builtin_amdgcn_s_setprio(0); } while (0)
#define PG8_WAIT_V(n) asm volatile("s_waitcnt vmcnt(" #n ")" ::: "memory")
#define PG8_WAIT_L(n) asm volatile("s_waitcnt lgkmcnt(" #n ")" ::: "memory")
#define PG8_BAR __builtin_amdgcn_s_barrier()
#define PG8_SCHED __builtin_amdgcn_sched_barrier(0)
    Unit cur, nxt; int ui = 0;
    if (!S.next(0, cur)) return;
    f32x4 acc[2][2][4][2];
#pragma unroll
    for (int a = 0; a < 2; ++a)
#pragma unroll
        for (int b = 0; b < 2; ++b)
#pragma unroll
            for (int m = 0; m < 4; ++m)
#pragma unroll
                for (int n = 0; n < 2; ++n) acc[a][b][m][n] = (f32x4){0.f, 0.f, 0.f, 0.f};
    bf16x8 At[4][2], B0[2][2], B1[2][2];
    const char* cA = (const char*)g.A + (size_t)cur.pm * tstep; const char* cB = (const char*)g.Bt + (size_t)cur.pn * tstep;
    S.a_ready(cur);
    if constexpr (SP2) {
        PG8_STAGE(PG8_SB(0, 0), cB, voffB); PG8_STAGE(PG8_SB(0, 1), cB + hstep, voffB); PG8_STAGE(PG8_SA(0, 0), cA, voffA); PG8_STAGE(PG8_SA(0, 1), cA + hstep, voffA);
        if (wr == 1) PG8_BAR;
        PG8_WAIT_V(2); PG8_BAR;
        PG8_STAGE(PG8_SB(1, 0), cB + kstep, voffB); PG8_STAGE(PG8_SA(1, 0), cA + kstep, voffA); PG8_STAGE(PG8_SB(1, 1), cB + hstep + kstep, voffB);
        PG8_WAIT_V(6); PG8_BAR;
    } else {
        PG8_STAGE(PG8_SB(0, 0), cB, voffB); PG8_STAGE(PG8_SA(0, 0), cA, voffA); PG8_STAGE(PG8_SB(0, 1), cB + hstep, voffB); PG8_STAGE(PG8_SA(0, 1), cA + hstep, voffA);
        if (wr == 1) PG8_BAR;
        PG8_WAIT_V(4); PG8_BAR;
        PG8_STAGE(PG8_SB(1, 0), cB + kstep, voffB); PG8_STAGE(PG8_SA(1, 0), cA + kstep, voffA); PG8_STAGE(PG8_SB(1, 1), cB + hstep + kstep, voffB);
        PG8_WAIT_V(6); PG8_BAR;
    }
    for (;;) {
        const bool has_next = S.next(ui + 1, nxt);
        const char* nA = has_next ? (const char*)g.A + (size_t)nxt.pm * tstep : cA; const char* nB = has_next ? (const char*)g.Bt + (size_t)nxt.pn * tstep : cB;
        for (int t = 0; t < nt; t += 2) {
            const bool last = (t == nt - 2);
            const char* a1 = cA + (size_t)(t + 1) * kstep;
            const char* a2 = last ? nA : cA + (size_t)(t + 2) * kstep; const char* b2 = last ? nB : cB + (size_t)(t + 2) * kstep;
            const char* a3 = a2 + kstep; const char* b3 = b2 + kstep;
            if (last && has_next) S.a_ready(nxt);
            if constexpr (SP2) {
            PG8_LDB(B0, 0, 0); PG8_LDB(B1, 0, 1); PG8_SCHED; PG8_LDA(At, 0, 0); PG8_STAGE(PG8_SA(1, 1), a1 + hstep, voffA);
            PG8_WAIT_V(8); PG8_WAIT_L(0); PG8_BAR; PG8_MMA(0, 0, At, B0); PG8_MMA(0, 1, At, B1); PG8_BAR; PG8_SCHED;
            PG8_LDA(At, 0, 1); PG8_STAGE(PG8_SB(0, 0), b2, voffB); PG8_STAGE(PG8_SB(0, 1), b2 + hstep, voffB); PG8_STAGE(PG8_SA(0, 0), a2, voffA);
            PG8_WAIT_V(8); PG8_WAIT_L(0); PG8_BAR; PG8_MMA(1, 0, At, B0); PG8_MMA(1, 1, At, B1); PG8_BAR; PG8_SCHED;
            PG8_LDB(B0, 1, 0); PG8_LDB(B1, 1, 1); PG8_SCHED; PG8_LDA(At, 1, 0); PG8_STAGE(PG8_SA(0, 1), a2 + hstep, voffA);
            PG8_WAIT_V(8); PG8_WAIT_L(0); PG8_BAR; PG8_MMA(0, 0, At, B0); PG8_MMA(0, 1, At, B1); PG8_BAR; PG8_SCHED;
            PG8_LDA(At, 1, 1); PG8_STAGE(PG8_SB(1, 0), b3, voffB); PG8_STAGE(PG8_SB(1, 1), b3 + hstep, voffB); PG8_STAGE(PG8_SA(1, 0), a3, voffA);
            PG8_WAIT_V(8); PG8_WAIT_L(0); PG8_BAR; PG8_MMA(1, 0, At, B0); PG8_MMA(1, 1, At, B1); PG8_BAR; PG8_SCHED;
            } else {
            PG8_LDB(B0, 0, 0); PG8_SCHED; PG8_LDA(At, 0, 0); PG8_STAGE(PG8_SA(1, 1), a1 + hstep, voffA);
            PG8_WAIT_L(8); PG8_BAR; PG8_WAIT_L(0); PG8_MMA(0, 0, At, B0); PG8_BAR; PG8_SCHED;
            PG8_LDB(B1, 0, 1); PG8_STAGE(PG8_SB(0, 0), b2, voffB);
            PG8_BAR; PG8_WAIT_L(0); PG8_MMA(0, 1, At, B1); PG8_BAR;
            PG8_LDA(At, 0, 1); PG8_STAGE(PG8_SA(0, 0), a2, voffA);
            PG8_BAR; PG8_WAIT_L(0); PG8_MMA(1, 0, At, B0); PG8_BAR; PG8_SCHED;
            PG8_STAGE(PG8_SB(0, 1), b2 + hstep, voffB);
            PG8_WAIT_V(6); PG8_BAR; PG8_MMA(1, 1, At, B1); PG8_BAR;
            PG8_LDB(B0, 1, 0); PG8_SCHED; PG8_LDA(At, 1, 0); PG8_STAGE(PG8_SA(0, 1), a2 + hstep, voffA);
            PG8_WAIT_L(8); PG8_BAR; PG8_WAIT_L(0); PG8_MMA(0, 0, At, B0); PG8_BAR; PG8_SCHED;
            PG8_LDB(B1, 1, 1); PG8_STAGE(PG8_SB(1, 0), b3, voffB);
            PG8_BAR; PG8_WAIT_L(0); PG8_MMA(0, 1, At, B1); PG8_BAR;
            PG8_LDA(At, 1, 1); PG8_STAGE(PG8_SA(1, 0), a3, voffA);
            PG8_BAR; PG8_WAIT_L(0); PG8_MMA(1, 0, At, B0); PG8_BAR; PG8_SCHED;
            PG8_STAGE(PG8_SB(1, 1), b3 + hstep, voffB);
            PG8_WAIT_V(6); PG8_BAR; PG8_MMA(1, 1, At, B1); PG8_BAR;
            }
        }
        if constexpr (ALIGN_EPI) { if (wr == 0) PG8_BAR; }
        if constexpr (!Epi::AFTER_DRAIN) { E(acc, cur, wr, wc, fr, fq); S.done(cur); }
        if (!has_next) break;
#pragma unroll
        for (int a = 0; a < 2; ++a)
#pragma unroll
            for (int b = 0; b < 2; ++b)
#pragma unroll
                for (int m = 0; m < 4; ++m)
#pragma unroll
                    for (int n = 0; n < 2; ++n) acc[a][b][m][n] = (f32x4){0.f, 0.f, 0.f, 0.f};
        cur = nxt; cA = nA; cB = nB; ++ui;
        if constexpr (ALIGN_EPI) { if (wr == 1) PG8_BAR; }
    }
    PG8_WAIT_V(0);
    if constexpr (!ALIGN_EPI) { if (wr == 0) PG8_BAR; }
    PG8_BAR;
    if constexpr (Epi::AFTER_DRAIN) { E.fused(acc, cur, wr, wc, fr, fq, lds, wid, lane); S.done(cur); }
#undef PG8_SA
#undef PG8_SB
#undef PG8_STAGE
#undef PG8_LDA
#undef PG8_LDB
#undef PG8_MMA
#undef PG8_WAIT_V
#undef PG8_WAIT_L
#undef PG8_BAR
#undef PG8_SCHED
}
}

constexpr int NWAVES = 8;
constexpr int LDS_BYTES = 163840, LDSCTL_OFF = LDS_BYTES - 512, MISC_OFF = LDSCTL_OFF + 320, PHASE_LDS = LDSCTL_OFF;
constexpr int SCAN_R = 2, SCAN_NCH = 8;

typedef unsigned short bf16;
typedef unsigned u32x4 __attribute__((ext_vector_type(4)));
typedef unsigned u32x2 __attribute__((ext_vector_type(2)));
typedef float f32x4 __attribute__((ext_vector_type(4)));
typedef float f32x16 __attribute__((ext_vector_type(16)));
typedef short bf16x8 __attribute__((ext_vector_type(8)));
typedef GAS unsigned gu32;
#define RLX_AGENT __ATOMIC_RELAXED, __HIP_MEMORY_SCOPE_AGENT
#define LDS_WAIT() asm volatile("s_waitcnt lgkmcnt(0)" ::: "memory")
#define VM_WAIT() asm volatile("s_waitcnt vmcnt(0)" ::: "memory")
__device__ __forceinline__ float bf2f(unsigned b) { return __uint_as_float(b << 16); }
__device__ __forceinline__ unsigned f2bf(float f) { unsigned u = __builtin_bit_cast(unsigned, f); return (u + 0x7fffu + ((u >> 16) & 1u)) >> 16; }
__device__ __forceinline__ unsigned pk2(float lo, float hi) { return pg8::cvt_pk_bf16(lo, hi); }
__device__ __forceinline__ float wave_sum(float v) {
#pragma unroll
    for (int o = 1; o < 64; o <<= 1) v += __shfl_xor(v, o);
    return v;
}
#define WS8_STEP(o) _Pragma("unroll") for (int q = 0; q < 8; ++q) v[q] += __shfl_xor(v[q], o);
__device__ __forceinline__ void wave_sum8(float (&v)[8]) { WS8_STEP(1) WS8_STEP(2) WS8_STEP(4) WS8_STEP(8) WS8_STEP(16) WS8_STEP(32) }
__device__ __forceinline__ float quad_sum(float x) {
    x += __builtin_bit_cast(float, __builtin_amdgcn_update_dpp(0, __builtin_bit_cast(int, x), 0xB1, 0xF, 0xF, true));
    x += __builtin_bit_cast(float, __builtin_amdgcn_update_dpp(0, __builtin_bit_cast(int, x), 0x4E, 0xF, 0xF, true));
    return x;
}
__device__ __forceinline__ float sigmoidf_(float x) { return __builtin_amdgcn_rcpf(1.0f + __expf(-x)); }
__device__ __forceinline__ int crow(int r, int hi) { return (r & 3) + 8 * (r >> 2) + 4 * hi; }
__device__ __forceinline__ bf16x8 pack_bf16x8(float a0, float a1, float a2, float a3, float a4, float a5, float a6, float a7) {
    u32x4 w; w.x = pk2(a0, a1); w.y = pk2(a2, a3); w.z = pk2(a4, a5); w.w = pk2(a6, a7); return __builtin_bit_cast(bf16x8, w);
}

#define XB_TMO      128
#define XB_XCNT(j)  (256  + 64 * (j))
#define XB_XSUB(j)  (1280 + 64 * (j))
#define XB_XGEN(j)  (2304 + 64 * (j))
#define XB_TOP      3328
#define XB_TOPGEN   3392
#define XCD_BAR_WORDS 3456
#define XB_SPIN_CAP (1u << 18)

__device__ __forceinline__ unsigned xb_ld(unsigned* p)              { return __hip_atomic_load(p, __ATOMIC_RELAXED, __HIP_MEMORY_SCOPE_AGENT); }
__device__ __forceinline__ unsigned xb_add(unsigned* p, unsigned v) { return __hip_atomic_fetch_add(p, v, __ATOMIC_RELAXED, __HIP_MEMORY_SCOPE_AGENT); }
__device__ __forceinline__ unsigned xb_xcc_id() { return (unsigned)__builtin_amdgcn_s_getreg((3 << 11) | 20) & 0xFu; }
#define XB_SPIN(cond, bar) do { unsigned _sp = 0; while (cond) { __builtin_amdgcn_s_sleep(1); \
    if ((++_sp & 255u) == 0u) { if (xb_ld(&(bar)[XB_TMO])) break; if (_sp > XB_SPIN_CAP) { atomicAdd(&(bar)[XB_TMO], 1u); break; } } } } while (0)

struct XcdBarrier {
    unsigned* bar; unsigned x;
    volatile LAS unsigned* st;
};

__device__ __forceinline__ XcdBarrier xcd_barrier_post(unsigned* bar, volatile LAS unsigned* st) {
    XcdBarrier b; b.bar = bar; b.x = xb_xcc_id(); b.st = st;
    if (threadIdx.x == 0) (void)xb_add(&bar[XB_XCNT(b.x)], 1u);
    return b;
}
__device__ __forceinline__ void xcd_barrier_complete(unsigned* bar, unsigned x, unsigned& nloc, unsigned& nx) {
    const unsigned G = gridDim.x * gridDim.y * gridDim.z;
    unsigned sum, cnt, mine, sp = 0u;
    for (;;) {
        sum = 0u; cnt = 0u; mine = 0u;
#pragma unroll
        for (unsigned j = 0; j < 16; ++j) { const unsigned c = xb_ld(&bar[XB_XCNT(j)]); sum += c; cnt += (c > 0u) ? 1u : 0u; mine = (j == x) ? c : mine; }
        if (sum == G) break;
        __builtin_amdgcn_s_sleep(1);
        if ((++sp & 255u) == 0u) { if (xb_ld(&bar[XB_TMO])) break; if (sp > XB_SPIN_CAP) { atomicAdd(&bar[XB_TMO], 1u); break; } }
    }
    nloc = mine > 0u ? mine : 1u; nx = cnt > 0u ? cnt : 1u;
}

__device__ __forceinline__ void xcd_barrier(const XcdBarrier& b) {
    asm volatile("s_waitcnt vmcnt(0)" ::: "memory");
    __syncthreads();
    if (threadIdx.x == 0) {
        unsigned* bar = b.bar;
        __builtin_amdgcn_s_waitcnt(0);
        unsigned nloc = b.st[0], nx = b.st[1];
        if (nloc == 0u) { xcd_barrier_complete(bar, b.x, nloc, nx); b.st[0] = nloc; b.st[1] = nx; }
        const unsigned old = xb_add(&bar[XB_XSUB(b.x)], 1u);
        const unsigned gen = old / nloc;
        if (old + 1u == (gen + 1u) * nloc) {
            __builtin_amdgcn_fence(__ATOMIC_RELEASE, "agent");
            asm volatile("s_waitcnt vmcnt(0)" ::: "memory");
            const unsigned og = xb_add(&bar[XB_TOP], 1u);
            const unsigned tg = og / nx;
            if (og + 1u == (tg + 1u) * nx) xb_add(&bar[XB_TOPGEN], 1u);
            else XB_SPIN(xb_ld(&bar[XB_TOPGEN]) == tg, bar);
            __builtin_amdgcn_fence(__ATOMIC_ACQUIRE, "agent");
            xb_add(&bar[XB_XGEN(b.x)], 1u);
            asm volatile("s_waitcnt vmcnt(0)" ::: "memory");
        } else {
            XB_SPIN(xb_ld(&bar[XB_XGEN(b.x)]) == gen, bar);
            __builtin_amdgcn_fence(__ATOMIC_ACQUIRE, "agent");
            asm volatile("s_waitcnt vmcnt(0)" ::: "memory");
        }
    }
    __syncthreads();
}


struct Args { const float* in[N_IN]; float* out; unsigned char* ws; int ph_lo, ph_hi; };
static_assert(sizeof(Args) == N_IN * 8 + 24, "Args has no padding");
struct Frame {
    LAS unsigned char* lds; volatile LAS unsigned* MISC; gu32* ctl;
    int tid, lane, wave, vcu, G;
    const __attribute__((address_space(4))) struct Args* ka; float* out; unsigned char* ws;
};
#define FIN(i) (F.ka->in[i])
#define PHASE_IDS() do { int t_ = threadIdx.x; asm volatile("" : "+v"(t_)); F.tid = t_; F.lane = t_ & 63; F.wave = __builtin_amdgcn_readfirstlane(t_ >> 6); } while (0)
#define WSP(T, off) ((T*)(F.ws + (off)))

__device__ __forceinline__ void ph_init(Frame& F) {
    PHASE_IDS();
    const int gw = F.vcu * NWAVES + F.wave, NGW = F.G * NWAVES;
    float* bias = WSP(float, WS_BIAS); const float* relb = FIN(I_RELB);
    for (int i = blockIdx.x * 512 + F.tid; i < NH * 2048; i += F.G * 512) { const int h = i >> 11, n = i & 2047; int bkt;
        if (n < 16) bkt = n; else { const float nf = (float)n; const int lg = 16 + (int)(logf(nf / 16.0f) / 4.1588830833596715f * 16.0f); bkt = lg < 31 ? lg : 31; }
        bias[i] = relb[h * 32 + bkt] * LOG2E; }
    const float* mem = FIN(I_MEM); bf16* memb = WSP(bf16, WS_MEMB); float* memrs = WSP(float, WS_MEMRS);
    for (int r = gw; r < MM; r += NGW) { const f32x4* xr = (const f32x4*)(mem + (size_t)r * DM) + F.lane; f32x4 v[4]; float s = 0.f;
#pragma unroll
        for (int j = 0; j < 4; ++j) { v[j] = xr[64 * j]; s += (v[j].x * v[j].x + v[j].y * v[j].y) + (v[j].z * v[j].z + v[j].w * v[j].w); }
        s = wave_sum(s); u32x2* o = (u32x2*)(memb + (size_t)r * DM) + F.lane;
#pragma unroll
        for (int j = 0; j < 4; ++j) { u32x2 w; w.x = pk2(v[j].x, v[j].y); w.y = pk2(v[j].z, v[j].w); o[64 * j] = w; }
        if (F.lane == 0) memrs[r] = __builtin_amdgcn_rsqf(s * (1.0f / DM) + NORM_EPS); }
    const float* x = FIN(I_X); bf16* xb = WSP(bf16, WS_XB); float* ssq = WSP(float, WS_SSQ);
    for (int r = gw; r < M; r += NGW) { const f32x4* xr = (const f32x4*)(x + (size_t)r * DM) + F.lane; f32x4 v[4]; float s = 0.f;
#pragma unroll
        for (int j = 0; j < 4; ++j) { v[j] = xr[64 * j]; s += (v[j].x * v[j].x + v[j].y * v[j].y) + (v[j].z * v[j].z + v[j].w * v[j].w); }
        s = wave_sum(s); u32x2* o = (u32x2*)(xb + (size_t)r * DM) + F.lane;
#pragma unroll
        for (int j = 0; j < 4; ++j) { u32x2 w; w.x = pk2(v[j].x, v[j].y); w.y = pk2(v[j].z, v[j].w); o[64 * j] = w; }
        if (F.lane < 16) ssq[(size_t)r * 16 + F.lane] = F.lane == 0 ? s : 0.f; }
}

__device__ __forceinline__ void conv_item(const float* W, int K, int N, const float* gk, bf16* WT, int item, bool ffn_in, LAS float* scr, int lane) {
    const int nblk = N / 32, kb = item / nblk, nb = item % nblk, k0 = 64 * kb, n0 = 32 * nb;
#pragma unroll 8
    for (int i = 0; i < 32; ++i) { const int kk = 2 * i + (lane >> 5); float w = W[(size_t)(k0 + kk) * N + n0 + (lane & 31)]; if (gk) w *= gk[k0 + kk]; scr[kk * 33 + (lane & 31)] = w; }
    LDS_WAIT(); asm volatile("" ::: "memory");
    int drow0 = n0; if (ffn_in) drow0 = n0 < DFF ? 256 * (n0 / 128) + (n0 % 128) : 256 * ((n0 - DFF) / 128) + 128 + ((n0 - DFF) % 128);
    const int c = lane & 7;
#pragma unroll
    for (int j = 0; j < 4; ++j) { const int n = (lane >> 3) + 8 * j; const LAS float* s = scr + (8 * c) * 33 + n;
        u32x4 o; o.x = pk2(s[0 * 33], s[1 * 33]); o.y = pk2(s[2 * 33], s[3 * 33]); o.z = pk2(s[4 * 33], s[5 * 33]); o.w = pk2(s[6 * 33], s[7 * 33]);
        *(u32x4*)(WT + (size_t)(drow0 + n) * K + k0 + 8 * c) = o; }
    LDS_WAIT(); asm volatile("" ::: "memory");
}
__device__ __forceinline__ void ph_conv(Frame& F, int l) {
    PHASE_IDS();
    LAS float* scr = (LAS float*)(F.lds + F.wave * 16384);
    const int gw = F.vcu * NWAVES + F.wave, NGW = F.G * NWAVES;
    constexpr int I_FIN = (DM / 64) * (2 * DFF / 32), I_FOUT = (DFF / 64) * (DM / 32), I_MI = (DM / 64) * (DPROJ / 32), I_SQ = (DM / 64) * (DM / 32), I_KV = (DM / 64) * (2 * DM / 32);
    constexpr int I_L64 = (64 / 64) * (RW / 32), I_L128 = (128 / 64) * (RW / 32);
    constexpr int NITEMS = 2 * I_FIN + 2 * I_FOUT + I_MI + 3 * I_SQ + I_KV + 2 * I_L64 + I_L128;
    unsigned char* wb = F.ws + WS_W;
    for (int it = gw; it < NITEMS; it += NGW) { int r = it;
        if (r < I_FIN) { conv_item(FIN(I_F1IN) + (size_t)l * DM * 2 * DFF, DM, 2 * DFF, FIN(I_F1G) + l * DM, (bf16*)(wb + W_F1IN), r, true, scr, F.lane); continue; } r -= I_FIN;
        if (r < I_FIN) { conv_item(FIN(I_F2IN) + (size_t)l * DM * 2 * DFF, DM, 2 * DFF, FIN(I_F2G) + l * DM, (bf16*)(wb + W_F2IN), r, true, scr, F.lane); continue; } r -= I_FIN;
        if (r < I_FOUT) { conv_item(FIN(I_F1OUT) + (size_t)l * DFF * DM, DFF, DM, nullptr, (bf16*)(wb + W_F1OUT), r, false, scr, F.lane); continue; } r -= I_FOUT;
        if (r < I_FOUT) { conv_item(FIN(I_F2OUT) + (size_t)l * DFF * DM, DFF, DM, nullptr, (bf16*)(wb + W_F2OUT), r, false, scr, F.lane); continue; } r -= I_FOUT;
        if (r < I_MI) { conv_item(FIN(I_MIXIN) + (size_t)l * DM * DPROJ, DM, DPROJ, FIN(I_MIXG) + l * DM, (bf16*)(wb + W_MIXIN), r, false, scr, F.lane); continue; } r -= I_MI;
        if (r < I_SQ) { conv_item(FIN(I_MIXOUT) + (size_t)l * DM * DM, DM, DM, nullptr, (bf16*)(wb + W_MIXOUT), r, false, scr, F.lane); continue; } r -= I_SQ;
        if (r < I_SQ) { conv_item(FIN(I_WQ) + (size_t)l * DM * DM, DM, DM, FIN(I_XG) + l * DM, (bf16*)(wb + W_WQ), r, false, scr, F.lane); continue; } r -= I_SQ;
        if (r < I_SQ) { conv_item(FIN(I_WO) + (size_t)l * DM * DM, DM, DM, nullptr, (bf16*)(wb + W_WO), r, false, scr, F.lane); continue; } r -= I_SQ;
        if (r < I_KV) { conv_item(FIN(I_WKV) + (size_t)l * DM * 2 * DM, DM, 2 * DM, FIN(I_MEMG) + l * DM, (bf16*)(wb + W_WKV), r, false, scr, F.lane); continue; } r -= I_KV;
        if (r < I_L64) { conv_item(FIN(I_WUP) + (size_t)l * 64 * RW, 64, RW, nullptr, (bf16*)(wb + W_WUPT), r, false, scr, F.lane); continue; } r -= I_L64;
        if (r < I_L64) { conv_item(FIN(I_AUP) + (size_t)l * 64 * RW, 64, RW, nullptr, (bf16*)(wb + W_AUPT), r, false, scr, F.lane); continue; } r -= I_L64;
        conv_item(FIN(I_GUP) + (size_t)l * 128 * RW, 128, RW, nullptr, (bf16*)(wb + W_GUPT), r, false, scr, F.lane);
    }
}

__device__ __forceinline__ void ph_moba(Frame& F) {
    PHASE_IDS();
    constexpr int KROW = 144, KBUF = 64 * KROW, OFF_K = 12288, OFF_V = OFF_K + 2 * KBUF;
    LAS float* kmean = (LAS float*)F.lds;
    LAS float* btab = (LAS float*)(F.lds + 2048);
    volatile LAS unsigned* needw = (volatile LAS unsigned*)(F.lds + 10240);
    const bf16* MQ = WSP(bf16, AR_MQ); const bf16* MK = WSP(bf16, AR_MK); const bf16* MVT = WSP(bf16, AR_MVT); bf16* XB = WSP(bf16, WS_XB); const float* bias = WSP(float, WS_BIAS);
    const int lane = F.lane, r32 = lane & 31, hi = lane >> 5, wave = F.wave, tid = F.tid;
    for (int u = blockIdx.x; u < 512; u += F.G) {
        const int rnd = u >> 8, iu = u & 255, qsel = iu >> 6, bh = iu & 63, qb = rnd == 0 ? 7 - qsel : qsel, b = bh >> 3, hh = bh & 7;
        __syncthreads();
        { const int n = tid >> 6, d = tid & 63;
          if (n < qb) { const float* kp = WSP(float, WS_KMS) + ((size_t)(b * 8 + n) * 2) * 512 + hh * 64 + d; kmean[n * 64 + d] = (kp[0] + kp[512]) * (1.0f / 256.0f); }
          for (int i2 = tid; i2 < 2048; i2 += 512) btab[i2] = bias[hh * 2048 + i2];
          if (tid == 0) needw[0] = 0u; }
        __syncthreads();
        const int q0 = qb * 256 + wave * 32; const size_t tok = (size_t)b * 2048 + q0 + r32;
        bf16x8 qf[4];
#pragma unroll
        for (int s = 0; s < 4; ++s) qf[s] = *(const bf16x8*)(MQ + tok * 512 + hh * 64 + 16 * s + 8 * hi);
        float g[7]; unsigned selmask = 0u;
#pragma unroll
        for (int n = 0; n < 7; ++n) { g[n] = -INFINITY;
            if (n < qb) { float p = 0.f;
#pragma unroll
                for (int s = 0; s < 4; ++s) { const f32x4 k0v = *(const LAS f32x4*)(kmean + n * 64 + 16 * s + 8 * hi), k1v = *(const LAS f32x4*)(kmean + n * 64 + 16 * s + 8 * hi + 4);
                    p += bf2f((unsigned short)qf[s][0]) * k0v[0] + bf2f((unsigned short)qf[s][1]) * k0v[1] + bf2f((unsigned short)qf[s][2]) * k0v[2] + bf2f((unsigned short)qf[s][3]) * k0v[3]
                       + bf2f((unsigned short)qf[s][4]) * k1v[0] + bf2f((unsigned short)qf[s][5]) * k1v[1] + bf2f((unsigned short)qf[s][6]) * k1v[2] + bf2f((unsigned short)qf[s][7]) * k1v[3]; }
                p += __shfl_xor(p, 32); g[n] = p; } }
        if (qb <= 3) selmask = (1u << qb) - 1u;
        else {
#pragma unroll
            for (int n = 0; n < 7; ++n) if (n < qb) { int cnt = 0;
#pragma unroll
                for (int n2 = 0; n2 < 7; ++n2) if (n2 != n && n2 < qb) cnt += (g[n2] > g[n] || (g[n2] == g[n] && n2 < n)) ? 1 : 0;
                if (cnt < 3) selmask |= 1u << n; } }
        unsigned wmask = 0u;
#pragma unroll
        for (int n = 0; n < 7; ++n) if (__ballot((selmask >> n) & 1u) != 0ull) wmask |= 1u << n;
        if (lane == 0 && wmask) __hip_atomic_fetch_or((LAS unsigned*)needw, wmask, __ATOMIC_RELAXED, __HIP_MEMORY_SCOPE_WORKGROUP);
        __syncthreads();
        const unsigned need = needw[0] | (1u << qb);
        float mrun = -INFINITY, lrun = 0.f; f32x16 o0, o1;
#pragma unroll
        for (int i = 0; i < 16; ++i) { o0[i] = 0.f; o1[i] = 0.f; }
        const int qpos = q0 + r32;
        const bf16* Kg = MK + ((size_t)b * 2048 + (tid >> 3)) * 512 + hh * 64 + (tid & 7) * 8;
        const bf16* Vg = MVT + ((size_t)(b * 8 + hh) * 64 + (tid >> 3)) * 2048 + (tid & 7) * 8;
        const int sto = (tid >> 3) * KROW + (tid & 7) * 16;
        int blk = 0; while (!((need >> blk) & 1u)) ++blk;
        int kt = 0, it = 0;
        { const int k0 = blk * 256; const u32x4 kr = *(const u32x4*)(Kg + (size_t)k0 * 512), vr = *(const u32x4*)(Vg + k0);
          *(LAS u32x4*)(F.lds + OFF_K + sto) = kr; *(LAS u32x4*)(F.lds + OFF_V + sto) = vr; }
        __syncthreads();
        while (blk <= qb) {
            int nblk = blk, nkt = kt + 1; if (nkt == 4) { nkt = 0; ++nblk; while (nblk <= qb && !((need >> nblk) & 1u)) ++nblk; }
            const bool more = nblk <= qb; u32x4 kr, vr;
            if (more) { const int k0n = nblk * 256 + nkt * 64; kr = *(const u32x4*)(Kg + (size_t)k0n * 512); vr = *(const u32x4*)(Vg + k0n); }
            const int k0 = blk * 256 + kt * 64; const bool own = blk == qb; const bool selme = own || ((selmask >> blk) & 1u);
            const bool active = own ? (k0 <= q0 + 31) : (__ballot(selme) != 0ull);
            if (active) {
                const LAS unsigned char* kb = F.lds + OFF_K + (it & 1) * KBUF + r32 * KROW + 16 * hi;
                const LAS unsigned char* vb = F.lds + OFF_V + (it & 1) * KBUF + r32 * KROW + 16 * hi;
                const bool h1 = !own || (k0 + 32 <= q0 + 31);
                f32x16 s0, s1;
#pragma unroll
                for (int i = 0; i < 16; ++i) { s0[i] = 0.f; s1[i] = 0.f; }
#pragma unroll
                for (int s = 0; s < 4; ++s) s0 = __builtin_amdgcn_mfma_f32_32x32x16_bf16(*(const LAS bf16x8*)(kb + 32 * s), qf[s], s0, 0, 0, 0);
                if (h1) {
#pragma unroll
                    for (int s = 0; s < 4; ++s) s1 = __builtin_amdgcn_mfma_f32_32x32x16_bf16(*(const LAS bf16x8*)(kb + 32 * KROW + 32 * s), qf[s], s1, 0, 0, 0); }
                float mx = -INFINITY;
                float bv0[16], bv1[16];
#pragma unroll
                for (int r = 0; r < 16; ++r) { const int d0 = qpos - (k0 + crow(r, hi)), d1 = d0 - 32; bv0[r] = btab[d0 < 0 ? 0 : d0]; bv1[r] = btab[d1 < 0 ? 0 : d1]; }
#pragma unroll
                for (int r = 0; r < 16; ++r) asm volatile("" : "+v"(bv0[r]), "+v"(bv1[r]));
#pragma unroll
                for (int r = 0; r < 16; ++r) { const int d0 = qpos - (k0 + crow(r, hi)), d1 = d0 - 32;
                    const bool v0 = selme && (!own || d0 >= 0), v1 = h1 && selme && (!own || d1 >= 0);
                    const float a0 = v0 ? s0[r] + bv0[r] : -INFINITY, a1 = v1 ? s1[r] + bv1[r] : -INFINITY;
                    s0[r] = a0; s1[r] = a1; mx = fmaxf(mx, fmaxf(a0, a1)); }
                mx = fmaxf(mx, __shfl_xor(mx, 32));
                const float mnew = fmaxf(mrun, mx), muse = (mnew == -INFINITY) ? 0.f : mnew;
                const float alpha = __builtin_amdgcn_exp2f(mrun - muse);
                float ps = 0.f;
#pragma unroll
                for (int r = 0; r < 16; ++r) { const float p0 = __builtin_amdgcn_exp2f(s0[r] - muse), p1 = __builtin_amdgcn_exp2f(s1[r] - muse); s0[r] = p0; s1[r] = p1; ps += p0 + p1; }
                lrun = lrun * alpha + ps; mrun = mnew;
#pragma unroll
                for (int i = 0; i < 16; ++i) { o0[i] *= alpha; o1[i] *= alpha; }
                const bf16x8 pa0 = pack_bf16x8(s0[0], s0[1], s0[2], s0[3], s0[4], s0[5], s0[6], s0[7]), pa1 = pack_bf16x8(s0[8], s0[9], s0[10], s0[11], s0[12], s0[13], s0[14], s0[15]);
                o0 = __builtin_amdgcn_mfma_f32_32x32x16_bf16(*(const LAS bf16x8*)(vb), pa0, o0, 0, 0, 0); o0 = __builtin_amdgcn_mfma_f32_32x32x16_bf16(*(const LAS bf16x8*)(vb + 32), pa1, o0, 0, 0, 0);
                o1 = __builtin_amdgcn_mfma_f32_32x32x16_bf16(*(const LAS bf16x8*)(vb + 32 * KROW), pa0, o1, 0, 0, 0); o1 = __builtin_amdgcn_mfma_f32_32x32x16_bf16(*(const LAS bf16x8*)(vb + 32 * KROW + 32), pa1, o1, 0, 0, 0);
                if (h1) {
                    const bf16x8 pb0 = pack_bf16x8(s1[0], s1[1], s1[2], s1[3], s1[4], s1[5], s1[6], s1[7]), pb1 = pack_bf16x8(s1[8], s1[9], s1[10], s1[11], s1[12], s1[13], s1[14], s1[15]);
                    o0 = __builtin_amdgcn_mfma_f32_32x32x16_bf16(*(const LAS bf16x8*)(vb + 64), pb0, o0, 0, 0, 0); o0 = __builtin_amdgcn_mfma_f32_32x32x16_bf16(*(const LAS bf16x8*)(vb + 96), pb1, o0, 0, 0, 0);
                    o1 = __builtin_amdgcn_mfma_f32_32x32x16_bf16(*(const LAS bf16x8*)(vb + 32 * KROW + 64), pb0, o1, 0, 0, 0); o1 = __builtin_amdgcn_mfma_f32_32x32x16_bf16(*(const LAS bf16x8*)(vb + 32 * KROW + 96), pb1, o1, 0, 0, 0); }
            }
            if (more) { *(LAS u32x4*)(F.lds + OFF_K + ((it + 1) & 1) * KBUF + sto) = kr; *(LAS u32x4*)(F.lds + OFF_V + ((it + 1) & 1) * KBUF + sto) = vr; }
            __syncthreads();
            blk = nblk; kt = nkt; ++it;
        }
        lrun += __shfl_xor(lrun, 32); const float inv = 1.0f / lrun;
        bf16* op = XB + tok * 1024 + 512 + hh * 64 + 4 * hi;
#pragma unroll
        for (int g4 = 0; g4 < 4; ++g4) { u32x2 w0, w1; w0.x = pk2(o0[4 * g4] * inv, o0[4 * g4 + 1] * inv); w0.y = pk2(o0[4 * g4 + 2] * inv, o0[4 * g4 + 3] * inv);
            w1.x = pk2(o1[4 * g4] * inv, o1[4 * g4 + 1] * inv); w1.y = pk2(o1[4 * g4 + 2] * inv, o1[4 * g4 + 3] * inv);
            *(u32x2*)(op + 8 * g4) = w0; *(u32x2*)(op + 32 + 8 * g4) = w1; }
    }
}

__device__ __forceinline__ void ph_xatt(Frame& F) {
    PHASE_IDS();
    constexpr int KROW = 528, KBUF = 32 * KROW, VROW = 80, VBUF = 256 * VROW, OFF_K = 0, OFF_V = 2 * KBUF;
    const bf16* XQ = WSP(bf16, AR_XQ); const bf16* XK = WSP(bf16, WS_XK); const bf16* XVT = WSP(bf16, WS_XVT); bf16* XO = WSP(bf16, AR_XO);
    const int lane = F.lane, r32 = lane & 31, hi = lane >> 5, wave = F.wave, tid = F.tid;
    for (int u = blockIdx.x; u < 256; u += F.G) {
        const int b = u >> 5, hx = (u >> 3) & 3, qt = u & 7;
        const size_t tok = (size_t)b * 2048 + qt * 256 + wave * 32 + r32;
        const bf16* Qg = XQ + tok * 1024 + hx * 256 + 8 * hi;
        const bf16* Kg = XK + (size_t)(b * 256 + (tid >> 5)) * 1024 + hx * 256 + (tid & 31) * 8;
        const bf16* Vg = XVT + ((size_t)(b * 4 + hx) * 256 + (tid >> 2)) * 256 + (tid & 3) * 8;
        const int ksto = (tid >> 5) * KROW + (tid & 31) * 16, vsto = (tid >> 2) * VROW + (tid & 3) * 16;
        float mrun = -INFINITY, lrun = 0.f; f32x16 o[8];
#pragma unroll
        for (int dt = 0; dt < 8; ++dt)
#pragma unroll
            for (int i = 0; i < 16; ++i) o[dt][i] = 0.f;
        __syncthreads();
        { const u32x4 k0r = *(const u32x4*)(Kg), k1r = *(const u32x4*)(Kg + (size_t)16 * 1024), v0r = *(const u32x4*)(Vg), v1r = *(const u32x4*)(Vg + (size_t)128 * 256);
          *(LAS u32x4*)(F.lds + OFF_K + ksto) = k0r; *(LAS u32x4*)(F.lds + OFF_K + ksto + 16 * KROW) = k1r; *(LAS u32x4*)(F.lds + OFF_V + vsto) = v0r; *(LAS u32x4*)(F.lds + OFF_V + vsto + 128 * VROW) = v1r; }
        __syncthreads();
        for (int kt = 0; kt < 8; ++kt) {
            const bool more = kt + 1 < 8; const int k0n = (kt + 1) * 32; u32x4 s0r, s1r;
            if (more) { s0r = *(const u32x4*)(Kg + (size_t)k0n * 1024); s1r = *(const u32x4*)(Kg + (size_t)(k0n + 16) * 1024); }
            const LAS unsigned char* kb = F.lds + OFF_K + (kt & 1) * KBUF + r32 * KROW + 16 * hi;
            const LAS unsigned char* vb = F.lds + OFF_V + (kt & 1) * VBUF + r32 * VROW + 16 * hi;
            f32x16 sc;
#pragma unroll
            for (int i = 0; i < 16; ++i) sc[i] = 0.f;
            bf16x8 qa[4], qb[4];
#pragma unroll
            for (int s = 0; s < 4; ++s) qa[s] = *(const bf16x8*)(Qg + 16 * s);
#pragma unroll
            for (int s = 0; s < 4; ++s) qb[s] = *(const bf16x8*)(Qg + 64 + 16 * s);
#pragma unroll
            for (int s = 0; s < 4; ++s) sc = __builtin_amdgcn_mfma_f32_32x32x16_bf16(*(const LAS bf16x8*)(kb + 32 * s), qa[s], sc, 0, 0, 0);
            asm volatile("" ::: "memory");
#pragma unroll
            for (int s = 0; s < 4; ++s) qa[s] = *(const bf16x8*)(Qg + 128 + 16 * s);
#pragma unroll
            for (int s = 0; s < 4; ++s) sc = __builtin_amdgcn_mfma_f32_32x32x16_bf16(*(const LAS bf16x8*)(kb + 128 + 32 * s), qb[s], sc, 0, 0, 0);
            asm volatile("" ::: "memory");
#pragma unroll
            for (int s = 0; s < 4; ++s) qb[s] = *(const bf16x8*)(Qg + 192 + 16 * s);
#pragma unroll
            for (int s = 0; s < 4; ++s) sc = __builtin_amdgcn_mfma_f32_32x32x16_bf16(*(const LAS bf16x8*)(kb + 256 + 32 * s), qa[s], sc, 0, 0, 0);
            asm volatile("" ::: "memory");
#pragma unroll
            for (int s = 0; s < 4; ++s) sc = __builtin_amdgcn_mfma_f32_32x32x16_bf16(*(const LAS bf16x8*)(kb + 384 + 32 * s), qb[s], sc, 0, 0, 0);
            if (more) { LAS unsigned char* kd = F.lds + OFF_K + ((kt + 1) & 1) * KBUF + ksto; *(LAS u32x4*)(kd) = s0r; *(LAS u32x4*)(kd + 16 * KROW) = s1r;
                s0r = *(const u32x4*)(Vg + k0n); s1r = *(const u32x4*)(Vg + (size_t)128 * 256 + k0n); }
            float mx = sc[0];
#pragma unroll
            for (int r = 1; r < 16; ++r) mx = fmaxf(mx, sc[r]);
            mx = fmaxf(mx, __shfl_xor(mx, 32));
            const float mnew = fmaxf(mrun, mx), alpha = __builtin_amdgcn_exp2f(mrun - mnew);
            float ps = 0.f;
#pragma unroll
            for (int r = 0; r < 16; ++r) { const float p = __builtin_amdgcn_exp2f(sc[r] - mnew); sc[r] = p; ps += p; }
            lrun = lrun * alpha + ps; mrun = mnew;
            const bf16x8 pf0 = pack_bf16x8(sc[0], sc[1], sc[2], sc[3], sc[4], sc[5], sc[6], sc[7]), pf1 = pack_bf16x8(sc[8], sc[9], sc[10], sc[11], sc[12], sc[13], sc[14], sc[15]);
#pragma unroll
            for (int dt = 0; dt < 8; ++dt) {
#pragma unroll
                for (int i = 0; i < 16; ++i) o[dt][i] *= alpha;
                o[dt] = __builtin_amdgcn_mfma_f32_32x32x16_bf16(*(const LAS bf16x8*)(vb + dt * 32 * VROW), pf0, o[dt], 0, 0, 0);
                o[dt] = __builtin_amdgcn_mfma_f32_32x32x16_bf16(*(const LAS bf16x8*)(vb + dt * 32 * VROW + 32), pf1, o[dt], 0, 0, 0); }
            if (more) { LAS unsigned char* vd = F.lds + OFF_V + ((kt + 1) & 1) * VBUF + vsto; *(LAS u32x4*)(vd) = s0r; *(LAS u32x4*)(vd + 128 * VROW) = s1r; }
            __syncthreads();
        }
        lrun += __shfl_xor(lrun, 32); const float inv = 1.0f / lrun;
        bf16* op = XO + tok * 1024 + hx * 256 + 4 * hi;
#pragma unroll
        for (int dt = 0; dt < 8; ++dt)
#pragma unroll
            for (int g4 = 0; g4 < 4; ++g4) { u32x2 w; w.x = pk2(o[dt][4 * g4] * inv, o[dt][4 * g4 + 1] * inv); w.y = pk2(o[dt][4 * g4 + 2] * inv, o[dt][4 * g4 + 3] * inv);
                *(u32x2*)(op + 32 * dt + 8 * g4) = w; }
    }
}

__device__ __forceinline__ void ph_prep(Frame& F, int l) {
    PHASE_IDS();
    constexpr int SROW = 3080, OFF_LAT = 33 * SROW + 8, LROW = 528, OFF_PAR = OFF_LAT + 32 * LROW;
    static_assert(OFF_LAT % 16 == 0 && OFF_PAR % 16 == 0 && OFF_PAR + 8 * 512 * 4 <= PHASE_LDS, "prep LDS map");
    LAS unsigned char* rows = F.lds; LAS unsigned char* lat = F.lds + OFF_LAT; LAS float* par = (LAS float*)(F.lds + OFF_PAR);
    const bf16* PR = WSP(bf16, AR_PR); bf16* SCANIN = WSP(bf16, AR_SCANIN); bf16* SV = WSP(bf16, AR_SV); bf16* XB = WSP(bf16, WS_XB); float* BONUS = WSP(float, WS_BONUS);
    const bf16* WUPT = (const bf16*)(F.ws + WS_W + W_WUPT); const bf16* AUPT = (const bf16*)(F.ws + WS_W + W_AUPT); const bf16* GUPT = (const bf16*)(F.ws + WS_W + W_GUPT);
    const int h = F.wave, lane = F.lane, r32 = lane & 31, hi = lane >> 5, tid = F.tid;
    const float* mu = FIN(I_MU) + l * RPROJ;
    __syncthreads();
    { const int c = tid;
      par[c] = mu[c]; par[512 + c] = mu[512 + c]; par[1024 + c] = mu[1024 + c]; par[1536 + c] = FIN(I_W0)[l * RW + c]; par[2048 + c] = FIN(I_A0)[l * RW + c];
      par[2560 + c] = FIN(I_KK)[l * RW + c]; par[3072 + c] = FIN(I_KA)[l * RW + c]; par[3584 + c] = FIN(I_RK)[l * RW + c]; }
    for (int task = blockIdx.x; task < M / 32; task += F.G) { const int t0 = task * 32;
        __syncthreads();
        {
          u32x4 st[13];
#pragma unroll
          for (int i = 0; i < 13; ++i) { const int q = tid + 512 * i; st[i] = (u32x4){0u, 0u, 0u, 0u};
              if (q < 33 * 192) { const int row = q / 192, c16 = q - row * 192; if (row > 0 || (t0 & 2047) != 0) st[i] = *(const u32x4*)(PR + (size_t)(t0 - 1 + row) * RPROJ + c16 * 8); } }
#pragma unroll
          for (int i = 0; i < 13; ++i) { const int q = tid + 512 * i;
              if (q < 33 * 192) { const int row = q / 192, c16 = q - row * 192; LAS unsigned char* d = rows + row * SROW + c16 * 16; *(LAS u32x2*)d = (u32x2){st[i].x, st[i].y}; *(LAS u32x2*)(d + 8) = (u32x2){st[i].z, st[i].w}; } } }
        {
          const int tt = tid >> 4, l16 = (tid & 15) * 16, t = t0 + tt; const bf16* pc = PR + (size_t)t * RPROJ + 1536 + l16;
          u32x4 cur[2], prv[2]; cur[0] = *(const u32x4*)pc; cur[1] = *(const u32x4*)(pc + 8); prv[0] = (u32x4){0u, 0u, 0u, 0u}; prv[1] = prv[0];
          if (t & 2047) { prv[0] = *(const u32x4*)(pc - RPROJ); prv[1] = *(const u32x4*)(pc - RPROJ + 8); }
          u32x4 ow[2];
#pragma unroll
          for (int hh = 0; hh < 2; ++hh) { const f32x4 m0 = *(const f32x4*)(mu + 1536 + l16 + 8 * hh), m1 = *(const f32x4*)(mu + 1536 + l16 + 8 * hh + 4); float xv[8];
#pragma unroll
              for (int i = 0; i < 4; ++i) { const unsigned cw = cur[hh][i], pw = prv[hh][i]; const float p0 = bf2f(cw & 0xffffu), p1 = bf2f(cw >> 16), q0 = bf2f(pw & 0xffffu), q1 = bf2f(pw >> 16);
                  const float ma = i < 2 ? m0[2 * i] : m1[2 * i - 4], mb = i < 2 ? m0[2 * i + 1] : m1[2 * i - 3];
                  xv[2 * i] = p0 + (q0 - p0) * ma; xv[2 * i + 1] = p1 + (q1 - p1) * mb; }
#pragma unroll
              for (int i = 0; i < 8; ++i) { if (l16 < 64) xv[i] = 1.0f - 2.0f * __builtin_amdgcn_rcpf(1.0f + __expf(2.0f * xv[i])); else if (l16 >= 128) xv[i] = sigmoidf_(xv[i]); }
              ow[hh] = (u32x4){pk2(xv[0], xv[1]), pk2(xv[2], xv[3]), pk2(xv[4], xv[5]), pk2(xv[6], xv[7])}; }
          *(LAS u32x4*)(lat + tt * LROW + l16 * 2) = ow[0]; *(LAS u32x4*)(lat + tt * LROW + l16 * 2 + 16) = ow[1]; }
        __syncthreads();
        const int t = t0 + r32, bb = t >> 11, tp = t & 2047, bh = bb * 8 + h;
        const LAS unsigned char* rc = rows + (r32 + 1) * SROW; const LAS unsigned char* rp = rows + r32 * SROW;
        float n2 = 0.f, bon = 0.f;
#pragma unroll
        for (int q = 0; q < 8; ++q) { const int c4 = h * 64 + 8 * q + 4 * hi;
            const u32x2 kc = *(const LAS u32x2*)(rc + (512 + c4) * 2), kp = *(const LAS u32x2*)(rp + (512 + c4) * 2);
            const f32x4 mk = *(const LAS f32x4*)(par + 512 + c4), kkc = *(const LAS f32x4*)(par + 2560 + c4);
#pragma unroll
            for (int i = 0; i < 4; ++i) { const unsigned sh = (i & 1) * 16; float k = bf2f((kc[i >> 1] >> sh) & 0xffffu); const float kq = bf2f((kp[i >> 1] >> sh) & 0xffffu);
                k += (kq - k) * mk[i]; const float kk = k * kkc[i]; n2 += kk * kk; } }
        n2 += __shfl_xor(n2, 32);
        const float inv = 1.0f / fmaxf(sqrtf(n2), 1e-12f);
        bf16* so = SCANIN + ((size_t)(bh * 64 + (tp >> 5)) * 10) * 1024 + lane * 16;
#pragma unroll 1
        for (int ct = 0; ct < 2; ++ct) { const int cb = h * 64 + 32 * ct;
            f32x16 aw, aa, ag;
#pragma unroll
            for (int i = 0; i < 16; ++i) { aw[i] = 0.f; aa[i] = 0.f; ag[i] = 0.f; }
            const LAS unsigned char* lb = lat + r32 * LROW + 16 * hi;
#pragma unroll
            for (int s = 0; s < 4; ++s) { const bf16x8 wf = *(const bf16x8*)(WUPT + (size_t)(cb + r32) * 64 + 16 * s + 8 * hi), af = *(const bf16x8*)(AUPT + (size_t)(cb + r32) * 64 + 16 * s + 8 * hi);
                const bf16x8 lw = *(const LAS bf16x8*)(lb + 32 * s), la = *(const LAS bf16x8*)(lb + 128 + 32 * s);
                aw = __builtin_amdgcn_mfma_f32_32x32x16_bf16(wf, lw, aw, 0, 0, 0); aa = __builtin_amdgcn_mfma_f32_32x32x16_bf16(af, la, aa, 0, 0, 0); }
#pragma unroll
            for (int s = 0; s < 8; ++s) { const bf16x8 gf = *(const bf16x8*)(GUPT + (size_t)(cb + r32) * 128 + 16 * s + 8 * hi); const bf16x8 lg = *(const LAS bf16x8*)(lb + 256 + 32 * s);
                ag = __builtin_amdgcn_mfma_f32_32x32x16_bf16(gf, lg, ag, 0, 0, 0); }
            unsigned onk[8], old_[8], obv[8], okt[8], orr[8];
#pragma unroll
            for (int g = 0; g < 4; ++g) { const int c4 = cb + 8 * g + 4 * hi;
                const u32x2 rcv = *(const LAS u32x2*)(rc + c4 * 2), kcv = *(const LAS u32x2*)(rc + (512 + c4) * 2), vcv = *(const LAS u32x2*)(rc + (1024 + c4) * 2);
                const u32x2 rpv = *(const LAS u32x2*)(rp + c4 * 2), kpv = *(const LAS u32x2*)(rp + (512 + c4) * 2), vpv = *(const LAS u32x2*)(rp + (1024 + c4) * 2);
                const f32x4 mr = *(const LAS f32x4*)(par + c4), mk = *(const LAS f32x4*)(par + 512 + c4), mv = *(const LAS f32x4*)(par + 1024 + c4);
                const f32x4 w0v = *(const LAS f32x4*)(par + 1536 + c4), a0v = *(const LAS f32x4*)(par + 2048 + c4), kkc = *(const LAS f32x4*)(par + 2560 + c4), kac = *(const LAS f32x4*)(par + 3072 + c4), rkc = *(const LAS f32x4*)(par + 3584 + c4);
                float ro[4], ko[4], vo[4], ldo[4], go[4], nk[4], bo[4];
#pragma unroll
                for (int i = 0; i < 4; ++i) { const unsigned sh = (i & 1) * 16;
                    float r = bf2f((rcv[i >> 1] >> sh) & 0xffffu), k = bf2f((kcv[i >> 1] >> sh) & 0xffffu), v = bf2f((vcv[i >> 1] >> sh) & 0xffffu);
                    const float rq = bf2f((rpv[i >> 1] >> sh) & 0xffffu), kq = bf2f((kpv[i >> 1] >> sh) & 0xffffu), vq = bf2f((vpv[i >> 1] >> sh) & 0xffffu);
                    r += (rq - r) * mr[i]; k += (kq - k) * mk[i]; v += (vq - v) * mv[i];
                    const float wv = w0v[i] + aw[4 * g + i], xs = -wv, sp = xs > 20.f ? xs : __logf(1.0f + __expf(xs)), ld = -__expf(-sp - 0.5f);
                    const float a = sigmoidf_(a0v[i] + aa[4 * g + i]);
                    const float kn = k * kkc[i] * inv, kt = k * (1.0f + (a - 1.0f) * kac[i]);
                    bon += r * kt * rkc[i];
                    ro[i] = r; ko[i] = kt; vo[i] = v; ldo[i] = ld; go[i] = ag[4 * g + i]; nk[i] = -kn; bo[i] = kn * a; }
                onk[2 * g] = pk2(nk[0], nk[1]); onk[2 * g + 1] = pk2(nk[2], nk[3]); old_[2 * g] = pk2(ldo[0], ldo[1]); old_[2 * g + 1] = pk2(ldo[2], ldo[3]);
                obv[2 * g] = pk2(bo[0], bo[1]); obv[2 * g + 1] = pk2(bo[2], bo[3]); okt[2 * g] = pk2(ko[0], ko[1]); okt[2 * g + 1] = pk2(ko[2], ko[3]);
                orr[2 * g] = pk2(ro[0], ro[1]); orr[2 * g + 1] = pk2(ro[2], ro[3]);
                *(u32x2*)(SV + ((size_t)bh * 2048 + tp) * 64 + 32 * ct + 8 * g + 4 * hi) = (u32x2){pk2(vo[0], vo[1]), pk2(vo[2], vo[3])};
                *(u32x2*)(XB + (size_t)t * 1024 + c4) = (u32x2){pk2(go[0], go[1]), pk2(go[2], go[3])}; }
            bf16* sq = so + ct * 1024;
            *(u32x4*)(sq) = (u32x4){onk[0], onk[1], onk[2], onk[3]}; *(u32x4*)(sq + 8) = (u32x4){onk[4], onk[5], onk[6], onk[7]};
            *(u32x4*)(sq + 2048) = (u32x4){old_[0], old_[1], old_[2], old_[3]}; *(u32x4*)(sq + 2048 + 8) = (u32x4){old_[4], old_[5], old_[6], old_[7]};
            *(u32x4*)(sq + 4096) = (u32x4){obv[0], obv[1], obv[2], obv[3]}; *(u32x4*)(sq + 4096 + 8) = (u32x4){obv[4], obv[5], obv[6], obv[7]};
            *(u32x4*)(sq + 6144) = (u32x4){okt[0], okt[1], okt[2], okt[3]}; *(u32x4*)(sq + 6144 + 8) = (u32x4){okt[4], okt[5], okt[6], okt[7]};
            *(u32x4*)(sq + 8192) = (u32x4){orr[0], orr[1], orr[2], orr[3]}; *(u32x4*)(sq + 8192 + 8) = (u32x4){orr[4], orr[5], orr[6], orr[7]};
        }
        bon += __shfl_xor(bon, 32);
        if (hi == 0) BONUS[(size_t)t * 8 + h] = bon;
    }
}

template <int R, int NCH, bool KINDP>
__device__ __forceinline__ void scan_stream(Frame& F, LAS float* ring, int bh, int ch, int rg, int lis) {
    typedef float f32x2 __attribute__((ext_vector_type(2)));
    constexpr int CLEN = SEQ / NCH, NHALF = CLEN / 8;
    const int lane = F.lane, js = lane & 3, q = lane >> 2, row0 = rg * 16 * R + q * R, tbase = ch * CLEN;
    const bf16* src5 = WSP(bf16, AR_SCANIN) + (size_t)bh * 64 * 10 * 1024; const bf16* srcv = WSP(bf16, AR_SV) + (size_t)bh * 2048 * 64;
    float* YL = WSP(float, AR_YLOC) + ((size_t)bh * 2048 + tbase) * 64; bf16* ZZ = WSP(bf16, AR_Z) + ((size_t)bh * 2048 + tbase) * 64;
    int soff[2], doff[2]; bool isv[2], isld[2], cval[2];
#pragma unroll
    for (int k = 0; k < 2; ++k) { int ci = lis + k * 256; cval[k] = ci < 384; if (!cval[k]) ci = lis; isv[k] = ci >= 320;
        const int run = ci >> 4, vec = run >> 2, ct = (run >> 1) & 1, hi2 = run & 1, tok = (ci & 15) >> 1, hf16 = ci & 1, cv = ci - 320;
        isld[k] = !isv[k] && vec == 1;
        soff[k] = isv[k] ? (cv >> 3) * 64 + (cv & 7) * 8 : ((vec * 2 + ct) * 64 + hi2 * 32 + tok) * 16 + 8 * hf16;
        doff[k] = isv[k] ? (cv >> 3) * 384 + 320 + (cv & 7) * 8 : tok * 384 + vec * 64 + 32 * ct + 16 * hf16 + 4 * hi2; }
#define SCAN_LOAD(hfx) do { const int tg_ = tbase + (hfx) * 8; _Pragma("unroll") for (int k = 0; k < 2; ++k) {   \
        const bf16* p_ = isv[k] ? srcv + (size_t)tg_ * 64 + soff[k] : src5 + (size_t)(tg_ >> 5) * 10240 + (tg_ & 31) * 16 + soff[k]; pre[k] = *(const u32x4*)p_; } } while (0)
#define SCAN_WRITE(hfx) do { _Pragma("unroll") for (int k = 0; k < 2; ++k) if (cval[k]) { float f[8]; \
        _Pragma("unroll") for (int i = 0; i < 4; ++i) { f[2 * i] = bf2f(pre[k][i] & 0xffffu); f[2 * i + 1] = bf2f(pre[k][i] >> 16); } \
        if (isld[k]) { _Pragma("unroll") for (int i = 0; i < 8; ++i) f[i] = __expf(f[i]); } \
        LAS float* d_ = ring + (((hfx) & 1) * 8) * 384 + doff[k]; \
        *(LAS f32x4*)(d_) = (f32x4){f[0], f[1], f[2], f[3]}; *(LAS f32x4*)(d_ + (isv[k] ? 4 : 8)) = (f32x4){f[4], f[5], f[6], f[7]}; } } while (0)
    f32x2 S[R][8];
#pragma unroll
    for (int rr = 0; rr < R; ++rr)
#pragma unroll
        for (int k = 0; k < 8; ++k) { S[rr][k].x = (KINDP && (row0 + rr) == 16 * js + 2 * k) ? 1.f : 0.f; S[rr][k].y = (KINDP && (row0 + rr) == 16 * js + 2 * k + 1) ? 1.f : 0.f; }
    u32x4 pre[2];
    SCAN_LOAD(0); SCAN_WRITE(0);
    __syncthreads();
    for (int hf = 0; hf < NHALF; ++hf) {
        const bool more = hf + 1 < NHALF;
        if (more) SCAN_LOAD(hf + 1);
#pragma unroll 2
        for (int st = 0; st < 8; ++st) {
            const LAS float* sp = ring + ((hf & 1) * 8 + st) * 384 + 16 * js;
            f32x2 nn[8], ww[8], bb[8], kk[8], rr2[8];
#pragma unroll
            for (int i = 0; i < 4; ++i) { const f32x4 a = *(const LAS f32x4*)(sp + 4 * i); nn[2 * i] = (f32x2){a[0], a[1]}; nn[2 * i + 1] = (f32x2){a[2], a[3]}; }
#pragma unroll
            for (int i = 0; i < 4; ++i) { const f32x4 a = *(const LAS f32x4*)(sp + 64 + 4 * i); ww[2 * i] = (f32x2){a[0], a[1]}; ww[2 * i + 1] = (f32x2){a[2], a[3]}; }
#pragma unroll
            for (int i = 0; i < 4; ++i) { const f32x4 a = *(const LAS f32x4*)(sp + 128 + 4 * i); bb[2 * i] = (f32x2){a[0], a[1]}; bb[2 * i + 1] = (f32x2){a[2], a[3]}; }
            if (!KINDP) {
#pragma unroll
                for (int i = 0; i < 4; ++i) { const f32x4 a = *(const LAS f32x4*)(sp + 192 + 4 * i); kk[2 * i] = (f32x2){a[0], a[1]}; kk[2 * i + 1] = (f32x2){a[2], a[3]}; } }
#pragma unroll
            for (int i = 0; i < 4; ++i) { const f32x4 a = *(const LAS f32x4*)(sp + 256 + 4 * i); rr2[2 * i] = (f32x2){a[0], a[1]}; rr2[2 * i + 1] = (f32x2){a[2], a[3]}; }
            float vv[R];
            if (!KINDP) {
#pragma unroll
                for (int rr = 0; rr < R; ++rr) vv[rr] = ring[((hf & 1) * 8 + st) * 384 + 320 + row0 + rr]; }
            float sa[R];
#pragma unroll
            for (int rr = 0; rr < R; ++rr) { f32x2 p0 = S[rr][0] * nn[0], p1 = S[rr][1] * nn[1];
#pragma unroll
                for (int k = 2; k < 8; k += 2) { p0 = S[rr][k] * nn[k] + p0; p1 = S[rr][k + 1] * nn[k + 1] + p1; }
                p0 = p0 + p1; sa[rr] = quad_sum(p0.x + p0.y); }
            float y[R];
#pragma unroll
            for (int rr = 0; rr < R; ++rr) { const f32x2 sa2 = (f32x2){sa[rr], sa[rr]}; f32x2 p0 = (f32x2){0.f, 0.f}, p1 = (f32x2){0.f, 0.f};
#pragma unroll
                for (int k = 0; k < 8; k += 2) {
                    f32x2 t0 = S[rr][k] * ww[k], t1 = S[rr][k + 1] * ww[k + 1];
                    t0 = sa2 * bb[k] + t0; t1 = sa2 * bb[k + 1] + t1;
                    if (!KINDP) { const f32x2 v2 = (f32x2){vv[rr], vv[rr]}; t0 = v2 * kk[k] + t0; t1 = v2 * kk[k + 1] + t1; }
                    S[rr][k] = t0; S[rr][k + 1] = t1; p0 = t0 * rr2[k] + p0; p1 = t1 * rr2[k + 1] + p1; }
                p0 = p0 + p1; y[rr] = quad_sum(p0.x + p0.y); }
            if (js == 0) { const int t = hf * 8 + st;
                if (R == 2) { if (KINDP) *(unsigned*)(ZZ + (size_t)t * 64 + row0) = pk2(y[0], y[R - 1]); else *(f32x2*)(YL + (size_t)t * 64 + row0) = (f32x2){y[0], y[R - 1]}; }
                else {
#pragma unroll
                    for (int rr = 0; rr < R; ++rr) { if (KINDP) ZZ[(size_t)t * 64 + row0 + rr] = (bf16)f2bf(y[rr]); else YL[(size_t)t * 64 + row0 + rr] = y[rr]; } } }
        }
        if (more) SCAN_WRITE(hf + 1);
        __syncthreads();
    }
#undef SCAN_LOAD
#undef SCAN_WRITE
    if (NCH > 1) {
        float* st = WSP(float, AR_STATE) + ((size_t)(bh * NCH + ch) * 2 + (KINDP ? 0 : 1)) * 4096;
#pragma unroll
        for (int rr = 0; rr < R; ++rr)
#pragma unroll
            for (int i = 0; i < 4; ++i) *(f32x4*)(st + (size_t)(row0 + rr) * 64 + 16 * js + 4 * i) = (f32x4){S[rr][2 * i].x, S[rr][2 * i].y, S[rr][2 * i + 1].x, S[rr][2 * i + 1].y};
    }
}
template <int R, int NCH>
__device__ __forceinline__ void ph_scan(Frame& F) {
    PHASE_IDS();
    constexpr int KINDS = NCH > 1 ? 2 : 1, RG = 4 / R, WPS = KINDS * RG, SPW = NWAVES / WPS, NSTREAM = BATCH * NH * NCH;
    static_assert(WPS == 4, "staging assumes 4 waves per stream");
    const int sl = F.wave / WPS, role = F.wave % WPS, kind = role / RG, rg = role % RG, lis = role * 64 + F.lane;
    LAS float* ring = (LAS float*)F.lds + sl * (16 * 384);
    for (int it = blockIdx.x; it * SPW < NSTREAM; it += F.G) {
        const int sid = it * SPW + sl, bh = sid / NCH, ch = sid % NCH;
        __syncthreads();
        if (kind == 0) scan_stream<R, NCH, false>(F, ring, bh, ch, rg, lis); else scan_stream<R, NCH, true>(F, ring, bh, ch, rg, lis);
    }
}

template <int NCH>
__device__ __forceinline__ void ph_fix(Frame& F) {
    PHASE_IDS();
    typedef float f32x2 __attribute__((ext_vector_type(2)));
    LAS float* cur = (LAS float*)F.lds;
    for (int u = blockIdx.x; u < 256; u += F.G) { const int bh = u >> 2, rgx = u & 3, i = F.tid >> 5, j2 = (F.tid & 31) * 2, row = rgx * 16 + i;
        float* base = WSP(float, AR_STATE) + (size_t)bh * NCH * 2 * 4096;
        __syncthreads();
        { const f32x2 v = *(const f32x2*)(base + 4096 + row * 64 + j2); cur[i * 64 + j2] = v.x; cur[i * 64 + j2 + 1] = v.y; }
        __syncthreads();
        for (int c = 1; c < NCH - 1; ++c) { const float* P = base + (size_t)(c * 2) * 4096; float* SL = base + (size_t)(c * 2 + 1) * 4096;
            f32x2 acc = *(const f32x2*)(SL + row * 64 + j2);
#pragma unroll
            for (int ii = 0; ii < 64; ++ii) { const float sv = cur[i * 64 + ii]; const f32x2 p = *(const f32x2*)(P + ii * 64 + j2); acc.x += sv * p.x; acc.y += sv * p.y; }
            __syncthreads();
            cur[i * 64 + j2] = acc.x; cur[i * 64 + j2 + 1] = acc.y; *(f32x2*)(SL + row * 64 + j2) = acc;
            __syncthreads(); }
    }
}

template <int NCH>
__device__ __forceinline__ void ph_post(Frame& F, int l) {
    PHASE_IDS();
    constexpr int CLEN = SEQ / NCH;
    const float* YL = WSP(float, AR_YLOC); const bf16* SV = WSP(bf16, AR_SV); bf16* XB = WSP(bf16, WS_XB); const float* BONUS = WSP(float, WS_BONUS); const bf16* ZZ = WSP(bf16, AR_Z);
    LAS float* zt = (LAS float*)F.lds;
    const int c = F.tid, h = F.wave, j = F.lane; const float lng = FIN(I_LNG)[l * RW + c], lnb = FIN(I_LNB)[l * RW + c];
    for (int grp = blockIdx.x; grp < M / 64; grp += F.G) { const int t0g = grp * 64, bb = t0g >> 11, ch = (t0g & 2047) / CLEN, bh = bb * 8 + h; const bool corr = NCH > 1 && ch > 0;
        float st[64];
        if (corr) { const float* sp = WSP(float, AR_STATE) + ((size_t)(bh * NCH + ch - 1) * 2 + 1) * 4096 + j * 64;
#pragma unroll
            for (int i4 = 0; i4 < 16; ++i4) { const f32x4 v = *(const f32x4*)(sp + 4 * i4); st[4 * i4] = v[0]; st[4 * i4 + 1] = v[1]; st[4 * i4 + 2] = v[2]; st[4 * i4 + 3] = v[3]; } }
        for (int ti = 0; ti < 4; ++ti) { const int t0 = t0g + 16 * ti;
            if (corr) { __syncthreads();
#pragma unroll 4
                for (int tt = 0; tt < 16; ++tt) zt[tt * 512 + c] = bf2f(ZZ[((size_t)bh * 2048 + ((t0 + tt) & 2047)) * 64 + j]);
                __syncthreads(); }
#pragma unroll 1
            for (int tb = 0; tb < 16; tb += 8) {
                float yv[8], vv[8], bv[8], gv[8];
#pragma unroll
                for (int q = 0; q < 8; ++q) { const int t = t0 + tb + q, tp = t & 2047;
                    yv[q] = YL[((size_t)bh * 2048 + tp) * 64 + j]; vv[q] = bf2f(SV[((size_t)bh * 2048 + tp) * 64 + j]); bv[q] = BONUS[(size_t)t * 8 + h]; gv[q] = bf2f(XB[(size_t)t * 1024 + c]); }
                if (corr) {
#pragma unroll
                    for (int q = 0; q < 8; ++q) { const LAS float* zp = zt + (tb + q) * 512 + h * 64; float p0 = 0.f, p1 = 0.f, p2 = 0.f, p3 = 0.f;
#pragma unroll
                        for (int qq = 0; qq < 4; ++qq) { asm volatile("" ::: "memory");
                            f32x4 zz[4];
#pragma unroll
                            for (int e = 0; e < 4; ++e) zz[e] = *(const LAS f32x4*)(zp + 16 * qq + 4 * e);
#pragma unroll
                            for (int e = 0; e < 4; ++e) { const int j4 = 4 * qq + e; p0 += st[4 * j4] * zz[e][0]; p1 += st[4 * j4 + 1] * zz[e][1]; p2 += st[4 * j4 + 2] * zz[e][2]; p3 += st[4 * j4 + 3] * zz[e][3]; }
                            asm volatile("" : "+v"(p0), "+v"(p1), "+v"(p2), "+v"(p3)); }
                        yv[q] += (p0 + p1) + (p2 + p3); } }
                float mean[8], var[8];
#pragma unroll
                for (int q = 0; q < 8; ++q) mean[q] = yv[q];
                wave_sum8(mean);
#pragma unroll
                for (int q = 0; q < 8; ++q) { mean[q] *= (1.0f / 64.0f); yv[q] -= mean[q]; var[q] = yv[q] * yv[q]; }
                wave_sum8(var);
#pragma unroll
                for (int q = 0; q < 8; ++q) { const int t = t0 + tb + q;
                    const float yn = yv[q] * __builtin_amdgcn_rsqf(var[q] * (1.0f / 64.0f) + LNX_EPS) * lng + lnb;
                    XB[(size_t)t * 1024 + c] = (bf16)f2bf((yn + bv[q] * vv[q]) * gv[q]); }
            }
        }
    }
}

__device__ __forceinline__ void ph_final(Frame& F) {
    PHASE_IDS();
    const int gw = F.vcu * NWAVES + F.wave, NGW = F.G * NWAVES; const float* ssq = WSP(float, WS_SSQ); const float* g = FIN(I_FING);
    f32x4 gv[4];
#pragma unroll
    for (int j = 0; j < 4; ++j) gv[j] = ((const f32x4*)g)[F.lane + 64 * j];
    for (int r = gw; r < M; r += NGW) { const float rs = pg8::row_rstd16(ssq, r); f32x4* xr = (f32x4*)(F.out + (size_t)r * DM) + F.lane;
#pragma unroll
        for (int j = 0; j < 4; ++j) { const f32x4 v = xr[64 * j]; xr[64 * j] = v * rs * gv[j]; } }
}

constexpr int PH_INIT = 0, PH_PER_LAYER = 16, PH_FINAL = 1 + DEPTH * PH_PER_LAYER, N_PHASES = PH_FINAL + 1;
enum { K_CONV = 0, K_KV, K_F1UP, K_F1DN, K_MIXIN, K_MOBA, K_PREP, K_SCAN, K_FIX, K_POST, K_MIXOUT, K_XQ, K_XATT, K_XO, K_F2UP, K_F2DN };

#ifdef ONLY
#define PH_ON(k) ((k) == (ONLY))
#else
#define PH_ON(k) true
#endif
__global__ void __launch_bounds__(NWAVES * 64, 2) fwd(Args args) {
    extern __shared__ __attribute__((aligned(16))) unsigned char lds[];
    Frame F;
    F.lds = (LAS unsigned char*)lds; F.MISC = (volatile LAS unsigned*)(F.lds + MISC_OFF);
    F.tid = threadIdx.x; F.lane = F.tid & 63; F.wave = __builtin_amdgcn_readfirstlane(F.tid >> 6);
    F.G = gridDim.x; { const int bx = blockIdx.x; F.vcu = (F.G % 8 == 0) ? (bx % 8) * (F.G / 8) + bx / 8 : bx; }
    F.out = args.out; F.ws = args.ws; F.ctl = (gu32*)(args.ws + WS_CTL);
    F.ka = (const __attribute__((address_space(4))) Args*)(uintptr_t)__builtin_amdgcn_kernarg_segment_ptr();
    for (int u = F.tid; u < (LDS_BYTES - LDSCTL_OFF) / 4; u += NWAVES * 64) ((LAS unsigned*)(F.lds + LDSCTL_OFF))[u] = 0u;
    __syncthreads();
    const bool multi = args.ph_hi - args.ph_lo > 1;
    XcdBarrier bar; bar.bar = (unsigned*)(F.ctl + 4096); bar.x = 0; bar.st = nullptr;
    if (multi) bar = xcd_barrier_post((unsigned*)(F.ctl + 4096), F.MISC + 8);
#ifndef REP_AT
#define REP_AT 1000
#endif
    for (int pi = args.ph_lo; pi < args.ph_hi + (REP_AT < 1000 ? 1 : 0); ++pi) { const int ph = pi - (pi > REP_AT ? 1 : 0);
        { uintptr_t kp = (uintptr_t)__builtin_amdgcn_kernarg_segment_ptr(); asm volatile("" : "+s"(kp)); F.ka = (const __attribute__((address_space(4))) Args*)kp; }
        unsigned char* wb = F.ws + WS_W;
        if (ph == PH_INIT) { if (PH_ON(100)) { ph_init(F); ph_conv(F, 0); } }
        else if (ph == PH_FINAL) { if (PH_ON(101)) ph_final(F); }
        else { const int l = (ph - 1) / PH_PER_LAYER, k = (ph - 1) % PH_PER_LAYER;
            const float* xin = (l == 0) ? FIN(I_X) : (const float*)F.out;
            switch (k) {
            case K_CONV: if (!PH_ON(K_CONV)) break; if (l > 0) ph_conv(F, l); break;
            case K_KV: break;
            case K_F1UP: case K_F2UP: if (!PH_ON(K_F1UP)) break; { pg8::Gemm g{WSP(bf16, WS_XB), (const bf16*)(wb + (k == K_F1UP ? W_F1IN : W_F2IN)), M, 2 * DFF, DM}; pg8::StaticOrder S; S.init(M, 2 * DFF, F.G, (int)blockIdx.x);
                pg8::EpiSwiGLU E{F.ws}; pg8::gemm_phase<pg8::EpiSwiGLU, pg8::StaticOrder, true, true>(F.lds, g, S, E); } break;
            case K_F1DN: case K_F2DN: if (!PH_ON(K_F1DN)) break; { pg8::Gemm g{WSP(bf16, AR_H), (const bf16*)(wb + (k == K_F1DN ? W_F1OUT : W_F2OUT)), M, DM, DFF}; pg8::StaticOrder S; S.init(M, DM, F.G, (int)blockIdx.x);
                pg8::EpiResid E{k == K_F1DN ? xin : (const float*)F.out, F.out, F.ws, WS_XB, 0.5f}; pg8::gemm_phase<pg8::EpiResid, pg8::StaticOrder, true, true>(F.lds, g, S, E); } break;
            case K_MIXIN: if (!PH_ON(K_MIXIN)) break; { pg8::Gemm g{WSP(bf16, WS_XB), (const bf16*)(wb + W_MIXIN), M, DPROJ, DM}; pg8::StaticOrder S; S.init(M, DPROJ, F.G, (int)blockIdx.x);
                pg8::EpiMixIn E{F.ws}; pg8::gemm_phase<pg8::EpiMixIn, pg8::StaticOrder, true, true>(F.lds, g, S, E); }
                {
                  pg8::Gemm g{WSP(bf16, WS_MEMB), (const bf16*)(wb + W_WKV), MM, 2 * DM, DM}; pg8::StaticOrder S; S.init(MM, 2 * DM, F.G, (int)((blockIdx.x + F.G - 64) % F.G));
                  pg8::EpiKV E{F.ws}; pg8::gemm_phase<pg8::EpiKV, pg8::StaticOrder, true, true>(F.lds, g, S, E); } break;
            case K_MOBA: if (!PH_ON(K_MOBA)) break; ph_moba(F); break;
            case K_PREP: if (!PH_ON(K_PREP)) break; ph_prep(F, l); break;
            case K_SCAN: if (!PH_ON(K_SCAN)) break; ph_scan<SCAN_R, SCAN_NCH>(F); break;
            case K_FIX: if (!PH_ON(K_FIX)) break; if (SCAN_NCH > 1) ph_fix<SCAN_NCH>(F); break;
            case K_POST: if (!PH_ON(K_POST)) break; ph_post<SCAN_NCH>(F, l); break;
            case K_MIXOUT: if (!PH_ON(K_MIXOUT)) break; { pg8::Gemm g{WSP(bf16, WS_XB), (const bf16*)(wb + W_MIXOUT), M, DM, DM}; pg8::StaticOrder S; S.init(M, DM, F.G, (int)blockIdx.x);
                pg8::EpiResid E{F.out, F.out, F.ws, AR_XB2, 1.0f}; pg8::gemm_phase<pg8::EpiResid, pg8::StaticOrder, true, true>(F.lds, g, S, E); } break;
            case K_XQ: if (!PH_ON(K_XQ)) break; { pg8::Gemm g{WSP(bf16, AR_XB2), (const bf16*)(wb + W_WQ), M, DM, DM}; pg8::StaticOrder S; S.init(M, DM, F.G, (int)blockIdx.x);
                pg8::EpiXQ E{F.ws}; pg8::gemm_phase<pg8::EpiXQ, pg8::StaticOrder, true, true>(F.lds, g, S, E); } break;
            case K_XATT: if (!PH_ON(K_XATT)) break; ph_xatt(F); break;
            case K_XO: if (!PH_ON(K_XO)) break; { pg8::Gemm g{WSP(bf16, AR_XO), (const bf16*)(wb + W_WO), M, DM, DM}; pg8::StaticOrder S; S.init(M, DM, F.G, (int)blockIdx.x);
                pg8::EpiResid E{F.out, F.out, F.ws, WS_XB, 1.0f}; pg8::gemm_phase<pg8::EpiResid, pg8::StaticOrder, true, true>(F.lds, g, S, E); } break;
            default: break;
            }
        }
        if (pi + 1 < args.ph_hi + (REP_AT < 1000 ? 1 : 0)) {
            const int kk_ = (ph - 1) % PH_PER_LAYER, ll_ = (ph - 1) / PH_PER_LAYER;
            const bool noop = ph != PH_INIT && ph != PH_FINAL && ((kk_ == K_FIX && SCAN_NCH == 1) || kk_ == K_KV || (kk_ == K_CONV && ll_ == 0));
            if (!noop) { if (ph == PH_INIT) cooperative_groups::this_grid().sync(); else xcd_barrier(bar); }
        }
    }
}

extern "C" void kernel_launch(void* const* d_in, const int* in_sizes, int n_in, void* d_out, int out_size, void* d_ws, size_t ws_size, hipStream_t stream) {
    static int grid = 0;
    if (grid == 0) {
        if (n_in != N_IN || in_sizes[0] != M * DM || out_size != M * DM || ws_size < WS_END) { fprintf(stderr, "kernel_launch: unexpected problem (n_in %d, in0 %d, out %d, ws %zu < %zu); nothing launched\n", n_in, n_in > 0 ? in_sizes[0] : -1, out_size, ws_size, (size_t)WS_END); grid = -1; return; }
        int dev = 0, cus = 0;
        if (hipGetDevice(&dev) != hipSuccess || hipDeviceGetAttribute(&cus, hipDeviceAttributeMultiprocessorCount, dev) != hipSuccess) { grid = -1; return; }
        if (hipFuncSetAttribute((const void*)fwd, hipFuncAttributeMaxDynamicSharedMemorySize, LDS_BYTES) != hipSuccess) { fprintf(stderr, "kernel_launch: hipFuncSetAttribute failed\n"); grid = -1; return; }
        int per_cu = 0;
        if (hipOccupancyMaxActiveBlocksPerMultiprocessor(&per_cu, (const void*)fwd, NWAVES * 64, LDS_BYTES) != hipSuccess || per_cu < 1) { fprintf(stderr, "kernel_launch: occupancy query reports %d workgroups per CU; nothing launched\n", per_cu); grid = -1; return; }
        grid = cus;
    }
    if (grid < 0) return;
    (void)hipMemsetAsync((char*)d_ws + WS_CTL, 0, CTL_ZERO_BYTES, stream);
    Args a{};
    for (int i = 0; i < N_IN; ++i) a.in[i] = (const float*)d_in[i];
    a.out = (float*)d_out; a.ws = (unsigned char*)d_ws;
    a.ph_lo = 0; a.ph_hi = N_PHASES;
    void* kargs[] = {&a};
    const hipError_t e = hipLaunchCooperativeKernel((const void*)fwd, dim3(grid), dim3(NWAVES * 64), kargs, LDS_BYTES, stream);
    if (e != hipSuccess) fprintf(stderr, "kernel_launch: cooperative launch failed: %s (grid %d)\n", hipGetErrorString(e), grid);
}
```

```cpp
#include <hip/hip_runtime.h>
#include <hip/hip_cooperative_groups.h>
#include <cstdio>
#include <cstdint>

constexpr int BATCH = 8, SEQ = 2048, DM = 1024, DEPTH = 2, M = BATCH * SEQ;
constexpr int RW = 512, NH = 8, HD = 64;
constexpr int RPROJ = 1792, DPROJ = 3328;
constexpr int DFF = 2816;
constexpr int MEMLEN = 256, XH = 4, XHD = 256, MM = BATCH * MEMLEN;
constexpr int MBLK = 256, NBLK = SEQ / MBLK;
constexpr float NORM_EPS = 1e-6f, LNX_EPS = 64e-5f;
constexpr float LOG2E = 1.4426950408889634f;
constexpr float MOBA_QSCALE = 0.125f * LOG2E;
constexpr float XATT_QSCALE = 0.0625f * LOG2E;

enum { I_X = 0, I_MEM, I_RELB, I_FING, I_F1G, I_F1IN, I_F1OUT, I_MIXG, I_MIXIN, I_MIXOUT, I_MU, I_W0, I_WUP, I_A0, I_AUP, I_GUP, I_KK, I_KA, I_RK, I_LNG, I_LNB,
       I_XG, I_MEMG, I_WQ, I_WKV, I_WO, I_F2G, I_F2IN, I_F2OUT, N_IN };

constexpr size_t MiB = 1u << 20;
constexpr size_t WS_CTL = 0, CTL_ZERO_BYTES = 1 * MiB;
constexpr size_t WS_BIAS = 1 * MiB;
constexpr size_t WS_MEMRS = WS_BIAS + 64 * 1024;
constexpr size_t WS_BONUS = WS_MEMRS + 64 * 1024;
constexpr size_t WS_KMS = WS_BONUS + 512 * 1024;
constexpr size_t WS_SSQ = 2 * MiB;
constexpr size_t WS_MEMB = 3 * MiB;
constexpr size_t WS_XK = 7 * MiB, WS_XVT = 11 * MiB;
constexpr size_t WS_W = 15 * MiB;
constexpr size_t W_F1IN = 0, W_F1OUT = W_F1IN + (size_t)2 * DFF * DM * 2, W_F2IN = W_F1OUT + (size_t)DM * DFF * 2, W_F2OUT = W_F2IN + (size_t)2 * DFF * DM * 2,
                 W_MIXIN = W_F2OUT + (size_t)DM * DFF * 2, W_MIXOUT = W_MIXIN + (size_t)DPROJ * DM * 2, W_WQ = W_MIXOUT + (size_t)DM * DM * 2, W_WKV = W_WQ + (size_t)DM * DM * 2,
                 W_WO = W_WKV + (size_t)2 * DM * DM * 2, W_WUPT = W_WO + (size_t)DM * DM * 2, W_AUPT = W_WUPT + (size_t)RW * 64 * 2, W_GUPT = W_AUPT + (size_t)RW * 64 * 2, W_END = W_GUPT + (size_t)RW * 128 * 2;
static_assert(W_END <= 50 * MiB, "weights fit");
constexpr size_t WS_XB = 65 * MiB;
constexpr size_t WS_AR = 97 * MiB;
constexpr size_t AR_H = WS_AR;
constexpr size_t AR_PR = WS_AR, AR_MQ = WS_AR + 56 * MiB, AR_MK = WS_AR + 72 * MiB, AR_MVT = WS_AR + 88 * MiB;
constexpr size_t AR_SCANIN = WS_AR + 56 * MiB;
constexpr size_t AR_SV = WS_AR + 136 * MiB;
constexpr size_t AR_YLOC = WS_AR, AR_Z = WS_AR + 32 * MiB;
constexpr size_t AR_STATE = WS_AR + 152 * MiB;
constexpr size_t AR_XB2 = WS_AR, AR_XQ = WS_AR + 32 * MiB, AR_XO = WS_AR + 64 * MiB;
constexpr size_t WS_END = WS_AR + 168 * MiB;

#define GAS __attribute__((address_space(1)))
#define LAS __attribute__((address_space(3)))

namespace pg8 {
#define PG8_LAS __attribute__((address_space(3)))
typedef unsigned short bf16_t;
typedef short bf16x8 __attribute__((ext_vector_type(8)));
typedef float f32x4 __attribute__((ext_vector_type(4)));
typedef unsigned u32x4 __attribute__((ext_vector_type(4)));
constexpr int BM = 256, BK = 64, HALF = 128, HTB = HALF * BK * 2  , STAGE_BYTES = 8 * HTB, NXCD = 8, WGM = 8;

__host__ __device__ __forceinline__ int lds_byte(int r, int c) { const int st = (r >> 4) * 2 + (c >> 5), rr = r & 15, cc = c & 31, ob = rr * 64 + cc * 2; return st * 1024 + (ob ^ (((ob >> 9) & 1) << 5)); }
__host__ __device__ __forceinline__ void stage_rc(int b, int& R, int& C) { const int st = b / 1024, sb = b % 1024, swz = sb ^ (((sb >> 9) & 1) << 5); R = (st >> 1) * 16 + swz / 64; C = (st & 1) * 32 + (swz % 64) / 2; }
__host__ __device__ __forceinline__ int perm32(int rho) { const int n = rho >> 4, i = rho & 15; return 8 * (i >> 2) + 4 * n + (i & 3); }

struct Unit { int pm, pn; };
struct Gemm { const bf16_t* A; const bf16_t* Bt; int M, N, K; };

struct StaticOrder {
    int nM, nN, nwg, G, c;
    __host__ __device__ void init(int M, int N, int G_, int c_) { nM = M / BM; nN = N / BM; nwg = nM * nN; G = G_; c = c_; }
    __host__ __device__ bool next(int i, Unit& u) const {
        const long L = (long)i * G + c; if (L >= nwg) return false;
        int wgid = (int)L; { const int q = nwg / NXCD, r = nwg % NXCD, xcd = wgid % NXCD, off = wgid / NXCD; wgid = (xcd < r ? xcd * (q + 1) : r * (q + 1) + (xcd - r) * q) + off; }
        const int nig = WGM * nN, gid = wgid / nig, fm = gid * WGM, gsz = (nM - fm) < WGM ? (nM - fm) : WGM;
        u.pm = fm + ((wgid % nig) % gsz); u.pn = (wgid % nig) / gsz; return true;
    }
    __device__ __forceinline__ void a_ready(const Unit&) const {}
    __device__ __forceinline__ void done(const Unit&) const {}
};

__device__ __forceinline__ unsigned cvt_pk_bf16(float lo, float hi) { unsigned r; asm volatile("v_cvt_pk_bf16_f32 %0, %1, %2" : "=v"(r) : "v"(lo), "v"(hi)); return r; }
typedef float f32x2 __attribute__((ext_vector_type(2)));
__device__ __forceinline__ float row_rstd16(const float* ssq, int r) {
    const f32x4* p = (const f32x4*)(ssq + (size_t)r * 16);
    const f32x4 a = p[0], b = p[1], c = p[2], d = p[3];
    const float s = ((a[0] + a[1]) + (a[2] + a[3])) + ((b[0] + b[1]) + (b[2] + b[3])) + ((c[0] + c[1]) + (c[2] + c[3])) + ((d[0] + d[1]) + (d[2] + d[3]));
    return __builtin_amdgcn_rsqf(s * (1.0f / 1024.0f) + 1e-6f);
}
__device__ __forceinline__ float silu_mul(float g, float u) { return g * __builtin_amdgcn_rcpf(1.0f + __expf(-g)) * u; }
__device__ __forceinline__ u32x4 pack8(const f32x4 v0, const f32x4 v1) { u32x4 w; w.x = cvt_pk_bf16(v0[0], v0[1]); w.y = cvt_pk_bf16(v0[2], v0[3]); w.z = cvt_pk_bf16(v1[0], v1[1]); w.w = cvt_pk_bf16(v1[2], v1[3]); return w; }
__device__ __forceinline__ int pos16(int k) { return 8 * ((k >> 2) & 1) + (k & 3) + 4 * (k >> 3); }

struct EpiSwiGLU {
    static constexpr bool PERM = true, AFTER_DRAIN = false;
    unsigned char* ws;
    __device__ __forceinline__ void operator()(const f32x4 (&acc)[2][2][4][2], const Unit& u, int wr, int wc, int fr, int fq) const {
        const int row0 = u.pm * BM + wr * 64 + fr, hcol = u.pn * 128 + wc * 32 + 8 * fq; bf16_t* H = (bf16_t*)(ws + AR_H); const float* ssq = (const float*)(ws + WS_SSQ);
#pragma unroll
        for (int ai = 0; ai < 2; ++ai)
#pragma unroll
            for (int m = 0; m < 4; ++m) { const int r = row0 + ai * HALF + m * 16; const float rs = row_rstd16(ssq, r);
                f32x4 h0, h1;
#pragma unroll
                for (int i = 0; i < 4; ++i) { h0[i] = silu_mul(acc[ai][0][m][0][i] * rs, acc[ai][1][m][0][i] * rs); h1[i] = silu_mul(acc[ai][0][m][1][i] * rs, acc[ai][1][m][1][i] * rs); }
                *(u32x4*)(H + (size_t)r * 2816 + hcol) = pack8(h0, h1); }
    }
};
struct EpiResid {
    static constexpr bool PERM = true, AFTER_DRAIN = false;
    const float* base; float* out; unsigned char* ws; size_t xb_off; float alpha;
    __device__ __forceinline__ void operator()(const f32x4 (&acc)[2][2][4][2], const Unit& u, int wr, int wc, int fr, int fq) const {
        const int row0 = u.pm * BM + wr * 64 + fr, col0 = u.pn * BM + wc * 32 + 8 * fq; bf16_t* xb = (bf16_t*)(ws + xb_off); float* ssq = (float*)(ws + WS_SSQ);
#pragma unroll
        for (int ai = 0; ai < 2; ++ai)
#pragma unroll
            for (int m = 0; m < 4; ++m) { const int r = row0 + ai * HALF + m * 16; float s = 0.f;
#pragma unroll
                for (int bj = 0; bj < 2; ++bj) { const size_t off = (size_t)r * 1024 + col0 + bj * HALF;
                    const f32x4 b0 = *(const f32x4*)(base + off), b1 = *(const f32x4*)(base + off + 4);
                    const f32x4 v0 = b0 + acc[ai][bj][m][0] * alpha, v1 = b1 + acc[ai][bj][m][1] * alpha;
                    *(f32x4*)(out + off) = v0; *(f32x4*)(out + off + 4) = v1; *(u32x4*)(xb + off) = pack8(v0, v1);
                    s += (v0[0] * v0[0] + v0[1] * v0[1]) + (v0[2] * v0[2] + v0[3] * v0[3]) + (v1[0] * v1[0] + v1[1] * v1[1]) + (v1[2] * v1[2] + v1[3] * v1[3]); }
                s += __shfl_xor(s, 16); s += __shfl_xor(s, 32);
                if (fq == 0) ssq[(size_t)r * 16 + u.pn * 4 + wc] = s; }
    }
};
struct EpiMixIn {
    static constexpr bool PERM = true, AFTER_DRAIN = false;
    unsigned char* ws;
    __device__ __forceinline__ void operator()(const f32x4 (&acc)[2][2][4][2], const Unit& u, int wr, int wc, int fr, int fq) const {
        const int row0 = u.pm * BM + wr * 64 + fr, cw = wc * 32 + 8 * fq; const float* ssq = (const float*)(ws + WS_SSQ);
        bf16_t* PR = (bf16_t*)(ws + AR_PR); bf16_t* MQ = (bf16_t*)(ws + AR_MQ); bf16_t* MK = (bf16_t*)(ws + AR_MK); bf16_t* MVT = (bf16_t*)(ws + AR_MVT);
        f32x4 ks[2][2]; ks[0][0] = (f32x4){0.f, 0.f, 0.f, 0.f}; ks[0][1] = ks[0][0]; ks[1][0] = ks[0][0]; ks[1][1] = ks[0][0];
#pragma unroll
        for (int ai = 0; ai < 2; ++ai)
#pragma unroll
            for (int m = 0; m < 4; ++m) { const int r = row0 + ai * HALF + m * 16; const float rs = row_rstd16(ssq, r);
#pragma unroll
                for (int bj = 0; bj < 2; ++bj) { const int c = cw + bj * HALF;
                    f32x4 v0 = acc[ai][bj][m][0] * rs, v1 = acc[ai][bj][m][1] * rs;
                    if (u.pn < 7) *(u32x4*)(PR + (size_t)r * 1792 + u.pn * 256 + c) = pack8(v0, v1);
                    else if (u.pn < 9) { v0 = v0 * MOBA_QSCALE; v1 = v1 * MOBA_QSCALE; *(u32x4*)(MQ + (size_t)r * 512 + (u.pn - 7) * 256 + c) = pack8(v0, v1); }
                    else if (u.pn < 11) { *(u32x4*)(MK + (size_t)r * 512 + (u.pn - 9) * 256 + c) = pack8(v0, v1); ks[bj][0] += v0; ks[bj][1] += v1; }
                    else { const int cc = (u.pn - 11) * 256 + c, hh = cc >> 6, d = cc & 63, b = r >> 11, t = r & 2047;
                        bf16_t* p = MVT + ((size_t)(b * 8 + hh) * 64 + d) * 2048 + (t & ~15) + pos16(t & 15);
                        const u32x4 w = pack8(v0, v1);
                        p[0] = (bf16_t)(w.x & 0xffffu); p[2048] = (bf16_t)(w.x >> 16); p[2 * 2048] = (bf16_t)(w.y & 0xffffu); p[3 * 2048] = (bf16_t)(w.y >> 16);
                        p[4 * 2048] = (bf16_t)(w.z & 0xffffu); p[5 * 2048] = (bf16_t)(w.z >> 16); p[6 * 2048] = (bf16_t)(w.w & 0xffffu); p[7 * 2048] = (bf16_t)(w.w >> 16); }
                } }
        if (u.pn == 9 || u.pn == 10) {
            float* KMS = (float*)(ws + WS_KMS) + ((size_t)u.pm * 2 + wr) * 512 + (u.pn - 9) * 256 + cw;
#pragma unroll
            for (int bj = 0; bj < 2; ++bj)
#pragma unroll
                for (int n = 0; n < 2; ++n) { f32x4 v = ks[bj][n];
#pragma unroll
                    for (int o = 1; o < 16; o <<= 1) { v[0] += __shfl_xor(v[0], o); v[1] += __shfl_xor(v[1], o); v[2] += __shfl_xor(v[2], o); v[3] += __shfl_xor(v[3], o); }
                    if (fr == 0) *(f32x4*)(KMS + bj * HALF + 4 * n) = v; } }
    }
};
struct EpiXQ {
    static constexpr bool PERM = true, AFTER_DRAIN = false;
    unsigned char* ws;
    __device__ __forceinline__ void operator()(const f32x4 (&acc)[2][2][4][2], const Unit& u, int wr, int wc, int fr, int fq) const {
        const int row0 = u.pm * BM + wr * 64 + fr, col0 = u.pn * BM + wc * 32 + 8 * fq; bf16_t* Q = (bf16_t*)(ws + AR_XQ); const float* ssq = (const float*)(ws + WS_SSQ);
#pragma unroll
        for (int ai = 0; ai < 2; ++ai)
#pragma unroll
            for (int m = 0; m < 4; ++m) { const int r = row0 + ai * HALF + m * 16; const float rs = row_rstd16(ssq, r) * XATT_QSCALE;
#pragma unroll
                for (int bj = 0; bj < 2; ++bj) *(u32x4*)(Q + (size_t)r * 1024 + col0 + bj * HALF) = pack8(acc[ai][bj][m][0] * rs, acc[ai][bj][m][1] * rs); }
    }
};
struct EpiKV {
    static constexpr bool PERM = true, AFTER_DRAIN = false;
    unsigned char* ws;
    __device__ __forceinline__ void operator()(const f32x4 (&acc)[2][2][4][2], const Unit& u, int wr, int wc, int fr, int fq) const {
        const int row0 = u.pm * BM + wr * 64 + fr, cw = wc * 32 + 8 * fq; bf16_t* XK = (bf16_t*)(ws + WS_XK); bf16_t* XVT = (bf16_t*)(ws + WS_XVT); const float* memrs = (const float*)(ws + WS_MEMRS);
#pragma unroll
        for (int ai = 0; ai < 2; ++ai)
#pragma unroll
            for (int m = 0; m < 4; ++m) { const int r = row0 + ai * HALF + m * 16; const float rs = memrs[r];
#pragma unroll
                for (int bj = 0; bj < 2; ++bj) { const int c = cw + bj * HALF;
                    const f32x4 v0 = acc[ai][bj][m][0] * rs, v1 = acc[ai][bj][m][1] * rs;
                    if (u.pn < 4) *(u32x4*)(XK + (size_t)r * 1024 + u.pn * 256 + c) = pack8(v0, v1);
                    else { const int hx = u.pn - 4, b = r >> 8, key = r & 255;
                        bf16_t* p = XVT + ((size_t)(b * 4 + hx) * 256 + c) * 256 + (key & ~15) + pos16(key & 15);
                        const u32x4 w = pack8(v0, v1);
                        p[0] = (bf16_t)(w.x & 0xffffu); p[256] = (bf16_t)(w.x >> 16); p[2 * 256] = (bf16_t)(w.y & 0xffffu); p[3 * 256] = (bf16_t)(w.y >> 16);
                        p[4 * 256] = (bf16_t)(w.z & 0xffffu); p[5 * 256] = (bf16_t)(w.z >> 16); p[6 * 256] = (bf16_t)(w.w & 0xffffu); p[7 * 256] = (bf16_t)(w.w >> 16); }
                } }
    }
};

template <class Epi, class Sched, bool ALIGN_EPI = false, bool SP2 = false>
__device__ __forceinline__ void gemm_phase(PG8_LAS unsigned char* lds, const Gemm g, const Sched& S, const Epi& E) {
    int tid_ = threadIdx.x; asm volatile("" : "+v"(tid_));
    const int tid = tid_, wid = __builtin_amdgcn_readfirstlane(tid >> 6), lane = tid & 63, wr = wid >> 2, wc = wid & 3, fr = lane & 15, fq = lane >> 4;
    const int K = g.K, nt = K / BK;
    unsigned voffA[2], voffB[2];
#pragma unroll
    for (int i = 0; i < 2; ++i) { int R, C; stage_rc(tid * 16 + i * 8192, R, C); const int Rb = Epi::PERM ? ((R & ~31) + perm32(R & 31)) : R;
        voffA[i] = (unsigned)(R * K + C) * 2u; voffB[i] = (unsigned)(Rb * K + C) * 2u; }
    const size_t kstep = (size_t)(BK * 2);
    const size_t hstep = (size_t)HALF * K * 2;
    const size_t tstep = 2 * hstep;
    const unsigned ldsw = (unsigned)wid * 1024u;
    const int aoff = lds_byte(wr * 64 + fr, fq * 8), boff = lds_byte(wc * 32 + fr, fq * 8);
#define PG8_SA(b, h) (((b) * 2 + (h)) * HTB)
#define PG8_SB(b, h) ((4 + (b) * 2 + (h)) * HTB)
#define PG8_STAGE(bufoff, gbase, voff) do { _Pragma("unroll") for (int _i = 0; _i < 2; ++_i) \
        __builtin_amdgcn_global_load_lds((const unsigned*)((const char*)(gbase) + (voff)[_i]), (PG8_LAS unsigned*)(lds + (bufoff) + ldsw + _i * 8192), 16, 0, 0); } while (0)
#define PG8_LDA(dst, b, h) do { _Pragma("unroll") for (int m = 0; m < 4; ++m) _Pragma("unroll") for (int k = 0; k < 2; ++k) dst[m][k] = *(const PG8_LAS bf16x8*)(lds + PG8_SA(b, h) + aoff + m * 2048 + k * 1024); } while (0)
#define PG8_LDB(dst, b, h) do { _Pragma("unroll") for (int n = 0; n < 2; ++n) _Pragma("unroll") for (int k = 0; k < 2; ++k) dst[n][k] = *(const PG8_LAS bf16x8*)(lds + PG8_SB(b, h) + boff + n * 2048 + k * 1024); } while (0)
#define PG8_MMA(ai, bj, At, Bt) do { __builtin_amdgcn_s_setprio(1); _Pragma("unroll") for (int m = 0; m < 4; ++m) _Pragma("unroll") for (int n = 0; n < 2; ++n) _Pragma("unroll") for (int k = 0; k < 2; ++k) \
        acc[ai][bj][m][n] = __builtin_amdgcn_mfma_f32_16x16x32_bf16(Bt[n][k], At[m][k], acc[ai][bj][m][n], 0, 0, 0); __builtin_amdgcn_s_setprio(0); } while (0)
#define PG8_WAIT_V(n) asm volatile("s_waitcnt vmcnt(" #n ")" ::: "memory")
#define PG8_WAIT_L(n) asm volatile("s_waitcnt lgkmcnt(" #n ")" ::: "memory")
#define PG8_BAR __builtin_amdgcn_s_barrier()
#define PG8_SCHED __builtin_amdgcn_sched_barrier(0)
    Unit cur, nxt; int ui = 0;
    if (!S.next(0, cur)) return;
    f32x4 acc[2][2][4][2];
#pragma unroll
    for (int a = 0; a < 2; ++a)
#pragma unroll
        for (int b = 0; b < 2; ++b)
#pragma unroll
            for (int m = 0; m < 4; ++m)
#pragma unroll
                for (int n = 0; n < 2; ++n) acc[a][b][m][n] = (f32x4){0.f, 0.f, 0.f, 0.f};
    bf16x8 At[4][2], B0[2][2], B1[2][2];
    const char* cA = (const char*)g.A + (size_t)cur.pm * tstep; const char* cB = (const char*)g.Bt + (size_t)cur.pn * tstep;
    S.a_ready(cur);
    if constexpr (SP2) {
        PG8_STAGE(PG8_SB(0, 0), cB, voffB); PG8_STAGE(PG8_SB(0, 1), cB + hstep, voffB); PG8_STAGE(PG8_SA(0, 0), cA, voffA); PG8_STAGE(PG8_SA(0, 1), cA + hstep, voffA);
        if (wr == 1) PG8_BAR;
        PG8_WAIT_V(2); PG8_BAR;
        PG8_STAGE(PG8_SB(1, 0), cB + kstep, voffB); PG8_STAGE(PG8_SA(1, 0), cA + kstep, voffA); PG8_STAGE(PG8_SB(1, 1), cB + hstep + kstep, voffB);
        PG8_WAIT_V(6); PG8_BAR;
    } else {
        PG8_STAGE(PG8_SB(0, 0), cB, voffB); PG8_STAGE(PG8_SA(0, 0), cA, voffA); PG8_STAGE(PG8_SB(0, 1), cB + hstep, voffB); PG8_STAGE(PG8_SA(0, 1), cA + hstep, voffA);
        if (wr == 1) PG8_BAR;
        PG8_WAIT_V(4); PG8_BAR;
        PG8_STAGE(PG8_SB(1, 0), cB + kstep, voffB); PG8_STAGE(PG8_SA(1, 0), cA + kstep, voffA); PG8_STAGE(PG8_SB(1, 1), cB + hstep + kstep, voffB);
        PG8_WAIT_V(6); PG8_BAR;
    }
    for (;;) {
        const bool has_next = S.next(ui + 1, nxt);
        const char* nA = has_next ? (const char*)g.A + (size_t)nxt.pm * tstep : cA; const char* nB = has_next ? (const char*)g.Bt + (size_t)nxt.pn * tstep : cB;
        for (int t = 0; t < nt; t += 2) {
            const bool last = (t == nt - 2);
            const char* a1 = cA + (size_t)(t + 1) * kstep;
            const char* a2 = last ? nA : cA + (size_t)(t + 2) * kstep; const char* b2 = last ? nB : cB + (size_t)(t + 2) * kstep;
            const char* a3 = a2 + kstep; const char* b3 = b2 + kstep;
            if (last && has_next) S.a_ready(nxt);
            if constexpr (SP2) {
            PG8_LDB(B0, 0, 0); PG8_LDB(B1, 0, 1); PG8_SCHED; PG8_LDA(At, 0, 0); PG8_STAGE(PG8_SA(1, 1), a1 + hstep, voffA);
            PG8_WAIT_V(8); PG8_WAIT_L(0); PG8_BAR; PG8_MMA(0, 0, At, B0); PG8_MMA(0, 1, At, B1); PG8_BAR; PG8_SCHED;
            PG8_LDA(At, 0, 1); PG8_STAGE(PG8_SB(0, 0), b2, voffB); PG8_STAGE(PG8_SB(0, 1), b2 + hstep, voffB); PG8_STAGE(PG8_SA(0, 0), a2, voffA);
            PG8_WAIT_V(8); PG8_WAIT_L(0); PG8_BAR; PG8_MMA(1, 0, At, B0); PG8_MMA(1, 1, At, B1); PG8_BAR; PG8_SCHED;
            PG8_LDB(B0, 1, 0); PG8_LDB(B1, 1, 1); PG8_SCHED; PG8_LDA(At, 1, 0); PG8_STAGE(PG8_SA(0, 1), a2 + hstep, voffA);
            PG8_WAIT_V(8); PG8_WAIT_L(0); PG8_BAR; PG8_MMA(0, 0, At, B0); PG8_MMA(0, 1, At, B1); PG8_BAR; PG8_SCHED;
            PG8_LDA(At, 1, 1); PG8_STAGE(PG8_SB(1, 0), b3, voffB); PG8_STAGE(PG8_SB(1, 1), b3 + hstep, voffB); PG8_STAGE(PG8_SA(1, 0), a3, voffA);
            PG8_WAIT_V(8); PG8_WAIT_L(0); PG8_BAR; PG8_MMA(1, 0, At, B0); PG8_MMA(1, 1, At, B1); PG8_BAR; PG8_SCHED;
            } else {
            PG8_LDB(B0, 0, 0); PG8_SCHED; PG8_LDA(At, 0, 0); PG8_STAGE(PG8_SA(1, 1), a1 + hstep, voffA);
            PG8_WAIT_L(8); PG8_BAR; PG8_WAIT_L(0); PG8_MMA(0, 0, At, B0); PG8_BAR; PG8_SCHED;
            PG8_LDB(B1, 0, 1); PG8_STAGE(PG8_SB(0, 0), b2, voffB);
            PG8_BAR; PG8_WAIT_L(0); PG8_MMA(0, 1, At, B1); PG8_BAR;
            PG8_LDA(At, 0, 1); PG8_STAGE(PG8_SA(0, 0), a2, voffA);
            PG8_BAR; PG8_WAIT_L(0); PG8_MMA(1, 0, At, B0); PG8_BAR; PG8_SCHED;
            PG8_STAGE(PG8_SB(0, 1), b2 + hstep, voffB);
            PG8_WAIT_V(6); PG8_BAR; PG8_MMA(1, 1, At, B1); PG8_BAR;
            PG8_LDB(B0, 1, 0); PG8_SCHED; PG8_LDA(At, 1, 0); PG8_STAGE(PG8_SA(0, 1), a2 + hstep, voffA);
            PG8_WAIT_L(8); PG8_BAR; PG8_WAIT_L(0); PG8_MMA(0, 0, At, B0); PG8_BAR; PG8_SCHED;
            PG8_LDB(B1, 1, 1); PG8_STAGE(PG8_SB(1, 0), b3, voffB);
            PG8_BAR; PG8_WAIT_L(0); PG8_MMA(0, 1, At, B1); PG8_BAR;
            PG8_LDA(At, 1, 1); PG8_STAGE(PG8_SA(1, 0), a3, voffA);
            PG8_BAR; PG8_WAIT_L(0); PG8_MMA(1, 0, At, B0); PG8_BAR; PG8_SCHED;
            PG8_STAGE(PG8_SB(1, 1), b3 + hstep, voffB);
            PG8_WAIT_V(6); PG8_BAR; PG8_MMA(1, 1, At, B1); PG8_BAR;
            }
        }
        if constexpr (ALIGN_EPI) { if (wr == 0) PG8_BAR; }
        if constexpr (!Epi::AFTER_DRAIN) { E(acc, cur, wr, wc, fr, fq); S.done(cur); }
        if (!has_next) break;
#pragma unroll
        for (int a = 0; a < 2; ++a)
#pragma unroll
            for (int b = 0; b < 2; ++b)
#pragma unroll
                for (int m = 0; m < 4; ++m)
#pragma unroll
                    for (int n = 0; n < 2; ++n) acc[a][b][m][n] = (f32x4){0.f, 0.f, 0.f, 0.f};
        cur = nxt; cA = nA; cB = nB; ++ui;
        if constexpr (ALIGN_EPI) { if (wr == 1) PG8_BAR; }
    }
    PG8_WAIT_V(0);
    if constexpr (!ALIGN_EPI) { if (wr == 0) PG8_BAR; }
    PG8_BAR;
    if constexpr (Epi::AFTER_DRAIN) { E.fused(acc, cur, wr, wc, fr, fq, lds, wid, lane); S.done(cur); }
#undef PG8_SA
#undef PG8_SB
#undef PG8_STAGE
#undef PG8_LDA
#undef PG8_LDB
#undef PG8_MMA
#undef PG8_WAIT_V
#undef PG8_WAIT_L
#undef PG8_BAR
#undef PG8_SCHED
}
}

constexpr int NWAVES = 8;
constexpr int LDS_BYTES = 163840, LDSCTL_OFF = LDS_BYTES - 512, MISC_OFF = LDSCTL_OFF + 320, PHASE_LDS = LDSCTL_OFF;
constexpr int SCAN_R = 2, SCAN_NCH = 8;

typedef unsigned short bf16;
typedef unsigned u32x4 __attribute__((ext_vector_type(4)));
typedef unsigned u32x2 __attribute__((ext_vector_type(2)));
typedef float f32x4 __attribute__((ext_vector_type(4)));
typedef float f32x16 __attribute__((ext_vector_type(16)));
typedef short bf16x8 __attribute__((ext_vector_type(8)));
typedef GAS unsigned gu32;
#define RLX_AGENT __ATOMIC_RELAXED, __HIP_MEMORY_SCOPE_AGENT
#define LDS_WAIT() asm volatile("s_waitcnt lgkmcnt(0)" ::: "memory")
#define VM_WAIT() asm volatile("s_waitcnt vmcnt(0)" ::: "memory")
__device__ __forceinline__ float bf2f(unsigned b) { return __uint_as_float(b << 16); }
__device__ __forceinline__ unsigned f2bf(float f) { unsigned u = __builtin_bit_cast(unsigned, f); return (u + 0x7fffu + ((u >> 16) & 1u)) >> 16; }
__device__ __forceinline__ unsigned pk2(float lo, float hi) { return pg8::cvt_pk_bf16(lo, hi); }
__device__ __forceinline__ float wave_sum(float v) {
#pragma unroll
    for (int o = 1; o < 64; o <<= 1) v += __shfl_xor(v, o);
    return v;
}
#define WS8_STEP(o) _Pragma("unroll") for (int q = 0; q < 8; ++q) v[q] += __shfl_xor(v[q], o);
__device__ __forceinline__ void wave_sum8(float (&v)[8]) { WS8_STEP(1) WS8_STEP(2) WS8_STEP(4) WS8_STEP(8) WS8_STEP(16) WS8_STEP(32) }
__device__ __forceinline__ float quad_sum(float x) {
    x += __builtin_bit_cast(float, __builtin_amdgcn_update_dpp(0, __builtin_bit_cast(int, x), 0xB1, 0xF, 0xF, true));
    x += __builtin_bit_cast(float, __builtin_amdgcn_update_dpp(0, __builtin_bit_cast(int, x), 0x4E, 0xF, 0xF, true));
    return x;
}
__device__ __forceinline__ float sigmoidf_(float x) { return __builtin_amdgcn_rcpf(1.0f + __expf(-x)); }
__device__ __forceinline__ int crow(int r, int hi) { return (r & 3) + 8 * (r >> 2) + 4 * hi; }
__device__ __forceinline__ bf16x8 pack_bf16x8(float a0, float a1, float a2, float a3, float a4, float a5, float a6, float a7) {
    u32x4 w; w.x = pk2(a0, a1); w.y = pk2(a2, a3); w.z = pk2(a4, a5); w.w = pk2(a6, a7); return __builtin_bit_cast(bf16x8, w);
}

#define XB_TMO      128
#define XB_XCNT(j)  (256  + 64 * (j))
#define XB_XSUB(j)  (1280 + 64 * (j))
#define XB_XGEN(j)  (2304 + 64 * (j))
#define XB_TOP      3328
#define XB_TOPGEN   3392
#define XCD_BAR_WORDS 3456
#define XB_SPIN_CAP (1u << 18)

__device__ __forceinline__ unsigned xb_ld(unsigned* p)              { return __hip_atomic_load(p, __ATOMIC_RELAXED, __HIP_MEMORY_SCOPE_AGENT); }
__device__ __forceinline__ unsigned xb_add(unsigned* p, unsigned v) { return __hip_atomic_fetch_add(p, v, __ATOMIC_RELAXED, __HIP_MEMORY_SCOPE_AGENT); }
__device__ __forceinline__ unsigned xb_xcc_id() { return (unsigned)__builtin_amdgcn_s_getreg((3 << 11) | 20) & 0xFu; }
#define XB_SPIN(cond, bar) do { unsigned _sp = 0; while (cond) { __builtin_amdgcn_s_sleep(1); \
    if ((++_sp & 255u) == 0u) { if (xb_ld(&(bar)[XB_TMO])) break; if (_sp > XB_SPIN_CAP) { atomicAdd(&(bar)[XB_TMO], 1u); break; } } } } while (0)

struct XcdBarrier {
    unsigned* bar; unsigned x;
    volatile LAS unsigned* st;
};

__device__ __forceinline__ XcdBarrier xcd_barrier_post(unsigned* bar, volatile LAS unsigned* st) {
    XcdBarrier b; b.bar = bar; b.x = xb_xcc_id(); b.st = st;
    if (threadIdx.x == 0) (void)xb_add(&bar[XB_XCNT(b.x)], 1u);
    return b;
}
__device__ __forceinline__ void xcd_barrier_complete(unsigned* bar, unsigned x, unsigned& nloc, unsigned& nx) {
    const unsigned G = gridDim.x * gridDim.y * gridDim.z;
    unsigned sum, cnt, mine, sp = 0u;
    for (;;) {
        sum = 0u; cnt = 0u; mine = 0u;
#pragma unroll
        for (unsigned j = 0; j < 16; ++j) { const unsigned c = xb_ld(&bar[XB_XCNT(j)]); sum += c; cnt += (c > 0u) ? 1u : 0u; mine = (j == x) ? c : mine; }
        if (sum == G) break;
        __builtin_amdgcn_s_sleep(1);
        if ((++sp & 255u) == 0u) { if (xb_ld(&bar[XB_TMO])) break; if (sp > XB_SPIN_CAP) { atomicAdd(&bar[XB_TMO], 1u); break; } }
    }
    nloc = mine > 0u ? mine : 1u; nx = cnt > 0u ? cnt : 1u;
}

__device__ __forceinline__ void xcd_barrier(const XcdBarrier& b) {
    asm volatile("s_waitcnt vmcnt(0)" ::: "memory");
    __syncthreads();
    if (threadIdx.x == 0) {
        unsigned* bar = b.bar;
        __builtin_amdgcn_s_waitcnt(0);
        unsigned nloc = b.st[0], nx = b.st[1];
        if (nloc == 0u) { xcd_barrier_complete(bar, b.x, nloc, nx); b.st[0] = nloc; b.st[1] = nx; }
        const unsigned old = xb_add(&bar[XB_XSUB(b.x)], 1u);
        const unsigned gen = old / nloc;
        if (old + 1u == (gen + 1u) * nloc) {
            __builtin_amdgcn_fence(__ATOMIC_RELEASE, "agent");
            asm volatile("s_waitcnt vmcnt(0)" ::: "memory");
            const unsigned og = xb_add(&bar[XB_TOP], 1u);
            const unsigned tg = og / nx;
            if (og + 1u == (tg + 1u) * nx) xb_add(&bar[XB_TOPGEN], 1u);
            else XB_SPIN(xb_ld(&bar[XB_TOPGEN]) == tg, bar);
            __builtin_amdgcn_fence(__ATOMIC_ACQUIRE, "agent");
            xb_add(&bar[XB_XGEN(b.x)], 1u);
            asm volatile("s_waitcnt vmcnt(0)" ::: "memory");
        } else {
            XB_SPIN(xb_ld(&bar[XB_XGEN(b.x)]) == gen, bar);
            __builtin_amdgcn_fence(__ATOMIC_ACQUIRE, "agent");
            asm volatile("s_waitcnt vmcnt(0)" ::: "memory");
        }
    }
    __syncthreads();
}


struct Args { const float* in[N_IN]; float* out; unsigned char* ws; int ph_lo, ph_hi; };
static_assert(sizeof(Args) == N_IN * 8 + 24, "Args has no padding");
struct Frame {
    LAS unsigned char* lds; volatile LAS unsigned* MISC; gu32* ctl;
    int tid, lane, wave, vcu, G;
    const __attribute__((address_space(4))) struct Args* ka; float* out; unsigned char* ws;
};
#define FIN(i) (F.ka->in[i])
#define PHASE_IDS() do { int t_ = threadIdx.x; asm volatile("" : "+v"(t_)); F.tid = t_; F.lane = t_ & 63; F.wave = __builtin_amdgcn_readfirstlane(t_ >> 6); } while (0)
#define WSP(T, off) ((T*)(F.ws + (off)))

__device__ __forceinline__ void ph_init(Frame& F) {
    PHASE_IDS();
    const int gw = F.vcu * NWAVES + F.wave, NGW = F.G * NWAVES;
    float* bias = WSP(float, WS_BIAS); const float* relb = FIN(I_RELB);
    for (int i = blockIdx.x * 512 + F.tid; i < NH * 2048; i += F.G * 512) { const int h = i >> 11, n = i & 2047; int bkt;
        if (n < 16) bkt = n; else { const float nf = (float)n; const int lg = 16 + (int)(logf(nf / 16.0f) / 4.1588830833596715f * 16.0f); bkt = lg < 31 ? lg : 31; }
        bias[i] = relb[h * 32 + bkt] * LOG2E; }
    const float* mem = FIN(I_MEM); bf16* memb = WSP(bf16, WS_MEMB); float* memrs = WSP(float, WS_MEMRS);
    for (int r = gw; r < MM; r += NGW) { const f32x4* xr = (const f32x4*)(mem + (size_t)r * DM) + F.lane; f32x4 v[4]; float s = 0.f;
#pragma unroll
        for (int j = 0; j < 4; ++j) { v[j] = xr[64 * j]; s += (v[j].x * v[j].x + v[j].y * v[j].y) + (v[j].z * v[j].z + v[j].w * v[j].w); }
        s = wave_sum(s); u32x2* o = (u32x2*)(memb + (size_t)r * DM) + F.lane;
#pragma unroll
        for (int j = 0; j < 4; ++j) { u32x2 w; w.x = pk2(v[j].x, v[j].y); w.y = pk2(v[j].z, v[j].w); o[64 * j] = w; }
        if (F.lane == 0) memrs[r] = __builtin_amdgcn_rsqf(s * (1.0f / DM) + NORM_EPS); }
    const float* x = FIN(I_X); bf16* xb = WSP(bf16, WS_XB); float* ssq = WSP(float, WS_SSQ);
    for (int r = gw; r < M; r += NGW) { const f32x4* xr = (const f32x4*)(x + (size_t)r * DM) + F.lane; f32x4 v[4]; float s = 0.f;
#pragma unroll
        for (int j = 0; j < 4; ++j) { v[j] = xr[64 * j]; s += (v[j].x * v[j].x + v[j].y * v[j].y) + (v[j].z * v[j].z + v[j].w * v[j].w); }
        s = wave_sum(s); u32x2* o = (u32x2*)(xb + (size_t)r * DM) + F.lane;
#pragma unroll
        for (int j = 0; j < 4; ++j) { u32x2 w; w.x = pk2(v[j].x, v[j].y); w.y = pk2(v[j].z, v[j].w); o[64 * j] = w; }
        if (F.lane < 16) ssq[(size_t)r * 16 + F.lane] = F.lane == 0 ? s : 0.f; }
}

__device__ __forceinline__ void conv_item(const float* W, int K, int N, const float* gk, bf16* WT, int item, bool ffn_in, LAS float* scr, int lane) {
    const int nblk = N / 32, kb = item / nblk, nb = item % nblk, k0 = 64 * kb, n0 = 32 * nb;
#pragma unroll 8
    for (int i = 0; i < 32; ++i) { const int kk = 2 * i + (lane >> 5); float w = W[(size_t)(k0 + kk) * N + n0 + (lane & 31)]; if (gk) w *= gk[k0 + kk]; scr[kk * 33 + (lane & 31)] = w; }
    LDS_WAIT(); asm volatile("" ::: "memory");
    int drow0 = n0; if (ffn_in) drow0 = n0 < DFF ? 256 * (n0 / 128) + (n0 % 128) : 256 * ((n0 - DFF) / 128) + 128 + ((n0 - DFF) % 128);
    const int c = lane & 7;
#pragma unroll
    for (int j = 0; j < 4; ++j) { const int n = (lane >> 3) + 8 * j; const LAS float* s = scr + (8 * c) * 33 + n;
        u32x4 o; o.x = pk2(s[0 * 33], s[1 * 33]); o.y = pk2(s[2 * 33], s[3 * 33]); o.z = pk2(s[4 * 33], s[5 * 33]); o.w = pk2(s[6 * 33], s[7 * 33]);
        *(u32x4*)(WT + (size_t)(drow0 + n) * K + k0 + 8 * c) = o; }
    LDS_WAIT(); asm volatile("" ::: "memory");
}
__device__ __forceinline__ void ph_conv(Frame& F, int l) {
    PHASE_IDS();
    LAS float* scr = (LAS float*)(F.lds + F.wave * 16384);
    const int gw = F.vcu * NWAVES + F.wave, NGW = F.G * NWAVES;
    constexpr int I_FIN = (DM / 64) * (2 * DFF / 32), I_FOUT = (DFF / 64) * (DM / 32), I_MI = (DM / 64) * (DPROJ / 32), I_SQ = (DM / 64) * (DM / 32), I_KV = (DM / 64) * (2 * DM / 32);
    constexpr int I_L64 = (64 / 64) * (RW / 32), I_L128 = (128 / 64) * (RW / 32);
    constexpr int NITEMS = 2 * I_FIN + 2 * I_FOUT + I_MI + 3 * I_SQ + I_KV + 2 * I_L64 + I_L128;
    unsigned char* wb = F.ws + WS_W;
    for (int it = gw; it < NITEMS; it += NGW) { int r = it;
        if (r < I_FIN) { conv_item(FIN(I_F1IN) + (size_t)l * DM * 2 * DFF, DM, 2 * DFF, FIN(I_F1G) + l * DM, (bf16*)(wb + W_F1IN), r, true, scr, F.lane); continue; } r -= I_FIN;
        if (r < I_FIN) { conv_item(FIN(I_F2IN) + (size_t)l * DM * 2 * DFF, DM, 2 * DFF, FIN(I_F2G) + l * DM, (bf16*)(wb + W_F2IN), r, true, scr, F.lane); continue; } r -= I_FIN;
        if (r < I_FOUT) { conv_item(FIN(I_F1OUT) + (size_t)l * DFF * DM, DFF, DM, nullptr, (bf16*)(wb + W_F1OUT), r, false, scr, F.lane); continue; } r -= I_FOUT;
        if (r < I_FOUT) { conv_item(FIN(I_F2OUT) + (size_t)l * DFF * DM, DFF, DM, nullptr, (bf16*)(wb + W_F2OUT), r, false, scr, F.lane); continue; } r -= I_FOUT;
        if (r < I_MI) { conv_item(FIN(I_MIXIN) + (size_t)l * DM * DPROJ, DM, DPROJ, FIN(I_MIXG) + l * DM, (bf16*)(wb + W_MIXIN), r, false, scr, F.lane); continue; } r -= I_MI;
        if (r < I_SQ) { conv_item(FIN(I_MIXOUT) + (size_t)l * DM * DM, DM, DM, nullptr, (bf16*)(wb + W_MIXOUT), r, false, scr, F.lane); continue; } r -= I_SQ;
        if (r < I_SQ) { conv_item(FIN(I_WQ) + (size_t)l * DM * DM, DM, DM, FIN(I_XG) + l * DM, (bf16*)(wb + W_WQ), r, false, scr, F.lane); continue; } r -= I_SQ;
        if (r < I_SQ) { conv_item(FIN(I_WO) + (size_t)l * DM * DM, DM, DM, nullptr, (bf16*)(wb + W_WO), r, false, scr, F.lane); continue; } r -= I_SQ;
        if (r < I_KV) { conv_item(FIN(I_WKV) + (size_t)l * DM * 2 * DM, DM, 2 * DM, FIN(I_MEMG) + l * DM, (bf16*)(wb + W_WKV), r, false, scr, F.lane); continue; } r -= I_KV;
        if (r < I_L64) { conv_item(FIN(I_WUP) + (size_t)l * 64 * RW, 64, RW, nullptr, (bf16*)(wb + W_WUPT), r, false, scr, F.lane); continue; } r -= I_L64;
        if (r < I_L64) { conv_item(FIN(I_AUP) + (size_t)l * 64 * RW, 64, RW, nullptr, (bf16*)(wb + W_AUPT), r, false, scr, F.lane); continue; } r -= I_L64;
        conv_item(FIN(I_GUP) + (size_t)l * 128 * RW, 128, RW, nullptr, (bf16*)(wb + W_GUPT), r, false, scr, F.lane);
    }
}

__device__ __forceinline__ void ph_moba(Frame& F) {
    PHASE_IDS();
    constexpr int KROW = 144, KBUF = 64 * KROW, OFF_K = 12288, OFF_V = OFF_K + 2 * KBUF;
    LAS float* kmean = (LAS float*)F.lds;
    LAS float* btab = (LAS float*)(F.lds + 2048);
    volatile LAS unsigned* needw = (volatile LAS unsigned*)(F.lds + 10240);
    const bf16* MQ = WSP(bf16, AR_MQ); const bf16* MK = WSP(bf16, AR_MK); const bf16* MVT = WSP(bf16, AR_MVT); bf16* XB = WSP(bf16, WS_XB); const float* bias = WSP(float, WS_BIAS);
    const int lane = F.lane, r32 = lane & 31, hi = lane >> 5, wave = F.wave, tid = F.tid;
    for (int u = blockIdx.x; u < 512; u += F.G) {
        const int rnd = u >> 8, iu = u & 255, qsel = iu >> 6, bh = iu & 63, qb = rnd == 0 ? 7 - qsel : qsel, b = bh >> 3, hh = bh & 7;
        __syncthreads();
        { const int n = tid >> 6, d = tid & 63;
          if (n < qb) { const float* kp = WSP(float, WS_KMS) + ((size_t)(b * 8 + n) * 2) * 512 + hh * 64 + d; kmean[n * 64 + d] = (kp[0] + kp[512]) * (1.0f / 256.0f); }
          for (int i2 = tid; i2 < 2048; i2 += 512) btab[i2] = bias[hh * 2048 + i2];
          if (tid == 0) needw[0] = 0u; }
        __syncthreads();
        const int q0 = qb * 256 + wave * 32; const size_t tok = (size_t)b * 2048 + q0 + r32;
        bf16x8 qf[4];
#pragma unroll
        for (int s = 0; s < 4; ++s) qf[s] = *(const bf16x8*)(MQ + tok * 512 + hh * 64 + 16 * s + 8 * hi);
        float g[7]; unsigned selmask = 0u;
#pragma unroll
        for (int n = 0; n < 7; ++n) { g[n] = -INFINITY;
            if (n < qb) { float p = 0.f;
#pragma unroll
                for (int s = 0; s < 4; ++s) { const f32x4 k0v = *(const LAS f32x4*)(kmean + n * 64 + 16 * s + 8 * hi), k1v = *(const LAS f32x4*)(kmean + n * 64 + 16 * s + 8 * hi + 4);
                    p += bf2f((unsigned short)qf[s][0]) * k0v[0] + bf2f((unsigned short)qf[s][1]) * k0v[1] + bf2f((unsigned short)qf[s][2]) * k0v[2] + bf2f((unsigned short)qf[s][3]) * k0v[3]
                       + bf2f((unsigned short)qf[s][4]) * k1v[0] + bf2f((unsigned short)qf[s][5]) * k1v[1] + bf2f((unsigned short)qf[s][6]) * k1v[2] + bf2f((unsigned short)qf[s][7]) * k1v[3]; }
                p += __shfl_xor(p, 32); g[n] = p; } }
        if (qb <= 3) selmask = (1u << qb) - 1u;
        else {
#pragma unroll
            for (int n = 0; n < 7; ++n) if (n < qb) { int cnt = 0;
#pragma unroll
                for (int n2 = 0; n2 < 7; ++n2) if (n2 != n && n2 < qb) cnt += (g[n2] > g[n] || (g[n2] == g[n] && n2 < n)) ? 1 : 0;
                if (cnt < 3) selmask |= 1u << n; } }
        unsigned wmask = 0u;
#pragma unroll
        for (int n = 0; n < 7; ++n) if (__ballot((selmask >> n) & 1u) != 0ull) wmask |= 1u << n;
        if (lane == 0 && wmask) __hip_atomic_fetch_or((LAS unsigned*)needw, wmask, __ATOMIC_RELAXED, __HIP_MEMORY_SCOPE_WORKGROUP);
        __syncthreads();
        const unsigned need = needw[0] | (1u << qb);
        float mrun = -INFINITY, lrun = 0.f; f32x16 o0, o1;
#pragma unroll
        for (int i = 0; i < 16; ++i) { o0[i] = 0.f; o1[i] = 0.f; }
        const int qpos = q0 + r32;
        const bf16* Kg = MK + ((size_t)b * 2048 + (tid >> 3)) * 512 + hh * 64 + (tid & 7) * 8;
        const bf16* Vg = MVT + ((size_t)(b * 8 + hh) * 64 + (tid >> 3)) * 2048 + (tid & 7) * 8;
        const int sto = (tid >> 3) * KROW + (tid & 7) * 16;
        int blk = 0; while (!((need >> blk) & 1u)) ++blk;
        int kt = 0, it = 0;
        { const int k0 = blk * 256; const u32x4 kr = *(const u32x4*)(Kg + (size_t)k0 * 512), vr = *(const u32x4*)(Vg + k0);
          *(LAS u32x4*)(F.lds + OFF_K + sto) = kr; *(LAS u32x4*)(F.lds + OFF_V + sto) = vr; }
        __syncthreads();
        while (blk <= qb) {
            int nblk = blk, nkt = kt + 1; if (nkt == 4) { nkt = 0; ++nblk; while (nblk <= qb && !((need >> nblk) & 1u)) ++nblk; }
            const bool more = nblk <= qb; u32x4 kr, vr;
            if (more) { const int k0n = nblk * 256 + nkt * 64; kr = *(const u32x4*)(Kg + (size_t)k0n * 512); vr = *(const u32x4*)(Vg + k0n); }
            const int k0 = blk * 256 + kt * 64; const bool own = blk == qb; const bool selme = own || ((selmask >> blk) & 1u);
            const bool active = own ? (k0 <= q0 + 31) : (__ballot(selme) != 0ull);
            if (active) {
                const LAS unsigned char* kb = F.lds + OFF_K + (it & 1) * KBUF + r32 * KROW + 16 * hi;
                const LAS unsigned char* vb = F.lds + OFF_V + (it & 1) * KBUF + r32 * KROW + 16 * hi;
                const bool h1 = !own || (k0 + 32 <= q0 + 31);
                f32x16 s0, s1;
#pragma unroll
                for (int i = 0; i < 16; ++i) { s0[i] = 0.f; s1[i] = 0.f; }
#pragma unroll
                for (int s = 0; s < 4; ++s) s0 = __builtin_amdgcn_mfma_f32_32x32x16_bf16(*(const LAS bf16x8*)(kb + 32 * s), qf[s], s0, 0, 0, 0);
                if (h1) {
#pragma unroll
                    for (int s = 0; s < 4; ++s) s1 = __builtin_amdgcn_mfma_f32_32x32x16_bf16(*(const LAS bf16x8*)(kb + 32 * KROW + 32 * s), qf[s], s1, 0, 0, 0); }
                float mx = -INFINITY;
                float bv0[16], bv1[16];
#pragma unroll
                for (int r = 0; r < 16; ++r) { const int d0 = qpos - (k0 + crow(r, hi)), d1 = d0 - 32; bv0[r] = btab[d0 < 0 ? 0 : d0]; bv1[r] = btab[d1 < 0 ? 0 : d1]; }
#pragma unroll
                for (int r = 0; r < 16; ++r) asm volatile("" : "+v"(bv0[r]), "+v"(bv1[r]));
#pragma unroll
                for (int r = 0; r < 16; ++r) { const int d0 = qpos - (k0 + crow(r, hi)), d1 = d0 - 32;
                    const bool v0 = selme && (!own || d0 >= 0), v1 = h1 && selme && (!own || d1 >= 0);
                    const float a0 = v0 ? s0[r] + bv0[r] : -INFINITY, a1 = v1 ? s1[r] + bv1[r] : -INFINITY;
                    s0[r] = a0; s1[r] = a1; mx = fmaxf(mx, fmaxf(a0, a1)); }
                mx = fmaxf(mx, __shfl_xor(mx, 32));
                const float mnew = fmaxf(mrun, mx), muse = (mnew == -INFINITY) ? 0.f : mnew;
                const float alpha = __builtin_amdgcn_exp2f(mrun - muse);
                float ps = 0.f;
#pragma unroll
                for (int r = 0; r < 16; ++r) { const float p0 = __builtin_amdgcn_exp2f(s0[r] - muse), p1 = __builtin_amdgcn_exp2f(s1[r] - muse); s0[r] = p0; s1[r] = p1; ps += p0 + p1; }
                lrun = lrun * alpha + ps; mrun = mnew;
#pragma unroll
                for (int i = 0; i < 16; ++i) { o0[i] *= alpha; o1[i] *= alpha; }
                const bf16x8 pa0 = pack_bf16x8(s0[0], s0[1], s0[2], s0[3], s0[4], s0[5], s0[6], s0[7]), pa1 = pack_bf16x8(s0[8], s0[9], s0[10], s0[11], s0[12], s0[13], s0[14], s0[15]);
                o0 = __builtin_amdgcn_mfma_f32_32x32x16_bf16(*(const LAS bf16x8*)(vb), pa0, o0, 0, 0, 0); o0 = __builtin_amdgcn_mfma_f32_32x32x16_bf16(*(const LAS bf16x8*)(vb + 32), pa1, o0, 0, 0, 0);
                o1 = __builtin_amdgcn_mfma_f32_32x32x16_bf16(*(const LAS bf16x8*)(vb + 32 * KROW), pa0, o1, 0, 0, 0); o1 = __builtin_amdgcn_mfma_f32_32x32x16_bf16(*(const LAS bf16x8*)(vb + 32 * KROW + 32), pa1, o1, 0, 0, 0);
                if (h1) {
                    const bf16x8 pb0 = pack_bf16x8(s1[0], s1[1], s1[2], s1[3], s1[4], s1[5], s1[6], s1[7]), pb1 = pack_bf16x8(s1[8], s1[9], s1[10], s1[11], s1[12], s1[13], s1[14], s1[15]);
                    o0 = __builtin_amdgcn_mfma_f32_32x32x16_bf16(*(const LAS bf16x8*)(vb + 64), pb0, o0, 0, 0, 0); o0 = __builtin_amdgcn_mfma_f32_32x32x16_bf16(*(const LAS bf16x8*)(vb + 96), pb1, o0, 0, 0, 0);
                    o1 = __builtin_amdgcn_mfma_f32_32x32x16_bf16(*(const LAS bf16x8*)(vb + 32 * KROW + 64), pb0, o1, 0, 0, 0); o1 = __builtin_amdgcn_mfma_f32_32x32x16_bf16(*(const LAS bf16x8*)(vb + 32 * KROW + 96), pb1, o1, 0, 0, 0); }
            }
            if (more) { *(LAS u32x4*)(F.lds + OFF_K + ((it + 1) & 1) * KBUF + sto) = kr; *(LAS u32x4*)(F.lds + OFF_V + ((it + 1) & 1) * KBUF + sto) = vr; }
            __syncthreads();
            blk = nblk; kt = nkt; ++it;
        }
        lrun += __shfl_xor(lrun, 32); const float inv = 1.0f / lrun;
        bf16* op = XB + tok * 1024 + 512 + hh * 64 + 4 * hi;
#pragma unroll
        for (int g4 = 0; g4 < 4; ++g4) { u32x2 w0, w1; w0.x = pk2(o0[4 * g4] * inv, o0[4 * g4 + 1] * inv); w0.y = pk2(o0[4 * g4 + 2] * inv, o0[4 * g4 + 3] * inv);
            w1.x = pk2(o1[4 * g4] * inv, o1[4 * g4 + 1] * inv); w1.y = pk2(o1[4 * g4 + 2] * inv, o1[4 * g4 + 3] * inv);
            *(u32x2*)(op + 8 * g4) = w0; *(u32x2*)(op + 32 + 8 * g4) = w1; }
    }
}

__device__ __forceinline__ void ph_xatt(Frame& F) {
    PHASE_IDS();
    constexpr int KROW = 528, KBUF = 32 * KROW, VROW = 80, VBUF = 256 * VROW, OFF_K = 0, OFF_V = 2 * KBUF;
    const bf16* XQ = WSP(bf16, AR_XQ); const bf16* XK = WSP(bf16, WS_XK); const bf16* XVT = WSP(bf16, WS_XVT); bf16* XO = WSP(bf16, AR_XO);
    const int lane = F.lane, r32 = lane & 31, hi = lane >> 5, wave = F.wave, tid = F.tid;
    for (int u = blockIdx.x; u < 256; u += F.G) {
        const int b = u >> 5, hx = (u >> 3) & 3, qt = u & 7;
        const size_t tok = (size_t)b * 2048 + qt * 256 + wave * 32 + r32;
        const bf16* Qg = XQ + tok * 1024 + hx * 256 + 8 * hi;
        const bf16* Kg = XK + (size_t)(b * 256 + (tid >> 5)) * 1024 + hx * 256 + (tid & 31) * 8;
        const bf16* Vg = XVT + ((size_t)(b * 4 + hx) * 256 + (tid >> 2)) * 256 + (tid & 3) * 8;
        const int ksto = (tid >> 5) * KROW + (tid & 31) * 16, vsto = (tid >> 2) * VROW + (tid & 3) * 16;
        float mrun = -INFINITY, lrun = 0.f; f32x16 o[8];
#pragma unroll
        for (int dt = 0; dt < 8; ++dt)
#pragma unroll
            for (int i = 0; i < 16; ++i) o[dt][i] = 0.f;
        __syncthreads();
        { const u32x4 k0r = *(const u32x4*)(Kg), k1r = *(const u32x4*)(Kg + (size_t)16 * 1024), v0r = *(const u32x4*)(Vg), v1r = *(const u32x4*)(Vg + (size_t)128 * 256);
          *(LAS u32x4*)(F.lds + OFF_K + ksto) = k0r; *(LAS u32x4*)(F.lds + OFF_K + ksto + 16 * KROW) = k1r; *(LAS u32x4*)(F.lds + OFF_V + vsto) = v0r; *(LAS u32x4*)(F.lds + OFF_V + vsto + 128 * VROW) = v1r; }
        __syncthreads();
        for (int kt = 0; kt < 8; ++kt) {
            const bool more = kt + 1 < 8; const int k0n = (kt + 1) * 32; u32x4 s0r, s1r;
            if (more) { s0r = *(const u32x4*)(Kg + (size_t)k0n * 1024); s1r = *(const u32x4*)(Kg + (size_t)(k0n + 16) * 1024); }
            const LAS unsigned char* kb = F.lds + OFF_K + (kt & 1) * KBUF + r32 * KROW + 16 * hi;
            const LAS unsigned char* vb = F.lds + OFF_V + (kt & 1) * VBUF + r32 * VROW + 16 * hi;
            f32x16 sc;
#pragma unroll
            for (int i = 0; i < 16; ++i) sc[i] = 0.f;
            bf16x8 qa[4], qb[4];
#pragma unroll
            for (int s = 0; s < 4; ++s) qa[s] = *(const bf16x8*)(Qg + 16 * s);
#pragma unroll
            for (int s = 0; s < 4; ++s) qb[s] = *(const bf16x8*)(Qg + 64 + 16 * s);
#pragma unroll
            for (int s = 0; s < 4; ++s) sc = __builtin_amdgcn_mfma_f32_32x32x16_bf16(*(const LAS bf16x8*)(kb + 32 * s), qa[s], sc, 0, 0, 0);
            asm volatile("" ::: "memory");
#pragma unroll
            for (int s = 0; s < 4; ++s) qa[s] = *(const bf16x8*)(Qg + 128 + 16 * s);
#pragma unroll
            for (int s = 0; s < 4; ++s) sc = __builtin_amdgcn_mfma_f32_32x32x16_bf16(*(const LAS bf16x8*)(kb + 128 + 32 * s), qb[s], sc, 0, 0, 0);
            asm volatile("" ::: "memory");
#pragma unroll
            for (int s = 0; s < 4; ++s) qb[s] = *(const bf16x8*)(Qg + 192 + 16 * s);
#pragma unroll
            for (int s = 0; s < 4; ++s) sc = __builtin_amdgcn_mfma_f32_32x32x16_bf16(*(const LAS bf16x8*)(kb + 256 + 32 * s), qa[s], sc, 0, 0, 0);
            asm volatile("" ::: "memory");
#pragma unroll
            for (int s = 0; s < 4; ++s) sc = __builtin_amdgcn_mfma_f32_32x32x16_bf16(*(const LAS bf16x8*)(kb + 384 + 32 * s), qb[s], sc, 0, 0, 0);
            if (more) { LAS unsigned char* kd = F.lds + OFF_K + ((kt + 1) & 1) * KBUF + ksto; *(LAS u32x4*)(kd) = s0r; *(LAS u32x4*)(kd + 16 * KROW) = s1r;
                s0r = *(const u32x4*)(Vg + k0n); s1r = *(const u32x4*)(Vg + (size_t)128 * 256 + k0n); }
            float mx = sc[0];
#pragma unroll
            for (int r = 1; r < 16; ++r) mx = fmaxf(mx, sc[r]);
            mx = fmaxf(mx, __shfl_xor(mx, 32));
            const float mnew = fmaxf(mrun, mx), alpha = __builtin_amdgcn_exp2f(mrun - mnew);
            float ps = 0.f;
#pragma unroll
            for (int r = 0; r < 16; ++r) { const float p = __builtin_amdgcn_exp2f(sc[r] - mnew); sc[r] = p; ps += p; }
            lrun = lrun * alpha + ps; mrun = mnew;
            const bf16x8 pf0 = pack_bf16x8(sc[0], sc[1], sc[2], sc[3], sc[4], sc[5], sc[6], sc[7]), pf1 = pack_bf16x8(sc[8], sc[9], sc[10], sc[11], sc[12], sc[13], sc[14], sc[15]);
#pragma unroll
            for (int dt = 0; dt < 8; ++dt) {
#pragma unroll
                for (int i = 0; i < 16; ++i) o[dt][i] *= alpha;
                o[dt] = __builtin_amdgcn_mfma_f32_32x32x16_bf16(*(const LAS bf16x8*)(vb + dt * 32 * VROW), pf0, o[dt], 0, 0, 0);
                o[dt] = __builtin_amdgcn_mfma_f32_32x32x16_bf16(*(const LAS bf16x8*)(vb + dt * 32 * VROW + 32), pf1, o[dt], 0, 0, 0); }
            if (more) { LAS unsigned char* vd = F.lds + OFF_V + ((kt + 1) & 1) * VBUF + vsto; *(LAS u32x4*)(vd) = s0r; *(LAS u32x4*)(vd + 128 * VROW) = s1r; }
            __syncthreads();
        }
        lrun += __shfl_xor(lrun, 32); const float inv = 1.0f / lrun;
        bf16* op = XO + tok * 1024 + hx * 256 + 4 * hi;
#pragma unroll
        for (int dt = 0; dt < 8; ++dt)
#pragma unroll
            for (int g4 = 0; g4 < 4; ++g4) { u32x2 w; w.x = pk2(o[dt][4 * g4] * inv, o[dt][4 * g4 + 1] * inv); w.y = pk2(o[dt][4 * g4 + 2] * inv, o[dt][4 * g4 + 3] * inv);
                *(u32x2*)(op + 32 * dt + 8 * g4) = w; }
    }
}

__device__ __forceinline__ void ph_prep(Frame& F, int l) {
    PHASE_IDS();
    constexpr int SROW = 3080, OFF_LAT = 33 * SROW + 8, LROW = 528, OFF_PAR = OFF_LAT + 32 * LROW;
    static_assert(OFF_LAT % 16 == 0 && OFF_PAR % 16 == 0 && OFF_PAR + 8 * 512 * 4 <= PHASE_LDS, "prep LDS map");
    LAS unsigned char* rows = F.lds; LAS unsigned char* lat = F.lds + OFF_LAT; LAS float* par = (LAS float*)(F.lds + OFF_PAR);
    const bf16* PR = WSP(bf16, AR_PR); bf16* SCANIN = WSP(bf16, AR_SCANIN); bf16* SV = WSP(bf16, AR_SV); bf16* XB = WSP(bf16, WS_XB); float* BONUS = WSP(float, WS_BONUS);
    const bf16* WUPT = (const bf16*)(F.ws + WS_W + W_WUPT); const bf16* AUPT = (const bf16*)(F.ws + WS_W + W_AUPT); const bf16* GUPT = (const bf16*)(F.ws + WS_W + W_GUPT);
    const int h = F.wave, lane = F.lane, r32 = lane & 31, hi = lane >> 5, tid = F.tid;
    const float* mu = FIN(I_MU) + l * RPROJ;
    __syncthreads();
    { const int c = tid;
      par[c] = mu[c]; par[512 + c] = mu[512 + c]; par[1024 + c] = mu[1024 + c]; par[1536 + c] = FIN(I_W0)[l * RW + c]; par[2048 + c] = FIN(I_A0)[l * RW + c];
      par[2560 + c] = FIN(I_KK)[l * RW + c]; par[3072 + c] = FIN(I_KA)[l * RW + c]; par[3584 + c] = FIN(I_RK)[l * RW + c]; }
    for (int task = blockIdx.x; task < M / 32; task += F.G) { const int t0 = task * 32;
        __syncthreads();
        {
          u32x4 st[13];
#pragma unroll
          for (int i = 0; i < 13; ++i) { const int q = tid + 512 * i; st[i] = (u32x4){0u, 0u, 0u, 0u};
              if (q < 33 * 192) { const int row = q / 192, c16 = q - row * 192; if (row > 0 || (t0 & 2047) != 0) st[i] = *(const u32x4*)(PR + (size_t)(t0 - 1 + row) * RPROJ + c16 * 8); } }
#pragma unroll
          for (int i = 0; i < 13; ++i) { const int q = tid + 512 * i;
              if (q < 33 * 192) { const int row = q / 192, c16 = q - row * 192; LAS unsigned char* d = rows + row * SROW + c16 * 16; *(LAS u32x2*)d = (u32x2){st[i].x, st[i].y}; *(LAS u32x2*)(d + 8) = (u32x2){st[i].z, st[i].w}; } } }
        {
          const int tt = tid >> 4, l16 = (tid & 15) * 16, t = t0 + tt; const bf16* pc = PR + (size_t)t * RPROJ + 1536 + l16;
          u32x4 cur[2], prv[2]; cur[0] = *(const u32x4*)pc; cur[1] = *(const u32x4*)(pc + 8); prv[0] = (u32x4){0u, 0u, 0u, 0u}; prv[1] = prv[0];
          if (t & 2047) { prv[0] = *(const u32x4*)(pc - RPROJ); prv[1] = *(const u32x4*)(pc - RPROJ + 8); }
          u32x4 ow[2];
#pragma unroll
          for (int hh = 0; hh < 2; ++hh) { const f32x4 m0 = *(const f32x4*)(mu + 1536 + l16 + 8 * hh), m1 = *(const f32x4*)(mu + 1536 + l16 + 8 * hh + 4); float xv[8];
#pragma unroll
              for (int i = 0; i < 4; ++i) { const unsigned cw = cur[hh][i], pw = prv[hh][i]; const float p0 = bf2f(cw & 0xffffu), p1 = bf2f(cw >> 16), q0 = bf2f(pw & 0xffffu), q1 = bf2f(pw >> 16);
                  const float ma = i < 2 ? m0[2 * i] : m1[2 * i - 4], mb = i < 2 ? m0[2 * i + 1] : m1[2 * i - 3];
                  xv[2 * i] = p0 + (q0 - p0) * ma; xv[2 * i + 1] = p1 + (q1 - p1) * mb; }
#pragma unroll
              for (int i = 0; i < 8; ++i) { if (l16 < 64) xv[i] = 1.0f - 2.0f * __builtin_amdgcn_rcpf(1.0f + __expf(2.0f * xv[i])); else if (l16 >= 128) xv[i] = sigmoidf_(xv[i]); }
              ow[hh] = (u32x4){pk2(xv[0], xv[1]), pk2(xv[2], xv[3]), pk2(xv[4], xv[5]), pk2(xv[6], xv[7])}; }
          *(LAS u32x4*)(lat + tt * LROW + l16 * 2) = ow[0]; *(LAS u32x4*)(lat + tt * LROW + l16 * 2 + 16) = ow[1]; }
        __syncthreads();
        const int t = t0 + r32, bb = t >> 11, tp = t & 2047, bh = bb * 8 + h;
        const LAS unsigned char* rc = rows + (r32 + 1) * SROW; const LAS unsigned char* rp = rows + r32 * SROW;
        float n2 = 0.f, bon = 0.f;
#pragma unroll
        for (int q = 0; q < 8; ++q) { const int c4 = h * 64 + 8 * q + 4 * hi;
            const u32x2 kc = *(const LAS u32x2*)(rc + (512 + c4) * 2), kp = *(const LAS u32x2*)(rp + (512 + c4) * 2);
            const f32x4 mk = *(const LAS f32x4*)(par + 512 + c4), kkc = *(const LAS f32x4*)(par + 2560 + c4);
#pragma unroll
            for (int i = 0; i < 4; ++i) { const unsigned sh = (i & 1) * 16; float k = bf2f((kc[i >> 1] >> sh) & 0xffffu); const float kq = bf2f((kp[i >> 1] >> sh) & 0xffffu);
                k += (kq - k) * mk[i]; const float kk = k * kkc[i]; n2 += kk * kk; } }
        n2 += __shfl_xor(n2, 32);
        const float inv = 1.0f / fmaxf(sqrtf(n2), 1e-12f);
        bf16* so = SCANIN + ((size_t)(bh * 64 + (tp >> 5)) * 10) * 1024 + lane * 16;
#pragma unroll 1
        for (int ct = 0; ct < 2; ++ct) { const int cb = h * 64 + 32 * ct;
            f32x16 aw, aa, ag;
#pragma unroll
            for (int i = 0; i < 16; ++i) { aw[i] = 0.f; aa[i] = 0.f; ag[i] = 0.f; }
            const LAS unsigned char* lb = lat + r32 * LROW + 16 * hi;
#pragma unroll
            for (int s = 0; s < 4; ++s) { const bf16x8 wf = *(const bf16x8*)(WUPT + (size_t)(cb + r32) * 64 + 16 * s + 8 * hi), af = *(const bf16x8*)(AUPT + (size_t)(cb + r32) * 64 + 16 * s + 8 * hi);
                const bf16x8 lw = *(const LAS bf16x8*)(lb + 32 * s), la = *(const LAS bf16x8*)(lb + 128 + 32 * s);
                aw = __builtin_amdgcn_mfma_f32_32x32x16_bf16(wf, lw, aw, 0, 0, 0); aa = __builtin_amdgcn_mfma_f32_32x32x16_bf16(af, la, aa, 0, 0, 0); }
#pragma unroll
            for (int s = 0; s < 8; ++s) { const bf16x8 gf = *(const bf16x8*)(GUPT + (size_t)(cb + r32) * 128 + 16 * s + 8 * hi); const bf16x8 lg = *(const LAS bf16x8*)(lb + 256 + 32 * s);
                ag = __builtin_amdgcn_mfma_f32_32x32x16_bf16(gf, lg, ag, 0, 0, 0); }
            unsigned onk[8], old_[8], obv[8], okt[8], orr[8];
#pragma unroll
            for (int g = 0; g < 4; ++g) { const int c4 = cb + 8 * g + 4 * hi;
                const u32x2 rcv = *(const LAS u32x2*)(rc + c4 * 2), kcv = *(const LAS u32x2*)(rc + (512 + c4) * 2), vcv = *(const LAS u32x2*)(rc + (1024 + c4) * 2);
                const u32x2 rpv = *(const LAS u32x2*)(rp + c4 * 2), kpv = *(const LAS u32x2*)(rp + (512 + c4) * 2), vpv = *(const LAS u32x2*)(rp + (1024 + c4) * 2);
                const f32x4 mr = *(const LAS f32x4*)(par + c4), mk = *(const LAS f32x4*)(par + 512 + c4), mv = *(const LAS f32x4*)(par + 1024 + c4);
                const f32x4 w0v = *(const LAS f32x4*)(par + 1536 + c4), a0v = *(const LAS f32x4*)(par + 2048 + c4), kkc = *(const LAS f32x4*)(par + 2560 + c4), kac = *(const LAS f32x4*)(par + 3072 + c4), rkc = *(const LAS f32x4*)(par + 3584 + c4);
                float ro[4], ko[4], vo[4], ldo[4], go[4], nk[4], bo[4];
#pragma unroll
                for (int i = 0; i < 4; ++i) { const unsigned sh = (i & 1) * 16;
                    float r = bf2f((rcv[i >> 1] >> sh) & 0xffffu), k = bf2f((kcv[i >> 1] >> sh) & 0xffffu), v = bf2f((vcv[i >> 1] >> sh) & 0xffffu);
                    const float rq = bf2f((rpv[i >> 1] >> sh) & 0xffffu), kq = bf2f((kpv[i >> 1] >> sh) & 0xffffu), vq = bf2f((vpv[i >> 1] >> sh) & 0xffffu);
                    r += (rq - r) * mr[i]; k += (kq - k) * mk[i]; v += (vq - v) * mv[i];
                    const float wv = w0v[i] + aw[4 * g + i], xs = -wv, sp = xs > 20.f ? xs : __logf(1.0f + __expf(xs)), ld = -__expf(-sp - 0.5f);
                    const float a = sigmoidf_(a0v[i] + aa[4 * g + i]);
                    const float kn = k * kkc[i] * inv, kt = k * (1.0f + (a - 1.0f) * kac[i]);
                    bon += r * kt * rkc[i];
                    ro[i] = r; ko[i] = kt; vo[i] = v; ldo[i] = ld; go[i] = ag[4 * g + i]; nk[i] = -kn; bo[i] = kn * a; }
                onk[2 * g] = pk2(nk[0], nk[1]); onk[2 * g + 1] = pk2(nk[2], nk[3]); old_[2 * g] = pk2(ldo[0], ldo[1]); old_[2 * g + 1] = pk2(ldo[2], ldo[3]);
                obv[2 * g] = pk2(bo[0], bo[1]); obv[2 * g + 1] = pk2(bo[2], bo[3]); okt[2 * g] = pk2(ko[0], ko[1]); okt[2 * g + 1] = pk2(ko[2], ko[3]);
                orr[2 * g] = pk2(ro[0], ro[1]); orr[2 * g + 1] = pk2(ro[2], ro[3]);
                *(u32x2*)(SV + ((size_t)bh * 2048 + tp) * 64 + 32 * ct + 8 * g + 4 * hi) = (u32x2){pk2(vo[0], vo[1]), pk2(vo[2], vo[3])};
                *(u32x2*)(XB + (size_t)t * 1024 + c4) = (u32x2){pk2(go[0], go[1]), pk2(go[2], go[3])}; }
            bf16* sq = so + ct * 1024;
            *(u32x4*)(sq) = (u32x4){onk[0], onk[1], onk[2], onk[3]}; *(u32x4*)(sq + 8) = (u32x4){onk[4], onk[5], onk[6], onk[7]};
            *(u32x4*)(sq + 2048) = (u32x4){old_[0], old_[1], old_[2], old_[3]}; *(u32x4*)(sq + 2048 + 8) = (u32x4){old_[4], old_[5], old_[6], old_[7]};
            *(u32x4*)(sq + 4096) = (u32x4){obv[0], obv[1], obv[2], obv[3]}; *(u32x4*)(sq + 4096 + 8) = (u32x4){obv[4], obv[5], obv[6], obv[7]};
            *(u32x4*)(sq + 6144) = (u32x4){okt[0], okt[1], okt[2], okt[3]}; *(u32x4*)(sq + 6144 + 8) = (u32x4){okt[4], okt[5], okt[6], okt[7]};
            *(u32x4*)(sq + 8192) = (u32x4){orr[0], orr[1], orr[2], orr[3]}; *(u32x4*)(sq + 8192 + 8) = (u32x4){orr[4], orr[5], orr[6], orr[7]};
        }
        bon += __shfl_xor(bon, 32);
        if (hi == 0) BONUS[(size_t)t * 8 + h] = bon;
    }
}

template <int R, int NCH, bool KINDP>
__device__ __forceinline__ void scan_stream(Frame& F, LAS float* ring, int bh, int ch, int rg, int lis) {
    typedef float f32x2 __attribute__((ext_vector_type(2)));
    constexpr int CLEN = SEQ / NCH, NHALF = CLEN / 8;
    const int lane = F.lane, js = lane & 3, q = lane >> 2, row0 = rg * 16 * R + q * R, tbase = ch * CLEN;
    const bf16* src5 = WSP(bf16, AR_SCANIN) + (size_t)bh * 64 * 10 * 1024; const bf16* srcv = WSP(bf16, AR_SV) + (size_t)bh * 2048 * 64;
    float* YL = WSP(float, AR_YLOC) + ((size_t)bh * 2048 + tbase) * 64; bf16* ZZ = WSP(bf16, AR_Z) + ((size_t)bh * 2048 + tbase) * 64;
    int soff[2], doff[2]; bool isv[2], isld[2], cval[2];
#pragma unroll
    for (int k = 0; k < 2; ++k) { int ci = lis + k * 256; cval[k] = ci < 384; if (!cval[k]) ci = lis; isv[k] = ci >= 320;
        const int run = ci >> 4, vec = run >> 2, ct = (run >> 1) & 1, hi2 = run & 1, tok = (ci & 15) >> 1, hf16 = ci & 1, cv = ci - 320;
        isld[k] = !isv[k] && vec == 1;
        soff[k] = isv[k] ? (cv >> 3) * 64 + (cv & 7) * 8 : ((vec * 2 + ct) * 64 + hi2 * 32 + tok) * 16 + 8 * hf16;
        doff[k] = isv[k] ? (cv >> 3) * 384 + 320 + (cv & 7) * 8 : tok * 384 + vec * 64 + 32 * ct + 16 * hf16 + 4 * hi2; }
#define SCAN_LOAD(hfx) do { const int tg_ = tbase + (hfx) * 8; _Pragma("unroll") for (int k = 0; k < 2; ++k) {   \
        const bf16* p_ = isv[k] ? srcv + (size_t)tg_ * 64 + soff[k] : src5 + (size_t)(tg_ >> 5) * 10240 + (tg_ & 31) * 16 + soff[k]; pre[k] = *(const u32x4*)p_; } } while (0)
#define SCAN_WRITE(hfx) do { _Pragma("unroll") for (int k = 0; k < 2; ++k) if (cval[k]) { float f[8]; \
        _Pragma("unroll") for (int i = 0; i < 4; ++i) { f[2 * i] = bf2f(pre[k][i] & 0xffffu); f[2 * i + 1] = bf2f(pre[k][i] >> 16); } \
        if (isld[k]) { _Pragma("unroll") for (int i = 0; i < 8; ++i) f[i] = __expf(f[i]); } \
        LAS float* d_ = ring + (((hfx) & 1) * 8) * 384 + doff[k]; \
        *(LAS f32x4*)(d_) = (f32x4){f[0], f[1], f[2], f[3]}; *(LAS f32x4*)(d_ + (isv[k] ? 4 : 8)) = (f32x4){f[4], f[5], f[6], f[7]}; } } while (0)
    f32x2 S[R][8];
#pragma unroll
    for (int rr = 0; rr < R; ++rr)
#pragma unroll
        for (int k = 0; k < 8; ++k) { S[rr][k].x = (KINDP && (row0 + rr) == 16 * js + 2 * k) ? 1.f : 0.f; S[rr][k].y = (KINDP && (row0 + rr) == 16 * js + 2 * k + 1) ? 1.f : 0.f; }
    u32x4 pre[2];
    SCAN_LOAD(0); SCAN_WRITE(0);
    __syncthreads();
    for (int hf = 0; hf < NHALF; ++hf) {
        const bool more = hf + 1 < NHALF;
        if (more) SCAN_LOAD(hf + 1);
#pragma unroll 2
        for (int st = 0; st < 8; ++st) {
            const LAS float* sp = ring + ((hf & 1) * 8 + st) * 384 + 16 * js;
            f32x2 nn[8], ww[8], bb[8], kk[8], rr2[8];
#pragma unroll
            for (int i = 0; i < 4; ++i) { const f32x4 a = *(const LAS f32x4*)(sp + 4 * i); nn[2 * i] = (f32x2){a[0], a[1]}; nn[2 * i + 1] = (f32x2){a[2], a[3]}; }
#pragma unroll
            for (int i = 0; i < 4; ++i) { const f32x4 a = *(const LAS f32x4*)(sp + 64 + 4 * i); ww[2 * i] = (f32x2){a[0], a[1]}; ww[2 * i + 1] = (f32x2){a[2], a[3]}; }
#pragma unroll
            for (int i = 0; i < 4; ++i) { const f32x4 a = *(const LAS f32x4*)(sp + 128 + 4 * i); bb[2 * i] = (f32x2){a[0], a[1]}; bb[2 * i + 1] = (f32x2){a[2], a[3]}; }
            if (!KINDP) {
#pragma unroll
                for (int i = 0; i < 4; ++i) { const f32x4 a = *(const LAS f32x4*)(sp + 192 + 4 * i); kk[2 * i] = (f32x2){a[0], a[1]}; kk[2 * i + 1] = (f32x2){a[2], a[3]}; } }
#pragma unroll
            for (int i = 0; i < 4; ++i) { const f32x4 a = *(const LAS f32x4*)(sp + 256 + 4 * i); rr2[2 * i] = (f32x2){a[0], a[1]}; rr2[2 * i + 1] = (f32x2){a[2], a[3]}; }
            float vv[R];
            if (!KINDP) {
#pragma unroll
                for (int rr = 0; rr < R; ++rr) vv[rr] = ring[((hf & 1) * 8 + st) * 384 + 320 + row0 + rr]; }
            float sa[R];
#pragma unroll
            for (int rr = 0; rr < R; ++rr) { f32x2 p0 = S[rr][0] * nn[0], p1 = S[rr][1] * nn[1];
#pragma unroll
                for (int k = 2; k < 8; k += 2) { p0 = S[rr][k] * nn[k] + p0; p1 = S[rr][k + 1] * nn[k + 1] + p1; }
                p0 = p0 + p1; sa[rr] = quad_sum(p0.x + p0.y); }
            float y[R];
#pragma unroll
            for (int rr = 0; rr < R; ++rr) { const f32x2 sa2 = (f32x2){sa[rr], sa[rr]}; f32x2 p0 = (f32x2){0.f, 0.f}, p1 = (f32x2){0.f, 0.f};
#pragma unroll
                for (int k = 0; k < 8; k += 2) {
                    f32x2 t0 = S[rr][k] * ww[k], t1 = S[rr][k + 1] * ww[k + 1];
                    t0 = sa2 * bb[k] + t0; t1 = sa2 * bb[k + 1] + t1;
                    if (!KINDP) { const f32x2 v2 = (f32x2){vv[rr], vv[rr]}; t0 = v2 * kk[k] + t0; t1 = v2 * kk[k + 1] + t1; }
                    S[rr][k] = t0; S[rr][k + 1] = t1; p0 = t0 * rr2[k] + p0; p1 = t1 * rr2[k + 1] + p1; }
                p0 = p0 + p1; y[rr] = quad_sum(p0.x + p0.y); }
            if (js == 0) { const int t = hf * 8 + st;
                if (R == 2) { if (KINDP) *(unsigned*)(ZZ + (size_t)t * 64 + row0) = pk2(y[0], y[R - 1]); else *(f32x2*)(YL + (size_t)t * 64 + row0) = (f32x2){y[0], y[R - 1]}; }
                else {
#pragma unroll
                    for (int rr = 0; rr < R; ++rr) { if (KINDP) ZZ[(size_t)t * 64 + row0 + rr] = (bf16)f2bf(y[rr]); else YL[(size_t)t * 64 + row0 + rr] = y[rr]; } } }
        }
        if (more) SCAN_WRITE(hf + 1);
        __syncthreads();
    }
#undef SCAN_LOAD
#undef SCAN_WRITE
    if (NCH > 1) {
        float* st = WSP(float, AR_STATE) + ((size_t)(bh * NCH + ch) * 2 + (KINDP ? 0 : 1)) * 4096;
#pragma unroll
        for (int rr = 0; rr < R; ++rr)
#pragma unroll
            for (int i = 0; i < 4; ++i) *(f32x4*)(st + (size_t)(row0 + rr) * 64 + 16 * js + 4 * i) = (f32x4){S[rr][2 * i].x, S[rr][2 * i].y, S[rr][2 * i + 1].x, S[rr][2 * i + 1].y};
    }
}
template <int R, int NCH>
__device__ __forceinline__ void ph_scan(Frame& F) {
    PHASE_IDS();
    constexpr int KINDS = NCH > 1 ? 2 : 1, RG = 4 / R, WPS = KINDS * RG, SPW = NWAVES / WPS, NSTREAM = BATCH * NH * NCH;
    static_assert(WPS == 4, "staging assumes 4 waves per stream");
    const int sl = F.wave / WPS, role = F.wave % WPS, kind = role / RG, rg = role % RG, lis = role * 64 + F.lane;
    LAS float* ring = (LAS float*)F.lds + sl * (16 * 384);
    for (int it = blockIdx.x; it * SPW < NSTREAM; it += F.G) {
        const int sid = it * SPW + sl, bh = sid / NCH, ch = sid % NCH;
        __syncthreads();
        if (kind == 0) scan_stream<R, NCH, false>(F, ring, bh, ch, rg, lis); else scan_stream<R, NCH, true>(F, ring, bh, ch, rg, lis);
    }
}

template <int NCH>
__device__ __forceinline__ void ph_fix(Frame& F) {
    PHASE_IDS();
    typedef float f32x2 __attribute__((ext_vector_type(2)));
    LAS float* cur = (LAS float*)F.lds;
    for (int u = blockIdx.x; u < 256; u += F.G) { const int bh = u >> 2, rgx = u & 3, i = F.tid >> 5, j2 = (F.tid & 31) * 2, row = rgx * 16 + i;
        float* base = WSP(float, AR_STATE) + (size_t)bh * NCH * 2 * 4096;
        __syncthreads();
        { const f32x2 v = *(const f32x2*)(base + 4096 + row * 64 + j2); cur[i * 64 + j2] = v.x; cur[i * 64 + j2 + 1] = v.y; }
        __syncthreads();
        for (int c = 1; c < NCH - 1; ++c) { const float* P = base + (size_t)(c * 2) * 4096; float* SL = base + (size_t)(c * 2 + 1) * 4096;
            f32x2 acc = *(const f32x2*)(SL + row * 64 + j2);
#pragma unroll
            for (int ii = 0; ii < 64; ++ii) { const float sv = cur[i * 64 + ii]; const f32x2 p = *(const f32x2*)(P + ii * 64 + j2); acc.x += sv * p.x; acc.y += sv * p.y; }
            __syncthreads();
            cur[i * 64 + j2] = acc.x; cur[i * 64 + j2 + 1] = acc.y; *(f32x2*)(SL + row * 64 + j2) = acc;
            __syncthreads(); }
    }
}

template <int NCH>
__device__ __forceinline__ void ph_post(Frame& F, int l) {
    PHASE_IDS();
    constexpr int CLEN = SEQ / NCH;
    const float* YL = WSP(float, AR_YLOC); const bf16* SV = WSP(bf16, AR_SV); bf16* XB = WSP(bf16, WS_XB); const float* BONUS = WSP(float, WS_BONUS); const bf16* ZZ = WSP(bf16, AR_Z);
    LAS float* zt = (LAS float*)F.lds;
    const int c = F.tid, h = F.wave, j = F.lane; const float lng = FIN(I_LNG)[l * RW + c], lnb = FIN(I_LNB)[l * RW + c];
    for (int grp = blockIdx.x; grp < M / 64; grp += F.G) { const int t0g = grp * 64, bb = t0g >> 11, ch = (t0g & 2047) / CLEN, bh = bb * 8 + h; const bool corr = NCH > 1 && ch > 0;
        float st[64];
        if (corr) { const float* sp = WSP(float, AR_STATE) + ((size_t)(bh * NCH + ch - 1) * 2 + 1) * 4096 + j * 64;
#pragma unroll
            for (int i4 = 0; i4 < 16; ++i4) { const f32x4 v = *(const f32x4*)(sp + 4 * i4); st[4 * i4] = v[0]; st[4 * i4 + 1] = v[1]; st[4 * i4 + 2] = v[2]; st[4 * i4 + 3] = v[3]; } }
        for (int ti = 0; ti < 4; ++ti) { const int t0 = t0g + 16 * ti;
            if (corr) { __syncthreads();
#pragma unroll 4
                for (int tt = 0; tt < 16; ++tt) zt[tt * 512 + c] = bf2f(ZZ[((size_t)bh * 2048 + ((t0 + tt) & 2047)) * 64 + j]);
                __syncthreads(); }
#pragma unroll 1
            for (int tb = 0; tb < 16; tb += 8) {
                float yv[8], vv[8], bv[8], gv[8];
#pragma unroll
                for (int q = 0; q < 8; ++q) { const int t = t0 + tb + q, tp = t & 2047;
                    yv[q] = YL[((size_t)bh * 2048 + tp) * 64 + j]; vv[q] = bf2f(SV[((size_t)bh * 2048 + tp) * 64 + j]); bv[q] = BONUS[(size_t)t * 8 + h]; gv[q] = bf2f(XB[(size_t)t * 1024 + c]); }
                if (corr) {
#pragma unroll
                    for (int q = 0; q < 8; ++q) { const LAS float* zp = zt + (tb + q) * 512 + h * 64; float p0 = 0.f, p1 = 0.f, p2 = 0.f, p3 = 0.f;
#pragma unroll
                        for (int qq = 0; qq < 4; ++qq) { asm volatile("" ::: "memory");
                            f32x4 zz[4];
#pragma unroll
                            for (int e = 0; e < 4; ++e) zz[e] = *(const LAS f32x4*)(zp + 16 * qq + 4 * e);
#pragma unroll
                            for (int e = 0; e < 4; ++e) { const int j4 = 4 * qq + e; p0 += st[4 * j4] * zz[e][0]; p1 += st[4 * j4 + 1] * zz[e][1]; p2 += st[4 * j4 + 2] * zz[e][2]; p3 += st[4 * j4 + 3] * zz[e][3]; }
                            asm volatile("" : "+v"(p0), "+v"(p1), "+v"(p2), "+v"(p3)); }
                        yv[q] += (p0 + p1) + (p2 + p3); } }
                float mean[8], var[8];
#pragma unroll
                for (int q = 0; q < 8; ++q) mean[q] = yv[q];
                wave_sum8(mean);
#pragma unroll
                for (int q = 0; q < 8; ++q) { mean[q] *= (1.0f / 64.0f); yv[q] -= mean[q]; var[q] = yv[q] * yv[q]; }
                wave_sum8(var);
#pragma unroll
                for (int q = 0; q < 8; ++q) { const int t = t0 + tb + q;
                    const float yn = yv[q] * __builtin_amdgcn_rsqf(var[q] * (1.0f / 64.0f) + LNX_EPS) * lng + lnb;
                    XB[(size_t)t * 1024 + c] = (bf16)f2bf((yn + bv[q] * vv[q]) * gv[q]); }
            }
        }
    }
}

__device__ __forceinline__ void ph_final(Frame& F) {
    PHASE_IDS();
    const int gw = F.vcu * NWAVES + F.wave, NGW = F.G * NWAVES; const float* ssq = WSP(float, WS_SSQ); const float* g = FIN(I_FING);
    f32x4 gv[4];
#pragma unroll
    for (int j = 0; j < 4; ++j) gv[j] = ((const f32x4*)g)[F.lane + 64 * j];
    for (int r = gw; r < M; r += NGW) { const float rs = pg8::row_rstd16(ssq, r); f32x4* xr = (f32x4*)(F.out + (size_t)r * DM) + F.lane;
#pragma unroll
        for (int j = 0; j < 4; ++j) { const f32x4 v = xr[64 * j]; xr[64 * j] = v * rs * gv[j]; } }
}

constexpr int PH_INIT = 0, PH_PER_LAYER = 16, PH_FINAL = 1 + DEPTH * PH_PER_LAYER, N_PHASES = PH_FINAL + 1;
enum { K_CONV = 0, K_KV, K_F1UP, K_F1DN, K_MIXIN, K_MOBA, K_PREP, K_SCAN, K_FIX, K_POST, K_MIXOUT, K_XQ, K_XATT, K_XO, K_F2UP, K_F2DN };

#ifdef ONLY
#define PH_ON(k) ((k) == (ONLY))
#else
#define PH_ON(k) true
#endif
__global__ void __launch_bounds__(NWAVES * 64, 2) fwd(Args args) {
    extern __shared__ __attribute__((aligned(16))) unsigned char lds[];
    Frame F;
    F.lds = (LAS unsigned char*)lds; F.MISC = (volatile LAS unsigned*)(F.lds + MISC_OFF);
    F.tid = threadIdx.x; F.lane = F.tid & 63; F.wave = __builtin_amdgcn_readfirstlane(F.tid >> 6);
    F.G = gridDim.x; { const int bx = blockIdx.x; F.vcu = (F.G % 8 == 0) ? (bx % 8) * (F.G / 8) + bx / 8 : bx; }
    F.out = args.out; F.ws = args.ws; F.ctl = (gu32*)(args.ws + WS_CTL);
    F.ka = (const __attribute__((address_space(4))) Args*)(uintptr_t)__builtin_amdgcn_kernarg_segment_ptr();
    for (int u = F.tid; u < (LDS_BYTES - LDSCTL_OFF) / 4; u += NWAVES * 64) ((LAS unsigned*)(F.lds + LDSCTL_OFF))[u] = 0u;
    __syncthreads();
    const bool multi = args.ph_hi - args.ph_lo > 1;
    XcdBarrier bar; bar.bar = (unsigned*)(F.ctl + 4096); bar.x = 0; bar.st = nullptr;
    if (multi) bar = xcd_barrier_post((unsigned*)(F.ctl + 4096), F.MISC + 8);
#ifndef REP_AT
#define REP_AT 1000
#endif
    for (int pi = args.ph_lo; pi < args.ph_hi + (REP_AT < 1000 ? 1 : 0); ++pi) { const int ph = pi - (pi > REP_AT ? 1 : 0);
        { uintptr_t kp = (uintptr_t)__builtin_amdgcn_kernarg_segment_ptr(); asm volatile("" : "+s"(kp)); F.ka = (const __attribute__((address_space(4))) Args*)kp; }
        unsigned char* wb = F.ws + WS_W;
        if (ph == PH_INIT) { if (PH_ON(100)) { ph_init(F); ph_conv(F, 0); } }
        else if (ph == PH_FINAL) { if (PH_ON(101)) ph_final(F); }
        else { const int l = (ph - 1) / PH_PER_LAYER, k = (ph - 1) % PH_PER_LAYER;
            const float* xin = (l == 0) ? FIN(I_X) : (const float*)F.out;
            switch (k) {
            case K_CONV: if (!PH_ON(K_CONV)) break; if (l > 0) ph_conv(F, l); break;
            case K_KV: break;
            case K_F1UP: case K_F2UP: if (!PH_ON(K_F1UP)) break; { pg8::Gemm g{WSP(bf16, WS_XB), (const bf16*)(wb + (k == K_F1UP ? W_F1IN : W_F2IN)), M, 2 * DFF, DM}; pg8::StaticOrder S; S.init(M, 2 * DFF, F.G, (int)blockIdx.x);
                pg8::EpiSwiGLU E{F.ws}; pg8::gemm_phase<pg8::EpiSwiGLU, pg8::StaticOrder, true, true>(F.lds, g, S, E); } break;
            case K_F1DN: case K_F2DN: if (!PH_ON(K_F1DN)) break; { pg8::Gemm g{WSP(bf16, AR_H), (const bf16*)(wb + (k == K_F1DN ? W_F1OUT : W_F2OUT)), M, DM, DFF}; pg8::StaticOrder S; S.init(M, DM, F.G, (int)blockIdx.x);
                pg8::EpiResid E{k == K_F1DN ? xin : (const float*)F.out, F.out, F.ws, WS_XB, 0.5f}; pg8::gemm_phase<pg8::EpiResid, pg8::StaticOrder, true, true>(F.lds, g, S, E); } break;
            case K_MIXIN: if (!PH_ON(K_MIXIN)) break; { pg8::Gemm g{WSP(bf16, WS_XB), (const bf16*)(wb + W_MIXIN), M, DPROJ, DM}; pg8::StaticOrder S; S.init(M, DPROJ, F.G, (int)blockIdx.x);
                pg8::EpiMixIn E{F.ws}; pg8::gemm_phase<pg8::EpiMixIn, pg8::StaticOrder, true, true>(F.lds, g, S, E); }
                {
                  pg8::Gemm g{WSP(bf16, WS_MEMB), (const bf16*)(wb + W_WKV), MM, 2 * DM, DM}; pg8::StaticOrder S; S.init(MM, 2 * DM, F.G, (int)((blockIdx.x + F.G - 64) % F.G));
                  pg8::EpiKV E{F.ws}; pg8::gemm_phase<pg8::EpiKV, pg8::StaticOrder, true, true>(F.lds, g, S, E); } break;
            case K_MOBA: if (!PH_ON(K_MOBA)) break; ph_moba(F); break;
            case K_PREP: if (!PH_ON(K_PREP)) break; ph_prep(F, l); break;
            case K_SCAN: if (!PH_ON(K_SCAN)) break; ph_scan<SCAN_R, SCAN_NCH>(F); break;
            case K_FIX: if (!PH_ON(K_FIX)) break; if (SCAN_NCH > 1) ph_fix<SCAN_NCH>(F); break;
            case K_POST: if (!PH_ON(K_POST)) break; ph_post<SCAN_NCH>(F, l); break;
            case K_MIXOUT: if (!PH_ON(K_MIXOUT)) break; { pg8::Gemm g{WSP(bf16, WS_XB), (const bf16*)(wb + W_MIXOUT), M, DM, DM}; pg8::StaticOrder S; S.init(M, DM, F.G, (int)blockIdx.x);
                pg8::EpiResid E{F.out, F.out, F.ws, AR_XB2, 1.0f}; pg8::gemm_phase<pg8::EpiResid, pg8::StaticOrder, true, true>(F.lds, g, S, E); } break;
            case K_XQ: if (!PH_ON(K_XQ)) break; { pg8::Gemm g{WSP(bf16, AR_XB2), (const bf16*)(wb + W_WQ), M, DM, DM}; pg8::StaticOrder S; S.init(M, DM, F.G, (int)blockIdx.x);
                pg8::EpiXQ E{F.ws}; pg8::gemm_phase<pg8::EpiXQ, pg8::StaticOrder, true, true>(F.lds, g, S, E); } break;
            case K_XATT: if (!PH_ON(K_XATT)) break; ph_xatt(F); break;
            case K_XO: if (!PH_ON(K_XO)) break; { pg8::Gemm g{WSP(bf16, AR_XO), (const bf16*)(wb + W_WO), M, DM, DM}; pg8::StaticOrder S; S.init(M, DM, F.G, (int)blockIdx.x);
                pg8::EpiResid E{F.out, F.out, F.ws, WS_XB, 1.0f}; pg8::gemm_phase<pg8::EpiResid, pg8::StaticOrder, true, true>(F.lds, g, S, E); } break;
            default: break;
            }
        }
        if (pi + 1 < args.ph_hi + (REP_AT < 1000 ? 1 : 0)) {
            const int kk_ = (ph - 1) % PH_PER_LAYER, ll_ = (ph - 1) / PH_PER_LAYER;
            const bool noop = ph != PH_INIT && ph != PH_FINAL && ((kk_ == K_FIX && SCAN_NCH == 1) || kk_ == K_KV || (kk_ == K_CONV && ll_ == 0));
            if (!noop) xcd_barrier(bar);
        }
    }
}

extern "C" void kernel_launch(void* const* d_in, const int* in_sizes, int n_in, void* d_out, int out_size, void* d_ws, size_t ws_size, hipStream_t stream) {
    static int grid = 0;
    if (grid == 0) {
        if (n_in != N_IN || in_sizes[0] != M * DM || out_size != M * DM || ws_size < WS_END) { fprintf(stderr, "kernel_launch: unexpected problem (n_in %d, in0 %d, out %d, ws %zu < %zu); nothing launched\n", n_in, n_in > 0 ? in_sizes[0] : -1, out_size, ws_size, (size_t)WS_END); grid = -1; return; }
        int dev = 0, cus = 0;
        if (hipGetDevice(&dev) != hipSuccess || hipDeviceGetAttribute(&cus, hipDeviceAttributeMultiprocessorCount, dev) != hipSuccess) { grid = -1; return; }
        if (hipFuncSetAttribute((const void*)fwd, hipFuncAttributeMaxDynamicSharedMemorySize, LDS_BYTES) != hipSuccess) { fprintf(stderr, "kernel_launch: hipFuncSetAttribute failed\n"); grid = -1; return; }
        int per_cu = 0;
        if (hipOccupancyMaxActiveBlocksPerMultiprocessor(&per_cu, (const void*)fwd, NWAVES * 64, LDS_BYTES) != hipSuccess || per_cu < 1) { fprintf(stderr, "kernel_launch: occupancy query reports %d workgroups per CU; nothing launched\n", per_cu); grid = -1; return; }
        grid = cus;
    }
    if (grid < 0) return;
    (void)hipMemsetAsync((char*)d_ws + WS_CTL, 0, CTL_ZERO_BYTES, stream);
    Args a{};
    for (int i = 0; i < N_IN; ++i) a.in[i] = (const float*)d_in[i];
    a.out = (float*)d_out; a.ws = (unsigned char*)d_ws;
    a.ph_lo = 0; a.ph_hi = N_PHASES;
    void* kargs[] = {&a};
    const hipError_t e = hipLaunchCooperativeKernel((const void*)fwd, dim3(grid), dim3(NWAVES * 64), kargs, LDS_BYTES, stream);
    if (e != hipSuccess) fprintf(stderr, "kernel_launch: cooperative launch failed: %s (grid %d)\n", hipGetErrorString(e), grid);
}
```

```cpp
#include <hip/hip_runtime.h>
#include <hip/hip_cooperative_groups.h>
#include <cstdio>
#include <cstdint>

constexpr int BATCH = 8, SEQ = 2048, DM = 1024, DEPTH = 2, M = BATCH * SEQ;
constexpr int RW = 512, NH = 8, HD = 64;
constexpr int RPROJ = 1792, DPROJ = 3328;
constexpr int DFF = 2816;
constexpr int MEMLEN = 256, XH = 4, XHD = 256, MM = BATCH * MEMLEN;
constexpr int MBLK = 256, NBLK = SEQ / MBLK;
constexpr float NORM_EPS = 1e-6f, LNX_EPS = 64e-5f;
constexpr float LOG2E = 1.4426950408889634f;
constexpr float MOBA_QSCALE = 0.125f * LOG2E;
constexpr float XATT_QSCALE = 0.0625f * LOG2E;

enum { I_X = 0, I_MEM, I_RELB, I_FING, I_F1G, I_F1IN, I_F1OUT, I_MIXG, I_MIXIN, I_MIXOUT, I_MU, I_W0, I_WUP, I_A0, I_AUP, I_GUP, I_KK, I_KA, I_RK, I_LNG, I_LNB,
       I_XG, I_MEMG, I_WQ, I_WKV, I_WO, I_F2G, I_F2IN, I_F2OUT, N_IN };

constexpr size_t MiB = 1u << 20;
constexpr size_t WS_CTL = 0, CTL_ZERO_BYTES = 1 * MiB;
constexpr size_t WS_BIAS = 1 * MiB;
constexpr size_t WS_MEMRS = WS_BIAS + 64 * 1024;
constexpr size_t WS_BONUS = WS_MEMRS + 64 * 1024;
constexpr size_t WS_KMS = WS_BONUS + 512 * 1024;
constexpr size_t WS_SSQ = 2 * MiB;
constexpr size_t WS_MEMB = 3 * MiB;
constexpr size_t WS_XK = 7 * MiB, WS_XVT = 11 * MiB;
constexpr size_t WS_W = 15 * MiB;
constexpr size_t W_F1IN = 0, W_F1OUT = W_F1IN + (size_t)2 * DFF * DM * 2, W_F2IN = W_F1OUT + (size_t)DM * DFF * 2, W_F2OUT = W_F2IN + (size_t)2 * DFF * DM * 2,
                 W_MIXIN = W_F2OUT + (size_t)DM * DFF * 2, W_MIXOUT = W_MIXIN + (size_t)DPROJ * DM * 2, W_WQ = W_MIXOUT + (size_t)DM * DM * 2, W_WKV = W_WQ + (size_t)DM * DM * 2,
                 W_WO = W_WKV + (size_t)2 * DM * DM * 2, W_WUPT = W_WO + (size_t)DM * DM * 2, W_AUPT = W_WUPT + (size_t)RW * 64 * 2, W_GUPT = W_AUPT + (size_t)RW * 64 * 2, W_END = W_GUPT + (size_t)RW * 128 * 2;
static_assert(W_END <= 50 * MiB, "weights fit");
constexpr size_t WS_XB = 65 * MiB;
constexpr size_t WS_AR = 97 * MiB;
constexpr size_t AR_H = WS_AR;
constexpr size_t AR_PR = WS_AR, AR_MQ = WS_AR + 56 * MiB, AR_MK = WS_AR + 72 * MiB, AR_MVT = WS_AR + 88 * MiB;
constexpr size_t AR_SCANIN = WS_AR + 56 * MiB;
constexpr size_t AR_SV = WS_AR + 136 * MiB;
constexpr size_t AR_YLOC = WS_AR, AR_Z = WS_AR + 32 * MiB;
constexpr size_t AR_STATE = WS_AR + 152 * MiB;
constexpr size_t AR_XB2 = WS_AR, AR_XQ = WS_AR + 32 * MiB, AR_XO = WS_AR + 64 * MiB;
constexpr size_t WS_END = WS_AR + 168 * MiB;

#define GAS __attribute__((address_space(1)))
#define LAS __attribute__((address_space(3)))

namespace pg8 {
#define PG8_LAS __attribute__((address_space(3)))
typedef unsigned short bf16_t;
typedef short bf16x8 __attribute__((ext_vector_type(8)));
typedef float f32x4 __attribute__((ext_vector_type(4)));
typedef unsigned u32x4 __attribute__((ext_vector_type(4)));
constexpr int BM = 256, BK = 64, HALF = 128, HTB = HALF * BK * 2  , STAGE_BYTES = 8 * HTB, NXCD = 8, WGM = 8;

__host__ __device__ __forceinline__ int lds_byte(int r, int c) { const int st = (r >> 4) * 2 + (c >> 5), rr = r & 15, cc = c & 31, ob = rr * 64 + cc * 2; return st * 1024 + (ob ^ (((ob >> 9) & 1) << 5)); }
__host__ __device__ __forceinline__ void stage_rc(int b, int& R, int& C) { const int st = b / 1024, sb = b % 1024, swz = sb ^ (((sb >> 9) & 1) << 5); R = (st >> 1) * 16 + swz / 64; C = (st & 1) * 32 + (swz % 64) / 2; }
__host__ __device__ __forceinline__ int perm32(int rho) { const int n = rho >> 4, i = rho & 15; return 8 * (i >> 2) + 4 * n + (i & 3); }

struct Unit { int pm, pn, i; };
struct Gemm { const bf16_t* A; const bf16_t* Bt; int M, N, K; };

struct StaticOrder {
    int nM, nN, nwg, G, c;
    __host__ __device__ void init(int M, int N, int G_, int c_) { nM = M / BM; nN = N / BM; nwg = nM * nN; G = G_; c = c_; }
    __host__ __device__ bool next(int i, Unit& u) const {
        const long L = (long)i * G + c; if (L >= nwg) return false;
        int wgid = (int)L; { const int q = nwg / NXCD, r = nwg % NXCD, xcd = wgid % NXCD, off = wgid / NXCD; wgid = (xcd < r ? xcd * (q + 1) : r * (q + 1) + (xcd - r) * q) + off; }
        const int nig = WGM * nN, gid = wgid / nig, fm = gid * WGM, gsz = (nM - fm) < WGM ? (nM - fm) : WGM;
        u.pm = fm + ((wgid % nig) % gsz); u.pn = (wgid % nig) / gsz; u.i = i; return true;
    }
    __device__ __forceinline__ void a_ready(const Unit&) const {}
    __device__ __forceinline__ void done(const Unit&) const {}
};

__device__ __forceinline__ unsigned cvt_pk_bf16(float lo, float hi) { unsigned r; asm volatile("v_cvt_pk_bf16_f32 %0, %1, %2" : "=v"(r) : "v"(lo), "v"(hi)); return r; }
typedef float f32x2 __attribute__((ext_vector_type(2)));
__device__ __forceinline__ float row_rstd16(const float* ssq, int r) {
    const f32x4* p = (const f32x4*)(ssq + (size_t)r * 16);
    const f32x4 a = p[0], b = p[1], c = p[2], d = p[3];
    const float s = ((a[0] + a[1]) + (a[2] + a[3])) + ((b[0] + b[1]) + (b[2] + b[3])) + ((c[0] + c[1]) + (c[2] + c[3])) + ((d[0] + d[1]) + (d[2] + d[3]));
    return __builtin_amdgcn_rsqf(s * (1.0f / 1024.0f) + 1e-6f);
}
constexpr int RST_OFF = 131072;
__device__ __forceinline__ float silu_mul(float g, float u) { return g * __builtin_amdgcn_rcpf(1.0f + __expf(-g)) * u; }
__device__ __forceinline__ u32x4 pack8(const f32x4 v0, const f32x4 v1) { u32x4 w; w.x = cvt_pk_bf16(v0[0], v0[1]); w.y = cvt_pk_bf16(v0[2], v0[3]); w.z = cvt_pk_bf16(v1[0], v1[1]); w.w = cvt_pk_bf16(v1[2], v1[3]); return w; }
__device__ __forceinline__ int pos16(int k) { return 8 * ((k >> 2) & 1) + (k & 3) + 4 * (k >> 3); }

struct EpiSwiGLU {
    static constexpr bool PERM = true, AFTER_DRAIN = false;
    unsigned char* ws; PG8_LAS unsigned char* lds;
    __device__ __forceinline__ void operator()(const f32x4 (&acc)[2][2][4][2], const Unit& u, int wr, int wc, int fr, int fq) const {
        const int row0 = u.pm * BM + wr * 64 + fr, hcol = u.pn * 128 + wc * 32 + 8 * fq; bf16_t* H = (bf16_t*)(ws + AR_H);
        const PG8_LAS float* rst = (const PG8_LAS float*)(lds + RST_OFF) + u.i * 256 + wr * 64 + fr;
#pragma unroll
        for (int ai = 0; ai < 2; ++ai)
#pragma unroll
            for (int m = 0; m < 4; ++m) { const int r = row0 + ai * HALF + m * 16; const float rs = rst[ai * HALF + m * 16];
                f32x4 h0, h1;
#pragma unroll
                for (int i = 0; i < 4; ++i) { h0[i] = silu_mul(acc[ai][0][m][0][i] * rs, acc[ai][1][m][0][i] * rs); h1[i] = silu_mul(acc[ai][0][m][1][i] * rs, acc[ai][1][m][1][i] * rs); }
                *(u32x4*)(H + (size_t)r * 2816 + hcol) = pack8(h0, h1); }
    }
};
struct EpiResid {
    static constexpr bool PERM = true, AFTER_DRAIN = false;
    const float* base; float* out; unsigned char* ws; size_t xb_off; float alpha;
    __device__ __forceinline__ void operator()(const f32x4 (&acc)[2][2][4][2], const Unit& u, int wr, int wc, int fr, int fq) const {
        const int row0 = u.pm * BM + wr * 64 + fr, col0 = u.pn * BM + wc * 32 + 8 * fq; bf16_t* xb = (bf16_t*)(ws + xb_off); float* ssq = (float*)(ws + WS_SSQ);
#pragma unroll
        for (int ai = 0; ai < 2; ++ai) {
            f32x4 bs[4][2][2];
#pragma unroll
            for (int m = 0; m < 4; ++m)
#pragma unroll
                for (int bj = 0; bj < 2; ++bj) { const size_t off = (size_t)(row0 + ai * HALF + m * 16) * 1024 + col0 + bj * HALF; bs[m][bj][0] = *(const f32x4*)(base + off); bs[m][bj][1] = *(const f32x4*)(base + off + 4); }
#pragma unroll
            for (int m = 0; m < 4; ++m)
#pragma unroll
                for (int bj = 0; bj < 2; ++bj) asm volatile("" : "+v"(bs[m][bj][0]), "+v"(bs[m][bj][1]));
#pragma unroll
            for (int m = 0; m < 4; ++m) { const int r = row0 + ai * HALF + m * 16; float s = 0.f;
#pragma unroll
                for (int bj = 0; bj < 2; ++bj) { const size_t off = (size_t)r * 1024 + col0 + bj * HALF;
                    const f32x4 v0 = bs[m][bj][0] + acc[ai][bj][m][0] * alpha, v1 = bs[m][bj][1] + acc[ai][bj][m][1] * alpha;
                    *(f32x4*)(out + off) = v0; *(f32x4*)(out + off + 4) = v1; *(u32x4*)(xb + off) = pack8(v0, v1);
                    s += (v0[0] * v0[0] + v0[1] * v0[1]) + (v0[2] * v0[2] + v0[3] * v0[3]) + (v1[0] * v1[0] + v1[1] * v1[1]) + (v1[2] * v1[2] + v1[3] * v1[3]); }
                s += __shfl_xor(s, 16); s += __shfl_xor(s, 32);
                if (fq == 0) ssq[(size_t)r * 16 + u.pn * 4 + wc] = s; } }
    }
};
struct EpiMixIn {
    static constexpr bool PERM = true, AFTER_DRAIN = false;
    unsigned char* ws; PG8_LAS unsigned char* lds;
    __device__ __forceinline__ void operator()(const f32x4 (&acc)[2][2][4][2], const Unit& u, int wr, int wc, int fr, int fq) const {
        const int row0 = u.pm * BM + wr * 64 + fr, cw = wc * 32 + 8 * fq; const PG8_LAS float* rst = (const PG8_LAS float*)(lds + RST_OFF) + u.i * 256 + wr * 64 + fr;
        bf16_t* PR = (bf16_t*)(ws + AR_PR); bf16_t* MQ = (bf16_t*)(ws + AR_MQ); bf16_t* MK = (bf16_t*)(ws + AR_MK); bf16_t* MVT = (bf16_t*)(ws + AR_MVT);
        f32x4 ks[2][2]; ks[0][0] = (f32x4){0.f, 0.f, 0.f, 0.f}; ks[0][1] = ks[0][0]; ks[1][0] = ks[0][0]; ks[1][1] = ks[0][0];
#pragma unroll
        for (int ai = 0; ai < 2; ++ai)
#pragma unroll
            for (int m = 0; m < 4; ++m) { const int r = row0 + ai * HALF + m * 16; const float rs = rst[ai * HALF + m * 16];
#pragma unroll
                for (int bj = 0; bj < 2; ++bj) { const int c = cw + bj * HALF;
                    f32x4 v0 = acc[ai][bj][m][0] * rs, v1 = acc[ai][bj][m][1] * rs;
                    if (u.pn < 7) *(u32x4*)(PR + (size_t)r * 1792 + u.pn * 256 + c) = pack8(v0, v1);
                    else if (u.pn < 9) { v0 = v0 * MOBA_QSCALE; v1 = v1 * MOBA_QSCALE; *(u32x4*)(MQ + (size_t)r * 512 + (u.pn - 7) * 256 + c) = pack8(v0, v1); }
                    else if (u.pn < 11) { *(u32x4*)(MK + (size_t)r * 512 + (u.pn - 9) * 256 + c) = pack8(v0, v1); ks[bj][0] += v0; ks[bj][1] += v1; }
                    else { const int cc = (u.pn - 11) * 256 + c, hh = cc >> 6, d = cc & 63, b = r >> 11, t = r & 2047;
                        bf16_t* p = MVT + ((size_t)(b * 8 + hh) * 64 + d) * 2048 + (t & ~15) + pos16(t & 15);
                        const u32x4 w = pack8(v0, v1);
                        p[0] = (bf16_t)(w.x & 0xffffu); p[2048] = (bf16_t)(w.x >> 16); p[2 * 2048] = (bf16_t)(w.y & 0xffffu); p[3 * 2048] = (bf16_t)(w.y >> 16);
                        p[4 * 2048] = (bf16_t)(w.z & 0xffffu); p[5 * 2048] = (bf16_t)(w.z >> 16); p[6 * 2048] = (bf16_t)(w.w & 0xffffu); p[7 * 2048] = (bf16_t)(w.w >> 16); }
                } }
        if (u.pn == 9 || u.pn == 10) {
            float* KMS = (float*)(ws + WS_KMS) + ((size_t)u.pm * 2 + wr) * 512 + (u.pn - 9) * 256 + cw;
#pragma unroll
            for (int bj = 0; bj < 2; ++bj)
#pragma unroll
                for (int n = 0; n < 2; ++n) { f32x4 v = ks[bj][n];
#pragma unroll
                    for (int o = 1; o < 16; o <<= 1) { v[0] += __shfl_xor(v[0], o); v[1] += __shfl_xor(v[1], o); v[2] += __shfl_xor(v[2], o); v[3] += __shfl_xor(v[3], o); }
                    if (fr == 0) *(f32x4*)(KMS + bj * HALF + 4 * n) = v; } }
    }
};
struct EpiXQ {
    static constexpr bool PERM = true, AFTER_DRAIN = false;
    unsigned char* ws; PG8_LAS unsigned char* lds;
    __device__ __forceinline__ void operator()(const f32x4 (&acc)[2][2][4][2], const Unit& u, int wr, int wc, int fr, int fq) const {
        const int row0 = u.pm * BM + wr * 64 + fr, col0 = u.pn * BM + wc * 32 + 8 * fq; bf16_t* Q = (bf16_t*)(ws + AR_XQ);
        const PG8_LAS float* rst = (const PG8_LAS float*)(lds + RST_OFF) + u.i * 256 + wr * 64 + fr;
#pragma unroll
        for (int ai = 0; ai < 2; ++ai)
#pragma unroll
            for (int m = 0; m < 4; ++m) { const int r = row0 + ai * HALF + m * 16; const float rs = rst[ai * HALF + m * 16] * XATT_QSCALE;
#pragma unroll
                for (int bj = 0; bj < 2; ++bj) *(u32x4*)(Q + (size_t)r * 1024 + col0 + bj * HALF) = pack8(acc[ai][bj][m][0] * rs, acc[ai][bj][m][1] * rs); }
    }
};
struct EpiKV {
    static constexpr bool PERM = true, AFTER_DRAIN = false;
    unsigned char* ws;
    __device__ __forceinline__ void operator()(const f32x4 (&acc)[2][2][4][2], const Unit& u, int wr, int wc, int fr, int fq) const {
        const int row0 = u.pm * BM + wr * 64 + fr, cw = wc * 32 + 8 * fq; bf16_t* XK = (bf16_t*)(ws + WS_XK); bf16_t* XVT = (bf16_t*)(ws + WS_XVT); const float* memrs = (const float*)(ws + WS_MEMRS);
        float rsv[2][4];
#pragma unroll
        for (int ai = 0; ai < 2; ++ai)
#pragma unroll
            for (int m = 0; m < 4; ++m) rsv[ai][m] = memrs[row0 + ai * HALF + m * 16];
#pragma unroll
        for (int ai = 0; ai < 2; ++ai)
#pragma unroll
            for (int m = 0; m < 4; ++m) { const int r = row0 + ai * HALF + m * 16; const float rs = rsv[ai][m];
#pragma unroll
                for (int bj = 0; bj < 2; ++bj) { const int c = cw + bj * HALF;
                    const f32x4 v0 = acc[ai][bj][m][0] * rs, v1 = acc[ai][bj][m][1] * rs;
                    if (u.pn < 4) *(u32x4*)(XK + (size_t)r * 1024 + u.pn * 256 + c) = pack8(v0, v1);
                    else { const int hx = u.pn - 4, b = r >> 8, key = r & 255;
                        bf16_t* p = XVT + ((size_t)(b * 4 + hx) * 256 + c) * 256 + (key & ~15) + pos16(key & 15);
                        const u32x4 w = pack8(v0, v1);
                        p[0] = (bf16_t)(w.x & 0xffffu); p[256] = (bf16_t)(w.x >> 16); p[2 * 256] = (bf16_t)(w.y & 0xffffu); p[3 * 256] = (bf16_t)(w.y >> 16);
                        p[4 * 256] = (bf16_t)(w.z & 0xffffu); p[5 * 256] = (bf16_t)(w.z >> 16); p[6 * 256] = (bf16_t)(w.w & 0xffffu); p[7 * 256] = (bf16_t)(w.w >> 16); }
                } }
    }
};

template <class Epi, class Sched, bool ALIGN_EPI = false, bool SP2 = false>
__device__ __forceinline__ void gemm_phase(PG8_LAS unsigned char* lds, const Gemm g, const Sched& S, const Epi& E) {
    int tid_ = threadIdx.x; asm volatile("" : "+v"(tid_));
    const int tid = tid_, wid = __builtin_amdgcn_readfirstlane(tid >> 6), lane = tid & 63, wr = wid >> 2, wc = wid & 3, fr = lane & 15, fq = lane >> 4;
    const int K = g.K, nt = K / BK;
    unsigned voffA[2], voffB[2];
#pragma unroll
    for (int i = 0; i < 2; ++i) { int R, C; stage_rc(tid * 16 + i * 8192, R, C); const int Rb = Epi::PERM ? ((R & ~31) + perm32(R & 31)) : R;
        voffA[i] = (unsigned)(R * K + C) * 2u; voffB[i] = (unsigned)(Rb * K + C) * 2u; }
    const size_t kstep = (size_t)(BK * 2);
    const size_t hstep = (size_t)HALF * K * 2;
    const size_t tstep = 2 * hstep;
    const unsigned ldsw = (unsigned)wid * 1024u;
    const int aoff = lds_byte(wr * 64 + fr, fq * 8), boff = lds_byte(wc * 32 + fr, fq * 8);
#define PG8_SA(b, h) (((b) * 2 + (h)) * HTB)
#define PG8_SB(b, h) ((4 + (b) * 2 + (h)) * HTB)
#define PG8_STAGE(bufoff, gbase, voff) do { _Pragma("unroll") for (int _i = 0; _i < 2; ++_i) \
        __builtin_amdgcn_global_load_lds((const unsigned*)((const char*)(gbase) + (voff)[_i]), (PG8_LAS unsigned*)(lds + (bufoff) + ldsw + _i * 8192), 16, 0, 0); } while (0)
#define PG8_LDA(dst, b, h) do { _Pragma("unroll") for (int m = 0; m < 4; ++m) _Pragma("unroll") for (int k = 0; k < 2; ++k) dst[m][k] = *(const PG8_LAS bf16x8*)(lds + PG8_SA(b, h) + aoff + m * 2048 + k * 1024); } while (0)
#define PG8_LDB(dst, b, h) do { _Pragma("unroll") for (int n = 0; n < 2; ++n) _Pragma("unroll") for (int k = 0; k < 2; ++k) dst[n][k] = *(const PG8_LAS bf16x8*)(lds + PG8_SB(b, h) + boff + n * 2048 + k * 1024); } while (0)
#define PG8_MMA(ai, bj, At, Bt) do { __builtin_amdgcn_s_setprio(1); _Pragma("unroll") for (int m = 0; m < 4; ++m) _Pragma("unroll") for (int n = 0; n < 2; ++n) _Pragma("unroll") for (int k = 0; k < 2; ++k) \
        acc[ai][bj][m][n] = __builtin_amdgcn_mfma_f32_16x16x32_bf16(Bt[n][k], At[m][k], acc[ai][bj][m][n], 0, 0, 0); __builtin_amdgcn_s_setprio(0); } while (0)
#define PG8_WAIT_V(n) asm volatile("s_waitcnt vmcnt(" #n ")" ::: "memory")
#define PG8_WAIT_L(n) asm volatile("s_waitcnt lgkmcnt(" #n ")" ::: "memory")
#define PG8_BAR __builtin_amdgcn_s_barrier()
#define PG8_SCHED __builtin_amdgcn_sched_barrier(0)
    Unit cur, nxt; int ui = 0;
    if (!S.next(0, cur)) return;
    f32x4 acc[2][2][4][2];
#pragma unroll
    for (int a = 0; a < 2; ++a)
#pragma unroll
        for (int b = 0; b < 2; ++b)
#pragma unroll
            for (int m = 0; m < 4; ++m)
#pragma unroll
                for (int n = 0; n < 2; ++n) acc[a][b][m][n] = (f32x4){0.f, 0.f, 0.f, 0.f};
    bf16x8 At[4][2], B0[2][2], B1[2][2];
    const char* cA = (const char*)g.A + (size_t)cur.pm * tstep; const char* cB = (const char*)g.Bt + (size_t)cur.pn * tstep;
    S.a_ready(cur);
    if constexpr (SP2) {
        PG8_STAGE(PG8_SB(0, 0), cB, voffB); PG8_STAGE(PG8_SB(0, 1), cB + hstep, voffB); PG8_STAGE(PG8_SA(0, 0), cA, voffA); PG8_STAGE(PG8_SA(0, 1), cA + hstep, voffA);
        if (wr == 1) PG8_BAR;
        PG8_WAIT_V(2); PG8_BAR;
        PG8_STAGE(PG8_SB(1, 0), cB + kstep, voffB); PG8_STAGE(PG8_SA(1, 0), cA + kstep, voffA); PG8_STAGE(PG8_SB(1, 1), cB + hstep + kstep, voffB);
        PG8_WAIT_V(6); PG8_BAR;
    } else {
        PG8_STAGE(PG8_SB(0, 0), cB, voffB); PG8_STAGE(PG8_SA(0, 0), cA, voffA); PG8_STAGE(PG8_SB(0, 1), cB + hstep, voffB); PG8_STAGE(PG8_SA(0, 1), cA + hstep, voffA);
        if (wr == 1) PG8_BAR;
        PG8_WAIT_V(4); PG8_BAR;
        PG8_STAGE(PG8_SB(1, 0), cB + kstep, voffB); PG8_STAGE(PG8_SA(1, 0), cA + kstep, voffA); PG8_STAGE(PG8_SB(1, 1), cB + hstep + kstep, voffB);
        PG8_WAIT_V(6); PG8_BAR;
    }
    for (;;) {
        const bool has_next = S.next(ui + 1, nxt);
        const char* nA = has_next ? (const char*)g.A + (size_t)nxt.pm * tstep : cA; const char* nB = has_next ? (const char*)g.Bt + (size_t)nxt.pn * tstep : cB;
        for (int t = 0; t < nt; t += 2) {
            const bool last = (t == nt - 2);
            const char* a1 = cA + (size_t)(t + 1) * kstep;
            const char* a2 = last ? nA : cA + (size_t)(t + 2) * kstep; const char* b2 = last ? nB : cB + (size_t)(t + 2) * kstep;
            const char* a3 = a2 + kstep; const char* b3 = b2 + kstep;
            if (last && has_next) S.a_ready(nxt);
            if constexpr (SP2) {
            PG8_LDB(B0, 0, 0); PG8_LDB(B1, 0, 1); PG8_SCHED; PG8_LDA(At, 0, 0); PG8_STAGE(PG8_SA(1, 1), a1 + hstep, voffA);
            PG8_WAIT_V(8); PG8_WAIT_L(0); PG8_BAR; PG8_MMA(0, 0, At, B0); PG8_MMA(0, 1, At, B1); PG8_BAR; PG8_SCHED;
            PG8_LDA(At, 0, 1); PG8_STAGE(PG8_SB(0, 0), b2, voffB); PG8_STAGE(PG8_SB(0, 1), b2 + hstep, voffB); PG8_STAGE(PG8_SA(0, 0), a2, voffA);
            PG8_WAIT_V(8); PG8_WAIT_L(0); PG8_BAR; PG8_MMA(1, 0, At, B0); PG8_MMA(1, 1, At, B1); PG8_BAR; PG8_SCHED;
            PG8_LDB(B0, 1, 0); PG8_LDB(B1, 1, 1); PG8_SCHED; PG8_LDA(At, 1, 0); PG8_STAGE(PG8_SA(0, 1), a2 + hstep, voffA);
            PG8_WAIT_V(8); PG8_WAIT_L(0); PG8_BAR; PG8_MMA(0, 0, At, B0); PG8_MMA(0, 1, At, B1); PG8_BAR; PG8_SCHED;
            PG8_LDA(At, 1, 1); PG8_STAGE(PG8_SB(1, 0), b3, voffB); PG8_STAGE(PG8_SB(1, 1), b3 + hstep, voffB); PG8_STAGE(PG8_SA(1, 0), a3, voffA);
            PG8_WAIT_V(8); PG8_WAIT_L(0); PG8_BAR; PG8_MMA(1, 0, At, B0); PG8_MMA(1, 1, At, B1); PG8_BAR; PG8_SCHED;
            } else {
            PG8_LDB(B0, 0, 0); PG8_SCHED; PG8_LDA(At, 0, 0); PG8_STAGE(PG8_SA(1, 1), a1 + hstep, voffA);
            PG8_WAIT_L(8); PG8_BAR; PG8_WAIT_L(0); PG8_MMA(0, 0, At, B0); PG8_BAR; PG8_SCHED;
            PG8_LDB(B1, 0, 1); PG8_STAGE(PG8_SB(0, 0), b2, voffB);
            PG8_BAR; PG8_WAIT_L(0); PG8_MMA(0, 1, At, B1); PG8_BAR;
            PG8_LDA(At, 0, 1); PG8_STAGE(PG8_SA(0, 0), a2, voffA);
            PG8_BAR; PG8_WAIT_L(0); PG8_MMA(1, 0, At, B0); PG8_BAR; PG8_SCHED;
            PG8_STAGE(PG8_SB(0, 1), b2 + hstep, voffB);
            PG8_WAIT_V(6); PG8_BAR; PG8_MMA(1, 1, At, B1); PG8_BAR;
            PG8_LDB(B0, 1, 0); PG8_SCHED; PG8_LDA(At, 1, 0); PG8_STAGE(PG8_SA(0, 1), a2 + hstep, voffA);
            PG8_WAIT_L(8); PG8_BAR; PG8_WAIT_L(0); PG8_MMA(0, 0, At, B0); PG8_BAR; PG8_SCHED;
            PG8_LDB(B1, 1, 1); PG8_STAGE(PG8_SB(1, 0), b3, voffB);
            PG8_BAR; PG8_WAIT_L(0); PG8_MMA(0, 1, At, B1); PG8_BAR;
            PG8_LDA(At, 1, 1); PG8_STAGE(PG8_SA(1, 0), a3, voffA);
            PG8_BAR; PG8_WAIT_L(0); PG8_MMA(1, 0, At, B0); PG8_BAR; PG8_SCHED;
            PG8_STAGE(PG8_SB(1, 1), b3 + hstep, voffB);
            PG8_WAIT_V(6); PG8_BAR; PG8_MMA(1, 1, At, B1); PG8_BAR;
            }
        }
        if constexpr (ALIGN_EPI) { if (wr == 0) PG8_BAR; }
        if constexpr (!Epi::AFTER_DRAIN) { E(acc, cur, wr, wc, fr, fq); S.done(cur); }
        if (!has_next) break;
#pragma unroll
        for (int a = 0; a < 2; ++a)
#pragma unroll
            for (int b = 0; b < 2; ++b)
#pragma unroll
                for (int m = 0; m < 4; ++m)
#pragma unroll
                    for (int n = 0; n < 2; ++n) acc[a][b][m][n] = (f32x4){0.f, 0.f, 0.f, 0.f};
        cur = nxt; cA = nA; cB = nB; ++ui;
        if constexpr (ALIGN_EPI) { if (wr == 1) PG8_BAR; }
    }
    PG8_WAIT_V(0);
    if constexpr (!ALIGN_EPI) { if (wr == 0) PG8_BAR; }
    PG8_BAR;
    if constexpr (Epi::AFTER_DRAIN) { E.fused(acc, cur, wr, wc, fr, fq, lds, wid, lane); S.done(cur); }
#undef PG8_SA
#undef PG8_SB
#undef PG8_STAGE
#undef PG8_LDA
#undef PG8_LDB
#undef PG8_MMA
#undef PG8_WAIT_V
#undef PG8_WAIT_L
#undef PG8_BAR
#undef PG8_SCHED
}
}

constexpr int NWAVES = 8;
constexpr int LDS_BYTES = 163840, LDSCTL_OFF = LDS_BYTES - 512, MISC_OFF = LDSCTL_OFF + 320, PHASE_LDS = LDSCTL_OFF;
constexpr int SCAN_R = 2, SCAN_NCH = 8;

typedef unsigned short bf16;
typedef unsigned u32x4 __attribute__((ext_vector_type(4)));
typedef unsigned u32x2 __attribute__((ext_vector_type(2)));
typedef float f32x4 __attribute__((ext_vector_type(4)));
typedef float f32x16 __attribute__((ext_vector_type(16)));
typedef short bf16x8 __attribute__((ext_vector_type(8)));
typedef GAS unsigned gu32;
#define RLX_AGENT __ATOMIC_RELAXED, __HIP_MEMORY_SCOPE_AGENT
#define LDS_WAIT() asm volatile("s_waitcnt lgkmcnt(0)" ::: "memory")
#define VM_WAIT() asm volatile("s_waitcnt vmcnt(0)" ::: "memory")
__device__ __forceinline__ float bf2f(unsigned b) { return __uint_as_float(b << 16); }
__device__ __forceinline__ unsigned f2bf(float f) { unsigned u = __builtin_bit_cast(unsigned, f); return (u + 0x7fffu + ((u >> 16) & 1u)) >> 16; }
__device__ __forceinline__ unsigned pk2(float lo, float hi) { return pg8::cvt_pk_bf16(lo, hi); }
__device__ __forceinline__ float wave_sum(float v) {
#pragma unroll
    for (int o = 1; o < 64; o <<= 1) v += __shfl_xor(v, o);
    return v;
}
#define WS8_STEP(o) _Pragma("unroll") for (int q = 0; q < 8; ++q) v[q] += __shfl_xor(v[q], o);
__device__ __forceinline__ void wave_sum8(float (&v)[8]) { WS8_STEP(1) WS8_STEP(2) WS8_STEP(4) WS8_STEP(8) WS8_STEP(16) WS8_STEP(32) }
__device__ __forceinline__ float quad_sum(float x) {
    x += __builtin_bit_cast(float, __builtin_amdgcn_update_dpp(0, __builtin_bit_cast(int, x), 0xB1, 0xF, 0xF, true));
    x += __builtin_bit_cast(float, __builtin_amdgcn_update_dpp(0, __builtin_bit_cast(int, x), 0x4E, 0xF, 0xF, true));
    return x;
}
__device__ __forceinline__ float sigmoidf_(float x) { return __builtin_amdgcn_rcpf(1.0f + __expf(-x)); }
__device__ __forceinline__ int crow(int r, int hi) { return (r & 3) + 8 * (r >> 2) + 4 * hi; }
__device__ __forceinline__ bf16x8 pack_bf16x8(float a0, float a1, float a2, float a3, float a4, float a5, float a6, float a7) {
    u32x4 w; w.x = pk2(a0, a1); w.y = pk2(a2, a3); w.z = pk2(a4, a5); w.w = pk2(a6, a7); return __builtin_bit_cast(bf16x8, w);
}

#define XB_TMO      128
#define XB_XCNT(j)  (256  + 64 * (j))
#define XB_XSUB(j)  (1280 + 64 * (j))
#define XB_XGEN(j)  (2304 + 64 * (j))
#define XB_TOP      3328
#define XB_TOPGEN   3392
#define XCD_BAR_WORDS 3456
#define XB_SPIN_CAP (1u << 18)

__device__ __forceinline__ unsigned xb_ld(unsigned* p)              { return __hip_atomic_load(p, __ATOMIC_RELAXED, __HIP_MEMORY_SCOPE_AGENT); }
__device__ __forceinline__ unsigned xb_add(unsigned* p, unsigned v) { return __hip_atomic_fetch_add(p, v, __ATOMIC_RELAXED, __HIP_MEMORY_SCOPE_AGENT); }
__device__ __forceinline__ unsigned xb_xcc_id() { return (unsigned)__builtin_amdgcn_s_getreg((3 << 11) | 20) & 0xFu; }
#define XB_SPIN(cond, bar) do { unsigned _sp = 0; while (cond) { __builtin_amdgcn_s_sleep(1); \
    if ((++_sp & 255u) == 0u) { if (xb_ld(&(bar)[XB_TMO])) break; if (_sp > XB_SPIN_CAP) { atomicAdd(&(bar)[XB_TMO], 1u); break; } } } } while (0)

struct XcdBarrier {
    unsigned* bar; unsigned x;
    volatile LAS unsigned* st;
};

__device__ __forceinline__ XcdBarrier xcd_barrier_post(unsigned* bar, volatile LAS unsigned* st) {
    XcdBarrier b; b.bar = bar; b.x = xb_xcc_id(); b.st = st;
    if (threadIdx.x == 0) (void)xb_add(&bar[XB_XCNT(b.x)], 1u);
    return b;
}
__device__ __forceinline__ void xcd_barrier_complete(unsigned* bar, unsigned x, unsigned& nloc, unsigned& nx) {
    const unsigned G = gridDim.x * gridDim.y * gridDim.z;
    unsigned sum, cnt, mine, sp = 0u;
    for (;;) {
        sum = 0u; cnt = 0u; mine = 0u;
#pragma unroll
        for (unsigned j = 0; j < 16; ++j) { const unsigned c = xb_ld(&bar[XB_XCNT(j)]); sum += c; cnt += (c > 0u) ? 1u : 0u; mine = (j == x) ? c : mine; }
        if (sum == G) break;
        __builtin_amdgcn_s_sleep(1);
        if ((++sp & 255u) == 0u) { if (xb_ld(&bar[XB_TMO])) break; if (sp > XB_SPIN_CAP) { atomicAdd(&bar[XB_TMO], 1u); break; } }
    }
    nloc = mine > 0u ? mine : 1u; nx = cnt > 0u ? cnt : 1u;
}

__device__ __forceinline__ void xcd_barrier(const XcdBarrier& b) {
    asm volatile("s_waitcnt vmcnt(0)" ::: "memory");
    __syncthreads();
    if (threadIdx.x == 0) {
        unsigned* bar = b.bar;
        __builtin_amdgcn_s_waitcnt(0);
        unsigned nloc = b.st[0], nx = b.st[1];
        if (nloc == 0u) { xcd_barrier_complete(bar, b.x, nloc, nx); b.st[0] = nloc; b.st[1] = nx; }
        const unsigned old = xb_add(&bar[XB_XSUB(b.x)], 1u);
        const unsigned gen = old / nloc;
        if (old + 1u == (gen + 1u) * nloc) {
            __builtin_amdgcn_fence(__ATOMIC_RELEASE, "agent");
            asm volatile("s_waitcnt vmcnt(0)" ::: "memory");
            const unsigned og = xb_add(&bar[XB_TOP], 1u);
            const unsigned tg = og / nx;
            if (og + 1u == (tg + 1u) * nx) xb_add(&bar[XB_TOPGEN], 1u);
            else XB_SPIN(xb_ld(&bar[XB_TOPGEN]) == tg, bar);
            __builtin_amdgcn_fence(__ATOMIC_ACQUIRE, "agent");
            xb_add(&bar[XB_XGEN(b.x)], 1u);
            asm volatile("s_waitcnt vmcnt(0)" ::: "memory");
        } else {
            XB_SPIN(xb_ld(&bar[XB_XGEN(b.x)]) == gen, bar);
            __builtin_amdgcn_fence(__ATOMIC_ACQUIRE, "agent");
            asm volatile("s_waitcnt vmcnt(0)" ::: "memory");
        }
    }
    __syncthreads();
}


struct Args { const float* in[N_IN]; float* out; unsigned char* ws; int ph_lo, ph_hi; };
static_assert(sizeof(Args) == N_IN * 8 + 24, "Args has no padding");
struct Frame {
    LAS unsigned char* lds; volatile LAS unsigned* MISC; gu32* ctl;
    int tid, lane, wave, vcu, G;
    const __attribute__((address_space(4))) struct Args* ka; float* out; unsigned char* ws;
};
#define FIN(i) (F.ka->in[i])
#define PHASE_IDS() do { int t_ = threadIdx.x; asm volatile("" : "+v"(t_)); F.tid = t_; F.lane = t_ & 63; F.wave = __builtin_amdgcn_readfirstlane(t_ >> 6); } while (0)
#define WSP(T, off) ((T*)(F.ws + (off)))

__device__ __forceinline__ void fill_rstd(Frame& F, const pg8::StaticOrder& S) {
    int tid = threadIdx.x; asm volatile("" : "+v"(tid)); LAS float* tab = (LAS float*)(F.lds + pg8::RST_OFF); const float* ssq = WSP(float, WS_SSQ);
    pg8::Unit u;
    for (int i0 = 0; S.next(i0, u); i0 += 2) { const int i = i0 + (tid >> 8); if (S.next(i, u)) tab[i * 256 + (tid & 255)] = pg8::row_rstd16(ssq, u.pm * 256 + (tid & 255)); }
    __syncthreads();
}

__device__ __forceinline__ void ph_init(Frame& F) {
    PHASE_IDS();
    const int gw = F.vcu * NWAVES + F.wave, NGW = F.G * NWAVES;
    float* bias = WSP(float, WS_BIAS); const float* relb = FIN(I_RELB);
    for (int i = blockIdx.x * 512 + F.tid; i < NH * 2048; i += F.G * 512) { const int h = i >> 11, n = i & 2047; int bkt;
        if (n < 16) bkt = n; else { const float nf = (float)n; const int lg = 16 + (int)(logf(nf / 16.0f) / 4.1588830833596715f * 16.0f); bkt = lg < 31 ? lg : 31; }
        bias[i] = relb[h * 32 + bkt] * LOG2E; }
    const float* mem = FIN(I_MEM); bf16* memb = WSP(bf16, WS_MEMB); float* memrs = WSP(float, WS_MEMRS);
    for (int r = gw; r < MM; r += NGW) { const f32x4* xr = (const f32x4*)(mem + (size_t)r * DM) + F.lane; f32x4 v[4]; float s = 0.f;
#pragma unroll
        for (int j = 0; j < 4; ++j) { v[j] = xr[64 * j]; s += (v[j].x * v[j].x + v[j].y * v[j].y) + (v[j].z * v[j].z + v[j].w * v[j].w); }
        s = wave_sum(s); u32x2* o = (u32x2*)(memb + (size_t)r * DM) + F.lane;
#pragma unroll
        for (int j = 0; j < 4; ++j) { u32x2 w; w.x = pk2(v[j].x, v[j].y); w.y = pk2(v[j].z, v[j].w); o[64 * j] = w; }
        if (F.lane == 0) memrs[r] = __builtin_amdgcn_rsqf(s * (1.0f / DM) + NORM_EPS); }
    const float* x = FIN(I_X); bf16* xb = WSP(bf16, WS_XB); float* ssq = WSP(float, WS_SSQ);
    for (int r = gw; r < M; r += NGW) { const f32x4* xr = (const f32x4*)(x + (size_t)r * DM) + F.lane; f32x4 v[4]; float s = 0.f;
#pragma unroll
        for (int j = 0; j < 4; ++j) { v[j] = xr[64 * j]; s += (v[j].x * v[j].x + v[j].y * v[j].y) + (v[j].z * v[j].z + v[j].w * v[j].w); }
        s = wave_sum(s); u32x2* o = (u32x2*)(xb + (size_t)r * DM) + F.lane;
#pragma unroll
        for (int j = 0; j < 4; ++j) { u32x2 w; w.x = pk2(v[j].x, v[j].y); w.y = pk2(v[j].z, v[j].w); o[64 * j] = w; }
        if (F.lane < 16) ssq[(size_t)r * 16 + F.lane] = F.lane == 0 ? s : 0.f; }
}

__device__ __forceinline__ void conv_item(const float* W, int K, int N, const float* gk, bf16* WT, int item, bool ffn_in, LAS float* scr, int lane) {
    const int nblk = N / 32, kb = item / nblk, nb = item % nblk, k0 = 64 * kb, n0 = 32 * nb;
#pragma unroll 8
    for (int i = 0; i < 32; ++i) { const int kk = 2 * i + (lane >> 5); float w = W[(size_t)(k0 + kk) * N + n0 + (lane & 31)]; if (gk) w *= gk[k0 + kk]; scr[kk * 33 + (lane & 31)] = w; }
    LDS_WAIT(); asm volatile("" ::: "memory");
    int drow0 = n0; if (ffn_in) drow0 = n0 < DFF ? 256 * (n0 / 128) + (n0 % 128) : 256 * ((n0 - DFF) / 128) + 128 + ((n0 - DFF) % 128);
    const int c = lane & 7;
#pragma unroll
    for (int j = 0; j < 4; ++j) { const int n = (lane >> 3) + 8 * j; const LAS float* s = scr + (8 * c) * 33 + n;
        u32x4 o; o.x = pk2(s[0 * 33], s[1 * 33]); o.y = pk2(s[2 * 33], s[3 * 33]); o.z = pk2(s[4 * 33], s[5 * 33]); o.w = pk2(s[6 * 33], s[7 * 33]);
        *(u32x4*)(WT + (size_t)(drow0 + n) * K + k0 + 8 * c) = o; }
    LDS_WAIT(); asm volatile("" ::: "memory");
}
__device__ __forceinline__ void ph_conv(Frame& F, int l) {
    PHASE_IDS();
    LAS float* scr = (LAS float*)(F.lds + F.wave * 16384);
    const int gw = F.vcu * NWAVES + F.wave, NGW = F.G * NWAVES;
    constexpr int I_FIN = (DM / 64) * (2 * DFF / 32), I_FOUT = (DFF / 64) * (DM / 32), I_MI = (DM / 64) * (DPROJ / 32), I_SQ = (DM / 64) * (DM / 32), I_KV = (DM / 64) * (2 * DM / 32);
    constexpr int I_L64 = (64 / 64) * (RW / 32), I_L128 = (128 / 64) * (RW / 32);
    constexpr int NITEMS = 2 * I_FIN + 2 * I_FOUT + I_MI + 3 * I_SQ + I_KV + 2 * I_L64 + I_L128;
    unsigned char* wb = F.ws + WS_W;
    for (int it = gw; it < NITEMS; it += NGW) { int r = it;
        if (r < I_FIN) { conv_item(FIN(I_F1IN) + (size_t)l * DM * 2 * DFF, DM, 2 * DFF, FIN(I_F1G) + l * DM, (bf16*)(wb + W_F1IN), r, true, scr, F.lane); continue; } r -= I_FIN;
        if (r < I_FIN) { conv_item(FIN(I_F2IN) + (size_t)l * DM * 2 * DFF, DM, 2 * DFF, FIN(I_F2G) + l * DM, (bf16*)(wb + W_F2IN), r, true, scr, F.lane); continue; } r -= I_FIN;
        if (r < I_FOUT) { conv_item(FIN(I_F1OUT) + (size_t)l * DFF * DM, DFF, DM, nullptr, (bf16*)(wb + W_F1OUT), r, false, scr, F.lane); continue; } r -= I_FOUT;
        if (r < I_FOUT) { conv_item(FIN(I_F2OUT) + (size_t)l * DFF * DM, DFF, DM, nullptr, (bf16*)(wb + W_F2OUT), r, false, scr, F.lane); continue; } r -= I_FOUT;
        if (r < I_MI) { conv_item(FIN(I_MIXIN) + (size_t)l * DM * DPROJ, DM, DPROJ, FIN(I_MIXG) + l * DM, (bf16*)(wb + W_MIXIN), r, false, scr, F.lane); continue; } r -= I_MI;
        if (r < I_SQ) { conv_item(FIN(I_MIXOUT) + (size_t)l * DM * DM, DM, DM, nullptr, (bf16*)(wb + W_MIXOUT), r, false, scr, F.lane); continue; } r -= I_SQ;
        if (r < I_SQ) { conv_item(FIN(I_WQ) + (size_t)l * DM * DM, DM, DM, FIN(I_XG) + l * DM, (bf16*)(wb + W_WQ), r, false, scr, F.lane); continue; } r -= I_SQ;
        if (r < I_SQ) { conv_item(FIN(I_WO) + (size_t)l * DM * DM, DM, DM, nullptr, (bf16*)(wb + W_WO), r, false, scr, F.lane); continue; } r -= I_SQ;
        if (r < I_KV) { conv_item(FIN(I_WKV) + (size_t)l * DM * 2 * DM, DM, 2 * DM, FIN(I_MEMG) + l * DM, (bf16*)(wb + W_WKV), r, false, scr, F.lane); continue; } r -= I_KV;
        if (r < I_L64) { conv_item(FIN(I_WUP) + (size_t)l * 64 * RW, 64, RW, nullptr, (bf16*)(wb + W_WUPT), r, false, scr, F.lane); continue; } r -= I_L64;
        if (r < I_L64) { conv_item(FIN(I_AUP) + (size_t)l * 64 * RW, 64, RW, nullptr, (bf16*)(wb + W_AUPT), r, false, scr, F.lane); continue; } r -= I_L64;
        conv_item(FIN(I_GUP) + (size_t)l * 128 * RW, 128, RW, nullptr, (bf16*)(wb + W_GUPT), r, false, scr, F.lane);
    }
}

__device__ __forceinline__ void ph_moba(Frame& F) {
    PHASE_IDS();
    constexpr int KROW = 144, KBUF = 64 * KROW, OFF_K = 12288, OFF_V = OFF_K + 2 * KBUF;
    LAS float* kmean = (LAS float*)F.lds;
    LAS float* btab = (LAS float*)(F.lds + 2048);
    volatile LAS unsigned* needw = (volatile LAS unsigned*)(F.lds + 10240);
    const bf16* MQ = WSP(bf16, AR_MQ); const bf16* MK = WSP(bf16, AR_MK); const bf16* MVT = WSP(bf16, AR_MVT); bf16* XB = WSP(bf16, WS_XB); const float* bias = WSP(float, WS_BIAS);
    const int lane = F.lane, r32 = lane & 31, hi = lane >> 5, wave = F.wave, tid = F.tid;
    for (int u = blockIdx.x; u < 512; u += F.G) {
        const int rnd = u >> 8, iu = u & 255, qsel = iu >> 6, bh = iu & 63, qb = rnd == 0 ? 7 - qsel : qsel, b = bh >> 3, hh = bh & 7;
        __syncthreads();
        { const int n = tid >> 6, d = tid & 63;
          if (n < qb) { const float* kp = WSP(float, WS_KMS) + ((size_t)(b * 8 + n) * 2) * 512 + hh * 64 + d; kmean[n * 64 + d] = (kp[0] + kp[512]) * (1.0f / 256.0f); }
          for (int i2 = tid; i2 < 2048; i2 += 512) btab[i2] = bias[hh * 2048 + i2];
          if (tid == 0) needw[0] = 0u; }
        __syncthreads();
        const int q0 = qb * 256 + wave * 32; const size_t tok = (size_t)b * 2048 + q0 + r32;
        bf16x8 qf[4];
#pragma unroll
        for (int s = 0; s < 4; ++s) qf[s] = *(const bf16x8*)(MQ + tok * 512 + hh * 64 + 16 * s + 8 * hi);
        float g[7]; unsigned selmask = 0u;
#pragma unroll
        for (int n = 0; n < 7; ++n) { g[n] = -INFINITY;
            if (n < qb) { float p = 0.f;
#pragma unroll
                for (int s = 0; s < 4; ++s) { const f32x4 k0v = *(const LAS f32x4*)(kmean + n * 64 + 16 * s + 8 * hi), k1v = *(const LAS f32x4*)(kmean + n * 64 + 16 * s + 8 * hi + 4);
                    p += bf2f((unsigned short)qf[s][0]) * k0v[0] + bf2f((unsigned short)qf[s][1]) * k0v[1] + bf2f((unsigned short)qf[s][2]) * k0v[2] + bf2f((unsigned short)qf[s][3]) * k0v[3]
                       + bf2f((unsigned short)qf[s][4]) * k1v[0] + bf2f((unsigned short)qf[s][5]) * k1v[1] + bf2f((unsigned short)qf[s][6]) * k1v[2] + bf2f((unsigned short)qf[s][7]) * k1v[3]; }
                p += __shfl_xor(p, 32); g[n] = p; } }
        if (qb <= 3) selmask = (1u << qb) - 1u;
        else {
#pragma unroll
            for (int n = 0; n < 7; ++n) if (n < qb) { int cnt = 0;
#pragma unroll
                for (int n2 = 0; n2 < 7; ++n2) if (n2 != n && n2 < qb) cnt += (g[n2] > g[n] || (g[n2] == g[n] && n2 < n)) ? 1 : 0;
                if (cnt < 3) selmask |= 1u << n; } }
        unsigned wmask = 0u;
#pragma unroll
        for (int n = 0; n < 7; ++n) if (__ballot((selmask >> n) & 1u) != 0ull) wmask |= 1u << n;
        if (lane == 0 && wmask) __hip_atomic_fetch_or((LAS unsigned*)needw, wmask, __ATOMIC_RELAXED, __HIP_MEMORY_SCOPE_WORKGROUP);
        __syncthreads();
        const unsigned need = needw[0] | (1u << qb);
        float mrun = -INFINITY, lrun = 0.f; f32x16 o0, o1;
#pragma unroll
        for (int i = 0; i < 16; ++i) { o0[i] = 0.f; o1[i] = 0.f; }
        const int qpos = q0 + r32;
        const bf16* Kg = MK + ((size_t)b * 2048 + (tid >> 3)) * 512 + hh * 64 + (tid & 7) * 8;
        const bf16* Vg = MVT + ((size_t)(b * 8 + hh) * 64 + (tid >> 3)) * 2048 + (tid & 7) * 8;
        const int sto = (tid >> 3) * KROW + (tid & 7) * 16;
        int blk = 0; while (!((need >> blk) & 1u)) ++blk;
        int kt = 0, it = 0;
        { const int k0 = blk * 256; const u32x4 kr = *(const u32x4*)(Kg + (size_t)k0 * 512), vr = *(const u32x4*)(Vg + k0);
          *(LAS u32x4*)(F.lds + OFF_K + sto) = kr; *(LAS u32x4*)(F.lds + OFF_V + sto) = vr; }
        __syncthreads();
        while (blk <= qb) {
            int nblk = blk, nkt = kt + 1; if (nkt == 4) { nkt = 0; ++nblk; while (nblk <= qb && !((need >> nblk) & 1u)) ++nblk; }
            const bool more = nblk <= qb; u32x4 kr, vr;
            if (more) { const int k0n = nblk * 256 + nkt * 64; kr = *(const u32x4*)(Kg + (size_t)k0n * 512); vr = *(const u32x4*)(Vg + k0n); }
            const int k0 = blk * 256 + kt * 64; const bool own = blk == qb; const bool selme = own || ((selmask >> blk) & 1u);
            const bool active = own ? (k0 <= q0 + 31) : (__ballot(selme) != 0ull);
            if (active) {
                const LAS unsigned char* kb = F.lds + OFF_K + (it & 1) * KBUF + r32 * KROW + 16 * hi;
                const LAS unsigned char* vb = F.lds + OFF_V + (it & 1) * KBUF + r32 * KROW + 16 * hi;
                const bool h1 = !own || (k0 + 32 <= q0 + 31);
                f32x16 s0, s1;
#pragma unroll
                for (int i = 0; i < 16; ++i) { s0[i] = 0.f; s1[i] = 0.f; }
#pragma unroll
                for (int s = 0; s < 4; ++s) s0 = __builtin_amdgcn_mfma_f32_32x32x16_bf16(*(const LAS bf16x8*)(kb + 32 * s), qf[s], s0, 0, 0, 0);
                if (h1) {
#pragma unroll
                    for (int s = 0; s < 4; ++s) s1 = __builtin_amdgcn_mfma_f32_32x32x16_bf16(*(const LAS bf16x8*)(kb + 32 * KROW + 32 * s), qf[s], s1, 0, 0, 0); }
                float mx = -INFINITY;
                float bv0[16], bv1[16];
#pragma unroll
                for (int r = 0; r < 16; ++r) { const int d0 = qpos - (k0 + crow(r, hi)), d1 = d0 - 32; bv0[r] = btab[d0 < 0 ? 0 : d0]; bv1[r] = btab[d1 < 0 ? 0 : d1]; }
#pragma unroll
                for (int r = 0; r < 16; ++r) asm volatile("" : "+v"(bv0[r]), "+v"(bv1[r]));
#pragma unroll
                for (int r = 0; r < 16; ++r) { const int d0 = qpos - (k0 + crow(r, hi)), d1 = d0 - 32;
                    const bool v0 = selme && (!own || d0 >= 0), v1 = h1 && selme && (!own || d1 >= 0);
                    const float a0 = v0 ? s0[r] + bv0[r] : -INFINITY, a1 = v1 ? s1[r] + bv1[r] : -INFINITY;
                    s0[r] = a0; s1[r] = a1; mx = fmaxf(mx, fmaxf(a0, a1)); }
                mx = fmaxf(mx, __shfl_xor(mx, 32));
                const float mnew = fmaxf(mrun, mx), muse = (mnew == -INFINITY) ? 0.f : mnew;
                const float alpha = __builtin_amdgcn_exp2f(mrun - muse);
                float ps = 0.f;
#pragma unroll
                for (int r = 0; r < 16; ++r) { const float p0 = __builtin_amdgcn_exp2f(s0[r] - muse), p1 = __builtin_amdgcn_exp2f(s1[r] - muse); s0[r] = p0; s1[r] = p1; ps += p0 + p1; }
                lrun = lrun * alpha + ps; mrun = mnew;
#pragma unroll
                for (int i = 0; i < 16; ++i) { o0[i] *= alpha; o1[i] *= alpha; }
                const bf16x8 pa0 = pack_bf16x8(s0[0], s0[1], s0[2], s0[3], s0[4], s0[5], s0[6], s0[7]), pa1 = pack_bf16x8(s0[8], s0[9], s0[10], s0[11], s0[12], s0[13], s0[14], s0[15]);
                o0 = __builtin_amdgcn_mfma_f32_32x32x16_bf16(*(const LAS bf16x8*)(vb), pa0, o0, 0, 0, 0); o0 = __builtin_amdgcn_mfma_f32_32x32x16_bf16(*(const LAS bf16x8*)(vb + 32), pa1, o0, 0, 0, 0);
                o1 = __builtin_amdgcn_mfma_f32_32x32x16_bf16(*(const LAS bf16x8*)(vb + 32 * KROW), pa0, o1, 0, 0, 0); o1 = __builtin_amdgcn_mfma_f32_32x32x16_bf16(*(const LAS bf16x8*)(vb + 32 * KROW + 32), pa1, o1, 0, 0, 0);
                if (h1) {
                    const bf16x8 pb0 = pack_bf16x8(s1[0], s1[1], s1[2], s1[3], s1[4], s1[5], s1[6], s1[7]), pb1 = pack_bf16x8(s1[8], s1[9], s1[10], s1[11], s1[12], s1[13], s1[14], s1[15]);
                    o0 = __builtin_amdgcn_mfma_f32_32x32x16_bf16(*(const LAS bf16x8*)(vb + 64), pb0, o0, 0, 0, 0); o0 = __builtin_amdgcn_mfma_f32_32x32x16_bf16(*(const LAS bf16x8*)(vb + 96), pb1, o0, 0, 0, 0);
                    o1 = __builtin_amdgcn_mfma_f32_32x32x16_bf16(*(const LAS bf16x8*)(vb + 32 * KROW + 64), pb0, o1, 0, 0, 0); o1 = __builtin_amdgcn_mfma_f32_32x32x16_bf16(*(const LAS bf16x8*)(vb + 32 * KROW + 96), pb1, o1, 0, 0, 0); }
            }
            if (more) { *(LAS u32x4*)(F.lds + OFF_K + ((it + 1) & 1) * KBUF + sto) = kr; *(LAS u32x4*)(F.lds + OFF_V + ((it + 1) & 1) * KBUF + sto) = vr; }
            __syncthreads();
            blk = nblk; kt = nkt; ++it;
        }
        lrun += __shfl_xor(lrun, 32); const float inv = 1.0f / lrun;
        bf16* op = XB + tok * 1024 + 512 + hh * 64 + 4 * hi;
#pragma unroll
        for (int g4 = 0; g4 < 4; ++g4) { u32x2 w0, w1; w0.x = pk2(o0[4 * g4] * inv, o0[4 * g4 + 1] * inv); w0.y = pk2(o0[4 * g4 + 2] * inv, o0[4 * g4 + 3] * inv);
            w1.x = pk2(o1[4 * g4] * inv, o1[4 * g4 + 1] * inv); w1.y = pk2(o1[4 * g4 + 2] * inv, o1[4 * g4 + 3] * inv);
            *(u32x2*)(op + 8 * g4) = w0; *(u32x2*)(op + 32 + 8 * g4) = w1; }
    }
}

__device__ __forceinline__ void ph_xatt(Frame& F) {
    PHASE_IDS();
    constexpr int KROW = 528, KBUF = 32 * KROW, VROW = 80, VBUF = 256 * VROW, OFF_K = 0, OFF_V = 2 * KBUF;
    const bf16* XQ = WSP(bf16, AR_XQ); const bf16* XK = WSP(bf16, WS_XK); const bf16* XVT = WSP(bf16, WS_XVT); bf16* XO = WSP(bf16, AR_XO);
    const int lane = F.lane, r32 = lane & 31, hi = lane >> 5, wave = F.wave, tid = F.tid;
    for (int u = blockIdx.x; u < 256; u += F.G) {
        const int b = u >> 5, hx = (u >> 3) & 3, qt = u & 7;
        const size_t tok = (size_t)b * 2048 + qt * 256 + wave * 32 + r32;
        const bf16* Qg = XQ + tok * 1024 + hx * 256 + 8 * hi;
        const bf16* Kg = XK + (size_t)(b * 256 + (tid >> 5)) * 1024 + hx * 256 + (tid & 31) * 8;
        const bf16* Vg = XVT + ((size_t)(b * 4 + hx) * 256 + (tid >> 2)) * 256 + (tid & 3) * 8;
        const int ksto = (tid >> 5) * KROW + (tid & 31) * 16, vsto = (tid >> 2) * VROW + (tid & 3) * 16;
        float mrun = -INFINITY, lrun = 0.f; f32x16 o[8];
#pragma unroll
        for (int dt = 0; dt < 8; ++dt)
#pragma unroll
            for (int i = 0; i < 16; ++i) o[dt][i] = 0.f;
        __syncthreads();
        { const u32x4 k0r = *(const u32x4*)(Kg), k1r = *(const u32x4*)(Kg + (size_t)16 * 1024), v0r = *(const u32x4*)(Vg), v1r = *(const u32x4*)(Vg + (size_t)128 * 256);
          *(LAS u32x4*)(F.lds + OFF_K + ksto) = k0r; *(LAS u32x4*)(F.lds + OFF_K + ksto + 16 * KROW) = k1r; *(LAS u32x4*)(F.lds + OFF_V + vsto) = v0r; *(LAS u32x4*)(F.lds + OFF_V + vsto + 128 * VROW) = v1r; }
        __syncthreads();
        for (int kt = 0; kt < 8; ++kt) {
            const bool more = kt + 1 < 8; const int k0n = (kt + 1) * 32; u32x4 s0r, s1r;
            if (more) { s0r = *(const u32x4*)(Kg + (size_t)k0n * 1024); s1r = *(const u32x4*)(Kg + (size_t)(k0n + 16) * 1024); }
            const LAS unsigned char* kb = F.lds + OFF_K + (kt & 1) * KBUF + r32 * KROW + 16 * hi;
            const LAS unsigned char* vb = F.lds + OFF_V + (kt & 1) * VBUF + r32 * VROW + 16 * hi;
            f32x16 sc;
#pragma unroll
            for (int i = 0; i < 16; ++i) sc[i] = 0.f;
            bf16x8 qa[4], qb[4];
#pragma unroll
            for (int s = 0; s < 4; ++s) qa[s] = *(const bf16x8*)(Qg + 16 * s);
#pragma unroll
            for (int s = 0; s < 4; ++s) qb[s] = *(const bf16x8*)(Qg + 64 + 16 * s);
#pragma unroll
            for (int s = 0; s < 4; ++s) sc = __builtin_amdgcn_mfma_f32_32x32x16_bf16(*(const LAS bf16x8*)(kb + 32 * s), qa[s], sc, 0, 0, 0);
            asm volatile("" ::: "memory");
#pragma unroll
            for (int s = 0; s < 4; ++s) qa[s] = *(const bf16x8*)(Qg + 128 + 16 * s);
#pragma unroll
            for (int s = 0; s < 4; ++s) sc = __builtin_amdgcn_mfma_f32_32x32x16_bf16(*(const LAS bf16x8*)(kb + 128 + 32 * s), qb[s], sc, 0, 0, 0);
            asm volatile("" ::: "memory");
#pragma unroll
            for (int s = 0; s < 4; ++s) qb[s] = *(const bf16x8*)(Qg + 192 + 16 * s);
#pragma unroll
            for (int s = 0; s < 4; ++s) sc = __builtin_amdgcn_mfma_f32_32x32x16_bf16(*(const LAS bf16x8*)(kb + 256 + 32 * s), qa[s], sc, 0, 0, 0);
            asm volatile("" ::: "memory");
#pragma unroll
            for (int s = 0; s < 4; ++s) sc = __builtin_amdgcn_mfma_f32_32x32x16_bf16(*(const LAS bf16x8*)(kb + 384 + 32 * s), qb[s], sc, 0, 0, 0);
            if (more) { LAS unsigned char* kd = F.lds + OFF_K + ((kt + 1) & 1) * KBUF + ksto; *(LAS u32x4*)(kd) = s0r; *(LAS u32x4*)(kd + 16 * KROW) = s1r;
                s0r = *(const u32x4*)(Vg + k0n); s1r = *(const u32x4*)(Vg + (size_t)128 * 256 + k0n); }
            float mx = sc[0];
#pragma unroll
            for (int r = 1; r < 16; ++r) mx = fmaxf(mx, sc[r]);
            mx = fmaxf(mx, __shfl_xor(mx, 32));
            const float mnew = fmaxf(mrun, mx), alpha = __builtin_amdgcn_exp2f(mrun - mnew);
            float ps = 0.f;
#pragma unroll
            for (int r = 0; r < 16; ++r) { const float p = __builtin_amdgcn_exp2f(sc[r] - mnew); sc[r] = p; ps += p; }
            lrun = lrun * alpha + ps; mrun = mnew;
            const bf16x8 pf0 = pack_bf16x8(sc[0], sc[1], sc[2], sc[3], sc[4], sc[5], sc[6], sc[7]), pf1 = pack_bf16x8(sc[8], sc[9], sc[10], sc[11], sc[12], sc[13], sc[14], sc[15]);
#pragma unroll
            for (int dt = 0; dt < 8; ++dt) {
#pragma unroll
                for (int i = 0; i < 16; ++i) o[dt][i] *= alpha;
                o[dt] = __builtin_amdgcn_mfma_f32_32x32x16_bf16(*(const LAS bf16x8*)(vb + dt * 32 * VROW), pf0, o[dt], 0, 0, 0);
                o[dt] = __builtin_amdgcn_mfma_f32_32x32x16_bf16(*(const LAS bf16x8*)(vb + dt * 32 * VROW + 32), pf1, o[dt], 0, 0, 0); }
            if (more) { LAS unsigned char* vd = F.lds + OFF_V + ((kt + 1) & 1) * VBUF + vsto; *(LAS u32x4*)(vd) = s0r; *(LAS u32x4*)(vd + 128 * VROW) = s1r; }
            __syncthreads();
        }
        lrun += __shfl_xor(lrun, 32); const float inv = 1.0f / lrun;
        bf16* op = XO + tok * 1024 + hx * 256 + 4 * hi;
#pragma unroll
        for (int dt = 0; dt < 8; ++dt)
#pragma unroll
            for (int g4 = 0; g4 < 4; ++g4) { u32x2 w; w.x = pk2(o[dt][4 * g4] * inv, o[dt][4 * g4 + 1] * inv); w.y = pk2(o[dt][4 * g4 + 2] * inv, o[dt][4 * g4 + 3] * inv);
                *(u32x2*)(op + 32 * dt + 8 * g4) = w; }
    }
}

__device__ __forceinline__ void ph_prep(Frame& F, int l) {
    PHASE_IDS();
    constexpr int SROW = 3080, OFF_LAT = 33 * SROW + 8, LROW = 528, OFF_PAR = OFF_LAT + 32 * LROW;
    static_assert(OFF_LAT % 16 == 0 && OFF_PAR % 16 == 0 && OFF_PAR + 8 * 512 * 4 <= PHASE_LDS, "prep LDS map");
    LAS unsigned char* rows = F.lds; LAS unsigned char* lat = F.lds + OFF_LAT; LAS float* par = (LAS float*)(F.lds + OFF_PAR);
    const bf16* PR = WSP(bf16, AR_PR); bf16* SCANIN = WSP(bf16, AR_SCANIN); bf16* SV = WSP(bf16, AR_SV); bf16* XB = WSP(bf16, WS_XB); float* BONUS = WSP(float, WS_BONUS);
    const bf16* WUPT = (const bf16*)(F.ws + WS_W + W_WUPT); const bf16* AUPT = (const bf16*)(F.ws + WS_W + W_AUPT); const bf16* GUPT = (const bf16*)(F.ws + WS_W + W_GUPT);
    const int h = F.wave, lane = F.lane, r32 = lane & 31, hi = lane >> 5, tid = F.tid;
    const float* mu = FIN(I_MU) + l * RPROJ;
    __syncthreads();
    { const int c = tid;
      par[c] = mu[c]; par[512 + c] = mu[512 + c]; par[1024 + c] = mu[1024 + c]; par[1536 + c] = FIN(I_W0)[l * RW + c]; par[2048 + c] = FIN(I_A0)[l * RW + c];
      par[2560 + c] = FIN(I_KK)[l * RW + c]; par[3072 + c] = FIN(I_KA)[l * RW + c]; par[3584 + c] = FIN(I_RK)[l * RW + c]; }
    for (int task = blockIdx.x; task < M / 32; task += F.G) { const int t0 = task * 32;
        __syncthreads();
        {
          u32x4 st[13];
#pragma unroll
          for (int i = 0; i < 13; ++i) { const int q = tid + 512 * i; st[i] = (u32x4){0u, 0u, 0u, 0u};
              if (q < 33 * 192) { const int row = q / 192, c16 = q - row * 192; if (row > 0 || (t0 & 2047) != 0) st[i] = *(const u32x4*)(PR + (size_t)(t0 - 1 + row) * RPROJ + c16 * 8); } }
#pragma unroll
          for (int i = 0; i < 13; ++i) { const int q = tid + 512 * i;
              if (q < 33 * 192) { const int row = q / 192, c16 = q - row * 192; LAS unsigned char* d = rows + row * SROW + c16 * 16; *(LAS u32x2*)d = (u32x2){st[i].x, st[i].y}; *(LAS u32x2*)(d + 8) = (u32x2){st[i].z, st[i].w}; } } }
        {
          const int tt = tid >> 4, l16 = (tid & 15) * 16, t = t0 + tt; const bf16* pc = PR + (size_t)t * RPROJ + 1536 + l16;
          u32x4 cur[2], prv[2]; cur[0] = *(const u32x4*)pc; cur[1] = *(const u32x4*)(pc + 8); prv[0] = (u32x4){0u, 0u, 0u, 0u}; prv[1] = prv[0];
          if (t & 2047) { prv[0] = *(const u32x4*)(pc - RPROJ); prv[1] = *(const u32x4*)(pc - RPROJ + 8); }
          u32x4 ow[2];
#pragma unroll
          for (int hh = 0; hh < 2; ++hh) { const f32x4 m0 = *(const f32x4*)(mu + 1536 + l16 + 8 * hh), m1 = *(const f32x4*)(mu + 1536 + l16 + 8 * hh + 4); float xv[8];
#pragma unroll
              for (int i = 0; i < 4; ++i) { const unsigned cw = cur[hh][i], pw = prv[hh][i]; const float p0 = bf2f(cw & 0xffffu), p1 = bf2f(cw >> 16), q0 = bf2f(pw & 0xffffu), q1 = bf2f(pw >> 16);
                  const float ma = i < 2 ? m0[2 * i] : m1[2 * i - 4], mb = i < 2 ? m0[2 * i + 1] : m1[2 * i - 3];
                  xv[2 * i] = p0 + (q0 - p0) * ma; xv[2 * i + 1] = p1 + (q1 - p1) * mb; }
#pragma unroll
              for (int i = 0; i < 8; ++i) { if (l16 < 64) xv[i] = 1.0f - 2.0f * __builtin_amdgcn_rcpf(1.0f + __expf(2.0f * xv[i])); else if (l16 >= 128) xv[i] = sigmoidf_(xv[i]); }
              ow[hh] = (u32x4){pk2(xv[0], xv[1]), pk2(xv[2], xv[3]), pk2(xv[4], xv[5]), pk2(xv[6], xv[7])}; }
          *(LAS u32x4*)(lat + tt * LROW + l16 * 2) = ow[0]; *(LAS u32x4*)(lat + tt * LROW + l16 * 2 + 16) = ow[1]; }
        __syncthreads();
        const int t = t0 + r32, bb = t >> 11, tp = t & 2047, bh = bb * 8 + h;
        const LAS unsigned char* rc = rows + (r32 + 1) * SROW; const LAS unsigned char* rp = rows + r32 * SROW;
        float n2 = 0.f, bon = 0.f;
#pragma unroll
        for (int q = 0; q < 8; ++q) { const int c4 = h * 64 + 8 * q + 4 * hi;
            const u32x2 kc = *(const LAS u32x2*)(rc + (512 + c4) * 2), kp = *(const LAS u32x2*)(rp + (512 + c4) * 2);
            const f32x4 mk = *(const LAS f32x4*)(par + 512 + c4), kkc = *(const LAS f32x4*)(par + 2560 + c4);
#pragma unroll
            for (int i = 0; i < 4; ++i) { const unsigned sh = (i & 1) * 16; float k = bf2f((kc[i >> 1] >> sh) & 0xffffu); const float kq = bf2f((kp[i >> 1] >> sh) & 0xffffu);
                k += (kq - k) * mk[i]; const float kk = k * kkc[i]; n2 += kk * kk; } }
        n2 += __shfl_xor(n2, 32);
        const float inv = 1.0f / fmaxf(sqrtf(n2), 1e-12f);
        bf16* so = SCANIN + ((size_t)(bh * 64 + (tp >> 5)) * 10) * 1024 + lane * 16;
#pragma unroll 1
        for (int ct = 0; ct < 2; ++ct) { const int cb = h * 64 + 32 * ct;
            f32x16 aw, aa, ag;
#pragma unroll
            for (int i = 0; i < 16; ++i) { aw[i] = 0.f; aa[i] = 0.f; ag[i] = 0.f; }
            const LAS unsigned char* lb = lat + r32 * LROW + 16 * hi;
#pragma unroll
            for (int s = 0; s < 4; ++s) { const bf16x8 wf = *(const bf16x8*)(WUPT + (size_t)(cb + r32) * 64 + 16 * s + 8 * hi), af = *(const bf16x8*)(AUPT + (size_t)(cb + r32) * 64 + 16 * s + 8 * hi);
                const bf16x8 lw = *(const LAS bf16x8*)(lb + 32 * s), la = *(const LAS bf16x8*)(lb + 128 + 32 * s);
                aw = __builtin_amdgcn_mfma_f32_32x32x16_bf16(wf, lw, aw, 0, 0, 0); aa = __builtin_amdgcn_mfma_f32_32x32x16_bf16(af, la, aa, 0, 0, 0); }
#pragma unroll
            for (int s = 0; s < 8; ++s) { const bf16x8 gf = *(const bf16x8*)(GUPT + (size_t)(cb + r32) * 128 + 16 * s + 8 * hi); const bf16x8 lg = *(const LAS bf16x8*)(lb + 256 + 32 * s);
                ag = __builtin_amdgcn_mfma_f32_32x32x16_bf16(gf, lg, ag, 0, 0, 0); }
            unsigned onk[8], old_[8], obv[8], okt[8], orr[8];
#pragma unroll
            for (int g = 0; g < 4; ++g) { const int c4 = cb + 8 * g + 4 * hi;
                const u32x2 rcv = *(const LAS u32x2*)(rc + c4 * 2), kcv = *(const LAS u32x2*)(rc + (512 + c4) * 2), vcv = *(const LAS u32x2*)(rc + (1024 + c4) * 2);
                const u32x2 rpv = *(const LAS u32x2*)(rp + c4 * 2), kpv = *(const LAS u32x2*)(rp + (512 + c4) * 2), vpv = *(const LAS u32x2*)(rp + (1024 + c4) * 2);
                const f32x4 mr = *(const LAS f32x4*)(par + c4), mk = *(const LAS f32x4*)(par + 512 + c4), mv = *(const LAS f32x4*)(par + 1024 + c4);
                const f32x4 w0v = *(const LAS f32x4*)(par + 1536 + c4), a0v = *(const LAS f32x4*)(par + 2048 + c4), kkc = *(const LAS f32x4*)(par + 2560 + c4), kac = *(const LAS f32x4*)(par + 3072 + c4), rkc = *(const LAS f32x4*)(par + 3584 + c4);
                float ro[4], ko[4], vo[4], ldo[4], go[4], nk[4], bo[4];
#pragma unroll
                for (int i = 0; i < 4; ++i) { const unsigned sh = (i & 1) * 16;
                    float r = bf2f((rcv[i >> 1] >> sh) & 0xffffu), k = bf2f((kcv[i >> 1] >> sh) & 0xffffu), v = bf2f((vcv[i >> 1] >> sh) & 0xffffu);
                    const float rq = bf2f((rpv[i >> 1] >> sh) & 0xffffu), kq = bf2f((kpv[i >> 1] >> sh) & 0xffffu), vq = bf2f((vpv[i >> 1] >> sh) & 0xffffu);
                    r += (rq - r) * mr[i]; k += (kq - k) * mk[i]; v += (vq - v) * mv[i];
                    const float wv = w0v[i] + aw[4 * g + i], xs = -wv, sp = xs > 20.f ? xs : __logf(1.0f + __expf(xs)), ld = -__expf(-sp - 0.5f);
                    const float a = sigmoidf_(a0v[i] + aa[4 * g + i]);
                    const float kn = k * kkc[i] * inv, kt = k * (1.0f + (a - 1.0f) * kac[i]);
                    bon += r * kt * rkc[i];
                    ro[i] = r; ko[i] = kt; vo[i] = v; ldo[i] = ld; go[i] = ag[4 * g + i]; nk[i] = -kn; bo[i] = kn * a; }
                onk[2 * g] = pk2(nk[0], nk[1]); onk[2 * g + 1] = pk2(nk[2], nk[3]); old_[2 * g] = pk2(ldo[0], ldo[1]); old_[2 * g + 1] = pk2(ldo[2], ldo[3]);
                obv[2 * g] = pk2(bo[0], bo[1]); obv[2 * g + 1] = pk2(bo[2], bo[3]); okt[2 * g] = pk2(ko[0], ko[1]); okt[2 * g + 1] = pk2(ko[2], ko[3]);
                orr[2 * g] = pk2(ro[0], ro[1]); orr[2 * g + 1] = pk2(ro[2], ro[3]);
                *(u32x2*)(SV + ((size_t)bh * 2048 + tp) * 64 + 32 * ct + 8 * g + 4 * hi) = (u32x2){pk2(vo[0], vo[1]), pk2(vo[2], vo[3])};
                *(u32x2*)(XB + (size_t)t * 1024 + c4) = (u32x2){pk2(go[0], go[1]), pk2(go[2], go[3])}; }
            bf16* sq = so + ct * 1024;
            *(u32x4*)(sq) = (u32x4){onk[0], onk[1], onk[2], onk[3]}; *(u32x4*)(sq + 8) = (u32x4){onk[4], onk[5], onk[6], onk[7]};
            *(u32x4*)(sq + 2048) = (u32x4){old_[0], old_[1], old_[2], old_[3]}; *(u32x4*)(sq + 2048 + 8) = (u32x4){old_[4], old_[5], old_[6], old_[7]};
            *(u32x4*)(sq + 4096) = (u32x4){obv[0], obv[1], obv[2], obv[3]}; *(u32x4*)(sq + 4096 + 8) = (u32x4){obv[4], obv[5], obv[6], obv[7]};
            *(u32x4*)(sq + 6144) = (u32x4){okt[0], okt[1], okt[2], okt[3]}; *(u32x4*)(sq + 6144 + 8) = (u32x4){okt[4], okt[5], okt[6], okt[7]};
            *(u32x4*)(sq + 8192) = (u32x4){orr[0], orr[1], orr[2], orr[3]}; *(u32x4*)(sq + 8192 + 8) = (u32x4){orr[4], orr[5], orr[6], orr[7]};
        }
        bon += __shfl_xor(bon, 32);
        if (hi == 0) BONUS[(size_t)t * 8 + h] = bon;
    }
}

template <int R, int NCH, bool KINDP>
__device__ __forceinline__ void scan_stream(Frame& F, LAS float* ring, int bh, int ch, int rg, int lis) {
    typedef float f32x2 __attribute__((ext_vector_type(2)));
    constexpr int CLEN = SEQ / NCH, NHALF = CLEN / 8;
    const int lane = F.lane, js = lane & 3, q = lane >> 2, row0 = rg * 16 * R + q * R, tbase = ch * CLEN;
    const bf16* src5 = WSP(bf16, AR_SCANIN) + (size_t)bh * 64 * 10 * 1024; const bf16* srcv = WSP(bf16, AR_SV) + (size_t)bh * 2048 * 64;
    float* YL = WSP(float, AR_YLOC) + ((size_t)bh * 2048 + tbase) * 64; bf16* ZZ = WSP(bf16, AR_Z) + ((size_t)bh * 2048 + tbase) * 64;
    int soff[2], doff[2]; bool isv[2], isld[2], cval[2];
#pragma unroll
    for (int k = 0; k < 2; ++k) { int ci = lis + k * 256; cval[k] = ci < 384; if (!cval[k]) ci = lis; isv[k] = ci >= 320;
        const int run = ci >> 4, vec = run >> 2, ct = (run >> 1) & 1, hi2 = run & 1, tok = (ci & 15) >> 1, hf16 = ci & 1, cv = ci - 320;
        isld[k] = !isv[k] && vec == 1;
        soff[k] = isv[k] ? (cv >> 3) * 64 + (cv & 7) * 8 : ((vec * 2 + ct) * 64 + hi2 * 32 + tok) * 16 + 8 * hf16;
        doff[k] = isv[k] ? (cv >> 3) * 384 + 320 + (cv & 7) * 8 : tok * 384 + vec * 64 + 32 * ct + 16 * hf16 + 4 * hi2; }
#define SCAN_LOAD(hfx) do { const int tg_ = tbase + (hfx) * 8; _Pragma("unroll") for (int k = 0; k < 2; ++k) {   \
        const bf16* p_ = isv[k] ? srcv + (size_t)tg_ * 64 + soff[k] : src5 + (size_t)(tg_ >> 5) * 10240 + (tg_ & 31) * 16 + soff[k]; pre[k] = *(const u32x4*)p_; } } while (0)
#define SCAN_WRITE(hfx) do { _Pragma("unroll") for (int k = 0; k < 2; ++k) if (cval[k]) { float f[8]; \
        _Pragma("unroll") for (int i = 0; i < 4; ++i) { f[2 * i] = bf2f(pre[k][i] & 0xffffu); f[2 * i + 1] = bf2f(pre[k][i] >> 16); } \
        if (isld[k]) { _Pragma("unroll") for (int i = 0; i < 8; ++i) f[i] = __expf(f[i]); } \
        LAS float* d_ = ring + (((hfx) & 1) * 8) * 384 + doff[k]; \
        *(LAS f32x4*)(d_) = (f32x4){f[0], f[1], f[2], f[3]}; *(LAS f32x4*)(d_ + (isv[k] ? 4 : 8)) = (f32x4){f[4], f[5], f[6], f[7]}; } } while (0)
    f32x2 S[R][8];
#pragma unroll
    for (int rr = 0; rr < R; ++rr)
#pragma unroll
        for (int k = 0; k < 8; ++k) { S[rr][k].x = (KINDP && (row0 + rr) == 16 * js + 2 * k) ? 1.f : 0.f; S[rr][k].y = (KINDP && (row0 + rr) == 16 * js + 2 * k + 1) ? 1.f : 0.f; }
    u32x4 pre[2];
    SCAN_LOAD(0); SCAN_WRITE(0);
    __syncthreads();
    for (int hf = 0; hf < NHALF; ++hf) {
        const bool more = hf + 1 < NHALF;
        if (more) SCAN_LOAD(hf + 1);
#pragma unroll 2
        for (int st = 0; st < 8; ++st) {
            const LAS float* sp = ring + ((hf & 1) * 8 + st) * 384 + 16 * js;
            f32x2 nn[8], ww[8], bb[8], kk[8], rr2[8];
#pragma unroll
            for (int i = 0; i < 4; ++i) { const f32x4 a = *(const LAS f32x4*)(sp + 4 * i); nn[2 * i] = (f32x2){a[0], a[1]}; nn[2 * i + 1] = (f32x2){a[2], a[3]}; }
#pragma unroll
            for (int i = 0; i < 4; ++i) { const f32x4 a = *(const LAS f32x4*)(sp + 64 + 4 * i); ww[2 * i] = (f32x2){a[0], a[1]}; ww[2 * i + 1] = (f32x2){a[2], a[3]}; }
#pragma unroll
            for (int i = 0; i < 4; ++i) { const f32x4 a = *(const LAS f32x4*)(sp + 128 + 4 * i); bb[2 * i] = (f32x2){a[0], a[1]}; bb[2 * i + 1] = (f32x2){a[2], a[3]}; }
            if (!KINDP) {
#pragma unroll
                for (int i = 0; i < 4; ++i) { const f32x4 a = *(const LAS f32x4*)(sp + 192 + 4 * i); kk[2 * i] = (f32x2){a[0], a[1]}; kk[2 * i + 1] = (f32x2){a[2], a[3]}; } }
#pragma unroll
            for (int i = 0; i < 4; ++i) { const f32x4 a = *(const LAS f32x4*)(sp + 256 + 4 * i); rr2[2 * i] = (f32x2){a[0], a[1]}; rr2[2 * i + 1] = (f32x2){a[2], a[3]}; }
            float vv[R];
            if (!KINDP) {
#pragma unroll
                for (int rr = 0; rr < R; ++rr) vv[rr] = ring[((hf & 1) * 8 + st) * 384 + 320 + row0 + rr]; }
            float sa[R];
#pragma unroll
            for (int rr = 0; rr < R; ++rr) { f32x2 p0 = S[rr][0] * nn[0], p1 = S[rr][1] * nn[1];
#pragma unroll
                for (int k = 2; k < 8; k += 2) { p0 = S[rr][k] * nn[k] + p0; p1 = S[rr][k + 1] * nn[k + 1] + p1; }
                p0 = p0 + p1; sa[rr] = quad_sum(p0.x + p0.y); }
            float y[R];
#pragma unroll
            for (int rr = 0; rr < R; ++rr) { const f32x2 sa2 = (f32x2){sa[rr], sa[rr]}; f32x2 p0 = (f32x2){0.f, 0.f}, p1 = (f32x2){0.f, 0.f};
#pragma unroll
                for (int k = 0; k < 8; k += 2) {
                    f32x2 t0 = S[rr][k] * ww[k], t1 = S[rr][k + 1] * ww[k + 1];
                    t0 = sa2 * bb[k] + t0; t1 = sa2 * bb[k + 1] + t1;
                    if (!KINDP) { const f32x2 v2 = (f32x2){vv[rr], vv[rr]}; t0 = v2 * kk[k] + t0; t1 = v2 * kk[k + 1] + t1; }
                    S[rr][k] = t0; S[rr][k + 1] = t1; p0 = t0 * rr2[k] + p0; p1 = t1 * rr2[k + 1] + p1; }
                p0 = p0 + p1; y[rr] = quad_sum(p0.x + p0.y); }
            if (js == 0) { const int t = hf * 8 + st;
                if (R == 2) { if (KINDP) *(unsigned*)(ZZ + (size_t)t * 64 + row0) = pk2(y[0], y[R - 1]); else *(f32x2*)(YL + (size_t)t * 64 + row0) = (f32x2){y[0], y[R - 1]}; }
                else {
#pragma unroll
                    for (int rr = 0; rr < R; ++rr) { if (KINDP) ZZ[(size_t)t * 64 + row0 + rr] = (bf16)f2bf(y[rr]); else YL[(size_t)t * 64 + row0 + rr] = y[rr]; } } }
        }
        if (more) SCAN_WRITE(hf + 1);
        __syncthreads();
    }
#undef SCAN_LOAD
#undef SCAN_WRITE
    if (NCH > 1) {
        float* st = WSP(float, AR_STATE) + ((size_t)(bh * NCH + ch) * 2 + (KINDP ? 0 : 1)) * 4096;
#pragma unroll
        for (int rr = 0; rr < R; ++rr)
#pragma unroll
            for (int i = 0; i < 4; ++i) *(f32x4*)(st + (size_t)(row0 + rr) * 64 + 16 * js + 4 * i) = (f32x4){S[rr][2 * i].x, S[rr][2 * i].y, S[rr][2 * i + 1].x, S[rr][2 * i + 1].y};
    }
}
template <int R, int NCH>
__device__ __forceinline__ void ph_scan(Frame& F) {
    PHASE_IDS();
    constexpr int KINDS = NCH > 1 ? 2 : 1, RG = 4 / R, WPS = KINDS * RG, SPW = NWAVES / WPS, NSTREAM = BATCH * NH * NCH;
    static_assert(WPS == 4, "staging assumes 4 waves per stream");
    const int sl = F.wave / WPS, role = F.wave % WPS, kind = role / RG, rg = role % RG, lis = role * 64 + F.lane;
    LAS float* ring = (LAS float*)F.lds + sl * (16 * 384);
    for (int it = blockIdx.x; it * SPW < NSTREAM; it += F.G) {
        const int sid = it * SPW + sl, bh = sid / NCH, ch = sid % NCH;
        __syncthreads();
        if (kind == 0) scan_stream<R, NCH, false>(F, ring, bh, ch, rg, lis); else scan_stream<R, NCH, true>(F, ring, bh, ch, rg, lis);
    }
}

template <int NCH>
__device__ __forceinline__ void ph_fix(Frame& F) {
    PHASE_IDS();
    typedef float f32x2 __attribute__((ext_vector_type(2)));
    LAS float* cur = (LAS float*)F.lds;
    for (int u = blockIdx.x; u < 256; u += F.G) { const int bh = u >> 2, rgx = u & 3, i = F.tid >> 5, j2 = (F.tid & 31) * 2, row = rgx * 16 + i;
        float* base = WSP(float, AR_STATE) + (size_t)bh * NCH * 2 * 4096;
        __syncthreads();
        { const f32x2 v = *(const f32x2*)(base + 4096 + row * 64 + j2); cur[i * 64 + j2] = v.x; cur[i * 64 + j2 + 1] = v.y; }
        __syncthreads();
        for (int c = 1; c < NCH - 1; ++c) { const float* P = base + (size_t)(c * 2) * 4096; float* SL = base + (size_t)(c * 2 + 1) * 4096;
            f32x2 acc = *(const f32x2*)(SL + row * 64 + j2);
#pragma unroll
            for (int ii = 0; ii < 64; ++ii) { const float sv = cur[i * 64 + ii]; const f32x2 p = *(const f32x2*)(P + ii * 64 + j2); acc.x += sv * p.x; acc.y += sv * p.y; }
            __syncthreads();
            cur[i * 64 + j2] = acc.x; cur[i * 64 + j2 + 1] = acc.y; *(f32x2*)(SL + row * 64 + j2) = acc;
            __syncthreads(); }
    }
}

template <int NCH>
__device__ __forceinline__ void ph_post(Frame& F, int l, bool dummy) {
    PHASE_IDS();
    constexpr int CLEN = SEQ / NCH;
    const float* YL = WSP(float, AR_YLOC); const bf16* SV = WSP(bf16, AR_SV); bf16* XB = WSP(bf16, WS_XB); const float* BONUS = WSP(float, WS_BONUS); const bf16* ZZ = WSP(bf16, AR_Z);
    LAS float* zt = (LAS float*)F.lds;
    const int c = F.tid, h = F.wave, j = F.lane; const float lng = FIN(I_LNG)[l * RW + c], lnb = FIN(I_LNB)[l * RW + c];
    for (int grp = blockIdx.x; grp < M / 64; grp += F.G) { const int t0g = grp * 64, bb = t0g >> 11, ch = (t0g & 2047) / CLEN, bh = bb * 8 + h; const bool corr = NCH > 1 && ch > 0;
        float st[64];
        if (corr) { const float* sp = WSP(float, AR_STATE) + ((size_t)(bh * NCH + ch - 1) * 2 + 1) * 4096 + j * 64;
#pragma unroll
            for (int i4 = 0; i4 < 16; ++i4) { const f32x4 v = *(const f32x4*)(sp + 4 * i4); st[4 * i4] = v[0]; st[4 * i4 + 1] = v[1]; st[4 * i4 + 2] = v[2]; st[4 * i4 + 3] = v[3]; } }
        for (int ti = 0; ti < 4; ++ti) { const int t0 = t0g + 16 * ti;
            if (corr) { __syncthreads();
#pragma unroll 4
                for (int tt = 0; tt < 16; ++tt) zt[tt * 512 + c] = bf2f(ZZ[((size_t)bh * 2048 + ((t0 + tt) & 2047)) * 64 + j]);
                __syncthreads(); }
#pragma unroll 1
            for (int tb = 0; tb < 16; tb += 8) {
                float yv[8], vv[8], bv[8], gv[8];
#pragma unroll
                for (int q = 0; q < 8; ++q) { const int t = t0 + tb + q, tp = t & 2047;
                    yv[q] = YL[((size_t)bh * 2048 + tp) * 64 + j]; vv[q] = bf2f(SV[((size_t)bh * 2048 + tp) * 64 + j]); bv[q] = BONUS[(size_t)t * 8 + h]; gv[q] = bf2f(XB[(size_t)t * 1024 + c]); }
                if (corr) {
#pragma unroll
                    for (int q = 0; q < 8; ++q) { const LAS float* zp = zt + (tb + q) * 512 + h * 64; float p0 = 0.f, p1 = 0.f, p2 = 0.f, p3 = 0.f;
#pragma unroll
                        for (int qq = 0; qq < 4; ++qq) { asm volatile("" ::: "memory");
                            f32x4 zz[4];
#pragma unroll
                            for (int e = 0; e < 4; ++e) zz[e] = *(const LAS f32x4*)(zp + 16 * qq + 4 * e);
#pragma unroll
                            for (int e = 0; e < 4; ++e) { const int j4 = 4 * qq + e; p0 += st[4 * j4] * zz[e][0]; p1 += st[4 * j4 + 1] * zz[e][1]; p2 += st[4 * j4 + 2] * zz[e][2]; p3 += st[4 * j4 + 3] * zz[e][3]; }
                            asm volatile("" : "+v"(p0), "+v"(p1), "+v"(p2), "+v"(p3)); }
                        yv[q] += (p0 + p1) + (p2 + p3); } }
                float mean[8], var[8];
#pragma unroll
                for (int q = 0; q < 8; ++q) mean[q] = yv[q];
                wave_sum8(mean);
#pragma unroll
                for (int q = 0; q < 8; ++q) { mean[q] *= (1.0f / 64.0f); yv[q] -= mean[q]; var[q] = yv[q] * yv[q]; }
                wave_sum8(var);
#pragma unroll
                for (int q = 0; q < 8; ++q) { const int t = t0 + tb + q;
                    const float yn = yv[q] * __builtin_amdgcn_rsqf(var[q] * (1.0f / 64.0f) + LNX_EPS) * lng + lnb;
                    if (dummy) WSP(bf16, WS_AR + 48 * MiB)[((size_t)t * 1024 + c) & 0x3fffff] = (bf16)f2bf((yn + bv[q] * vv[q]) * gv[q]);
                    else XB[(size_t)t * 1024 + c] = (bf16)f2bf((yn + bv[q] * vv[q]) * gv[q]); }
            }
        }
    }
}

__device__ __forceinline__ void ph_final(Frame& F) {
    PHASE_IDS();
    const int gw = F.vcu * NWAVES + F.wave, NGW = F.G * NWAVES; const float* ssq = WSP(float, WS_SSQ); const float* g = FIN(I_FING);
    f32x4 gv[4];
#pragma unroll
    for (int j = 0; j < 4; ++j) gv[j] = ((const f32x4*)g)[F.lane + 64 * j];
    for (int r = gw; r < M; r += NGW) { const float rs = pg8::row_rstd16(ssq, r); f32x4* xr = (f32x4*)(F.out + (size_t)r * DM) + F.lane;
#pragma unroll
        for (int j = 0; j < 4; ++j) { const f32x4 v = xr[64 * j]; xr[64 * j] = v * rs * gv[j]; } }
}

constexpr int PH_INIT = 0, PH_PER_LAYER = 16, PH_FINAL = 1 + DEPTH * PH_PER_LAYER, N_PHASES = PH_FINAL + 1;
enum { K_CONV = 0, K_KV, K_F1UP, K_F1DN, K_MIXIN, K_MOBA, K_PREP, K_SCAN, K_FIX, K_POST, K_MIXOUT, K_XQ, K_XATT, K_XO, K_F2UP, K_F2DN };

#ifdef ONLY
#define PH_ON(k) ((k) == (ONLY))
#else
#define PH_ON(k) true
#endif
__global__ void __launch_bounds__(NWAVES * 64, 2) fwd(Args args) {
    extern __shared__ __attribute__((aligned(16))) unsigned char lds[];
    Frame F;
    F.lds = (LAS unsigned char*)lds; F.MISC = (volatile LAS unsigned*)(F.lds + MISC_OFF);
    F.tid = threadIdx.x; F.lane = F.tid & 63; F.wave = __builtin_amdgcn_readfirstlane(F.tid >> 6);
    F.G = gridDim.x; { const int bx = blockIdx.x; F.vcu = (F.G % 8 == 0) ? (bx % 8) * (F.G / 8) + bx / 8 : bx; }
    F.out = args.out; F.ws = args.ws; F.ctl = (gu32*)(args.ws + WS_CTL);
    F.ka = (const __attribute__((address_space(4))) Args*)(uintptr_t)__builtin_amdgcn_kernarg_segment_ptr();
    for (int u = F.tid; u < (LDS_BYTES - LDSCTL_OFF) / 4; u += NWAVES * 64) ((LAS unsigned*)(F.lds + LDSCTL_OFF))[u] = 0u;
    __syncthreads();
    const bool multi = args.ph_hi - args.ph_lo > 1;
    XcdBarrier bar; bar.bar = (unsigned*)(F.ctl + 4096); bar.x = 0; bar.st = nullptr;
    if (multi) bar = xcd_barrier_post((unsigned*)(F.ctl + 4096), F.MISC + 8);
#ifndef REP_AT
#define REP_AT 1000
#endif
    for (int pi = args.ph_lo; pi < args.ph_hi + (REP_AT < 1000 ? 1 : 0); ++pi) { const int ph = pi - (pi > REP_AT ? 1 : 0);
        const bool dummy = REP_AT < 1000 && pi == REP_AT;
        { uintptr_t kp = (uintptr_t)__builtin_amdgcn_kernarg_segment_ptr(); asm volatile("" : "+s"(kp)); F.ka = (const __attribute__((address_space(4))) Args*)kp; }
        unsigned char* wb = F.ws + WS_W;
        if (ph == PH_INIT) { if (PH_ON(100)) { ph_init(F); ph_conv(F, 0); } }
        else if (ph == PH_FINAL) { if (PH_ON(101)) ph_final(F); }
        else { const int l = (ph - 1) / PH_PER_LAYER, k = (ph - 1) % PH_PER_LAYER;
            const float* xin = (l == 0) ? FIN(I_X) : (const float*)F.out;
            switch (k) {
            case K_CONV: if (!PH_ON(K_CONV)) break; if (l > 0) ph_conv(F, l); break;
            case K_KV: break;
            case K_F1UP: case K_F2UP: if (!PH_ON(K_F1UP)) break; { pg8::Gemm g{WSP(bf16, WS_XB), (const bf16*)(wb + (k == K_F1UP ? W_F1IN : W_F2IN)), M, 2 * DFF, DM}; pg8::StaticOrder S; S.init(M, 2 * DFF, F.G, (int)blockIdx.x);
                pg8::EpiSwiGLU E{F.ws, F.lds}; fill_rstd(F, S); pg8::gemm_phase<pg8::EpiSwiGLU, pg8::StaticOrder, true, true>(F.lds, g, S, E); } break;
            case K_F1DN: case K_F2DN: if (!PH_ON(K_F1DN)) break; { pg8::Gemm g{WSP(bf16, AR_H), (const bf16*)(wb + (k == K_F1DN ? W_F1OUT : W_F2OUT)), M, DM, DFF}; pg8::StaticOrder S; S.init(M, DM, F.G, (int)blockIdx.x);
                pg8::EpiResid E{k == K_F1DN ? xin : (const float*)F.out, dummy ? WSP(float, WS_AR + 96 * MiB) : F.out, F.ws, dummy ? WS_AR + 100 * MiB : WS_XB, 0.5f}; pg8::gemm_phase<pg8::EpiResid, pg8::StaticOrder, true, true>(F.lds, g, S, E); } break;
            case K_MIXIN: if (!PH_ON(K_MIXIN)) break; { pg8::Gemm g{WSP(bf16, WS_XB), (const bf16*)(wb + W_MIXIN), M, DPROJ, DM}; pg8::StaticOrder S; S.init(M, DPROJ, F.G, (int)blockIdx.x);
                pg8::EpiMixIn E{F.ws, F.lds}; fill_rstd(F, S); pg8::gemm_phase<pg8::EpiMixIn, pg8::StaticOrder, true, true>(F.lds, g, S, E); }
                {
                  pg8::Gemm g{WSP(bf16, WS_MEMB), (const bf16*)(wb + W_WKV), MM, 2 * DM, DM}; pg8::StaticOrder S; S.init(MM, 2 * DM, F.G, (int)((blockIdx.x + F.G - 64) % F.G));
                  pg8::EpiKV E{F.ws}; pg8::gemm_phase<pg8::EpiKV, pg8::StaticOrder, true, true>(F.lds, g, S, E); } break;
            case K_MOBA: if (!PH_ON(K_MOBA)) break; ph_moba(F); break;
            case K_PREP: if (!PH_ON(K_PREP)) break; ph_prep(F, l); break;
            case K_SCAN: if (!PH_ON(K_SCAN)) break; ph_scan<SCAN_R, SCAN_NCH>(F); break;
            case K_FIX: if (!PH_ON(K_FIX)) break; if (SCAN_NCH > 1) ph_fix<SCAN_NCH>(F); break;
            case K_POST: if (!PH_ON(K_POST)) break; ph_post<SCAN_NCH>(F, l, dummy); break;
            case K_MIXOUT: if (!PH_ON(K_MIXOUT)) break; { pg8::Gemm g{WSP(bf16, WS_XB), (const bf16*)(wb + W_MIXOUT), M, DM, DM}; pg8::StaticOrder S; S.init(M, DM, F.G, (int)blockIdx.x);
                pg8::EpiResid E{F.out, dummy ? WSP(float, WS_AR + 96 * MiB) : F.out, F.ws, dummy ? WS_AR + 100 * MiB : AR_XB2, 1.0f}; pg8::gemm_phase<pg8::EpiResid, pg8::StaticOrder, true, true>(F.lds, g, S, E); } break;
            case K_XQ: if (!PH_ON(K_XQ)) break; { pg8::Gemm g{WSP(bf16, AR_XB2), (const bf16*)(wb + W_WQ), M, DM, DM}; pg8::StaticOrder S; S.init(M, DM, F.G, (int)blockIdx.x);
                pg8::EpiXQ E{F.ws, F.lds}; fill_rstd(F, S); pg8::gemm_phase<pg8::EpiXQ, pg8::StaticOrder, true, true>(F.lds, g, S, E); } break;
            case K_XATT: if (!PH_ON(K_XATT)) break; ph_xatt(F); break;
            case K_XO: if (!PH_ON(K_XO)) break; { pg8::Gemm g{WSP(bf16, AR_XO), (const bf16*)(wb + W_WO), M, DM, DM}; pg8::StaticOrder S; S.init(M, DM, F.G, (int)blockIdx.x);
                pg8::EpiResid E{F.out, dummy ? WSP(float, WS_AR + 96 * MiB) : F.out, F.ws, dummy ? WS_AR + 100 * MiB : WS_XB, 1.0f}; pg8::gemm_phase<pg8::EpiResid, pg8::StaticOrder, true, true>(F.lds, g, S, E); } break;
            default: break;
            }
        }
        if (pi + 1 < args.ph_hi + (REP_AT < 1000 ? 1 : 0)) {
            const int kk_ = (ph - 1) % PH_PER_LAYER, ll_ = (ph - 1) / PH_PER_LAYER;
            const bool noop = ph != PH_INIT && ph != PH_FINAL && ((kk_ == K_FIX && SCAN_NCH == 1) || kk_ == K_KV || (kk_ == K_CONV && ll_ == 0));
            if (!noop) xcd_barrier(bar);
        }
    }
}

extern "C" void kernel_launch(void* const* d_in, const int* in_sizes, int n_in, void* d_out, int out_size, void* d_ws, size_t ws_size, hipStream_t stream) {
    static int grid = 0;
    if (grid == 0) {
        if (n_in != N_IN || in_sizes[0] != M * DM || out_size != M * DM || ws_size < WS_END) { fprintf(stderr, "kernel_launch: unexpected problem (n_in %d, in0 %d, out %d, ws %zu < %zu); nothing launched\n", n_in, n_in > 0 ? in_sizes[0] : -1, out_size, ws_size, (size_t)WS_END); grid = -1; return; }
        int dev = 0, cus = 0;
        if (hipGetDevice(&dev) != hipSuccess || hipDeviceGetAttribute(&cus, hipDeviceAttributeMultiprocessorCount, dev) != hipSuccess) { grid = -1; return; }
        if (hipFuncSetAttribute((const void*)fwd, hipFuncAttributeMaxDynamicSharedMemorySize, LDS_BYTES) != hipSuccess) { fprintf(stderr, "kernel_launch: hipFuncSetAttribute failed\n"); grid = -1; return; }
        int per_cu = 0;
        if (hipOccupancyMaxActiveBlocksPerMultiprocessor(&per_cu, (const void*)fwd, NWAVES * 64, LDS_BYTES) != hipSuccess || per_cu < 1) { fprintf(stderr, "kernel_launch: occupancy query reports %d workgroups per CU; nothing launched\n", per_cu); grid = -1; return; }
        grid = cus;
    }
    if (grid < 0) return;
    (void)hipMemsetAsync((char*)d_ws + WS_CTL, 0, CTL_ZERO_BYTES, stream);
    Args a{};
    for (int i = 0; i < N_IN; ++i) a.in[i] = (const float*)d_in[i];
    a.out = (float*)d_out; a.ws = (unsigned char*)d_ws;
    a.ph_lo = 0; a.ph_hi = N_PHASES;
    void* kargs[] = {&a};
    const hipError_t e = hipLaunchCooperativeKernel((const void*)fwd, dim3(grid), dim3(NWAVES * 64), kargs, LDS_BYTES, stream);
    if (e != hipSuccess) fprintf(stderr, "kernel_launch: cooperative launch failed: %s (grid %d)\n", hipGetErrorString(e), grid);
}
```

```cpp
#include <hip/hip_runtime.h>
#include <hip/hip_cooperative_groups.h>
#include <cstdio>
#include <cstdint>

constexpr int BATCH = 8, SEQ = 2048, DM = 1024, DEPTH = 2, M = BATCH * SEQ;
constexpr int RW = 512, NH = 8, HD = 64;
constexpr int RPROJ = 1792, DPROJ = 3328;
constexpr int DFF = 2816;
constexpr int MEMLEN = 256, XH = 4, XHD = 256, MM = BATCH * MEMLEN;
constexpr int MBLK = 256, NBLK = SEQ / MBLK;
constexpr float NORM_EPS = 1e-6f, LNX_EPS = 64e-5f;
constexpr float LOG2E = 1.4426950408889634f;
constexpr float MOBA_QSCALE = 0.125f * LOG2E;
constexpr float XATT_QSCALE = 0.0625f * LOG2E;

enum { I_X = 0, I_MEM, I_RELB, I_FING, I_F1G, I_F1IN, I_F1OUT, I_MIXG, I_MIXIN, I_MIXOUT, I_MU, I_W0, I_WUP, I_A0, I_AUP, I_GUP, I_KK, I_KA, I_RK, I_LNG, I_LNB,
       I_XG, I_MEMG, I_WQ, I_WKV, I_WO, I_F2G, I_F2IN, I_F2OUT, N_IN };

constexpr size_t MiB = 1u << 20;
constexpr size_t WS_CTL = 0, CTL_ZERO_BYTES = 1 * MiB;
constexpr size_t WS_BIAS = 1 * MiB;
constexpr size_t WS_MEMRS = WS_BIAS + 64 * 1024;
constexpr size_t WS_BONUS = WS_MEMRS + 64 * 1024;
constexpr size_t WS_KMS = WS_BONUS + 512 * 1024;
constexpr size_t WS_SSQ = 2 * MiB;
constexpr size_t WS_MEMB = 3 * MiB;
constexpr size_t WS_XK = 7 * MiB, WS_XVT = 11 * MiB;
constexpr size_t WS_W = 15 * MiB;
constexpr size_t W_F1IN = 0, W_F1OUT = W_F1IN + (size_t)2 * DFF * DM * 2, W_F2IN = W_F1OUT + (size_t)DM * DFF * 2, W_F2OUT = W_F2IN + (size_t)2 * DFF * DM * 2,
                 W_MIXIN = W_F2OUT + (size_t)DM * DFF * 2, W_MIXOUT = W_MIXIN + (size_t)DPROJ * DM * 2, W_WQ = W_MIXOUT + (size_t)DM * DM * 2, W_WKV = W_WQ + (size_t)DM * DM * 2,
                 W_WO = W_WKV + (size_t)2 * DM * DM * 2, W_WUPT = W_WO + (size_t)DM * DM * 2, W_AUPT = W_WUPT + (size_t)RW * 64 * 2, W_GUPT = W_AUPT + (size_t)RW * 64 * 2, W_END = W_GUPT + (size_t)RW * 128 * 2;
static_assert(W_END <= 50 * MiB, "weights fit");
constexpr size_t WS_XB = 65 * MiB;
constexpr size_t WS_AR = 97 * MiB;
constexpr size_t AR_H = WS_AR;
constexpr size_t AR_PR = WS_AR, AR_MQ = WS_AR + 56 * MiB, AR_MK = WS_AR + 72 * MiB, AR_MVT = WS_AR + 88 * MiB;
constexpr size_t AR_SCANIN = WS_AR + 56 * MiB;
constexpr size_t AR_SV = WS_AR + 136 * MiB;
constexpr size_t AR_YLOC = WS_AR, AR_Z = WS_AR + 32 * MiB;
constexpr size_t AR_STATE = WS_AR + 152 * MiB;
constexpr size_t AR_XB2 = WS_AR, AR_XQ = WS_AR + 32 * MiB, AR_XO = WS_AR + 64 * MiB;
constexpr size_t WS_END = WS_AR + 168 * MiB;

#define GAS __attribute__((address_space(1)))
#define LAS __attribute__((address_space(3)))

namespace pg8 {
#define PG8_LAS __attribute__((address_space(3)))
typedef unsigned short bf16_t;
typedef short bf16x8 __attribute__((ext_vector_type(8)));
typedef float f32x4 __attribute__((ext_vector_type(4)));
typedef unsigned u32x4 __attribute__((ext_vector_type(4)));
constexpr int BM = 256, BK = 64, HALF = 128, HTB = HALF * BK * 2  , STAGE_BYTES = 8 * HTB, NXCD = 8, WGM = 8;

__host__ __device__ __forceinline__ int lds_byte(int r, int c) { const int st = (r >> 4) * 2 + (c >> 5), rr = r & 15, cc = c & 31, ob = rr * 64 + cc * 2; return st * 1024 + (ob ^ (((ob >> 9) & 1) << 5)); }
__host__ __device__ __forceinline__ void stage_rc(int b, int& R, int& C) { const int st = b / 1024, sb = b % 1024, swz = sb ^ (((sb >> 9) & 1) << 5); R = (st >> 1) * 16 + swz / 64; C = (st & 1) * 32 + (swz % 64) / 2; }
__host__ __device__ __forceinline__ int perm32(int rho) { const int n = rho >> 4, i = rho & 15; return 8 * (i >> 2) + 4 * n + (i & 3); }

struct Unit { int pm, pn, i; };
struct Gemm { const bf16_t* A; const bf16_t* Bt; int M, N, K; };

struct StaticOrder {
    int nM, nN, nwg, G, c;
    __host__ __device__ void init(int M, int N, int G_, int c_) { nM = M / BM; nN = N / BM; nwg = nM * nN; G = G_; c = c_; }
    __host__ __device__ bool next(int i, Unit& u) const {
        const long L = (long)i * G + c; if (L >= nwg) return false;
        int wgid = (int)L; { const int q = nwg / NXCD, r = nwg % NXCD, xcd = wgid % NXCD, off = wgid / NXCD; wgid = (xcd < r ? xcd * (q + 1) : r * (q + 1) + (xcd - r) * q) + off; }
        const int nig = WGM * nN, gid = wgid / nig, fm = gid * WGM, gsz = (nM - fm) < WGM ? (nM - fm) : WGM;
        u.pm = fm + ((wgid % nig) % gsz); u.pn = (wgid % nig) / gsz; u.i = i; return true;
    }
    __device__ __forceinline__ void a_ready(const Unit&) const {}
    __device__ __forceinline__ void done(const Unit&) const {}
};

__device__ __forceinline__ unsigned cvt_pk_bf16(float lo, float hi) { unsigned r; asm volatile("v_cvt_pk_bf16_f32 %0, %1, %2" : "=v"(r) : "v"(lo), "v"(hi)); return r; }
typedef float f32x2 __attribute__((ext_vector_type(2)));
__device__ __forceinline__ float row_rstd16(const float* ssq, int r) {
    const f32x4* p = (const f32x4*)(ssq + (size_t)r * 16);
    const f32x4 a = p[0], b = p[1], c = p[2], d = p[3];
    const float s = ((a[0] + a[1]) + (a[2] + a[3])) + ((b[0] + b[1]) + (b[2] + b[3])) + ((c[0] + c[1]) + (c[2] + c[3])) + ((d[0] + d[1]) + (d[2] + d[3]));
    return __builtin_amdgcn_rsqf(s * (1.0f / 1024.0f) + 1e-6f);
}
constexpr int RST_OFF = 131072;
__device__ __forceinline__ float silu_mul(float g, float u) { return g * __builtin_amdgcn_rcpf(1.0f + __expf(-g)) * u; }
__device__ __forceinline__ u32x4 pack8(const f32x4 v0, const f32x4 v1) { u32x4 w; w.x = cvt_pk_bf16(v0[0], v0[1]); w.y = cvt_pk_bf16(v0[2], v0[3]); w.z = cvt_pk_bf16(v1[0], v1[1]); w.w = cvt_pk_bf16(v1[2], v1[3]); return w; }
__device__ __forceinline__ int pos16(int k) { return 8 * ((k >> 2) & 1) + (k & 3) + 4 * (k >> 3); }

struct EpiSwiGLU {
    static constexpr bool PERM = true, AFTER_DRAIN = false;
    unsigned char* ws; PG8_LAS unsigned char* lds;
    __device__ __forceinline__ void operator()(const f32x4 (&acc)[2][2][4][2], const Unit& u, int wr, int wc, int fr, int fq) const {
        const int row0 = u.pm * BM + wr * 64 + fr, hcol = u.pn * 128 + wc * 32 + 8 * fq; bf16_t* H = (bf16_t*)(ws + AR_H);
        const PG8_LAS float* rst = (const PG8_LAS float*)(lds + RST_OFF) + u.i * 256 + wr * 64 + fr;
#pragma unroll
        for (int ai = 0; ai < 2; ++ai)
#pragma unroll
            for (int m = 0; m < 4; ++m) { const int r = row0 + ai * HALF + m * 16; const float rs = rst[ai * HALF + m * 16];
                f32x4 h0, h1;
#pragma unroll
                for (int i = 0; i < 4; ++i) { h0[i] = silu_mul(acc[ai][0][m][0][i] * rs, acc[ai][1][m][0][i] * rs); h1[i] = silu_mul(acc[ai][0][m][1][i] * rs, acc[ai][1][m][1][i] * rs); }
                *(u32x4*)(H + (size_t)r * 2816 + hcol) = pack8(h0, h1); }
    }
};
struct EpiResid {
    static constexpr bool PERM = true, AFTER_DRAIN = false;
    const float* base; float* out; unsigned char* ws; size_t xb_off; float alpha;
    __device__ __forceinline__ void operator()(const f32x4 (&acc)[2][2][4][2], const Unit& u, int wr, int wc, int fr, int fq) const {
        const int row0 = u.pm * BM + wr * 64 + fr, col0 = u.pn * BM + wc * 32 + 8 * fq; bf16_t* xb = (bf16_t*)(ws + xb_off); float* ssq = (float*)(ws + WS_SSQ);
#pragma unroll
        for (int ai = 0; ai < 2; ++ai) {
            f32x4 bs[4][2][2];
#pragma unroll
            for (int m = 0; m < 4; ++m)
#pragma unroll
                for (int bj = 0; bj < 2; ++bj) { const size_t off = (size_t)(row0 + ai * HALF + m * 16) * 1024 + col0 + bj * HALF; bs[m][bj][0] = *(const f32x4*)(base + off); bs[m][bj][1] = *(const f32x4*)(base + off + 4); }
#pragma unroll
            for (int m = 0; m < 4; ++m)
#pragma unroll
                for (int bj = 0; bj < 2; ++bj) asm volatile("" : "+v"(bs[m][bj][0]), "+v"(bs[m][bj][1]));
#pragma unroll
            for (int m = 0; m < 4; ++m) { const int r = row0 + ai * HALF + m * 16; float s = 0.f;
#pragma unroll
                for (int bj = 0; bj < 2; ++bj) { const size_t off = (size_t)r * 1024 + col0 + bj * HALF;
                    const f32x4 v0 = bs[m][bj][0] + acc[ai][bj][m][0] * alpha, v1 = bs[m][bj][1] + acc[ai][bj][m][1] * alpha;
                    *(f32x4*)(out + off) = v0; *(f32x4*)(out + off + 4) = v1; *(u32x4*)(xb + off) = pack8(v0, v1);
                    s += (v0[0] * v0[0] + v0[1] * v0[1]) + (v0[2] * v0[2] + v0[3] * v0[3]) + (v1[0] * v1[0] + v1[1] * v1[1]) + (v1[2] * v1[2] + v1[3] * v1[3]); }
                s += __shfl_xor(s, 16); s += __shfl_xor(s, 32);
                if (fq == 0) ssq[(size_t)r * 16 + u.pn * 4 + wc] = s; } }
    }
};
struct EpiMixIn {
    static constexpr bool PERM = true, AFTER_DRAIN = false;
    unsigned char* ws; PG8_LAS unsigned char* lds;
    __device__ __forceinline__ void operator()(const f32x4 (&acc)[2][2][4][2], const Unit& u, int wr, int wc, int fr, int fq) const {
        const int row0 = u.pm * BM + wr * 64 + fr, cw = wc * 32 + 8 * fq; const PG8_LAS float* rst = (const PG8_LAS float*)(lds + RST_OFF) + u.i * 256 + wr * 64 + fr;
        bf16_t* PR = (bf16_t*)(ws + AR_PR); bf16_t* MQ = (bf16_t*)(ws + AR_MQ); bf16_t* MK = (bf16_t*)(ws + AR_MK); bf16_t* MVT = (bf16_t*)(ws + AR_MVT);
        f32x4 ks[2][2]; ks[0][0] = (f32x4){0.f, 0.f, 0.f, 0.f}; ks[0][1] = ks[0][0]; ks[1][0] = ks[0][0]; ks[1][1] = ks[0][0];
#pragma unroll
        for (int ai = 0; ai < 2; ++ai)
#pragma unroll
            for (int m = 0; m < 4; ++m) { const int r = row0 + ai * HALF + m * 16; const float rs = rst[ai * HALF + m * 16];
#pragma unroll
                for (int bj = 0; bj < 2; ++bj) { const int c = cw + bj * HALF;
                    f32x4 v0 = acc[ai][bj][m][0] * rs, v1 = acc[ai][bj][m][1] * rs;
                    if (u.pn < 7) *(u32x4*)(PR + (size_t)r * 1792 + u.pn * 256 + c) = pack8(v0, v1);
                    else if (u.pn < 9) { v0 = v0 * MOBA_QSCALE; v1 = v1 * MOBA_QSCALE; *(u32x4*)(MQ + (size_t)r * 512 + (u.pn - 7) * 256 + c) = pack8(v0, v1); }
                    else if (u.pn < 11) { *(u32x4*)(MK + (size_t)r * 512 + (u.pn - 9) * 256 + c) = pack8(v0, v1); ks[bj][0] += v0; ks[bj][1] += v1; }
                    else { const int cc = (u.pn - 11) * 256 + c, hh = cc >> 6, d = cc & 63, b = r >> 11, t = r & 2047;
                        bf16_t* p = MVT + ((size_t)(b * 8 + hh) * 64 + d) * 2048 + (t & ~15) + pos16(t & 15);
                        const u32x4 w = pack8(v0, v1);
                        p[0] = (bf16_t)(w.x & 0xffffu); p[2048] = (bf16_t)(w.x >> 16); p[2 * 2048] = (bf16_t)(w.y & 0xffffu); p[3 * 2048] = (bf16_t)(w.y >> 16);
                        p[4 * 2048] = (bf16_t)(w.z & 0xffffu); p[5 * 2048] = (bf16_t)(w.z >> 16); p[6 * 2048] = (bf16_t)(w.w & 0xffffu); p[7 * 2048] = (bf16_t)(w.w >> 16); }
                } }
        if (u.pn == 9 || u.pn == 10) {
            float* KMS = (float*)(ws + WS_KMS) + ((size_t)u.pm * 2 + wr) * 512 + (u.pn - 9) * 256 + cw;
#pragma unroll
            for (int bj = 0; bj < 2; ++bj)
#pragma unroll
                for (int n = 0; n < 2; ++n) { f32x4 v = ks[bj][n];
#pragma unroll
                    for (int o = 1; o < 16; o <<= 1) { v[0] += __shfl_xor(v[0], o); v[1] += __shfl_xor(v[1], o); v[2] += __shfl_xor(v[2], o); v[3] += __shfl_xor(v[3], o); }
                    if (fr == 0) *(f32x4*)(KMS + bj * HALF + 4 * n) = v; } }
    }
};
struct EpiXQ {
    static constexpr bool PERM = true, AFTER_DRAIN = false;
    unsigned char* ws; PG8_LAS unsigned char* lds;
    __device__ __forceinline__ void operator()(const f32x4 (&acc)[2][2][4][2], const Unit& u, int wr, int wc, int fr, int fq) const {
        const int row0 = u.pm * BM + wr * 64 + fr, col0 = u.pn * BM + wc * 32 + 8 * fq; bf16_t* Q = (bf16_t*)(ws + AR_XQ);
        const PG8_LAS float* rst = (const PG8_LAS float*)(lds + RST_OFF) + u.i * 256 + wr * 64 + fr;
#pragma unroll
        for (int ai = 0; ai < 2; ++ai)
#pragma unroll
            for (int m = 0; m < 4; ++m) { const int r = row0 + ai * HALF + m * 16; const float rs = rst[ai * HALF + m * 16] * XATT_QSCALE;
#pragma unroll
                for (int bj = 0; bj < 2; ++bj) *(u32x4*)(Q + (size_t)r * 1024 + col0 + bj * HALF) = pack8(acc[ai][bj][m][0] * rs, acc[ai][bj][m][1] * rs); }
    }
};
struct EpiKV {
    static constexpr bool PERM = true, AFTER_DRAIN = false;
    unsigned char* ws;
    __device__ __forceinline__ void operator()(const f32x4 (&acc)[2][2][4][2], const Unit& u, int wr, int wc, int fr, int fq) const {
        const int row0 = u.pm * BM + wr * 64 + fr, cw = wc * 32 + 8 * fq; bf16_t* XK = (bf16_t*)(ws + WS_XK); bf16_t* XVT = (bf16_t*)(ws + WS_XVT); const float* memrs = (const float*)(ws + WS_MEMRS);
        float rsv[2][4];
#pragma unroll
        for (int ai = 0; ai < 2; ++ai)
#pragma unroll
            for (int m = 0; m < 4; ++m) rsv[ai][m] = memrs[row0 + ai * HALF + m * 16];
#pragma unroll
        for (int ai = 0; ai < 2; ++ai)
#pragma unroll
            for (int m = 0; m < 4; ++m) { const int r = row0 + ai * HALF + m * 16; const float rs = rsv[ai][m];
#pragma unroll
                for (int bj = 0; bj < 2; ++bj) { const int c = cw + bj * HALF;
                    const f32x4 v0 = acc[ai][bj][m][0] * rs, v1 = acc[ai][bj][m][1] * rs;
                    if (u.pn < 4) *(u32x4*)(XK + (size_t)r * 1024 + u.pn * 256 + c) = pack8(v0, v1);
                    else { const int hx = u.pn - 4, b = r >> 8, key = r & 255;
                        bf16_t* p = XVT + ((size_t)(b * 4 + hx) * 256 + c) * 256 + (key & ~15) + pos16(key & 15);
                        const u32x4 w = pack8(v0, v1);
                        p[0] = (bf16_t)(w.x & 0xffffu); p[256] = (bf16_t)(w.x >> 16); p[2 * 256] = (bf16_t)(w.y & 0xffffu); p[3 * 256] = (bf16_t)(w.y >> 16);
                        p[4 * 256] = (bf16_t)(w.z & 0xffffu); p[5 * 256] = (bf16_t)(w.z >> 16); p[6 * 256] = (bf16_t)(w.w & 0xffffu); p[7 * 256] = (bf16_t)(w.w >> 16); }
                } }
    }
};

template <class Epi, class Sched, bool ALIGN_EPI = false, bool SP2 = false>
__device__ __forceinline__ void gemm_phase(PG8_LAS unsigned char* lds, const Gemm g, const Sched& S, const Epi& E) {
    int tid_ = threadIdx.x; asm volatile("" : "+v"(tid_));
    const int tid = tid_, wid = __builtin_amdgcn_readfirstlane(tid >> 6), lane = tid & 63, wr = wid >> 2, wc = wid & 3, fr = lane & 15, fq = lane >> 4;
    const int K = g.K, nt = K / BK;
    unsigned voffA[2], voffB[2];
#pragma unroll
    for (int i = 0; i < 2; ++i) { int R, C; stage_rc(tid * 16 + i * 8192, R, C); const int Rb = Epi::PERM ? ((R & ~31) + perm32(R & 31)) : R;
        voffA[i] = (unsigned)(R * K + C) * 2u; voffB[i] = (unsigned)(Rb * K + C) * 2u; }
    const size_t kstep = (size_t)(BK * 2);
    const size_t hstep = (size_t)HALF * K * 2;
    const size_t tstep = 2 * hstep;
    const unsigned ldsw = (unsigned)wid * 1024u;
    const int aoff = lds_byte(wr * 64 + fr, fq * 8), boff = lds_byte(wc * 32 + fr, fq * 8);
#define PG8_SA(b, h) (((b) * 2 + (h)) * HTB)
#define PG8_SB(b, h) ((4 + (b) * 2 + (h)) * HTB)
#define PG8_STAGE(bufoff, gbase, voff) do { _Pragma("unroll") for (int _i = 0; _i < 2; ++_i) \
        __builtin_amdgcn_global_load_lds((const unsigned*)((const char*)(gbase) + (voff)[_i]), (PG8_LAS unsigned*)(lds + (bufoff) + ldsw + _i * 8192), 16, 0, 0); } while (0)
#define PG8_LDA(dst, b, h) do { _Pragma("unroll") for (int m = 0; m < 4; ++m) _Pragma("unroll") for (int k = 0; k < 2; ++k) dst[m][k] = *(const PG8_LAS bf16x8*)(lds + PG8_SA(b, h) + aoff + m * 2048 + k * 1024); } while (0)
#define PG8_LDB(dst, b, h) do { _Pragma("unroll") for (int n = 0; n < 2; ++n) _Pragma("unroll") for (int k = 0; k < 2; ++k) dst[n][k] = *(const PG8_LAS bf16x8*)(lds + PG8_SB(b, h) + boff + n * 2048 + k * 1024); } while (0)
#define PG8_MMA(ai, bj, At, Bt) do { __builtin_amdgcn_s_setprio(1); _Pragma("unroll") for (int m = 0; m < 4; ++m) _Pragma("unroll") for (int n = 0; n < 2; ++n) _Pragma("unroll") for (int k = 0; k < 2; ++k) \
        acc[ai][bj][m][n] = __builtin_amdgcn_mfma_f32_16x16x32_bf16(Bt[n][k], At[m][k], acc[ai][bj][m][n], 0, 0, 0); __builtin_amdgcn_s_setprio(0); } while (0)
#define PG8_WAIT_V(n) asm volatile("s_waitcnt vmcnt(" #n ")" ::: "memory")
#define PG8_WAIT_L(n) asm volatile("s_waitcnt lgkmcnt(" #n ")" ::: "memory")
#define PG8_BAR __builtin_amdgcn_s_barrier()
#define PG8_SCHED __builtin_amdgcn_sched_barrier(0)
    Unit cur, nxt; int ui = 0;
    if (!S.next(0, cur)) return;
    f32x4 acc[2][2][4][2];
#pragma unroll
    for (int a = 0; a < 2; ++a)
#pragma unroll
        for (int b = 0; b < 2; ++b)
#pragma unroll
            for (int m = 0; m < 4; ++m)
#pragma unroll
                for (int n = 0; n < 2; ++n) acc[a][b][m][n] = (f32x4){0.f, 0.f, 0.f, 0.f};
    bf16x8 At[4][2], B0[2][2], B1[2][2];
    const char* cA = (const char*)g.A + (size_t)cur.pm * tstep; const char* cB = (const char*)g.Bt + (size_t)cur.pn * tstep;
    S.a_ready(cur);
    if constexpr (SP2) {
        PG8_STAGE(PG8_SB(0, 0), cB, voffB); PG8_STAGE(PG8_SB(0, 1), cB + hstep, voffB); PG8_STAGE(PG8_SA(0, 0), cA, voffA); PG8_STAGE(PG8_SA(0, 1), cA + hstep, voffA);
        if (wr == 1) PG8_BAR;
        PG8_WAIT_V(2); PG8_BAR;
        PG8_STAGE(PG8_SB(1, 0), cB + kstep, voffB); PG8_STAGE(PG8_SA(1, 0), cA + kstep, voffA); PG8_STAGE(PG8_SB(1, 1), cB + hstep + kstep, voffB);
        PG8_WAIT_V(6); PG8_BAR;
    } else {
        PG8_STAGE(PG8_SB(0, 0), cB, voffB); PG8_STAGE(PG8_SA(0, 0), cA, voffA); PG8_STAGE(PG8_SB(0, 1), cB + hstep, voffB); PG8_STAGE(PG8_SA(0, 1), cA + hstep, voffA);
        if (wr == 1) PG8_BAR;
        PG8_WAIT_V(4); PG8_BAR;
        PG8_STAGE(PG8_SB(1, 0), cB + kstep, voffB); PG8_STAGE(PG8_SA(1, 0), cA + kstep, voffA); PG8_STAGE(PG8_SB(1, 1), cB + hstep + kstep, voffB);
        PG8_WAIT_V(6); PG8_BAR;
    }
    for (;;) {
        const bool has_next = S.next(ui + 1, nxt);
        const char* nA = has_next ? (const char*)g.A + (size_t)nxt.pm * tstep : cA; const char* nB = has_next ? (const char*)g.Bt + (size_t)nxt.pn * tstep : cB;
        for (int t = 0; t < nt; t += 2) {
            const bool last = (t == nt - 2);
            const char* a1 = cA + (size_t)(t + 1) * kstep;
            const char* a2 = last ? nA : cA + (size_t)(t + 2) * kstep; const char* b2 = last ? nB : cB + (size_t)(t + 2) * kstep;
            const char* a3 = a2 + kstep; const char* b3 = b2 + kstep;
            if (last && has_next) S.a_ready(nxt);
            if constexpr (SP2) {
            PG8_LDB(B0, 0, 0); PG8_LDB(B1, 0, 1); PG8_SCHED; PG8_LDA(At, 0, 0); PG8_STAGE(PG8_SA(1, 1), a1 + hstep, voffA);
            PG8_WAIT_V(8); PG8_WAIT_L(0); PG8_BAR; PG8_MMA(0, 0, At, B0); PG8_MMA(0, 1, At, B1); PG8_BAR; PG8_SCHED;
            PG8_LDA(At, 0, 1); PG8_STAGE(PG8_SB(0, 0), b2, voffB); PG8_STAGE(PG8_SB(0, 1), b2 + hstep, voffB); PG8_STAGE(PG8_SA(0, 0), a2, voffA);
            PG8_WAIT_V(8); PG8_WAIT_L(0); PG8_BAR; PG8_MMA(1, 0, At, B0); PG8_MMA(1, 1, At, B1); PG8_BAR; PG8_SCHED;
            PG8_LDB(B0, 1, 0); PG8_LDB(B1, 1, 1); PG8_SCHED; PG8_LDA(At, 1, 0); PG8_STAGE(PG8_SA(0, 1), a2 + hstep, voffA);
            PG8_WAIT_V(8); PG8_WAIT_L(0); PG8_BAR; PG8_MMA(0, 0, At, B0); PG8_MMA(0, 1, At, B1); PG8_BAR; PG8_SCHED;
            PG8_LDA(At, 1, 1); PG8_STAGE(PG8_SB(1, 0), b3, voffB); PG8_STAGE(PG8_SB(1, 1), b3 + hstep, voffB); PG8_STAGE(PG8_SA(1, 0), a3, voffA);
            PG8_WAIT_V(8); PG8_WAIT_L(0); PG8_BAR; PG8_MMA(1, 0, At, B0); PG8_MMA(1, 1, At, B1); PG8_BAR; PG8_SCHED;
            } else {
            PG8_LDB(B0, 0, 0); PG8_SCHED; PG8_LDA(At, 0, 0); PG8_STAGE(PG8_SA(1, 1), a1 + hstep, voffA);
            PG8_WAIT_L(8); PG8_BAR; PG8_WAIT_L(0); PG8_MMA(0, 0, At, B0); PG8_BAR; PG8_SCHED;
            PG8_LDB(B1, 0, 1); PG8_STAGE(PG8_SB(0, 0), b2, voffB);
            PG8_BAR; PG8_WAIT_L(0); PG8_MMA(0, 1, At, B1); PG8_BAR;
            PG8_LDA(At, 0, 1); PG8_STAGE(PG8_SA(0, 0), a2, voffA);
            PG8_BAR; PG8_WAIT_L(0); PG8_MMA(1, 0, At, B0); PG8_BAR; PG8_SCHED;
            PG8_STAGE(PG8_SB(0, 1), b2 + hstep, voffB);
            PG8_WAIT_V(6); PG8_BAR; PG8_MMA(1, 1, At, B1); PG8_BAR;
            PG8_LDB(B0, 1, 0); PG8_SCHED; PG8_LDA(At, 1, 0); PG8_STAGE(PG8_SA(0, 1), a2 + hstep, voffA);
            PG8_WAIT_L(8); PG8_BAR; PG8_WAIT_L(0); PG8_MMA(0, 0, At, B0); PG8_BAR; PG8_SCHED;
            PG8_LDB(B1, 1, 1); PG8_STAGE(PG8_SB(1, 0), b3, voffB);
            PG8_BAR; PG8_WAIT_L(0); PG8_MMA(0, 1, At, B1); PG8_BAR;
            PG8_LDA(At, 1, 1); PG8_STAGE(PG8_SA(1, 0), a3, voffA);
            PG8_BAR; PG8_WAIT_L(0); PG8_MMA(1, 0, At, B0); PG8_BAR; PG8_SCHED;
            PG8_STAGE(PG8_SB(1, 1), b3 + hstep, voffB);
            PG8_WAIT_V(6); PG8_BAR; PG8_MMA(1, 1, At, B1); PG8_BAR;
            }
        }
        if constexpr (ALIGN_EPI) { if (wr == 0) PG8_BAR; }
        if constexpr (!Epi::AFTER_DRAIN) { E(acc, cur, wr, wc, fr, fq); S.done(cur); }
        if (!has_next) break;
#pragma unroll
        for (int a = 0; a < 2; ++a)
#pragma unroll
            for (int b = 0; b < 2; ++b)
#pragma unroll
                for (int m = 0; m < 4; ++m)
#pragma unroll
                    for (int n = 0; n < 2; ++n) acc[a][b][m][n] = (f32x4){0.f, 0.f, 0.f, 0.f};
        cur = nxt; cA = nA; cB = nB; ++ui;
        if constexpr (ALIGN_EPI) { if (wr == 1) PG8_BAR; }
    }
    PG8_WAIT_V(0);
    if constexpr (!ALIGN_EPI) { if (wr == 0) PG8_BAR; }
    PG8_BAR;
    if constexpr (Epi::AFTER_DRAIN) { E.fused(acc, cur, wr, wc, fr, fq, lds, wid, lane); S.done(cur); }
#undef PG8_SA
#undef PG8_SB
#undef PG8_STAGE
#undef PG8_LDA
#undef PG8_LDB
#undef PG8_MMA
#undef PG8_WAIT_V
#undef PG8_WAIT_L
#undef PG8_BAR
#undef PG8_SCHED
}
}

constexpr int NWAVES = 8;
constexpr int LDS_BYTES = 163840, LDSCTL_OFF = LDS_BYTES - 512, MISC_OFF = LDSCTL_OFF + 320, PHASE_LDS = LDSCTL_OFF;
constexpr int SCAN_R = 2, SCAN_NCH = 8;

typedef unsigned short bf16;
typedef unsigned u32x4 __attribute__((ext_vector_type(4)));
typedef unsigned u32x2 __attribute__((ext_vector_type(2)));
typedef float f32x4 __attribute__((ext_vector_type(4)));
typedef float f32x16 __attribute__((ext_vector_type(16)));
typedef short bf16x8 __attribute__((ext_vector_type(8)));
typedef GAS unsigned gu32;
#define RLX_AGENT __ATOMIC_RELAXED, __HIP_MEMORY_SCOPE_AGENT
#define LDS_WAIT() asm volatile("s_waitcnt lgkmcnt(0)" ::: "memory")
#define VM_WAIT() asm volatile("s_waitcnt vmcnt(0)" ::: "memory")
__device__ __forceinline__ float bf2f(unsigned b) { return __uint_as_float(b << 16); }
__device__ __forceinline__ unsigned f2bf(float f) { unsigned u = __builtin_bit_cast(unsigned, f); return (u + 0x7fffu + ((u >> 16) & 1u)) >> 16; }
__device__ __forceinline__ unsigned pk2(float lo, float hi) { return pg8::cvt_pk_bf16(lo, hi); }
__device__ __forceinline__ float wave_sum(float v) {
#pragma unroll
    for (int o = 1; o < 64; o <<= 1) v += __shfl_xor(v, o);
    return v;
}
#define WS8_STEP(o) _Pragma("unroll") for (int q = 0; q < 8; ++q) v[q] += __shfl_xor(v[q], o);
__device__ __forceinline__ void wave_sum8(float (&v)[8]) { WS8_STEP(1) WS8_STEP(2) WS8_STEP(4) WS8_STEP(8) WS8_STEP(16) WS8_STEP(32) }
__device__ __forceinline__ float quad_sum(float x) {
    x += __builtin_bit_cast(float, __builtin_amdgcn_update_dpp(0, __builtin_bit_cast(int, x), 0xB1, 0xF, 0xF, true));
    x += __builtin_bit_cast(float, __builtin_amdgcn_update_dpp(0, __builtin_bit_cast(int, x), 0x4E, 0xF, 0xF, true));
    return x;
}
__device__ __forceinline__ float sigmoidf_(float x) { return __builtin_amdgcn_rcpf(1.0f + __expf(-x)); }
__device__ __forceinline__ int crow(int r, int hi) { return (r & 3) + 8 * (r >> 2) + 4 * hi; }
__device__ __forceinline__ bf16x8 pack_bf16x8(float a0, float a1, float a2, float a3, float a4, float a5, float a6, float a7) {
    u32x4 w; w.x = pk2(a0, a1); w.y = pk2(a2, a3); w.z = pk2(a4, a5); w.w = pk2(a6, a7); return __builtin_bit_cast(bf16x8, w);
}

#define XB_TMO      128
#define XB_XCNT(j)  (256  + 64 * (j))
#define XB_XSUB(j)  (1280 + 64 * (j))
#define XB_XGEN(j)  (2304 + 64 * (j))
#define XB_TOP      3328
#define XB_TOPGEN   3392
#define XCD_BAR_WORDS 3456
#define XB_SPIN_CAP (1u << 18)

__device__ __forceinline__ unsigned xb_ld(unsigned* p)              { return __hip_atomic_load(p, __ATOMIC_RELAXED, __HIP_MEMORY_SCOPE_AGENT); }
__device__ __forceinline__ unsigned xb_add(unsigned* p, unsigned v) { return __hip_atomic_fetch_add(p, v, __ATOMIC_RELAXED, __HIP_MEMORY_SCOPE_AGENT); }
__device__ __forceinline__ unsigned xb_xcc_id() { return (unsigned)__builtin_amdgcn_s_getreg((3 << 11) | 20) & 0xFu; }
#define XB_SPIN(cond, bar) do { unsigned _sp = 0; while (cond) { __builtin_amdgcn_s_sleep(1); \
    if ((++_sp & 255u) == 0u) { if (xb_ld(&(bar)[XB_TMO])) break; if (_sp > XB_SPIN_CAP) { atomicAdd(&(bar)[XB_TMO], 1u); break; } } } } while (0)

struct XcdBarrier {
    unsigned* bar; unsigned x;
    volatile LAS unsigned* st;
};

__device__ __forceinline__ XcdBarrier xcd_barrier_post(unsigned* bar, volatile LAS unsigned* st) {
    XcdBarrier b; b.bar = bar; b.x = xb_xcc_id(); b.st = st;
    if (threadIdx.x == 0) (void)xb_add(&bar[XB_XCNT(b.x)], 1u);
    return b;
}
__device__ __forceinline__ void xcd_barrier_complete(unsigned* bar, unsigned x, unsigned& nloc, unsigned& nx) {
    const unsigned G = gridDim.x * gridDim.y * gridDim.z;
    unsigned sum, cnt, mine, sp = 0u;
    for (;;) {
        sum = 0u; cnt = 0u; mine = 0u;
#pragma unroll
        for (unsigned j = 0; j < 16; ++j) { const unsigned c = xb_ld(&bar[XB_XCNT(j)]); sum += c; cnt += (c > 0u) ? 1u : 0u; mine = (j == x) ? c : mine; }
        if (sum == G) break;
        __builtin_amdgcn_s_sleep(1);
        if ((++sp & 255u) == 0u) { if (xb_ld(&bar[XB_TMO])) break; if (sp > XB_SPIN_CAP) { atomicAdd(&bar[XB_TMO], 1u); break; } }
    }
    nloc = mine > 0u ? mine : 1u; nx = cnt > 0u ? cnt : 1u;
}

__device__ __forceinline__ void xcd_barrier(const XcdBarrier& b) {
    asm volatile("s_waitcnt vmcnt(0)" ::: "memory");
    __syncthreads();
    if (threadIdx.x == 0) {
        unsigned* bar = b.bar;
        __builtin_amdgcn_s_waitcnt(0);
        unsigned nloc = b.st[0], nx = b.st[1];
        if (nloc == 0u) { xcd_barrier_complete(bar, b.x, nloc, nx); b.st[0] = nloc; b.st[1] = nx; }
        const unsigned old = xb_add(&bar[XB_XSUB(b.x)], 1u);
        const unsigned gen = old / nloc;
        if (old + 1u == (gen + 1u) * nloc) {
            __builtin_amdgcn_fence(__ATOMIC_RELEASE, "agent");
            asm volatile("s_waitcnt vmcnt(0)" ::: "memory");
            const unsigned og = xb_add(&bar[XB_TOP], 1u);
            const unsigned tg = og / nx;
            if (og + 1u == (tg + 1u) * nx) xb_add(&bar[XB_TOPGEN], 1u);
            else XB_SPIN(xb_ld(&bar[XB_TOPGEN]) == tg, bar);
            __builtin_amdgcn_fence(__ATOMIC_ACQUIRE, "agent");
            xb_add(&bar[XB_XGEN(b.x)], 1u);
            asm volatile("s_waitcnt vmcnt(0)" ::: "memory");
        } else {
            XB_SPIN(xb_ld(&bar[XB_XGEN(b.x)]) == gen, bar);
            __builtin_amdgcn_fence(__ATOMIC_ACQUIRE, "agent");
            asm volatile("s_waitcnt vmcnt(0)" ::: "memory");
        }
    }
    __syncthreads();
}


struct Args { const float* in[N_IN]; float* out; unsigned char* ws; int ph_lo, ph_hi; };
static_assert(sizeof(Args) == N_IN * 8 + 24, "Args has no padding");
struct Frame {
    LAS unsigned char* lds; volatile LAS unsigned* MISC; gu32* ctl;
    int tid, lane, wave, vcu, G;
    const __attribute__((address_space(4))) struct Args* ka; float* out; unsigned char* ws;
};
#define FIN(i) (F.ka->in[i])
#define PHASE_IDS() do { int t_ = threadIdx.x; asm volatile("" : "+v"(t_)); F.tid = t_; F.lane = t_ & 63; F.wave = __builtin_amdgcn_readfirstlane(t_ >> 6); } while (0)
#define WSP(T, off) ((T*)(F.ws + (off)))

__device__ __forceinline__ void fill_rstd(Frame& F, const pg8::StaticOrder& S) {
    int tid = threadIdx.x; asm volatile("" : "+v"(tid)); LAS float* tab = (LAS float*)(F.lds + pg8::RST_OFF); const float* ssq = WSP(float, WS_SSQ);
    pg8::Unit u;
    for (int i0 = 0; S.next(i0, u); i0 += 2) { const int i = i0 + (tid >> 8); if (S.next(i, u)) tab[i * 256 + (tid & 255)] = pg8::row_rstd16(ssq, u.pm * 256 + (tid & 255)); }
    __syncthreads();
}

__device__ __forceinline__ void ph_init(Frame& F) {
    PHASE_IDS();
    const int gw = F.vcu * NWAVES + F.wave, NGW = F.G * NWAVES;
    float* bias = WSP(float, WS_BIAS); const float* relb = FIN(I_RELB);
    for (int i = blockIdx.x * 512 + F.tid; i < NH * 2048; i += F.G * 512) { const int h = i >> 11, n = i & 2047; int bkt;
        if (n < 16) bkt = n; else { const float nf = (float)n; const int lg = 16 + (int)(logf(nf / 16.0f) / 4.1588830833596715f * 16.0f); bkt = lg < 31 ? lg : 31; }
        bias[i] = relb[h * 32 + bkt] * LOG2E; }
    const float* mem = FIN(I_MEM); bf16* memb = WSP(bf16, WS_MEMB); float* memrs = WSP(float, WS_MEMRS);
    for (int r = gw; r < MM; r += NGW) { const f32x4* xr = (const f32x4*)(mem + (size_t)r * DM) + F.lane; f32x4 v[4]; float s = 0.f;
#pragma unroll
        for (int j = 0; j < 4; ++j) { v[j] = xr[64 * j]; s += (v[j].x * v[j].x + v[j].y * v[j].y) + (v[j].z * v[j].z + v[j].w * v[j].w); }
        s = wave_sum(s); u32x2* o = (u32x2*)(memb + (size_t)r * DM) + F.lane;
#pragma unroll
        for (int j = 0; j < 4; ++j) { u32x2 w; w.x = pk2(v[j].x, v[j].y); w.y = pk2(v[j].z, v[j].w); o[64 * j] = w; }
        if (F.lane == 0) memrs[r] = __builtin_amdgcn_rsqf(s * (1.0f / DM) + NORM_EPS); }
    const float* x = FIN(I_X); bf16* xb = WSP(bf16, WS_XB); float* ssq = WSP(float, WS_SSQ);
    for (int r = gw; r < M; r += NGW) { const f32x4* xr = (const f32x4*)(x + (size_t)r * DM) + F.lane; f32x4 v[4]; float s = 0.f;
#pragma unroll
        for (int j = 0; j < 4; ++j) { v[j] = xr[64 * j]; s += (v[j].x * v[j].x + v[j].y * v[j].y) + (v[j].z * v[j].z + v[j].w * v[j].w); }
        s = wave_sum(s); u32x2* o = (u32x2*)(xb + (size_t)r * DM) + F.lane;
#pragma unroll
        for (int j = 0; j < 4; ++j) { u32x2 w; w.x = pk2(v[j].x, v[j].y); w.y = pk2(v[j].z, v[j].w); o[64 * j] = w; }
        if (F.lane < 16) ssq[(size_t)r * 16 + F.lane] = F.lane == 0 ? s : 0.f; }
}

__device__ __forceinline__ void conv_item(const float* W, int K, int N, const float* gk, bf16* WT, int item, bool ffn_in, LAS float* scr, int lane) {
    const int nblk = N / 32, kb = item / nblk, nb = item % nblk, k0 = 64 * kb, n0 = 32 * nb;
#pragma unroll 8
    for (int i = 0; i < 32; ++i) { const int kk = 2 * i + (lane >> 5); float w = W[(size_t)(k0 + kk) * N + n0 + (lane & 31)]; if (gk) w *= gk[k0 + kk]; scr[kk * 33 + (lane & 31)] = w; }
    LDS_WAIT(); asm volatile("" ::: "memory");
    int drow0 = n0; if (ffn_in) drow0 = n0 < DFF ? 256 * (n0 / 128) + (n0 % 128) : 256 * ((n0 - DFF) / 128) + 128 + ((n0 - DFF) % 128);
    const int c = lane & 7;
#pragma unroll
    for (int j = 0; j < 4; ++j) { const int n = (lane >> 3) + 8 * j; const LAS float* s = scr + (8 * c) * 33 + n;
        u32x4 o; o.x = pk2(s[0 * 33], s[1 * 33]); o.y = pk2(s[2 * 33], s[3 * 33]); o.z = pk2(s[4 * 33], s[5 * 33]); o.w = pk2(s[6 * 33], s[7 * 33]);
        *(u32x4*)(WT + (size_t)(drow0 + n) * K + k0 + 8 * c) = o; }
    LDS_WAIT(); asm volatile("" ::: "memory");
}
__device__ __forceinline__ void ph_conv(Frame& F, int l) {
    PHASE_IDS();
    LAS float* scr = (LAS float*)(F.lds + F.wave * 16384);
    const int gw = F.vcu * NWAVES + F.wave, NGW = F.G * NWAVES;
    constexpr int I_FIN = (DM / 64) * (2 * DFF / 32), I_FOUT = (DFF / 64) * (DM / 32), I_MI = (DM / 64) * (DPROJ / 32), I_SQ = (DM / 64) * (DM / 32), I_KV = (DM / 64) * (2 * DM / 32);
    constexpr int I_L64 = (64 / 64) * (RW / 32), I_L128 = (128 / 64) * (RW / 32);
    constexpr int NITEMS = 2 * I_FIN + 2 * I_FOUT + I_MI + 3 * I_SQ + I_KV + 2 * I_L64 + I_L128;
    unsigned char* wb = F.ws + WS_W;
    for (int it = gw; it < NITEMS; it += NGW) { int r = it;
        if (r < I_FIN) { conv_item(FIN(I_F1IN) + (size_t)l * DM * 2 * DFF, DM, 2 * DFF, FIN(I_F1G) + l * DM, (bf16*)(wb + W_F1IN), r, true, scr, F.lane); continue; } r -= I_FIN;
        if (r < I_FIN) { conv_item(FIN(I_F2IN) + (size_t)l * DM * 2 * DFF, DM, 2 * DFF, FIN(I_F2G) + l * DM, (bf16*)(wb + W_F2IN), r, true, scr, F.lane); continue; } r -= I_FIN;
        if (r < I_FOUT) { conv_item(FIN(I_F1OUT) + (size_t)l * DFF * DM, DFF, DM, nullptr, (bf16*)(wb + W_F1OUT), r, false, scr, F.lane); continue; } r -= I_FOUT;
        if (r < I_FOUT) { conv_item(FIN(I_F2OUT) + (size_t)l * DFF * DM, DFF, DM, nullptr, (bf16*)(wb + W_F2OUT), r, false, scr, F.lane); continue; } r -= I_FOUT;
        if (r < I_MI) { conv_item(FIN(I_MIXIN) + (size_t)l * DM * DPROJ, DM, DPROJ, FIN(I_MIXG) + l * DM, (bf16*)(wb + W_MIXIN), r, false, scr, F.lane); continue; } r -= I_MI;
        if (r < I_SQ) { conv_item(FIN(I_MIXOUT) + (size_t)l * DM * DM, DM, DM, nullptr, (bf16*)(wb + W_MIXOUT), r, false, scr, F.lane); continue; } r -= I_SQ;
        if (r < I_SQ) { conv_item(FIN(I_WQ) + (size_t)l * DM * DM, DM, DM, FIN(I_XG) + l * DM, (bf16*)(wb + W_WQ), r, false, scr, F.lane); continue; } r -= I_SQ;
        if (r < I_SQ) { conv_item(FIN(I_WO) + (size_t)l * DM * DM, DM, DM, nullptr, (bf16*)(wb + W_WO), r, false, scr, F.lane); continue; } r -= I_SQ;
        if (r < I_KV) { conv_item(FIN(I_WKV) + (size_t)l * DM * 2 * DM, DM, 2 * DM, FIN(I_MEMG) + l * DM, (bf16*)(wb + W_WKV), r, false, scr, F.lane); continue; } r -= I_KV;
        if (r < I_L64) { conv_item(FIN(I_WUP) + (size_t)l * 64 * RW, 64, RW, nullptr, (bf16*)(wb + W_WUPT), r, false, scr, F.lane); continue; } r -= I_L64;
        if (r < I_L64) { conv_item(FIN(I_AUP) + (size_t)l * 64 * RW, 64, RW, nullptr, (bf16*)(wb + W_AUPT), r, false, scr, F.lane); continue; } r -= I_L64;
        conv_item(FIN(I_GUP) + (size_t)l * 128 * RW, 128, RW, nullptr, (bf16*)(wb + W_GUPT), r, false, scr, F.lane);
    }
}

__device__ __forceinline__ void ph_moba(Frame& F) {
    PHASE_IDS();
    constexpr int KROW = 144, KBUF = 64 * KROW, OFF_K = 12288, OFF_V = OFF_K + 2 * KBUF;
    LAS float* kmean = (LAS float*)F.lds;
    LAS float* btab = (LAS float*)(F.lds + 2048);
    volatile LAS unsigned* needw = (volatile LAS unsigned*)(F.lds + 10240);
    const bf16* MQ = WSP(bf16, AR_MQ); const bf16* MK = WSP(bf16, AR_MK); const bf16* MVT = WSP(bf16, AR_MVT); bf16* XB = WSP(bf16, WS_XB); const float* bias = WSP(float, WS_BIAS);
    const int lane = F.lane, r32 = lane & 31, hi = lane >> 5, wave = F.wave, tid = F.tid;
    for (int u = blockIdx.x; u < 512; u += F.G) {
        const int rnd = u >> 8, iu = u & 255, qsel = iu >> 6, bh = iu & 63, qb = rnd == 0 ? 7 - qsel : qsel, b = bh >> 3, hh = bh & 7;
        __syncthreads();
        { const int n = tid >> 6, d = tid & 63;
          if (n < qb) { const float* kp = WSP(float, WS_KMS) + ((size_t)(b * 8 + n) * 2) * 512 + hh * 64 + d; kmean[n * 64 + d] = (kp[0] + kp[512]) * (1.0f / 256.0f); }
          for (int i2 = tid; i2 < 2048; i2 += 512) btab[i2] = bias[hh * 2048 + i2];
          if (tid == 0) needw[0] = 0u; }
        __syncthreads();
        const int q0 = qb * 256 + wave * 32; const size_t tok = (size_t)b * 2048 + q0 + r32;
        bf16x8 qf[4];
#pragma unroll
        for (int s = 0; s < 4; ++s) qf[s] = *(const bf16x8*)(MQ + tok * 512 + hh * 64 + 16 * s + 8 * hi);
        float g[7]; unsigned selmask = 0u;
#pragma unroll
        for (int n = 0; n < 7; ++n) { g[n] = -INFINITY;
            if (n < qb) { float p = 0.f;
#pragma unroll
                for (int s = 0; s < 4; ++s) { const f32x4 k0v = *(const LAS f32x4*)(kmean + n * 64 + 16 * s + 8 * hi), k1v = *(const LAS f32x4*)(kmean + n * 64 + 16 * s + 8 * hi + 4);
                    p += bf2f((unsigned short)qf[s][0]) * k0v[0] + bf2f((unsigned short)qf[s][1]) * k0v[1] + bf2f((unsigned short)qf[s][2]) * k0v[2] + bf2f((unsigned short)qf[s][3]) * k0v[3]
                       + bf2f((unsigned short)qf[s][4]) * k1v[0] + bf2f((unsigned short)qf[s][5]) * k1v[1] + bf2f((unsigned short)qf[s][6]) * k1v[2] + bf2f((unsigned short)qf[s][7]) * k1v[3]; }
                p += __shfl_xor(p, 32); g[n] = p; } }
        if (qb <= 3) selmask = (1u << qb) - 1u;
        else {
#pragma unroll
            for (int n = 0; n < 7; ++n) if (n < qb) { int cnt = 0;
#pragma unroll
                for (int n2 = 0; n2 < 7; ++n2) if (n2 != n && n2 < qb) cnt += (g[n2] > g[n] || (g[n2] == g[n] && n2 < n)) ? 1 : 0;
                if (cnt < 3) selmask |= 1u << n; } }
        unsigned wmask = 0u;
#pragma unroll
        for (int n = 0; n < 7; ++n) if (__ballot((selmask >> n) & 1u) != 0ull) wmask |= 1u << n;
        if (lane == 0 && wmask) __hip_atomic_fetch_or((LAS unsigned*)needw, wmask, __ATOMIC_RELAXED, __HIP_MEMORY_SCOPE_WORKGROUP);
        __syncthreads();
        const unsigned need = needw[0] | (1u << qb);
        float mrun = -INFINITY, lrun = 0.f; f32x16 o0, o1;
#pragma unroll
        for (int i = 0; i < 16; ++i) { o0[i] = 0.f; o1[i] = 0.f; }
        const int qpos = q0 + r32;
        const bf16* Kg = MK + ((size_t)b * 2048 + (tid >> 3)) * 512 + hh * 64 + (tid & 7) * 8;
        const bf16* Vg = MVT + ((size_t)(b * 8 + hh) * 64 + (tid >> 3)) * 2048 + (tid & 7) * 8;
        const int sto = (tid >> 3) * KROW + (tid & 7) * 16;
        int blk = 0; while (!((need >> blk) & 1u)) ++blk;
        int kt = 0, it = 0;
        { const int k0 = blk * 256; const u32x4 kr = *(const u32x4*)(Kg + (size_t)k0 * 512), vr = *(const u32x4*)(Vg + k0);
          *(LAS u32x4*)(F.lds + OFF_K + sto) = kr; *(LAS u32x4*)(F.lds + OFF_V + sto) = vr; }
        __syncthreads();
        while (blk <= qb) {
            int nblk = blk, nkt = kt + 1; if (nkt == 4) { nkt = 0; ++nblk; while (nblk <= qb && !((need >> nblk) & 1u)) ++nblk; }
            const bool more = nblk <= qb; u32x4 kr, vr;
            if (more) { const int k0n = nblk * 256 + nkt * 64; kr = *(const u32x4*)(Kg + (size_t)k0n * 512); vr = *(const u32x4*)(Vg + k0n); }
            const int k0 = blk * 256 + kt * 64; const bool own = blk == qb; const bool selme = own || ((selmask >> blk) & 1u);
            const bool active = own ? (k0 <= q0 + 31) : (__ballot(selme) != 0ull);
            if (active) {
                const LAS unsigned char* kb = F.lds + OFF_K + (it & 1) * KBUF + r32 * KROW + 16 * hi;
                const LAS unsigned char* vb = F.lds + OFF_V + (it & 1) * KBUF + r32 * KROW + 16 * hi;
                const bool h1 = !own || (k0 + 32 <= q0 + 31);
                f32x16 s0, s1;
#pragma unroll
                for (int i = 0; i < 16; ++i) { s0[i] = 0.f; s1[i] = 0.f; }
                bf16x8 kf[8];
#pragma unroll
                for (int s = 0; s < 4; ++s) { kf[s] = *(const LAS bf16x8*)(kb + 32 * s); kf[4 + s] = *(const LAS bf16x8*)(kb + 32 * KROW + 32 * s); }
#pragma unroll
                for (int s = 0; s < 4; ++s) s0 = __builtin_amdgcn_mfma_f32_32x32x16_bf16(kf[s], qf[s], s0, 0, 0, 0);
                if (h1) {
#pragma unroll
                    for (int s = 0; s < 4; ++s) s1 = __builtin_amdgcn_mfma_f32_32x32x16_bf16(kf[4 + s], qf[s], s1, 0, 0, 0); }
                bf16x8 vf[8];
#pragma unroll
                for (int s = 0; s < 4; ++s) { vf[s] = *(const LAS bf16x8*)(vb + 32 * s); vf[4 + s] = *(const LAS bf16x8*)(vb + 32 * KROW + 32 * s); }
                float mx = -INFINITY;
                float bv0[16], bv1[16];
#pragma unroll
                for (int r = 0; r < 16; ++r) { const int d0 = qpos - (k0 + crow(r, hi)), d1 = d0 - 32; bv0[r] = btab[d0 < 0 ? 0 : d0]; bv1[r] = btab[d1 < 0 ? 0 : d1]; }
#pragma unroll
                for (int r = 0; r < 16; ++r) asm volatile("" : "+v"(bv0[r]), "+v"(bv1[r]));
#pragma unroll
                for (int r = 0; r < 16; ++r) { const int d0 = qpos - (k0 + crow(r, hi)), d1 = d0 - 32;
                    const bool v0 = selme && (!own || d0 >= 0), v1 = h1 && selme && (!own || d1 >= 0);
                    const float a0 = v0 ? s0[r] + bv0[r] : -INFINITY, a1 = v1 ? s1[r] + bv1[r] : -INFINITY;
                    s0[r] = a0; s1[r] = a1; mx = fmaxf(mx, fmaxf(a0, a1)); }
                mx = fmaxf(mx, __shfl_xor(mx, 32));
                const float mnew = fmaxf(mrun, mx), muse = (mnew == -INFINITY) ? 0.f : mnew;
                const float alpha = __builtin_amdgcn_exp2f(mrun - muse);
                float ps = 0.f;
#pragma unroll
                for (int r = 0; r < 16; ++r) { const float p0 = __builtin_amdgcn_exp2f(s0[r] - muse), p1 = __builtin_amdgcn_exp2f(s1[r] - muse); s0[r] = p0; s1[r] = p1; ps += p0 + p1; }
                lrun = lrun * alpha + ps; mrun = mnew;
#pragma unroll
                for (int i = 0; i < 16; ++i) { o0[i] *= alpha; o1[i] *= alpha; }
                const bf16x8 pa0 = pack_bf16x8(s0[0], s0[1], s0[2], s0[3], s0[4], s0[5], s0[6], s0[7]), pa1 = pack_bf16x8(s0[8], s0[9], s0[10], s0[11], s0[12], s0[13], s0[14], s0[15]);
                o0 = __builtin_amdgcn_mfma_f32_32x32x16_bf16(vf[0], pa0, o0, 0, 0, 0); o0 = __builtin_amdgcn_mfma_f32_32x32x16_bf16(vf[1], pa1, o0, 0, 0, 0);
                o1 = __builtin_amdgcn_mfma_f32_32x32x16_bf16(vf[4], pa0, o1, 0, 0, 0); o1 = __builtin_amdgcn_mfma_f32_32x32x16_bf16(vf[5], pa1, o1, 0, 0, 0);
                if (h1) {
                    const bf16x8 pb0 = pack_bf16x8(s1[0], s1[1], s1[2], s1[3], s1[4], s1[5], s1[6], s1[7]), pb1 = pack_bf16x8(s1[8], s1[9], s1[10], s1[11], s1[12], s1[13], s1[14], s1[15]);
                    o0 = __builtin_amdgcn_mfma_f32_32x32x16_bf16(vf[2], pb0, o0, 0, 0, 0); o0 = __builtin_amdgcn_mfma_f32_32x32x16_bf16(vf[3], pb1, o0, 0, 0, 0);
                    o1 = __builtin_amdgcn_mfma_f32_32x32x16_bf16(vf[6], pb0, o1, 0, 0, 0); o1 = __builtin_amdgcn_mfma_f32_32x32x16_bf16(vf[7], pb1, o1, 0, 0, 0); }
            }
            if (more) { *(LAS u32x4*)(F.lds + OFF_K + ((it + 1) & 1) * KBUF + sto) = kr; *(LAS u32x4*)(F.lds + OFF_V + ((it + 1) & 1) * KBUF + sto) = vr; }
            __syncthreads();
            blk = nblk; kt = nkt; ++it;
        }
        lrun += __shfl_xor(lrun, 32); const float inv = 1.0f / lrun;
        bf16* op = XB + tok * 1024 + 512 + hh * 64 + 4 * hi;
#pragma unroll
        for (int g4 = 0; g4 < 4; ++g4) { u32x2 w0, w1; w0.x = pk2(o0[4 * g4] * inv, o0[4 * g4 + 1] * inv); w0.y = pk2(o0[4 * g4 + 2] * inv, o0[4 * g4 + 3] * inv);
            w1.x = pk2(o1[4 * g4] * inv, o1[4 * g4 + 1] * inv); w1.y = pk2(o1[4 * g4 + 2] * inv, o1[4 * g4 + 3] * inv);
            *(u32x2*)(op + 8 * g4) = w0; *(u32x2*)(op + 32 + 8 * g4) = w1; }
    }
}

__device__ __forceinline__ void ph_xatt(Frame& F) {
    PHASE_IDS();
    constexpr int KROW = 528, KBUF = 32 * KROW, VROW = 80, VBUF = 256 * VROW, OFF_K = 0, OFF_V = 2 * KBUF;
    const bf16* XQ = WSP(bf16, AR_XQ); const bf16* XK = WSP(bf16, WS_XK); const bf16* XVT = WSP(bf16, WS_XVT); bf16* XO = WSP(bf16, AR_XO);
    const int lane = F.lane, r32 = lane & 31, hi = lane >> 5, wave = F.wave, tid = F.tid;
    for (int u = blockIdx.x; u < 256; u += F.G) {
        const int b = u >> 5, hx = (u >> 3) & 3, qt = u & 7;
        const size_t tok = (size_t)b * 2048 + qt * 256 + wave * 32 + r32;
        const bf16* Qg = XQ + tok * 1024 + hx * 256 + 8 * hi;
        const bf16* Kg = XK + (size_t)(b * 256 + (tid >> 5)) * 1024 + hx * 256 + (tid & 31) * 8;
        const bf16* Vg = XVT + ((size_t)(b * 4 + hx) * 256 + (tid >> 2)) * 256 + (tid & 3) * 8;
        const int ksto = (tid >> 5) * KROW + (tid & 31) * 16, vsto = (tid >> 2) * VROW + (tid & 3) * 16;
        float mrun = -INFINITY, lrun = 0.f; f32x16 o[8];
#pragma unroll
        for (int dt = 0; dt < 8; ++dt)
#pragma unroll
            for (int i = 0; i < 16; ++i) o[dt][i] = 0.f;
        __syncthreads();
        { const u32x4 k0r = *(const u32x4*)(Kg), k1r = *(const u32x4*)(Kg + (size_t)16 * 1024), v0r = *(const u32x4*)(Vg), v1r = *(const u32x4*)(Vg + (size_t)128 * 256);
          *(LAS u32x4*)(F.lds + OFF_K + ksto) = k0r; *(LAS u32x4*)(F.lds + OFF_K + ksto + 16 * KROW) = k1r; *(LAS u32x4*)(F.lds + OFF_V + vsto) = v0r; *(LAS u32x4*)(F.lds + OFF_V + vsto + 128 * VROW) = v1r; }
        __syncthreads();
        for (int kt = 0; kt < 8; ++kt) {
            const bool more = kt + 1 < 8; const int k0n = (kt + 1) * 32; u32x4 s0r, s1r;
            if (more) { s0r = *(const u32x4*)(Kg + (size_t)k0n * 1024); s1r = *(const u32x4*)(Kg + (size_t)(k0n + 16) * 1024); }
            const LAS unsigned char* kb = F.lds + OFF_K + (kt & 1) * KBUF + r32 * KROW + 16 * hi;
            const LAS unsigned char* vb = F.lds + OFF_V + (kt & 1) * VBUF + r32 * VROW + 16 * hi;
            f32x16 sc;
#pragma unroll
            for (int i = 0; i < 16; ++i) sc[i] = 0.f;
            bf16x8 qa[4], qb[4];
#pragma unroll
            for (int s = 0; s < 4; ++s) qa[s] = *(const bf16x8*)(Qg + 16 * s);
#pragma unroll
            for (int s = 0; s < 4; ++s) qb[s] = *(const bf16x8*)(Qg + 64 + 16 * s);
#pragma unroll
            for (int s = 0; s < 4; ++s) sc = __builtin_amdgcn_mfma_f32_32x32x16_bf16(*(const LAS bf16x8*)(kb + 32 * s), qa[s], sc, 0, 0, 0);
            asm volatile("" ::: "memory");
#pragma unroll
            for (int s = 0; s < 4; ++s) qa[s] = *(const bf16x8*)(Qg + 128 + 16 * s);
#pragma unroll
            for (int s = 0; s < 4; ++s) sc = __builtin_amdgcn_mfma_f32_32x32x16_bf16(*(const LAS bf16x8*)(kb + 128 + 32 * s), qb[s], sc, 0, 0, 0);
            asm volatile("" ::: "memory");
#pragma unroll
            for (int s = 0; s < 4; ++s) qb[s] = *(const bf16x8*)(Qg + 192 + 16 * s);
#pragma unroll
            for (int s = 0; s < 4; ++s) sc = __builtin_amdgcn_mfma_f32_32x32x16_bf16(*(const LAS bf16x8*)(kb + 256 + 32 * s), qa[s], sc, 0, 0, 0);
            asm volatile("" ::: "memory");
#pragma unroll
            for (int s = 0; s < 4; ++s) sc = __builtin_amdgcn_mfma_f32_32x32x16_bf16(*(const LAS bf16x8*)(kb + 384 + 32 * s), qb[s], sc, 0, 0, 0);
            if (more) { LAS unsigned char* kd = F.lds + OFF_K + ((kt + 1) & 1) * KBUF + ksto; *(LAS u32x4*)(kd) = s0r; *(LAS u32x4*)(kd + 16 * KROW) = s1r;
                s0r = *(const u32x4*)(Vg + k0n); s1r = *(const u32x4*)(Vg + (size_t)128 * 256 + k0n); }
            float mx = sc[0];
#pragma unroll
            for (int r = 1; r < 16; ++r) mx = fmaxf(mx, sc[r]);
            mx = fmaxf(mx, __shfl_xor(mx, 32));
            const float mnew = fmaxf(mrun, mx), alpha = __builtin_amdgcn_exp2f(mrun - mnew);
            float ps = 0.f;
#pragma unroll
            for (int r = 0; r < 16; ++r) { const float p = __builtin_amdgcn_exp2f(sc[r] - mnew); sc[r] = p; ps += p; }
            lrun = lrun * alpha + ps; mrun = mnew;
            const bf16x8 pf0 = pack_bf16x8(sc[0], sc[1], sc[2], sc[3], sc[4], sc[5], sc[6], sc[7]), pf1 = pack_bf16x8(sc[8], sc[9], sc[10], sc[11], sc[12], sc[13], sc[14], sc[15]);
#pragma unroll
            for (int dt = 0; dt < 8; ++dt) {
#pragma unroll
                for (int i = 0; i < 16; ++i) o[dt][i] *= alpha;
                o[dt] = __builtin_amdgcn_mfma_f32_32x32x16_bf16(*(const LAS bf16x8*)(vb + dt * 32 * VROW), pf0, o[dt], 0, 0, 0);
                o[dt] = __builtin_amdgcn_mfma_f32_32x32x16_bf16(*(const LAS bf16x8*)(vb + dt * 32 * VROW + 32), pf1, o[dt], 0, 0, 0); }
            if (more) { LAS unsigned char* vd = F.lds + OFF_V + ((kt + 1) & 1) * VBUF + vsto; *(LAS u32x4*)(vd) = s0r; *(LAS u32x4*)(vd + 128 * VROW) = s1r; }
            __syncthreads();
        }
        lrun += __shfl_xor(lrun, 32); const float inv = 1.0f / lrun;
        bf16* op = XO + tok * 1024 + hx * 256 + 4 * hi;
#pragma unroll
        for (int dt = 0; dt < 8; ++dt)
#pragma unroll
            for (int g4 = 0; g4 < 4; ++g4) { u32x2 w; w.x = pk2(o[dt][4 * g4] * inv, o[dt][4 * g4 + 1] * inv); w.y = pk2(o[dt][4 * g4 + 2] * inv, o[dt][4 * g4 + 3] * inv);
                *(u32x2*)(op + 32 * dt + 8 * g4) = w; }
    }
}

__device__ __forceinline__ void ph_prep(Frame& F, int l) {
    PHASE_IDS();
    constexpr int SROW = 3080, OFF_LAT = 33 * SROW + 8, LROW = 528, OFF_PAR = OFF_LAT + 32 * LROW;
    static_assert(OFF_LAT % 16 == 0 && OFF_PAR % 16 == 0 && OFF_PAR + 8 * 512 * 4 <= PHASE_LDS, "prep LDS map");
    LAS unsigned char* rows = F.lds; LAS unsigned char* lat = F.lds + OFF_LAT; LAS float* par = (LAS float*)(F.lds + OFF_PAR);
    const bf16* PR = WSP(bf16, AR_PR); bf16* SCANIN = WSP(bf16, AR_SCANIN); bf16* SV = WSP(bf16, AR_SV); bf16* XB = WSP(bf16, WS_XB); float* BONUS = WSP(float, WS_BONUS);
    const bf16* WUPT = (const bf16*)(F.ws + WS_W + W_WUPT); const bf16* AUPT = (const bf16*)(F.ws + WS_W + W_AUPT); const bf16* GUPT = (const bf16*)(F.ws + WS_W + W_GUPT);
    const int h = F.wave, lane = F.lane, r32 = lane & 31, hi = lane >> 5, tid = F.tid;
    const float* mu = FIN(I_MU) + l * RPROJ;
    __syncthreads();
    { const int c = tid;
      par[c] = mu[c]; par[512 + c] = mu[512 + c]; par[1024 + c] = mu[1024 + c]; par[1536 + c] = FIN(I_W0)[l * RW + c]; par[2048 + c] = FIN(I_A0)[l * RW + c];
      par[2560 + c] = FIN(I_KK)[l * RW + c]; par[3072 + c] = FIN(I_KA)[l * RW + c]; par[3584 + c] = FIN(I_RK)[l * RW + c]; }
    for (int task = blockIdx.x; task < M / 32; task += F.G) { const int t0 = task * 32;
        __syncthreads();
        {
          u32x4 st[13];
#pragma unroll
          for (int i = 0; i < 13; ++i) { const int q = tid + 512 * i; st[i] = (u32x4){0u, 0u, 0u, 0u};
              if (q < 33 * 192) { const int row = q / 192, c16 = q - row * 192; if (row > 0 || (t0 & 2047) != 0) st[i] = *(const u32x4*)(PR + (size_t)(t0 - 1 + row) * RPROJ + c16 * 8); } }
#pragma unroll
          for (int i = 0; i < 13; ++i) { const int q = tid + 512 * i;
              if (q < 33 * 192) { const int row = q / 192, c16 = q - row * 192; LAS unsigned char* d = rows + row * SROW + c16 * 16; *(LAS u32x2*)d = (u32x2){st[i].x, st[i].y}; *(LAS u32x2*)(d + 8) = (u32x2){st[i].z, st[i].w}; } } }
        {
          const int tt = tid >> 4, l16 = (tid & 15) * 16, t = t0 + tt; const bf16* pc = PR + (size_t)t * RPROJ + 1536 + l16;
          u32x4 cur[2], prv[2]; cur[0] = *(const u32x4*)pc; cur[1] = *(const u32x4*)(pc + 8); prv[0] = (u32x4){0u, 0u, 0u, 0u}; prv[1] = prv[0];
          if (t & 2047) { prv[0] = *(const u32x4*)(pc - RPROJ); prv[1] = *(const u32x4*)(pc - RPROJ + 8); }
          u32x4 ow[2];
#pragma unroll
          for (int hh = 0; hh < 2; ++hh) { const f32x4 m0 = *(const f32x4*)(mu + 1536 + l16 + 8 * hh), m1 = *(const f32x4*)(mu + 1536 + l16 + 8 * hh + 4); float xv[8];
#pragma unroll
              for (int i = 0; i < 4; ++i) { const unsigned cw = cur[hh][i], pw = prv[hh][i]; const float p0 = bf2f(cw & 0xffffu), p1 = bf2f(cw >> 16), q0 = bf2f(pw & 0xffffu), q1 = bf2f(pw >> 16);
                  const float ma = i < 2 ? m0[2 * i] : m1[2 * i - 4], mb = i < 2 ? m0[2 * i + 1] : m1[2 * i - 3];
                  xv[2 * i] = p0 + (q0 - p0) * ma; xv[2 * i + 1] = p1 + (q1 - p1) * mb; }
#pragma unroll
              for (int i = 0; i < 8; ++i) { if (l16 < 64) xv[i] = 1.0f - 2.0f * __builtin_amdgcn_rcpf(1.0f + __expf(2.0f * xv[i])); else if (l16 >= 128) xv[i] = sigmoidf_(xv[i]); }
              ow[hh] = (u32x4){pk2(xv[0], xv[1]), pk2(xv[2], xv[3]), pk2(xv[4], xv[5]), pk2(xv[6], xv[7])}; }
          *(LAS u32x4*)(lat + tt * LROW + l16 * 2) = ow[0]; *(LAS u32x4*)(lat + tt * LROW + l16 * 2 + 16) = ow[1]; }
        __syncthreads();
        const int t = t0 + r32, bb = t >> 11, tp = t & 2047, bh = bb * 8 + h;
        const LAS unsigned char* rc = rows + (r32 + 1) * SROW; const LAS unsigned char* rp = rows + r32 * SROW;
        float n2 = 0.f, bon = 0.f;
#pragma unroll
        for (int q = 0; q < 8; ++q) { const int c4 = h * 64 + 8 * q + 4 * hi;
            const u32x2 kc = *(const LAS u32x2*)(rc + (512 + c4) * 2), kp = *(const LAS u32x2*)(rp + (512 + c4) * 2);
            const f32x4 mk = *(const LAS f32x4*)(par + 512 + c4), kkc = *(const LAS f32x4*)(par + 2560 + c4);
#pragma unroll
            for (int i = 0; i < 4; ++i) { const unsigned sh = (i & 1) * 16; float k = bf2f((kc[i >> 1] >> sh) & 0xffffu); const float kq = bf2f((kp[i >> 1] >> sh) & 0xffffu);
                k += (kq - k) * mk[i]; const float kk = k * kkc[i]; n2 += kk * kk; } }
        n2 += __shfl_xor(n2, 32);
        const float inv = 1.0f / fmaxf(sqrtf(n2), 1e-12f);
        bf16* so = SCANIN + ((size_t)(bh * 64 + (tp >> 5)) * 10) * 1024 + lane * 16;
#pragma unroll 1
        for (int ct = 0; ct < 2; ++ct) { const int cb = h * 64 + 32 * ct;
            f32x16 aw, aa, ag;
#pragma unroll
            for (int i = 0; i < 16; ++i) { aw[i] = 0.f; aa[i] = 0.f; ag[i] = 0.f; }
            const LAS unsigned char* lb = lat + r32 * LROW + 16 * hi;
#pragma unroll
            for (int s = 0; s < 4; ++s) { const bf16x8 wf = *(const bf16x8*)(WUPT + (size_t)(cb + r32) * 64 + 16 * s + 8 * hi), af = *(const bf16x8*)(AUPT + (size_t)(cb + r32) * 64 + 16 * s + 8 * hi);
                const bf16x8 lw = *(const LAS bf16x8*)(lb + 32 * s), la = *(const LAS bf16x8*)(lb + 128 + 32 * s);
                aw = __builtin_amdgcn_mfma_f32_32x32x16_bf16(wf, lw, aw, 0, 0, 0); aa = __builtin_amdgcn_mfma_f32_32x32x16_bf16(af, la, aa, 0, 0, 0); }
#pragma unroll
            for (int s = 0; s < 8; ++s) { const bf16x8 gf = *(const bf16x8*)(GUPT + (size_t)(cb + r32) * 128 + 16 * s + 8 * hi); const bf16x8 lg = *(const LAS bf16x8*)(lb + 256 + 32 * s);
                ag = __builtin_amdgcn_mfma_f32_32x32x16_bf16(gf, lg, ag, 0, 0, 0); }
            unsigned onk[8], old_[8], obv[8], okt[8], orr[8];
#pragma unroll
            for (int g = 0; g < 4; ++g) { const int c4 = cb + 8 * g + 4 * hi;
                const u32x2 rcv = *(const LAS u32x2*)(rc + c4 * 2), kcv = *(const LAS u32x2*)(rc + (512 + c4) * 2), vcv = *(const LAS u32x2*)(rc + (1024 + c4) * 2);
                const u32x2 rpv = *(const LAS u32x2*)(rp + c4 * 2), kpv = *(const LAS u32x2*)(rp + (512 + c4) * 2), vpv = *(const LAS u32x2*)(rp + (1024 + c4) * 2);
                const f32x4 mr = *(const LAS f32x4*)(par + c4), mk = *(const LAS f32x4*)(par + 512 + c4), mv = *(const LAS f32x4*)(par + 1024 + c4);
                const f32x4 w0v = *(const LAS f32x4*)(par + 1536 + c4), a0v = *(const LAS f32x4*)(par + 2048 + c4), kkc = *(const LAS f32x4*)(par + 2560 + c4), kac = *(const LAS f32x4*)(par + 3072 + c4), rkc = *(const LAS f32x4*)(par + 3584 + c4);
                float ro[4], ko[4], vo[4], ldo[4], go[4], nk[4], bo[4];
#pragma unroll
                for (int i = 0; i < 4; ++i) { const unsigned sh = (i & 1) * 16;
                    float r = bf2f((rcv[i >> 1] >> sh) & 0xffffu), k = bf2f((kcv[i >> 1] >> sh) & 0xffffu), v = bf2f((vcv[i >> 1] >> sh) & 0xffffu);
                    const float rq = bf2f((rpv[i >> 1] >> sh) & 0xffffu), kq = bf2f((kpv[i >> 1] >> sh) & 0xffffu), vq = bf2f((vpv[i >> 1] >> sh) & 0xffffu);
                    r += (rq - r) * mr[i]; k += (kq - k) * mk[i]; v += (vq - v) * mv[i];
                    const float wv = w0v[i] + aw[4 * g + i], xs = -wv, sp = xs > 20.f ? xs : __logf(1.0f + __expf(xs)), ld = -__expf(-sp - 0.5f);
                    const float a = sigmoidf_(a0v[i] + aa[4 * g + i]);
                    const float kn = k * kkc[i] * inv, kt = k * (1.0f + (a - 1.0f) * kac[i]);
                    bon += r * kt * rkc[i];
                    ro[i] = r; ko[i] = kt; vo[i] = v; ldo[i] = ld; go[i] = ag[4 * g + i]; nk[i] = -kn; bo[i] = kn * a; }
                onk[2 * g] = pk2(nk[0], nk[1]); onk[2 * g + 1] = pk2(nk[2], nk[3]); old_[2 * g] = pk2(ldo[0], ldo[1]); old_[2 * g + 1] = pk2(ldo[2], ldo[3]);
                obv[2 * g] = pk2(bo[0], bo[1]); obv[2 * g + 1] = pk2(bo[2], bo[3]); okt[2 * g] = pk2(ko[0], ko[1]); okt[2 * g + 1] = pk2(ko[2], ko[3]);
                orr[2 * g] = pk2(ro[0], ro[1]); orr[2 * g + 1] = pk2(ro[2], ro[3]);
                *(u32x2*)(SV + ((size_t)bh * 2048 + tp) * 64 + 32 * ct + 8 * g + 4 * hi) = (u32x2){pk2(vo[0], vo[1]), pk2(vo[2], vo[3])};
                *(u32x2*)(XB + (size_t)t * 1024 + c4) = (u32x2){pk2(go[0], go[1]), pk2(go[2], go[3])}; }
            bf16* sq = so + ct * 1024;
            *(u32x4*)(sq) = (u32x4){onk[0], onk[1], onk[2], onk[3]}; *(u32x4*)(sq + 8) = (u32x4){onk[4], onk[5], onk[6], onk[7]};
            *(u32x4*)(sq + 2048) = (u32x4){old_[0], old_[1], old_[2], old_[3]}; *(u32x4*)(sq + 2048 + 8) = (u32x4){old_[4], old_[5], old_[6], old_[7]};
            *(u32x4*)(sq + 4096) = (u32x4){obv[0], obv[1], obv[2], obv[3]}; *(u32x4*)(sq + 4096 + 8) = (u32x4){obv[4], obv[5], obv[6], obv[7]};
            *(u32x4*)(sq + 6144) = (u32x4){okt[0], okt[1], okt[2], okt[3]}; *(u32x4*)(sq + 6144 + 8) = (u32x4){okt[4], okt[5], okt[6], okt[7]};
            *(u32x4*)(sq + 8192) = (u32x4){orr[0], orr[1], orr[2], orr[3]}; *(u32x4*)(sq + 8192 + 8) = (u32x4){orr[4], orr[5], orr[6], orr[7]};
        }
        bon += __shfl_xor(bon, 32);
        if (hi == 0) BONUS[(size_t)t * 8 + h] = bon;
    }
}

template <int R, int NCH, bool KINDP>
__device__ __forceinline__ void scan_stream(Frame& F, LAS float* ring, int bh, int ch, int rg, int lis) {
    typedef float f32x2 __attribute__((ext_vector_type(2)));
    constexpr int CLEN = SEQ / NCH, NHALF = CLEN / 8;
    const int lane = F.lane, js = lane & 3, q = lane >> 2, row0 = rg * 16 * R + q * R, tbase = ch * CLEN;
    const bf16* src5 = WSP(bf16, AR_SCANIN) + (size_t)bh * 64 * 10 * 1024; const bf16* srcv = WSP(bf16, AR_SV) + (size_t)bh * 2048 * 64;
    float* YL = WSP(float, AR_YLOC) + ((size_t)bh * 2048 + tbase) * 64; bf16* ZZ = WSP(bf16, AR_Z) + ((size_t)bh * 2048 + tbase) * 64;
    int soff[2], doff[2]; bool isv[2], isld[2], cval[2];
#pragma unroll
    for (int k = 0; k < 2; ++k) { int ci = lis + k * 256; cval[k] = ci < 384; if (!cval[k]) ci = lis; isv[k] = ci >= 320;
        const int run = ci >> 4, vec = run >> 2, ct = (run >> 1) & 1, hi2 = run & 1, tok = (ci & 15) >> 1, hf16 = ci & 1, cv = ci - 320;
        isld[k] = !isv[k] && vec == 1;
        soff[k] = isv[k] ? (cv >> 3) * 64 + (cv & 7) * 8 : ((vec * 2 + ct) * 64 + hi2 * 32 + tok) * 16 + 8 * hf16;
        doff[k] = isv[k] ? (cv >> 3) * 384 + 320 + (cv & 7) * 8 : tok * 384 + vec * 64 + 32 * ct + 16 * hf16 + 4 * hi2; }
#define SCAN_LOAD(hfx) do { const int tg_ = tbase + (hfx) * 8; _Pragma("unroll") for (int k = 0; k < 2; ++k) {   \
        const bf16* p_ = isv[k] ? srcv + (size_t)tg_ * 64 + soff[k] : src5 + (size_t)(tg_ >> 5) * 10240 + (tg_ & 31) * 16 + soff[k]; pre[k] = *(const u32x4*)p_; } } while (0)
#define SCAN_WRITE(hfx) do { _Pragma("unroll") for (int k = 0; k < 2; ++k) if (cval[k]) { float f[8]; \
        _Pragma("unroll") for (int i = 0; i < 4; ++i) { f[2 * i] = bf2f(pre[k][i] & 0xffffu); f[2 * i + 1] = bf2f(pre[k][i] >> 16); } \
        if (isld[k]) { _Pragma("unroll") for (int i = 0; i < 8; ++i) f[i] = __expf(f[i]); } \
        LAS float* d_ = ring + (((hfx) & 1) * 8) * 384 + doff[k]; \
        *(LAS f32x4*)(d_) = (f32x4){f[0], f[1], f[2], f[3]}; *(LAS f32x4*)(d_ + (isv[k] ? 4 : 8)) = (f32x4){f[4], f[5], f[6], f[7]}; } } while (0)
    f32x2 S[R][8];
#pragma unroll
    for (int rr = 0; rr < R; ++rr)
#pragma unroll
        for (int k = 0; k < 8; ++k) { S[rr][k].x = (KINDP && (row0 + rr) == 16 * js + 2 * k) ? 1.f : 0.f; S[rr][k].y = (KINDP && (row0 + rr) == 16 * js + 2 * k + 1) ? 1.f : 0.f; }
    u32x4 pre[2];
    SCAN_LOAD(0); SCAN_WRITE(0);
    __syncthreads();
    for (int hf = 0; hf < NHALF; ++hf) {
        const bool more = hf + 1 < NHALF;
        if (more) SCAN_LOAD(hf + 1);
#pragma unroll 2
        for (int st = 0; st < 8; ++st) {
            const LAS float* sp = ring + ((hf & 1) * 8 + st) * 384 + 16 * js;
            f32x2 nn[8], ww[8], bb[8], kk[8], rr2[8];
#pragma unroll
            for (int i = 0; i < 4; ++i) { const f32x4 a = *(const LAS f32x4*)(sp + 4 * i); nn[2 * i] = (f32x2){a[0], a[1]}; nn[2 * i + 1] = (f32x2){a[2], a[3]}; }
#pragma unroll
            for (int i = 0; i < 4; ++i) { const f32x4 a = *(const LAS f32x4*)(sp + 64 + 4 * i); ww[2 * i] = (f32x2){a[0], a[1]}; ww[2 * i + 1] = (f32x2){a[2], a[3]}; }
#pragma unroll
            for (int i = 0; i < 4; ++i) { const f32x4 a = *(const LAS f32x4*)(sp + 128 + 4 * i); bb[2 * i] = (f32x2){a[0], a[1]}; bb[2 * i + 1] = (f32x2){a[2], a[3]}; }
            if (!KINDP) {
#pragma unroll
                for (int i = 0; i < 4; ++i) { const f32x4 a = *(const LAS f32x4*)(sp + 192 + 4 * i); kk[2 * i] = (f32x2){a[0], a[1]}; kk[2 * i + 1] = (f32x2){a[2], a[3]}; } }
#pragma unroll
            for (int i = 0; i < 4; ++i) { const f32x4 a = *(const LAS f32x4*)(sp + 256 + 4 * i); rr2[2 * i] = (f32x2){a[0], a[1]}; rr2[2 * i + 1] = (f32x2){a[2], a[3]}; }
            float vv[R];
            if (!KINDP) {
#pragma unroll
                for (int rr = 0; rr < R; ++rr) vv[rr] = ring[((hf & 1) * 8 + st) * 384 + 320 + row0 + rr]; }
            float sa[R];
#pragma unroll
            for (int rr = 0; rr < R; ++rr) { f32x2 p0 = S[rr][0] * nn[0], p1 = S[rr][1] * nn[1];
#pragma unroll
                for (int k = 2; k < 8; k += 2) { p0 = S[rr][k] * nn[k] + p0; p1 = S[rr][k + 1] * nn[k + 1] + p1; }
                p0 = p0 + p1; sa[rr] = quad_sum(p0.x + p0.y); }
            float y[R];
#pragma unroll
            for (int rr = 0; rr < R; ++rr) { const f32x2 sa2 = (f32x2){sa[rr], sa[rr]}; f32x2 p0 = (f32x2){0.f, 0.f}, p1 = (f32x2){0.f, 0.f};
#pragma unroll
                for (int k = 0; k < 8; k += 2) {
                    f32x2 t0 = S[rr][k] * ww[k], t1 = S[rr][k + 1] * ww[k + 1];
                    t0 = sa2 * bb[k] + t0; t1 = sa2 * bb[k + 1] + t1;
                    if (!KINDP) { const f32x2 v2 = (f32x2){vv[rr], vv[rr]}; t0 = v2 * kk[k] + t0; t1 = v2 * kk[k + 1] + t1; }
                    S[rr][k] = t0; S[rr][k + 1] = t1; p0 = t0 * rr2[k] + p0; p1 = t1 * rr2[k + 1] + p1; }
                p0 = p0 + p1; y[rr] = quad_sum(p0.x + p0.y); }
            if (js == 0) { const int t = hf * 8 + st;
                if (R == 2) { if (KINDP) *(unsigned*)(ZZ + (size_t)t * 64 + row0) = pk2(y[0], y[R - 1]); else *(f32x2*)(YL + (size_t)t * 64 + row0) = (f32x2){y[0], y[R - 1]}; }
                else {
#pragma unroll
                    for (int rr = 0; rr < R; ++rr) { if (KINDP) ZZ[(size_t)t * 64 + row0 + rr] = (bf16)f2bf(y[rr]); else YL[(size_t)t * 64 + row0 + rr] = y[rr]; } } }
        }
        if (more) SCAN_WRITE(hf + 1);
        __syncthreads();
    }
#undef SCAN_LOAD
#undef SCAN_WRITE
    if (NCH > 1) {
        float* st = WSP(float, AR_STATE) + ((size_t)(bh * NCH + ch) * 2 + (KINDP ? 0 : 1)) * 4096;
#pragma unroll
        for (int rr = 0; rr < R; ++rr)
#pragma unroll
            for (int i = 0; i < 4; ++i) *(f32x4*)(st + (size_t)(row0 + rr) * 64 + 16 * js + 4 * i) = (f32x4){S[rr][2 * i].x, S[rr][2 * i].y, S[rr][2 * i + 1].x, S[rr][2 * i + 1].y};
    }
}
template <int R, int NCH>
__device__ __forceinline__ void ph_scan(Frame& F) {
    PHASE_IDS();
    constexpr int KINDS = NCH > 1 ? 2 : 1, RG = 4 / R, WPS = KINDS * RG, SPW = NWAVES / WPS, NSTREAM = BATCH * NH * NCH;
    static_assert(WPS == 4, "staging assumes 4 waves per stream");
    const int sl = F.wave / WPS, role = F.wave % WPS, kind = (KINDS > 1) ? ((role / RG) ^ (sl & 1)) : 0, rg = role % RG, lis = role * 64 + F.lane;
    LAS float* ring = (LAS float*)F.lds + sl * (16 * 384);
    for (int it = blockIdx.x; it * SPW < NSTREAM; it += F.G) {
        const int sid = it * SPW + sl, bh = sid / NCH, ch = sid % NCH;
        __syncthreads();
        if (kind == 0) scan_stream<R, NCH, false>(F, ring, bh, ch, rg, lis); else scan_stream<R, NCH, true>(F, ring, bh, ch, rg, lis);
    }
}

template <int NCH>
__device__ __forceinline__ void ph_fix(Frame& F) {
    PHASE_IDS();
    typedef float f32x2 __attribute__((ext_vector_type(2)));
    LAS float* cur = (LAS float*)F.lds;
    for (int u = blockIdx.x; u < 256; u += F.G) { const int bh = u >> 2, rgx = u & 3, i = F.tid >> 5, j2 = (F.tid & 31) * 2, row = rgx * 16 + i;
        float* base = WSP(float, AR_STATE) + (size_t)bh * NCH * 2 * 4096;
        __syncthreads();
        { const f32x2 v = *(const f32x2*)(base + 4096 + row * 64 + j2); cur[i * 64 + j2] = v.x; cur[i * 64 + j2 + 1] = v.y; }
        __syncthreads();
        for (int c = 1; c < NCH - 1; ++c) { const float* P = base + (size_t)(c * 2) * 4096; float* SL = base + (size_t)(c * 2 + 1) * 4096;
            f32x2 acc = *(const f32x2*)(SL + row * 64 + j2);
#pragma unroll
            for (int ii = 0; ii < 64; ++ii) { const float sv = cur[i * 64 + ii]; const f32x2 p = *(const f32x2*)(P + ii * 64 + j2); acc.x += sv * p.x; acc.y += sv * p.y; }
            __syncthreads();
            cur[i * 64 + j2] = acc.x; cur[i * 64 + j2 + 1] = acc.y; *(f32x2*)(SL + row * 64 + j2) = acc;
            __syncthreads(); }
    }
}

template <int NCH>
__device__ __forceinline__ void ph_post(Frame& F, int l, bool dummy) {
    PHASE_IDS();
    constexpr int CLEN = SEQ / NCH;
    const float* YL = WSP(float, AR_YLOC); const bf16* SV = WSP(bf16, AR_SV); bf16* XB = WSP(bf16, WS_XB); const float* BONUS = WSP(float, WS_BONUS); const bf16* ZZ = WSP(bf16, AR_Z);
    LAS float* zt = (LAS float*)F.lds;
    const int c = F.tid, h = F.wave, j = F.lane; const float lng = FIN(I_LNG)[l * RW + c], lnb = FIN(I_LNB)[l * RW + c];
    for (int grp = blockIdx.x; grp < M / 64; grp += F.G) { const int t0g = grp * 64, bb = t0g >> 11, ch = (t0g & 2047) / CLEN, bh = bb * 8 + h; const bool corr = NCH > 1 && ch > 0;
        float st[64];
        if (corr) { const float* sp = WSP(float, AR_STATE) + ((size_t)(bh * NCH + ch - 1) * 2 + 1) * 4096 + j * 64;
#pragma unroll
            for (int i4 = 0; i4 < 16; ++i4) { const f32x4 v = *(const f32x4*)(sp + 4 * i4); st[4 * i4] = v[0]; st[4 * i4 + 1] = v[1]; st[4 * i4 + 2] = v[2]; st[4 * i4 + 3] = v[3]; } }
        for (int ti = 0; ti < 4; ++ti) { const int t0 = t0g + 16 * ti;
            if (corr) { __syncthreads();
#pragma unroll 4
                for (int tt = 0; tt < 16; ++tt) zt[tt * 512 + c] = bf2f(ZZ[((size_t)bh * 2048 + ((t0 + tt) & 2047)) * 64 + j]);
                __syncthreads(); }
#pragma unroll 1
            for (int tb = 0; tb < 16; tb += 8) {
                float yv[8], vv[8], bv[8], gv[8];
#pragma unroll
                for (int q = 0; q < 8; ++q) { const int t = t0 + tb + q, tp = t & 2047;
                    yv[q] = YL[((size_t)bh * 2048 + tp) * 64 + j]; vv[q] = bf2f(SV[((size_t)bh * 2048 + tp) * 64 + j]); bv[q] = BONUS[(size_t)t * 8 + h]; gv[q] = bf2f(XB[(size_t)t * 1024 + c]); }
                if (corr) {
#pragma unroll
                    for (int q = 0; q < 8; ++q) { const LAS float* zp = zt + (tb + q) * 512 + h * 64; float p0 = 0.f, p1 = 0.f, p2 = 0.f, p3 = 0.f;
#pragma unroll
                        for (int qq = 0; qq < 4; ++qq) { asm volatile("" ::: "memory");
                            f32x4 zz[4];
#pragma unroll
                            for (int e = 0; e < 4; ++e) zz[e] = *(const LAS f32x4*)(zp + 16 * qq + 4 * e);
#pragma unroll
                            for (int e = 0; e < 4; ++e) { const int j4 = 4 * qq + e; p0 += st[4 * j4] * zz[e][0]; p1 += st[4 * j4 + 1] * zz[e][1]; p2 += st[4 * j4 + 2] * zz[e][2]; p3 += st[4 * j4 + 3] * zz[e][3]; }
                            asm volatile("" : "+v"(p0), "+v"(p1), "+v"(p2), "+v"(p3)); }
                        yv[q] += (p0 + p1) + (p2 + p3); } }
                float mean[8], var[8];
#pragma unroll
                for (int q = 0; q < 8; ++q) mean[q] = yv[q];
                wave_sum8(mean);
#pragma unroll
                for (int q = 0; q < 8; ++q) { mean[q] *= (1.0f / 64.0f); yv[q] -= mean[q]; var[q] = yv[q] * yv[q]; }
                wave_sum8(var);
#pragma unroll
                for (int q = 0; q < 8; ++q) { const int t = t0 + tb + q;
                    const float yn = yv[q] * __builtin_amdgcn_rsqf(var[q] * (1.0f / 64.0f) + LNX_EPS) * lng + lnb;
                    if (dummy) WSP(bf16, WS_AR + 48 * MiB)[((size_t)t * 1024 + c) & 0x3fffff] = (bf16)f2bf((yn + bv[q] * vv[q]) * gv[q]);
                    else XB[(size_t)t * 1024 + c] = (bf16)f2bf((yn + bv[q] * vv[q]) * gv[q]); }
            }
        }
    }
}

__device__ __forceinline__ void ph_final(Frame& F) {
    PHASE_IDS();
    const int gw = F.vcu * NWAVES + F.wave, NGW = F.G * NWAVES; const float* ssq = WSP(float, WS_SSQ); const float* g = FIN(I_FING);
    f32x4 gv[4];
#pragma unroll
    for (int j = 0; j < 4; ++j) gv[j] = ((const f32x4*)g)[F.lane + 64 * j];
    for (int r = gw; r < M; r += NGW) { const float rs = pg8::row_rstd16(ssq, r); f32x4* xr = (f32x4*)(F.out + (size_t)r * DM) + F.lane;
#pragma unroll
        for (int j = 0; j < 4; ++j) { const f32x4 v = xr[64 * j]; xr[64 * j] = v * rs * gv[j]; } }
}

constexpr int PH_INIT = 0, PH_PER_LAYER = 16, PH_FINAL = 1 + DEPTH * PH_PER_LAYER, N_PHASES = PH_FINAL + 1;
enum { K_CONV = 0, K_KV, K_F1UP, K_F1DN, K_MIXIN, K_MOBA, K_PREP, K_SCAN, K_FIX, K_POST, K_MIXOUT, K_XQ, K_XATT, K_XO, K_F2UP, K_F2DN };

#ifdef ONLY
#define PH_ON(k) ((k) == (ONLY))
#else
#define PH_ON(k) true
#endif
__global__ void __launch_bounds__(NWAVES * 64, 2) fwd(Args args) {
    extern __shared__ __attribute__((aligned(16))) unsigned char lds[];
    Frame F;
    F.lds = (LAS unsigned char*)lds; F.MISC = (volatile LAS unsigned*)(F.lds + MISC_OFF);
    F.tid = threadIdx.x; F.lane = F.tid & 63; F.wave = __builtin_amdgcn_readfirstlane(F.tid >> 6);
    F.G = gridDim.x; { const int bx = blockIdx.x; F.vcu = (F.G % 8 == 0) ? (bx % 8) * (F.G / 8) + bx / 8 : bx; }
    F.out = args.out; F.ws = args.ws; F.ctl = (gu32*)(args.ws + WS_CTL);
    F.ka = (const __attribute__((address_space(4))) Args*)(uintptr_t)__builtin_amdgcn_kernarg_segment_ptr();
    for (int u = F.tid; u < (LDS_BYTES - LDSCTL_OFF) / 4; u += NWAVES * 64) ((LAS unsigned*)(F.lds + LDSCTL_OFF))[u] = 0u;
    __syncthreads();
    const bool multi = args.ph_hi - args.ph_lo > 1;
    XcdBarrier bar; bar.bar = (unsigned*)(F.ctl + 4096); bar.x = 0; bar.st = nullptr;
    if (multi) bar = xcd_barrier_post((unsigned*)(F.ctl + 4096), F.MISC + 8);
#ifndef REP_AT
#define REP_AT 1000
#endif
    for (int pi = args.ph_lo; pi < args.ph_hi + (REP_AT < 1000 ? 1 : 0); ++pi) { const int ph = pi - (pi > REP_AT ? 1 : 0);
        const bool dummy = REP_AT < 1000 && pi == REP_AT;
        { uintptr_t kp = (uintptr_t)__builtin_amdgcn_kernarg_segment_ptr(); asm volatile("" : "+s"(kp)); F.ka = (const __attribute__((address_space(4))) Args*)kp; }
        unsigned char* wb = F.ws + WS_W;
        if (ph == PH_INIT) { if (PH_ON(100)) { ph_init(F); ph_conv(F, 0); } }
        else if (ph == PH_FINAL) { if (PH_ON(101)) ph_final(F); }
        else { const int l = (ph - 1) / PH_PER_LAYER, k = (ph - 1) % PH_PER_LAYER;
            const float* xin = (l == 0) ? FIN(I_X) : (const float*)F.out;
            switch (k) {
            case K_CONV: if (!PH_ON(K_CONV)) break; if (l > 0) ph_conv(F, l); break;
            case K_KV: break;
            case K_F1UP: case K_F2UP: if (!PH_ON(K_F1UP)) break; { pg8::Gemm g{WSP(bf16, WS_XB), (const bf16*)(wb + (k == K_F1UP ? W_F1IN : W_F2IN)), M, 2 * DFF, DM}; pg8::StaticOrder S; S.init(M, 2 * DFF, F.G, (int)blockIdx.x);
                pg8::EpiSwiGLU E{F.ws, F.lds}; fill_rstd(F, S); pg8::gemm_phase<pg8::EpiSwiGLU, pg8::StaticOrder, true, true>(F.lds, g, S, E); } break;
            case K_F1DN: case K_F2DN: if (!PH_ON(K_F1DN)) break; { pg8::Gemm g{WSP(bf16, AR_H), (const bf16*)(wb + (k == K_F1DN ? W_F1OUT : W_F2OUT)), M, DM, DFF}; pg8::StaticOrder S; S.init(M, DM, F.G, (int)blockIdx.x);
                pg8::EpiResid E{k == K_F1DN ? xin : (const float*)F.out, dummy ? WSP(float, WS_AR + 96 * MiB) : F.out, F.ws, dummy ? WS_AR + 100 * MiB : WS_XB, 0.5f}; pg8::gemm_phase<pg8::EpiResid, pg8::StaticOrder, true, true>(F.lds, g, S, E); } break;
            case K_MIXIN: if (!PH_ON(K_MIXIN)) break; { pg8::Gemm g{WSP(bf16, WS_XB), (const bf16*)(wb + W_MIXIN), M, DPROJ, DM}; pg8::StaticOrder S; S.init(M, DPROJ, F.G, (int)blockIdx.x);
                pg8::EpiMixIn E{F.ws, F.lds}; fill_rstd(F, S); pg8::gemm_phase<pg8::EpiMixIn, pg8::StaticOrder, true, true>(F.lds, g, S, E); }
                {
                  pg8::Gemm g{WSP(bf16, WS_MEMB), (const bf16*)(wb + W_WKV), MM, 2 * DM, DM}; pg8::StaticOrder S; S.init(MM, 2 * DM, F.G, (int)((blockIdx.x + F.G - 64) % F.G));
                  pg8::EpiKV E{F.ws}; pg8::gemm_phase<pg8::EpiKV, pg8::StaticOrder, true, true>(F.lds, g, S, E); } break;
            case K_MOBA: if (!PH_ON(K_MOBA)) break; ph_moba(F); break;
            case K_PREP: if (!PH_ON(K_PREP)) break; ph_prep(F, l); break;
            case K_SCAN: if (!PH_ON(K_SCAN)) break; ph_scan<SCAN_R, SCAN_NCH>(F); break;
            case K_FIX: if (!PH_ON(K_FIX)) break; if (SCAN_NCH > 1) ph_fix<SCAN_NCH>(F); break;
            case K_POST: if (!PH_ON(K_POST)) break; ph_post<SCAN_NCH>(F, l, dummy); break;
            case K_MIXOUT: if (!PH_ON(K_MIXOUT)) break; { pg8::Gemm g{WSP(bf16, WS_XB), (const bf16*)(wb + W_MIXOUT), M, DM, DM}; pg8::StaticOrder S; S.init(M, DM, F.G, (int)blockIdx.x);
                pg8::EpiResid E{F.out, dummy ? WSP(float, WS_AR + 96 * MiB) : F.out, F.ws, dummy ? WS_AR + 100 * MiB : AR_XB2, 1.0f}; pg8::gemm_phase<pg8::EpiResid, pg8::StaticOrder, true, true>(F.lds, g, S, E); } break;
            case K_XQ: if (!PH_ON(K_XQ)) break; { pg8::Gemm g{WSP(bf16, AR_XB2), (const bf16*)(wb + W_WQ), M, DM, DM}; pg8::StaticOrder S; S.init(M, DM, F.G, (int)blockIdx.x);
                pg8::EpiXQ E{F.ws, F.lds}; fill_rstd(F, S); pg8::gemm_phase<pg8::EpiXQ, pg8::StaticOrder, true, true>(F.lds, g, S, E); } break;
            case K_XATT: if (!PH_ON(K_XATT)) break; ph_xatt(F); break;
            case K_XO: if (!PH_ON(K_XO)) break; { pg8::Gemm g{WSP(bf16, AR_XO), (const bf16*)(wb + W_WO), M, DM, DM}; pg8::StaticOrder S; S.init(M, DM, F.G, (int)blockIdx.x);
                pg8::EpiResid E{F.out, dummy ? WSP(float, WS_AR + 96 * MiB) : F.out, F.ws, dummy ? WS_AR + 100 * MiB : WS_XB, 1.0f}; pg8::gemm_phase<pg8::EpiResid, pg8::StaticOrder, true, true>(F.lds, g, S, E); } break;
            default: break;
            }
        }
        if (pi + 1 < args.ph_hi + (REP_AT < 1000 ? 1 : 0)) {
            const int kk_ = (ph - 1) % PH_PER_LAYER, ll_ = (ph - 1) / PH_PER_LAYER;
            const bool noop = ph != PH_INIT && ph != PH_FINAL && ((kk_ == K_FIX && SCAN_NCH == 1) || kk_ == K_KV || (kk_ == K_CONV && ll_ == 0));
            if (!noop) xcd_barrier(bar);
        }
    }
}

extern "C" void kernel_launch(void* const* d_in, const int* in_sizes, int n_in, void* d_out, int out_size, void* d_ws, size_t ws_size, hipStream_t stream) {
    static int grid = 0;
    if (grid == 0) {
        if (n_in != N_IN || in_sizes[0] != M * DM || out_size != M * DM || ws_size < WS_END) { fprintf(stderr, "kernel_launch: unexpected problem (n_in %d, in0 %d, out %d, ws %zu < %zu); nothing launched\n", n_in, n_in > 0 ? in_sizes[0] : -1, out_size, ws_size, (size_t)WS_END); grid = -1; return; }
        int dev = 0, cus = 0;
        if (hipGetDevice(&dev) != hipSuccess || hipDeviceGetAttribute(&cus, hipDeviceAttributeMultiprocessorCount, dev) != hipSuccess) { grid = -1; return; }
        if (hipFuncSetAttribute((const void*)fwd, hipFuncAttributeMaxDynamicSharedMemorySize, LDS_BYTES) != hipSuccess) { fprintf(stderr, "kernel_launch: hipFuncSetAttribute failed\n"); grid = -1; return; }
        int per_cu = 0;
        if (hipOccupancyMaxActiveBlocksPerMultiprocessor(&per_cu, (const void*)fwd, NWAVES * 64, LDS_BYTES) != hipSuccess || per_cu < 1) { fprintf(stderr, "kernel_launch: occupancy query reports %d workgroups per CU; nothing launched\n", per_cu); grid = -1; return; }
        grid = cus;
    }
    if (grid < 0) return;
    (void)hipMemsetAsync((char*)d_ws + WS_CTL, 0, CTL_ZERO_BYTES, stream);
    Args a{};
    for (int i = 0; i < N_IN; ++i) a.in[i] = (const float*)d_in[i];
    a.out = (float*)d_out; a.ws = (unsigned char*)d_ws;
    a.ph_lo = 0; a.ph_hi = N_PHASES;
    void* kargs[] = {&a};
    const hipError_t e = hipLaunchCooperativeKernel((const void*)fwd, dim3(grid), dim3(NWAVES * 64), kargs, LDS_BYTES, stream);
    if (e != hipSuccess) fprintf(stderr, "kernel_launch: cooperative launch failed: %s (grid %d)\n", hipGetErrorString(e), grid);
}
```

```cpp
#include <hip/hip_runtime.h>
#include <hip/hip_cooperative_groups.h>
#include <cstdio>
#include <cstdint>

constexpr int BATCH = 8, SEQ = 2048, DM = 1024, DEPTH = 2, M = BATCH * SEQ;
constexpr int RW = 512, NH = 8, HD = 64;
constexpr int RPROJ = 1792, DPROJ = 3328;
constexpr int DFF = 2816;
constexpr int MEMLEN = 256, XH = 4, XHD = 256, MM = BATCH * MEMLEN;
constexpr int MBLK = 256, NBLK = SEQ / MBLK;
constexpr float NORM_EPS = 1e-6f, LNX_EPS = 64e-5f;
constexpr float LOG2E = 1.4426950408889634f;
constexpr float MOBA_QSCALE = 0.125f * LOG2E;
constexpr float XATT_QSCALE = 0.0625f * LOG2E;

enum { I_X = 0, I_MEM, I_RELB, I_FING, I_F1G, I_F1IN, I_F1OUT, I_MIXG, I_MIXIN, I_MIXOUT, I_MU, I_W0, I_WUP, I_A0, I_AUP, I_GUP, I_KK, I_KA, I_RK, I_LNG, I_LNB,
       I_XG, I_MEMG, I_WQ, I_WKV, I_WO, I_F2G, I_F2IN, I_F2OUT, N_IN };

constexpr size_t MiB = 1u << 20;
constexpr size_t WS_CTL = 0, CTL_ZERO_BYTES = 1 * MiB;
constexpr size_t WS_BIAS = 1 * MiB;
constexpr size_t WS_MEMRS = WS_BIAS + 64 * 1024;
constexpr size_t WS_BONUS = WS_MEMRS + 64 * 1024;
constexpr size_t WS_KMS = WS_BONUS + 512 * 1024;
constexpr size_t WS_SSQ = 2 * MiB;
constexpr size_t WS_MEMB = 3 * MiB;
constexpr size_t WS_XK = 7 * MiB, WS_XVT = 11 * MiB;
constexpr size_t WS_W = 15 * MiB;
constexpr size_t W_F1IN = 0, W_F1OUT = W_F1IN + (size_t)2 * DFF * DM * 2, W_F2IN = W_F1OUT + (size_t)DM * DFF * 2, W_F2OUT = W_F2IN + (size_t)2 * DFF * DM * 2,
                 W_MIXIN = W_F2OUT + (size_t)DM * DFF * 2, W_MIXOUT = W_MIXIN + (size_t)DPROJ * DM * 2, W_WQ = W_MIXOUT + (size_t)DM * DM * 2, W_WKV = W_WQ + (size_t)DM * DM * 2,
                 W_WO = W_WKV + (size_t)2 * DM * DM * 2, W_WUPT = W_WO + (size_t)DM * DM * 2, W_AUPT = W_WUPT + (size_t)RW * 64 * 2, W_GUPT = W_AUPT + (size_t)RW * 64 * 2, W_END = W_GUPT + (size_t)RW * 128 * 2;
static_assert(W_END <= 50 * MiB, "weights fit");
constexpr size_t WS_XB = 65 * MiB;
constexpr size_t WS_AR = 97 * MiB;
constexpr size_t AR_H = WS_AR;
constexpr size_t AR_PR = WS_AR, AR_MQ = WS_AR + 56 * MiB, AR_MK = WS_AR + 72 * MiB, AR_MVT = WS_AR + 88 * MiB;
constexpr size_t AR_SCANIN = WS_AR + 56 * MiB;
constexpr size_t AR_SV = WS_AR + 136 * MiB;
constexpr size_t AR_YLOC = WS_AR, AR_Z = WS_AR + 32 * MiB;
constexpr size_t AR_STATE = WS_AR + 152 * MiB;
constexpr size_t AR_XB2 = WS_AR, AR_XQ = WS_AR + 32 * MiB, AR_XO = WS_AR + 64 * MiB;
constexpr size_t WS_END = WS_AR + 168 * MiB;

#define GAS __attribute__((address_space(1)))
#define LAS __attribute__((address_space(3)))

namespace pg8 {
#define PG8_LAS __attribute__((address_space(3)))
typedef unsigned short bf16_t;
typedef short bf16x8 __attribute__((ext_vector_type(8)));
typedef float f32x4 __attribute__((ext_vector_type(4)));
typedef unsigned u32x4 __attribute__((ext_vector_type(4)));
constexpr int BM = 256, BK = 64, HALF = 128, HTB = HALF * BK * 2  , STAGE_BYTES = 8 * HTB, NXCD = 8, WGM = 8;

__host__ __device__ __forceinline__ int lds_byte(int r, int c) { const int st = (r >> 4) * 2 + (c >> 5), rr = r & 15, cc = c & 31, ob = rr * 64 + cc * 2; return st * 1024 + (ob ^ (((ob >> 9) & 1) << 5)); }
__host__ __device__ __forceinline__ void stage_rc(int b, int& R, int& C) { const int st = b / 1024, sb = b % 1024, swz = sb ^ (((sb >> 9) & 1) << 5); R = (st >> 1) * 16 + swz / 64; C = (st & 1) * 32 + (swz % 64) / 2; }
__host__ __device__ __forceinline__ int perm32(int rho) { const int n = rho >> 4, i = rho & 15; return 8 * (i >> 2) + 4 * n + (i & 3); }

struct Unit { int pm, pn, i; };
struct Gemm { const bf16_t* A; const bf16_t* Bt; int M, N, K; };

struct StaticOrder {
    int nM, nN, nwg, G, c;
    __host__ __device__ void init(int M, int N, int G_, int c_) { nM = M / BM; nN = N / BM; nwg = nM * nN; G = G_; c = c_; }
    __host__ __device__ bool next(int i, Unit& u) const {
        const long L = (long)i * G + c; if (L >= nwg) return false;
        int wgid = (int)L; { const int q = nwg / NXCD, r = nwg % NXCD, xcd = wgid % NXCD, off = wgid / NXCD; wgid = (xcd < r ? xcd * (q + 1) : r * (q + 1) + (xcd - r) * q) + off; }
        const int nig = WGM * nN, gid = wgid / nig, fm = gid * WGM, gsz = (nM - fm) < WGM ? (nM - fm) : WGM;
        u.pm = fm + ((wgid % nig) % gsz); u.pn = (wgid % nig) / gsz; u.i = i; return true;
    }
    __device__ __forceinline__ void a_ready(const Unit&) const {}
    __device__ __forceinline__ void done(const Unit&) const {}
};

__device__ __forceinline__ unsigned cvt_pk_bf16(float lo, float hi) { unsigned r; asm volatile("v_cvt_pk_bf16_f32 %0, %1, %2" : "=v"(r) : "v"(lo), "v"(hi)); return r; }
typedef float f32x2 __attribute__((ext_vector_type(2)));
__device__ __forceinline__ float row_rstd16(const float* ssq, int r) {
    const f32x4* p = (const f32x4*)(ssq + (size_t)r * 16);
    const f32x4 a = p[0], b = p[1], c = p[2], d = p[3];
    const float s = ((a[0] + a[1]) + (a[2] + a[3])) + ((b[0] + b[1]) + (b[2] + b[3])) + ((c[0] + c[1]) + (c[2] + c[3])) + ((d[0] + d[1]) + (d[2] + d[3]));
    return __builtin_amdgcn_rsqf(s * (1.0f / 1024.0f) + 1e-6f);
}
constexpr int RST_OFF = 131072;
__device__ __forceinline__ float silu_mul(float g, float u) { return g * __builtin_amdgcn_rcpf(1.0f + __expf(-g)) * u; }
__device__ __forceinline__ u32x4 pack8(const f32x4 v0, const f32x4 v1) { u32x4 w; w.x = cvt_pk_bf16(v0[0], v0[1]); w.y = cvt_pk_bf16(v0[2], v0[3]); w.z = cvt_pk_bf16(v1[0], v1[1]); w.w = cvt_pk_bf16(v1[2], v1[3]); return w; }
__device__ __forceinline__ int pos16(int k) { return 8 * ((k >> 2) & 1) + (k & 3) + 4 * (k >> 3); }

struct EpiSwiGLU {
    static constexpr bool PERM = true, AFTER_DRAIN = false;
    unsigned char* ws; PG8_LAS unsigned char* lds;
    __device__ __forceinline__ void operator()(const f32x4 (&acc)[2][2][4][2], const Unit& u, int wr, int wc, int fr, int fq) const {
        const int row0 = u.pm * BM + wr * 64 + fr, hcol = u.pn * 128 + wc * 32 + 8 * fq; bf16_t* H = (bf16_t*)(ws + AR_H);
        const PG8_LAS float* rst = (const PG8_LAS float*)(lds + RST_OFF) + u.i * 256 + wr * 64 + fr;
#pragma unroll
        for (int ai = 0; ai < 2; ++ai)
#pragma unroll
            for (int m = 0; m < 4; ++m) { const int r = row0 + ai * HALF + m * 16; const float rs = rst[ai * HALF + m * 16];
                f32x4 h0, h1;
#pragma unroll
                for (int i = 0; i < 4; ++i) { h0[i] = silu_mul(acc[ai][0][m][0][i] * rs, acc[ai][1][m][0][i] * rs); h1[i] = silu_mul(acc[ai][0][m][1][i] * rs, acc[ai][1][m][1][i] * rs); }
                *(u32x4*)(H + (size_t)r * 2816 + hcol) = pack8(h0, h1); }
    }
};
struct EpiResid {
    static constexpr bool PERM = true, AFTER_DRAIN = false;
    const float* base; float* out; unsigned char* ws; size_t xb_off; float alpha;
    __device__ __forceinline__ void operator()(const f32x4 (&acc)[2][2][4][2], const Unit& u, int wr, int wc, int fr, int fq) const {
        const int row0 = u.pm * BM + wr * 64 + fr, col0 = u.pn * BM + wc * 32 + 8 * fq; bf16_t* xb = (bf16_t*)(ws + xb_off); float* ssq = (float*)(ws + WS_SSQ);
#pragma unroll
        for (int ai = 0; ai < 2; ++ai) {
            f32x4 bs[4][2][2];
#pragma unroll
            for (int m = 0; m < 4; ++m)
#pragma unroll
                for (int bj = 0; bj < 2; ++bj) { const size_t off = (size_t)(row0 + ai * HALF + m * 16) * 1024 + col0 + bj * HALF; bs[m][bj][0] = *(const f32x4*)(base + off); bs[m][bj][1] = *(const f32x4*)(base + off + 4); }
#pragma unroll
            for (int m = 0; m < 4; ++m)
#pragma unroll
                for (int bj = 0; bj < 2; ++bj) asm volatile("" : "+v"(bs[m][bj][0]), "+v"(bs[m][bj][1]));
#pragma unroll
            for (int m = 0; m < 4; ++m) { const int r = row0 + ai * HALF + m * 16; float s = 0.f;
#pragma unroll
                for (int bj = 0; bj < 2; ++bj) { const size_t off = (size_t)r * 1024 + col0 + bj * HALF;
                    const f32x4 v0 = bs[m][bj][0] + acc[ai][bj][m][0] * alpha, v1 = bs[m][bj][1] + acc[ai][bj][m][1] * alpha;
                    *(f32x4*)(out + off) = v0; *(f32x4*)(out + off + 4) = v1; *(u32x4*)(xb + off) = pack8(v0, v1);
                    s += (v0[0] * v0[0] + v0[1] * v0[1]) + (v0[2] * v0[2] + v0[3] * v0[3]) + (v1[0] * v1[0] + v1[1] * v1[1]) + (v1[2] * v1[2] + v1[3] * v1[3]); }
                s += __shfl_xor(s, 16); s += __shfl_xor(s, 32);
                if (fq == 0) ssq[(size_t)r * 16 + u.pn * 4 + wc] = s; } }
    }
};
struct EpiMixIn {
    static constexpr bool PERM = true, AFTER_DRAIN = false;
    unsigned char* ws; PG8_LAS unsigned char* lds;
    __device__ __forceinline__ void operator()(const f32x4 (&acc)[2][2][4][2], const Unit& u, int wr, int wc, int fr, int fq) const {
        const int row0 = u.pm * BM + wr * 64 + fr, cw = wc * 32 + 8 * fq; const PG8_LAS float* rst = (const PG8_LAS float*)(lds + RST_OFF) + u.i * 256 + wr * 64 + fr;
        bf16_t* PR = (bf16_t*)(ws + AR_PR); bf16_t* MQ = (bf16_t*)(ws + AR_MQ); bf16_t* MK = (bf16_t*)(ws + AR_MK); bf16_t* MVT = (bf16_t*)(ws + AR_MVT);
        f32x4 ks[2][2]; ks[0][0] = (f32x4){0.f, 0.f, 0.f, 0.f}; ks[0][1] = ks[0][0]; ks[1][0] = ks[0][0]; ks[1][1] = ks[0][0];
#pragma unroll
        for (int ai = 0; ai < 2; ++ai)
#pragma unroll
            for (int m = 0; m < 4; ++m) { const int r = row0 + ai * HALF + m * 16; const float rs = rst[ai * HALF + m * 16];
#pragma unroll
                for (int bj = 0; bj < 2; ++bj) { const int c = cw + bj * HALF;
                    f32x4 v0 = acc[ai][bj][m][0] * rs, v1 = acc[ai][bj][m][1] * rs;
                    if (u.pn < 7) *(u32x4*)(PR + (size_t)r * 1792 + u.pn * 256 + c) = pack8(v0, v1);
                    else if (u.pn < 9) { v0 = v0 * MOBA_QSCALE; v1 = v1 * MOBA_QSCALE; *(u32x4*)(MQ + (size_t)r * 512 + (u.pn - 7) * 256 + c) = pack8(v0, v1); }
                    else if (u.pn < 11) { *(u32x4*)(MK + (size_t)r * 512 + (u.pn - 9) * 256 + c) = pack8(v0, v1); ks[bj][0] += v0; ks[bj][1] += v1; }
                    else { const int cc = (u.pn - 11) * 256 + c, hh = cc >> 6, d = cc & 63, b = r >> 11, t = r & 2047;
                        bf16_t* p = MVT + ((size_t)(b * 8 + hh) * 64 + d) * 2048 + (t & ~15) + pos16(t & 15);
                        const u32x4 w = pack8(v0, v1);
                        p[0] = (bf16_t)(w.x & 0xffffu); p[2048] = (bf16_t)(w.x >> 16); p[2 * 2048] = (bf16_t)(w.y & 0xffffu); p[3 * 2048] = (bf16_t)(w.y >> 16);
                        p[4 * 2048] = (bf16_t)(w.z & 0xffffu); p[5 * 2048] = (bf16_t)(w.z >> 16); p[6 * 2048] = (bf16_t)(w.w & 0xffffu); p[7 * 2048] = (bf16_t)(w.w >> 16); }
                } }
        if (u.pn == 9 || u.pn == 10) {
            float* KMS = (float*)(ws + WS_KMS) + ((size_t)u.pm * 2 + wr) * 512 + (u.pn - 9) * 256 + cw;
#pragma unroll
            for (int bj = 0; bj < 2; ++bj)
#pragma unroll
                for (int n = 0; n < 2; ++n) { f32x4 v = ks[bj][n];
#pragma unroll
                    for (int o = 1; o < 16; o <<= 1) { v[0] += __shfl_xor(v[0], o); v[1] += __shfl_xor(v[1], o); v[2] += __shfl_xor(v[2], o); v[3] += __shfl_xor(v[3], o); }
                    if (fr == 0) *(f32x4*)(KMS + bj * HALF + 4 * n) = v; } }
    }
};
struct EpiXQ {
    static constexpr bool PERM = true, AFTER_DRAIN = false;
    unsigned char* ws; PG8_LAS unsigned char* lds;
    __device__ __forceinline__ void operator()(const f32x4 (&acc)[2][2][4][2], const Unit& u, int wr, int wc, int fr, int fq) const {
        const int row0 = u.pm * BM + wr * 64 + fr, col0 = u.pn * BM + wc * 32 + 8 * fq; bf16_t* Q = (bf16_t*)(ws + AR_XQ);
        const PG8_LAS float* rst = (const PG8_LAS float*)(lds + RST_OFF) + u.i * 256 + wr * 64 + fr;
#pragma unroll
        for (int ai = 0; ai < 2; ++ai)
#pragma unroll
            for (int m = 0; m < 4; ++m) { const int r = row0 + ai * HALF + m * 16; const float rs = rst[ai * HALF + m * 16] * XATT_QSCALE;
#pragma unroll
                for (int bj = 0; bj < 2; ++bj) *(u32x4*)(Q + (size_t)r * 1024 + col0 + bj * HALF) = pack8(acc[ai][bj][m][0] * rs, acc[ai][bj][m][1] * rs); }
    }
};
struct EpiKV {
    static constexpr bool PERM = true, AFTER_DRAIN = false;
    unsigned char* ws;
    __device__ __forceinline__ void operator()(const f32x4 (&acc)[2][2][4][2], const Unit& u, int wr, int wc, int fr, int fq) const {
        const int row0 = u.pm * BM + wr * 64 + fr, cw = wc * 32 + 8 * fq; bf16_t* XK = (bf16_t*)(ws + WS_XK); bf16_t* XVT = (bf16_t*)(ws + WS_XVT); const float* memrs = (const float*)(ws + WS_MEMRS);
        float rsv[2][4];
#pragma unroll
        for (int ai = 0; ai < 2; ++ai)
#pragma unroll
            for (int m = 0; m < 4; ++m) rsv[ai][m] = memrs[row0 + ai * HALF + m * 16];
#pragma unroll
        for (int ai = 0; ai < 2; ++ai)
#pragma unroll
            for (int m = 0; m < 4; ++m) { const int r = row0 + ai * HALF + m * 16; const float rs = rsv[ai][m];
#pragma unroll
                for (int bj = 0; bj < 2; ++bj) { const int c = cw + bj * HALF;
                    const f32x4 v0 = acc[ai][bj][m][0] * rs, v1 = acc[ai][bj][m][1] * rs;
                    if (u.pn < 4) *(u32x4*)(XK + (size_t)r * 1024 + u.pn * 256 + c) = pack8(v0, v1);
                    else { const int hx = u.pn - 4, b = r >> 8, key = r & 255;
                        bf16_t* p = XVT + ((size_t)(b * 4 + hx) * 256 + c) * 256 + (key & ~15) + pos16(key & 15);
                        const u32x4 w = pack8(v0, v1);
                        p[0] = (bf16_t)(w.x & 0xffffu); p[256] = (bf16_t)(w.x >> 16); p[2 * 256] = (bf16_t)(w.y & 0xffffu); p[3 * 256] = (bf16_t)(w.y >> 16);
                        p[4 * 256] = (bf16_t)(w.z & 0xffffu); p[5 * 256] = (bf16_t)(w.z >> 16); p[6 * 256] = (bf16_t)(w.w & 0xffffu); p[7 * 256] = (bf16_t)(w.w >> 16); }
                } }
    }
};

template <class Epi, class Sched, bool ALIGN_EPI = false, bool SP2 = false>
__device__ __forceinline__ void gemm_phase(PG8_LAS unsigned char* lds, const Gemm g, const Sched& S, const Epi& E) {
    int tid_ = threadIdx.x; asm volatile("" : "+v"(tid_));
    const int tid = tid_, wid = __builtin_amdgcn_readfirstlane(tid >> 6), lane = tid & 63, wr = wid >> 2, wc = wid & 3, fr = lane & 15, fq = lane >> 4;
    const int K = g.K, nt = K / BK;
    unsigned voffA[2], voffB[2];
#pragma unroll
    for (int i = 0; i < 2; ++i) { int R, C; stage_rc(tid * 16 + i * 8192, R, C); const int Rb = Epi::PERM ? ((R & ~31) + perm32(R & 31)) : R;
        voffA[i] = (unsigned)(R * K + C) * 2u; voffB[i] = (unsigned)(Rb * K + C) * 2u; }
    const size_t kstep = (size_t)(BK * 2);
    const size_t hstep = (size_t)HALF * K * 2;
    const size_t tstep = 2 * hstep;
    const unsigned ldsw = (unsigned)wid * 1024u;
    const int aoff = lds_byte(wr * 64 + fr, fq * 8), boff = lds_byte(wc * 32 + fr, fq * 8);
#define PG8_SA(b, h) (((b) * 2 + (h)) * HTB)
#define PG8_SB(b, h) ((4 + (b) * 2 + (h)) * HTB)
#define PG8_STAGE(bufoff, gbase, voff) do { _Pragma("unroll") for (int _i = 0; _i < 2; ++_i) \
        __builtin_amdgcn_global_load_lds((const unsigned*)((const char*)(gbase) + (voff)[_i]), (PG8_LAS unsigned*)(lds + (bufoff) + ldsw + _i * 8192), 16, 0, 0); } while (0)
#define PG8_LDA(dst, b, h) do { _Pragma("unroll") for (int m = 0; m < 4; ++m) _Pragma("unroll") for (int k = 0; k < 2; ++k) dst[m][k] = *(const PG8_LAS bf16x8*)(lds + PG8_SA(b, h) + aoff + m * 2048 + k * 1024); } while (0)
#define PG8_LDB(dst, b, h) do { _Pragma("unroll") for (int n = 0; n < 2; ++n) _Pragma("unroll") for (int k = 0; k < 2; ++k) dst[n][k] = *(const PG8_LAS bf16x8*)(lds + PG8_SB(b, h) + boff + n * 2048 + k * 1024); } while (0)
#define PG8_MMA(ai, bj, At, Bt) do { __builtin_amdgcn_s_setprio(1); _Pragma("unroll") for (int m = 0; m < 4; ++m) _Pragma("unroll") for (int n = 0; n < 2; ++n) _Pragma("unroll") for (int k = 0; k < 2; ++k) \
        acc[ai][bj][m][n] = __builtin_amdgcn_mfma_f32_16x16x32_bf16(Bt[n][k], At[m][k], acc[ai][bj][m][n], 0, 0, 0); __builtin_amdgcn_s_setprio(0); } while (0)
#define PG8_WAIT_V(n) asm volatile("s_waitcnt vmcnt(" #n ")" ::: "memory")
#define PG8_WAIT_L(n) asm volatile("s_waitcnt lgkmcnt(" #n ")" ::: "memory")
#define PG8_BAR __builtin_amdgcn_s_barrier()
#define PG8_SCHED __builtin_amdgcn_sched_barrier(0)
    Unit cur, nxt; int ui = 0;
    if (!S.next(0, cur)) return;
    f32x4 acc[2][2][4][2];
#pragma unroll
    for (int a = 0; a < 2; ++a)
#pragma unroll
        for (int b = 0; b < 2; ++b)
#pragma unroll
            for (int m = 0; m < 4; ++m)
#pragma unroll
                for (int n = 0; n < 2; ++n) acc[a][b][m][n] = (f32x4){0.f, 0.f, 0.f, 0.f};
    bf16x8 At[4][2], B0[2][2], B1[2][2];
    const char* cA = (const char*)g.A + (size_t)cur.pm * tstep; const char* cB = (const char*)g.Bt + (size_t)cur.pn * tstep;
    S.a_ready(cur);
    if constexpr (SP2) {
        PG8_STAGE(PG8_SB(0, 0), cB, voffB); PG8_STAGE(PG8_SB(0, 1), cB + hstep, voffB); PG8_STAGE(PG8_SA(0, 0), cA, voffA); PG8_STAGE(PG8_SA(0, 1), cA + hstep, voffA);
        if (wr == 1) PG8_BAR;
        PG8_WAIT_V(2); PG8_BAR;
        PG8_STAGE(PG8_SB(1, 0), cB + kstep, voffB); PG8_STAGE(PG8_SA(1, 0), cA + kstep, voffA); PG8_STAGE(PG8_SB(1, 1), cB + hstep + kstep, voffB);
        PG8_WAIT_V(6); PG8_BAR;
    } else {
        PG8_STAGE(PG8_SB(0, 0), cB, voffB); PG8_STAGE(PG8_SA(0, 0), cA, voffA); PG8_STAGE(PG8_SB(0, 1), cB + hstep, voffB); PG8_STAGE(PG8_SA(0, 1), cA + hstep, voffA);
        if (wr == 1) PG8_BAR;
        PG8_WAIT_V(4); PG8_BAR;
        PG8_STAGE(PG8_SB(1, 0), cB + kstep, voffB); PG8_STAGE(PG8_SA(1, 0), cA + kstep, voffA); PG8_STAGE(PG8_SB(1, 1), cB + hstep + kstep, voffB);
        PG8_WAIT_V(6); PG8_BAR;
    }
    for (;;) {
        const bool has_next = S.next(ui + 1, nxt);
        const char* nA = has_next ? (const char*)g.A + (size_t)nxt.pm * tstep : cA; const char* nB = has_next ? (const char*)g.Bt + (size_t)nxt.pn * tstep : cB;
        for (int t = 0; t < nt; t += 2) {
            const bool last = (t == nt - 2);
            const char* a1 = cA + (size_t)(t + 1) * kstep;
            const char* a2 = last ? nA : cA + (size_t)(t + 2) * kstep; const char* b2 = last ? nB : cB + (size_t)(t + 2) * kstep;
            const char* a3 = a2 + kstep; const char* b3 = b2 + kstep;
            if (last && has_next) S.a_ready(nxt);
            if constexpr (SP2) {
            PG8_LDB(B0, 0, 0); PG8_LDB(B1, 0, 1); PG8_SCHED; PG8_LDA(At, 0, 0); PG8_STAGE(PG8_SA(1, 1), a1 + hstep, voffA);
            PG8_WAIT_V(8); PG8_WAIT_L(0); PG8_BAR; PG8_MMA(0, 0, At, B0); PG8_MMA(0, 1, At, B1); PG8_BAR; PG8_SCHED;
            PG8_LDA(At, 0, 1); PG8_STAGE(PG8_SB(0, 0), b2, voffB); PG8_STAGE(PG8_SB(0, 1), b2 + hstep, voffB); PG8_STAGE(PG8_SA(0, 0), a2, voffA);
            PG8_WAIT_V(8); PG8_WAIT_L(0); PG8_BAR; PG8_MMA(1, 0, At, B0); PG8_MMA(1, 1, At, B1); PG8_BAR; PG8_SCHED;
            PG8_LDB(B0, 1, 0); PG8_LDB(B1, 1, 1); PG8_SCHED; PG8_LDA(At, 1, 0); PG8_STAGE(PG8_SA(0, 1), a2 + hstep, voffA);
            PG8_WAIT_V(8); PG8_WAIT_L(0); PG8_BAR; PG8_MMA(0, 0, At, B0); PG8_MMA(0, 1, At, B1); PG8_BAR; PG8_SCHED;
            PG8_LDA(At, 1, 1); PG8_STAGE(PG8_SB(1, 0), b3, voffB); PG8_STAGE(PG8_SB(1, 1), b3 + hstep, voffB); PG8_STAGE(PG8_SA(1, 0), a3, voffA);
            PG8_WAIT_V(8); PG8_WAIT_L(0); PG8_BAR; PG8_MMA(1, 0, At, B0); PG8_MMA(1, 1, At, B1); PG8_BAR; PG8_SCHED;
            } else {
            PG8_LDB(B0, 0, 0); PG8_SCHED; PG8_LDA(At, 0, 0); PG8_STAGE(PG8_SA(1, 1), a1 + hstep, voffA);
            PG8_WAIT_L(8); PG8_BAR; PG8_WAIT_L(0); PG8_MMA(0, 0, At, B0); PG8_BAR; PG8_SCHED;
            PG8_LDB(B1, 0, 1); PG8_STAGE(PG8_SB(0, 0), b2, voffB);
            PG8_BAR; PG8_WAIT_L(0); PG8_MMA(0, 1, At, B1); PG8_BAR;
            PG8_LDA(At, 0, 1); PG8_STAGE(PG8_SA(0, 0), a2, voffA);
            PG8_BAR; PG8_WAIT_L(0); PG8_MMA(1, 0, At, B0); PG8_BAR; PG8_SCHED;
            PG8_STAGE(PG8_SB(0, 1), b2 + hstep, voffB);
            PG8_WAIT_V(6); PG8_BAR; PG8_MMA(1, 1, At, B1); PG8_BAR;
            PG8_LDB(B0, 1, 0); PG8_SCHED; PG8_LDA(At, 1, 0); PG8_STAGE(PG8_SA(0, 1), a2 + hstep, voffA);
            PG8_WAIT_L(8); PG8_BAR; PG8_WAIT_L(0); PG8_MMA(0, 0, At, B0); PG8_BAR; PG8_SCHED;
            PG8_LDB(B1, 1, 1); PG8_STAGE(PG8_SB(1, 0), b3, voffB);
            PG8_BAR; PG8_WAIT_L(0); PG8_MMA(0, 1, At, B1); PG8_BAR;
            PG8_LDA(At, 1, 1); PG8_STAGE(PG8_SA(1, 0), a3, voffA);
            PG8_BAR; PG8_WAIT_L(0); PG8_MMA(1, 0, At, B0); PG8_BAR; PG8_SCHED;
            PG8_STAGE(PG8_SB(1, 1), b3 + hstep, voffB);
            PG8_WAIT_V(6); PG8_BAR; PG8_MMA(1, 1, At, B1); PG8_BAR;
            }
        }
        if constexpr (ALIGN_EPI) { if (wr == 0) PG8_BAR; }
        if constexpr (!Epi::AFTER_DRAIN) { E(acc, cur, wr, wc, fr, fq); S.done(cur); }
        if (!has_next) break;
#pragma unroll
        for (int a = 0; a < 2; ++a)
#pragma unroll
            for (int b = 0; b < 2; ++b)
#pragma unroll
                for (int m = 0; m < 4; ++m)
#pragma unroll
                    for (int n = 0; n < 2; ++n) acc[a][b][m][n] = (f32x4){0.f, 0.f, 0.f, 0.f};
        cur = nxt; cA = nA; cB = nB; ++ui;
        if constexpr (ALIGN_EPI) { if (wr == 1) PG8_BAR; }
    }
    PG8_WAIT_V(0);
    if constexpr (!ALIGN_EPI) { if (wr == 0) PG8_BAR; }
    PG8_BAR;
    if constexpr (Epi::AFTER_DRAIN) { E.fused(acc, cur, wr, wc, fr, fq, lds, wid, lane); S.done(cur); }
#undef PG8_SA
#undef PG8_SB
#undef PG8_STAGE
#undef PG8_LDA
#undef PG8_LDB
#undef PG8_MMA
#undef PG8_WAIT_V
#undef PG8_WAIT_L
#undef PG8_BAR
#undef PG8_SCHED
}
}

constexpr int NWAVES = 8;
constexpr int LDS_BYTES = 163840, LDSCTL_OFF = LDS_BYTES - 512, MISC_OFF = LDSCTL_OFF + 320, PHASE_LDS = LDSCTL_OFF;
constexpr int SCAN_R = 2, SCAN_NCH = 8;

typedef unsigned short bf16;
typedef unsigned u32x4 __attribute__((ext_vector_type(4)));
typedef unsigned u32x2 __attribute__((ext_vector_type(2)));
typedef float f32x4 __attribute__((ext_vector_type(4)));
typedef float f32x16 __attribute__((ext_vector_type(16)));
typedef short bf16x8 __attribute__((ext_vector_type(8)));
typedef GAS unsigned gu32;
#define RLX_AGENT __ATOMIC_RELAXED, __HIP_MEMORY_SCOPE_AGENT
#define LDS_WAIT() asm volatile("s_waitcnt lgkmcnt(0)" ::: "memory")
#define VM_WAIT() asm volatile("s_waitcnt vmcnt(0)" ::: "memory")
__device__ __forceinline__ float bf2f(unsigned b) { return __uint_as_float(b << 16); }
__device__ __forceinline__ unsigned f2bf(float f) { unsigned u = __builtin_bit_cast(unsigned, f); return (u + 0x7fffu + ((u >> 16) & 1u)) >> 16; }
__device__ __forceinline__ unsigned pk2(float lo, float hi) { return pg8::cvt_pk_bf16(lo, hi); }
__device__ __forceinline__ float wave_sum(float v) {
#pragma unroll
    for (int o = 1; o < 64; o <<= 1) v += __shfl_xor(v, o);
    return v;
}
#define WS8_STEP(o) _Pragma("unroll") for (int q = 0; q < 8; ++q) v[q] += __shfl_xor(v[q], o);
__device__ __forceinline__ void wave_sum8(float (&v)[8]) { WS8_STEP(1) WS8_STEP(2) WS8_STEP(4) WS8_STEP(8) WS8_STEP(16) WS8_STEP(32) }
__device__ __forceinline__ float quad_sum(float x) {
    x += __builtin_bit_cast(float, __builtin_amdgcn_update_dpp(0, __builtin_bit_cast(int, x), 0xB1, 0xF, 0xF, true));
    x += __builtin_bit_cast(float, __builtin_amdgcn_update_dpp(0, __builtin_bit_cast(int, x), 0x4E, 0xF, 0xF, true));
    return x;
}
__device__ __forceinline__ float sigmoidf_(float x) { return __builtin_amdgcn_rcpf(1.0f + __expf(-x)); }
__device__ __forceinline__ int crow(int r, int hi) { return (r & 3) + 8 * (r >> 2) + 4 * hi; }
__device__ __forceinline__ bf16x8 pack_bf16x8(float a0, float a1, float a2, float a3, float a4, float a5, float a6, float a7) {
    u32x4 w; w.x = pk2(a0, a1); w.y = pk2(a2, a3); w.z = pk2(a4, a5); w.w = pk2(a6, a7); return __builtin_bit_cast(bf16x8, w);
}

#define XB_TMO      128
#define XB_XCNT(j)  (256  + 64 * (j))
#define XB_XSUB(j)  (1280 + 64 * (j))
#define XB_XGEN(j)  (2304 + 64 * (j))
#define XB_TOP      3328
#define XB_TOPGEN   3392
#define XCD_BAR_WORDS 3456
#define XB_SPIN_CAP (1u << 18)

__device__ __forceinline__ unsigned xb_ld(unsigned* p)              { return __hip_atomic_load(p, __ATOMIC_RELAXED, __HIP_MEMORY_SCOPE_AGENT); }
__device__ __forceinline__ unsigned xb_add(unsigned* p, unsigned v) { return __hip_atomic_fetch_add(p, v, __ATOMIC_RELAXED, __HIP_MEMORY_SCOPE_AGENT); }
__device__ __forceinline__ unsigned xb_xcc_id() { return (unsigned)__builtin_amdgcn_s_getreg((3 << 11) | 20) & 0xFu; }
#define XB_SPIN(cond, bar) do { unsigned _sp = 0; while (cond) { __builtin_amdgcn_s_sleep(1); \
    if ((++_sp & 255u) == 0u) { if (xb_ld(&(bar)[XB_TMO])) break; if (_sp > XB_SPIN_CAP) { atomicAdd(&(bar)[XB_TMO], 1u); break; } } } } while (0)

struct XcdBarrier {
    unsigned* bar; unsigned x;
    volatile LAS unsigned* st;
};

__device__ __forceinline__ XcdBarrier xcd_barrier_post(unsigned* bar, volatile LAS unsigned* st) {
    XcdBarrier b; b.bar = bar; b.x = xb_xcc_id(); b.st = st;
    if (threadIdx.x == 0) (void)xb_add(&bar[XB_XCNT(b.x)], 1u);
    return b;
}
__device__ __forceinline__ void xcd_barrier_complete(unsigned* bar, unsigned x, unsigned& nloc, unsigned& nx) {
    const unsigned G = gridDim.x * gridDim.y * gridDim.z;
    unsigned sum, cnt, mine, sp = 0u;
    for (;;) {
        sum = 0u; cnt = 0u; mine = 0u;
#pragma unroll
        for (unsigned j = 0; j < 16; ++j) { const unsigned c = xb_ld(&bar[XB_XCNT(j)]); sum += c; cnt += (c > 0u) ? 1u : 0u; mine = (j == x) ? c : mine; }
        if (sum == G) break;
        __builtin_amdgcn_s_sleep(1);
        if ((++sp & 255u) == 0u) { if (xb_ld(&bar[XB_TMO])) break; if (sp > XB_SPIN_CAP) { atomicAdd(&bar[XB_TMO], 1u); break; } }
    }
    nloc = mine > 0u ? mine : 1u; nx = cnt > 0u ? cnt : 1u;
}

__device__ __forceinline__ void xcd_barrier(const XcdBarrier& b) {
    asm volatile("s_waitcnt vmcnt(0)" ::: "memory");
    __syncthreads();
    if (threadIdx.x == 0) {
        unsigned* bar = b.bar;
        __builtin_amdgcn_s_waitcnt(0);
        unsigned nloc = b.st[0], nx = b.st[1];
        if (nloc == 0u) { xcd_barrier_complete(bar, b.x, nloc, nx); b.st[0] = nloc; b.st[1] = nx; }
        const unsigned old = xb_add(&bar[XB_XSUB(b.x)], 1u);
        const unsigned gen = old / nloc;
        if (old + 1u == (gen + 1u) * nloc) {
            __builtin_amdgcn_fence(__ATOMIC_RELEASE, "agent");
            asm volatile("s_waitcnt vmcnt(0)" ::: "memory");
            const unsigned og = xb_add(&bar[XB_TOP], 1u);
            const unsigned tg = og / nx;
            if (og + 1u == (tg + 1u) * nx) xb_add(&bar[XB_TOPGEN], 1u);
            else XB_SPIN(xb_ld(&bar[XB_TOPGEN]) == tg, bar);
            __builtin_amdgcn_fence(__ATOMIC_ACQUIRE, "agent");
            xb_add(&bar[XB_XGEN(b.x)], 1u);
            asm volatile("s_waitcnt vmcnt(0)" ::: "memory");
        } else {
            XB_SPIN(xb_ld(&bar[XB_XGEN(b.x)]) == gen, bar);
            __builtin_amdgcn_fence(__ATOMIC_ACQUIRE, "agent");
            asm volatile("s_waitcnt vmcnt(0)" ::: "memory");
        }
    }
    __syncthreads();
}


struct Args { const float* in[N_IN]; float* out; unsigned char* ws; int ph_lo, ph_hi; };
static_assert(sizeof(Args) == N_IN * 8 + 24, "Args has no padding");
struct Frame {
    LAS unsigned char* lds; volatile LAS unsigned* MISC; gu32* ctl;
    int tid, lane, wave, vcu, G;
    const __attribute__((address_space(4))) struct Args* ka; float* out; unsigned char* ws;
};
#define FIN(i) (F.ka->in[i])
#define PHASE_IDS() do { int t_ = threadIdx.x; asm volatile("" : "+v"(t_)); F.tid = t_; F.lane = t_ & 63; F.wave = __builtin_amdgcn_readfirstlane(t_ >> 6); } while (0)
#define WSP(T, off) ((T*)(F.ws + (off)))

__device__ __forceinline__ void fill_rstd(Frame& F, const pg8::StaticOrder& S) {
    int tid = threadIdx.x; asm volatile("" : "+v"(tid)); LAS float* tab = (LAS float*)(F.lds + pg8::RST_OFF); const float* ssq = WSP(float, WS_SSQ);
    pg8::Unit u;
    for (int i0 = 0; S.next(i0, u); i0 += 2) { const int i = i0 + (tid >> 8); if (S.next(i, u)) tab[i * 256 + (tid & 255)] = pg8::row_rstd16(ssq, u.pm * 256 + (tid & 255)); }
    __syncthreads();
}

__device__ __forceinline__ void ph_init(Frame& F) {
    PHASE_IDS();
    const int gw = F.vcu * NWAVES + F.wave, NGW = F.G * NWAVES;
    float* bias = WSP(float, WS_BIAS); const float* relb = FIN(I_RELB);
    for (int i = blockIdx.x * 512 + F.tid; i < NH * 2048; i += F.G * 512) { const int h = i >> 11, n = i & 2047; int bkt;
        if (n < 16) bkt = n; else { const float nf = (float)n; const int lg = 16 + (int)(logf(nf / 16.0f) / 4.1588830833596715f * 16.0f); bkt = lg < 31 ? lg : 31; }
        bias[i] = relb[h * 32 + bkt] * LOG2E; }
    const float* mem = FIN(I_MEM); bf16* memb = WSP(bf16, WS_MEMB); float* memrs = WSP(float, WS_MEMRS);
    for (int r = gw; r < MM; r += NGW) { const f32x4* xr = (const f32x4*)(mem + (size_t)r * DM) + F.lane; f32x4 v[4]; float s = 0.f;
#pragma unroll
        for (int j = 0; j < 4; ++j) { v[j] = xr[64 * j]; s += (v[j].x * v[j].x + v[j].y * v[j].y) + (v[j].z * v[j].z + v[j].w * v[j].w); }
        s = wave_sum(s); u32x2* o = (u32x2*)(memb + (size_t)r * DM) + F.lane;
#pragma unroll
        for (int j = 0; j < 4; ++j) { u32x2 w; w.x = pk2(v[j].x, v[j].y); w.y = pk2(v[j].z, v[j].w); o[64 * j] = w; }
        if (F.lane == 0) memrs[r] = __builtin_amdgcn_rsqf(s * (1.0f / DM) + NORM_EPS); }
    const float* x = FIN(I_X); bf16* xb = WSP(bf16, WS_XB); float* ssq = WSP(float, WS_SSQ);
    for (int r = gw; r < M; r += NGW) { const f32x4* xr = (const f32x4*)(x + (size_t)r * DM) + F.lane; f32x4 v[4]; float s = 0.f;
#pragma unroll
        for (int j = 0; j < 4; ++j) { v[j] = xr[64 * j]; s += (v[j].x * v[j].x + v[j].y * v[j].y) + (v[j].z * v[j].z + v[j].w * v[j].w); }
        s = wave_sum(s); u32x2* o = (u32x2*)(xb + (size_t)r * DM) + F.lane;
#pragma unroll
        for (int j = 0; j < 4; ++j) { u32x2 w; w.x = pk2(v[j].x, v[j].y); w.y = pk2(v[j].z, v[j].w); o[64 * j] = w; }
        if (F.lane < 16) ssq[(size_t)r * 16 + F.lane] = F.lane == 0 ? s : 0.f; }
}

__device__ __forceinline__ void conv_item(const float* W, int K, int N, const float* gk, bf16* WT, int item, bool ffn_in, LAS float* scr, int lane) {
    const int nblk = N / 32, kb = item / nblk, nb = item % nblk, k0 = 64 * kb, n0 = 32 * nb;
    float wv[32];
#pragma unroll
    for (int i = 0; i < 32; ++i) { const int kk = 2 * i + (lane >> 5); wv[i] = W[(size_t)(k0 + kk) * N + n0 + (lane & 31)]; }
    if (gk) {
#pragma unroll
        for (int i = 0; i < 32; ++i) wv[i] *= gk[k0 + 2 * i + (lane >> 5)]; }
#pragma unroll
    for (int i = 0; i < 32; ++i) { const int kk = 2 * i + (lane >> 5); scr[kk * 33 + (lane & 31)] = wv[i]; }
    LDS_WAIT(); asm volatile("" ::: "memory");
    int drow0 = n0; if (ffn_in) drow0 = n0 < DFF ? 256 * (n0 / 128) + (n0 % 128) : 256 * ((n0 - DFF) / 128) + 128 + ((n0 - DFF) % 128);
    const int c = lane & 7;
#pragma unroll
    for (int j = 0; j < 4; ++j) { const int n = (lane >> 3) + 8 * j; const LAS float* s = scr + (8 * c) * 33 + n;
        u32x4 o; o.x = pk2(s[0 * 33], s[1 * 33]); o.y = pk2(s[2 * 33], s[3 * 33]); o.z = pk2(s[4 * 33], s[5 * 33]); o.w = pk2(s[6 * 33], s[7 * 33]);
        *(u32x4*)(WT + (size_t)(drow0 + n) * K + k0 + 8 * c) = o; }
    LDS_WAIT(); asm volatile("" ::: "memory");
}
__device__ __forceinline__ void ph_conv(Frame& F, int l) {
    PHASE_IDS();
    LAS float* scr = (LAS float*)(F.lds + F.wave * 16384);
    const int gw = F.vcu * NWAVES + F.wave, NGW = F.G * NWAVES;
    constexpr int I_FIN = (DM / 64) * (2 * DFF / 32), I_FOUT = (DFF / 64) * (DM / 32), I_MI = (DM / 64) * (DPROJ / 32), I_SQ = (DM / 64) * (DM / 32), I_KV = (DM / 64) * (2 * DM / 32);
    constexpr int I_L64 = (64 / 64) * (RW / 32), I_L128 = (128 / 64) * (RW / 32);
    constexpr int NITEMS = 2 * I_FIN + 2 * I_FOUT + I_MI + 3 * I_SQ + I_KV + 2 * I_L64 + I_L128;
    unsigned char* wb = F.ws + WS_W;
    for (int it = gw; it < NITEMS; it += NGW) { int r = it;
        if (r < I_FIN) { conv_item(FIN(I_F1IN) + (size_t)l * DM * 2 * DFF, DM, 2 * DFF, FIN(I_F1G) + l * DM, (bf16*)(wb + W_F1IN), r, true, scr, F.lane); continue; } r -= I_FIN;
        if (r < I_FIN) { conv_item(FIN(I_F2IN) + (size_t)l * DM * 2 * DFF, DM, 2 * DFF, FIN(I_F2G) + l * DM, (bf16*)(wb + W_F2IN), r, true, scr, F.lane); continue; } r -= I_FIN;
        if (r < I_FOUT) { conv_item(FIN(I_F1OUT) + (size_t)l * DFF * DM, DFF, DM, nullptr, (bf16*)(wb + W_F1OUT), r, false, scr, F.lane); continue; } r -= I_FOUT;
        if (r < I_FOUT) { conv_item(FIN(I_F2OUT) + (size_t)l * DFF * DM, DFF, DM, nullptr, (bf16*)(wb + W_F2OUT), r, false, scr, F.lane); continue; } r -= I_FOUT;
        if (r < I_MI) { conv_item(FIN(I_MIXIN) + (size_t)l * DM * DPROJ, DM, DPROJ, FIN(I_MIXG) + l * DM, (bf16*)(wb + W_MIXIN), r, false, scr, F.lane); continue; } r -= I_MI;
        if (r < I_SQ) { conv_item(FIN(I_MIXOUT) + (size_t)l * DM * DM, DM, DM, nullptr, (bf16*)(wb + W_MIXOUT), r, false, scr, F.lane); continue; } r -= I_SQ;
        if (r < I_SQ) { conv_item(FIN(I_WQ) + (size_t)l * DM * DM, DM, DM, FIN(I_XG) + l * DM, (bf16*)(wb + W_WQ), r, false, scr, F.lane); continue; } r -= I_SQ;
        if (r < I_SQ) { conv_item(FIN(I_WO) + (size_t)l * DM * DM, DM, DM, nullptr, (bf16*)(wb + W_WO), r, false, scr, F.lane); continue; } r -= I_SQ;
        if (r < I_KV) { conv_item(FIN(I_WKV) + (size_t)l * DM * 2 * DM, DM, 2 * DM, FIN(I_MEMG) + l * DM, (bf16*)(wb + W_WKV), r, false, scr, F.lane); continue; } r -= I_KV;
        if (r < I_L64) { conv_item(FIN(I_WUP) + (size_t)l * 64 * RW, 64, RW, nullptr, (bf16*)(wb + W_WUPT), r, false, scr, F.lane); continue; } r -= I_L64;
        if (r < I_L64) { conv_item(FIN(I_AUP) + (size_t)l * 64 * RW, 64, RW, nullptr, (bf16*)(wb + W_AUPT), r, false, scr, F.lane); continue; } r -= I_L64;
        conv_item(FIN(I_GUP) + (size_t)l * 128 * RW, 128, RW, nullptr, (bf16*)(wb + W_GUPT), r, false, scr, F.lane);
    }
}

__device__ __forceinline__ void ph_moba(Frame& F) {
    PHASE_IDS();
    constexpr int KROW = 144, KBUF = 64 * KROW, OFF_K = 12288, OFF_V = OFF_K + 2 * KBUF;
    LAS float* kmean = (LAS float*)F.lds;
    LAS float* btab = (LAS float*)(F.lds + 2048);
    volatile LAS unsigned* needw = (volatile LAS unsigned*)(F.lds + 10240);
    const bf16* MQ = WSP(bf16, AR_MQ); const bf16* MK = WSP(bf16, AR_MK); const bf16* MVT = WSP(bf16, AR_MVT); bf16* XB = WSP(bf16, WS_XB); const float* bias = WSP(float, WS_BIAS);
    const int lane = F.lane, r32 = lane & 31, hi = lane >> 5, wave = F.wave, tid = F.tid;
    for (int u = blockIdx.x; u < 512; u += F.G) {
        const int rnd = u >> 8, iu = u & 255, qsel = iu >> 6, bh = iu & 63, qb = rnd == 0 ? 7 - qsel : qsel, b = bh >> 3, hh = bh & 7;
        __syncthreads();
        { const int n = tid >> 6, d = tid & 63;
          if (n < qb) { const float* kp = WSP(float, WS_KMS) + ((size_t)(b * 8 + n) * 2) * 512 + hh * 64 + d; kmean[n * 64 + d] = (kp[0] + kp[512]) * (1.0f / 256.0f); }
          for (int i2 = tid; i2 < 2048; i2 += 512) btab[i2] = bias[hh * 2048 + i2];
          if (tid == 0) needw[0] = 0u; }
        __syncthreads();
        const int q0 = qb * 256 + wave * 32; const size_t tok = (size_t)b * 2048 + q0 + r32;
        bf16x8 qf[4];
#pragma unroll
        for (int s = 0; s < 4; ++s) qf[s] = *(const bf16x8*)(MQ + tok * 512 + hh * 64 + 16 * s + 8 * hi);
        float g[7]; unsigned selmask = 0u;
#pragma unroll
        for (int n = 0; n < 7; ++n) { g[n] = -INFINITY;
            if (n < qb) { float p = 0.f;
#pragma unroll
                for (int s = 0; s < 4; ++s) { const f32x4 k0v = *(const LAS f32x4*)(kmean + n * 64 + 16 * s + 8 * hi), k1v = *(const LAS f32x4*)(kmean + n * 64 + 16 * s + 8 * hi + 4);
                    p += bf2f((unsigned short)qf[s][0]) * k0v[0] + bf2f((unsigned short)qf[s][1]) * k0v[1] + bf2f((unsigned short)qf[s][2]) * k0v[2] + bf2f((unsigned short)qf[s][3]) * k0v[3]
                       + bf2f((unsigned short)qf[s][4]) * k1v[0] + bf2f((unsigned short)qf[s][5]) * k1v[1] + bf2f((unsigned short)qf[s][6]) * k1v[2] + bf2f((unsigned short)qf[s][7]) * k1v[3]; }
                p += __shfl_xor(p, 32); g[n] = p; } }
        if (qb <= 3) selmask = (1u << qb) - 1u;
        else {
#pragma unroll
            for (int n = 0; n < 7; ++n) if (n < qb) { int cnt = 0;
#pragma unroll
                for (int n2 = 0; n2 < 7; ++n2) if (n2 != n && n2 < qb) cnt += (g[n2] > g[n] || (g[n2] == g[n] && n2 < n)) ? 1 : 0;
                if (cnt < 3) selmask |= 1u << n; } }
        unsigned wmask = 0u;
#pragma unroll
        for (int n = 0; n < 7; ++n) if (__ballot((selmask >> n) & 1u) != 0ull) wmask |= 1u << n;
        if (lane == 0 && wmask) __hip_atomic_fetch_or((LAS unsigned*)needw, wmask, __ATOMIC_RELAXED, __HIP_MEMORY_SCOPE_WORKGROUP);
        __syncthreads();
        const unsigned need = needw[0] | (1u << qb);
        float mrun = -INFINITY, lrun = 0.f; f32x16 o0, o1;
#pragma unroll
        for (int i = 0; i < 16; ++i) { o0[i] = 0.f; o1[i] = 0.f; }
        const int qpos = q0 + r32;
        const bf16* Kg = MK + ((size_t)b * 2048 + (tid >> 3)) * 512 + hh * 64 + (tid & 7) * 8;
        const bf16* Vg = MVT + ((size_t)(b * 8 + hh) * 64 + (tid >> 3)) * 2048 + (tid & 7) * 8;
        const int sto = (tid >> 3) * KROW + (tid & 7) * 16;
        int blk = 0; while (!((need >> blk) & 1u)) ++blk;
        int kt = 0, it = 0;
        { const int k0 = blk * 256; const u32x4 kr = *(const u32x4*)(Kg + (size_t)k0 * 512), vr = *(const u32x4*)(Vg + k0);
          *(LAS u32x4*)(F.lds + OFF_K + sto) = kr; *(LAS u32x4*)(F.lds + OFF_V + sto) = vr; }
        __syncthreads();
        while (blk <= qb) {
            int nblk = blk, nkt = kt + 1; if (nkt == 4) { nkt = 0; ++nblk; while (nblk <= qb && !((need >> nblk) & 1u)) ++nblk; }
            const bool more = nblk <= qb; u32x4 kr, vr;
            if (more) { const int k0n = nblk * 256 + nkt * 64; kr = *(const u32x4*)(Kg + (size_t)k0n * 512); vr = *(const u32x4*)(Vg + k0n); }
            const int k0 = blk * 256 + kt * 64; const bool own = blk == qb; const bool selme = own || ((selmask >> blk) & 1u);
            const bool active = own ? (k0 <= q0 + 31) : (__ballot(selme) != 0ull);
            if (active) {
                const LAS unsigned char* kb = F.lds + OFF_K + (it & 1) * KBUF + r32 * KROW + 16 * hi;
                const LAS unsigned char* vb = F.lds + OFF_V + (it & 1) * KBUF + r32 * KROW + 16 * hi;
                const bool h1 = !own || (k0 + 32 <= q0 + 31);
                f32x16 s0, s1;
#pragma unroll
                for (int i = 0; i < 16; ++i) { s0[i] = 0.f; s1[i] = 0.f; }
                bf16x8 kf[8];
#pragma unroll
                for (int s = 0; s < 4; ++s) { kf[s] = *(const LAS bf16x8*)(kb + 32 * s); kf[4 + s] = *(const LAS bf16x8*)(kb + 32 * KROW + 32 * s); }
#pragma unroll
                for (int s = 0; s < 4; ++s) s0 = __builtin_amdgcn_mfma_f32_32x32x16_bf16(kf[s], qf[s], s0, 0, 0, 0);
                if (h1) {
#pragma unroll
                    for (int s = 0; s < 4; ++s) s1 = __builtin_amdgcn_mfma_f32_32x32x16_bf16(kf[4 + s], qf[s], s1, 0, 0, 0); }
                bf16x8 vf[8];
#pragma unroll
                for (int s = 0; s < 4; ++s) { vf[s] = *(const LAS bf16x8*)(vb + 32 * s); vf[4 + s] = *(const LAS bf16x8*)(vb + 32 * KROW + 32 * s); }
                float mx = -INFINITY;
                float bv0[16], bv1[16];
#pragma unroll
                for (int r = 0; r < 16; ++r) { const int d0 = qpos - (k0 + crow(r, hi)), d1 = d0 - 32; bv0[r] = btab[d0 < 0 ? 0 : d0]; bv1[r] = btab[d1 < 0 ? 0 : d1]; }
#pragma unroll
                for (int r = 0; r < 16; ++r) asm volatile("" : "+v"(bv0[r]), "+v"(bv1[r]));
#pragma unroll
                for (int r = 0; r < 16; ++r) { const int d0 = qpos - (k0 + crow(r, hi)), d1 = d0 - 32;
                    const bool v0 = selme && (!own || d0 >= 0), v1 = h1 && selme && (!own || d1 >= 0);
                    const float a0 = v0 ? s0[r] + bv0[r] : -INFINITY, a1 = v1 ? s1[r] + bv1[r] : -INFINITY;
                    s0[r] = a0; s1[r] = a1; mx = fmaxf(mx, fmaxf(a0, a1)); }
                mx = fmaxf(mx, __shfl_xor(mx, 32));
                const float mnew = fmaxf(mrun, mx), muse = (mnew == -INFINITY) ? 0.f : mnew;
                const float alpha = __builtin_amdgcn_exp2f(mrun - muse);
                float ps = 0.f;
#pragma unroll
                for (int r = 0; r < 16; ++r) { const float p0 = __builtin_amdgcn_exp2f(s0[r] - muse), p1 = __builtin_amdgcn_exp2f(s1[r] - muse); s0[r] = p0; s1[r] = p1; ps += p0 + p1; }
                lrun = lrun * alpha + ps; mrun = mnew;
#pragma unroll
                for (int i = 0; i < 16; ++i) { o0[i] *= alpha; o1[i] *= alpha; }
                const bf16x8 pa0 = pack_bf16x8(s0[0], s0[1], s0[2], s0[3], s0[4], s0[5], s0[6], s0[7]), pa1 = pack_bf16x8(s0[8], s0[9], s0[10], s0[11], s0[12], s0[13], s0[14], s0[15]);
                o0 = __builtin_amdgcn_mfma_f32_32x32x16_bf16(vf[0], pa0, o0, 0, 0, 0); o0 = __builtin_amdgcn_mfma_f32_32x32x16_bf16(vf[1], pa1, o0, 0, 0, 0);
                o1 = __builtin_amdgcn_mfma_f32_32x32x16_bf16(vf[4], pa0, o1, 0, 0, 0); o1 = __builtin_amdgcn_mfma_f32_32x32x16_bf16(vf[5], pa1, o1, 0, 0, 0);
                if (h1) {
                    const bf16x8 pb0 = pack_bf16x8(s1[0], s1[1], s1[2], s1[3], s1[4], s1[5], s1[6], s1[7]), pb1 = pack_bf16x8(s1[8], s1[9], s1[10], s1[11], s1[12], s1[13], s1[14], s1[15]);
                    o0 = __builtin_amdgcn_mfma_f32_32x32x16_bf16(vf[2], pb0, o0, 0, 0, 0); o0 = __builtin_amdgcn_mfma_f32_32x32x16_bf16(vf[3], pb1, o0, 0, 0, 0);
                    o1 = __builtin_amdgcn_mfma_f32_32x32x16_bf16(vf[6], pb0, o1, 0, 0, 0); o1 = __builtin_amdgcn_mfma_f32_32x32x16_bf16(vf[7], pb1, o1, 0, 0, 0); }
            }
            if (more) { *(LAS u32x4*)(F.lds + OFF_K + ((it + 1) & 1) * KBUF + sto) = kr; *(LAS u32x4*)(F.lds + OFF_V + ((it + 1) & 1) * KBUF + sto) = vr; }
            __syncthreads();
            blk = nblk; kt = nkt; ++it;
        }
        lrun += __shfl_xor(lrun, 32); const float inv = 1.0f / lrun;
        bf16* op = XB + tok * 1024 + 512 + hh * 64 + 4 * hi;
#pragma unroll
        for (int g4 = 0; g4 < 4; ++g4) { u32x2 w0, w1; w0.x = pk2(o0[4 * g4] * inv, o0[4 * g4 + 1] * inv); w0.y = pk2(o0[4 * g4 + 2] * inv, o0[4 * g4 + 3] * inv);
            w1.x = pk2(o1[4 * g4] * inv, o1[4 * g4 + 1] * inv); w1.y = pk2(o1[4 * g4 + 2] * inv, o1[4 * g4 + 3] * inv);
            *(u32x2*)(op + 8 * g4) = w0; *(u32x2*)(op + 32 + 8 * g4) = w1; }
    }
}

__device__ __forceinline__ void ph_xatt(Frame& F, const pg8::StaticOrder& S) {
    PHASE_IDS();
    constexpr int KROW = 528, KBUF = 32 * KROW, VROW = 80, VBUF = 256 * VROW, OFF_K = 0, OFF_V = 2 * KBUF;
    const bf16* XQ = WSP(bf16, AR_XQ); const bf16* XK = WSP(bf16, WS_XK); const bf16* XVT = WSP(bf16, WS_XVT); bf16* XO = WSP(bf16, AR_XO);
    const int lane = F.lane, r32 = lane & 31, hi = lane >> 5, wave = F.wave, tid = F.tid;
    pg8::Unit un;
    for (int ui = 0; S.next(ui, un); ++ui) {
        const int b = un.pm >> 3, hx = un.pn, qt = un.pm & 7;
        const size_t tok = (size_t)b * 2048 + qt * 256 + wave * 32 + r32;
        const bf16* Qg = XQ + tok * 1024 + hx * 256 + 8 * hi;
        const bf16* Kg = XK + (size_t)(b * 256 + (tid >> 5)) * 1024 + hx * 256 + (tid & 31) * 8;
        const bf16* Vg = XVT + ((size_t)(b * 4 + hx) * 256 + (tid >> 2)) * 256 + (tid & 3) * 8;
        const int ksto = (tid >> 5) * KROW + (tid & 31) * 16, vsto = (tid >> 2) * VROW + (tid & 3) * 16;
        float mrun = -INFINITY, lrun = 0.f; f32x16 o[8];
#pragma unroll
        for (int dt = 0; dt < 8; ++dt)
#pragma unroll
            for (int i = 0; i < 16; ++i) o[dt][i] = 0.f;
        __syncthreads();
        { const u32x4 k0r = *(const u32x4*)(Kg), k1r = *(const u32x4*)(Kg + (size_t)16 * 1024), v0r = *(const u32x4*)(Vg), v1r = *(const u32x4*)(Vg + (size_t)128 * 256);
          *(LAS u32x4*)(F.lds + OFF_K + ksto) = k0r; *(LAS u32x4*)(F.lds + OFF_K + ksto + 16 * KROW) = k1r; *(LAS u32x4*)(F.lds + OFF_V + vsto) = v0r; *(LAS u32x4*)(F.lds + OFF_V + vsto + 128 * VROW) = v1r; }
        __syncthreads();
        for (int kt = 0; kt < 8; ++kt) {
            const bool more = kt + 1 < 8; const int k0n = (kt + 1) * 32; u32x4 s0r, s1r;
            if (more) { s0r = *(const u32x4*)(Kg + (size_t)k0n * 1024); s1r = *(const u32x4*)(Kg + (size_t)(k0n + 16) * 1024); }
            const LAS unsigned char* kb = F.lds + OFF_K + (kt & 1) * KBUF + r32 * KROW + 16 * hi;
            const LAS unsigned char* vb = F.lds + OFF_V + (kt & 1) * VBUF + r32 * VROW + 16 * hi;
            f32x16 sc;
#pragma unroll
            for (int i = 0; i < 16; ++i) sc[i] = 0.f;
            bf16x8 qa[4], qb[4];
#pragma unroll
            for (int s = 0; s < 4; ++s) qa[s] = *(const bf16x8*)(Qg + 16 * s);
#pragma unroll
            for (int s = 0; s < 4; ++s) qb[s] = *(const bf16x8*)(Qg + 64 + 16 * s);
#pragma unroll
            for (int s = 0; s < 4; ++s) sc = __builtin_amdgcn_mfma_f32_32x32x16_bf16(*(const LAS bf16x8*)(kb + 32 * s), qa[s], sc, 0, 0, 0);
            asm volatile("" ::: "memory");
#pragma unroll
            for (int s = 0; s < 4; ++s) qa[s] = *(const bf16x8*)(Qg + 128 + 16 * s);
#pragma unroll
            for (int s = 0; s < 4; ++s) sc = __builtin_amdgcn_mfma_f32_32x32x16_bf16(*(const LAS bf16x8*)(kb + 128 + 32 * s), qb[s], sc, 0, 0, 0);
            asm volatile("" ::: "memory");
#pragma unroll
            for (int s = 0; s < 4; ++s) qb[s] = *(const bf16x8*)(Qg + 192 + 16 * s);
#pragma unroll
            for (int s = 0; s < 4; ++s) sc = __builtin_amdgcn_mfma_f32_32x32x16_bf16(*(const LAS bf16x8*)(kb + 256 + 32 * s), qa[s], sc, 0, 0, 0);
            asm volatile("" ::: "memory");
#pragma unroll
            for (int s = 0; s < 4; ++s) sc = __builtin_amdgcn_mfma_f32_32x32x16_bf16(*(const LAS bf16x8*)(kb + 384 + 32 * s), qb[s], sc, 0, 0, 0);
            if (more) { LAS unsigned char* kd = F.lds + OFF_K + ((kt + 1) & 1) * KBUF + ksto; *(LAS u32x4*)(kd) = s0r; *(LAS u32x4*)(kd + 16 * KROW) = s1r;
                s0r = *(const u32x4*)(Vg + k0n); s1r = *(const u32x4*)(Vg + (size_t)128 * 256 + k0n); }
            float mx = sc[0];
#pragma unroll
            for (int r = 1; r < 16; ++r) mx = fmaxf(mx, sc[r]);
            mx = fmaxf(mx, __shfl_xor(mx, 32));
            const float mnew = fmaxf(mrun, mx), alpha = __builtin_amdgcn_exp2f(mrun - mnew);
            float ps = 0.f;
#pragma unroll
            for (int r = 0; r < 16; ++r) { const float p = __builtin_amdgcn_exp2f(sc[r] - mnew); sc[r] = p; ps += p; }
            lrun = lrun * alpha + ps; mrun = mnew;
            const bf16x8 pf0 = pack_bf16x8(sc[0], sc[1], sc[2], sc[3], sc[4], sc[5], sc[6], sc[7]), pf1 = pack_bf16x8(sc[8], sc[9], sc[10], sc[11], sc[12], sc[13], sc[14], sc[15]);
#pragma unroll
            for (int dt = 0; dt < 8; ++dt) {
#pragma unroll
                for (int i = 0; i < 16; ++i) o[dt][i] *= alpha;
                o[dt] = __builtin_amdgcn_mfma_f32_32x32x16_bf16(*(const LAS bf16x8*)(vb + dt * 32 * VROW), pf0, o[dt], 0, 0, 0);
                o[dt] = __builtin_amdgcn_mfma_f32_32x32x16_bf16(*(const LAS bf16x8*)(vb + dt * 32 * VROW + 32), pf1, o[dt], 0, 0, 0); }
            if (more) { LAS unsigned char* vd = F.lds + OFF_V + ((kt + 1) & 1) * VBUF + vsto; *(LAS u32x4*)(vd) = s0r; *(LAS u32x4*)(vd + 128 * VROW) = s1r; }
            __syncthreads();
        }
        lrun += __shfl_xor(lrun, 32); const float inv = 1.0f / lrun;
        bf16* op = XO + tok * 1024 + hx * 256 + 4 * hi;
#pragma unroll
        for (int dt = 0; dt < 8; ++dt)
#pragma unroll
            for (int g4 = 0; g4 < 4; ++g4) { u32x2 w; w.x = pk2(o[dt][4 * g4] * inv, o[dt][4 * g4 + 1] * inv); w.y = pk2(o[dt][4 * g4 + 2] * inv, o[dt][4 * g4 + 3] * inv);
                *(u32x2*)(op + 32 * dt + 8 * g4) = w; }
    }
}

#ifndef SUBREP
#define SUBREP 0
#endif
#define SUBLOOP(id) for (int sr_ = 0; sr_ < ((SUBREP == (id)) ? 2 : 1); ++sr_)
__device__ __forceinline__ void ph_prep(Frame& F, int l) {
    PHASE_IDS();
    constexpr int SROW = 3080, OFF_LAT = 33 * SROW + 8, LROW = 528, OFF_PAR = OFF_LAT + 32 * LROW;
    static_assert(OFF_LAT % 16 == 0 && OFF_PAR % 16 == 0 && OFF_PAR + 8 * 512 * 4 <= PHASE_LDS, "prep LDS map");
    LAS unsigned char* rows = F.lds; LAS unsigned char* lat = F.lds + OFF_LAT; LAS float* par = (LAS float*)(F.lds + OFF_PAR);
    const bf16* PR = WSP(bf16, AR_PR); bf16* SCANIN = WSP(bf16, AR_SCANIN); bf16* SV = WSP(bf16, AR_SV); bf16* XB = WSP(bf16, WS_XB); float* BONUS = WSP(float, WS_BONUS);
    const bf16* WUPT = (const bf16*)(F.ws + WS_W + W_WUPT); const bf16* AUPT = (const bf16*)(F.ws + WS_W + W_AUPT); const bf16* GUPT = (const bf16*)(F.ws + WS_W + W_GUPT);
    const int h = F.wave, lane = F.lane, r32 = lane & 31, hi = lane >> 5, tid = F.tid;
    const float* mu = FIN(I_MU) + l * RPROJ;
    __syncthreads();
    { const int c = tid;
      par[c] = mu[c]; par[512 + c] = mu[512 + c]; par[1024 + c] = mu[1024 + c]; par[1536 + c] = FIN(I_W0)[l * RW + c]; par[2048 + c] = FIN(I_A0)[l * RW + c];
      par[2560 + c] = FIN(I_KK)[l * RW + c]; par[3072 + c] = FIN(I_KA)[l * RW + c]; par[3584 + c] = FIN(I_RK)[l * RW + c]; }
    for (int task = blockIdx.x; task < M / 32; task += F.G) { const int t0 = task * 32;
        __syncthreads();
        SUBLOOP(1) {
          u32x4 st[13];
#pragma unroll
          for (int i = 0; i < 13; ++i) { const int q = tid + 512 * i; st[i] = (u32x4){0u, 0u, 0u, 0u};
              if (q < 33 * 192) { const int row = q / 192, c16 = q - row * 192; if (row > 0 || (t0 & 2047) != 0) st[i] = *(const u32x4*)(PR + (size_t)(t0 - 1 + row) * RPROJ + c16 * 8); } }
#pragma unroll
          for (int i = 0; i < 13; ++i) { const int q = tid + 512 * i;
              if (q < 33 * 192) { const int row = q / 192, c16 = q - row * 192; LAS unsigned char* d = rows + row * SROW + c16 * 16; *(LAS u32x2*)d = (u32x2){st[i].x, st[i].y}; *(LAS u32x2*)(d + 8) = (u32x2){st[i].z, st[i].w}; } } }
        SUBLOOP(2) {
          const int tt = tid >> 4, l16 = (tid & 15) * 16, t = t0 + tt; const bf16* pc = PR + (size_t)t * RPROJ + 1536 + l16;
          u32x4 cur[2], prv[2]; cur[0] = *(const u32x4*)pc; cur[1] = *(const u32x4*)(pc + 8); prv[0] = (u32x4){0u, 0u, 0u, 0u}; prv[1] = prv[0];
          if (t & 2047) { prv[0] = *(const u32x4*)(pc - RPROJ); prv[1] = *(const u32x4*)(pc - RPROJ + 8); }
          u32x4 ow[2];
#pragma unroll
          for (int hh = 0; hh < 2; ++hh) { const f32x4 m0 = *(const f32x4*)(mu + 1536 + l16 + 8 * hh), m1 = *(const f32x4*)(mu + 1536 + l16 + 8 * hh + 4); float xv[8];
#pragma unroll
              for (int i = 0; i < 4; ++i) { const unsigned cw = cur[hh][i], pw = prv[hh][i]; const float p0 = bf2f(cw & 0xffffu), p1 = bf2f(cw >> 16), q0 = bf2f(pw & 0xffffu), q1 = bf2f(pw >> 16);
                  const float ma = i < 2 ? m0[2 * i] : m1[2 * i - 4], mb = i < 2 ? m0[2 * i + 1] : m1[2 * i - 3];
                  xv[2 * i] = p0 + (q0 - p0) * ma; xv[2 * i + 1] = p1 + (q1 - p1) * mb; }
#pragma unroll
              for (int i = 0; i < 8; ++i) { if (l16 < 64) xv[i] = 1.0f - 2.0f * __builtin_amdgcn_rcpf(1.0f + __expf(2.0f * xv[i])); else if (l16 >= 128) xv[i] = sigmoidf_(xv[i]); }
              ow[hh] = (u32x4){pk2(xv[0], xv[1]), pk2(xv[2], xv[3]), pk2(xv[4], xv[5]), pk2(xv[6], xv[7])}; }
          *(LAS u32x4*)(lat + tt * LROW + l16 * 2) = ow[0]; *(LAS u32x4*)(lat + tt * LROW + l16 * 2 + 16) = ow[1]; }
        __syncthreads();
        const int t = t0 + r32, bb = t >> 11, tp = t & 2047, bh = bb * 8 + h;
        const LAS unsigned char* rc = rows + (r32 + 1) * SROW; const LAS unsigned char* rp = rows + r32 * SROW;
        float n2 = 0.f, bon = 0.f;
#pragma unroll
        for (int q = 0; q < 8; ++q) { const int c4 = h * 64 + 8 * q + 4 * hi;
            const u32x2 kc = *(const LAS u32x2*)(rc + (512 + c4) * 2), kp = *(const LAS u32x2*)(rp + (512 + c4) * 2);
            const f32x4 mk = *(const LAS f32x4*)(par + 512 + c4), kkc = *(const LAS f32x4*)(par + 2560 + c4);
#pragma unroll
            for (int i = 0; i < 4; ++i) { const unsigned sh = (i & 1) * 16; float k = bf2f((kc[i >> 1] >> sh) & 0xffffu); const float kq = bf2f((kp[i >> 1] >> sh) & 0xffffu);
                k += (kq - k) * mk[i]; const float kk = k * kkc[i]; n2 += kk * kk; } }
        n2 += __shfl_xor(n2, 32);
        const float inv = 1.0f / fmaxf(sqrtf(n2), 1e-12f);
        bf16* so = SCANIN + ((size_t)(bh * 64 + (tp >> 5)) * 10) * 1024 + lane * 16;
        SUBLOOP(3) { bon = 0.f;
#pragma unroll 1
        for (int ct = 0; ct < 2; ++ct) { const int cb = h * 64 + 32 * ct;
            f32x16 aw, aa, ag;
#pragma unroll
            for (int i = 0; i < 16; ++i) { aw[i] = 0.f; aa[i] = 0.f; ag[i] = 0.f; }
            const LAS unsigned char* lb = lat + r32 * LROW + 16 * hi;
#pragma unroll
            for (int s = 0; s < 4; ++s) { const bf16x8 wf = *(const bf16x8*)(WUPT + (size_t)(cb + r32) * 64 + 16 * s + 8 * hi), af = *(const bf16x8*)(AUPT + (size_t)(cb + r32) * 64 + 16 * s + 8 * hi);
                const bf16x8 lw = *(const LAS bf16x8*)(lb + 32 * s), la = *(const LAS bf16x8*)(lb + 128 + 32 * s);
                aw = __builtin_amdgcn_mfma_f32_32x32x16_bf16(wf, lw, aw, 0, 0, 0); aa = __builtin_amdgcn_mfma_f32_32x32x16_bf16(af, la, aa, 0, 0, 0); }
#pragma unroll
            for (int s = 0; s < 8; ++s) { const bf16x8 gf = *(const bf16x8*)(GUPT + (size_t)(cb + r32) * 128 + 16 * s + 8 * hi); const bf16x8 lg = *(const LAS bf16x8*)(lb + 256 + 32 * s);
                ag = __builtin_amdgcn_mfma_f32_32x32x16_bf16(gf, lg, ag, 0, 0, 0); }
            unsigned onk[8], old_[8], obv[8], okt[8], orr[8];
#pragma unroll
            for (int g = 0; g < 4; ++g) { const int c4 = cb + 8 * g + 4 * hi;
                const u32x2 rcv = *(const LAS u32x2*)(rc + c4 * 2), kcv = *(const LAS u32x2*)(rc + (512 + c4) * 2), vcv = *(const LAS u32x2*)(rc + (1024 + c4) * 2);
                const u32x2 rpv = *(const LAS u32x2*)(rp + c4 * 2), kpv = *(const LAS u32x2*)(rp + (512 + c4) * 2), vpv = *(const LAS u32x2*)(rp + (1024 + c4) * 2);
                const f32x4 mr = *(const LAS f32x4*)(par + c4), mk = *(const LAS f32x4*)(par + 512 + c4), mv = *(const LAS f32x4*)(par + 1024 + c4);
                const f32x4 w0v = *(const LAS f32x4*)(par + 1536 + c4), a0v = *(const LAS f32x4*)(par + 2048 + c4), kkc = *(const LAS f32x4*)(par + 2560 + c4), kac = *(const LAS f32x4*)(par + 3072 + c4), rkc = *(const LAS f32x4*)(par + 3584 + c4);
                float ro[4], ko[4], vo[4], ldo[4], go[4], nk[4], bo[4];
#pragma unroll
                for (int i = 0; i < 4; ++i) { const unsigned sh = (i & 1) * 16;
                    float r = bf2f((rcv[i >> 1] >> sh) & 0xffffu), k = bf2f((kcv[i >> 1] >> sh) & 0xffffu), v = bf2f((vcv[i >> 1] >> sh) & 0xffffu);
                    const float rq = bf2f((rpv[i >> 1] >> sh) & 0xffffu), kq = bf2f((kpv[i >> 1] >> sh) & 0xffffu), vq = bf2f((vpv[i >> 1] >> sh) & 0xffffu);
                    r += (rq - r) * mr[i]; k += (kq - k) * mk[i]; v += (vq - v) * mv[i];
                    const float wv = w0v[i] + aw[4 * g + i], ld = -0.60653065971263342f * sigmoidf_(wv);
                    const float a = sigmoidf_(a0v[i] + aa[4 * g + i]);
                    const float kn = k * kkc[i] * inv, kt = k * (1.0f + (a - 1.0f) * kac[i]);
                    bon += r * kt * rkc[i];
                    ro[i] = r; ko[i] = kt; vo[i] = v; ldo[i] = ld; go[i] = ag[4 * g + i]; nk[i] = -kn; bo[i] = kn * a; }
                onk[2 * g] = pk2(nk[0], nk[1]); onk[2 * g + 1] = pk2(nk[2], nk[3]); old_[2 * g] = pk2(ldo[0], ldo[1]); old_[2 * g + 1] = pk2(ldo[2], ldo[3]);
                obv[2 * g] = pk2(bo[0], bo[1]); obv[2 * g + 1] = pk2(bo[2], bo[3]); okt[2 * g] = pk2(ko[0], ko[1]); okt[2 * g + 1] = pk2(ko[2], ko[3]);
                orr[2 * g] = pk2(ro[0], ro[1]); orr[2 * g + 1] = pk2(ro[2], ro[3]);
                *(u32x2*)(SV + ((size_t)bh * 2048 + tp) * 64 + 32 * ct + 8 * g + 4 * hi) = (u32x2){pk2(vo[0], vo[1]), pk2(vo[2], vo[3])};
                *(u32x2*)(XB + (size_t)t * 1024 + c4) = (u32x2){pk2(go[0], go[1]), pk2(go[2], go[3])}; }
            bf16* sq = so + ct * 1024;
            *(u32x4*)(sq) = (u32x4){onk[0], onk[1], onk[2], onk[3]}; *(u32x4*)(sq + 8) = (u32x4){onk[4], onk[5], onk[6], onk[7]};
            *(u32x4*)(sq + 2048) = (u32x4){old_[0], old_[1], old_[2], old_[3]}; *(u32x4*)(sq + 2048 + 8) = (u32x4){old_[4], old_[5], old_[6], old_[7]};
            *(u32x4*)(sq + 4096) = (u32x4){obv[0], obv[1], obv[2], obv[3]}; *(u32x4*)(sq + 4096 + 8) = (u32x4){obv[4], obv[5], obv[6], obv[7]};
            *(u32x4*)(sq + 6144) = (u32x4){okt[0], okt[1], okt[2], okt[3]}; *(u32x4*)(sq + 6144 + 8) = (u32x4){okt[4], okt[5], okt[6], okt[7]};
            *(u32x4*)(sq + 8192) = (u32x4){orr[0], orr[1], orr[2], orr[3]}; *(u32x4*)(sq + 8192 + 8) = (u32x4){orr[4], orr[5], orr[6], orr[7]};
        } }
        bon += __shfl_xor(bon, 32);
        if (hi == 0) BONUS[(size_t)t * 8 + h] = bon;
    }
}

template <int R, int NCH, bool KINDP>
__device__ __forceinline__ void scan_stream(Frame& F, LAS float* ring, int bh, int ch, int rg, int lis) {
    typedef float f32x2 __attribute__((ext_vector_type(2)));
    constexpr int CLEN = SEQ / NCH, NHALF = CLEN / 8;
    const int lane = F.lane, js = lane & 3, q = lane >> 2, row0 = rg * 16 * R + q * R, tbase = ch * CLEN;
    const bf16* src5 = WSP(bf16, AR_SCANIN) + (size_t)bh * 64 * 10 * 1024; const bf16* srcv = WSP(bf16, AR_SV) + (size_t)bh * 2048 * 64;
    float* YL = WSP(float, AR_YLOC) + ((size_t)bh * 2048 + tbase) * 64; bf16* ZZ = WSP(bf16, AR_Z) + ((size_t)bh * 2048 + tbase) * 64;
    int soff[2], doff[2]; bool isv[2], isld[2], cval[2];
#pragma unroll
    for (int k = 0; k < 2; ++k) { int ci = lis + k * 256; cval[k] = ci < 384; if (!cval[k]) ci = lis; isv[k] = ci >= 320;
        const int run = ci >> 4, vec = run >> 2, ct = (run >> 1) & 1, hi2 = run & 1, tok = (ci & 15) >> 1, hf16 = ci & 1, cv = ci - 320;
        isld[k] = !isv[k] && vec == 1;
        soff[k] = isv[k] ? (cv >> 3) * 64 + (cv & 7) * 8 : ((vec * 2 + ct) * 64 + hi2 * 32 + tok) * 16 + 8 * hf16;
        doff[k] = isv[k] ? (cv >> 3) * 384 + 320 + (cv & 7) * 8 : tok * 384 + vec * 64 + 32 * ct + 16 * hf16 + 4 * hi2; }
#define SCAN_LOAD(hfx) do { const int tg_ = tbase + (hfx) * 8; _Pragma("unroll") for (int k = 0; k < 2; ++k) {   \
        const bf16* p_ = isv[k] ? srcv + (size_t)tg_ * 64 + soff[k] : src5 + (size_t)(tg_ >> 5) * 10240 + (tg_ & 31) * 16 + soff[k]; pre[k] = *(const u32x4*)p_; } } while (0)
#define SCAN_WRITE(hfx) do { _Pragma("unroll") for (int k = 0; k < 2; ++k) if (cval[k]) { float f[8]; \
        _Pragma("unroll") for (int i = 0; i < 4; ++i) { f[2 * i] = bf2f(pre[k][i] & 0xffffu); f[2 * i + 1] = bf2f(pre[k][i] >> 16); } \
        if (isld[k]) { _Pragma("unroll") for (int i = 0; i < 8; ++i) f[i] = __expf(f[i]); } \
        LAS float* d_ = ring + (((hfx) & 1) * 8) * 384 + doff[k]; \
        *(LAS f32x4*)(d_) = (f32x4){f[0], f[1], f[2], f[3]}; *(LAS f32x4*)(d_ + (isv[k] ? 4 : 8)) = (f32x4){f[4], f[5], f[6], f[7]}; } } while (0)
    f32x2 S[R][8];
#pragma unroll
    for (int rr = 0; rr < R; ++rr)
#pragma unroll
        for (int k = 0; k < 8; ++k) { S[rr][k].x = (KINDP && (row0 + rr) == 16 * js + 2 * k) ? 1.f : 0.f; S[rr][k].y = (KINDP && (row0 + rr) == 16 * js + 2 * k + 1) ? 1.f : 0.f; }
    u32x4 pre[2];
    SCAN_LOAD(0); SCAN_WRITE(0);
    __syncthreads();
    for (int hf = 0; hf < NHALF; ++hf) {
        const bool more = hf + 1 < NHALF;
        if (more) SCAN_LOAD(hf + 1);
#pragma unroll 2
        for (int st = 0; st < 8; ++st) {
            const LAS float* sp = ring + ((hf & 1) * 8 + st) * 384 + 16 * js;
            f32x2 nn[8], ww[8], bb[8], kk[8], rr2[8];
#pragma unroll
            for (int i = 0; i < 4; ++i) { const f32x4 a = *(const LAS f32x4*)(sp + 4 * i); nn[2 * i] = (f32x2){a[0], a[1]}; nn[2 * i + 1] = (f32x2){a[2], a[3]}; }
#pragma unroll
            for (int i = 0; i < 4; ++i) { const f32x4 a = *(const LAS f32x4*)(sp + 64 + 4 * i); ww[2 * i] = (f32x2){a[0], a[1]}; ww[2 * i + 1] = (f32x2){a[2], a[3]}; }
#pragma unroll
            for (int i = 0; i < 4; ++i) { const f32x4 a = *(const LAS f32x4*)(sp + 128 + 4 * i); bb[2 * i] = (f32x2){a[0], a[1]}; bb[2 * i + 1] = (f32x2){a[2], a[3]}; }
            if (!KINDP) {
#pragma unroll
                for (int i = 0; i < 4; ++i) { const f32x4 a = *(const LAS f32x4*)(sp + 192 + 4 * i); kk[2 * i] = (f32x2){a[0], a[1]}; kk[2 * i + 1] = (f32x2){a[2], a[3]}; } }
#pragma unroll
            for (int i = 0; i < 4; ++i) { const f32x4 a = *(const LAS f32x4*)(sp + 256 + 4 * i); rr2[2 * i] = (f32x2){a[0], a[1]}; rr2[2 * i + 1] = (f32x2){a[2], a[3]}; }
            float vv[R];
            if (!KINDP) {
#pragma unroll
                for (int rr = 0; rr < R; ++rr) vv[rr] = ring[((hf & 1) * 8 + st) * 384 + 320 + row0 + rr]; }
            float sa[R];
#pragma unroll
            for (int rr = 0; rr < R; ++rr) { f32x2 p0 = S[rr][0] * nn[0], p1 = S[rr][1] * nn[1];
#pragma unroll
                for (int k = 2; k < 8; k += 2) { p0 = S[rr][k] * nn[k] + p0; p1 = S[rr][k + 1] * nn[k + 1] + p1; }
                p0 = p0 + p1; sa[rr] = quad_sum(p0.x + p0.y); }
            float y[R];
#pragma unroll
            for (int rr = 0; rr < R; ++rr) { const f32x2 sa2 = (f32x2){sa[rr], sa[rr]}; f32x2 p0 = (f32x2){0.f, 0.f}, p1 = (f32x2){0.f, 0.f};
#pragma unroll
                for (int k = 0; k < 8; k += 2) {
                    f32x2 t0 = S[rr][k] * ww[k], t1 = S[rr][k + 1] * ww[k + 1];
                    t0 = sa2 * bb[k] + t0; t1 = sa2 * bb[k + 1] + t1;
                    if (!KINDP) { const f32x2 v2 = (f32x2){vv[rr], vv[rr]}; t0 = v2 * kk[k] + t0; t1 = v2 * kk[k + 1] + t1; }
                    S[rr][k] = t0; S[rr][k + 1] = t1; p0 = t0 * rr2[k] + p0; p1 = t1 * rr2[k + 1] + p1; }
                p0 = p0 + p1; y[rr] = quad_sum(p0.x + p0.y); }
            if (js == 0) { const int t = hf * 8 + st;
                if (R == 2) { if (KINDP) *(unsigned*)(ZZ + (size_t)t * 64 + row0) = pk2(y[0], y[R - 1]); else *(f32x2*)(YL + (size_t)t * 64 + row0) = (f32x2){y[0], y[R - 1]}; }
                else {
#pragma unroll
                    for (int rr = 0; rr < R; ++rr) { if (KINDP) ZZ[(size_t)t * 64 + row0 + rr] = (bf16)f2bf(y[rr]); else YL[(size_t)t * 64 + row0 + rr] = y[rr]; } } }
        }
        if (more) SCAN_WRITE(hf + 1);
        __syncthreads();
    }
#undef SCAN_LOAD
#undef SCAN_WRITE
    if (NCH > 1) {
        float* st = WSP(float, AR_STATE) + ((size_t)(bh * NCH + ch) * 2 + (KINDP ? 0 : 1)) * 4096;
#pragma unroll
        for (int rr = 0; rr < R; ++rr)
#pragma unroll
            for (int i = 0; i < 4; ++i) *(f32x4*)(st + (size_t)(row0 + rr) * 64 + 16 * js + 4 * i) = (f32x4){S[rr][2 * i].x, S[rr][2 * i].y, S[rr][2 * i + 1].x, S[rr][2 * i + 1].y};
    }
}
template <int R, int NCH>
__device__ __forceinline__ void ph_scan(Frame& F) {
    PHASE_IDS();
    constexpr int KINDS = NCH > 1 ? 2 : 1, RG = 4 / R, WPS = KINDS * RG, SPW = NWAVES / WPS, NSTREAM = BATCH * NH * NCH;
    static_assert(WPS == 4, "staging assumes 4 waves per stream");
    const int sl = F.wave / WPS, role = F.wave % WPS, kind = (KINDS > 1) ? ((role / RG) ^ (sl & 1)) : 0, rg = role % RG, lis = role * 64 + F.lane;
    LAS float* ring = (LAS float*)F.lds + sl * (16 * 384);
    for (int it = blockIdx.x; it * SPW < NSTREAM; it += F.G) {
        const int sid = it * SPW + sl, bh = sid / NCH, ch = sid % NCH;
        __syncthreads();
        if (kind == 0) scan_stream<R, NCH, false>(F, ring, bh, ch, rg, lis); else scan_stream<R, NCH, true>(F, ring, bh, ch, rg, lis);
    }
}

template <int NCH>
__device__ __forceinline__ void ph_fix(Frame& F) {
    PHASE_IDS();
    typedef float f32x2 __attribute__((ext_vector_type(2)));
    LAS float* cur = (LAS float*)F.lds;
    for (int u = blockIdx.x; u < 256; u += F.G) { const int bh = u >> 2, rgx = u & 3, i = F.tid >> 5, j2 = (F.tid & 31) * 2, row = rgx * 16 + i;
        float* base = WSP(float, AR_STATE) + (size_t)bh * NCH * 2 * 4096;
        __syncthreads();
        { const f32x2 v = *(const f32x2*)(base + 4096 + row * 64 + j2); cur[i * 64 + j2] = v.x; cur[i * 64 + j2 + 1] = v.y; }
        __syncthreads();
        for (int c = 1; c < NCH - 1; ++c) { const float* P = base + (size_t)(c * 2) * 4096; float* SL = base + (size_t)(c * 2 + 1) * 4096;
            f32x2 acc = *(const f32x2*)(SL + row * 64 + j2);
#pragma unroll
            for (int ii = 0; ii < 64; ++ii) { const float sv = cur[i * 64 + ii]; const f32x2 p = *(const f32x2*)(P + ii * 64 + j2); acc.x += sv * p.x; acc.y += sv * p.y; }
            __syncthreads();
            cur[i * 64 + j2] = acc.x; cur[i * 64 + j2 + 1] = acc.y; *(f32x2*)(SL + row * 64 + j2) = acc;
            __syncthreads(); }
    }
}

template <int NCH>
__device__ __forceinline__ void ph_post(Frame& F, int l, bool dummy) {
    PHASE_IDS();
    constexpr int CLEN = SEQ / NCH;
    const float* YL = WSP(float, AR_YLOC); const bf16* SV = WSP(bf16, AR_SV); bf16* XB = WSP(bf16, WS_XB); const float* BONUS = WSP(float, WS_BONUS); const bf16* ZZ = WSP(bf16, AR_Z);
    LAS float* zt = (LAS float*)F.lds;
    const int c = F.tid, h = F.wave, j = F.lane; const float lng = FIN(I_LNG)[l * RW + c], lnb = FIN(I_LNB)[l * RW + c];
    for (int grp = blockIdx.x; grp < M / 64; grp += F.G) { const int t0g = grp * 64, bb = t0g >> 11, ch = (t0g & 2047) / CLEN, bh = bb * 8 + h; const bool corr = NCH > 1 && ch > 0;
        float st[64];
        if (corr) { const float* sp = WSP(float, AR_STATE) + ((size_t)(bh * NCH + ch - 1) * 2 + 1) * 4096 + j * 64;
#pragma unroll
            for (int i4 = 0; i4 < 16; ++i4) { const f32x4 v = *(const f32x4*)(sp + 4 * i4); st[4 * i4] = v[0]; st[4 * i4 + 1] = v[1]; st[4 * i4 + 2] = v[2]; st[4 * i4 + 3] = v[3]; } }
        for (int ti = 0; ti < 4; ++ti) { const int t0 = t0g + 16 * ti;
            if (corr) { __syncthreads();
#pragma unroll 4
                for (int tt = 0; tt < 16; ++tt) zt[tt * 512 + c] = bf2f(ZZ[((size_t)bh * 2048 + ((t0 + tt) & 2047)) * 64 + j]);
                __syncthreads(); }
#pragma unroll 1
            for (int tb = 0; tb < 16; tb += 8) {
                float yv[8], vv[8], bv[8], gv[8];
#pragma unroll
                for (int q = 0; q < 8; ++q) { const int t = t0 + tb + q, tp = t & 2047;
                    yv[q] = YL[((size_t)bh * 2048 + tp) * 64 + j]; vv[q] = bf2f(SV[((size_t)bh * 2048 + tp) * 64 + j]); bv[q] = BONUS[(size_t)t * 8 + h]; gv[q] = bf2f(XB[(size_t)t * 1024 + c]); }
                if (corr) {
#pragma unroll
                    for (int q = 0; q < 8; ++q) { const LAS float* zp = zt + (tb + q) * 512 + h * 64; float p0 = 0.f, p1 = 0.f, p2 = 0.f, p3 = 0.f;
#pragma unroll
                        for (int qq = 0; qq < 4; ++qq) { asm volatile("" ::: "memory");
                            f32x4 zz[4];
#pragma unroll
                            for (int e = 0; e < 4; ++e) zz[e] = *(const LAS f32x4*)(zp + 16 * qq + 4 * e);
#pragma unroll
                            for (int e = 0; e < 4; ++e) { const int j4 = 4 * qq + e; p0 += st[4 * j4] * zz[e][0]; p1 += st[4 * j4 + 1] * zz[e][1]; p2 += st[4 * j4 + 2] * zz[e][2]; p3 += st[4 * j4 + 3] * zz[e][3]; }
                            asm volatile("" : "+v"(p0), "+v"(p1), "+v"(p2), "+v"(p3)); }
                        yv[q] += (p0 + p1) + (p2 + p3); } }
                float mean[8], var[8];
#pragma unroll
                for (int q = 0; q < 8; ++q) mean[q] = yv[q];
                wave_sum8(mean);
#pragma unroll
                for (int q = 0; q < 8; ++q) { mean[q] *= (1.0f / 64.0f); yv[q] -= mean[q]; var[q] = yv[q] * yv[q]; }
                wave_sum8(var);
#pragma unroll
                for (int q = 0; q < 8; ++q) { const int t = t0 + tb + q;
                    const float yn = yv[q] * __builtin_amdgcn_rsqf(var[q] * (1.0f / 64.0f) + LNX_EPS) * lng + lnb;
                    if (dummy) WSP(bf16, WS_AR + 48 * MiB)[((size_t)t * 1024 + c) & 0x3fffff] = (bf16)f2bf((yn + bv[q] * vv[q]) * gv[q]);
                    else XB[(size_t)t * 1024 + c] = (bf16)f2bf((yn + bv[q] * vv[q]) * gv[q]); }
            }
        }
    }
}

__device__ __forceinline__ void ph_final(Frame& F) {
    PHASE_IDS();
    const int gw = F.vcu * NWAVES + F.wave, NGW = F.G * NWAVES; const float* ssq = WSP(float, WS_SSQ); const float* g = FIN(I_FING);
    f32x4 gv[4];
#pragma unroll
    for (int j = 0; j < 4; ++j) gv[j] = ((const f32x4*)g)[F.lane + 64 * j];
    for (int r = gw; r < M; r += NGW) { const float rs = pg8::row_rstd16(ssq, r); f32x4* xr = (f32x4*)(F.out + (size_t)r * DM) + F.lane;
#pragma unroll
        for (int j = 0; j < 4; ++j) { const f32x4 v = xr[64 * j]; xr[64 * j] = v * rs * gv[j]; } }
}

constexpr int PH_INIT = 0, PH_PER_LAYER = 16, PH_FINAL = 1 + DEPTH * PH_PER_LAYER, N_PHASES = PH_FINAL + 1;
enum { K_CONV = 0, K_KV, K_F1UP, K_F1DN, K_MIXIN, K_MOBA, K_PREP, K_SCAN, K_FIX, K_POST, K_MIXOUT, K_XQ, K_XATT, K_XO, K_F2UP, K_F2DN };

#ifdef ONLY
#define PH_ON(k) ((k) == (ONLY))
#else
#define PH_ON(k) true
#endif
__global__ void __launch_bounds__(NWAVES * 64, 2) fwd(Args args) {
    extern __shared__ __attribute__((aligned(16))) unsigned char lds[];
    Frame F;
    F.lds = (LAS unsigned char*)lds; F.MISC = (volatile LAS unsigned*)(F.lds + MISC_OFF);
    F.tid = threadIdx.x; F.lane = F.tid & 63; F.wave = __builtin_amdgcn_readfirstlane(F.tid >> 6);
    F.G = gridDim.x; { const int bx = blockIdx.x; F.vcu = (F.G % 8 == 0) ? (bx % 8) * (F.G / 8) + bx / 8 : bx; }
    F.out = args.out; F.ws = args.ws; F.ctl = (gu32*)(args.ws + WS_CTL);
    F.ka = (const __attribute__((address_space(4))) Args*)(uintptr_t)__builtin_amdgcn_kernarg_segment_ptr();
    for (int u = F.tid; u < (LDS_BYTES - LDSCTL_OFF) / 4; u += NWAVES * 64) ((LAS unsigned*)(F.lds + LDSCTL_OFF))[u] = 0u;
    __syncthreads();
    const bool multi = args.ph_hi - args.ph_lo > 1;
    XcdBarrier bar; bar.bar = (unsigned*)(F.ctl + 4096); bar.x = 0; bar.st = nullptr;
    if (multi) bar = xcd_barrier_post((unsigned*)(F.ctl + 4096), F.MISC + 8);
#ifndef REP_AT
#define REP_AT 1000
#endif
    for (int pi = args.ph_lo; pi < args.ph_hi + (REP_AT < 1000 ? 1 : 0); ++pi) { const int ph = pi - (pi > REP_AT ? 1 : 0);
        const bool dummy = REP_AT < 1000 && pi == REP_AT;
        { uintptr_t kp = (uintptr_t)__builtin_amdgcn_kernarg_segment_ptr(); asm volatile("" : "+s"(kp)); F.ka = (const __attribute__((address_space(4))) Args*)kp; }
        unsigned char* wb = F.ws + WS_W;
        if (ph == PH_INIT) { if (PH_ON(100)) { ph_init(F); ph_conv(F, 0); } }
        else if (ph == PH_FINAL) { if (PH_ON(101)) ph_final(F); }
        else { const int l = (ph - 1) / PH_PER_LAYER, k = (ph - 1) % PH_PER_LAYER;
            const float* xin = (l == 0) ? FIN(I_X) : (const float*)F.out;
            switch (k) {
            case K_CONV: if (!PH_ON(K_CONV)) break; if (l > 0) ph_conv(F, l); break;
            case K_KV: break;
            case K_F1UP: case K_F2UP: if (!PH_ON(K_F1UP)) break; { pg8::Gemm g{WSP(bf16, WS_XB), (const bf16*)(wb + (k == K_F1UP ? W_F1IN : W_F2IN)), M, 2 * DFF, DM}; pg8::StaticOrder S; S.init(M, 2 * DFF, F.G, (int)blockIdx.x);
                pg8::EpiSwiGLU E{F.ws, F.lds}; fill_rstd(F, S); pg8::gemm_phase<pg8::EpiSwiGLU, pg8::StaticOrder, true, true>(F.lds, g, S, E); } break;
            case K_F1DN: case K_F2DN: if (!PH_ON(K_F1DN)) break; { pg8::Gemm g{WSP(bf16, AR_H), (const bf16*)(wb + (k == K_F1DN ? W_F1OUT : W_F2OUT)), M, DM, DFF}; pg8::StaticOrder S; S.init(M, DM, F.G, (int)blockIdx.x);
                pg8::EpiResid E{k == K_F1DN ? xin : (const float*)F.out, dummy ? WSP(float, WS_AR + 96 * MiB) : F.out, F.ws, dummy ? WS_AR + 100 * MiB : WS_XB, 0.5f}; pg8::gemm_phase<pg8::EpiResid, pg8::StaticOrder, true, true>(F.lds, g, S, E); } break;
            case K_MIXIN: if (!PH_ON(K_MIXIN)) break; { pg8::Gemm g{WSP(bf16, WS_XB), (const bf16*)(wb + W_MIXIN), M, DPROJ, DM}; pg8::StaticOrder S; S.init(M, DPROJ, F.G, (int)blockIdx.x);
                pg8::EpiMixIn E{F.ws, F.lds}; fill_rstd(F, S); pg8::gemm_phase<pg8::EpiMixIn, pg8::StaticOrder, true, true>(F.lds, g, S, E); }
                {
                  pg8::Gemm g{WSP(bf16, WS_MEMB), (const bf16*)(wb + W_WKV), MM, 2 * DM, DM}; pg8::StaticOrder S; S.init(MM, 2 * DM, F.G, (int)((blockIdx.x + F.G - 64) % F.G));
                  pg8::EpiKV E{F.ws}; pg8::gemm_phase<pg8::EpiKV, pg8::StaticOrder, true, true>(F.lds, g, S, E); } break;
            case K_MOBA: if (!PH_ON(K_MOBA)) break; ph_moba(F); break;
            case K_PREP: if (!PH_ON(K_PREP)) break; ph_prep(F, l); break;
            case K_SCAN: if (!PH_ON(K_SCAN)) break; ph_scan<SCAN_R, SCAN_NCH>(F); break;
            case K_FIX: if (!PH_ON(K_FIX)) break; if (SCAN_NCH > 1) ph_fix<SCAN_NCH>(F); break;
            case K_POST: if (!PH_ON(K_POST)) break; ph_post<SCAN_NCH>(F, l, dummy); break;
            case K_MIXOUT: if (!PH_ON(K_MIXOUT)) break; { pg8::Gemm g{WSP(bf16, WS_XB), (const bf16*)(wb + W_MIXOUT), M, DM, DM}; pg8::StaticOrder S; S.init(M, DM, F.G, (int)blockIdx.x);
                pg8::EpiResid E{F.out, dummy ? WSP(float, WS_AR + 96 * MiB) : F.out, F.ws, dummy ? WS_AR + 100 * MiB : AR_XB2, 1.0f}; pg8::gemm_phase<pg8::EpiResid, pg8::StaticOrder, true, true>(F.lds, g, S, E); } break;
            case K_XQ: if (!PH_ON(K_XQ)) break; { pg8::Gemm g{WSP(bf16, AR_XB2), (const bf16*)(wb + W_WQ), M, DM, DM}; pg8::StaticOrder S; S.init(M, DM, F.G, (int)blockIdx.x);
                pg8::EpiXQ E{F.ws, F.lds}; fill_rstd(F, S); pg8::gemm_phase<pg8::EpiXQ, pg8::StaticOrder, true, true>(F.lds, g, S, E);
                asm volatile("s_waitcnt vmcnt(0)" ::: "memory"); __syncthreads();
                if (threadIdx.x == 0) { __builtin_amdgcn_fence(__ATOMIC_ACQUIRE, "agent"); asm volatile("s_waitcnt vmcnt(0)" ::: "memory"); }
                __syncthreads();
                ph_xatt(F, S); } break;
            case K_XATT: break;
            case K_XO: if (!PH_ON(K_XO)) break; { pg8::Gemm g{WSP(bf16, AR_XO), (const bf16*)(wb + W_WO), M, DM, DM}; pg8::StaticOrder S; S.init(M, DM, F.G, (int)blockIdx.x);
                pg8::EpiResid E{F.out, dummy ? WSP(float, WS_AR + 96 * MiB) : F.out, F.ws, dummy ? WS_AR + 100 * MiB : WS_XB, 1.0f}; pg8::gemm_phase<pg8::EpiResid, pg8::StaticOrder, true, true>(F.lds, g, S, E); } break;
            default: break;
            }
        }
        if (pi + 1 < args.ph_hi + (REP_AT < 1000 ? 1 : 0)) {
            const int kk_ = (ph - 1) % PH_PER_LAYER, ll_ = (ph - 1) / PH_PER_LAYER;
            const bool noop = ph != PH_INIT && ph != PH_FINAL && ((kk_ == K_FIX && SCAN_NCH == 1) || kk_ == K_KV || kk_ == K_XATT || (kk_ == K_CONV && ll_ == 0));
            if (!noop) xcd_barrier(bar);
        }
    }
}

extern "C" void kernel_launch(void* const* d_in, const int* in_sizes, int n_in, void* d_out, int out_size, void* d_ws, size_t ws_size, hipStream_t stream) {
    static int grid = 0;
    if (grid == 0) {
        if (n_in != N_IN || in_sizes[0] != M * DM || out_size != M * DM || ws_size < WS_END) { fprintf(stderr, "kernel_launch: unexpected problem (n_in %d, in0 %d, out %d, ws %zu < %zu); nothing launched\n", n_in, n_in > 0 ? in_sizes[0] : -1, out_size, ws_size, (size_t)WS_END); grid = -1; return; }
        int dev = 0, cus = 0;
        if (hipGetDevice(&dev) != hipSuccess || hipDeviceGetAttribute(&cus, hipDeviceAttributeMultiprocessorCount, dev) != hipSuccess) { grid = -1; return; }
        if (hipFuncSetAttribute((const void*)fwd, hipFuncAttributeMaxDynamicSharedMemorySize, LDS_BYTES) != hipSuccess) { fprintf(stderr, "kernel_launch: hipFuncSetAttribute failed\n"); grid = -1; return; }
        int per_cu = 0;
        if (hipOccupancyMaxActiveBlocksPerMultiprocessor(&per_cu, (const void*)fwd, NWAVES * 64, LDS_BYTES) != hipSuccess || per_cu < 1) { fprintf(stderr, "kernel_launch: occupancy query reports %d workgroups per CU; nothing launched\n", per_cu); grid = -1; return; }
        grid = cus;
    }
    if (grid < 0) return;
    (void)hipMemsetAsync((char*)d_ws + WS_CTL, 0, CTL_ZERO_BYTES, stream);
    Args a{};
    for (int i = 0; i < N_IN; ++i) a.in[i] = (const float*)d_in[i];
    a.out = (float*)d_out; a.ws = (unsigned char*)d_ws;
    a.ph_lo = 0; a.ph_hi = N_PHASES;
    void* kargs[] = {&a};
    const hipError_t e = hipLaunchCooperativeKernel((const void*)fwd, dim3(grid), dim3(NWAVES * 64), kargs, LDS_BYTES, stream);
    if (e != hipSuccess) fprintf(stderr, "kernel_launch: cooperative launch failed: %s (grid %d)\n", hipGetErrorString(e), grid);
}
```
